# Optimizing an MI355X kernel written in HIP

```python
import math
import jax, jax.numpy as jnp
from jax import lax
import numpy as np

D_MODEL = 1024
BATCH = 8
SEQ = 4096
DEPTH = 1

MIX_WIDTH = D_MODEL
RWKV_WIDTH = MIX_WIDTH // 2
RWKV_HEAD_DIM = 64
RWKV_HEADS = RWKV_WIDTH // RWKV_HEAD_DIM
DECAY_LORA = 64
ICLR_LORA = 64
GATE_LORA = 128
RWKV_COLS = 3 * RWKV_WIDTH + DECAY_LORA + ICLR_LORA + GATE_LORA
DIFF_WIDTH = MIX_WIDTH - RWKV_WIDTH
DIFF_HEAD_DIM = 64
DIFF_HEADS = DIFF_WIDTH // (2 * DIFF_HEAD_DIM)
DIFF_COLS = 3 * DIFF_WIDTH
IN_COLS = RWKV_COLS + DIFF_COLS
Q_BLOCK = 128
N_EXPERTS = 32
TOP_K = 4
D_EXPERT = D_MODEL
SWIGLU_LIMIT = 7.0
SWIGLU_ALPHA = 1.702
MOE_BLOCK = 512
NORM_EPS = 1e-5
GN_EPS = 64e-5

kernel_name = "hymba_rwkv7_diffattn_alibi_moe_adaln"


def rms_norm(x, gain, eps=NORM_EPS):
    xf = x.astype(jnp.float32)
    y = xf * lax.rsqrt(jnp.mean(xf * xf, axis=-1, keepdims=True) + eps)
    return (y * gain.astype(jnp.float32)).astype(x.dtype)


def token_shift_lerp(y, mu):
    prev = jnp.pad(y, ((0, 0), (1, 0), (0, 0)))[:, :-1]
    return y + mu * (prev - y)


def alibi_slopes(n_heads):
    return jnp.asarray([2.0 ** (-8.0 * (i + 1) / n_heads) for i in range(n_heads)], jnp.float32)


def rwkv7_mixer(p, shift_mu, w0, w_up, a0, a_up, g_up, k_k, k_a, r_k, gn_gain, gn_bias):
    f32 = jnp.float32
    B, S, _ = p.shape
    H, Dh = RWKV_HEADS, RWKV_HEAD_DIM
    p = token_shift_lerp(p.astype(f32), shift_mu.astype(f32))
    splits = np.cumsum([RWKV_WIDTH, RWKV_WIDTH, RWKV_WIDTH, DECAY_LORA, ICLR_LORA]).tolist()
    r, k, v, w_lo, a_lo, g_lo = jnp.split(p, splits, axis=-1)
    w = -jax.nn.softplus(-(w0.astype(f32) + jnp.tanh(w_lo) @ w_up.astype(f32))) - 0.5
    decay = jnp.exp(-jnp.exp(w))
    a = jax.nn.sigmoid(a0.astype(f32) + a_lo @ a_up.astype(f32))
    g = jax.nn.sigmoid(g_lo) @ g_up.astype(f32)
    kk = (k * k_k.astype(f32)).reshape(B, S, H, Dh)
    kk = kk / jnp.maximum(jnp.linalg.norm(kk, axis=-1, keepdims=True), 1e-12)
    k = k * (1.0 + (a - 1.0) * k_a.astype(f32))
    rh, kh, vh = (t.reshape(B, S, H, Dh) for t in (r, k, v))
    wh = decay.reshape(B, S, H, Dh)
    ah = a.reshape(B, S, H, Dh)
    a_vec = -kk
    b_vec = kk * ah

    def step(state, inp):
        r_t, k_t, v_t, w_t, a_t, b_t = inp
        sa = jnp.einsum('bhvk,bhk->bhv', state, a_t)
        state = (state * w_t[:, :, None, :] + sa[..., None] * b_t[:, :, None, :]
                 + v_t[..., None] * k_t[:, :, None, :])
        return state, jnp.einsum('bhvk,bhk->bhv', state, r_t)

    xs = tuple(jnp.moveaxis(t, 1, 0) for t in (rh, kh, vh, wh, a_vec, b_vec))
    state0 = jnp.zeros((B, H, Dh, Dh), f32)
    _, ys = lax.scan(step, state0, xs)
    y = jnp.moveaxis(ys, 0, 1)
    mean = jnp.mean(y, axis=-1, keepdims=True)
    var = jnp.mean(jnp.square(y - mean), axis=-1, keepdims=True)
    y = ((y - mean) * lax.rsqrt(var + GN_EPS)).reshape(B, S, RWKV_WIDTH)
    y = y * gn_gain.astype(f32) + gn_bias.astype(f32)
    bonus = jnp.sum(rh * kh * r_k.astype(f32), axis=-1, keepdims=True) * vh
    y = (y + bonus.reshape(B, S, RWKV_WIDTH)) * g
    return y


def diff_attention(p, lambda_init, lambda_q1, lambda_k1, lambda_q2, lambda_k2, subln_gain):
    f32 = jnp.float32
    B, S, _ = p.shape
    H, Dh = DIFF_HEADS, DIFF_HEAD_DIM
    nb = S // Q_BLOCK
    q, k, v = jnp.split(p, 3, axis=-1)
    q = q.reshape(B, S, H, 2, Dh)
    k = k.reshape(B, S, H, 2, Dh)
    v = v.reshape(B, S, H, 2 * Dh)
    scale = 1.0 / math.sqrt(Dh)
    lam = (jnp.exp(jnp.sum(lambda_q1.astype(f32) * lambda_k1.astype(f32)))
           - jnp.exp(jnp.sum(lambda_q2.astype(f32) * lambda_k2.astype(f32))) + lambda_init)
    slopes = alibi_slopes(H)
    qb = q.reshape(B, nb, Q_BLOCK, H, 2, Dh).transpose(1, 0, 3, 4, 2, 5)
    kt = k.transpose(0, 2, 3, 1, 4)
    vt = v.transpose(0, 2, 1, 3)
    key_pos = jnp.arange(S, dtype=jnp.int32)
    starts = jnp.arange(nb, dtype=jnp.int32) * Q_BLOCK

    def attend(args):
        q_blk, start = args
        q_pos = start + jnp.arange(Q_BLOCK, dtype=jnp.int32)
        dist = (q_pos[:, None] - key_pos[None, :]).astype(f32)
        s = jnp.einsum('bhcqd,bhcsd->bhcqs', q_blk, kt).astype(f32) * scale
        s = s - slopes[None, :, None, None, None] * dist
        s = jnp.where(dist >= 0, s, -jnp.inf)
        pr = jax.nn.softmax(s, axis=-1)
        attn = pr[:, :, 0] - lam * pr[:, :, 1]
        return jnp.einsum('bhqs,bhsd->bhqd', attn.astype(vt.dtype), vt)

    out = lax.map(attend, (qb, starts))
    out = out.transpose(1, 0, 3, 2, 4).reshape(B, S, H, 2 * Dh)
    out = rms_norm(out, subln_gain) * (1.0 - lambda_init)
    return out.reshape(B, S, DIFF_WIDTH).astype(p.dtype)


def moe_ffn(h, router_w, router_b, w_gate_up, b_gate_up, w_down, b_down):
    B, S, D = h.shape
    T = B * S
    A = T * TOP_K
    hf = h.reshape(T, D)
    logits = (hf @ router_w + router_b).astype(jnp.float32)
    top_logits, top_idx = lax.top_k(logits, TOP_K)
    top_w = jax.nn.softmax(top_logits, axis=-1)
    e_flat = top_idx.reshape(A).astype(jnp.int32)
    w_flat = top_w.reshape(A)
    tok_flat = jnp.arange(A, dtype=jnp.int32) // TOP_K
    order = jnp.argsort(e_flat)
    e_s, tok_s, w_s = e_flat[order], tok_flat[order], w_flat[order]
    counts = jnp.bincount(e_flat, length=N_EXPERTS)
    starts = jnp.cumsum(counts) - counts
    padded = ((counts + MOE_BLOCK - 1) // MOE_BLOCK) * MOE_BLOCK
    pad_ends = jnp.cumsum(padded)
    pad_starts = pad_ends - padded
    slot = pad_starts[e_s] + (jnp.arange(A, dtype=jnp.int32) - starts[e_s])
    n_blocks = -(-(A + N_EXPERTS * (MOE_BLOCK - 1)) // MOE_BLOCK)
    P = n_blocks * MOE_BLOCK
    slot_tok = jnp.zeros((P,), jnp.int32).at[slot].set(tok_s)
    slot_w = jnp.zeros((P,), jnp.float32).at[slot].set(w_s)
    block_e = jnp.minimum(
        jnp.searchsorted(pad_ends, jnp.arange(n_blocks, dtype=pad_ends.dtype) * MOE_BLOCK, side='right'),
        N_EXPERTS - 1).astype(jnp.int32)

    def expert_block(args):
        tok, wt, e = args
        xb = hf[tok]
        gu = xb @ w_gate_up[e] + b_gate_up[e]
        gate, up = gu[:, :D_EXPERT], gu[:, D_EXPERT:]
        gate = jnp.minimum(gate, SWIGLU_LIMIT)
        up = jnp.clip(up, -SWIGLU_LIMIT, SWIGLU_LIMIT)
        act = (up + 1.0) * (gate * jax.nn.sigmoid(SWIGLU_ALPHA * gate))
        y = act @ w_down[e] + b_down[e]
        return y * wt[:, None].astype(y.dtype)

    ys = lax.map(expert_block, (slot_tok.reshape(n_blocks, MOE_BLOCK),
                                slot_w.reshape(n_blocks, MOE_BLOCK), block_e))
    out = jnp.zeros((T, D), ys.dtype).at[slot_tok].add(ys.reshape(P, D))
    return out.reshape(B, S, D).astype(h.dtype)


def hybrid_layer(x, c, lambda_init, mod_w, mod_b, norm1_gain, w_in, rwkv_shift_mu, rwkv_w0,
                 rwkv_w_up, rwkv_a0, rwkv_a_up, rwkv_g_up, rwkv_k_k, rwkv_k_a, rwkv_r_k,
                 rwkv_gn_gain, rwkv_gn_bias, diff_lambda_q1, diff_lambda_k1, diff_lambda_q2,
                 diff_lambda_k2, diff_subln_gain, w_out, norm2_gain, router_w, router_b,
                 w_gate_up, b_gate_up, w_down, b_down):
    mod = jax.nn.silu(c) @ mod_w + mod_b
    shift1, scale1, gate1, shift2, scale2, gate2 = jnp.split(mod[:, None, :], 6, axis=-1)
    h = rms_norm(x, norm1_gain) * (1.0 + scale1) + shift1
    proj = h @ w_in
    y_rwkv = rwkv7_mixer(proj[..., :RWKV_COLS], rwkv_shift_mu, rwkv_w0, rwkv_w_up, rwkv_a0,
                         rwkv_a_up, rwkv_g_up, rwkv_k_k, rwkv_k_a, rwkv_r_k, rwkv_gn_gain,
                         rwkv_gn_bias).astype(x.dtype)
    y_diff = diff_attention(proj[..., RWKV_COLS:], lambda_init, diff_lambda_q1, diff_lambda_k1,
                            diff_lambda_q2, diff_lambda_k2, diff_subln_gain)
    mix = jnp.concatenate([y_rwkv, y_diff], axis=-1) @ w_out
    x = x + gate1 * mix
    h = rms_norm(x, norm2_gain) * (1.0 + scale2) + shift2
    x = x + gate2 * moe_ffn(h, router_w, router_b, w_gate_up, b_gate_up, w_down, b_down)
    return x


def setup_inputs(seed: int = 0) -> dict:
    key = jax.random.key(seed)
    ks = jax.random.split(key, 40)
    L, D = DEPTH, D_MODEL
    nrm = lambda k, shape, s: jax.random.normal(k, shape, jnp.float32) * s
    return {
        "x": nrm(ks[0], (BATCH, SEQ, D), 1.0),
        "c": nrm(ks[1], (BATCH, D), 1.0),
        "mod_w": nrm(ks[2], (L, D, 6 * D), 0.5 * D ** -0.5),
        "mod_b": nrm(ks[3], (L, 6 * D), 0.02),
        "norm1_gain": 1.0 + nrm(ks[4], (L, D), 0.01),
        "w_in": nrm(ks[5], (L, D, IN_COLS), D ** -0.5),
        "rwkv_shift_mu": jax.random.uniform(ks[6], (L, RWKV_COLS), jnp.float32),
        "rwkv_w0": nrm(ks[7], (L, RWKV_WIDTH), 0.5),
        "rwkv_w_up": nrm(ks[8], (L, DECAY_LORA, RWKV_WIDTH), 0.5 * DECAY_LORA ** -0.5),
        "rwkv_a0": nrm(ks[9], (L, RWKV_WIDTH), 0.5),
        "rwkv_a_up": nrm(ks[10], (L, ICLR_LORA, RWKV_WIDTH), 0.5 * ICLR_LORA ** -0.5),
        "rwkv_g_up": nrm(ks[11], (L, GATE_LORA, RWKV_WIDTH), GATE_LORA ** -0.5),
        "rwkv_k_k": 0.85 + nrm(ks[12], (L, RWKV_WIDTH), 0.05),
        "rwkv_k_a": 1.0 + nrm(ks[13], (L, RWKV_WIDTH), 0.05),
        "rwkv_r_k": nrm(ks[14], (L, RWKV_HEADS, RWKV_HEAD_DIM), 0.1),
        "rwkv_gn_gain": 1.0 + nrm(ks[15], (L, RWKV_WIDTH), 0.01),
        "rwkv_gn_bias": nrm(ks[16], (L, RWKV_WIDTH), 0.01),
        "diff_lambda_q1": nrm(ks[17], (L, DIFF_HEAD_DIM), 0.1),
        "diff_lambda_k1": nrm(ks[18], (L, DIFF_HEAD_DIM), 0.1),
        "diff_lambda_q2": nrm(ks[19], (L, DIFF_HEAD_DIM), 0.1),
        "diff_lambda_k2": nrm(ks[20], (L, DIFF_HEAD_DIM), 0.1),
        "diff_subln_gain": 1.0 + nrm(ks[21], (L, 2 * DIFF_HEAD_DIM), 0.01),
        "w_out": nrm(ks[22], (L, MIX_WIDTH, D), MIX_WIDTH ** -0.5),
        "norm2_gain": 1.0 + nrm(ks[23], (L, D), 0.01),
        "router_w": nrm(ks[24], (L, D, N_EXPERTS), D ** -0.5),
        "router_b": nrm(ks[25], (L, N_EXPERTS), 0.01),
        "w_gate_up": nrm(ks[26], (L, N_EXPERTS, D, 2 * D_EXPERT), D ** -0.5),
        "b_gate_up": nrm(ks[27], (L, N_EXPERTS, 2 * D_EXPERT), 0.01),
        "w_down": nrm(ks[28], (L, N_EXPERTS, D_EXPERT, D), D_EXPERT ** -0.5),
        "b_down": nrm(ks[29], (L, N_EXPERTS, D), 0.01),
        "final_gain": 1.0 + nrm(ks[30], (D,), 0.01),
    }


def reference(x, c, mod_w, mod_b, norm1_gain, w_in, rwkv_shift_mu, rwkv_w0, rwkv_w_up, rwkv_a0,
              rwkv_a_up, rwkv_g_up, rwkv_k_k, rwkv_k_a, rwkv_r_k, rwkv_gn_gain, rwkv_gn_bias,
              diff_lambda_q1, diff_lambda_k1, diff_lambda_q2, diff_lambda_k2, diff_subln_gain,
              w_out, norm2_gain, router_w, router_b, w_gate_up, b_gate_up, w_down, b_down,
              final_gain):
    for l in range(DEPTH):
        lambda_init = 0.8 - 0.6 * math.exp(-0.3 * l)
        x = hybrid_layer(
            x, c, lambda_init, mod_w[l], mod_b[l], norm1_gain[l], w_in[l], rwkv_shift_mu[l],
            rwkv_w0[l], rwkv_w_up[l], rwkv_a0[l], rwkv_a_up[l], rwkv_g_up[l], rwkv_k_k[l],
            rwkv_k_a[l], rwkv_r_k[l], rwkv_gn_gain[l], rwkv_gn_bias[l], diff_lambda_q1[l],
            diff_lambda_k1[l], diff_lambda_q2[l], diff_lambda_k2[l], diff_subln_gain[l],
            w_out[l], norm2_gain[l], router_w[l], router_b[l], w_gate_up[l], b_gate_up[l],
            w_down[l], b_down[l])
    return rms_norm(x, final_gain)
```

```cpp
#include <hip/hip_runtime.h>
#include <hip/hip_cooperative_groups.h>
#include <cstdio>
#include <cstdint>
namespace cg = cooperative_groups;

#ifndef DBG_STAGE
#define DBG_STAGE 99
#endif

#define LAS __attribute__((address_space(3)))
typedef unsigned short bf16_t;
typedef short bf16x8 __attribute__((ext_vector_type(8)));
typedef short s16x4 __attribute__((ext_vector_type(4)));
typedef float f32x4 __attribute__((ext_vector_type(4)));
typedef float f32x16 __attribute__((ext_vector_type(16)));
typedef float f32x2_t __attribute__((ext_vector_type(2)));
typedef __bf16 bf16x2_t __attribute__((ext_vector_type(2)));
typedef unsigned u32x4 __attribute__((ext_vector_type(4)));
typedef unsigned u32x2 __attribute__((ext_vector_type(2)));

constexpr int D = 1024, NB = 8, SEQ = 4096, T = NB * SEQ;
constexpr int RW = 512, RC = 1792, DC = 1536, IC = 3328;
constexpr int NE = 32, TOPK = 4, NA = T * TOPK;
constexpr int PMAX = NA + NE * 256;
constexpr float NORM_EPS = 1e-5f, GN_EPS = 64e-5f;
constexpr float LOG2E = 1.4426950408889634f;
constexpr float QSCALE = 0.125f * LOG2E;
constexpr float LAMBDA_INIT = 0.2f;
constexpr int NTHREADS = 512, NWAVES = 8;
constexpr int LDS_BYTES = 163840;

constexpr size_t MiB = 1u << 20;
constexpr size_t WS_CTL = 0;
constexpr size_t CTL_BYTES = 65536;
constexpr size_t WS_MOD = 1 * MiB;
constexpr size_t WS_TILE = 1 * MiB + 512 * 1024;
constexpr size_t WS_WIN_T = 2 * MiB;
constexpr size_t WS_WOUT_T = 9 * MiB;
constexpr size_t WS_ROUTE = 11 * MiB;
constexpr size_t WS_WG_T = 16 * MiB;
constexpr size_t WS_WD_T = 144 * MiB;
constexpr size_t WS_H = 208 * MiB;
constexpr size_t WS_YMIX = 272 * MiB;
constexpr size_t WS_PROJ = 336 * MiB;
constexpr size_t WS_ACT = 608 * MiB;
constexpr size_t WS_END = 880 * MiB;

__device__ __forceinline__ unsigned cvtpk(float lo, float hi) { f32x2_t v = {lo, hi}; bf16x2_t b = __builtin_convertvector(v, bf16x2_t); return __builtin_bit_cast(unsigned, b); }
__device__ __forceinline__ float bf2f(unsigned short u) { return __uint_as_float(((unsigned)u) << 16); }
__device__ __forceinline__ float wave_sum(float v) {
#pragma unroll
    for (int o = 1; o < 64; o <<= 1) v += __shfl_xor(v, o);
    return v;
}
__device__ __forceinline__ float wave_max(float v) {
#pragma unroll
    for (int o = 1; o < 64; o <<= 1) v = fmaxf(v, __shfl_xor(v, o));
    return v;
}
__device__ __forceinline__ float sigmoidf_(float x) { return 1.0f / (1.0f + __expf(-x)); }

struct Params {
    const float* in[31];
    float* out;
    unsigned char* ws;
};
enum { I_X = 0, I_C, I_MODW, I_MODB, I_N1G, I_WIN, I_MU, I_W0, I_WUP, I_A0, I_AUP, I_GUP, I_KK, I_KA, I_RK, I_GNG, I_GNB, I_LQ1, I_LK1, I_LQ2, I_LK2, I_SUBLN, I_WOUT, I_N2G, I_RTW, I_RTB, I_WGU, I_BGU, I_WDN, I_BDN, I_FG };

namespace pg8 {
constexpr int BM = 256, BK = 64, HALF = 128, HTB = HALF * BK * 2, STAGE_BYTES = 8 * HTB, NXCD = 8, WGM = 8;
__host__ __device__ __forceinline__ int lds_byte(int r, int c) { const int st = (r >> 4) * 2 + (c >> 5), rr = r & 15, cc = c & 31, ob = rr * 64 + cc * 2; return st * 1024 + (ob ^ (((ob >> 9) & 1) << 5)); }
__host__ __device__ __forceinline__ void stage_rc(int b, int& R, int& C) { const int st = b / 1024, sb = b % 1024, swz = sb ^ (((sb >> 9) & 1) << 5); R = (st >> 1) * 16 + swz / 64; C = (st & 1) * 32 + (swz % 64) / 2; }
__host__ __device__ __forceinline__ int perm32(int rho) { const int n = rho >> 4, i = rho & 15; return 8 * (i >> 2) + 4 * n + (i & 3); }

struct Unit { int pm, pn, arow, brow, e; };
struct Gemm { const bf16_t* A; const bf16_t* Bt; int K; };

struct TileOrder {
    int nM, nN, nwg, G, c;
    __device__ void init(int nM_, int nN_, int G_, int c_) { nM = nM_; nN = nN_; nwg = nM * nN; G = G_; c = c_; }
    __device__ bool map(int i, int& pm, int& pn) const {
        const long L = (long)i * G + c; if (L >= nwg) return false;
        int wgid = (int)L; { const int q = nwg / NXCD, r = nwg % NXCD, xcd = wgid % NXCD, off = wgid / NXCD; wgid = (xcd < r ? xcd * (q + 1) : r * (q + 1) + (xcd - r) * q) + off; }
        const int nig = WGM * nN, gid = wgid / nig, fm = gid * WGM, gsz = (nM - fm) < WGM ? (nM - fm) : WGM;
        pm = fm + ((wgid % nig) % gsz); pn = (wgid % nig) / gsz; return true;
    }
};
struct DenseSched {
    TileOrder o;
    __device__ bool next(int i, Unit& u) const { int pm, pn; if (!o.map(i, pm, pn)) return false; u.pm = pm; u.pn = pn; u.arow = pm * BM; u.brow = pn * BM; u.e = 0; return true; }
};
struct MoeSched {
    TileOrder o; const int* tile_e; int N;
    __device__ bool next(int i, Unit& u) const { int pm, pn; if (!o.map(i, pm, pn)) return false; const int e = tile_e[pm]; u.pm = pm; u.pn = pn; u.arow = pm * BM; u.brow = e * N + pn * BM; u.e = e; return true; }
};

template <class Epi, class Sched>
__device__ __forceinline__ void gemm_phase(LAS unsigned char* lds, const Gemm g, const Sched& S, const Epi& E) {
    const int tid = threadIdx.x, wid = __builtin_amdgcn_readfirstlane(tid >> 6), lane = tid & 63, wr = wid >> 2, wc = wid & 3, fr = lane & 15, fq = lane >> 4;
    const int K = g.K, nt = K / BK;
    unsigned voffA[2], voffB[2];
#pragma unroll
    for (int i = 0; i < 2; ++i) { int R, C; stage_rc(tid * 16 + i * 8192, R, C); const int Rb = (R & ~31) + perm32(R & 31);
        voffA[i] = (unsigned)(R * K + C) * 2u; voffB[i] = (unsigned)(Rb * K + C) * 2u; }
    const size_t kstep = (size_t)(BK * 2);
    const size_t hstep = (size_t)HALF * K * 2;
    const size_t rowb = (size_t)K * 2;
    const unsigned ldsw = (unsigned)wid * 1024u;
    const int aoff = lds_byte(wr * 64 + fr, fq * 8), boff = lds_byte(wc * 32 + fr, fq * 8);
#define PG8_SA(b, h) (((b) * 2 + (h)) * HTB)
#define PG8_SB(b, h) ((4 + (b) * 2 + (h)) * HTB)
#define PG8_STAGE(bufoff, gbase, voff) do { _Pragma("unroll") for (int _i = 0; _i < 2; ++_i) \
        __builtin_amdgcn_global_load_lds((const unsigned*)((const char*)(gbase) + (voff)[_i]), (LAS unsigned*)(lds + (bufoff) + ldsw + _i * 8192), 16, 0, 0); } while (0)
#define PG8_LDA(dst, b, h) do { _Pragma("unroll") for (int m = 0; m < 4; ++m) _Pragma("unroll") for (int k = 0; k < 2; ++k) dst[m][k] = *(const LAS bf16x8*)(lds + PG8_SA(b, h) + aoff + m * 2048 + k * 1024); } while (0)
#define PG8_LDB(dst, b, h) do { _Pragma("unroll") for (int n = 0; n < 2; ++n) _Pragma("unroll") for (int k = 0; k < 2; ++k) dst[n][k] = *(const LAS bf16x8*)(lds + PG8_SB(b, h) + boff + n * 2048 + k * 1024); } while (0)
#define PG8_MMA(ai, bj, At, Bt) do { __builtin_amdgcn_s_setprio(1); _Pragma("unroll") for (int m = 0; m < 4; ++m) _Pragma("unroll") for (int n = 0; n < 2; ++n) _Pragma("unroll") for (int k = 0; k < 2; ++k) \
        acc[ai][bj][m][n] = __builtin_amdgcn_mfma_f32_16x16x32_bf16(Bt[n][k], At[m][k], acc[ai][bj][m][n], 0, 0, 0); __builtin_amdgcn_s_setprio(0); } while (0)
#define PG8_WAIT_V(n) asm volatile("s_waitcnt vmcnt(" #n ")" ::: "memory")
#define PG8_WAIT_L(n) asm volatile("s_waitcnt lgkmcnt(" #n ")" ::: "memory")
#define PG8_BAR __builtin_amdgcn_s_barrier()
#define PG8_SCHED __builtin_amdgcn_sched_barrier(0)
    Unit cur, nxt; int ui = 0;
    if (!S.next(0, cur)) return;
    f32x4 acc[2][2][4][2];
#pragma unroll
    for (int a = 0; a < 2; ++a)
#pragma unroll
        for (int b = 0; b < 2; ++b)
#pragma unroll
            for (int m = 0; m < 4; ++m)
#pragma unroll
                for (int n = 0; n < 2; ++n) acc[a][b][m][n] = (f32x4){0.f, 0.f, 0.f, 0.f};
    bf16x8 At[4][2], B0[2][2], B1[2][2];
    const char* cA = (const char*)g.A + (size_t)cur.arow * rowb; const char* cB = (const char*)g.Bt + (size_t)cur.brow * rowb;
    PG8_STAGE(PG8_SB(0, 0), cB, voffB); PG8_STAGE(PG8_SB(0, 1), cB + hstep, voffB); PG8_STAGE(PG8_SA(0, 0), cA, voffA); PG8_STAGE(PG8_SA(0, 1), cA + hstep, voffA);
    if (wr == 1) PG8_BAR;
    PG8_WAIT_V(2); PG8_BAR;
    PG8_STAGE(PG8_SB(1, 0), cB + kstep, voffB); PG8_STAGE(PG8_SA(1, 0), cA + kstep, voffA); PG8_STAGE(PG8_SB(1, 1), cB + hstep + kstep, voffB);
    PG8_WAIT_V(6); PG8_BAR;
    for (;;) {
        const bool has_next = S.next(ui + 1, nxt);
        const char* nA = has_next ? (const char*)g.A + (size_t)nxt.arow * rowb : cA; const char* nB = has_next ? (const char*)g.Bt + (size_t)nxt.brow * rowb : cB;
        for (int t = 0; t < nt; t += 2) {
            const bool last = (t == nt - 2);
            const char* a1 = cA + (size_t)(t + 1) * kstep;
            const char* a2 = last ? nA : cA + (size_t)(t + 2) * kstep; const char* b2 = last ? nB : cB + (size_t)(t + 2) * kstep;
            const char* a3 = a2 + kstep; const char* b3 = b2 + kstep;
            PG8_LDB(B0, 0, 0); PG8_LDB(B1, 0, 1); PG8_SCHED; PG8_LDA(At, 0, 0); PG8_STAGE(PG8_SA(1, 1), a1 + hstep, voffA);
            PG8_WAIT_V(8); PG8_WAIT_L(0); PG8_BAR; PG8_MMA(0, 0, At, B0); PG8_MMA(0, 1, At, B1); PG8_BAR; PG8_SCHED;
            PG8_LDA(At, 0, 1); PG8_STAGE(PG8_SB(0, 0), b2, voffB); PG8_STAGE(PG8_SB(0, 1), b2 + hstep, voffB); PG8_STAGE(PG8_SA(0, 0), a2, voffA);
            PG8_WAIT_V(8); PG8_WAIT_L(0); PG8_BAR; PG8_MMA(1, 0, At, B0); PG8_MMA(1, 1, At, B1); PG8_BAR; PG8_SCHED;
            PG8_LDB(B0, 1, 0); PG8_LDB(B1, 1, 1); PG8_SCHED; PG8_LDA(At, 1, 0); PG8_STAGE(PG8_SA(0, 1), a2 + hstep, voffA);
            PG8_WAIT_V(8); PG8_WAIT_L(0); PG8_BAR; PG8_MMA(0, 0, At, B0); PG8_MMA(0, 1, At, B1); PG8_BAR; PG8_SCHED;
            PG8_LDA(At, 1, 1); PG8_STAGE(PG8_SB(1, 0), b3, voffB); PG8_STAGE(PG8_SB(1, 1), b3 + hstep, voffB); PG8_STAGE(PG8_SA(1, 0), a3, voffA);
            PG8_WAIT_V(8); PG8_WAIT_L(0); PG8_BAR; PG8_MMA(1, 0, At, B0); PG8_MMA(1, 1, At, B1); PG8_BAR; PG8_SCHED;
        }
        if (wr == 0) PG8_BAR;
        E(acc, cur, wr, wc, fr, fq);
        if (!has_next) break;
#pragma unroll
        for (int a = 0; a < 2; ++a)
#pragma unroll
            for (int b = 0; b < 2; ++b)
#pragma unroll
                for (int m = 0; m < 4; ++m)
#pragma unroll
                    for (int n = 0; n < 2; ++n) acc[a][b][m][n] = (f32x4){0.f, 0.f, 0.f, 0.f};
        cur = nxt; cA = nA; cB = nB; ++ui;
        if (wr == 1) PG8_BAR;
    }
    PG8_WAIT_V(0);
    PG8_BAR;
#undef PG8_SA
#undef PG8_SB
#undef PG8_STAGE
#undef PG8_LDA
#undef PG8_LDB
#undef PG8_MMA
#undef PG8_WAIT_V
#undef PG8_WAIT_L
#undef PG8_BAR
#undef PG8_SCHED
}
}

struct EpiInProj {
    bf16_t* O;
    __device__ __forceinline__ void operator()(const f32x4 (&acc)[2][2][4][2], const pg8::Unit& u, int wr, int wc, int fr, int fq) const {
        const int row0 = u.pm * 256 + wr * 64 + fr, col0 = u.pn * 256 + wc * 32 + 8 * fq;
        const float sc = (u.pn == 7 || u.pn == 8) ? QSCALE : 1.0f;
#pragma unroll
        for (int ai = 0; ai < 2; ++ai)
#pragma unroll
            for (int m = 0; m < 4; ++m) { bf16_t* rowp = O + (size_t)(row0 + ai * 128 + m * 16) * IC + col0;
#pragma unroll
                for (int bj = 0; bj < 2; ++bj) { const f32x4 v0 = acc[ai][bj][m][0] * sc, v1 = acc[ai][bj][m][1] * sc;
                    u32x4 w; w.x = cvtpk(v0[0], v0[1]); w.y = cvtpk(v0[2], v0[3]); w.z = cvtpk(v1[0], v1[1]); w.w = cvtpk(v1[2], v1[3]);
                    *(u32x4*)(rowp + bj * 128) = w; } }
    }
};
struct EpiOutProj {
    const float* x; const float* mod; float* O;
    __device__ __forceinline__ void operator()(const f32x4 (&acc)[2][2][4][2], const pg8::Unit& u, int wr, int wc, int fr, int fq) const {
        const int row0 = u.pm * 256 + wr * 64 + fr, col0 = u.pn * 256 + wc * 32 + 8 * fq;
        const int b = (u.pm * 256) / SEQ;
        const float* g1 = mod + b * 6144 + 2048;
        f32x4 gv[2][2];
#pragma unroll
        for (int bj = 0; bj < 2; ++bj)
#pragma unroll
            for (int n = 0; n < 2; ++n) gv[bj][n] = *(const f32x4*)(g1 + col0 + bj * 128 + 4 * n);
#pragma unroll
        for (int ai = 0; ai < 2; ++ai)
#pragma unroll
            for (int m = 0; m < 4; ++m) { const size_t off = (size_t)(row0 + ai * 128 + m * 16) * D + col0;
#pragma unroll
                for (int bj = 0; bj < 2; ++bj)
#pragma unroll
                    for (int n = 0; n < 2; ++n) { const f32x4 xv = *(const f32x4*)(x + off + bj * 128 + 4 * n);
                        *(f32x4*)(O + off + bj * 128 + 4 * n) = xv + gv[bj][n] * acc[ai][bj][m][n]; } }
    }
};
struct EpiMoe1 {
    const float* bgu; bf16_t* O;
    __device__ __forceinline__ void operator()(const f32x4 (&acc)[2][2][4][2], const pg8::Unit& u, int wr, int wc, int fr, int fq) const {
        const int row0 = u.pm * 256 + wr * 64 + fr, col0 = u.pn * 128 + wc * 32 + 8 * fq;
        const float* bg = bgu + (size_t)u.e * 2048 + col0;
        f32x4 bgv[2], buv[2];
#pragma unroll
        for (int n = 0; n < 2; ++n) { bgv[n] = *(const f32x4*)(bg + 4 * n); buv[n] = *(const f32x4*)(bg + 1024 + 4 * n); }
#pragma unroll
        for (int ai = 0; ai < 2; ++ai)
#pragma unroll
            for (int m = 0; m < 4; ++m) { float a[8];
#pragma unroll
                for (int n = 0; n < 2; ++n) { const f32x4 gt = acc[ai][0][m][n] + bgv[n], up = acc[ai][1][m][n] + buv[n];
#pragma unroll
                    for (int j = 0; j < 4; ++j) { const float gg = fminf(gt[j], 7.0f), uu = fminf(fmaxf(up[j], -7.0f), 7.0f);
                        a[4 * n + j] = (uu + 1.0f) * (gg * __builtin_amdgcn_rcpf(1.0f + __builtin_amdgcn_exp2f(-1.702f * LOG2E * gg))); } }
                u32x4 w; w.x = cvtpk(a[0], a[1]); w.y = cvtpk(a[2], a[3]); w.z = cvtpk(a[4], a[5]); w.w = cvtpk(a[6], a[7]);
                *(u32x4*)(O + (size_t)(row0 + ai * 128 + m * 16) * 1024 + col0) = w; }
    }
};
struct EpiMoe2 {
    const float* bdn; bf16_t* O;
    __device__ __forceinline__ void operator()(const f32x4 (&acc)[2][2][4][2], const pg8::Unit& u, int wr, int wc, int fr, int fq) const {
        const int row0 = u.pm * 256 + wr * 64 + fr, col0 = u.pn * 256 + wc * 32 + 8 * fq;
        const float* bd = bdn + (size_t)u.e * 1024 + col0;
        f32x4 bv[2][2];
#pragma unroll
        for (int bj = 0; bj < 2; ++bj)
#pragma unroll
            for (int n = 0; n < 2; ++n) bv[bj][n] = *(const f32x4*)(bd + bj * 128 + 4 * n);
#pragma unroll
        for (int ai = 0; ai < 2; ++ai)
#pragma unroll
            for (int m = 0; m < 4; ++m) { bf16_t* rowp = O + (size_t)(row0 + ai * 128 + m * 16) * 1024 + col0;
#pragma unroll
                for (int bj = 0; bj < 2; ++bj) { const f32x4 v0 = acc[ai][bj][m][0] + bv[bj][0], v1 = acc[ai][bj][m][1] + bv[bj][1];
                    u32x4 w; w.x = cvtpk(v0[0], v0[1]); w.y = cvtpk(v0[2], v0[3]); w.z = cvtpk(v1[0], v1[1]); w.w = cvtpk(v1[2], v1[3]);
                    *(u32x4*)(rowp + bj * 128) = w; } }
    }
};

__device__ __forceinline__ void phase_mod(const Params& p, unsigned char* lds, int G) {
    const int tid = threadIdx.x, lane = tid & 63, wave = tid >> 6;
    float* sc = (float*)lds;
    const float* c = p.in[I_C];
    for (int i = tid; i < 8192; i += NTHREADS) { const int b = i & 7, k = i >> 3; const float cv = c[b * 1024 + k]; sc[k * 8 + b] = cv / (1.0f + __expf(-cv)); }
    __syncthreads();
    float* mod = (float*)(p.ws + WS_MOD);
    const float* mw = p.in[I_MODW]; const float* mb = p.in[I_MODB];
    for (int item = wave * G + (int)blockIdx.x; item < 192; item += NWAVES * G) {
        const int col = item * 32 + (lane & 31), kh = lane >> 5;
        float acc[8];
#pragma unroll
        for (int b = 0; b < 8; ++b) acc[b] = 0.f;
        const float* wp = mw + (size_t)(kh * 512) * 6144 + col;
        const float* sp = sc + (kh * 512) * 8;
#pragma unroll 8
        for (int k = 0; k < 512; ++k) { const float wv = wp[(size_t)k * 6144]; const f32x4 s0 = *(const f32x4*)(sp + k * 8), s1 = *(const f32x4*)(sp + k * 8 + 4);
            acc[0] += s0[0] * wv; acc[1] += s0[1] * wv; acc[2] += s0[2] * wv; acc[3] += s0[3] * wv; acc[4] += s1[0] * wv; acc[5] += s1[1] * wv; acc[6] += s1[2] * wv; acc[7] += s1[3] * wv; }
#pragma unroll
        for (int b = 0; b < 8; ++b) acc[b] += __shfl_xor(acc[b], 32);
        if (lane < 32) {
            const float bias = mb[col];
#pragma unroll
            for (int b = 0; b < 8; ++b) mod[b * 6144 + col] = acc[b] + bias;
        }
    }
    __syncthreads();
}
__device__ __forceinline__ void transpose_item(const float* W, int N, int k0, int n0, bf16_t* WT, int Kdst, int dst_row_base, bool gu_interleave, float* scr, int lane) {
#pragma unroll 4
    for (int i = 0; i < 16; ++i) { const int row = 4 * i + (lane >> 4), c4 = lane & 15;
        const f32x4 v = *(const f32x4*)(W + (size_t)(k0 + row) * N + n0 + 4 * c4);
        float* s = scr + row * 65 + 4 * c4; s[0] = v[0]; s[1] = v[1]; s[2] = v[2]; s[3] = v[3]; }
    asm volatile("s_waitcnt lgkmcnt(0)" ::: "memory");
    const int cch = lane & 7;
#pragma unroll
    for (int i = 0; i < 8; ++i) { const int n = 8 * i + (lane >> 3); const float* s = scr + (8 * cch) * 65 + n;
        u32x4 o; o.x = cvtpk(s[0], s[65]); o.y = cvtpk(s[2 * 65], s[3 * 65]); o.z = cvtpk(s[4 * 65], s[5 * 65]); o.w = cvtpk(s[6 * 65], s[7 * 65]);
        int nn = n0 + n;
        if (gu_interleave) nn = (nn < 1024) ? ((nn >> 7) * 256 + (nn & 127)) : (((nn - 1024) >> 7) * 256 + 128 + ((nn - 1024) & 127));
        *(u32x4*)(WT + (size_t)(dst_row_base + nn) * Kdst + k0 + 8 * cch) = o; }
    asm volatile("s_waitcnt lgkmcnt(0)" ::: "memory");
}
__device__ __forceinline__ void phase_convert(const Params& p, unsigned char* lds, int G) {
    const int tid = threadIdx.x, lane = tid & 63, wave = tid >> 6;
    float* scr = (float*)lds + wave * (64 * 65);
    const int gw = (int)blockIdx.x * NWAVES + wave, NGW = G * NWAVES;
    constexpr int I_IN = 16 * 52, I_OUT = 16 * 16, I_GU = 32 * 16 * 32, I_DN = 32 * 16 * 16, NITEMS = I_IN + I_OUT + I_GU + I_DN;
    bf16_t* win_t = (bf16_t*)(p.ws + WS_WIN_T); bf16_t* wout_t = (bf16_t*)(p.ws + WS_WOUT_T); bf16_t* wg_t = (bf16_t*)(p.ws + WS_WG_T); bf16_t* wd_t = (bf16_t*)(p.ws + WS_WD_T);
    for (int it = gw; it < NITEMS; it += NGW) {
        int r = it;
        if (r < I_IN) { transpose_item(p.in[I_WIN], IC, (r / 52) * 64, (r % 52) * 64, win_t, 1024, 0, false, scr, lane); continue; } r -= I_IN;
        if (r < I_OUT) { transpose_item(p.in[I_WOUT], D, (r / 16) * 64, (r % 16) * 64, wout_t, 1024, 0, false, scr, lane); continue; } r -= I_OUT;
        if (r < I_GU) { const int e = r / 512, rr = r % 512; transpose_item(p.in[I_WGU] + (size_t)e * 1024 * 2048, 2048, (rr / 32) * 64, (rr % 32) * 64, wg_t, 1024, e * 2048, true, scr, lane); continue; } r -= I_GU;
        { const int e = r / 256, rr = r % 256; transpose_item(p.in[I_WDN] + (size_t)e * 1024 * 1024, 1024, (rr / 16) * 64, (rr % 16) * 64, wd_t, 1024, e * 1024, false, scr, lane); }
    }
}

__device__ __forceinline__ void phase_norm1(const Params& p, int G) {
    const int tid = threadIdx.x, lane = tid & 63, wave = tid >> 6;
    const int gw = (int)blockIdx.x * NWAVES + wave, NGW = G * NWAVES;
    const float* x = p.in[I_X]; const float* gain = p.in[I_N1G]; const float* mod = (const float*)(p.ws + WS_MOD);
    bf16_t* h = (bf16_t*)(p.ws + WS_H);
    for (int row = gw; row < T; row += NGW) {
        const int b = row / SEQ;
        const f32x4* xr = (const f32x4*)(x + (size_t)row * D) + lane;
        f32x4 v[4]; float s = 0.f;
#pragma unroll
        for (int j = 0; j < 4; ++j) { v[j] = xr[64 * j]; s += (v[j][0] * v[j][0] + v[j][1] * v[j][1]) + (v[j][2] * v[j][2] + v[j][3] * v[j][3]); }
        const float rstd = rsqrtf(wave_sum(s) * (1.0f / D) + NORM_EPS);
        const float* sh = mod + b * 6144; const float* scl = mod + b * 6144 + 1024;
        unsigned long long* o8 = (unsigned long long*)(h + (size_t)row * D) + lane;
#pragma unroll
        for (int j = 0; j < 4; ++j) { const int k = 4 * lane + 256 * j;
            const f32x4 g = *(const f32x4*)(gain + k), s1 = *(const f32x4*)(scl + k), s0 = *(const f32x4*)(sh + k);
            const f32x4 y = (v[j] * rstd) * g * (s1 + 1.0f) + s0;
            o8[64 * j] = (unsigned long long)cvtpk(y[0], y[1]) | ((unsigned long long)cvtpk(y[2], y[3]) << 32); }
    }
}

__device__ __forceinline__ s16x4 vtr(const LAS unsigned char* pp) { typedef short v4i16_t __attribute__((ext_vector_type(4))); return __builtin_bit_cast(s16x4, __builtin_amdgcn_ds_read_tr16_b64_v4i16((LAS v4i16_t*)pp)); }
constexpr int ATT_BUF = 32768;
constexpr int ATT_QROWS = 128, ATT_NQB = SEQ / ATT_QROWS, ATT_UNITS = NB * 4 * ATT_NQB;
__device__ __forceinline__ void attn_unit(const Params& p, LAS unsigned char* lds, int b, int h, int qb, float lam) {
    const int tid = threadIdx.x, lane = tid & 63, wid = __builtin_amdgcn_readfirstlane(tid >> 6), r32 = lane & 31, hi = lane >> 5;
    const int c = wid & 1, qblk = wid >> 1;
    const bf16_t* proj = (const bf16_t*)(p.ws + WS_PROJ) + (size_t)b * SEQ * IC;
    const int q0 = qb * ATT_QROWS, qw0 = q0 + 32 * qblk;
    const bf16_t* Qb = proj + RC + h * 128 + c * 64;
    const bf16_t* Kb = proj + RC + 512 + h * 128;
    const bf16_t* Vb = proj + RC + 1024 + h * 128;
    const float slope = exp2f(-2.0f * (float)(h + 1)) * LOG2E;
    bf16x8 qr[4];
#pragma unroll
    for (int d0 = 0; d0 < 4; ++d0) qr[d0] = *(const bf16x8*)(Qb + (size_t)(qw0 + r32) * IC + d0 * 16 + hi * 8);
    f32x16 o[4];
#pragma unroll
    for (int d = 0; d < 4; ++d) o[d] = f32x16{};
    float m_ = -INFINITY, l_ = 0.f;
    const int NT = (q0 + ATT_QROWS) / 64;
    const bf16_t* ksrc = Kb + (size_t)lane * IC + wid * 8;
    const int p0i = wid, p1i = wid + 8;
    const bf16_t* vsrc0 = Vb + (size_t)(16 * (p0i & 3) + (lane >> 2)) * IC + (p0i >> 2) * 32 + (lane & 3) * 8;
    const bf16_t* vsrc1 = Vb + (size_t)(16 * (p1i & 3) + (lane >> 2)) * IC + (p1i >> 2) * 32 + (lane & 3) * 8;
#define ATT_DMA(t, buf) do { const size_t ro = (size_t)(t) * 64 * IC; LAS unsigned char* bb_ = lds + (buf) * ATT_BUF; \
        __builtin_amdgcn_global_load_lds((const unsigned*)(ksrc + ro), (LAS unsigned*)(bb_ + wid * 1024), 16, 0, 0); \
        __builtin_amdgcn_global_load_lds((const unsigned*)(ksrc + ro + 64), (LAS unsigned*)(bb_ + 8192 + wid * 1024), 16, 0, 0); \
        __builtin_amdgcn_global_load_lds((const unsigned*)(vsrc0 + ro), (LAS unsigned*)(bb_ + 16384 + p0i * 1024), 16, 0, 0); \
        __builtin_amdgcn_global_load_lds((const unsigned*)(vsrc1 + ro), (LAS unsigned*)(bb_ + 16384 + p1i * 1024), 16, 0, 0); } while (0)
    ATT_DMA(0, 0);
    asm volatile("s_waitcnt vmcnt(0)" ::: "memory");
    __syncthreads();
    const int voff = ((lane >> 4) & 1) * 32 + (lane & 3) * 8 + (4 * hi + ((lane & 15) >> 2)) * 64;
    const int qpos = qw0 + r32;
    for (int kt = 0; kt < NT; ++kt) {
        const int cur = kt & 1;
        if (kt + 1 < NT) ATT_DMA(kt + 1, cur ^ 1);
        const int k0 = kt * 64;
        if (k0 <= qw0 + 31) {
            const LAS unsigned char* bb = lds + cur * ATT_BUF;
            const bool need_mask = (k0 + 63 > qw0);
            const LAS unsigned char* kb = bb + c * 8192 + hi * 1024 + r32 * 16;
            f32x16 s0 = f32x16{}, s1 = f32x16{};
#pragma unroll
            for (int d0 = 0; d0 < 4; ++d0) {
                const bf16x8 a0 = *(const LAS bf16x8*)(kb + d0 * 2048), a1 = *(const LAS bf16x8*)(kb + d0 * 2048 + 512);
                s0 = __builtin_amdgcn_mfma_f32_32x32x16_bf16(a0, qr[d0], s0, 0, 0, 0);
                s1 = __builtin_amdgcn_mfma_f32_32x32x16_bf16(a1, qr[d0], s1, 0, 0, 0);
            }
            const float fb = (float)(k0 - qpos + 4 * hi);
            float rm = -INFINITY;
#pragma unroll
            for (int r = 0; r < 16; ++r) { const float t0 = fb + (float)((r & 3) + 8 * (r >> 2)), t1 = fb + (float)((r & 3) + 8 * (r >> 2) + 32);
                float v0 = __builtin_fmaf(slope, t0, s0[r]), v1 = __builtin_fmaf(slope, t1, s1[r]);
                if (need_mask) { if (t0 > 0.f) v0 = -INFINITY; if (t1 > 0.f) v1 = -INFINITY; }
                s0[r] = v0; s1[r] = v1; rm = fmaxf(rm, fmaxf(v0, v1)); }
            rm = fmaxf(rm, __shfl_xor(rm, 32));
            const float mn = fmaxf(m_, rm);
            const float alpha = __builtin_amdgcn_exp2f(m_ - mn);
            m_ = mn;
            float ps = 0.f;
#pragma unroll
            for (int r = 0; r < 16; ++r) { s0[r] = __builtin_amdgcn_exp2f(s0[r] - mn); s1[r] = __builtin_amdgcn_exp2f(s1[r] - mn); ps += s0[r] + s1[r]; }
            l_ = l_ * alpha + ps;
            if (__any(alpha != 1.0f)) {
#pragma unroll
                for (int d = 0; d < 4; ++d)
#pragma unroll
                    for (int r = 0; r < 16; ++r) o[d][r] *= alpha;
            }
            bf16x8 pf[4];
#pragma unroll
            for (int ks = 0; ks < 2; ++ks) {
                u32x4 w0, w1;
                w0.x = cvtpk(s0[8 * ks + 0], s0[8 * ks + 1]); w0.y = cvtpk(s0[8 * ks + 2], s0[8 * ks + 3]); w0.z = cvtpk(s0[8 * ks + 4], s0[8 * ks + 5]); w0.w = cvtpk(s0[8 * ks + 6], s0[8 * ks + 7]);
                w1.x = cvtpk(s1[8 * ks + 0], s1[8 * ks + 1]); w1.y = cvtpk(s1[8 * ks + 2], s1[8 * ks + 3]); w1.z = cvtpk(s1[8 * ks + 4], s1[8 * ks + 5]); w1.w = cvtpk(s1[8 * ks + 6], s1[8 * ks + 7]);
                pf[ks] = __builtin_bit_cast(bf16x8, w0); pf[2 + ks] = __builtin_bit_cast(bf16x8, w1);
            }
            const LAS unsigned char* vb = bb + 16384 + voff;
#pragma unroll
            for (int dblk = 0; dblk < 4; ++dblk) {
#pragma unroll
                for (int ks = 0; ks < 4; ++ks) {
                    const s16x4 lo = vtr(vb + (dblk * 4 + ks) * 1024), hh = vtr(vb + (dblk * 4 + ks) * 1024 + 512);
                    const bf16x8 vf = (bf16x8){lo[0], lo[1], lo[2], lo[3], hh[0], hh[1], hh[2], hh[3]};
                    o[dblk] = __builtin_amdgcn_mfma_f32_32x32x16_bf16(vf, pf[ks], o[dblk], 0, 0, 0);
                }
            }
        }
        asm volatile("s_waitcnt vmcnt(0)" ::: "memory");
        __syncthreads();
    }
#undef ATT_DMA
    l_ += __shfl_xor(l_, 32);
    LAS float* xb = (LAS float*)(lds + qblk * 16384);
    if (c == 1) {
        const float i1 = lam / l_;
#pragma unroll
        for (int d = 0; d < 4; ++d)
#pragma unroll
            for (int r = 0; r < 16; ++r) xb[(d * 16 + r) * 64 + lane] = o[d][r] * i1;
    }
    __syncthreads();
    if (c == 0) {
        const float i0 = 1.0f / l_;
        float ss = 0.f;
#pragma unroll
        for (int d = 0; d < 4; ++d)
#pragma unroll
            for (int r = 0; r < 16; ++r) { const float v = o[d][r] * i0 - xb[(d * 16 + r) * 64 + lane]; o[d][r] = v; ss += v * v; }
        ss += __shfl_xor(ss, 32);
        const float rstd = rsqrtf(ss * (1.0f / 128.0f) + NORM_EPS) * (1.0f - LAMBDA_INIT);
        const float* sg = p.in[I_SUBLN];
        bf16_t* yo = (bf16_t*)(p.ws + WS_YMIX) + (size_t)(b * SEQ + qw0 + r32) * D + RW + h * 128;
#pragma unroll
        for (int d = 0; d < 4; ++d)
#pragma unroll
            for (int g = 0; g < 4; ++g) { const int dd = 32 * d + 8 * g + 4 * hi; const f32x4 gv = *(const f32x4*)(sg + dd);
                u32x2 w; w.x = cvtpk(o[d][4 * g] * rstd * gv[0], o[d][4 * g + 1] * rstd * gv[1]); w.y = cvtpk(o[d][4 * g + 2] * rstd * gv[2], o[d][4 * g + 3] * rstd * gv[3]);
                *(u32x2*)(yo + dd) = w; }
    }
    __syncthreads();
}

constexpr int RK_R = 0, RK_KM = 16384, RK_DEC = 32768, RK_KK = 49152, RK_BB = 65536, RK_VV = 81920, RK_GG = 98304;
constexpr int RK_AW = 114688;
constexpr int RK_AA = RK_AW + 9216;
constexpr int RK_AG = RK_AA + 9216;
constexpr int RK_YY = RK_AW;
constexpr int RK_BON = RK_AG + 17408;
constexpr int RK_END = RK_BON + 256;
static_assert(RK_END <= LDS_BYTES, "rwkv LDS map");
template <int CTRL> __device__ __forceinline__ float dpp_add(float v) { return v + __builtin_bit_cast(float, __builtin_amdgcn_update_dpp(0, __builtin_bit_cast(int, v), CTRL, 0xf, 0xf, true)); }
__device__ __forceinline__ float red8(float v) {
    v = dpp_add<0xB1>(v);
    v = dpp_add<0x4E>(v);
    v = dpp_add<0x141>(v);
    return v;
}
__device__ __forceinline__ void rwkv_unit(const Params& p, LAS unsigned char* lds, int b, int h) {
    const int tid = threadIdx.x, lane = tid & 63, wid = __builtin_amdgcn_readfirstlane(tid >> 6);
    const bf16_t* proj = (const bf16_t*)(p.ws + WS_PROJ) + (size_t)b * SEQ * IC;
    const float* mu = p.in[I_MU];
    LAS float* R_ = (LAS float*)(lds + RK_R); LAS float* KM_ = (LAS float*)(lds + RK_KM); LAS float* DEC_ = (LAS float*)(lds + RK_DEC); LAS float* KK_ = (LAS float*)(lds + RK_KK);
    LAS float* BB_ = (LAS float*)(lds + RK_BB); LAS float* VV_ = (LAS float*)(lds + RK_VV); LAS float* GG_ = (LAS float*)(lds + RK_GG); LAS float* YY_ = (LAS float*)(lds + RK_YY); LAS float* BON_ = (LAS float*)(lds + RK_BON);
    const int ntile = wid & 3, tt0 = 2 * (wid >> 2), fn = lane & 15, fk = lane >> 4;
    const int ncol = h * 64 + ntile * 16 + fn;
    bf16x8 bw[2], ba[2], bg[4];
    {
        const float* wup = p.in[I_WUP]; const float* aup = p.in[I_AUP]; const float* gup = p.in[I_GUP];
#pragma unroll
        for (int ks = 0; ks < 2; ++ks) { float t[8], u[8];
#pragma unroll
            for (int j = 0; j < 8; ++j) { const int k = 32 * ks + 8 * fk + j; t[j] = wup[k * RW + ncol]; u[j] = aup[k * RW + ncol]; }
            u32x4 a, c; a.x = cvtpk(t[0], t[1]); a.y = cvtpk(t[2], t[3]); a.z = cvtpk(t[4], t[5]); a.w = cvtpk(t[6], t[7]);
            c.x = cvtpk(u[0], u[1]); c.y = cvtpk(u[2], u[3]); c.z = cvtpk(u[4], u[5]); c.w = cvtpk(u[6], u[7]);
            bw[ks] = __builtin_bit_cast(bf16x8, a); ba[ks] = __builtin_bit_cast(bf16x8, c); }
#pragma unroll
        for (int ks = 0; ks < 4; ++ks) { float t[8];
#pragma unroll
            for (int j = 0; j < 8; ++j) { const int k = 32 * ks + 8 * fk + j; t[j] = gup[k * RW + ncol]; }
            u32x4 a; a.x = cvtpk(t[0], t[1]); a.y = cvtpk(t[2], t[3]); a.z = cvtpk(t[4], t[5]); a.w = cvtpk(t[6], t[7]);
            bg[ks] = __builtin_bit_cast(bf16x8, a); }
    }
    const float w0n = p.in[I_W0][ncol], a0n = p.in[I_A0][ncol];
    const int hc = h * 64 + lane;
    const float kkc = p.in[I_KK][hc], kac = p.in[I_KA][hc], rkc = p.in[I_RK][hc], gng = p.in[I_GNG][hc], gnb = p.in[I_GNB][hc];
    float S[8];
#pragma unroll
    for (int i = 0; i < 8; ++i) S[i] = 0.f;
    const int row_l = lane >> 3, kc = lane & 7, srow = 8 * wid + row_l;
    bf16_t* ymix = (bf16_t*)(p.ws + WS_YMIX) + (size_t)b * SEQ * D;
    for (int ch = 0; ch < SEQ / 64; ++ch) {
        const int t0 = ch * 64;
        {
            const int tk = tid >> 3, seg = tid & 7;
            const int tg = t0 + tk;
            const bf16_t* rowc = proj + (size_t)tg * IC;
            const bf16_t* rowp = rowc - IC;
            const bool hasprev = tg > 0;
            if (seg < 7) {
                int col;
                if (seg == 0) col = h * 64; else if (seg == 1) col = 512 + h * 64; else if (seg == 2) col = 1024 + h * 64; else if (seg == 3) col = 1536; else if (seg == 4) col = 1600; else if (seg == 5) col = 1664; else col = 1728;
#pragma unroll
                for (int q = 0; q < 8; ++q) {
                    const u32x4 cv = *(const u32x4*)(rowc + col + 8 * q);
                    u32x4 pv = (u32x4){0u, 0u, 0u, 0u};
                    if (hasprev) pv = *(const u32x4*)(rowp + col + 8 * q);
                    float xv[8];
#pragma unroll
                    for (int j = 0; j < 4; ++j) { const unsigned cw = cv[j], pw = pv[j];
                        const float c0 = __uint_as_float(cw << 16), c1 = __uint_as_float(cw & 0xffff0000u), p0 = __uint_as_float(pw << 16), p1 = __uint_as_float(pw & 0xffff0000u);
                        const float m0 = mu[col + 8 * q + 2 * j], m1 = mu[col + 8 * q + 2 * j + 1];
                        xv[2 * j] = c0 + m0 * (p0 - c0); xv[2 * j + 1] = c1 + m1 * (p1 - c1); }
                    if (seg <= 2) { LAS float* dst = (seg == 0 ? R_ : (seg == 1 ? KM_ : VV_)) + tk * 64 + 8 * q;
#pragma unroll
                        for (int j = 0; j < 8; ++j) dst[j] = xv[j]; }
                    else if (seg == 3) { u32x4 w; w.x = cvtpk(tanhf(xv[0]), tanhf(xv[1])); w.y = cvtpk(tanhf(xv[2]), tanhf(xv[3])); w.z = cvtpk(tanhf(xv[4]), tanhf(xv[5])); w.w = cvtpk(tanhf(xv[6]), tanhf(xv[7]));
                        *(LAS u32x4*)(lds + RK_AW + tk * 144 + 16 * q) = w; }
                    else if (seg == 4) { u32x4 w; w.x = cvtpk(xv[0], xv[1]); w.y = cvtpk(xv[2], xv[3]); w.z = cvtpk(xv[4], xv[5]); w.w = cvtpk(xv[6], xv[7]);
                        *(LAS u32x4*)(lds + RK_AA + tk * 144 + 16 * q) = w; }
                    else { u32x4 w; w.x = cvtpk(sigmoidf_(xv[0]), sigmoidf_(xv[1])); w.y = cvtpk(sigmoidf_(xv[2]), sigmoidf_(xv[3])); w.z = cvtpk(sigmoidf_(xv[4]), sigmoidf_(xv[5])); w.w = cvtpk(sigmoidf_(xv[6]), sigmoidf_(xv[7]));
                        *(LAS u32x4*)(lds + RK_AG + tk * 272 + (seg - 5) * 128 + 16 * q) = w; }
                }
            }
        }
        __syncthreads();
        {
            f32x4 cw[2], ca[2], cg2[2];
#pragma unroll
            for (int tt = 0; tt < 2; ++tt) { cw[tt] = (f32x4){0.f, 0.f, 0.f, 0.f}; ca[tt] = cw[tt]; cg2[tt] = cw[tt];
                const int tok = (tt0 + tt) * 16 + fn;
#pragma unroll
                for (int ks = 0; ks < 2; ++ks) {
                    const bf16x8 aw = *(const LAS bf16x8*)(lds + RK_AW + tok * 144 + (32 * ks + 8 * fk) * 2);
                    const bf16x8 aa = *(const LAS bf16x8*)(lds + RK_AA + tok * 144 + (32 * ks + 8 * fk) * 2);
                    cw[tt] = __builtin_amdgcn_mfma_f32_16x16x32_bf16(aw, bw[ks], cw[tt], 0, 0, 0);
                    ca[tt] = __builtin_amdgcn_mfma_f32_16x16x32_bf16(aa, ba[ks], ca[tt], 0, 0, 0);
                }
#pragma unroll
                for (int ks = 0; ks < 4; ++ks) {
                    const bf16x8 ag = *(const LAS bf16x8*)(lds + RK_AG + tok * 272 + (32 * ks + 8 * fk) * 2);
                    cg2[tt] = __builtin_amdgcn_mfma_f32_16x16x32_bf16(ag, bg[ks], cg2[tt], 0, 0, 0);
                }
            }
#pragma unroll
            for (int tt = 0; tt < 2; ++tt)
#pragma unroll
                for (int r = 0; r < 4; ++r) { const int tok = (tt0 + tt) * 16 + 4 * fk + r, n = ntile * 16 + fn;
                    const float xw = cw[tt][r] + w0n;
                    DEC_[tok * 64 + n] = __expf(-0.6065306597126334f * sigmoidf_(xw));
                    BB_[tok * 64 + n] = sigmoidf_(ca[tt][r] + a0n);
                    GG_[tok * 64 + n] = cg2[tt][r]; }
        }
        __syncthreads();
#pragma unroll 2
        for (int i = 0; i < 8; ++i) { const int tk = wid * 8 + i;
            const float kp = KM_[tk * 64 + lane], a = BB_[tk * 64 + lane], rr = R_[tk * 64 + lane];
            const float kkv = kp * kkc; const float nrm = sqrtf(wave_sum(kkv * kkv)); const float kkn = kkv / fmaxf(nrm, 1e-12f);
            const float kmod = kp * (1.0f + (a - 1.0f) * kac);
            const float bs = wave_sum(rr * kmod * rkc);
            KK_[tk * 64 + lane] = kkn; BB_[tk * 64 + lane] = kkn * a; KM_[tk * 64 + lane] = kmod;
            if (lane == 0) BON_[tk] = bs; }
        __syncthreads();
        for (int t = 0; t < 64; ++t) {
            const f32x4 a0 = *(const LAS f32x4*)(KK_ + t * 64 + 8 * kc), a1 = *(const LAS f32x4*)(KK_ + t * 64 + 8 * kc + 4);
            const f32x4 w0 = *(const LAS f32x4*)(DEC_ + t * 64 + 8 * kc), w1 = *(const LAS f32x4*)(DEC_ + t * 64 + 8 * kc + 4);
            const f32x4 b0 = *(const LAS f32x4*)(BB_ + t * 64 + 8 * kc), b1 = *(const LAS f32x4*)(BB_ + t * 64 + 8 * kc + 4);
            const f32x4 k0 = *(const LAS f32x4*)(KM_ + t * 64 + 8 * kc), k1 = *(const LAS f32x4*)(KM_ + t * 64 + 8 * kc + 4);
            const f32x4 r0 = *(const LAS f32x4*)(R_ + t * 64 + 8 * kc), r1 = *(const LAS f32x4*)(R_ + t * 64 + 8 * kc + 4);
            const float vv = VV_[t * 64 + srow];
            float sa = 0.f;
#pragma unroll
            for (int i = 0; i < 4; ++i) { sa += S[i] * a0[i]; sa += S[4 + i] * a1[i]; }
            sa = -red8(sa);
            float y = 0.f;
#pragma unroll
            for (int i = 0; i < 4; ++i) { S[i] = S[i] * w0[i] + sa * b0[i] + vv * k0[i]; S[4 + i] = S[4 + i] * w1[i] + sa * b1[i] + vv * k1[i]; y += S[i] * r0[i]; y += S[4 + i] * r1[i]; }
            y = red8(y);
            if (kc == 0) YY_[t * 64 + srow] = y;
        }
        __syncthreads();
#pragma unroll 2
        for (int i = 0; i < 8; ++i) { const int tk = wid * 8 + i;
            const float y = YY_[tk * 64 + lane]; const float mean = wave_sum(y) * (1.0f / 64.0f); const float dlt = y - mean; const float var = wave_sum(dlt * dlt) * (1.0f / 64.0f);
            const float yn = dlt * rsqrtf(var + GN_EPS) * gng + gnb;
            const float ov = (yn + BON_[tk] * VV_[tk * 64 + lane]) * GG_[tk * 64 + lane];
            const unsigned pk = cvtpk(ov, __shfl_down(ov, 1));
            if ((lane & 1) == 0) *(unsigned*)(ymix + (size_t)(t0 + tk) * D + h * 64 + lane) = pk; }
        __syncthreads();
    }
}

constexpr int RT_PITCH = 36;
__device__ __forceinline__ void phase_router(const Params& p, LAS unsigned char* lds, int G) {
    const int tid = threadIdx.x, lane = tid & 63, wave = tid >> 6;
    LAS float* wr_ = (LAS float*)lds;
    LAS int* hist = (LAS int*)(lds + 147456);
    const float* rw = p.in[I_RTW];
    for (int i = tid; i < 1024 * 8; i += NTHREADS) { const int k = i >> 3, c4 = i & 7; const f32x4 v = *(const f32x4*)(rw + k * 32 + 4 * c4);
        const int ln = (k & 255) >> 2, ii = k & 3, jj = k >> 8; *(LAS f32x4*)(wr_ + ((ii + 4 * jj) * 64 + ln) * RT_PITCH + 4 * c4) = v; }
    const float* x1 = p.out; const float* gain = p.in[I_N2G]; const float* mod = (const float*)(p.ws + WS_MOD); const float* rb = p.in[I_RTB];
    bf16_t* h2 = (bf16_t*)(p.ws + WS_H);
    int* ridx = (int*)(p.ws + WS_ROUTE); float* rwt = (float*)(p.ws + WS_ROUTE + 512 * 1024);
    int* blockcnt = (int*)(p.ws + WS_CTL + 4096);
    const int TPB = T / G;
    for (int blk = blockIdx.x; blk < G; blk += G) {
        if (tid < 32) hist[tid] = 0;
        __syncthreads();
        for (int ti = wave; ti < TPB; ti += NWAVES) {
            const int row = blk * TPB + ti; const int b = row / SEQ;
            const f32x4* xr = (const f32x4*)(x1 + (size_t)row * D) + lane;
            f32x4 v[4]; float s = 0.f;
#pragma unroll
            for (int j = 0; j < 4; ++j) { v[j] = xr[64 * j]; s += (v[j][0] * v[j][0] + v[j][1] * v[j][1]) + (v[j][2] * v[j][2] + v[j][3] * v[j][3]); }
            const float rstd = rsqrtf(wave_sum(s) * (1.0f / D) + NORM_EPS);
            const float* sh = mod + b * 6144 + 3072; const float* scl = mod + b * 6144 + 4096;
            unsigned long long* o8 = (unsigned long long*)(h2 + (size_t)row * D) + lane;
            float acc[32];
#pragma unroll
            for (int e = 0; e < 32; ++e) acc[e] = 0.f;
#pragma unroll
            for (int j = 0; j < 4; ++j) { const int k = 4 * lane + 256 * j;
                const f32x4 g = *(const f32x4*)(gain + k), s1 = *(const f32x4*)(scl + k), s0 = *(const f32x4*)(sh + k);
                const f32x4 y = (v[j] * rstd) * g * (s1 + 1.0f) + s0;
                o8[64 * j] = (unsigned long long)cvtpk(y[0], y[1]) | ((unsigned long long)cvtpk(y[2], y[3]) << 32);
#pragma unroll
                for (int i = 0; i < 4; ++i) { const LAS float* wrow = wr_ + ((i + 4 * j) * 64 + lane) * RT_PITCH; const float yv = y[i];
#pragma unroll
                    for (int c4 = 0; c4 < 8; ++c4) { const f32x4 wv = *(const LAS f32x4*)(wrow + 4 * c4);
                        acc[4 * c4 + 0] += yv * wv[0]; acc[4 * c4 + 1] += yv * wv[1]; acc[4 * c4 + 2] += yv * wv[2]; acc[4 * c4 + 3] += yv * wv[3]; } } }
            float r16[16];
#pragma unroll
            for (int e = 0; e < 16; ++e) { const bool up = (lane & 32) != 0; const float keep = up ? acc[e + 16] : acc[e], send = up ? acc[e] : acc[e + 16]; r16[e] = keep + __shfl_xor(send, 32); }
            float r8[8];
#pragma unroll
            for (int e = 0; e < 8; ++e) { const bool up = (lane & 16) != 0; const float keep = up ? r16[e + 8] : r16[e], send = up ? r16[e] : r16[e + 8]; r8[e] = keep + __shfl_xor(send, 16); }
            float r4[4];
#pragma unroll
            for (int e = 0; e < 4; ++e) { const bool up = (lane & 8) != 0; const float keep = up ? r8[e + 4] : r8[e], send = up ? r8[e] : r8[e + 4]; r4[e] = keep + __shfl_xor(send, 8); }
            float r2[2];
#pragma unroll
            for (int e = 0; e < 2; ++e) { const bool up = (lane & 4) != 0; const float keep = up ? r4[e + 2] : r4[e], send = up ? r4[e] : r4[e + 2]; r2[e] = keep + __shfl_xor(send, 4); }
            float r1;
            { const bool up = (lane & 2) != 0; const float keep = up ? r2[1] : r2[0], send = up ? r2[0] : r2[1]; r1 = keep + __shfl_xor(send, 2); }
            r1 += __shfl_xor(r1, 1);
            const int e_l = lane >> 1;
            float logit = r1 + rb[e_l];
            int sel[4]; float sv[4];
#pragma unroll
            for (int k = 0; k < 4; ++k) { const float mx = wave_max(logit); const unsigned long long bal = __ballot(logit == mx); const int ln = __ffsll((long long)bal) - 1;
                sel[k] = ln >> 1; sv[k] = mx; if (e_l == sel[k]) logit = -INFINITY; }
            const float e1 = __expf(sv[1] - sv[0]), e2 = __expf(sv[2] - sv[0]), e3 = __expf(sv[3] - sv[0]); const float inv = 1.0f / (1.0f + e1 + e2 + e3);
            if (lane == 0) { *(int4*)(ridx + (size_t)row * 4) = make_int4(sel[0], sel[1], sel[2], sel[3]); *(float4*)(rwt + (size_t)row * 4) = make_float4(inv, e1 * inv, e2 * inv, e3 * inv);
                atomicAdd((int*)&hist[sel[0]], 1); atomicAdd((int*)&hist[sel[1]], 1); atomicAdd((int*)&hist[sel[2]], 1); atomicAdd((int*)&hist[sel[3]], 1); }
        }
        __syncthreads();
        if (tid < 32) blockcnt[blk * 32 + tid] = hist[tid];
        __syncthreads();
    }
}

__device__ __forceinline__ void phase_assign(const Params& p, LAS unsigned char* lds, int G) {
    const int tid = threadIdx.x, lane = tid & 63, wave = tid >> 6;
    LAS int* part = (LAS int*)lds;
    LAS int* partb = part + 512;
    LAS int* total = partb + 512;
    LAS int* base = total + 32;
    LAS int* segst = base + 32;
    LAS int* cursor = segst + 32;
    LAS int* slotl = cursor + 32;
    const int* blockcnt = (const int*)(p.ws + WS_CTL + 4096);
    const int* ridx = (const int*)(p.ws + WS_ROUTE); int* rslot = (int*)(p.ws + WS_ROUTE + 1024 * 1024);
    const bf16_t* h2 = (const bf16_t*)(p.ws + WS_H); bf16_t* xs = (bf16_t*)(p.ws + WS_PROJ);
    int* tile = (int*)(p.ws + WS_TILE);
    const int TPB = T / G; const int blk = blockIdx.x;
    { const int e = tid & 31, part_i = tid >> 5; int st = 0, sb = 0;
        for (int bb = part_i; bb < G; bb += 16) { const int c = blockcnt[bb * 32 + e]; st += c; if (bb < blk) sb += c; }
        part[part_i * 32 + e] = st; partb[part_i * 32 + e] = sb; }
    __syncthreads();
    if (tid < 32) { int st = 0, sb = 0;
#pragma unroll
        for (int i = 0; i < 16; ++i) { st += part[i * 32 + tid]; sb += partb[i * 32 + tid]; }
        total[tid] = st; base[tid] = sb; cursor[tid] = 0; }
    __syncthreads();
    if (tid == 0) { int acc = 0; for (int e = 0; e < 32; ++e) { segst[e] = acc; acc += (total[e] + 255) & ~255; }
        if (blk == 0) { int pm = 0; for (int e = 0; e < 32; ++e) { const int nt = (total[e] + 255) >> 8; for (int i = 0; i < nt; ++i) tile[16 + pm + i] = e; pm += nt; } tile[0] = pm; } }
    __syncthreads();
    if (tid < 32) base[tid] += segst[tid];
    __syncthreads();
    for (int a = tid; a < TPB * 4; a += NTHREADS) { const int tok = blk * TPB + (a >> 2); const int e = ridx[(size_t)tok * 4 + (a & 3)];
        const int rank = atomicAdd((int*)&cursor[e], 1); const int slot = base[e] + rank; slotl[a] = slot; rslot[(size_t)tok * 4 + (a & 3)] = slot; }
    __syncthreads();
    for (int a = wave; a < TPB * 4; a += NWAVES) { const int tok = blk * TPB + (a >> 2); const int slot = slotl[a];
        const u32x4* src = (const u32x4*)(h2 + (size_t)tok * D) + lane; u32x4* dst = (u32x4*)(xs + (size_t)slot * D) + lane;
        const u32x4 v0 = src[0], v1 = src[64]; dst[0] = v0; dst[64] = v1; }
    for (int e = blk; e < 32; e += G) { const int s0 = segst[e] + total[e], s1 = segst[e] + ((total[e] + 255) & ~255);
        for (int r = s0 + wave; r < s1; r += NWAVES) { u32x4* dst = (u32x4*)(xs + (size_t)r * D) + lane; dst[0] = (u32x4){0u, 0u, 0u, 0u}; dst[64] = (u32x4){0u, 0u, 0u, 0u}; } }
}

__device__ __forceinline__ void phase_final(const Params& p, int G, int stage) {
    const int tid = threadIdx.x, lane = tid & 63, wave = tid >> 6;
    const int gw = (int)blockIdx.x * NWAVES + wave, NGW = G * NWAVES;
    const float* fg = p.in[I_FG]; const float* mod = (const float*)(p.ws + WS_MOD);
    const int* rslot = (const int*)(p.ws + WS_ROUTE + 1024 * 1024); const float* rwt = (const float*)(p.ws + WS_ROUTE + 512 * 1024);
    const bf16_t* Y = (const bf16_t*)(p.ws + WS_PROJ);
    const float* src = (stage >= 4) ? p.out : p.in[I_X];
    for (int row = gw; row < T; row += NGW) {
        const int b = row / SEQ;
        const f32x4* xr = (const f32x4*)(src + (size_t)row * D) + lane;
        f32x4 v[4];
#pragma unroll
        for (int j = 0; j < 4; ++j) v[j] = xr[64 * j];
        if (stage >= 9) {
            const int4 sl = *(const int4*)(rslot + (size_t)row * 4); const float4 wt = *(const float4*)(rwt + (size_t)row * 4);
            const float* g2 = mod + b * 6144 + 5120;
            const int sls[4] = {sl.x, sl.y, sl.z, sl.w}; const float wts[4] = {wt.x, wt.y, wt.z, wt.w};
#pragma unroll
            for (int j = 0; j < 4; ++j) { f32x4 m = (f32x4){0.f, 0.f, 0.f, 0.f};
#pragma unroll
                for (int k = 0; k < 4; ++k) { const u32x2 yv = *((const u32x2*)(Y + (size_t)sls[k] * D) + lane + 64 * j);
                    m[0] += wts[k] * __uint_as_float(yv.x << 16); m[1] += wts[k] * __uint_as_float(yv.x & 0xffff0000u); m[2] += wts[k] * __uint_as_float(yv.y << 16); m[3] += wts[k] * __uint_as_float(yv.y & 0xffff0000u); }
                const f32x4 g = *(const f32x4*)(g2 + 4 * lane + 256 * j); v[j] = v[j] + g * m; }
        }
        float s = 0.f;
#pragma unroll
        for (int j = 0; j < 4; ++j) s += (v[j][0] * v[j][0] + v[j][1] * v[j][1]) + (v[j][2] * v[j][2] + v[j][3] * v[j][3]);
        const float rstd = rsqrtf(wave_sum(s) * (1.0f / D) + NORM_EPS);
        f32x4* orow = (f32x4*)(p.out + (size_t)row * D) + lane;
#pragma unroll
        for (int j = 0; j < 4; ++j) { const f32x4 g = *(const f32x4*)(fg + 4 * lane + 256 * j); orow[64 * j] = v[j] * rstd * g; }
    }
}

__global__ void __launch_bounds__(NTHREADS, 2) hymba_fwd(Params p) {
    extern __shared__ __attribute__((aligned(16))) unsigned char lds_raw[];
    cg::grid_group grid = cg::this_grid();
    LAS unsigned char* lds = (LAS unsigned char*)lds_raw;
    const int G = gridDim.x, tid = threadIdx.x;
    constexpr int STAGE = DBG_STAGE;

    phase_mod(p, lds_raw, G);
    if (STAGE >= 2) phase_convert(p, lds_raw, G);
    grid.sync();
    if (STAGE >= 2) { phase_norm1(p, G); grid.sync(); }
    if (STAGE >= 2) {
        pg8::Gemm g{(const bf16_t*)(p.ws + WS_H), (const bf16_t*)(p.ws + WS_WIN_T), D};
        pg8::DenseSched S; S.o.init(T / 256, IC / 256, G, (int)blockIdx.x);
        EpiInProj E{(bf16_t*)(p.ws + WS_PROJ)};
        pg8::gemm_phase(lds, g, S, E);
        grid.sync();
    }
    if (STAGE >= 2) {
        if (STAGE >= 3) { for (int u = blockIdx.x; u < NB * 8; u += G) rwkv_unit(p, lds, u >> 3, u & 7); }
        else {
            bf16_t* ymix = (bf16_t*)(p.ws + WS_YMIX);
            for (size_t i = (size_t)blockIdx.x * NTHREADS + tid; i < (size_t)T * 64; i += (size_t)G * NTHREADS) { const size_t row = i >> 6, c = i & 63; *(u32x4*)(ymix + row * D + c * 8) = (u32x4){0u, 0u, 0u, 0u}; }
        }
        float lam;
        { const float* q1 = p.in[I_LQ1]; const float* k1 = p.in[I_LK1]; const float* q2 = p.in[I_LQ2]; const float* k2 = p.in[I_LK2]; float s1 = 0.f, s2 = 0.f;
            for (int i = 0; i < 64; ++i) { s1 += q1[i] * k1[i]; s2 += q2[i] * k2[i]; } lam = expf(s1) - expf(s2) + LAMBDA_INIT; }
        unsigned* qhead = (unsigned*)(p.ws + WS_CTL);
        LAS unsigned* ubox = (LAS unsigned*)(lds + 2 * ATT_BUF);
        for (;;) {
            __syncthreads();
            if (tid == 0) ubox[0] = atomicAdd(qhead, 1u);
            __syncthreads();
            const unsigned u = (unsigned)__builtin_amdgcn_readfirstlane((int)ubox[0]);
            if (u >= (unsigned)ATT_UNITS) break;
            attn_unit(p, lds, (int)(u & 31u) >> 2, (int)(u & 3u), ATT_NQB - 1 - (int)(u >> 5), lam);
        }
        grid.sync();
    }
    if (STAGE >= 2) {
        pg8::Gemm g{(const bf16_t*)(p.ws + WS_YMIX), (const bf16_t*)(p.ws + WS_WOUT_T), D};
        pg8::DenseSched S; S.o.init(T / 256, D / 256, G, (int)blockIdx.x);
        EpiOutProj E{p.in[I_X], (const float*)(p.ws + WS_MOD), p.out};
        pg8::gemm_phase(lds, g, S, E);
        grid.sync();
    }
    if (STAGE >= 9) {
        phase_router(p, lds, G);
        grid.sync();
        phase_assign(p, lds, G);
        grid.sync();
        const int* tile = (const int*)(p.ws + WS_TILE);
        const int MT = tile[0];
        {
            pg8::Gemm g{(const bf16_t*)(p.ws + WS_PROJ), (const bf16_t*)(p.ws + WS_WG_T), D};
            pg8::MoeSched S; S.o.init(MT, 8, G, (int)blockIdx.x); S.tile_e = tile + 16; S.N = 2048;
            EpiMoe1 E{p.in[I_BGU], (bf16_t*)(p.ws + WS_ACT)};
            pg8::gemm_phase(lds, g, S, E);
        }
        grid.sync();
        {
            pg8::Gemm g{(const bf16_t*)(p.ws + WS_ACT), (const bf16_t*)(p.ws + WS_WD_T), D};
            pg8::MoeSched S; S.o.init(MT, 4, G, (int)blockIdx.x); S.tile_e = tile + 16; S.N = 1024;
            EpiMoe2 E{p.in[I_BDN], (bf16_t*)(p.ws + WS_PROJ)};
            pg8::gemm_phase(lds, g, S, E);
        }
        grid.sync();
    }
    phase_final(p, G, STAGE >= 9 ? 9 : (STAGE >= 2 ? 4 : 0));
}

extern "C" void kernel_launch(void* const* d_in, const int* in_sizes, int n_in, void* d_out, int out_size, void* d_ws, size_t ws_size, hipStream_t stream) {
    static int grid = 0;
    if (grid == 0) {
        if (n_in != 31 || out_size != T * D || ws_size < WS_END) { fprintf(stderr, "kernel_launch: unexpected shapes (n_in %d out %d ws %zu)\n", n_in, out_size, ws_size); grid = -1; return; }
        int dev = 0, cus = 0, per_cu = 0;
        hipGetDevice(&dev);
        hipDeviceGetAttribute(&cus, hipDeviceAttributeMultiprocessorCount, dev);
        hipFuncSetAttribute((const void*)hymba_fwd, hipFuncAttributeMaxDynamicSharedMemorySize, LDS_BYTES);
        hipOccupancyMaxActiveBlocksPerMultiprocessor(&per_cu, (const void*)hymba_fwd, NTHREADS, LDS_BYTES);
        if (per_cu < 1) { fprintf(stderr, "kernel_launch: occupancy query returned %d\n", per_cu); grid = -1; return; }
        grid = cus;
        if (grid > 256) grid = 256;
        while (T % grid != 0) --grid;
        (void)hipGetLastError();
    }
    if (grid < 0) return;
    hipMemsetAsync((char*)d_ws + WS_CTL, 0, CTL_BYTES, stream);
    Params p{};
    for (int i = 0; i < 31; ++i) p.in[i] = (const float*)d_in[i];
    p.out = (float*)d_out; p.ws = (unsigned char*)d_ws;
    void* args[] = {&p};
    hipError_t e = hipLaunchCooperativeKernel((const void*)hymba_fwd, dim3(grid), dim3(NTHREADS), args, LDS_BYTES, stream);
    if (e != hipSuccess) fprintf(stderr, "cooperative launch failed: %s (grid %d)\n", hipGetErrorString(e), grid);
}
```

```cpp
#include <hip/hip_runtime.h>
#include <hip/hip_cooperative_groups.h>
#include <cstdio>
#include <cstdint>
namespace cg = cooperative_groups;

#ifndef DBG_STAGE
#define DBG_STAGE 99
#endif

#define LAS __attribute__((address_space(3)))
typedef unsigned short bf16_t;
typedef short bf16x8 __attribute__((ext_vector_type(8)));
typedef short s16x4 __attribute__((ext_vector_type(4)));
typedef float f32x4 __attribute__((ext_vector_type(4)));
typedef float f32x16 __attribute__((ext_vector_type(16)));
typedef float f32x2_t __attribute__((ext_vector_type(2)));
typedef __bf16 bf16x2_t __attribute__((ext_vector_type(2)));
typedef unsigned u32x4 __attribute__((ext_vector_type(4)));
typedef unsigned u32x2 __attribute__((ext_vector_type(2)));

constexpr int D = 1024, NB = 8, SEQ = 4096, T = NB * SEQ;
constexpr int RW = 512, RC = 1792, DC = 1536, IC = 3328;
constexpr int NE = 32, TOPK = 4, NA = T * TOPK;
constexpr int PMAX = NA + NE * 256;
constexpr float NORM_EPS = 1e-5f, GN_EPS = 64e-5f;
constexpr float LOG2E = 1.4426950408889634f;
constexpr float QSCALE = 0.125f * LOG2E;
constexpr float LAMBDA_INIT = 0.2f;
constexpr int NTHREADS = 512, NWAVES = 8;
constexpr int LDS_BYTES = 163840;

constexpr size_t MiB = 1u << 20;
constexpr size_t WS_CTL = 0;
constexpr size_t CTL_BYTES = 65536;
constexpr size_t WS_MOD = 1 * MiB;
constexpr size_t WS_TILE = 1 * MiB + 512 * 1024;
constexpr size_t WS_WIN_T = 2 * MiB;
constexpr size_t WS_WOUT_T = 9 * MiB;
constexpr size_t WS_ROUTE = 11 * MiB;
constexpr size_t WS_WG_T = 16 * MiB;
constexpr size_t WS_WD_T = 144 * MiB;
constexpr size_t WS_H = 208 * MiB;
constexpr size_t WS_YMIX = 272 * MiB;
constexpr size_t WS_PROJ = 336 * MiB;
constexpr size_t WS_ACT = 608 * MiB;
constexpr size_t WS_END = 1008 * MiB;
constexpr size_t WS_RS = WS_ACT, WS_KMS = WS_ACT + 64 * MiB, WS_DECS = WS_ACT + 128 * MiB, WS_KKS = WS_ACT + 192 * MiB, WS_BBS = 880 * MiB, WS_VS = 944 * MiB;
constexpr size_t WS_BON = WS_H;

__device__ __forceinline__ unsigned cvtpk(float lo, float hi) { f32x2_t v = {lo, hi}; bf16x2_t b = __builtin_convertvector(v, bf16x2_t); return __builtin_bit_cast(unsigned, b); }
__device__ __forceinline__ float bf2f(unsigned short u) { return __uint_as_float(((unsigned)u) << 16); }
__device__ __forceinline__ float wave_sum(float v) {
#pragma unroll
    for (int o = 1; o < 64; o <<= 1) v += __shfl_xor(v, o);
    return v;
}
__device__ __forceinline__ float wave_max(float v) {
#pragma unroll
    for (int o = 1; o < 64; o <<= 1) v = fmaxf(v, __shfl_xor(v, o));
    return v;
}
__device__ __forceinline__ float sigmoidf_(float x) { return __builtin_amdgcn_rcpf(1.0f + __expf(-x)); }
__device__ __forceinline__ float tanh_fast(float x) { return 1.0f - 2.0f * __builtin_amdgcn_rcpf(1.0f + __expf(2.0f * x)); }

struct Params {
    const float* in[31];
    float* out;
    unsigned char* ws;
};
enum { I_X = 0, I_C, I_MODW, I_MODB, I_N1G, I_WIN, I_MU, I_W0, I_WUP, I_A0, I_AUP, I_GUP, I_KK, I_KA, I_RK, I_GNG, I_GNB, I_LQ1, I_LK1, I_LQ2, I_LK2, I_SUBLN, I_WOUT, I_N2G, I_RTW, I_RTB, I_WGU, I_BGU, I_WDN, I_BDN, I_FG };

namespace pg8 {
constexpr int BM = 256, BK = 64, HALF = 128, HTB = HALF * BK * 2, STAGE_BYTES = 8 * HTB, NXCD = 8, WGM = 8;
__host__ __device__ __forceinline__ int lds_byte(int r, int c) { const int st = (r >> 4) * 2 + (c >> 5), rr = r & 15, cc = c & 31, ob = rr * 64 + cc * 2; return st * 1024 + (ob ^ (((ob >> 9) & 1) << 5)); }
__host__ __device__ __forceinline__ void stage_rc(int b, int& R, int& C) { const int st = b / 1024, sb = b % 1024, swz = sb ^ (((sb >> 9) & 1) << 5); R = (st >> 1) * 16 + swz / 64; C = (st & 1) * 32 + (swz % 64) / 2; }
__host__ __device__ __forceinline__ int perm32(int rho) { const int n = rho >> 4, i = rho & 15; return 8 * (i >> 2) + 4 * n + (i & 3); }

struct Unit { int pm, pn, arow, brow, e; };
struct Gemm { const bf16_t* A; const bf16_t* Bt; int K; };

struct TileOrder {
    int nM, nN, nwg, G, c;
    __device__ void init(int nM_, int nN_, int G_, int c_) { nM = nM_; nN = nN_; nwg = nM * nN; G = G_; c = c_; }
    __device__ bool map(int i, int& pm, int& pn) const {
        const long L = (long)i * G + c; if (L >= nwg) return false;
        int wgid = (int)L; { const int q = nwg / NXCD, r = nwg % NXCD, xcd = wgid % NXCD, off = wgid / NXCD; wgid = (xcd < r ? xcd * (q + 1) : r * (q + 1) + (xcd - r) * q) + off; }
        const int nig = WGM * nN, gid = wgid / nig, fm = gid * WGM, gsz = (nM - fm) < WGM ? (nM - fm) : WGM;
        pm = fm + ((wgid % nig) % gsz); pn = (wgid % nig) / gsz; return true;
    }
};
struct DenseSched {
    TileOrder o;
    __device__ bool next(int i, Unit& u) const { int pm, pn; if (!o.map(i, pm, pn)) return false; u.pm = pm; u.pn = pn; u.arow = pm * BM; u.brow = pn * BM; u.e = 0; return true; }
};
struct MoeSched {
    TileOrder o; const int* tile_e; int N;
    __device__ bool next(int i, Unit& u) const { int pm, pn; if (!o.map(i, pm, pn)) return false; const int e = tile_e[pm]; u.pm = pm; u.pn = pn; u.arow = pm * BM; u.brow = e * N + pn * BM; u.e = e; return true; }
};

template <class Epi, class Sched>
__device__ __forceinline__ void gemm_phase(LAS unsigned char* lds, const Gemm g, const Sched& S, const Epi& E) {
    const int tid = threadIdx.x, wid = __builtin_amdgcn_readfirstlane(tid >> 6), lane = tid & 63, wr = wid >> 2, wc = wid & 3, fr = lane & 15, fq = lane >> 4;
    const int K = g.K, nt = K / BK;
    unsigned voffA[2], voffB[2];
#pragma unroll
    for (int i = 0; i < 2; ++i) { int R, C; stage_rc(tid * 16 + i * 8192, R, C); const int Rb = (R & ~31) + perm32(R & 31);
        voffA[i] = (unsigned)(R * K + C) * 2u; voffB[i] = (unsigned)(Rb * K + C) * 2u; }
    const size_t kstep = (size_t)(BK * 2);
    const size_t hstep = (size_t)HALF * K * 2;
    const size_t rowb = (size_t)K * 2;
    const unsigned ldsw = (unsigned)wid * 1024u;
    const int aoff = lds_byte(wr * 64 + fr, fq * 8), boff = lds_byte(wc * 32 + fr, fq * 8);
#define PG8_SA(b, h) (((b) * 2 + (h)) * HTB)
#define PG8_SB(b, h) ((4 + (b) * 2 + (h)) * HTB)
#define PG8_STAGE(bufoff, gbase, voff) do { _Pragma("unroll") for (int _i = 0; _i < 2; ++_i) \
        __builtin_amdgcn_global_load_lds((const unsigned*)((const char*)(gbase) + (voff)[_i]), (LAS unsigned*)(lds + (bufoff) + ldsw + _i * 8192), 16, 0, 0); } while (0)
#define PG8_LDA(dst, b, h) do { _Pragma("unroll") for (int m = 0; m < 4; ++m) _Pragma("unroll") for (int k = 0; k < 2; ++k) dst[m][k] = *(const LAS bf16x8*)(lds + PG8_SA(b, h) + aoff + m * 2048 + k * 1024); } while (0)
#define PG8_LDB(dst, b, h) do { _Pragma("unroll") for (int n = 0; n < 2; ++n) _Pragma("unroll") for (int k = 0; k < 2; ++k) dst[n][k] = *(const LAS bf16x8*)(lds + PG8_SB(b, h) + boff + n * 2048 + k * 1024); } while (0)
#define PG8_MMA(ai, bj, At, Bt) do { __builtin_amdgcn_s_setprio(1); _Pragma("unroll") for (int m = 0; m < 4; ++m) _Pragma("unroll") for (int n = 0; n < 2; ++n) _Pragma("unroll") for (int k = 0; k < 2; ++k) \
        acc[ai][bj][m][n] = __builtin_amdgcn_mfma_f32_16x16x32_bf16(Bt[n][k], At[m][k], acc[ai][bj][m][n], 0, 0, 0); __builtin_amdgcn_s_setprio(0); } while (0)
#define PG8_WAIT_V(n) asm volatile("s_waitcnt vmcnt(" #n ")" ::: "memory")
#define PG8_WAIT_L(n) asm volatile("s_waitcnt lgkmcnt(" #n ")" ::: "memory")
#define PG8_BAR __builtin_amdgcn_s_barrier()
#define PG8_SCHED __builtin_amdgcn_sched_barrier(0)
    Unit cur, nxt; int ui = 0;
    if (!S.next(0, cur)) return;
    f32x4 acc[2][2][4][2];
#pragma unroll
    for (int a = 0; a < 2; ++a)
#pragma unroll
        for (int b = 0; b < 2; ++b)
#pragma unroll
            for (int m = 0; m < 4; ++m)
#pragma unroll
                for (int n = 0; n < 2; ++n) acc[a][b][m][n] = (f32x4){0.f, 0.f, 0.f, 0.f};
    bf16x8 At[4][2], B0[2][2], B1[2][2];
    const char* cA = (const char*)g.A + (size_t)cur.arow * rowb; const char* cB = (const char*)g.Bt + (size_t)cur.brow * rowb;
    PG8_STAGE(PG8_SB(0, 0), cB, voffB); PG8_STAGE(PG8_SB(0, 1), cB + hstep, voffB); PG8_STAGE(PG8_SA(0, 0), cA, voffA); PG8_STAGE(PG8_SA(0, 1), cA + hstep, voffA);
    if (wr == 1) PG8_BAR;
    PG8_WAIT_V(2); PG8_BAR;
    PG8_STAGE(PG8_SB(1, 0), cB + kstep, voffB); PG8_STAGE(PG8_SA(1, 0), cA + kstep, voffA); PG8_STAGE(PG8_SB(1, 1), cB + hstep + kstep, voffB);
    PG8_WAIT_V(6); PG8_BAR;
    for (;;) {
        const bool has_next = S.next(ui + 1, nxt);
        const char* nA = has_next ? (const char*)g.A + (size_t)nxt.arow * rowb : cA; const char* nB = has_next ? (const char*)g.Bt + (size_t)nxt.brow * rowb : cB;
        for (int t = 0; t < nt; t += 2) {
            const bool last = (t == nt - 2);
            const char* a1 = cA + (size_t)(t + 1) * kstep;
            const char* a2 = last ? nA : cA + (size_t)(t + 2) * kstep; const char* b2 = last ? nB : cB + (size_t)(t + 2) * kstep;
            const char* a3 = a2 + kstep; const char* b3 = b2 + kstep;
            PG8_LDB(B0, 0, 0); PG8_LDB(B1, 0, 1); PG8_SCHED; PG8_LDA(At, 0, 0); PG8_STAGE(PG8_SA(1, 1), a1 + hstep, voffA);
            PG8_WAIT_V(8); PG8_WAIT_L(0); PG8_BAR; PG8_MMA(0, 0, At, B0); PG8_MMA(0, 1, At, B1); PG8_BAR; PG8_SCHED;
            PG8_LDA(At, 0, 1); PG8_STAGE(PG8_SB(0, 0), b2, voffB); PG8_STAGE(PG8_SB(0, 1), b2 + hstep, voffB); PG8_STAGE(PG8_SA(0, 0), a2, voffA);
            PG8_WAIT_V(8); PG8_WAIT_L(0); PG8_BAR; PG8_MMA(1, 0, At, B0); PG8_MMA(1, 1, At, B1); PG8_BAR; PG8_SCHED;
            PG8_LDB(B0, 1, 0); PG8_LDB(B1, 1, 1); PG8_SCHED; PG8_LDA(At, 1, 0); PG8_STAGE(PG8_SA(0, 1), a2 + hstep, voffA);
            PG8_WAIT_V(8); PG8_WAIT_L(0); PG8_BAR; PG8_MMA(0, 0, At, B0); PG8_MMA(0, 1, At, B1); PG8_BAR; PG8_SCHED;
            PG8_LDA(At, 1, 1); PG8_STAGE(PG8_SB(1, 0), b3, voffB); PG8_STAGE(PG8_SB(1, 1), b3 + hstep, voffB); PG8_STAGE(PG8_SA(1, 0), a3, voffA);
            PG8_WAIT_V(8); PG8_WAIT_L(0); PG8_BAR; PG8_MMA(1, 0, At, B0); PG8_MMA(1, 1, At, B1); PG8_BAR; PG8_SCHED;
        }
        if (wr == 0) PG8_BAR;
        E(acc, cur, wr, wc, fr, fq);
        if (!has_next) break;
#pragma unroll
        for (int a = 0; a < 2; ++a)
#pragma unroll
            for (int b = 0; b < 2; ++b)
#pragma unroll
                for (int m = 0; m < 4; ++m)
#pragma unroll
                    for (int n = 0; n < 2; ++n) acc[a][b][m][n] = (f32x4){0.f, 0.f, 0.f, 0.f};
        cur = nxt; cA = nA; cB = nB; ++ui;
        if (wr == 1) PG8_BAR;
    }
    PG8_WAIT_V(0);
    PG8_BAR;
#undef PG8_SA
#undef PG8_SB
#undef PG8_STAGE
#undef PG8_LDA
#undef PG8_LDB
#undef PG8_MMA
#undef PG8_WAIT_V
#undef PG8_WAIT_L
#undef PG8_BAR
#undef PG8_SCHED
}
}

struct EpiInProj {
    bf16_t* O;
    __device__ __forceinline__ void operator()(const f32x4 (&acc)[2][2][4][2], const pg8::Unit& u, int wr, int wc, int fr, int fq) const {
        const int row0 = u.pm * 256 + wr * 64 + fr, col0 = u.pn * 256 + wc * 32 + 8 * fq;
        const float sc = (u.pn == 7 || u.pn == 8) ? QSCALE : 1.0f;
#pragma unroll
        for (int ai = 0; ai < 2; ++ai)
#pragma unroll
            for (int m = 0; m < 4; ++m) { bf16_t* rowp = O + (size_t)(row0 + ai * 128 + m * 16) * IC + col0;
#pragma unroll
                for (int bj = 0; bj < 2; ++bj) { const f32x4 v0 = acc[ai][bj][m][0] * sc, v1 = acc[ai][bj][m][1] * sc;
                    u32x4 w; w.x = cvtpk(v0[0], v0[1]); w.y = cvtpk(v0[2], v0[3]); w.z = cvtpk(v1[0], v1[1]); w.w = cvtpk(v1[2], v1[3]);
                    *(u32x4*)(rowp + bj * 128) = w; } }
    }
};
struct EpiOutProj {
    const float* x; const float* mod; float* O;
    __device__ __forceinline__ void operator()(const f32x4 (&acc)[2][2][4][2], const pg8::Unit& u, int wr, int wc, int fr, int fq) const {
        const int row0 = u.pm * 256 + wr * 64 + fr, col0 = u.pn * 256 + wc * 32 + 8 * fq;
        const int b = (u.pm * 256) / SEQ;
        const float* g1 = mod + b * 6144 + 2048;
        f32x4 gv[2][2];
#pragma unroll
        for (int bj = 0; bj < 2; ++bj)
#pragma unroll
            for (int n = 0; n < 2; ++n) gv[bj][n] = *(const f32x4*)(g1 + col0 + bj * 128 + 4 * n);
#pragma unroll
        for (int ai = 0; ai < 2; ++ai)
#pragma unroll
            for (int m = 0; m < 4; ++m) { const size_t off = (size_t)(row0 + ai * 128 + m * 16) * D + col0;
#pragma unroll
                for (int bj = 0; bj < 2; ++bj)
#pragma unroll
                    for (int n = 0; n < 2; ++n) { const f32x4 xv = *(const f32x4*)(x + off + bj * 128 + 4 * n);
                        *(f32x4*)(O + off + bj * 128 + 4 * n) = xv + gv[bj][n] * acc[ai][bj][m][n]; } }
    }
};
struct EpiMoe1 {
    const float* bgu; bf16_t* O;
    __device__ __forceinline__ void operator()(const f32x4 (&acc)[2][2][4][2], const pg8::Unit& u, int wr, int wc, int fr, int fq) const {
        const int row0 = u.pm * 256 + wr * 64 + fr, col0 = u.pn * 128 + wc * 32 + 8 * fq;
        const float* bg = bgu + (size_t)u.e * 2048 + col0;
        f32x4 bgv[2], buv[2];
#pragma unroll
        for (int n = 0; n < 2; ++n) { bgv[n] = *(const f32x4*)(bg + 4 * n); buv[n] = *(const f32x4*)(bg + 1024 + 4 * n); }
#pragma unroll
        for (int ai = 0; ai < 2; ++ai)
#pragma unroll
            for (int m = 0; m < 4; ++m) { float a[8];
#pragma unroll
                for (int n = 0; n < 2; ++n) { const f32x4 gt = acc[ai][0][m][n] + bgv[n], up = acc[ai][1][m][n] + buv[n];
#pragma unroll
                    for (int j = 0; j < 4; ++j) { const float gg = fminf(gt[j], 7.0f), uu = fminf(fmaxf(up[j], -7.0f), 7.0f);
                        a[4 * n + j] = (uu + 1.0f) * (gg * __builtin_amdgcn_rcpf(1.0f + __builtin_amdgcn_exp2f(-1.702f * LOG2E * gg))); } }
                u32x4 w; w.x = cvtpk(a[0], a[1]); w.y = cvtpk(a[2], a[3]); w.z = cvtpk(a[4], a[5]); w.w = cvtpk(a[6], a[7]);
                *(u32x4*)(O + (size_t)(row0 + ai * 128 + m * 16) * 1024 + col0) = w; }
    }
};
struct EpiMoe2 {
    const float* bdn; bf16_t* O;
    __device__ __forceinline__ void operator()(const f32x4 (&acc)[2][2][4][2], const pg8::Unit& u, int wr, int wc, int fr, int fq) const {
        const int row0 = u.pm * 256 + wr * 64 + fr, col0 = u.pn * 256 + wc * 32 + 8 * fq;
        const float* bd = bdn + (size_t)u.e * 1024 + col0;
        f32x4 bv[2][2];
#pragma unroll
        for (int bj = 0; bj < 2; ++bj)
#pragma unroll
            for (int n = 0; n < 2; ++n) bv[bj][n] = *(const f32x4*)(bd + bj * 128 + 4 * n);
#pragma unroll
        for (int ai = 0; ai < 2; ++ai)
#pragma unroll
            for (int m = 0; m < 4; ++m) { bf16_t* rowp = O + (size_t)(row0 + ai * 128 + m * 16) * 1024 + col0;
#pragma unroll
                for (int bj = 0; bj < 2; ++bj) { const f32x4 v0 = acc[ai][bj][m][0] + bv[bj][0], v1 = acc[ai][bj][m][1] + bv[bj][1];
                    u32x4 w; w.x = cvtpk(v0[0], v0[1]); w.y = cvtpk(v0[2], v0[3]); w.z = cvtpk(v1[0], v1[1]); w.w = cvtpk(v1[2], v1[3]);
                    *(u32x4*)(rowp + bj * 128) = w; } }
    }
};

__device__ __forceinline__ void phase_mod(const Params& p, unsigned char* lds, int G) {
    const int tid = threadIdx.x, lane = tid & 63, wave = tid >> 6;
    float* sc = (float*)lds;
    const float* c = p.in[I_C];
    for (int i = tid; i < 8192; i += NTHREADS) { const int b = i & 7, k = i >> 3; const float cv = c[b * 1024 + k]; sc[k * 8 + b] = cv / (1.0f + __expf(-cv)); }
    __syncthreads();
    float* mod = (float*)(p.ws + WS_MOD);
    const float* mw = p.in[I_MODW]; const float* mb = p.in[I_MODB];
    for (int item = wave * G + (int)blockIdx.x; item < 192; item += NWAVES * G) {
        const int col = item * 32 + (lane & 31), kh = lane >> 5;
        float acc[8];
#pragma unroll
        for (int b = 0; b < 8; ++b) acc[b] = 0.f;
        const float* wp = mw + (size_t)(kh * 512) * 6144 + col;
        const float* sp = sc + (kh * 512) * 8;
#pragma unroll 8
        for (int k = 0; k < 512; ++k) { const float wv = wp[(size_t)k * 6144]; const f32x4 s0 = *(const f32x4*)(sp + k * 8), s1 = *(const f32x4*)(sp + k * 8 + 4);
            acc[0] += s0[0] * wv; acc[1] += s0[1] * wv; acc[2] += s0[2] * wv; acc[3] += s0[3] * wv; acc[4] += s1[0] * wv; acc[5] += s1[1] * wv; acc[6] += s1[2] * wv; acc[7] += s1[3] * wv; }
#pragma unroll
        for (int b = 0; b < 8; ++b) acc[b] += __shfl_xor(acc[b], 32);
        if (lane < 32) {
            const float bias = mb[col];
#pragma unroll
            for (int b = 0; b < 8; ++b) mod[b * 6144 + col] = acc[b] + bias;
        }
    }
    __syncthreads();
}
__device__ __forceinline__ void transpose_item(const float* W, int N, int k0, int n0, bf16_t* WT, int Kdst, int dst_row_base, bool gu_interleave, float* scr, int lane) {
#pragma unroll 4
    for (int i = 0; i < 16; ++i) { const int row = 4 * i + (lane >> 4), c4 = lane & 15;
        const f32x4 v = *(const f32x4*)(W + (size_t)(k0 + row) * N + n0 + 4 * c4);
        float* s = scr + row * 65 + 4 * c4; s[0] = v[0]; s[1] = v[1]; s[2] = v[2]; s[3] = v[3]; }
    asm volatile("s_waitcnt lgkmcnt(0)" ::: "memory");
    const int cch = lane & 7;
#pragma unroll
    for (int i = 0; i < 8; ++i) { const int n = 8 * i + (lane >> 3); const float* s = scr + (8 * cch) * 65 + n;
        u32x4 o; o.x = cvtpk(s[0], s[65]); o.y = cvtpk(s[2 * 65], s[3 * 65]); o.z = cvtpk(s[4 * 65], s[5 * 65]); o.w = cvtpk(s[6 * 65], s[7 * 65]);
        int nn = n0 + n;
        if (gu_interleave) nn = (nn < 1024) ? ((nn >> 7) * 256 + (nn & 127)) : (((nn - 1024) >> 7) * 256 + 128 + ((nn - 1024) & 127));
        *(u32x4*)(WT + (size_t)(dst_row_base + nn) * Kdst + k0 + 8 * cch) = o; }
    asm volatile("s_waitcnt lgkmcnt(0)" ::: "memory");
}
__device__ __forceinline__ void phase_convert(const Params& p, unsigned char* lds, int G) {
    const int tid = threadIdx.x, lane = tid & 63, wave = tid >> 6;
    float* scr = (float*)lds + wave * (64 * 65);
    const int gw = (int)blockIdx.x * NWAVES + wave, NGW = G * NWAVES;
    constexpr int I_IN = 16 * 52, I_OUT = 16 * 16, I_GU = 32 * 16 * 32, I_DN = 32 * 16 * 16, NITEMS = I_IN + I_OUT + I_GU + I_DN;
    bf16_t* win_t = (bf16_t*)(p.ws + WS_WIN_T); bf16_t* wout_t = (bf16_t*)(p.ws + WS_WOUT_T); bf16_t* wg_t = (bf16_t*)(p.ws + WS_WG_T); bf16_t* wd_t = (bf16_t*)(p.ws + WS_WD_T);
    for (int it = gw; it < NITEMS; it += NGW) {
        int r = it;
        if (r < I_IN) { transpose_item(p.in[I_WIN], IC, (r / 52) * 64, (r % 52) * 64, win_t, 1024, 0, false, scr, lane); continue; } r -= I_IN;
        if (r < I_OUT) { transpose_item(p.in[I_WOUT], D, (r / 16) * 64, (r % 16) * 64, wout_t, 1024, 0, false, scr, lane); continue; } r -= I_OUT;
        if (r < I_GU) { const int e = r / 512, rr = r % 512; transpose_item(p.in[I_WGU] + (size_t)e * 1024 * 2048, 2048, (rr / 32) * 64, (rr % 32) * 64, wg_t, 1024, e * 2048, true, scr, lane); continue; } r -= I_GU;
        { const int e = r / 256, rr = r % 256; transpose_item(p.in[I_WDN] + (size_t)e * 1024 * 1024, 1024, (rr / 16) * 64, (rr % 16) * 64, wd_t, 1024, e * 1024, false, scr, lane); }
    }
}

__device__ __forceinline__ void phase_norm1(const Params& p, int G) {
    const int tid = threadIdx.x, lane = tid & 63, wave = tid >> 6;
    const int gw = (int)blockIdx.x * NWAVES + wave, NGW = G * NWAVES;
    const float* x = p.in[I_X]; const float* gain = p.in[I_N1G]; const float* mod = (const float*)(p.ws + WS_MOD);
    bf16_t* h = (bf16_t*)(p.ws + WS_H);
    for (int row = gw; row < T; row += NGW) {
        const int b = row / SEQ;
        const f32x4* xr = (const f32x4*)(x + (size_t)row * D) + lane;
        f32x4 v[4]; float s = 0.f;
#pragma unroll
        for (int j = 0; j < 4; ++j) { v[j] = xr[64 * j]; s += (v[j][0] * v[j][0] + v[j][1] * v[j][1]) + (v[j][2] * v[j][2] + v[j][3] * v[j][3]); }
        const float rstd = rsqrtf(wave_sum(s) * (1.0f / D) + NORM_EPS);
        const float* sh = mod + b * 6144; const float* scl = mod + b * 6144 + 1024;
        unsigned long long* o8 = (unsigned long long*)(h + (size_t)row * D) + lane;
#pragma unroll
        for (int j = 0; j < 4; ++j) { const int k = 4 * lane + 256 * j;
            const f32x4 g = *(const f32x4*)(gain + k), s1 = *(const f32x4*)(scl + k), s0 = *(const f32x4*)(sh + k);
            const f32x4 y = (v[j] * rstd) * g * (s1 + 1.0f) + s0;
            o8[64 * j] = (unsigned long long)cvtpk(y[0], y[1]) | ((unsigned long long)cvtpk(y[2], y[3]) << 32); }
    }
}

__device__ __forceinline__ s16x4 vtr(const LAS unsigned char* pp) { typedef short v4i16_t __attribute__((ext_vector_type(4))); return __builtin_bit_cast(s16x4, __builtin_amdgcn_ds_read_tr16_b64_v4i16((LAS v4i16_t*)pp)); }
constexpr int ATT_BUF = 32768;
constexpr int ATT_QROWS = 128, ATT_NQB = SEQ / ATT_QROWS, ATT_UNITS = NB * 4 * ATT_NQB;
__device__ __forceinline__ void attn_unit(const Params& p, LAS unsigned char* lds, int b, int h, int qb, float lam) {
    const int tid = threadIdx.x, lane = tid & 63, wid = __builtin_amdgcn_readfirstlane(tid >> 6), r32 = lane & 31, hi = lane >> 5;
    const int c = wid & 1, qblk = wid >> 1;
    const bf16_t* proj = (const bf16_t*)(p.ws + WS_PROJ) + (size_t)b * SEQ * IC;
    const int q0 = qb * ATT_QROWS, qw0 = q0 + 32 * qblk;
    const bf16_t* Qb = proj + RC + h * 128 + c * 64;
    const bf16_t* Kb = proj + RC + 512 + h * 128;
    const bf16_t* Vb = proj + RC + 1024 + h * 128;
    const float slope = exp2f(-2.0f * (float)(h + 1)) * LOG2E;
    bf16x8 qr[4];
#pragma unroll
    for (int d0 = 0; d0 < 4; ++d0) qr[d0] = *(const bf16x8*)(Qb + (size_t)(qw0 + r32) * IC + d0 * 16 + hi * 8);
    f32x16 o[4];
#pragma unroll
    for (int d = 0; d < 4; ++d) o[d] = f32x16{};
    float m_ = -INFINITY, l_ = 0.f;
    const int NT = (q0 + ATT_QROWS) / 64;
    const bf16_t* ksrc = Kb + (size_t)lane * IC + wid * 8;
    const int p0i = wid, p1i = wid + 8;
    const bf16_t* vsrc0 = Vb + (size_t)(16 * (p0i & 3) + (lane >> 2)) * IC + (p0i >> 2) * 32 + (lane & 3) * 8;
    const bf16_t* vsrc1 = Vb + (size_t)(16 * (p1i & 3) + (lane >> 2)) * IC + (p1i >> 2) * 32 + (lane & 3) * 8;
#define ATT_DMA(t, buf) do { const size_t ro = (size_t)(t) * 64 * IC; LAS unsigned char* bb_ = lds + (buf) * ATT_BUF; \
        __builtin_amdgcn_global_load_lds((const unsigned*)(ksrc + ro), (LAS unsigned*)(bb_ + wid * 1024), 16, 0, 0); \
        __builtin_amdgcn_global_load_lds((const unsigned*)(ksrc + ro + 64), (LAS unsigned*)(bb_ + 8192 + wid * 1024), 16, 0, 0); \
        __builtin_amdgcn_global_load_lds((const unsigned*)(vsrc0 + ro), (LAS unsigned*)(bb_ + 16384 + p0i * 1024), 16, 0, 0); \
        __builtin_amdgcn_global_load_lds((const unsigned*)(vsrc1 + ro), (LAS unsigned*)(bb_ + 16384 + p1i * 1024), 16, 0, 0); } while (0)
    ATT_DMA(0, 0); ATT_DMA(1, 1);
    if (NT >= 3) { ATT_DMA(2, 2); asm volatile("s_waitcnt vmcnt(8)" ::: "memory"); } else { asm volatile("s_waitcnt vmcnt(4)" ::: "memory"); }
    __builtin_amdgcn_s_barrier();
    const int voff = ((lane >> 4) & 1) * 32 + (lane & 3) * 8 + (4 * hi + ((lane & 15) >> 2)) * 64;
    const int qpos = qw0 + r32;
    for (int kt = 0; kt < NT; ++kt) {
        const int cur = kt & 3;
        if (kt + 3 < NT) ATT_DMA(kt + 3, (kt + 3) & 3);
        const int k0 = kt * 64;
        if (k0 <= qw0 + 31) {
            const LAS unsigned char* bb = lds + cur * ATT_BUF;
            const bool need_mask = (k0 + 63 > qw0);
            const LAS unsigned char* kb = bb + c * 8192 + hi * 1024 + r32 * 16;
            f32x16 s0 = f32x16{}, s1 = f32x16{};
#pragma unroll
            for (int d0 = 0; d0 < 4; ++d0) {
                const bf16x8 a0 = *(const LAS bf16x8*)(kb + d0 * 2048), a1 = *(const LAS bf16x8*)(kb + d0 * 2048 + 512);
                s0 = __builtin_amdgcn_mfma_f32_32x32x16_bf16(a0, qr[d0], s0, 0, 0, 0);
                s1 = __builtin_amdgcn_mfma_f32_32x32x16_bf16(a1, qr[d0], s1, 0, 0, 0);
            }
            const float fb = (float)(k0 - qpos + 4 * hi);
            float rm = -INFINITY;
#pragma unroll
            for (int r = 0; r < 16; ++r) { const float t0 = fb + (float)((r & 3) + 8 * (r >> 2)), t1 = fb + (float)((r & 3) + 8 * (r >> 2) + 32);
                float v0 = __builtin_fmaf(slope, t0, s0[r]), v1 = __builtin_fmaf(slope, t1, s1[r]);
                if (need_mask) { if (t0 > 0.f) v0 = -INFINITY; if (t1 > 0.f) v1 = -INFINITY; }
                s0[r] = v0; s1[r] = v1; rm = fmaxf(rm, fmaxf(v0, v1)); }
            rm = fmaxf(rm, __shfl_xor(rm, 32));
            const float mn = fmaxf(m_, rm);
            const float alpha = __builtin_amdgcn_exp2f(m_ - mn);
            m_ = mn;
            float ps = 0.f;
#pragma unroll
            for (int r = 0; r < 16; ++r) { s0[r] = __builtin_amdgcn_exp2f(s0[r] - mn); s1[r] = __builtin_amdgcn_exp2f(s1[r] - mn); ps += s0[r] + s1[r]; }
            l_ = l_ * alpha + ps;
            if (__any(alpha != 1.0f)) {
#pragma unroll
                for (int d = 0; d < 4; ++d)
#pragma unroll
                    for (int r = 0; r < 16; ++r) o[d][r] *= alpha;
            }
            bf16x8 pf[4];
#pragma unroll
            for (int ks = 0; ks < 2; ++ks) {
                u32x4 w0, w1;
                w0.x = cvtpk(s0[8 * ks + 0], s0[8 * ks + 1]); w0.y = cvtpk(s0[8 * ks + 2], s0[8 * ks + 3]); w0.z = cvtpk(s0[8 * ks + 4], s0[8 * ks + 5]); w0.w = cvtpk(s0[8 * ks + 6], s0[8 * ks + 7]);
                w1.x = cvtpk(s1[8 * ks + 0], s1[8 * ks + 1]); w1.y = cvtpk(s1[8 * ks + 2], s1[8 * ks + 3]); w1.z = cvtpk(s1[8 * ks + 4], s1[8 * ks + 5]); w1.w = cvtpk(s1[8 * ks + 6], s1[8 * ks + 7]);
                pf[ks] = __builtin_bit_cast(bf16x8, w0); pf[2 + ks] = __builtin_bit_cast(bf16x8, w1);
            }
            const LAS unsigned char* vb = bb + 16384 + voff;
#pragma unroll
            for (int dblk = 0; dblk < 4; ++dblk) {
#pragma unroll
                for (int ks = 0; ks < 4; ++ks) {
                    const s16x4 lo = vtr(vb + (dblk * 4 + ks) * 1024), hh = vtr(vb + (dblk * 4 + ks) * 1024 + 512);
                    const bf16x8 vf = (bf16x8){lo[0], lo[1], lo[2], lo[3], hh[0], hh[1], hh[2], hh[3]};
                    o[dblk] = __builtin_amdgcn_mfma_f32_32x32x16_bf16(vf, pf[ks], o[dblk], 0, 0, 0);
                }
            }
        }
        const int rem = (NT - 1 - kt) < 3 ? (NT - 1 - kt) : 3;
        if (rem == 3) asm volatile("s_waitcnt vmcnt(8)" ::: "memory"); else if (rem == 2) asm volatile("s_waitcnt vmcnt(4)" ::: "memory"); else asm volatile("s_waitcnt vmcnt(0)" ::: "memory");
        asm volatile("s_waitcnt lgkmcnt(0)" ::: "memory");
        __builtin_amdgcn_s_barrier();
    }
#undef ATT_DMA
    l_ += __shfl_xor(l_, 32);
    LAS float* xb = (LAS float*)(lds + qblk * 16384);
    if (c == 1) {
        const float i1 = lam / l_;
#pragma unroll
        for (int d = 0; d < 4; ++d)
#pragma unroll
            for (int r = 0; r < 16; ++r) xb[(d * 16 + r) * 64 + lane] = o[d][r] * i1;
    }
    __syncthreads();
    if (c == 0) {
        const float i0 = 1.0f / l_;
        float ss = 0.f;
#pragma unroll
        for (int d = 0; d < 4; ++d)
#pragma unroll
            for (int r = 0; r < 16; ++r) { const float v = o[d][r] * i0 - xb[(d * 16 + r) * 64 + lane]; o[d][r] = v; ss += v * v; }
        ss += __shfl_xor(ss, 32);
        const float rstd = rsqrtf(ss * (1.0f / 128.0f) + NORM_EPS) * (1.0f - LAMBDA_INIT);
        const float* sg = p.in[I_SUBLN];
        bf16_t* yo = (bf16_t*)(p.ws + WS_YMIX) + (size_t)(b * SEQ + qw0 + r32) * D + RW + h * 128;
#pragma unroll
        for (int d = 0; d < 4; ++d)
#pragma unroll
            for (int g = 0; g < 4; ++g) { const int dd = 32 * d + 8 * g + 4 * hi; const f32x4 gv = *(const f32x4*)(sg + dd);
                u32x2 w; w.x = cvtpk(o[d][4 * g] * rstd * gv[0], o[d][4 * g + 1] * rstd * gv[1]); w.y = cvtpk(o[d][4 * g + 2] * rstd * gv[2], o[d][4 * g + 3] * rstd * gv[3]);
                *(u32x2*)(yo + dd) = w; }
    }
    __syncthreads();
}

constexpr int RCH = 32;
constexpr int RK_R = 0, RK_KM = 8192, RK_DEC = 16384, RK_KK = 24576, RK_BB = 32768, RK_VV = 40960, RK_GG = 49152;
constexpr int RK_AW = 57344;
constexpr int RK_AA = RK_AW + 4608;
constexpr int RK_AG = RK_AA + 4608;
constexpr int RK_BON = RK_AG + 8704;
constexpr int RK_MU = RK_BON + 128;
constexpr int RK_RAW = 77824;
constexpr int RK_END = RK_RAW + 33 * 1024;
static_assert(RK_MU + 1792 <= RK_RAW && RK_END <= LDS_BYTES && (RK_RAW % 1024) == 0, "rwkv prep LDS map");
template <int CTRL> __device__ __forceinline__ float dpp_add(float v) { return v + __builtin_bit_cast(float, __builtin_amdgcn_update_dpp(0, __builtin_bit_cast(int, v), CTRL, 0xf, 0xf, true)); }
__device__ __forceinline__ float red16(float v) {
    v = dpp_add<0xB1>(v);
    v = dpp_add<0x4E>(v);
    v = dpp_add<0x141>(v);
    v = dpp_add<0x140>(v);
    return v;
}
__device__ __forceinline__ int rk_piece_col(int pc, int h) {
    return pc < 8 ? h * 64 + 8 * pc : (pc < 16 ? 512 + h * 64 + 8 * (pc - 8) : (pc < 24 ? 1024 + h * 64 + 8 * (pc - 16) : 1536 + 8 * (pc - 24)));
}
#define RK_BAR() do { asm volatile("s_waitcnt lgkmcnt(0)" ::: "memory"); __builtin_amdgcn_s_barrier(); asm volatile("" ::: "memory"); } while (0)
__device__ __forceinline__ void rwkv_prep(const Params& p, LAS unsigned char* lds, int b, int h, int ch0, int ch1) {
    const int tid = threadIdx.x, lane = tid & 63, wid = __builtin_amdgcn_readfirstlane(tid >> 6);
    const bf16_t* proj = (const bf16_t*)(p.ws + WS_PROJ) + (size_t)b * SEQ * IC;
    LAS float* R_ = (LAS float*)(lds + RK_R); LAS float* KM_ = (LAS float*)(lds + RK_KM); LAS float* DEC_ = (LAS float*)(lds + RK_DEC); LAS float* KK_ = (LAS float*)(lds + RK_KK);
    LAS float* BB_ = (LAS float*)(lds + RK_BB); LAS float* VV_ = (LAS float*)(lds + RK_VV); LAS float* GG_ = (LAS float*)(lds + RK_GG); LAS float* BON_ = (LAS float*)(lds + RK_BON);
    LAS float* MU_ = (LAS float*)(lds + RK_MU);
    const int dpc = lane < 56 ? lane : 55;
    const bf16_t* dsrc = proj + rk_piece_col(dpc, h);
#define RK_DMA(t0_) do { for (int rho = wid; rho < 33; rho += NWAVES) { int tok = (t0_) - 1 + rho; tok = tok < 0 ? 0 : tok; \
        __builtin_amdgcn_global_load_lds((const unsigned*)(dsrc + (size_t)tok * IC), (LAS unsigned*)(lds + RK_RAW + rho * 1024), 16, 0, 0); } } while (0)
    RK_DMA(ch0 * RCH);
    if (tid < 448) MU_[tid] = p.in[I_MU][rk_piece_col(tid >> 3, h) + (tid & 7)];
    const int ntile = wid & 3, ttile = wid >> 2, fn = lane & 15, fk = lane >> 4;
    const int ncol = h * 64 + ntile * 16 + fn;
    bf16x8 bw[2], ba[2], bg[4];
    {
        const float* wup = p.in[I_WUP]; const float* aup = p.in[I_AUP]; const float* gup = p.in[I_GUP];
#pragma unroll
        for (int ks = 0; ks < 2; ++ks) { float t[8], u[8];
#pragma unroll
            for (int j = 0; j < 8; ++j) { const int k = 32 * ks + 8 * fk + j; t[j] = wup[k * RW + ncol]; u[j] = aup[k * RW + ncol]; }
            u32x4 a, c; a.x = cvtpk(t[0], t[1]); a.y = cvtpk(t[2], t[3]); a.z = cvtpk(t[4], t[5]); a.w = cvtpk(t[6], t[7]);
            c.x = cvtpk(u[0], u[1]); c.y = cvtpk(u[2], u[3]); c.z = cvtpk(u[4], u[5]); c.w = cvtpk(u[6], u[7]);
            bw[ks] = __builtin_bit_cast(bf16x8, a); ba[ks] = __builtin_bit_cast(bf16x8, c); }
#pragma unroll
        for (int ks = 0; ks < 4; ++ks) { float t[8];
#pragma unroll
            for (int j = 0; j < 8; ++j) { const int k = 32 * ks + 8 * fk + j; t[j] = gup[k * RW + ncol]; }
            u32x4 a; a.x = cvtpk(t[0], t[1]); a.y = cvtpk(t[2], t[3]); a.z = cvtpk(t[4], t[5]); a.w = cvtpk(t[6], t[7]);
            bg[ks] = __builtin_bit_cast(bf16x8, a); }
    }
    const float w0n = p.in[I_W0][ncol], a0n = p.in[I_A0][ncol];
    const int q16 = tid & 15, tk16 = tid >> 4;
    const f32x4 kkc = *(const f32x4*)(p.in[I_KK] + h * 64 + 4 * q16), kac = *(const f32x4*)(p.in[I_KA] + h * 64 + 4 * q16), rkc = *(const f32x4*)(p.in[I_RK] + h * 64 + 4 * q16);
    const size_t hb = (size_t)(b * 8 + h) * SEQ * 64;
    float* gR = (float*)(p.ws + WS_RS) + hb; float* gKM = (float*)(p.ws + WS_KMS) + hb; float* gDEC = (float*)(p.ws + WS_DECS) + hb; float* gKK = (float*)(p.ws + WS_KKS) + hb;
    float* gBB = (float*)(p.ws + WS_BBS) + hb; float* gVS = (float*)(p.ws + WS_VS) + hb; float* gGG = p.out + (size_t)16 * 1024 * 1024 + hb; float* gBON = (float*)(p.ws + WS_BON) + (size_t)(b * 8 + h) * SEQ;
    for (int ch = ch0; ch < ch1; ++ch) {
        const int t0 = ch * RCH;
        asm volatile("s_waitcnt vmcnt(0)" ::: "memory");
        __syncthreads();
#pragma unroll
        for (int it = 0; it < 4; ++it) { const int item = tid + it * NTHREADS;
            if (item < RCH * 56) { const int tk = item / 56, pc = item - tk * 56;
                const u32x4 cv = *(const LAS u32x4*)(lds + RK_RAW + (tk + 1) * 1024 + pc * 16);
                u32x4 pv = *(const LAS u32x4*)(lds + RK_RAW + tk * 1024 + pc * 16);
                if (t0 + tk == 0) pv = (u32x4){0u, 0u, 0u, 0u};
                const f32x4 m0 = *(const LAS f32x4*)(MU_ + pc * 8), m1 = *(const LAS f32x4*)(MU_ + pc * 8 + 4);
                float xv[8];
#pragma unroll
                for (int j = 0; j < 4; ++j) { const unsigned cw = cv[j], pw = pv[j];
                    const float c0 = __uint_as_float(cw << 16), c1 = __uint_as_float(cw & 0xffff0000u), p0 = __uint_as_float(pw << 16), p1 = __uint_as_float(pw & 0xffff0000u);
                    const float ma = (j < 2) ? m0[2 * j] : m1[2 * j - 4], mb = (j < 2) ? m0[2 * j + 1] : m1[2 * j - 3];
                    xv[2 * j] = c0 + ma * (p0 - c0); xv[2 * j + 1] = c1 + mb * (p1 - c1); }
                const int seg = pc >> 3, pi = pc & 7;
                if (seg <= 2) { LAS float* dst = (seg == 0 ? R_ : (seg == 1 ? KM_ : VV_)) + tk * 64 + 8 * pi;
                    *(LAS f32x4*)dst = (f32x4){xv[0], xv[1], xv[2], xv[3]}; *(LAS f32x4*)(dst + 4) = (f32x4){xv[4], xv[5], xv[6], xv[7]}; }
                else if (seg == 3) { u32x4 w; w.x = cvtpk(tanh_fast(xv[0]), tanh_fast(xv[1])); w.y = cvtpk(tanh_fast(xv[2]), tanh_fast(xv[3])); w.z = cvtpk(tanh_fast(xv[4]), tanh_fast(xv[5])); w.w = cvtpk(tanh_fast(xv[6]), tanh_fast(xv[7]));
                    *(LAS u32x4*)(lds + RK_AW + tk * 144 + 16 * pi) = w; }
                else if (seg == 4) { u32x4 w; w.x = cvtpk(xv[0], xv[1]); w.y = cvtpk(xv[2], xv[3]); w.z = cvtpk(xv[4], xv[5]); w.w = cvtpk(xv[6], xv[7]);
                    *(LAS u32x4*)(lds + RK_AA + tk * 144 + 16 * pi) = w; }
                else { u32x4 w; w.x = cvtpk(sigmoidf_(xv[0]), sigmoidf_(xv[1])); w.y = cvtpk(sigmoidf_(xv[2]), sigmoidf_(xv[3])); w.z = cvtpk(sigmoidf_(xv[4]), sigmoidf_(xv[5])); w.w = cvtpk(sigmoidf_(xv[6]), sigmoidf_(xv[7]));
                    *(LAS u32x4*)(lds + RK_AG + tk * 272 + (pc - 40) * 16) = w; }
            } }
        __syncthreads();
        if (ch + 1 < ch1) RK_DMA(t0 + RCH);
        {
            f32x4 cw = (f32x4){0.f, 0.f, 0.f, 0.f}, ca = cw, cg2 = cw;
            const int tok = ttile * 16 + fn;
#pragma unroll
            for (int ks = 0; ks < 2; ++ks) {
                const bf16x8 aw = *(const LAS bf16x8*)(lds + RK_AW + tok * 144 + (32 * ks + 8 * fk) * 2);
                const bf16x8 aa = *(const LAS bf16x8*)(lds + RK_AA + tok * 144 + (32 * ks + 8 * fk) * 2);
                cw = __builtin_amdgcn_mfma_f32_16x16x32_bf16(aw, bw[ks], cw, 0, 0, 0);
                ca = __builtin_amdgcn_mfma_f32_16x16x32_bf16(aa, ba[ks], ca, 0, 0, 0);
            }
#pragma unroll
            for (int ks = 0; ks < 4; ++ks) {
                const bf16x8 ag = *(const LAS bf16x8*)(lds + RK_AG + tok * 272 + (32 * ks + 8 * fk) * 2);
                cg2 = __builtin_amdgcn_mfma_f32_16x16x32_bf16(ag, bg[ks], cg2, 0, 0, 0);
            }
#pragma unroll
            for (int r = 0; r < 4; ++r) { const int tk = ttile * 16 + 4 * fk + r, n = ntile * 16 + fn;
                DEC_[tk * 64 + n] = __expf(-0.6065306597126334f * sigmoidf_(cw[r] + w0n));
                BB_[tk * 64 + n] = sigmoidf_(ca[r] + a0n);
                GG_[tk * 64 + n] = cg2[r]; }
        }
        RK_BAR();
        {
            const f32x4 kp = *(const LAS f32x4*)(KM_ + tk16 * 64 + 4 * q16), av = *(const LAS f32x4*)(BB_ + tk16 * 64 + 4 * q16), rr = *(const LAS f32x4*)(R_ + tk16 * 64 + 4 * q16);
            const f32x4 kkv = kp * kkc;
            const float nrm2 = red16((kkv[0] * kkv[0] + kkv[1] * kkv[1]) + (kkv[2] * kkv[2] + kkv[3] * kkv[3]));
            const f32x4 kkn = kkv * __builtin_amdgcn_rsqf(fmaxf(nrm2, 1e-24f));
            const f32x4 kmod = kp * ((av - 1.0f) * kac + 1.0f);
            const f32x4 t = rr * kmod * rkc;
            const float bs = red16((t[0] + t[1]) + (t[2] + t[3]));
            *(LAS f32x4*)(KK_ + tk16 * 64 + 4 * q16) = kkn; *(LAS f32x4*)(BB_ + tk16 * 64 + 4 * q16) = kkn * av; *(LAS f32x4*)(KM_ + tk16 * 64 + 4 * q16) = kmod;
            if (q16 == 0) BON_[tk16] = bs;
        }
        RK_BAR();
        {
            const size_t go = (size_t)t0 * 64 + tid * 4;
            *(f32x4*)(gR + go) = *(const LAS f32x4*)(R_ + tid * 4); *(f32x4*)(gKM + go) = *(const LAS f32x4*)(KM_ + tid * 4); *(f32x4*)(gDEC + go) = *(const LAS f32x4*)(DEC_ + tid * 4);
            *(f32x4*)(gKK + go) = *(const LAS f32x4*)(KK_ + tid * 4); *(f32x4*)(gBB + go) = *(const LAS f32x4*)(BB_ + tid * 4); *(f32x4*)(gVS + go) = *(const LAS f32x4*)(VV_ + tid * 4);
            *(f32x4*)(gGG + go) = *(const LAS f32x4*)(GG_ + tid * 4);
            if (tid < RCH) gBON[t0 + tid] = BON_[tid];
        }
    }
    asm volatile("s_waitcnt vmcnt(0)" ::: "memory");
    __syncthreads();
#undef RK_DMA
}

constexpr int RS_BUF = 45056;
constexpr int RS_YY = 2 * RS_BUF;
constexpr int RS_JUNK = RS_YY + 4096;
constexpr int RS_END = RS_JUNK + 2048 + 32 * 128;
static_assert(RS_END <= LDS_BYTES, "rwkv scan LDS map");
__device__ __forceinline__ void rwkv_scan(const Params& p, LAS unsigned char* lds, int b, int h, int half) {
    const int tid = threadIdx.x, lane = tid & 63, wid = __builtin_amdgcn_readfirstlane(tid >> 6);
    const size_t hb = (size_t)(b * 8 + h) * SEQ * 64;
    const float* gKK = (const float*)(p.ws + WS_KKS) + hb; const float* gDEC = (const float*)(p.ws + WS_DECS) + hb; const float* gBB = (const float*)(p.ws + WS_BBS) + hb;
    const float* gKM = (const float*)(p.ws + WS_KMS) + hb; const float* gR = (const float*)(p.ws + WS_RS) + hb; const float* gVS = (const float*)(p.ws + WS_VS) + hb;
    float* yraw = p.out + (size_t)b * SEQ * RW + h * 64 + half * 32;
    const int vtok = lane >> 3, vsub = lane & 7;
#define RS_DMA(t0_, buf) do { LAS unsigned char* bb_ = lds + (buf) * RS_BUF; \
        for (int pc = wid; pc < 44; pc += NWAVES) { \
            const float* src_; \
            if (pc < 40) { const int ar = pc >> 3, pp = pc & 7; const float* base_ = ar == 0 ? gKK : (ar == 1 ? gDEC : (ar == 2 ? gBB : (ar == 3 ? gKM : gR))); src_ = base_ + (size_t)(t0_) * 64 + pp * 256 + lane * 4; } \
            else { const int pp = pc - 40; src_ = gVS + (size_t)((t0_) + pp * 8 + vtok) * 64 + half * 32 + vsub * 4; } \
            __builtin_amdgcn_global_load_lds((const unsigned*)src_, (LAS unsigned*)(bb_ + pc * 1024), 16, 0, 0); } } while (0)
    RS_DMA(0, 0);
    f32x4 S = (f32x4){0.f, 0.f, 0.f, 0.f};
    const int kc = lane & 15, row = 4 * wid + (lane >> 4);
    const int ybase = (kc == 0) ? (RS_YY + row * 4) : (RS_JUNK + tid * 4);
    for (int ch = 0; ch < SEQ / RCH; ++ch) {
        const int t0 = ch * RCH, cur = ch & 1;
        asm volatile("s_waitcnt vmcnt(0)" ::: "memory");
        __syncthreads();
        if (ch + 1 < SEQ / RCH) RS_DMA(t0 + RCH, cur ^ 1);
        const LAS float* KK_ = (const LAS float*)(lds + cur * RS_BUF), * DEC_ = KK_ + 2048, * BB_ = KK_ + 4096, * KM_ = KK_ + 6144, * R_ = KK_ + 8192, * VV_ = KK_ + 10240;
        {
#define RK_LD(t_, A, W, B, K, R, V) do { A = *(const LAS f32x4*)(KK_ + (t_) * 64 + 4 * kc); W = *(const LAS f32x4*)(DEC_ + (t_) * 64 + 4 * kc); B = *(const LAS f32x4*)(BB_ + (t_) * 64 + 4 * kc); \
        K = *(const LAS f32x4*)(KM_ + (t_) * 64 + 4 * kc); R = *(const LAS f32x4*)(R_ + (t_) * 64 + 4 * kc); V = VV_[(t_) * 32 + row]; } while (0)
#define RK_DOT(S_, X_) ((S_[0] * X_[0] + S_[1] * X_[1]) + (S_[2] * X_[2] + S_[3] * X_[3]))
            f32x4 a4, w4, b4, k4, r4, an, wn, bn, kn, rn; float v1, vn;
            RK_LD(0, a4, w4, b4, k4, r4, v1);
            float yp = 0.f;
#pragma unroll
            for (int t = 0; t < RCH; ++t) {
                if (t + 1 < RCH) RK_LD(t + 1, an, wn, bn, kn, rn, vn);
                float pp = RK_DOT(S, a4);
                pp = red16(pp); yp = red16(yp);
                if (t > 0) *(LAS float*)(lds + ybase + (t - 1) * 128) = yp;
                S = S * w4 - b4 * pp + k4 * v1;
                yp = RK_DOT(S, r4);
                a4 = an; w4 = wn; b4 = bn; k4 = kn; r4 = rn; v1 = vn;
            }
            yp = red16(yp);
            *(LAS float*)(lds + ybase + (RCH - 1) * 128) = yp;
#undef RK_LD
#undef RK_DOT
        }
        RK_BAR();
        if (tid < 256) { const int tk = tid >> 3, sub = tid & 7; *(f32x4*)(yraw + (size_t)(t0 + tk) * RW + sub * 4) = *(const LAS f32x4*)(lds + RS_YY + tk * 128 + sub * 16); }
    }
    asm volatile("s_waitcnt vmcnt(0)" ::: "memory");
    __syncthreads();
#undef RS_DMA
}
__device__ __forceinline__ void rwkv_finalize(const Params& p, int G) {
    const int tid = threadIdx.x, q16 = tid & 15;
    const float* yraw = p.out; const float* gGG = p.out + (size_t)16 * 1024 * 1024; const float* gVS = (const float*)(p.ws + WS_VS); const float* gBON = (const float*)(p.ws + WS_BON);
    bf16_t* ymix = (bf16_t*)(p.ws + WS_YMIX);
    for (int item = (int)blockIdx.x * (NTHREADS / 16) + (tid >> 4); item < T * 8; item += G * (NTHREADS / 16)) {
        const int tok = item >> 3, h = item & 7, b = tok / SEQ, t = tok - b * SEQ;
        const f32x4 y = *(const f32x4*)(yraw + (size_t)tok * RW + h * 64 + 4 * q16);
        const size_t ho = ((size_t)(b * 8 + h) * SEQ + t) * 64 + 4 * q16;
        const f32x4 vv = *(const f32x4*)(gVS + ho), gg = *(const f32x4*)(gGG + ho);
        const float bon = gBON[(size_t)(b * 8 + h) * SEQ + t];
        const f32x4 gng = *(const f32x4*)(p.in[I_GNG] + h * 64 + 4 * q16), gnb = *(const f32x4*)(p.in[I_GNB] + h * 64 + 4 * q16);
        const float mean = red16((y[0] + y[1]) + (y[2] + y[3])) * (1.0f / 64.0f);
        const f32x4 dl = y - mean;
        const float var = red16((dl[0] * dl[0] + dl[1] * dl[1]) + (dl[2] * dl[2] + dl[3] * dl[3])) * (1.0f / 64.0f);
        const f32x4 yn = dl * __builtin_amdgcn_rsqf(var + GN_EPS) * gng + gnb;
        const f32x4 ov = (yn + vv * bon) * gg;
        u32x2 w; w.x = cvtpk(ov[0], ov[1]); w.y = cvtpk(ov[2], ov[3]);
        *(u32x2*)(ymix + (size_t)tok * D + h * 64 + 4 * q16) = w;
    }
}
#undef RK_BAR

constexpr int RT_PITCH = 36;
__device__ __forceinline__ void phase_router(const Params& p, LAS unsigned char* lds, int G) {
    const int tid = threadIdx.x, lane = tid & 63, wave = tid >> 6;
    LAS float* wr_ = (LAS float*)lds;
    LAS int* hist = (LAS int*)(lds + 147456);
    const float* rw = p.in[I_RTW];
    for (int i = tid; i < 1024 * 8; i += NTHREADS) { const int k = i >> 3, c4 = i & 7; const f32x4 v = *(const f32x4*)(rw + k * 32 + 4 * c4);
        const int ln = (k & 255) >> 2, ii = k & 3, jj = k >> 8; *(LAS f32x4*)(wr_ + ((ii + 4 * jj) * 64 + ln) * RT_PITCH + 4 * c4) = v; }
    const float* x1 = p.out; const float* gain = p.in[I_N2G]; const float* mod = (const float*)(p.ws + WS_MOD); const float* rb = p.in[I_RTB];
    bf16_t* h2 = (bf16_t*)(p.ws + WS_H);
    int* ridx = (int*)(p.ws + WS_ROUTE); float* rwt = (float*)(p.ws + WS_ROUTE + 512 * 1024);
    int* blockcnt = (int*)(p.ws + WS_CTL + 4096);
    const int TPB = T / G;
    for (int blk = blockIdx.x; blk < G; blk += G) {
        if (tid < 32) hist[tid] = 0;
        __syncthreads();
        for (int ti = wave; ti < TPB; ti += NWAVES) {
            const int row = blk * TPB + ti; const int b = row / SEQ;
            const f32x4* xr = (const f32x4*)(x1 + (size_t)row * D) + lane;
            f32x4 v[4]; float s = 0.f;
#pragma unroll
            for (int j = 0; j < 4; ++j) { v[j] = xr[64 * j]; s += (v[j][0] * v[j][0] + v[j][1] * v[j][1]) + (v[j][2] * v[j][2] + v[j][3] * v[j][3]); }
            const float rstd = rsqrtf(wave_sum(s) * (1.0f / D) + NORM_EPS);
            const float* sh = mod + b * 6144 + 3072; const float* scl = mod + b * 6144 + 4096;
            unsigned long long* o8 = (unsigned long long*)(h2 + (size_t)row * D) + lane;
            float acc[32];
#pragma unroll
            for (int e = 0; e < 32; ++e) acc[e] = 0.f;
#pragma unroll
            for (int j = 0; j < 4; ++j) { const int k = 4 * lane + 256 * j;
                const f32x4 g = *(const f32x4*)(gain + k), s1 = *(const f32x4*)(scl + k), s0 = *(const f32x4*)(sh + k);
                const f32x4 y = (v[j] * rstd) * g * (s1 + 1.0f) + s0;
                o8[64 * j] = (unsigned long long)cvtpk(y[0], y[1]) | ((unsigned long long)cvtpk(y[2], y[3]) << 32);
#pragma unroll
                for (int i = 0; i < 4; ++i) { const LAS float* wrow = wr_ + ((i + 4 * j) * 64 + lane) * RT_PITCH; const float yv = y[i];
#pragma unroll
                    for (int c4 = 0; c4 < 8; ++c4) { const f32x4 wv = *(const LAS f32x4*)(wrow + 4 * c4);
                        acc[4 * c4 + 0] += yv * wv[0]; acc[4 * c4 + 1] += yv * wv[1]; acc[4 * c4 + 2] += yv * wv[2]; acc[4 * c4 + 3] += yv * wv[3]; } } }
            float r16[16];
#pragma unroll
            for (int e = 0; e < 16; ++e) { const bool up = (lane & 32) != 0; const float keep = up ? acc[e + 16] : acc[e], send = up ? acc[e] : acc[e + 16]; r16[e] = keep + __shfl_xor(send, 32); }
            float r8[8];
#pragma unroll
            for (int e = 0; e < 8; ++e) { const bool up = (lane & 16) != 0; const float keep = up ? r16[e + 8] : r16[e], send = up ? r16[e] : r16[e + 8]; r8[e] = keep + __shfl_xor(send, 16); }
            float r4[4];
#pragma unroll
            for (int e = 0; e < 4; ++e) { const bool up = (lane & 8) != 0; const float keep = up ? r8[e + 4] : r8[e], send = up ? r8[e] : r8[e + 4]; r4[e] = keep + __shfl_xor(send, 8); }
            float r2[2];
#pragma unroll
            for (int e = 0; e < 2; ++e) { const bool up = (lane & 4) != 0; const float keep = up ? r4[e + 2] : r4[e], send = up ? r4[e] : r4[e + 2]; r2[e] = keep + __shfl_xor(send, 4); }
            float r1;
            { const bool up = (lane & 2) != 0; const float keep = up ? r2[1] : r2[0], send = up ? r2[0] : r2[1]; r1 = keep + __shfl_xor(send, 2); }
            r1 += __shfl_xor(r1, 1);
            const int e_l = lane >> 1;
            float logit = r1 + rb[e_l];
            int sel[4]; float sv[4];
#pragma unroll
            for (int k = 0; k < 4; ++k) { const float mx = wave_max(logit); const unsigned long long bal = __ballot(logit == mx); const int ln = __ffsll((long long)bal) - 1;
                sel[k] = ln >> 1; sv[k] = mx; if (e_l == sel[k]) logit = -INFINITY; }
            const float e1 = __expf(sv[1] - sv[0]), e2 = __expf(sv[2] - sv[0]), e3 = __expf(sv[3] - sv[0]); const float inv = 1.0f / (1.0f + e1 + e2 + e3);
            if (lane == 0) { *(int4*)(ridx + (size_t)row * 4) = make_int4(sel[0], sel[1], sel[2], sel[3]); *(float4*)(rwt + (size_t)row * 4) = make_float4(inv, e1 * inv, e2 * inv, e3 * inv);
                atomicAdd((int*)&hist[sel[0]], 1); atomicAdd((int*)&hist[sel[1]], 1); atomicAdd((int*)&hist[sel[2]], 1); atomicAdd((int*)&hist[sel[3]], 1); }
        }
        __syncthreads();
        if (tid < 32) blockcnt[blk * 32 + tid] = hist[tid];
        __syncthreads();
    }
}

__device__ __forceinline__ void phase_assign(const Params& p, LAS unsigned char* lds, int G) {
    const int tid = threadIdx.x, lane = tid & 63, wave = tid >> 6;
    LAS int* part = (LAS int*)lds;
    LAS int* partb = part + 512;
    LAS int* total = partb + 512;
    LAS int* base = total + 32;
    LAS int* segst = base + 32;
    LAS int* cursor = segst + 32;
    LAS int* slotl = cursor + 32;
    const int* blockcnt = (const int*)(p.ws + WS_CTL + 4096);
    const int* ridx = (const int*)(p.ws + WS_ROUTE); int* rslot = (int*)(p.ws + WS_ROUTE + 1024 * 1024);
    const bf16_t* h2 = (const bf16_t*)(p.ws + WS_H); bf16_t* xs = (bf16_t*)(p.ws + WS_PROJ);
    int* tile = (int*)(p.ws + WS_TILE);
    const int TPB = T / G; const int blk = blockIdx.x;
    { const int e = tid & 31, part_i = tid >> 5; int st = 0, sb = 0;
        for (int bb = part_i; bb < G; bb += 16) { const int c = blockcnt[bb * 32 + e]; st += c; if (bb < blk) sb += c; }
        part[part_i * 32 + e] = st; partb[part_i * 32 + e] = sb; }
    __syncthreads();
    if (tid < 32) { int st = 0, sb = 0;
#pragma unroll
        for (int i = 0; i < 16; ++i) { st += part[i * 32 + tid]; sb += partb[i * 32 + tid]; }
        total[tid] = st; base[tid] = sb; cursor[tid] = 0; }
    __syncthreads();
    if (tid == 0) { int acc = 0; for (int e = 0; e < 32; ++e) { segst[e] = acc; acc += (total[e] + 255) & ~255; }
        if (blk == 0) { int pm = 0; for (int e = 0; e < 32; ++e) { const int nt = (total[e] + 255) >> 8; for (int i = 0; i < nt; ++i) tile[16 + pm + i] = e; pm += nt; } tile[0] = pm; } }
    __syncthreads();
    if (tid < 32) base[tid] += segst[tid];
    __syncthreads();
    for (int a = tid; a < TPB * 4; a += NTHREADS) { const int tok = blk * TPB + (a >> 2); const int e = ridx[(size_t)tok * 4 + (a & 3)];
        const int rank = atomicAdd((int*)&cursor[e], 1); const int slot = base[e] + rank; slotl[a] = slot; rslot[(size_t)tok * 4 + (a & 3)] = slot; }
    __syncthreads();
    for (int a = wave; a < TPB * 4; a += NWAVES) { const int tok = blk * TPB + (a >> 2); const int slot = slotl[a];
        const u32x4* src = (const u32x4*)(h2 + (size_t)tok * D) + lane; u32x4* dst = (u32x4*)(xs + (size_t)slot * D) + lane;
        const u32x4 v0 = src[0], v1 = src[64]; dst[0] = v0; dst[64] = v1; }
    for (int e = blk; e < 32; e += G) { const int s0 = segst[e] + total[e], s1 = segst[e] + ((total[e] + 255) & ~255);
        for (int r = s0 + wave; r < s1; r += NWAVES) { u32x4* dst = (u32x4*)(xs + (size_t)r * D) + lane; dst[0] = (u32x4){0u, 0u, 0u, 0u}; dst[64] = (u32x4){0u, 0u, 0u, 0u}; } }
}

__device__ __forceinline__ void phase_final(const Params& p, int G, int stage) {
    const int tid = threadIdx.x, lane = tid & 63, wave = tid >> 6;
    const int gw = (int)blockIdx.x * NWAVES + wave, NGW = G * NWAVES;
    const float* fg = p.in[I_FG]; const float* mod = (const float*)(p.ws + WS_MOD);
    const int* rslot = (const int*)(p.ws + WS_ROUTE + 1024 * 1024); const float* rwt = (const float*)(p.ws + WS_ROUTE + 512 * 1024);
    const bf16_t* Y = (const bf16_t*)(p.ws + WS_PROJ);
    const float* src = (stage >= 4) ? p.out : p.in[I_X];
    for (int row = gw; row < T; row += NGW) {
        const int b = row / SEQ;
        const f32x4* xr = (const f32x4*)(src + (size_t)row * D) + lane;
        f32x4 v[4];
#pragma unroll
        for (int j = 0; j < 4; ++j) v[j] = xr[64 * j];
        if (stage >= 9) {
            const int4 sl = *(const int4*)(rslot + (size_t)row * 4); const float4 wt = *(const float4*)(rwt + (size_t)row * 4);
            const float* g2 = mod + b * 6144 + 5120;
            const int sls[4] = {sl.x, sl.y, sl.z, sl.w}; const float wts[4] = {wt.x, wt.y, wt.z, wt.w};
#pragma unroll
            for (int j = 0; j < 4; ++j) { f32x4 m = (f32x4){0.f, 0.f, 0.f, 0.f};
#pragma unroll
                for (int k = 0; k < 4; ++k) { const u32x2 yv = *((const u32x2*)(Y + (size_t)sls[k] * D) + lane + 64 * j);
                    m[0] += wts[k] * __uint_as_float(yv.x << 16); m[1] += wts[k] * __uint_as_float(yv.x & 0xffff0000u); m[2] += wts[k] * __uint_as_float(yv.y << 16); m[3] += wts[k] * __uint_as_float(yv.y & 0xffff0000u); }
                const f32x4 g = *(const f32x4*)(g2 + 4 * lane + 256 * j); v[j] = v[j] + g * m; }
        }
        float s = 0.f;
#pragma unroll
        for (int j = 0; j < 4; ++j) s += (v[j][0] * v[j][0] + v[j][1] * v[j][1]) + (v[j][2] * v[j][2] + v[j][3] * v[j][3]);
        const float rstd = rsqrtf(wave_sum(s) * (1.0f / D) + NORM_EPS);
        f32x4* orow = (f32x4*)(p.out + (size_t)row * D) + lane;
#pragma unroll
        for (int j = 0; j < 4; ++j) { const f32x4 g = *(const f32x4*)(fg + 4 * lane + 256 * j); orow[64 * j] = v[j] * rstd * g; }
    }
}


#define XB_TMO      128
#define XB_XCNT(j)  (256  + 64 * (j))
#define XB_XSUB(j)  (1280 + 64 * (j))
#define XB_XGEN(j)  (2304 + 64 * (j))
#define XB_TOP      3328
#define XB_TOPGEN   3392
#define XCD_BAR_WORDS 3456
#define XB_SPIN_CAP (1u << 22)
__device__ __forceinline__ unsigned xb_ld(unsigned* p)              { return __hip_atomic_load(p, __ATOMIC_RELAXED, __HIP_MEMORY_SCOPE_AGENT); }
__device__ __forceinline__ unsigned xb_add(unsigned* p, unsigned v) { return __hip_atomic_fetch_add(p, v, __ATOMIC_RELAXED, __HIP_MEMORY_SCOPE_AGENT); }
__device__ __forceinline__ unsigned xb_xcc_id() { return (unsigned)__builtin_amdgcn_s_getreg((3 << 11) | 20) & 0xFu; }
#define XB_SPIN(cond, bar) do { unsigned _sp = 0; while (cond) { __builtin_amdgcn_s_sleep(1); \
    if ((++_sp & 255u) == 0u) { if (xb_ld(&(bar)[XB_TMO])) break; if (_sp > XB_SPIN_CAP) { atomicAdd(&(bar)[XB_TMO], 1u); break; } } } } while (0)
struct XcdBarrier { unsigned* bar; unsigned x; volatile LAS unsigned* st; };
__device__ __forceinline__ XcdBarrier xcd_barrier_post(unsigned* bar, volatile LAS unsigned* st) {
    XcdBarrier b; b.bar = bar; b.x = xb_xcc_id(); b.st = st;
    if (threadIdx.x == 0) (void)xb_add(&bar[XB_XCNT(b.x)], 1u);
    return b;
}
__device__ __forceinline__ void xcd_barrier_complete(unsigned* bar, unsigned x, unsigned& nloc, unsigned& nx) {
    const unsigned G = gridDim.x * gridDim.y * gridDim.z;
    unsigned sum, cnt, mine, sp = 0u;
    for (;;) {
        sum = 0u; cnt = 0u; mine = 0u;
#pragma unroll
        for (unsigned j = 0; j < 16; ++j) { const unsigned c = xb_ld(&bar[XB_XCNT(j)]); sum += c; cnt += (c > 0u) ? 1u : 0u; mine = (j == x) ? c : mine; }
        if (sum == G) break;
        __builtin_amdgcn_s_sleep(1);
        if ((++sp & 255u) == 0u) { if (xb_ld(&bar[XB_TMO])) break; if (sp > XB_SPIN_CAP) { atomicAdd(&bar[XB_TMO], 1u); break; } }
    }
    nloc = mine > 0u ? mine : 1u; nx = cnt > 0u ? cnt : 1u;
}
__device__ __forceinline__ void xcd_barrier(const XcdBarrier& b) {
    asm volatile("s_waitcnt vmcnt(0)" ::: "memory");
    __syncthreads();
    if (threadIdx.x == 0) {
        unsigned* bar = b.bar;
        __builtin_amdgcn_s_waitcnt(0);
        unsigned nloc = b.st[0], nx = b.st[1];
        if (nloc == 0u) { xcd_barrier_complete(bar, b.x, nloc, nx); b.st[0] = nloc; b.st[1] = nx; }
        const unsigned old = xb_add(&bar[XB_XSUB(b.x)], 1u);
        const unsigned gen = old / nloc;
        if (old + 1u == (gen + 1u) * nloc) {
            __builtin_amdgcn_fence(__ATOMIC_RELEASE, "agent");
            asm volatile("s_waitcnt vmcnt(0)" ::: "memory");
            const unsigned og = xb_add(&bar[XB_TOP], 1u);
            const unsigned tg = og / nx;
            if (og + 1u == (tg + 1u) * nx) xb_add(&bar[XB_TOPGEN], 1u);
            else XB_SPIN(xb_ld(&bar[XB_TOPGEN]) == tg, bar);
            __builtin_amdgcn_fence(__ATOMIC_ACQUIRE, "agent");
            xb_add(&bar[XB_XGEN(b.x)], 1u);
            asm volatile("s_waitcnt vmcnt(0)" ::: "memory");
        } else {
            XB_SPIN(xb_ld(&bar[XB_XGEN(b.x)]) == gen, bar);
            __builtin_amdgcn_fence(__ATOMIC_ACQUIRE, "agent");
            asm volatile("s_waitcnt vmcnt(0)" ::: "memory");
        }
    }
    __syncthreads();
}

__global__ void __launch_bounds__(NTHREADS, 2) hymba_fwd(Params p) {
    extern __shared__ __attribute__((aligned(16))) unsigned char lds_raw[];
    cg::grid_group grid = cg::this_grid();
    LAS unsigned char* lds = (LAS unsigned char*)lds_raw;
    const int G = gridDim.x, tid = threadIdx.x;
    constexpr int STAGE = DBG_STAGE;
    volatile LAS unsigned* xst = (volatile LAS unsigned*)(lds + LDS_BYTES - 64);
    if (tid == 0) { xst[0] = 0u; xst[1] = 0u; }
    __syncthreads();
    const XcdBarrier xbar = xcd_barrier_post((unsigned*)(p.ws + WS_CTL + 40960), xst);
#define GRID_BAR() xcd_barrier(xbar)

    phase_mod(p, lds_raw, G);
    if (STAGE >= 2) phase_convert(p, lds_raw, G);
    grid.sync();
    if (STAGE >= 2) { phase_norm1(p, G); GRID_BAR(); }
    if (STAGE >= 2) {
        pg8::Gemm g{(const bf16_t*)(p.ws + WS_H), (const bf16_t*)(p.ws + WS_WIN_T), D};
        pg8::DenseSched S; S.o.init(T / 256, IC / 256, G, (int)blockIdx.x);
        EpiInProj E{(bf16_t*)(p.ws + WS_PROJ)};
        pg8::gemm_phase(lds, g, S, E);
        GRID_BAR();
    }
    if (STAGE >= 3) {
        for (int it = blockIdx.x; it < NB * 8 * 4; it += G) rwkv_prep(p, lds, it >> 5, (it >> 2) & 7, (it & 3) * 32, (it & 3) * 32 + 32);
        GRID_BAR();
    }
    if (STAGE >= 2) {
        if (STAGE >= 3) { for (int u = blockIdx.x; u < NB * 8 * 2; u += G) rwkv_scan(p, lds, u >> 4, (u >> 1) & 7, u & 1); }
        else {
            bf16_t* ymix = (bf16_t*)(p.ws + WS_YMIX);
            for (size_t i = (size_t)blockIdx.x * NTHREADS + tid; i < (size_t)T * 64; i += (size_t)G * NTHREADS) { const size_t row = i >> 6, c = i & 63; *(u32x4*)(ymix + row * D + c * 8) = (u32x4){0u, 0u, 0u, 0u}; }
        }
        float lam;
        { const float* q1 = p.in[I_LQ1]; const float* k1 = p.in[I_LK1]; const float* q2 = p.in[I_LQ2]; const float* k2 = p.in[I_LK2]; float s1 = 0.f, s2 = 0.f;
            for (int i = 0; i < 64; ++i) { s1 += q1[i] * k1[i]; s2 += q2[i] * k2[i]; } lam = expf(s1) - expf(s2) + LAMBDA_INIT; }
        unsigned* qhead = (unsigned*)(p.ws + WS_CTL);
        LAS unsigned* ubox = (LAS unsigned*)(lds + 4 * ATT_BUF);
        for (;;) {
            __syncthreads();
            if (tid == 0) ubox[0] = atomicAdd(qhead, 1u);
            __syncthreads();
            const unsigned u = (unsigned)__builtin_amdgcn_readfirstlane((int)ubox[0]);
            if (u >= (unsigned)ATT_UNITS) break;
            attn_unit(p, lds, (int)(u & 31u) >> 2, (int)(u & 3u), ATT_NQB - 1 - (int)(u >> 5), lam);
        }
        GRID_BAR();
        if (STAGE >= 3) { rwkv_finalize(p, G); GRID_BAR(); }
    }
    if (STAGE >= 2) {
        pg8::Gemm g{(const bf16_t*)(p.ws + WS_YMIX), (const bf16_t*)(p.ws + WS_WOUT_T), D};
        pg8::DenseSched S; S.o.init(T / 256, D / 256, G, (int)blockIdx.x);
        EpiOutProj E{p.in[I_X], (const float*)(p.ws + WS_MOD), p.out};
        pg8::gemm_phase(lds, g, S, E);
        GRID_BAR();
    }
    if (STAGE >= 9) {
        phase_router(p, lds, G);
        GRID_BAR();
        phase_assign(p, lds, G);
        GRID_BAR();
        const int* tile = (const int*)(p.ws + WS_TILE);
        const int MT = tile[0];
        {
            pg8::Gemm g{(const bf16_t*)(p.ws + WS_PROJ), (const bf16_t*)(p.ws + WS_WG_T), D};
            pg8::MoeSched S; S.o.init(MT, 8, G, (int)blockIdx.x); S.tile_e = tile + 16; S.N = 2048;
            EpiMoe1 E{p.in[I_BGU], (bf16_t*)(p.ws + WS_ACT)};
            pg8::gemm_phase(lds, g, S, E);
        }
        GRID_BAR();
        {
            pg8::Gemm g{(const bf16_t*)(p.ws + WS_ACT), (const bf16_t*)(p.ws + WS_WD_T), D};
            pg8::MoeSched S; S.o.init(MT, 4, G, (int)blockIdx.x); S.tile_e = tile + 16; S.N = 1024;
            EpiMoe2 E{p.in[I_BDN], (bf16_t*)(p.ws + WS_PROJ)};
            pg8::gemm_phase(lds, g, S, E);
        }
        GRID_BAR();
    }
    phase_final(p, G, STAGE >= 9 ? 9 : (STAGE >= 2 ? 4 : 0));
}

extern "C" void kernel_launch(void* const* d_in, const int* in_sizes, int n_in, void* d_out, int out_size, void* d_ws, size_t ws_size, hipStream_t stream) {
    static int grid = 0;
    if (grid == 0) {
        if (n_in != 31 || out_size != T * D || ws_size < WS_END) { fprintf(stderr, "kernel_launch: unexpected shapes (n_in %d out %d ws %zu)\n", n_in, out_size, ws_size); grid = -1; return; }
        int dev = 0, cus = 0, per_cu = 0;
        hipGetDevice(&dev);
        hipDeviceGetAttribute(&cus, hipDeviceAttributeMultiprocessorCount, dev);
        hipFuncSetAttribute((const void*)hymba_fwd, hipFuncAttributeMaxDynamicSharedMemorySize, LDS_BYTES);
        hipOccupancyMaxActiveBlocksPerMultiprocessor(&per_cu, (const void*)hymba_fwd, NTHREADS, LDS_BYTES);
        if (per_cu < 1) { fprintf(stderr, "kernel_launch: occupancy query returned %d\n", per_cu); grid = -1; return; }
        grid = cus;
        if (grid > 256) grid = 256;
        while (T % grid != 0) --grid;
        (void)hipGetLastError();
    }
    if (grid < 0) return;
    hipMemsetAsync((char*)d_ws + WS_CTL, 0, CTL_BYTES, stream);
    Params p{};
    for (int i = 0; i < 31; ++i) p.in[i] = (const float*)d_in[i];
    p.out = (float*)d_out; p.ws = (unsigned char*)d_ws;
    void* args[] = {&p};
    hipError_t e = hipLaunchCooperativeKernel((const void*)hymba_fwd, dim3(grid), dim3(NTHREADS), args, LDS_BYTES, stream);
    if (e != hipSuccess) fprintf(stderr, "cooperative launch failed: %s (grid %d)\n", hipGetErrorString(e), grid);
}
```

```cpp
#include <hip/hip_runtime.h>
#include <hip/hip_cooperative_groups.h>
#include <cstdio>
#include <cstdint>
namespace cg = cooperative_groups;

#ifndef DBG_STAGE
#define DBG_STAGE 99
#endif

#define LAS __attribute__((address_space(3)))
typedef unsigned short bf16_t;
typedef short bf16x8 __attribute__((ext_vector_type(8)));
typedef short s16x4 __attribute__((ext_vector_type(4)));
typedef float f32x4 __attribute__((ext_vector_type(4)));
typedef float f32x16 __attribute__((ext_vector_type(16)));
typedef float f32x2_t __attribute__((ext_vector_type(2)));
typedef __bf16 bf16x2_t __attribute__((ext_vector_type(2)));
typedef unsigned u32x4 __attribute__((ext_vector_type(4)));
typedef unsigned u32x2 __attribute__((ext_vector_type(2)));

constexpr int D = 1024, NB = 8, SEQ = 4096, T = NB * SEQ;
constexpr int RW = 512, RC = 1792, DC = 1536, IC = 3328;
constexpr int NE = 32, TOPK = 4, NA = T * TOPK;
constexpr int PMAX = NA + NE * 256;
constexpr float NORM_EPS = 1e-5f, GN_EPS = 64e-5f;
constexpr float LOG2E = 1.4426950408889634f;
constexpr float QSCALE = 0.125f * LOG2E;
constexpr float LAMBDA_INIT = 0.2f;
constexpr int NTHREADS = 512, NWAVES = 8;
constexpr int LDS_BYTES = 163840;

constexpr size_t MiB = 1u << 20;
constexpr size_t WS_CTL = 0;
constexpr size_t CTL_BYTES = 65536;
constexpr size_t WS_MOD = 1 * MiB;
constexpr size_t WS_TILE = 1 * MiB + 512 * 1024;
constexpr size_t WS_WIN_T = 2 * MiB;
constexpr size_t WS_WOUT_T = 9 * MiB;
constexpr size_t WS_ROUTE = 11 * MiB;
constexpr size_t WS_WG_T = 16 * MiB;
constexpr size_t WS_WD_T = 144 * MiB;
constexpr size_t WS_H = 208 * MiB;
constexpr size_t WS_YMIX = 272 * MiB;
constexpr size_t WS_PROJ = 336 * MiB;
constexpr size_t WS_ACT = 608 * MiB;
constexpr size_t WS_END = 1008 * MiB;
constexpr size_t WS_RS = WS_ACT, WS_KMS = WS_ACT + 64 * MiB, WS_DECS = WS_ACT + 128 * MiB, WS_KKS = WS_ACT + 192 * MiB, WS_BBS = 880 * MiB, WS_VS = 944 * MiB;
constexpr size_t WS_BON = WS_H;

__device__ __forceinline__ unsigned cvtpk(float lo, float hi) { f32x2_t v = {lo, hi}; bf16x2_t b = __builtin_convertvector(v, bf16x2_t); return __builtin_bit_cast(unsigned, b); }
__device__ __forceinline__ float bf2f(unsigned short u) { return __uint_as_float(((unsigned)u) << 16); }
__device__ __forceinline__ float wave_sum(float v) {
#pragma unroll
    for (int o = 1; o < 64; o <<= 1) v += __shfl_xor(v, o);
    return v;
}
__device__ __forceinline__ float wave_max(float v) {
#pragma unroll
    for (int o = 1; o < 64; o <<= 1) v = fmaxf(v, __shfl_xor(v, o));
    return v;
}
__device__ __forceinline__ int opaque_tid() { int t = (int)threadIdx.x; asm volatile("" : "+v"(t)); return t; }
__device__ __forceinline__ float sigmoidf_(float x) { return __builtin_amdgcn_rcpf(1.0f + __expf(-x)); }
__device__ __forceinline__ float tanh_fast(float x) { return 1.0f - 2.0f * __builtin_amdgcn_rcpf(1.0f + __expf(2.0f * x)); }

struct Params {
    const float* in[31];
    float* out;
    unsigned char* ws;
};
enum { I_X = 0, I_C, I_MODW, I_MODB, I_N1G, I_WIN, I_MU, I_W0, I_WUP, I_A0, I_AUP, I_GUP, I_KK, I_KA, I_RK, I_GNG, I_GNB, I_LQ1, I_LK1, I_LQ2, I_LK2, I_SUBLN, I_WOUT, I_N2G, I_RTW, I_RTB, I_WGU, I_BGU, I_WDN, I_BDN, I_FG };

namespace pg8 {
constexpr int BM = 256, BK = 64, HALF = 128, HTB = HALF * BK * 2, STAGE_BYTES = 8 * HTB, NXCD = 8, WGM = 8;
__host__ __device__ __forceinline__ int lds_byte(int r, int c) { const int st = (r >> 4) * 2 + (c >> 5), rr = r & 15, cc = c & 31, ob = rr * 64 + cc * 2; return st * 1024 + (ob ^ (((ob >> 9) & 1) << 5)); }
__host__ __device__ __forceinline__ void stage_rc(int b, int& R, int& C) { const int st = b / 1024, sb = b % 1024, swz = sb ^ (((sb >> 9) & 1) << 5); R = (st >> 1) * 16 + swz / 64; C = (st & 1) * 32 + (swz % 64) / 2; }
__host__ __device__ __forceinline__ int perm32(int rho) { const int n = rho >> 4, i = rho & 15; return 8 * (i >> 2) + 4 * n + (i & 3); }

struct Unit { int pm, pn, arow, brow, e; };
struct Gemm { const bf16_t* A; const bf16_t* Bt; int K; };

struct TileOrder {
    int nM, nN, nwg, G, c;
    __device__ void init(int nM_, int nN_, int G_, int c_) { nM = nM_; nN = nN_; nwg = nM * nN; G = G_; c = c_; }
    __device__ bool map(int i, int& pm, int& pn) const {
        const long L = (long)i * G + c; if (L >= nwg) return false;
        int wgid = (int)L; { const int q = nwg / NXCD, r = nwg % NXCD, xcd = wgid % NXCD, off = wgid / NXCD; wgid = (xcd < r ? xcd * (q + 1) : r * (q + 1) + (xcd - r) * q) + off; }
        const int nig = WGM * nN, gid = wgid / nig, fm = gid * WGM, gsz = (nM - fm) < WGM ? (nM - fm) : WGM;
        pm = fm + ((wgid % nig) % gsz); pn = (wgid % nig) / gsz; return true;
    }
};
struct DenseSched {
    TileOrder o;
    __device__ bool next(int i, Unit& u) const { int pm, pn; if (!o.map(i, pm, pn)) return false; u.pm = pm; u.pn = pn; u.arow = pm * BM; u.brow = pn * BM; u.e = 0; return true; }
};
struct MoeSched {
    TileOrder o; const int* tile_e; int N;
    __device__ bool next(int i, Unit& u) const { int pm, pn; if (!o.map(i, pm, pn)) return false; const int e = tile_e[pm]; u.pm = pm; u.pn = pn; u.arow = pm * BM; u.brow = e * N + pn * BM; u.e = e; return true; }
};

template <class Epi, class Sched>
__device__ __forceinline__ void gemm_phase(LAS unsigned char* lds, const Gemm g, const Sched& S, const Epi& E) {
    const int tid = opaque_tid(), wid = __builtin_amdgcn_readfirstlane(tid >> 6), lane = tid & 63, wr = wid >> 2, wc = wid & 3, fr = lane & 15, fq = lane >> 4;
    const int K = g.K, nt = K / BK;
    unsigned voffA[2], voffB[2];
#pragma unroll
    for (int i = 0; i < 2; ++i) { int R, C; stage_rc(tid * 16 + i * 8192, R, C); const int Rb = (R & ~31) + perm32(R & 31);
        voffA[i] = (unsigned)(R * K + C) * 2u; voffB[i] = (unsigned)(Rb * K + C) * 2u; }
    const size_t kstep = (size_t)(BK * 2);
    const size_t hstep = (size_t)HALF * K * 2;
    const size_t rowb = (size_t)K * 2;
    const unsigned ldsw = (unsigned)wid * 1024u;
    const int aoff = lds_byte(wr * 64 + fr, fq * 8), boff = lds_byte(wc * 32 + fr, fq * 8);
#define PG8_SA(b, h) (((b) * 2 + (h)) * HTB)
#define PG8_SB(b, h) ((4 + (b) * 2 + (h)) * HTB)
#define PG8_STAGE(bufoff, gbase, voff) do { _Pragma("unroll") for (int _i = 0; _i < 2; ++_i) \
        __builtin_amdgcn_global_load_lds((const unsigned*)((const char*)(gbase) + (voff)[_i]), (LAS unsigned*)(lds + (bufoff) + ldsw + _i * 8192), 16, 0, 0); } while (0)
#define PG8_LDA(dst, b, h) do { _Pragma("unroll") for (int m = 0; m < 4; ++m) _Pragma("unroll") for (int k = 0; k < 2; ++k) dst[m][k] = *(const LAS bf16x8*)(lds + PG8_SA(b, h) + aoff + m * 2048 + k * 1024); } while (0)
#define PG8_LDB(dst, b, h) do { _Pragma("unroll") for (int n = 0; n < 2; ++n) _Pragma("unroll") for (int k = 0; k < 2; ++k) dst[n][k] = *(const LAS bf16x8*)(lds + PG8_SB(b, h) + boff + n * 2048 + k * 1024); } while (0)
#define PG8_MMA(ai, bj, At, Bt) do { __builtin_amdgcn_s_setprio(1); _Pragma("unroll") for (int m = 0; m < 4; ++m) _Pragma("unroll") for (int n = 0; n < 2; ++n) _Pragma("unroll") for (int k = 0; k < 2; ++k) \
        acc[ai][bj][m][n] = __builtin_amdgcn_mfma_f32_16x16x32_bf16(Bt[n][k], At[m][k], acc[ai][bj][m][n], 0, 0, 0); __builtin_amdgcn_s_setprio(0); } while (0)
#define PG8_WAIT_V(n) asm volatile("s_waitcnt vmcnt(" #n ")" ::: "memory")
#define PG8_WAIT_L(n) asm volatile("s_waitcnt lgkmcnt(" #n ")" ::: "memory")
#define PG8_BAR __builtin_amdgcn_s_barrier()
#define PG8_SCHED __builtin_amdgcn_sched_barrier(0)
    Unit cur, nxt; int ui = 0;
    if (!S.next(0, cur)) return;
    f32x4 acc[2][2][4][2];
#pragma unroll
    for (int a = 0; a < 2; ++a)
#pragma unroll
        for (int b = 0; b < 2; ++b)
#pragma unroll
            for (int m = 0; m < 4; ++m)
#pragma unroll
                for (int n = 0; n < 2; ++n) acc[a][b][m][n] = (f32x4){0.f, 0.f, 0.f, 0.f};
    bf16x8 At[4][2], B0[2][2], B1[2][2];
    const char* cA = (const char*)g.A + (size_t)cur.arow * rowb; const char* cB = (const char*)g.Bt + (size_t)cur.brow * rowb;
    PG8_STAGE(PG8_SB(0, 0), cB, voffB); PG8_STAGE(PG8_SB(0, 1), cB + hstep, voffB); PG8_STAGE(PG8_SA(0, 0), cA, voffA); PG8_STAGE(PG8_SA(0, 1), cA + hstep, voffA);
    if (wr == 1) PG8_BAR;
    PG8_WAIT_V(2); PG8_BAR;
    PG8_STAGE(PG8_SB(1, 0), cB + kstep, voffB); PG8_STAGE(PG8_SA(1, 0), cA + kstep, voffA); PG8_STAGE(PG8_SB(1, 1), cB + hstep + kstep, voffB);
    PG8_WAIT_V(6); PG8_BAR;
    for (;;) {
        const bool has_next = S.next(ui + 1, nxt);
        const char* nA = has_next ? (const char*)g.A + (size_t)nxt.arow * rowb : cA; const char* nB = has_next ? (const char*)g.Bt + (size_t)nxt.brow * rowb : cB;
        for (int t = 0; t < nt; t += 2) {
            const bool last = (t == nt - 2);
            const char* a1 = cA + (size_t)(t + 1) * kstep;
            const char* a2 = last ? nA : cA + (size_t)(t + 2) * kstep; const char* b2 = last ? nB : cB + (size_t)(t + 2) * kstep;
            const char* a3 = a2 + kstep; const char* b3 = b2 + kstep;
            PG8_LDB(B0, 0, 0); PG8_LDB(B1, 0, 1); PG8_SCHED; PG8_LDA(At, 0, 0); PG8_STAGE(PG8_SA(1, 1), a1 + hstep, voffA);
            PG8_WAIT_V(8); PG8_WAIT_L(0); PG8_BAR; PG8_MMA(0, 0, At, B0); PG8_MMA(0, 1, At, B1); PG8_BAR; PG8_SCHED;
            PG8_LDA(At, 0, 1); PG8_STAGE(PG8_SB(0, 0), b2, voffB); PG8_STAGE(PG8_SB(0, 1), b2 + hstep, voffB); PG8_STAGE(PG8_SA(0, 0), a2, voffA);
            PG8_WAIT_V(8); PG8_WAIT_L(0); PG8_BAR; PG8_MMA(1, 0, At, B0); PG8_MMA(1, 1, At, B1); PG8_BAR; PG8_SCHED;
            PG8_LDB(B0, 1, 0); PG8_LDB(B1, 1, 1); PG8_SCHED; PG8_LDA(At, 1, 0); PG8_STAGE(PG8_SA(0, 1), a2 + hstep, voffA);
            PG8_WAIT_V(8); PG8_WAIT_L(0); PG8_BAR; PG8_MMA(0, 0, At, B0); PG8_MMA(0, 1, At, B1); PG8_BAR; PG8_SCHED;
            PG8_LDA(At, 1, 1); PG8_STAGE(PG8_SB(1, 0), b3, voffB); PG8_STAGE(PG8_SB(1, 1), b3 + hstep, voffB); PG8_STAGE(PG8_SA(1, 0), a3, voffA);
            PG8_WAIT_V(8); PG8_WAIT_L(0); PG8_BAR; PG8_MMA(1, 0, At, B0); PG8_MMA(1, 1, At, B1); PG8_BAR; PG8_SCHED;
        }
        if (wr == 0) PG8_BAR;
        E(acc, cur, wr, wc, fr, fq);
        if (!has_next) break;
#pragma unroll
        for (int a = 0; a < 2; ++a)
#pragma unroll
            for (int b = 0; b < 2; ++b)
#pragma unroll
                for (int m = 0; m < 4; ++m)
#pragma unroll
                    for (int n = 0; n < 2; ++n) acc[a][b][m][n] = (f32x4){0.f, 0.f, 0.f, 0.f};
        cur = nxt; cA = nA; cB = nB; ++ui;
        if (wr == 1) PG8_BAR;
    }
    PG8_WAIT_V(0);
    PG8_BAR;
#undef PG8_SA
#undef PG8_SB
#undef PG8_STAGE
#undef PG8_LDA
#undef PG8_LDB
#undef PG8_MMA
#undef PG8_WAIT_V
#undef PG8_WAIT_L
#undef PG8_BAR
#undef PG8_SCHED
}
}

struct EpiInProj {
    bf16_t* O;
    __device__ __forceinline__ void operator()(const f32x4 (&acc)[2][2][4][2], const pg8::Unit& u, int wr, int wc, int fr, int fq) const {
        const int row0 = u.pm * 256 + wr * 64 + fr, col0 = u.pn * 256 + wc * 32 + 8 * fq;
        const float sc = (u.pn == 7 || u.pn == 8) ? QSCALE : 1.0f;
#pragma unroll
        for (int ai = 0; ai < 2; ++ai)
#pragma unroll
            for (int m = 0; m < 4; ++m) { bf16_t* rowp = O + (size_t)(row0 + ai * 128 + m * 16) * IC + col0;
#pragma unroll
                for (int bj = 0; bj < 2; ++bj) { const f32x4 v0 = acc[ai][bj][m][0] * sc, v1 = acc[ai][bj][m][1] * sc;
                    u32x4 w; w.x = cvtpk(v0[0], v0[1]); w.y = cvtpk(v0[2], v0[3]); w.z = cvtpk(v1[0], v1[1]); w.w = cvtpk(v1[2], v1[3]);
                    *(u32x4*)(rowp + bj * 128) = w; } }
    }
};
struct EpiOutProj {
    const float* x; const float* mod; float* O;
    __device__ __forceinline__ void operator()(const f32x4 (&acc)[2][2][4][2], const pg8::Unit& u, int wr, int wc, int fr, int fq) const {
        const int row0 = u.pm * 256 + wr * 64 + fr, col0 = u.pn * 256 + wc * 32 + 8 * fq;
        const int b = (u.pm * 256) / SEQ;
        const float* g1 = mod + b * 6144 + 2048;
        f32x4 gv[2][2];
#pragma unroll
        for (int bj = 0; bj < 2; ++bj)
#pragma unroll
            for (int n = 0; n < 2; ++n) gv[bj][n] = *(const f32x4*)(g1 + col0 + bj * 128 + 4 * n);
#pragma unroll
        for (int ai = 0; ai < 2; ++ai)
#pragma unroll
            for (int m = 0; m < 4; ++m) { const size_t off = (size_t)(row0 + ai * 128 + m * 16) * D + col0;
#pragma unroll
                for (int bj = 0; bj < 2; ++bj)
#pragma unroll
                    for (int n = 0; n < 2; ++n) { const f32x4 xv = *(const f32x4*)(x + off + bj * 128 + 4 * n);
                        *(f32x4*)(O + off + bj * 128 + 4 * n) = xv + gv[bj][n] * acc[ai][bj][m][n]; } }
    }
};
struct EpiMoe1 {
    const float* bgu; bf16_t* O;
    __device__ __forceinline__ void operator()(const f32x4 (&acc)[2][2][4][2], const pg8::Unit& u, int wr, int wc, int fr, int fq) const {
        const int row0 = u.pm * 256 + wr * 64 + fr, col0 = u.pn * 128 + wc * 32 + 8 * fq;
        const float* bg = bgu + (size_t)u.e * 2048 + col0;
        f32x4 bgv[2], buv[2];
#pragma unroll
        for (int n = 0; n < 2; ++n) { bgv[n] = *(const f32x4*)(bg + 4 * n); buv[n] = *(const f32x4*)(bg + 1024 + 4 * n); }
#pragma unroll
        for (int ai = 0; ai < 2; ++ai)
#pragma unroll
            for (int m = 0; m < 4; ++m) { float a[8];
#pragma unroll
                for (int n = 0; n < 2; ++n) { const f32x4 gt = acc[ai][0][m][n] + bgv[n], up = acc[ai][1][m][n] + buv[n];
#pragma unroll
                    for (int j = 0; j < 4; ++j) { const float gg = fminf(gt[j], 7.0f), uu = fminf(fmaxf(up[j], -7.0f), 7.0f);
                        a[4 * n + j] = (uu + 1.0f) * (gg * __builtin_amdgcn_rcpf(1.0f + __builtin_amdgcn_exp2f(-1.702f * LOG2E * gg))); } }
                u32x4 w; w.x = cvtpk(a[0], a[1]); w.y = cvtpk(a[2], a[3]); w.z = cvtpk(a[4], a[5]); w.w = cvtpk(a[6], a[7]);
                *(u32x4*)(O + (size_t)(row0 + ai * 128 + m * 16) * 1024 + col0) = w; }
    }
};
struct EpiMoe2 {
    const float* bdn; bf16_t* O;
    __device__ __forceinline__ void operator()(const f32x4 (&acc)[2][2][4][2], const pg8::Unit& u, int wr, int wc, int fr, int fq) const {
        const int row0 = u.pm * 256 + wr * 64 + fr, col0 = u.pn * 256 + wc * 32 + 8 * fq;
        const float* bd = bdn + (size_t)u.e * 1024 + col0;
        f32x4 bv[2][2];
#pragma unroll
        for (int bj = 0; bj < 2; ++bj)
#pragma unroll
            for (int n = 0; n < 2; ++n) bv[bj][n] = *(const f32x4*)(bd + bj * 128 + 4 * n);
#pragma unroll
        for (int ai = 0; ai < 2; ++ai)
#pragma unroll
            for (int m = 0; m < 4; ++m) { bf16_t* rowp = O + (size_t)(row0 + ai * 128 + m * 16) * 1024 + col0;
#pragma unroll
                for (int bj = 0; bj < 2; ++bj) { const f32x4 v0 = acc[ai][bj][m][0] + bv[bj][0], v1 = acc[ai][bj][m][1] + bv[bj][1];
                    u32x4 w; w.x = cvtpk(v0[0], v0[1]); w.y = cvtpk(v0[2], v0[3]); w.z = cvtpk(v1[0], v1[1]); w.w = cvtpk(v1[2], v1[3]);
                    *(u32x4*)(rowp + bj * 128) = w; } }
    }
};

__device__ __forceinline__ void phase_mod(const Params& p, unsigned char* lds, int G) {
    const int tid = opaque_tid(), lane = tid & 63, wave = tid >> 6;
    float* sc = (float*)lds;
    const float* c = p.in[I_C];
    for (int i = tid; i < 8192; i += NTHREADS) { const int b = i & 7, k = i >> 3; const float cv = c[b * 1024 + k]; sc[k * 8 + b] = cv / (1.0f + __expf(-cv)); }
    __syncthreads();
    float* mod = (float*)(p.ws + WS_MOD);
    const float* mw = p.in[I_MODW]; const float* mb = p.in[I_MODB];
    for (int item = wave * G + (int)blockIdx.x; item < 192; item += NWAVES * G) {
        const int col = item * 32 + (lane & 31), kh = lane >> 5;
        float acc[8];
#pragma unroll
        for (int b = 0; b < 8; ++b) acc[b] = 0.f;
        const float* wp = mw + (size_t)(kh * 512) * 6144 + col;
        const float* sp = sc + (kh * 512) * 8;
#pragma unroll 8
        for (int k = 0; k < 512; ++k) { const float wv = wp[(size_t)k * 6144]; const f32x4 s0 = *(const f32x4*)(sp + k * 8), s1 = *(const f32x4*)(sp + k * 8 + 4);
            acc[0] += s0[0] * wv; acc[1] += s0[1] * wv; acc[2] += s0[2] * wv; acc[3] += s0[3] * wv; acc[4] += s1[0] * wv; acc[5] += s1[1] * wv; acc[6] += s1[2] * wv; acc[7] += s1[3] * wv; }
#pragma unroll
        for (int b = 0; b < 8; ++b) acc[b] += __shfl_xor(acc[b], 32);
        if (lane < 32) {
            const float bias = mb[col];
#pragma unroll
            for (int b = 0; b < 8; ++b) mod[b * 6144 + col] = acc[b] + bias;
        }
    }
    __syncthreads();
}
__device__ __forceinline__ void transpose_item(const float* W, int N, int k0, int n0, bf16_t* WT, int Kdst, int dst_row_base, bool gu_interleave, float* scr, int lane) {
#pragma unroll 4
    for (int i = 0; i < 16; ++i) { const int row = 4 * i + (lane >> 4), c4 = lane & 15;
        const f32x4 v = *(const f32x4*)(W + (size_t)(k0 + row) * N + n0 + 4 * c4);
        float* s = scr + row * 65 + 4 * c4; s[0] = v[0]; s[1] = v[1]; s[2] = v[2]; s[3] = v[3]; }
    asm volatile("s_waitcnt lgkmcnt(0)" ::: "memory");
    const int cch = lane & 7;
#pragma unroll
    for (int i = 0; i < 8; ++i) { const int n = 8 * i + (lane >> 3); const float* s = scr + (8 * cch) * 65 + n;
        u32x4 o; o.x = cvtpk(s[0], s[65]); o.y = cvtpk(s[2 * 65], s[3 * 65]); o.z = cvtpk(s[4 * 65], s[5 * 65]); o.w = cvtpk(s[6 * 65], s[7 * 65]);
        int nn = n0 + n;
        if (gu_interleave) nn = (nn < 1024) ? ((nn >> 7) * 256 + (nn & 127)) : (((nn - 1024) >> 7) * 256 + 128 + ((nn - 1024) & 127));
        *(u32x4*)(WT + (size_t)(dst_row_base + nn) * Kdst + k0 + 8 * cch) = o; }
    asm volatile("s_waitcnt lgkmcnt(0)" ::: "memory");
}
__device__ __forceinline__ void phase_convert(const Params& p, unsigned char* lds, int G) {
    const int tid = opaque_tid(), lane = tid & 63, wave = tid >> 6;
    float* scr = (float*)lds + wave * (64 * 65);
    const int gw = (int)blockIdx.x * NWAVES + wave, NGW = G * NWAVES;
    constexpr int I_IN = 16 * 52, I_OUT = 16 * 16, I_GU = 32 * 16 * 32, I_DN = 32 * 16 * 16, NITEMS = I_IN + I_OUT + I_GU + I_DN;
    bf16_t* win_t = (bf16_t*)(p.ws + WS_WIN_T); bf16_t* wout_t = (bf16_t*)(p.ws + WS_WOUT_T); bf16_t* wg_t = (bf16_t*)(p.ws + WS_WG_T); bf16_t* wd_t = (bf16_t*)(p.ws + WS_WD_T);
    for (int it = gw; it < NITEMS; it += NGW) {
        int r = it;
        if (r < I_IN) { transpose_item(p.in[I_WIN], IC, (r / 52) * 64, (r % 52) * 64, win_t, 1024, 0, false, scr, lane); continue; } r -= I_IN;
        if (r < I_OUT) { transpose_item(p.in[I_WOUT], D, (r / 16) * 64, (r % 16) * 64, wout_t, 1024, 0, false, scr, lane); continue; } r -= I_OUT;
        if (r < I_GU) { const int e = r / 512, rr = r % 512; transpose_item(p.in[I_WGU] + (size_t)e * 1024 * 2048, 2048, (rr / 32) * 64, (rr % 32) * 64, wg_t, 1024, e * 2048, true, scr, lane); continue; } r -= I_GU;
        { const int e = r / 256, rr = r % 256; transpose_item(p.in[I_WDN] + (size_t)e * 1024 * 1024, 1024, (rr / 16) * 64, (rr % 16) * 64, wd_t, 1024, e * 1024, false, scr, lane); }
    }
}

__device__ __forceinline__ void phase_norm1(const Params& p, int G) {
    const int tid = opaque_tid(), lane = tid & 63, wave = tid >> 6;
    const int gw = (int)blockIdx.x * NWAVES + wave, NGW = G * NWAVES;
    const float* x = p.in[I_X]; const float* gain = p.in[I_N1G]; const float* mod = (const float*)(p.ws + WS_MOD);
    bf16_t* h = (bf16_t*)(p.ws + WS_H);
    for (int row = gw; row < T; row += NGW) {
        const int b = row / SEQ;
        const f32x4* xr = (const f32x4*)(x + (size_t)row * D) + lane;
        f32x4 v[4]; float s = 0.f;
#pragma unroll
        for (int j = 0; j < 4; ++j) { v[j] = xr[64 * j]; s += (v[j][0] * v[j][0] + v[j][1] * v[j][1]) + (v[j][2] * v[j][2] + v[j][3] * v[j][3]); }
        const float rstd = rsqrtf(wave_sum(s) * (1.0f / D) + NORM_EPS);
        const float* sh = mod + b * 6144; const float* scl = mod + b * 6144 + 1024;
        unsigned long long* o8 = (unsigned long long*)(h + (size_t)row * D) + lane;
#pragma unroll
        for (int j = 0; j < 4; ++j) { const int k = 4 * lane + 256 * j;
            const f32x4 g = *(const f32x4*)(gain + k), s1 = *(const f32x4*)(scl + k), s0 = *(const f32x4*)(sh + k);
            const f32x4 y = (v[j] * rstd) * g * (s1 + 1.0f) + s0;
            o8[64 * j] = (unsigned long long)cvtpk(y[0], y[1]) | ((unsigned long long)cvtpk(y[2], y[3]) << 32); }
    }
}

__device__ __forceinline__ s16x4 vtr(const LAS unsigned char* pp) { typedef short v4i16_t __attribute__((ext_vector_type(4))); return __builtin_bit_cast(s16x4, __builtin_amdgcn_ds_read_tr16_b64_v4i16((LAS v4i16_t*)pp)); }
constexpr int ATT_BUF = 32768;
__device__ __forceinline__ float att_max3(float a, float b, float c) { float r; asm("v_max3_f32 %0, %1, %2, %3" : "=v"(r) : "v"(a), "v"(b), "v"(c)); return r; }
constexpr int ATT_QROWS = 128, ATT_NQB = SEQ / ATT_QROWS, ATT_UNITS = NB * 4 * ATT_NQB;
__device__ __forceinline__ void attn_unit(const Params& p, LAS unsigned char* lds, int b, int h, int qb, float lam) {
    const int tid = opaque_tid(), lane = tid & 63, wid = __builtin_amdgcn_readfirstlane(tid >> 6), r32 = lane & 31, hi = lane >> 5;
    const int c = wid & 1, qblk = wid >> 1;
    const bf16_t* proj = (const bf16_t*)(p.ws + WS_PROJ) + (size_t)b * SEQ * IC;
    const int q0 = qb * ATT_QROWS, qw0 = q0 + 32 * qblk;
    const bf16_t* Qb = proj + RC + h * 128 + c * 64;
    const bf16_t* Kb = proj + RC + 512 + h * 128;
    const bf16_t* Vb = proj + RC + 1024 + h * 128;
    const float slope = exp2f(-2.0f * (float)(h + 1)) * LOG2E;
    f32x16 o[4];
#pragma unroll
    for (int d = 0; d < 4; ++d) o[d] = f32x16{};
    f32x16 cb0;
#pragma unroll
    for (int r = 0; r < 16; ++r) cb0[r] = slope * (float)((r & 3) + 8 * (r >> 2) + 4 * hi);
    const float c32 = slope * 32.0f;
    float m_ = 0.f, l_ = 0.f;
    const int NT = (q0 + ATT_QROWS) / 64;
    const bf16_t* ksrc = Kb + (size_t)lane * IC + wid * 8;
    const int p0i = wid, p1i = wid + 8;
    const bf16_t* vsrc0 = Vb + (size_t)(16 * (p0i & 3) + (lane >> 2)) * IC + (p0i >> 2) * 32 + (lane & 3) * 8;
    const bf16_t* vsrc1 = Vb + (size_t)(16 * (p1i & 3) + (lane >> 2)) * IC + (p1i >> 2) * 32 + (lane & 3) * 8;
#define ATT_GLDS(gsrc_, ldsdst_) do { unsigned keep_; asm volatile("s_mov_b32 %0, m0\n\ts_mov_b32 m0, %2\n\ts_nop 0\n\tglobal_load_lds_dwordx4 %1, off\n\ts_mov_b32 m0, %0" : "=&s"(keep_) : "v"(gsrc_), "s"(ldsdst_) : "memory"); } while (0)
    const unsigned lds0 = (unsigned)(uintptr_t)lds;
#define ATT_DMA(t, buf) do { const size_t ro = (size_t)(t) * 64 * IC; const unsigned bb_ = (unsigned)__builtin_amdgcn_readfirstlane((int)(lds0 + (buf) * ATT_BUF + wid * 1024)); \
        ATT_GLDS(ksrc + ro, bb_); ATT_GLDS(ksrc + ro + 64, bb_ + 8192u); ATT_GLDS(vsrc0 + ro, bb_ + 16384u); ATT_GLDS(vsrc1 + ro, bb_ + 16384u + 8192u); } while (0)
    ATT_DMA(0, 0); ATT_DMA(1, 1);
    LAS unsigned char* qlds = lds + 3 * ATT_BUF + wid * 4096;
    {
        bf16x8 qr[4];
#pragma unroll
        for (int d0 = 0; d0 < 4; ++d0) qr[d0] = *(const bf16x8*)(Qb + (size_t)(qw0 + r32) * IC + d0 * 16 + hi * 8);
#pragma unroll
        for (int d0 = 0; d0 < 4; ++d0) *(LAS bf16x8*)(qlds + (d0 * 64 + lane) * 16) = qr[d0];
    }
    asm volatile("s_waitcnt vmcnt(0) lgkmcnt(0)" ::: "memory");
    __builtin_amdgcn_s_barrier();
    const int voff = ((lane >> 4) & 1) * 32 + (lane & 3) * 8 + (4 * hi + ((lane & 15) >> 2)) * 64;
    const int qpos = qw0 + r32;
    int cur = 0, nxt2 = 2;
    for (int kt = 0; kt < NT; ++kt) {
        if (kt + 2 < NT) ATT_DMA(kt + 2, nxt2);
        const int k0 = kt * 64;
        if (k0 <= qw0 + 31) {
            const LAS unsigned char* bb = lds + cur * ATT_BUF;
            const bool need_mask = (k0 + 63 > qw0);
            const LAS unsigned char* kb = bb + c * 8192 + hi * 1024 + r32 * 16;
            f32x16 s0 = cb0, s1 = cb0;
#pragma unroll
            for (int d0 = 0; d0 < 4; ++d0) {
                const bf16x8 a0 = *(const LAS bf16x8*)(kb + d0 * 2048), a1 = *(const LAS bf16x8*)(kb + d0 * 2048 + 512);
                const bf16x8 qf = *(const LAS bf16x8*)(qlds + (d0 * 64 + lane) * 16);
                s0 = __builtin_amdgcn_mfma_f32_32x32x16_bf16(a0, qf, s0, 0, 0, 0);
                s1 = __builtin_amdgcn_mfma_f32_32x32x16_bf16(a1, qf, s1, 0, 0, 0);
            }
            if (need_mask) {
                const int dq = k0 - qpos + 4 * hi;
#pragma unroll
                for (int r = 0; r < 16; ++r) { if (dq + ((r & 3) + 8 * (r >> 2)) > 0) s0[r] = -INFINITY; if (dq + ((r & 3) + 8 * (r >> 2)) + 32 > 0) s1[r] = -INFINITY; }
            }
            const float tb = slope * (float)(k0 - qpos);
            float rm0 = att_max3(s0[0], s0[1], s0[2]), rm1 = att_max3(s1[0], s1[1], s1[2]);
#pragma unroll
            for (int r = 3; r < 15; r += 2) { rm0 = att_max3(rm0, s0[r], s0[r + 1]); rm1 = att_max3(rm1, s1[r], s1[r + 1]); }
            float rm = att_max3(rm0, s0[15], att_max3(rm1, s1[15], -INFINITY) + c32);
            rm += tb;
            rm = fmaxf(rm, __shfl_xor(rm, 32));
            if (__any(rm > m_ + 8.0f)) {
                const float mn = fmaxf(m_, rm);
                const float alpha = __builtin_amdgcn_exp2f(m_ - mn);
                m_ = mn; l_ *= alpha;
#pragma unroll
                for (int d = 0; d < 4; ++d)
#pragma unroll
                    for (int r = 0; r < 16; ++r) o[d][r] *= alpha;
            }
            const float off = tb - m_, off1 = off + c32;
            float ps = 0.f;
#pragma unroll
            for (int r = 0; r < 16; ++r) { s0[r] = __builtin_amdgcn_exp2f(s0[r] + off); s1[r] = __builtin_amdgcn_exp2f(s1[r] + off1); ps += s0[r] + s1[r]; }
            l_ += ps;
            bf16x8 pf[4];
#pragma unroll
            for (int ks = 0; ks < 2; ++ks) {
                u32x4 w0, w1;
                w0.x = cvtpk(s0[8 * ks + 0], s0[8 * ks + 1]); w0.y = cvtpk(s0[8 * ks + 2], s0[8 * ks + 3]); w0.z = cvtpk(s0[8 * ks + 4], s0[8 * ks + 5]); w0.w = cvtpk(s0[8 * ks + 6], s0[8 * ks + 7]);
                w1.x = cvtpk(s1[8 * ks + 0], s1[8 * ks + 1]); w1.y = cvtpk(s1[8 * ks + 2], s1[8 * ks + 3]); w1.z = cvtpk(s1[8 * ks + 4], s1[8 * ks + 5]); w1.w = cvtpk(s1[8 * ks + 6], s1[8 * ks + 7]);
                pf[ks] = __builtin_bit_cast(bf16x8, w0); pf[2 + ks] = __builtin_bit_cast(bf16x8, w1);
            }
            const LAS unsigned char* vb = bb + 16384 + voff;
#pragma unroll
            for (int dblk = 0; dblk < 4; ++dblk) {
#pragma unroll
                for (int ks = 0; ks < 4; ++ks) {
                    const s16x4 lo = vtr(vb + (dblk * 4 + ks) * 1024), hh = vtr(vb + (dblk * 4 + ks) * 1024 + 512);
                    const bf16x8 vf = (bf16x8){lo[0], lo[1], lo[2], lo[3], hh[0], hh[1], hh[2], hh[3]};
                    o[dblk] = __builtin_amdgcn_mfma_f32_32x32x16_bf16(vf, pf[ks], o[dblk], 0, 0, 0);
                }
            }
        }
        if (kt + 2 < NT) asm volatile("s_waitcnt vmcnt(4)" ::: "memory"); else asm volatile("s_waitcnt vmcnt(0)" ::: "memory");
        cur = (cur == 2) ? 0 : cur + 1; nxt2 = (nxt2 == 2) ? 0 : nxt2 + 1;
        asm volatile("s_waitcnt lgkmcnt(0)" ::: "memory");
        __builtin_amdgcn_s_barrier();
    }
#undef ATT_DMA
#undef ATT_GLDS
    l_ += __shfl_xor(l_, 32);
    LAS float* xb = (LAS float*)(lds + qblk * 16384);
    if (c == 1) {
        const float i1 = lam / l_;
#pragma unroll
        for (int d = 0; d < 4; ++d)
#pragma unroll
            for (int r = 0; r < 16; ++r) xb[(d * 16 + r) * 64 + lane] = o[d][r] * i1;
    }
    __syncthreads();
    if (c == 0) {
        const float i0 = 1.0f / l_;
        float ss = 0.f;
#pragma unroll
        for (int d = 0; d < 4; ++d)
#pragma unroll
            for (int r = 0; r < 16; ++r) { const float v = o[d][r] * i0 - xb[(d * 16 + r) * 64 + lane]; o[d][r] = v; ss += v * v; }
        ss += __shfl_xor(ss, 32);
        const float rstd = rsqrtf(ss * (1.0f / 128.0f) + NORM_EPS) * (1.0f - LAMBDA_INIT);
        const float* sg = p.in[I_SUBLN];
        bf16_t* yo = (bf16_t*)(p.ws + WS_YMIX) + (size_t)(b * SEQ + qw0 + r32) * D + RW + h * 128;
#pragma unroll
        for (int d = 0; d < 4; ++d)
#pragma unroll
            for (int g = 0; g < 4; ++g) { const int dd = 32 * d + 8 * g + 4 * hi; const f32x4 gv = *(const f32x4*)(sg + dd);
                u32x2 w; w.x = cvtpk(o[d][4 * g] * rstd * gv[0], o[d][4 * g + 1] * rstd * gv[1]); w.y = cvtpk(o[d][4 * g + 2] * rstd * gv[2], o[d][4 * g + 3] * rstd * gv[3]);
                *(u32x2*)(yo + dd) = w; }
    }
    __syncthreads();
}

constexpr int RCH = 32;
constexpr int RK_R = 0, RK_KM = 8192, RK_DEC = 16384, RK_KK = 24576, RK_BB = 32768, RK_VV = 40960, RK_GG = 49152;
constexpr int RK_AW = 57344;
constexpr int RK_AA = RK_AW + 4608;
constexpr int RK_AG = RK_AA + 4608;
constexpr int RK_BON = RK_AG + 8704;
constexpr int RK_MU = RK_BON + 128;
constexpr int RK_RAW = 77824;
constexpr int RK_END = RK_RAW + 33 * 1024;
static_assert(RK_MU + 1792 <= RK_RAW && RK_END <= LDS_BYTES && (RK_RAW % 1024) == 0, "rwkv prep LDS map");
template <int CTRL> __device__ __forceinline__ float dpp_add(float v) { return v + __builtin_bit_cast(float, __builtin_amdgcn_update_dpp(0, __builtin_bit_cast(int, v), CTRL, 0xf, 0xf, true)); }
__device__ __forceinline__ float red16(float v) {
    v = dpp_add<0xB1>(v);
    v = dpp_add<0x4E>(v);
    v = dpp_add<0x141>(v);
    v = dpp_add<0x140>(v);
    return v;
}
__device__ __forceinline__ int rk_piece_col(int pc, int h) {
    return pc < 8 ? h * 64 + 8 * pc : (pc < 16 ? 512 + h * 64 + 8 * (pc - 8) : (pc < 24 ? 1024 + h * 64 + 8 * (pc - 16) : 1536 + 8 * (pc - 24)));
}
#define RK_BAR() do { asm volatile("s_waitcnt lgkmcnt(0)" ::: "memory"); __builtin_amdgcn_s_barrier(); asm volatile("" ::: "memory"); } while (0)
__device__ __forceinline__ void rwkv_prep(const Params& p, LAS unsigned char* lds, int b, int h, int ch0, int ch1) {
    const int tid = opaque_tid(), lane = tid & 63, wid = __builtin_amdgcn_readfirstlane(tid >> 6);
    const bf16_t* proj = (const bf16_t*)(p.ws + WS_PROJ) + (size_t)b * SEQ * IC;
    LAS float* R_ = (LAS float*)(lds + RK_R); LAS float* KM_ = (LAS float*)(lds + RK_KM); LAS float* DEC_ = (LAS float*)(lds + RK_DEC); LAS float* KK_ = (LAS float*)(lds + RK_KK);
    LAS float* BB_ = (LAS float*)(lds + RK_BB); LAS float* VV_ = (LAS float*)(lds + RK_VV); LAS float* GG_ = (LAS float*)(lds + RK_GG); LAS float* BON_ = (LAS float*)(lds + RK_BON);
    LAS float* MU_ = (LAS float*)(lds + RK_MU);
    const int dpc = lane < 56 ? lane : 55;
    const bf16_t* dsrc = proj + rk_piece_col(dpc, h);
#define RK_DMA(t0_) do { for (int rho = wid; rho < 33; rho += NWAVES) { int tok = (t0_) - 1 + rho; tok = tok < 0 ? 0 : tok; \
        __builtin_amdgcn_global_load_lds((const unsigned*)(dsrc + (size_t)tok * IC), (LAS unsigned*)(lds + RK_RAW + rho * 1024), 16, 0, 0); } } while (0)
    RK_DMA(ch0 * RCH);
    if (tid < 448) MU_[tid] = p.in[I_MU][rk_piece_col(tid >> 3, h) + (tid & 7)];
    const int ntile = wid & 3, ttile = wid >> 2, fn = lane & 15, fk = lane >> 4;
    const int ncol = h * 64 + ntile * 16 + fn;
    bf16x8 bw[2], ba[2], bg[4];
    {
        const float* wup = p.in[I_WUP]; const float* aup = p.in[I_AUP]; const float* gup = p.in[I_GUP];
#pragma unroll
        for (int ks = 0; ks < 2; ++ks) { float t[8], u[8];
#pragma unroll
            for (int j = 0; j < 8; ++j) { const int k = 32 * ks + 8 * fk + j; t[j] = wup[k * RW + ncol]; u[j] = aup[k * RW + ncol]; }
            u32x4 a, c; a.x = cvtpk(t[0], t[1]); a.y = cvtpk(t[2], t[3]); a.z = cvtpk(t[4], t[5]); a.w = cvtpk(t[6], t[7]);
            c.x = cvtpk(u[0], u[1]); c.y = cvtpk(u[2], u[3]); c.z = cvtpk(u[4], u[5]); c.w = cvtpk(u[6], u[7]);
            bw[ks] = __builtin_bit_cast(bf16x8, a); ba[ks] = __builtin_bit_cast(bf16x8, c); }
#pragma unroll
        for (int ks = 0; ks < 4; ++ks) { float t[8];
#pragma unroll
            for (int j = 0; j < 8; ++j) { const int k = 32 * ks + 8 * fk + j; t[j] = gup[k * RW + ncol]; }
            u32x4 a; a.x = cvtpk(t[0], t[1]); a.y = cvtpk(t[2], t[3]); a.z = cvtpk(t[4], t[5]); a.w = cvtpk(t[6], t[7]);
            bg[ks] = __builtin_bit_cast(bf16x8, a); }
    }
    const float w0n = p.in[I_W0][ncol], a0n = p.in[I_A0][ncol];
    const int q16 = tid & 15, tk16 = tid >> 4;
    const f32x4 kkc = *(const f32x4*)(p.in[I_KK] + h * 64 + 4 * q16), kac = *(const f32x4*)(p.in[I_KA] + h * 64 + 4 * q16), rkc = *(const f32x4*)(p.in[I_RK] + h * 64 + 4 * q16);
    const size_t hb = (size_t)(b * 8 + h) * SEQ * 64;
    float* gR = (float*)(p.ws + WS_RS) + hb; float* gKM = (float*)(p.ws + WS_KMS) + hb; float* gDEC = (float*)(p.ws + WS_DECS) + hb; float* gKK = (float*)(p.ws + WS_KKS) + hb;
    float* gBB = (float*)(p.ws + WS_BBS) + hb; float* gVS = (float*)(p.ws + WS_VS) + hb; float* gGG = p.out + (size_t)16 * 1024 * 1024 + hb; float* gBON = (float*)(p.ws + WS_BON) + (size_t)(b * 8 + h) * SEQ;
    for (int ch = ch0; ch < ch1; ++ch) {
        const int t0 = ch * RCH;
        if (ch > ch0) { if (wid == 0) asm volatile("s_waitcnt vmcnt(8)" ::: "memory"); else asm volatile("s_waitcnt vmcnt(7)" ::: "memory"); } else asm volatile("s_waitcnt vmcnt(0)" ::: "memory");
        RK_BAR();
#pragma unroll
        for (int it = 0; it < 4; ++it) { const int item = tid + it * NTHREADS;
            if (item < RCH * 56) { const int tk = item / 56, pc = item - tk * 56;
                const u32x4 cv = *(const LAS u32x4*)(lds + RK_RAW + (tk + 1) * 1024 + pc * 16);
                u32x4 pv = *(const LAS u32x4*)(lds + RK_RAW + tk * 1024 + pc * 16);
                if (t0 + tk == 0) pv = (u32x4){0u, 0u, 0u, 0u};
                const f32x4 m0 = *(const LAS f32x4*)(MU_ + pc * 8), m1 = *(const LAS f32x4*)(MU_ + pc * 8 + 4);
                float xv[8];
#pragma unroll
                for (int j = 0; j < 4; ++j) { const unsigned cw = cv[j], pw = pv[j];
                    const float c0 = __uint_as_float(cw << 16), c1 = __uint_as_float(cw & 0xffff0000u), p0 = __uint_as_float(pw << 16), p1 = __uint_as_float(pw & 0xffff0000u);
                    const float ma = (j < 2) ? m0[2 * j] : m1[2 * j - 4], mb = (j < 2) ? m0[2 * j + 1] : m1[2 * j - 3];
                    xv[2 * j] = c0 + ma * (p0 - c0); xv[2 * j + 1] = c1 + mb * (p1 - c1); }
                const int seg = pc >> 3, pi = pc & 7;
                if (seg <= 2) { LAS float* dst = (seg == 0 ? R_ : (seg == 1 ? KM_ : VV_)) + tk * 64 + 8 * pi;
                    *(LAS f32x4*)dst = (f32x4){xv[0], xv[1], xv[2], xv[3]}; *(LAS f32x4*)(dst + 4) = (f32x4){xv[4], xv[5], xv[6], xv[7]}; }
                else if (seg == 3) { u32x4 w; w.x = cvtpk(tanh_fast(xv[0]), tanh_fast(xv[1])); w.y = cvtpk(tanh_fast(xv[2]), tanh_fast(xv[3])); w.z = cvtpk(tanh_fast(xv[4]), tanh_fast(xv[5])); w.w = cvtpk(tanh_fast(xv[6]), tanh_fast(xv[7]));
                    *(LAS u32x4*)(lds + RK_AW + tk * 144 + 16 * pi) = w; }
                else if (seg == 4) { u32x4 w; w.x = cvtpk(xv[0], xv[1]); w.y = cvtpk(xv[2], xv[3]); w.z = cvtpk(xv[4], xv[5]); w.w = cvtpk(xv[6], xv[7]);
                    *(LAS u32x4*)(lds + RK_AA + tk * 144 + 16 * pi) = w; }
                else { u32x4 w; w.x = cvtpk(sigmoidf_(xv[0]), sigmoidf_(xv[1])); w.y = cvtpk(sigmoidf_(xv[2]), sigmoidf_(xv[3])); w.z = cvtpk(sigmoidf_(xv[4]), sigmoidf_(xv[5])); w.w = cvtpk(sigmoidf_(xv[6]), sigmoidf_(xv[7]));
                    *(LAS u32x4*)(lds + RK_AG + tk * 272 + (pc - 40) * 16) = w; }
            } }
        __syncthreads();
        if (ch + 1 < ch1) RK_DMA(t0 + RCH);
        {
            f32x4 cw = (f32x4){0.f, 0.f, 0.f, 0.f}, ca = cw, cg2 = cw;
            const int tok = ttile * 16 + fn;
#pragma unroll
            for (int ks = 0; ks < 2; ++ks) {
                const bf16x8 aw = *(const LAS bf16x8*)(lds + RK_AW + tok * 144 + (32 * ks + 8 * fk) * 2);
                const bf16x8 aa = *(const LAS bf16x8*)(lds + RK_AA + tok * 144 + (32 * ks + 8 * fk) * 2);
                cw = __builtin_amdgcn_mfma_f32_16x16x32_bf16(aw, bw[ks], cw, 0, 0, 0);
                ca = __builtin_amdgcn_mfma_f32_16x16x32_bf16(aa, ba[ks], ca, 0, 0, 0);
            }
#pragma unroll
            for (int ks = 0; ks < 4; ++ks) {
                const bf16x8 ag = *(const LAS bf16x8*)(lds + RK_AG + tok * 272 + (32 * ks + 8 * fk) * 2);
                cg2 = __builtin_amdgcn_mfma_f32_16x16x32_bf16(ag, bg[ks], cg2, 0, 0, 0);
            }
#pragma unroll
            for (int r = 0; r < 4; ++r) { const int tk = ttile * 16 + 4 * fk + r, n = ntile * 16 + fn;
                DEC_[tk * 64 + n] = -0.6065306597126334f * sigmoidf_(cw[r] + w0n);
                BB_[tk * 64 + n] = sigmoidf_(ca[r] + a0n);
                GG_[tk * 64 + n] = cg2[r]; }
        }
        RK_BAR();
        {
            const f32x4 kp = *(const LAS f32x4*)(KM_ + tk16 * 64 + 4 * q16), av = *(const LAS f32x4*)(BB_ + tk16 * 64 + 4 * q16), rr = *(const LAS f32x4*)(R_ + tk16 * 64 + 4 * q16);
            const f32x4 kkv = kp * kkc;
            const float nrm2 = red16((kkv[0] * kkv[0] + kkv[1] * kkv[1]) + (kkv[2] * kkv[2] + kkv[3] * kkv[3]));
            const f32x4 kkn = kkv * __builtin_amdgcn_rsqf(fmaxf(nrm2, 1e-24f));
            const f32x4 kmod = kp * ((av - 1.0f) * kac + 1.0f);
            const f32x4 t = rr * kmod * rkc;
            const float bs = red16((t[0] + t[1]) + (t[2] + t[3]));
            *(LAS f32x4*)(KK_ + tk16 * 64 + 4 * q16) = kkn; *(LAS f32x4*)(BB_ + tk16 * 64 + 4 * q16) = kkn * av; *(LAS f32x4*)(KM_ + tk16 * 64 + 4 * q16) = kmod;
            if (q16 == 0) BON_[tk16] = bs;
        }
        RK_BAR();
        {
            const size_t go = (size_t)t0 * 64 + tid * 4;
            *(f32x4*)(gR + go) = *(const LAS f32x4*)(R_ + tid * 4); *(f32x4*)(gKM + go) = *(const LAS f32x4*)(KM_ + tid * 4); *(f32x4*)(gDEC + go) = *(const LAS f32x4*)(DEC_ + tid * 4);
            *(f32x4*)(gKK + go) = *(const LAS f32x4*)(KK_ + tid * 4); *(f32x4*)(gBB + go) = *(const LAS f32x4*)(BB_ + tid * 4); *(f32x4*)(gVS + go) = *(const LAS f32x4*)(VV_ + tid * 4);
            *(f32x4*)(gGG + go) = *(const LAS f32x4*)(GG_ + tid * 4);
            if (tid < RCH) gBON[t0 + tid] = BON_[tid];
        }
    }
    asm volatile("s_waitcnt vmcnt(0)" ::: "memory");
    __syncthreads();
#undef RK_DMA
}

constexpr int CS_IN = 45056;
constexpr int CS_OP = 2 * CS_IN;
constexpr int CS_AT = CS_OP, CS_RT = CS_OP + 4608, CS_BH = CS_OP + 9216, CS_KH = CS_OP + 13824;
constexpr int CS_BCT = CS_OP + 18432, CS_KCT = CS_OP + 23552;
constexpr int CS_VT = CS_OP + 28672;
constexpr int CS_MT2 = CS_OP + 31232, CS_MT3 = CS_OP + 33792, CS_MT4 = CS_OP + 36352;
constexpr int CS_M1F = CS_OP + 38912;
constexpr int CS_XF = CS_OP + 43520;
constexpr int CS_UB = CS_OP + 48128;
constexpr int CS_SB = CS_OP + 50688;
constexpr int CS_YY = CS_OP + 55296;
constexpr int CS_P31 = CS_OP + 59392;
constexpr int CS_LSEG = CS_OP + 59648;
constexpr int CS_END = CS_OP + 61696;
static_assert(CS_END <= LDS_BYTES - 64, "rwkv scan LDS map");
__device__ __forceinline__ int crow32(int r, int hi) { return (r & 3) + 8 * (r >> 2) + 4 * hi; }
__device__ __forceinline__ void rwkv_scan(const Params& p, LAS unsigned char* lds, int b, int h, int half) {
    const int tid = opaque_tid(), lane = tid & 63, wid = __builtin_amdgcn_readfirstlane(tid >> 6), r32 = lane & 31, hi = lane >> 5;
    const size_t hb = (size_t)(b * 8 + h) * SEQ * 64;
    const float* gKK = (const float*)(p.ws + WS_KKS) + hb; const float* gLW = (const float*)(p.ws + WS_DECS) + hb; const float* gBB = (const float*)(p.ws + WS_BBS) + hb;
    const float* gKM = (const float*)(p.ws + WS_KMS) + hb; const float* gR = (const float*)(p.ws + WS_RS) + hb; const float* gVS = (const float*)(p.ws + WS_VS) + hb;
    float* yraw = p.out + (size_t)b * SEQ * RW + h * 64 + half * 32;
    const int vtok = lane >> 3, vsub = lane & 7;
#define RS_DMA(t0_, buf) do { LAS unsigned char* bb_ = lds + (buf) * CS_IN; \
        for (int pc = wid; pc < 44; pc += NWAVES) { \
            const float* src_; \
            if (pc < 40) { const int ar = pc >> 3, pp = pc & 7; const float* base_ = ar == 0 ? gKK : (ar == 1 ? gLW : (ar == 2 ? gBB : (ar == 3 ? gKM : gR))); src_ = base_ + (size_t)(t0_) * 64 + pp * 256 + lane * 4; } \
            else { const int pp = pc - 40; src_ = gVS + (size_t)((t0_) + pp * 8 + vtok) * 64 + half * 32 + vsub * 4; } \
            __builtin_amdgcn_global_load_lds((const unsigned*)src_, (LAS unsigned*)(bb_ + pc * 1024), 16, 0, 0); } } while (0)
    RS_DMA(0, 0);
    for (int i = tid; i < 4608 / 4; i += NTHREADS) ((LAS unsigned*)(lds + CS_SB))[i] = 0u;
    f32x16 Sacc = f32x16{};
    f32x16 Xacc = f32x16{};
    const int d1 = tid & 63, q1 = wid;
    for (int ch = 0; ch < SEQ / RCH; ++ch) {
        const int t0 = ch * RCH, cur = ch & 1;
        if (wid < 4 && ch > 0) asm volatile("s_waitcnt vmcnt(1)" ::: "memory"); else asm volatile("s_waitcnt vmcnt(0)" ::: "memory");
        RK_BAR();
        if (ch + 1 < SEQ / RCH) RS_DMA(t0 + RCH, cur ^ 1);
        const LAS float* KK_ = (const LAS float*)(lds + cur * CS_IN), * LW_ = KK_ + 2048, * BB_ = KK_ + 4096, * KM_ = KK_ + 6144, * R_ = KK_ + 8192, * VV_ = KK_ + 10240;
        float lw[4], cs[4];
#pragma unroll
        for (int e = 0; e < 4; ++e) lw[e] = LW_[(4 * q1 + e) * 64 + d1];
        cs[0] = lw[0]; cs[1] = cs[0] + lw[1]; cs[2] = cs[1] + lw[2]; cs[3] = cs[2] + lw[3];
        ((LAS float*)(lds + CS_LSEG))[q1 * 64 + d1] = cs[3];
        if (tid < 256) { const int v = tid & 31, tq = tid >> 5; const float x0 = VV_[(4 * tq) * 32 + v], x1 = VV_[(4 * tq + 1) * 32 + v], x2 = VV_[(4 * tq + 2) * 32 + v], x3 = VV_[(4 * tq + 3) * 32 + v];
            u32x2 w; w.x = cvtpk(x0, x1); w.y = cvtpk(x2, x3); *(LAS u32x2*)(lds + CS_VT + v * 80 + tq * 8) = w; }
        RK_BAR();
        {
            float off = 0.f, tot = 0.f;
#pragma unroll
            for (int qq = 0; qq < 8; ++qq) { const float sg = ((const LAS float*)(lds + CS_LSEG))[qq * 64 + d1]; tot += sg; if (qq < q1) off += sg; }
            const float etot = __expf(tot);
            float ePprev = __expf(off);
            float bc[4], kc4[4];
#pragma unroll
            for (int e = 0; e < 4; ++e) { const int tk = 4 * q1 + e;
                const float eP = __expf(off + cs[e]), eN = __builtin_amdgcn_rcpf(eP), eE = etot * eN;
                const float kap = KK_[tk * 64 + d1], bet = BB_[tk * 64 + d1], kk_ = KM_[tk * 64 + d1], rr = R_[tk * 64 + d1];
                const unsigned w0 = cvtpk(-kap * ePprev, rr * eP), w1 = cvtpk(bet * eN, kk_ * eN);
                *(LAS unsigned short*)(lds + CS_AT + tk * 144 + d1 * 2) = (unsigned short)(w0 & 0xffffu); *(LAS unsigned short*)(lds + CS_RT + tk * 144 + d1 * 2) = (unsigned short)(w0 >> 16);
                *(LAS unsigned short*)(lds + CS_BH + tk * 144 + d1 * 2) = (unsigned short)(w1 & 0xffffu); *(LAS unsigned short*)(lds + CS_KH + tk * 144 + d1 * 2) = (unsigned short)(w1 >> 16);
                bc[e] = bet * eE; kc4[e] = kk_ * eE; ePprev = eP; }
            u32x2 wb, wk; wb.x = cvtpk(bc[0], bc[1]); wb.y = cvtpk(bc[2], bc[3]); wk.x = cvtpk(kc4[0], kc4[1]); wk.y = cvtpk(kc4[2], kc4[3]);
            *(LAS u32x2*)(lds + CS_BCT + d1 * 80 + q1 * 8) = wb; *(LAS u32x2*)(lds + CS_KCT + d1 * 80 + q1 * 8) = wk;
            if (q1 == 0) ((LAS float*)(lds + CS_P31))[d1] = etot;
        }
        RK_BAR();
        if (wid < 4) {
            const LAS unsigned char* Am = lds + ((wid & 1) ? CS_KH : CS_BH) + r32 * 144 + hi * 16;
            const LAS unsigned char* Bm = lds + ((wid & 2) ? CS_RT : CS_AT) + r32 * 144 + hi * 16;
            f32x16 acc = f32x16{};
#pragma unroll
            for (int ks = 0; ks < 4; ++ks) acc = __builtin_amdgcn_mfma_f32_32x32x16_bf16(*(const LAS bf16x8*)(Am + ks * 32), *(const LAS bf16x8*)(Bm + ks * 32), acc, 0, 0, 0);
            const int lim = (wid < 2) ? r32 : r32 + 1;
#pragma unroll
            for (int rg = 0; rg < 16; ++rg) if (crow32(rg, hi) >= lim) acc[rg] = 0.f;
            if (wid == 0) {
#pragma unroll
                for (int rg = 0; rg < 16; ++rg) ((LAS float*)(lds + CS_M1F))[crow32(rg, hi) * 36 + r32] = acc[rg];
            } else {
                LAS unsigned char* Mt = lds + (wid == 1 ? CS_MT2 : (wid == 2 ? CS_MT3 : CS_MT4)) + r32 * 80 + hi * 8;
#pragma unroll
                for (int g = 0; g < 4; ++g) { u32x2 w; w.x = cvtpk(acc[4 * g], acc[4 * g + 1]); w.y = cvtpk(acc[4 * g + 2], acc[4 * g + 3]); *(LAS u32x2*)(Mt + g * 16) = w; }
            }
        } else if (wid < 6) {
            const LAS unsigned char* Am = lds + (wid == 4 ? CS_AT : CS_RT) + r32 * 144 + hi * 16;
            const LAS unsigned char* Bm = lds + CS_SB + r32 * 144 + hi * 16;
            Xacc = f32x16{};
#pragma unroll
            for (int ks = 0; ks < 4; ++ks) Xacc = __builtin_amdgcn_mfma_f32_32x32x16_bf16(*(const LAS bf16x8*)(Am + ks * 32), *(const LAS bf16x8*)(Bm + ks * 32), Xacc, 0, 0, 0);
        }
        RK_BAR();
        if (wid == 4) {
            const LAS unsigned char* Am = lds + CS_MT2 + r32 * 80 + hi * 16;
            const LAS unsigned char* Bm = lds + CS_VT + r32 * 80 + hi * 16;
#pragma unroll
            for (int ks = 0; ks < 2; ++ks) Xacc = __builtin_amdgcn_mfma_f32_32x32x16_bf16(*(const LAS bf16x8*)(Am + ks * 32), *(const LAS bf16x8*)(Bm + ks * 32), Xacc, 0, 0, 0);
#pragma unroll
            for (int g = 0; g < 4; ++g) *(LAS f32x4*)(lds + CS_XF + r32 * 144 + (8 * g + 4 * hi) * 4) = (f32x4){Xacc[4 * g], Xacc[4 * g + 1], Xacc[4 * g + 2], Xacc[4 * g + 3]};
        }
        RK_BAR();
        {
            const int v = tid >> 4, l = tid & 15;
            float m0[32], m1[32];
#pragma unroll
            for (int c4 = 0; c4 < 8; ++c4) { const f32x4 a = *(const LAS f32x4*)(lds + CS_M1F + l * 144 + c4 * 16), c = *(const LAS f32x4*)(lds + CS_M1F + (l + 16) * 144 + c4 * 16);
                m0[4 * c4] = a[0]; m0[4 * c4 + 1] = a[1]; m0[4 * c4 + 2] = a[2]; m0[4 * c4 + 3] = a[3]; m1[4 * c4] = c[0]; m1[4 * c4 + 1] = c[1]; m1[4 * c4 + 2] = c[2]; m1[4 * c4 + 3] = c[3]; }
            const float x0 = ((const LAS float*)(lds + CS_XF))[v * 36 + l], x1 = ((const LAS float*)(lds + CS_XF))[v * 36 + l + 16];
            float u0 = 0.f, u1 = 0.f;
#pragma unroll
            for (int i = 0; i < 32; ++i) {
                const float part = (i < 16) ? u0 * m0[i] : (u0 * m0[i] + u1 * m1[i]);
                const float tot = red16(part);
                if (i < 16) u0 = (l == i) ? x0 + tot : u0; else u1 = (l == i - 16) ? x1 + tot : u1;
            }
            const unsigned w = cvtpk(u0, u1);
            *(LAS unsigned short*)(lds + CS_UB + v * 80 + l * 2) = (unsigned short)(w & 0xffffu); *(LAS unsigned short*)(lds + CS_UB + v * 80 + (l + 16) * 2) = (unsigned short)(w >> 16);
        }
        RK_BAR();
        if (wid == 5) {
            const LAS unsigned char* A3 = lds + CS_MT3 + r32 * 80 + hi * 16; const LAS unsigned char* A4 = lds + CS_MT4 + r32 * 80 + hi * 16;
            const LAS unsigned char* Bu = lds + CS_UB + r32 * 80 + hi * 16; const LAS unsigned char* Bv = lds + CS_VT + r32 * 80 + hi * 16;
#pragma unroll
            for (int ks = 0; ks < 2; ++ks) { Xacc = __builtin_amdgcn_mfma_f32_32x32x16_bf16(*(const LAS bf16x8*)(A3 + ks * 32), *(const LAS bf16x8*)(Bu + ks * 32), Xacc, 0, 0, 0);
                Xacc = __builtin_amdgcn_mfma_f32_32x32x16_bf16(*(const LAS bf16x8*)(A4 + ks * 32), *(const LAS bf16x8*)(Bv + ks * 32), Xacc, 0, 0, 0); }
#pragma unroll
            for (int rg = 0; rg < 16; ++rg) ((LAS float*)(lds + CS_YY))[crow32(rg, hi) * 32 + r32] = Xacc[rg];
        } else if (wid < 2) {
#pragma unroll
            for (int g = 0; g < 4; ++g) { const f32x4 pv = *(const LAS f32x4*)(lds + CS_P31 + (32 * wid + 8 * g + 4 * hi) * 4);
                Sacc[4 * g] *= pv[0]; Sacc[4 * g + 1] *= pv[1]; Sacc[4 * g + 2] *= pv[2]; Sacc[4 * g + 3] *= pv[3]; }
            const LAS unsigned char* Ab = lds + CS_BCT + (32 * wid + r32) * 80 + hi * 16; const LAS unsigned char* Ak = lds + CS_KCT + (32 * wid + r32) * 80 + hi * 16;
            const LAS unsigned char* Bu = lds + CS_UB + r32 * 80 + hi * 16; const LAS unsigned char* Bv = lds + CS_VT + r32 * 80 + hi * 16;
#pragma unroll
            for (int ks = 0; ks < 2; ++ks) { Sacc = __builtin_amdgcn_mfma_f32_32x32x16_bf16(*(const LAS bf16x8*)(Ab + ks * 32), *(const LAS bf16x8*)(Bu + ks * 32), Sacc, 0, 0, 0);
                Sacc = __builtin_amdgcn_mfma_f32_32x32x16_bf16(*(const LAS bf16x8*)(Ak + ks * 32), *(const LAS bf16x8*)(Bv + ks * 32), Sacc, 0, 0, 0); }
#pragma unroll
            for (int g = 0; g < 4; ++g) { u32x2 w; w.x = cvtpk(Sacc[4 * g], Sacc[4 * g + 1]); w.y = cvtpk(Sacc[4 * g + 2], Sacc[4 * g + 3]); *(LAS u32x2*)(lds + CS_SB + r32 * 144 + (32 * wid + 8 * g + 4 * hi) * 2) = w; }
        }
        RK_BAR();
        if (tid < 256) { const int tk = tid >> 3, sub = tid & 7; *(f32x4*)(yraw + (size_t)(t0 + tk) * RW + sub * 4) = *(const LAS f32x4*)(lds + CS_YY + tk * 128 + sub * 16); }
    }
    asm volatile("s_waitcnt vmcnt(0)" ::: "memory");
    __syncthreads();
#undef RS_DMA
}
__device__ __forceinline__ void rwkv_finalize(const Params& p, int G) {
    const int tid = opaque_tid(), q16 = tid & 15;
    const float* yraw = p.out; const float* gGG = p.out + (size_t)16 * 1024 * 1024; const float* gVS = (const float*)(p.ws + WS_VS); const float* gBON = (const float*)(p.ws + WS_BON);
    bf16_t* ymix = (bf16_t*)(p.ws + WS_YMIX);
    for (int item = (int)blockIdx.x * (NTHREADS / 16) + (tid >> 4); item < T * 8; item += G * (NTHREADS / 16)) {
        const int tok = item >> 3, h = item & 7, b = tok / SEQ, t = tok - b * SEQ;
        const f32x4 y = *(const f32x4*)(yraw + (size_t)tok * RW + h * 64 + 4 * q16);
        const size_t ho = ((size_t)(b * 8 + h) * SEQ + t) * 64 + 4 * q16;
        const f32x4 vv = *(const f32x4*)(gVS + ho), gg = *(const f32x4*)(gGG + ho);
        const float bon = gBON[(size_t)(b * 8 + h) * SEQ + t];
        const f32x4 gng = *(const f32x4*)(p.in[I_GNG] + h * 64 + 4 * q16), gnb = *(const f32x4*)(p.in[I_GNB] + h * 64 + 4 * q16);
        const float mean = red16((y[0] + y[1]) + (y[2] + y[3])) * (1.0f / 64.0f);
        const f32x4 dl = y - mean;
        const float var = red16((dl[0] * dl[0] + dl[1] * dl[1]) + (dl[2] * dl[2] + dl[3] * dl[3])) * (1.0f / 64.0f);
        const f32x4 yn = dl * __builtin_amdgcn_rsqf(var + GN_EPS) * gng + gnb;
        const f32x4 ov = (yn + vv * bon) * gg;
        u32x2 w; w.x = cvtpk(ov[0], ov[1]); w.y = cvtpk(ov[2], ov[3]);
        *(u32x2*)(ymix + (size_t)tok * D + h * 64 + 4 * q16) = w;
    }
}
#undef RK_BAR

constexpr int RT_PITCH = 36;
__device__ __forceinline__ void phase_router(const Params& p, LAS unsigned char* lds, int G) {
    const int tid = opaque_tid(), lane = tid & 63, wave = tid >> 6;
    LAS float* wr_ = (LAS float*)lds;
    LAS int* hist = (LAS int*)(lds + 147456);
    const float* rw = p.in[I_RTW];
    for (int i = tid; i < 1024 * 8; i += NTHREADS) { const int k = i >> 3, c4 = i & 7; const f32x4 v = *(const f32x4*)(rw + k * 32 + 4 * c4);
        const int ln = (k & 255) >> 2, ii = k & 3, jj = k >> 8; *(LAS f32x4*)(wr_ + ((ii + 4 * jj) * 64 + ln) * RT_PITCH + 4 * c4) = v; }
    const float* x1 = p.out; const float* gain = p.in[I_N2G]; const float* mod = (const float*)(p.ws + WS_MOD); const float* rb = p.in[I_RTB];
    bf16_t* h2 = (bf16_t*)(p.ws + WS_H);
    int* ridx = (int*)(p.ws + WS_ROUTE); float* rwt = (float*)(p.ws + WS_ROUTE + 512 * 1024);
    int* blockcnt = (int*)(p.ws + WS_CTL + 4096);
    const int TPB = T / G;
    for (int blk = blockIdx.x; blk < G; blk += G) {
        if (tid < 32) hist[tid] = 0;
        __syncthreads();
        for (int ti = wave; ti < TPB; ti += NWAVES) {
            const int row = blk * TPB + ti; const int b = row / SEQ;
            const f32x4* xr = (const f32x4*)(x1 + (size_t)row * D) + lane;
            f32x4 v[4]; float s = 0.f;
#pragma unroll
            for (int j = 0; j < 4; ++j) { v[j] = xr[64 * j]; s += (v[j][0] * v[j][0] + v[j][1] * v[j][1]) + (v[j][2] * v[j][2] + v[j][3] * v[j][3]); }
            const float rstd = rsqrtf(wave_sum(s) * (1.0f / D) + NORM_EPS);
            const float* sh = mod + b * 6144 + 3072; const float* scl = mod + b * 6144 + 4096;
            unsigned long long* o8 = (unsigned long long*)(h2 + (size_t)row * D) + lane;
            float acc[32];
#pragma unroll
            for (int e = 0; e < 32; ++e) acc[e] = 0.f;
#pragma unroll
            for (int j = 0; j < 4; ++j) { const int k = 4 * lane + 256 * j;
                const f32x4 g = *(const f32x4*)(gain + k), s1 = *(const f32x4*)(scl + k), s0 = *(const f32x4*)(sh + k);
                const f32x4 y = (v[j] * rstd) * g * (s1 + 1.0f) + s0;
                o8[64 * j] = (unsigned long long)cvtpk(y[0], y[1]) | ((unsigned long long)cvtpk(y[2], y[3]) << 32);
#pragma unroll
                for (int i = 0; i < 4; ++i) { const LAS float* wrow = wr_ + ((i + 4 * j) * 64 + lane) * RT_PITCH; const float yv = y[i];
#pragma unroll
                    for (int c4 = 0; c4 < 8; ++c4) { const f32x4 wv = *(const LAS f32x4*)(wrow + 4 * c4);
                        acc[4 * c4 + 0] += yv * wv[0]; acc[4 * c4 + 1] += yv * wv[1]; acc[4 * c4 + 2] += yv * wv[2]; acc[4 * c4 + 3] += yv * wv[3]; } } }
            float r16[16];
#pragma unroll
            for (int e = 0; e < 16; ++e) { const bool up = (lane & 32) != 0; const float keep = up ? acc[e + 16] : acc[e], send = up ? acc[e] : acc[e + 16]; r16[e] = keep + __shfl_xor(send, 32); }
            float r8[8];
#pragma unroll
            for (int e = 0; e < 8; ++e) { const bool up = (lane & 16) != 0; const float keep = up ? r16[e + 8] : r16[e], send = up ? r16[e] : r16[e + 8]; r8[e] = keep + __shfl_xor(send, 16); }
            float r4[4];
#pragma unroll
            for (int e = 0; e < 4; ++e) { const bool up = (lane & 8) != 0; const float keep = up ? r8[e + 4] : r8[e], send = up ? r8[e] : r8[e + 4]; r4[e] = keep + __shfl_xor(send, 8); }
            float r2[2];
#pragma unroll
            for (int e = 0; e < 2; ++e) { const bool up = (lane & 4) != 0; const float keep = up ? r4[e + 2] : r4[e], send = up ? r4[e] : r4[e + 2]; r2[e] = keep + __shfl_xor(send, 4); }
            float r1;
            { const bool up = (lane & 2) != 0; const float keep = up ? r2[1] : r2[0], send = up ? r2[0] : r2[1]; r1 = keep + __shfl_xor(send, 2); }
            r1 += __shfl_xor(r1, 1);
            const int e_l = lane >> 1;
            float logit = r1 + rb[e_l];
            int sel[4]; float sv[4];
#pragma unroll
            for (int k = 0; k < 4; ++k) { const float mx = wave_max(logit); const unsigned long long bal = __ballot(logit == mx); const int ln = __ffsll((long long)bal) - 1;
                sel[k] = ln >> 1; sv[k] = mx; if (e_l == sel[k]) logit = -INFINITY; }
            const float e1 = __expf(sv[1] - sv[0]), e2 = __expf(sv[2] - sv[0]), e3 = __expf(sv[3] - sv[0]); const float inv = 1.0f / (1.0f + e1 + e2 + e3);
            if (lane == 0) { *(int4*)(ridx + (size_t)row * 4) = make_int4(sel[0], sel[1], sel[2], sel[3]); *(float4*)(rwt + (size_t)row * 4) = make_float4(inv, e1 * inv, e2 * inv, e3 * inv);
                atomicAdd((int*)&hist[sel[0]], 1); atomicAdd((int*)&hist[sel[1]], 1); atomicAdd((int*)&hist[sel[2]], 1); atomicAdd((int*)&hist[sel[3]], 1); }
        }
        __syncthreads();
        if (tid < 32) blockcnt[blk * 32 + tid] = hist[tid];
        __syncthreads();
    }
}

__device__ __forceinline__ void phase_assign(const Params& p, LAS unsigned char* lds, int G) {
    const int tid = opaque_tid(), lane = tid & 63, wave = tid >> 6;
    LAS int* part = (LAS int*)lds;
    LAS int* partb = part + 512;
    LAS int* total = partb + 512;
    LAS int* base = total + 32;
    LAS int* segst = base + 32;
    LAS int* cursor = segst + 32;
    LAS int* slotl = cursor + 32;
    const int* blockcnt = (const int*)(p.ws + WS_CTL + 4096);
    const int* ridx = (const int*)(p.ws + WS_ROUTE); int* rslot = (int*)(p.ws + WS_ROUTE + 1024 * 1024);
    const bf16_t* h2 = (const bf16_t*)(p.ws + WS_H); bf16_t* xs = (bf16_t*)(p.ws + WS_PROJ);
    int* tile = (int*)(p.ws + WS_TILE);
    const int TPB = T / G; const int blk = blockIdx.x;
    { const int e = tid & 31, part_i = tid >> 5; int st = 0, sb = 0;
        for (int bb = part_i; bb < G; bb += 16) { const int c = blockcnt[bb * 32 + e]; st += c; if (bb < blk) sb += c; }
        part[part_i * 32 + e] = st; partb[part_i * 32 + e] = sb; }
    __syncthreads();
    if (tid < 32) { int st = 0, sb = 0;
#pragma unroll
        for (int i = 0; i < 16; ++i) { st += part[i * 32 + tid]; sb += partb[i * 32 + tid]; }
        total[tid] = st; base[tid] = sb; cursor[tid] = 0; }
    __syncthreads();
    if (tid == 0) { int acc = 0; for (int e = 0; e < 32; ++e) { segst[e] = acc; acc += (total[e] + 255) & ~255; }
        if (blk == 0) { int pm = 0; for (int e = 0; e < 32; ++e) { const int nt = (total[e] + 255) >> 8; for (int i = 0; i < nt; ++i) tile[16 + pm + i] = e; pm += nt; } tile[0] = pm; } }
    __syncthreads();
    if (tid < 32) base[tid] += segst[tid];
    __syncthreads();
    for (int a = tid; a < TPB * 4; a += NTHREADS) { const int tok = blk * TPB + (a >> 2); const int e = ridx[(size_t)tok * 4 + (a & 3)];
        const int rank = atomicAdd((int*)&cursor[e], 1); const int slot = base[e] + rank; slotl[a] = slot; rslot[(size_t)tok * 4 + (a & 3)] = slot; }
    __syncthreads();
    for (int a = wave; a < TPB * 4; a += NWAVES) { const int tok = blk * TPB + (a >> 2); const int slot = slotl[a];
        const u32x4* src = (const u32x4*)(h2 + (size_t)tok * D) + lane; u32x4* dst = (u32x4*)(xs + (size_t)slot * D) + lane;
        const u32x4 v0 = src[0], v1 = src[64]; dst[0] = v0; dst[64] = v1; }
    for (int e = blk; e < 32; e += G) { const int s0 = segst[e] + total[e], s1 = segst[e] + ((total[e] + 255) & ~255);
        for (int r = s0 + wave; r < s1; r += NWAVES) { u32x4* dst = (u32x4*)(xs + (size_t)r * D) + lane; dst[0] = (u32x4){0u, 0u, 0u, 0u}; dst[64] = (u32x4){0u, 0u, 0u, 0u}; } }
}

__device__ __forceinline__ void phase_final(const Params& p, int G, int stage) {
    const int tid = opaque_tid(), lane = tid & 63, wave = tid >> 6;
    const int gw = (int)blockIdx.x * NWAVES + wave, NGW = G * NWAVES;
    const float* fg = p.in[I_FG]; const float* mod = (const float*)(p.ws + WS_MOD);
    const int* rslot = (const int*)(p.ws + WS_ROUTE + 1024 * 1024); const float* rwt = (const float*)(p.ws + WS_ROUTE + 512 * 1024);
    const bf16_t* Y = (const bf16_t*)(p.ws + WS_PROJ);
    const float* src = (stage >= 4) ? p.out : p.in[I_X];
    for (int row = gw; row < T; row += NGW) {
        const int b = row / SEQ;
        const f32x4* xr = (const f32x4*)(src + (size_t)row * D) + lane;
        f32x4 v[4];
#pragma unroll
        for (int j = 0; j < 4; ++j) v[j] = xr[64 * j];
        if (stage >= 9) {
            const int4 sl = *(const int4*)(rslot + (size_t)row * 4); const float4 wt = *(const float4*)(rwt + (size_t)row * 4);
            const float* g2 = mod + b * 6144 + 5120;
            const int sls[4] = {sl.x, sl.y, sl.z, sl.w}; const float wts[4] = {wt.x, wt.y, wt.z, wt.w};
#pragma unroll
            for (int j = 0; j < 4; ++j) { f32x4 m = (f32x4){0.f, 0.f, 0.f, 0.f};
#pragma unroll
                for (int k = 0; k < 4; ++k) { const u32x2 yv = *((const u32x2*)(Y + (size_t)sls[k] * D) + lane + 64 * j);
                    m[0] += wts[k] * __uint_as_float(yv.x << 16); m[1] += wts[k] * __uint_as_float(yv.x & 0xffff0000u); m[2] += wts[k] * __uint_as_float(yv.y << 16); m[3] += wts[k] * __uint_as_float(yv.y & 0xffff0000u); }
                const f32x4 g = *(const f32x4*)(g2 + 4 * lane + 256 * j); v[j] = v[j] + g * m; }
        }
        float s = 0.f;
#pragma unroll
        for (int j = 0; j < 4; ++j) s += (v[j][0] * v[j][0] + v[j][1] * v[j][1]) + (v[j][2] * v[j][2] + v[j][3] * v[j][3]);
        const float rstd = rsqrtf(wave_sum(s) * (1.0f / D) + NORM_EPS);
        f32x4* orow = (f32x4*)(p.out + (size_t)row * D) + lane;
#pragma unroll
        for (int j = 0; j < 4; ++j) { const f32x4 g = *(const f32x4*)(fg + 4 * lane + 256 * j); orow[64 * j] = v[j] * rstd * g; }
    }
}


#define XB_TMO      128
#define XB_XCNT(j)  (256  + 64 * (j))
#define XB_XSUB(j)  (1280 + 64 * (j))
#define XB_XGEN(j)  (2304 + 64 * (j))
#define XB_TOP      3328
#define XB_TOPGEN   3392
#define XCD_BAR_WORDS 3456
#define XB_SPIN_CAP (1u << 22)
__device__ __forceinline__ unsigned xb_ld(unsigned* p)              { return __hip_atomic_load(p, __ATOMIC_RELAXED, __HIP_MEMORY_SCOPE_AGENT); }
__device__ __forceinline__ unsigned xb_add(unsigned* p, unsigned v) { return __hip_atomic_fetch_add(p, v, __ATOMIC_RELAXED, __HIP_MEMORY_SCOPE_AGENT); }
__device__ __forceinline__ unsigned xb_xcc_id() { return (unsigned)__builtin_amdgcn_s_getreg((3 << 11) | 20) & 0xFu; }
#define XB_SPIN(cond, bar) do { unsigned _sp = 0; while (cond) { __builtin_amdgcn_s_sleep(1); \
    if ((++_sp & 255u) == 0u) { if (xb_ld(&(bar)[XB_TMO])) break; if (_sp > XB_SPIN_CAP) { atomicAdd(&(bar)[XB_TMO], 1u); break; } } } } while (0)
struct XcdBarrier { unsigned* bar; unsigned x; volatile LAS unsigned* st; };
__device__ __forceinline__ XcdBarrier xcd_barrier_post(unsigned* bar, volatile LAS unsigned* st) {
    XcdBarrier b; b.bar = bar; b.x = xb_xcc_id(); b.st = st;
    if (threadIdx.x == 0) (void)xb_add(&bar[XB_XCNT(b.x)], 1u);
    return b;
}
__device__ __forceinline__ void xcd_barrier_complete(unsigned* bar, unsigned x, unsigned& nloc, unsigned& nx) {
    const unsigned G = gridDim.x * gridDim.y * gridDim.z;
    unsigned sum, cnt, mine, sp = 0u;
    for (;;) {
        sum = 0u; cnt = 0u; mine = 0u;
#pragma unroll
        for (unsigned j = 0; j < 16; ++j) { const unsigned c = xb_ld(&bar[XB_XCNT(j)]); sum += c; cnt += (c > 0u) ? 1u : 0u; mine = (j == x) ? c : mine; }
        if (sum == G) break;
        __builtin_amdgcn_s_sleep(1);
        if ((++sp & 255u) == 0u) { if (xb_ld(&bar[XB_TMO])) break; if (sp > XB_SPIN_CAP) { atomicAdd(&bar[XB_TMO], 1u); break; } }
    }
    nloc = mine > 0u ? mine : 1u; nx = cnt > 0u ? cnt : 1u;
}
__device__ __forceinline__ void xcd_barrier(const XcdBarrier& b) {
    asm volatile("s_waitcnt vmcnt(0)" ::: "memory");
    __syncthreads();
    if (threadIdx.x == 0) {
        unsigned* bar = b.bar;
        __builtin_amdgcn_s_waitcnt(0);
        unsigned nloc = b.st[0], nx = b.st[1];
        if (nloc == 0u) { xcd_barrier_complete(bar, b.x, nloc, nx); b.st[0] = nloc; b.st[1] = nx; }
        const unsigned old = xb_add(&bar[XB_XSUB(b.x)], 1u);
        const unsigned gen = old / nloc;
        if (old + 1u == (gen + 1u) * nloc) {
            __builtin_amdgcn_fence(__ATOMIC_RELEASE, "agent");
            asm volatile("s_waitcnt vmcnt(0)" ::: "memory");
            const unsigned og = xb_add(&bar[XB_TOP], 1u);
            const unsigned tg = og / nx;
            if (og + 1u == (tg + 1u) * nx) xb_add(&bar[XB_TOPGEN], 1u);
            else XB_SPIN(xb_ld(&bar[XB_TOPGEN]) == tg, bar);
            __builtin_amdgcn_fence(__ATOMIC_ACQUIRE, "agent");
            xb_add(&bar[XB_XGEN(b.x)], 1u);
            asm volatile("s_waitcnt vmcnt(0)" ::: "memory");
        } else {
            XB_SPIN(xb_ld(&bar[XB_XGEN(b.x)]) == gen, bar);
            __builtin_amdgcn_fence(__ATOMIC_ACQUIRE, "agent");
            asm volatile("s_waitcnt vmcnt(0)" ::: "memory");
        }
    }
    __syncthreads();
}

__device__ __forceinline__ const Params* launder_params(const Params* q) { asm volatile("" : "+s"(q)); return q; }
__global__ void __launch_bounds__(NTHREADS, 2) hymba_fwd(Params p) {
    extern __shared__ __attribute__((aligned(16))) unsigned char lds_raw[];
    cg::grid_group grid = cg::this_grid();
    LAS unsigned char* lds = (LAS unsigned char*)lds_raw;
    const int G = gridDim.x, tid = threadIdx.x;
    constexpr int STAGE = DBG_STAGE;
    volatile LAS unsigned* xst = (volatile LAS unsigned*)(lds + LDS_BYTES - 64);
    if (tid == 0) { xst[0] = 0u; xst[1] = 0u; }
    __syncthreads();
    const XcdBarrier xbar = xcd_barrier_post((unsigned*)(p.ws + WS_CTL + 40960), xst);
#define GRID_BAR() xcd_barrier(xbar)

    phase_mod(p, lds_raw, G);
    if (STAGE >= 2) phase_convert(p, lds_raw, G);
    grid.sync();
    if (STAGE >= 2) { phase_norm1(p, G); GRID_BAR(); }
    if (STAGE >= 2) {
        pg8::Gemm g{(const bf16_t*)(p.ws + WS_H), (const bf16_t*)(p.ws + WS_WIN_T), D};
        pg8::DenseSched S; S.o.init(T / 256, IC / 256, G, (int)blockIdx.x);
        EpiInProj E{(bf16_t*)(p.ws + WS_PROJ)};
        pg8::gemm_phase(lds, g, S, E);
        GRID_BAR();
    }
    if (STAGE >= 3) {
        for (int it = blockIdx.x; it < NB * 8 * 4; it += G) rwkv_prep(p, lds, it >> 5, (it >> 2) & 7, (it & 3) * 32, (it & 3) * 32 + 32);
        GRID_BAR();
    }
    if (STAGE >= 2) {
        if (STAGE >= 3) { for (int u = blockIdx.x; u < NB * 8 * 2; u += G) rwkv_scan(p, lds, u >> 4, (u >> 1) & 7, u & 1); }
        else {
            bf16_t* ymix = (bf16_t*)(p.ws + WS_YMIX);
            for (size_t i = (size_t)blockIdx.x * NTHREADS + tid; i < (size_t)T * 64; i += (size_t)G * NTHREADS) { const size_t row = i >> 6, c = i & 63; *(u32x4*)(ymix + row * D + c * 8) = (u32x4){0u, 0u, 0u, 0u}; }
        }
        float lam;
        { const float* q1 = p.in[I_LQ1]; const float* k1 = p.in[I_LK1]; const float* q2 = p.in[I_LQ2]; const float* k2 = p.in[I_LK2]; float s1 = 0.f, s2 = 0.f;
            for (int i = 0; i < 64; ++i) { s1 += q1[i] * k1[i]; s2 += q2[i] * k2[i]; } lam = expf(s1) - expf(s2) + LAMBDA_INIT; }
        unsigned* qhead = (unsigned*)(p.ws + WS_CTL);
        LAS unsigned* ubox = (LAS unsigned*)(lds + 4 * ATT_BUF);
        for (;;) {
            __syncthreads();
            if (tid == 0) ubox[0] = atomicAdd(qhead, 1u);
            __syncthreads();
            const unsigned u = (unsigned)__builtin_amdgcn_readfirstlane((int)ubox[0]);
            if (u >= (unsigned)ATT_UNITS) break;
            attn_unit(p, lds, (int)(u & 31u) >> 2, (int)(u & 3u), ATT_NQB - 1 - (int)(u >> 5), lam);
        }
        GRID_BAR();
        if (STAGE >= 3) { rwkv_finalize(p, G); GRID_BAR(); }
    }
    if (STAGE >= 2) {
        pg8::Gemm g{(const bf16_t*)(p.ws + WS_YMIX), (const bf16_t*)(p.ws + WS_WOUT_T), D};
        pg8::DenseSched S; S.o.init(T / 256, D / 256, G, (int)blockIdx.x);
        EpiOutProj E{p.in[I_X], (const float*)(p.ws + WS_MOD), p.out};
        pg8::gemm_phase(lds, g, S, E);
        GRID_BAR();
    }
    if (STAGE >= 9) {
        phase_router(p, lds, G);
        GRID_BAR();
        phase_assign(p, lds, G);
        GRID_BAR();
        const int* tile = (const int*)(p.ws + WS_TILE);
        const int MT = tile[0];
        {
            pg8::Gemm g{(const bf16_t*)(p.ws + WS_PROJ), (const bf16_t*)(p.ws + WS_WG_T), D};
            pg8::MoeSched S; S.o.init(MT, 8, G, (int)blockIdx.x); S.tile_e = tile + 16; S.N = 2048;
            EpiMoe1 E{p.in[I_BGU], (bf16_t*)(p.ws + WS_ACT)};
            pg8::gemm_phase(lds, g, S, E);
        }
        GRID_BAR();
        {
            pg8::Gemm g{(const bf16_t*)(p.ws + WS_ACT), (const bf16_t*)(p.ws + WS_WD_T), D};
            pg8::MoeSched S; S.o.init(MT, 4, G, (int)blockIdx.x); S.tile_e = tile + 16; S.N = 1024;
            EpiMoe2 E{p.in[I_BDN], (bf16_t*)(p.ws + WS_PROJ)};
            pg8::gemm_phase(lds, g, S, E);
        }
        GRID_BAR();
    }
    phase_final(p, G, STAGE >= 9 ? 9 : (STAGE >= 2 ? 4 : 0));
}

extern "C" void kernel_launch(void* const* d_in, const int* in_sizes, int n_in, void* d_out, int out_size, void* d_ws, size_t ws_size, hipStream_t stream) {
    static int grid = 0;
    if (grid == 0) {
        if (n_in != 31 || out_size != T * D || ws_size < WS_END) { fprintf(stderr, "kernel_launch: unexpected shapes (n_in %d out %d ws %zu)\n", n_in, out_size, ws_size); grid = -1; return; }
        int dev = 0, cus = 0, per_cu = 0;
        hipGetDevice(&dev);
        hipDeviceGetAttribute(&cus, hipDeviceAttributeMultiprocessorCount, dev);
        hipFuncSetAttribute((const void*)hymba_fwd, hipFuncAttributeMaxDynamicSharedMemorySize, LDS_BYTES);
        hipOccupancyMaxActiveBlocksPerMultiprocessor(&per_cu, (const void*)hymba_fwd, NTHREADS, LDS_BYTES);
        if (per_cu < 1) { fprintf(stderr, "kernel_launch: occupancy query returned %d\n", per_cu); grid = -1; return; }
        grid = cus;
        if (grid > 256) grid = 256;
        while (T % grid != 0) --grid;
        (void)hipGetLastError();
    }
    if (grid < 0) return;
    hipMemsetAsync((char*)d_ws + WS_CTL, 0, CTL_BYTES, stream);
    Params p{};
    for (int i = 0; i < 31; ++i) p.in[i] = (const float*)d_in[i];
    p.out = (float*)d_out; p.ws = (unsigned char*)d_ws;
    void* args[] = {&p};
    hipError_t e = hipLaunchCooperativeKernel((const void*)hymba_fwd, dim3(grid), dim3(NTHREADS), args, LDS_BYTES, stream);
    if (e != hipSuccess) fprintf(stderr, "cooperative launch failed: %s (grid %d)\n", hipGetErrorString(e), grid);
}
```

```cpp
#include <hip/hip_runtime.h>
#include <hip/hip_cooperative_groups.h>
#include <cstdio>
#include <cstdint>
namespace cg = cooperative_groups;

#ifndef DBG_STAGE
#define DBG_STAGE 99
#endif

#define LAS __attribute__((address_space(3)))
typedef unsigned short bf16_t;
typedef short bf16x8 __attribute__((ext_vector_type(8)));
typedef short s16x4 __attribute__((ext_vector_type(4)));
typedef float f32x4 __attribute__((ext_vector_type(4)));
typedef float f32x16 __attribute__((ext_vector_type(16)));
typedef float f32x2_t __attribute__((ext_vector_type(2)));
typedef __bf16 bf16x2_t __attribute__((ext_vector_type(2)));
typedef unsigned u32x4 __attribute__((ext_vector_type(4)));
typedef unsigned u32x2 __attribute__((ext_vector_type(2)));

constexpr int D = 1024, NB = 8, SEQ = 4096, T = NB * SEQ;
constexpr int RW = 512, RC = 1792, DC = 1536, IC = 3328;
constexpr int NE = 32, TOPK = 4, NA = T * TOPK;
constexpr int PMAX = NA + NE * 256;
constexpr float NORM_EPS = 1e-5f, GN_EPS = 64e-5f;
constexpr float LOG2E = 1.4426950408889634f;
constexpr float QSCALE = 0.125f * LOG2E;
constexpr float LAMBDA_INIT = 0.2f;
constexpr int NTHREADS = 512, NWAVES = 8;
constexpr int LDS_BYTES = 163840;

constexpr size_t MiB = 1u << 20;
constexpr size_t WS_CTL = 0;
constexpr size_t CTL_BYTES = 65536;
constexpr size_t WS_MOD = 1 * MiB;
constexpr size_t WS_TILE = 1 * MiB + 512 * 1024;
constexpr size_t WS_WIN_T = 2 * MiB;
constexpr size_t WS_WOUT_T = 9 * MiB;
constexpr size_t WS_ROUTE = 11 * MiB;
constexpr size_t WS_WG_T = 16 * MiB;
constexpr size_t WS_WD_T = 144 * MiB;
constexpr size_t WS_H = 208 * MiB;
constexpr size_t WS_YMIX = 272 * MiB;
constexpr size_t WS_PROJ = 336 * MiB;
constexpr size_t WS_ACT = 608 * MiB;
constexpr size_t WS_END = 1008 * MiB;
constexpr int OPREC = 34816;
constexpr int OP_AT = 0, OP_RT = 4608, OP_BH = 9216, OP_KH = 13824, OP_BCT = 18432, OP_KCT = 23552, OP_VT = 28672, OP_P31 = 33792;
constexpr size_t WS_OPS = WS_ACT;
constexpr size_t WS_VS = 944 * MiB;
constexpr size_t WS_BON = WS_H;

__device__ __forceinline__ unsigned cvtpk(float lo, float hi) { f32x2_t v = {lo, hi}; bf16x2_t b = __builtin_convertvector(v, bf16x2_t); return __builtin_bit_cast(unsigned, b); }
__device__ __forceinline__ float bf2f(unsigned short u) { return __uint_as_float(((unsigned)u) << 16); }
__device__ __forceinline__ float wave_sum(float v) {
#pragma unroll
    for (int o = 1; o < 64; o <<= 1) v += __shfl_xor(v, o);
    return v;
}
__device__ __forceinline__ float wave_max(float v) {
#pragma unroll
    for (int o = 1; o < 64; o <<= 1) v = fmaxf(v, __shfl_xor(v, o));
    return v;
}
__device__ __forceinline__ int opaque_tid() { int t = (int)threadIdx.x; asm volatile("" : "+v"(t)); return t; }
__device__ __forceinline__ float sigmoidf_(float x) { return __builtin_amdgcn_rcpf(1.0f + __expf(-x)); }
__device__ __forceinline__ float tanh_fast(float x) { return 1.0f - 2.0f * __builtin_amdgcn_rcpf(1.0f + __expf(2.0f * x)); }

struct Params {
    const float* in[31];
    float* out;
    unsigned char* ws;
};
enum { I_X = 0, I_C, I_MODW, I_MODB, I_N1G, I_WIN, I_MU, I_W0, I_WUP, I_A0, I_AUP, I_GUP, I_KK, I_KA, I_RK, I_GNG, I_GNB, I_LQ1, I_LK1, I_LQ2, I_LK2, I_SUBLN, I_WOUT, I_N2G, I_RTW, I_RTB, I_WGU, I_BGU, I_WDN, I_BDN, I_FG };

namespace pg8 {
constexpr int BM = 256, BK = 64, HALF = 128, HTB = HALF * BK * 2, STAGE_BYTES = 8 * HTB, NXCD = 8, WGM = 8;
__host__ __device__ __forceinline__ int lds_byte(int r, int c) { const int st = (r >> 4) * 2 + (c >> 5), rr = r & 15, cc = c & 31, ob = rr * 64 + cc * 2; return st * 1024 + (ob ^ (((ob >> 9) & 1) << 5)); }
__host__ __device__ __forceinline__ void stage_rc(int b, int& R, int& C) { const int st = b / 1024, sb = b % 1024, swz = sb ^ (((sb >> 9) & 1) << 5); R = (st >> 1) * 16 + swz / 64; C = (st & 1) * 32 + (swz % 64) / 2; }
__host__ __device__ __forceinline__ int perm32(int rho) { const int n = rho >> 4, i = rho & 15; return 8 * (i >> 2) + 4 * n + (i & 3); }

struct Unit { int pm, pn, arow, brow, e; };
struct Gemm { const bf16_t* A; const bf16_t* Bt; int K; const int* rowmap; };

struct TileOrder {
    int nM, nN, nwg, G, c;
    __device__ void init(int nM_, int nN_, int G_, int c_) { nM = nM_; nN = nN_; nwg = nM * nN; G = G_; c = c_; }
    __device__ bool map(int i, int& pm, int& pn) const {
        const long L = (long)i * G + c; if (L >= nwg) return false;
        int wgid = (int)L; { const int q = nwg / NXCD, r = nwg % NXCD, xcd = wgid % NXCD, off = wgid / NXCD; wgid = (xcd < r ? xcd * (q + 1) : r * (q + 1) + (xcd - r) * q) + off; }
        const int nig = WGM * nN, gid = wgid / nig, fm = gid * WGM, gsz = (nM - fm) < WGM ? (nM - fm) : WGM;
        pm = fm + ((wgid % nig) % gsz); pn = (wgid % nig) / gsz; return true;
    }
};
struct DenseSched {
    TileOrder o;
    __device__ bool next(int i, Unit& u) const { int pm, pn; if (!o.map(i, pm, pn)) return false; u.pm = pm; u.pn = pn; u.arow = pm * BM; u.brow = pn * BM; u.e = 0; return true; }
};
struct MoeSched {
    TileOrder o; const int* tile_e; int N;
    __device__ bool next(int i, Unit& u) const { int pm, pn; if (!o.map(i, pm, pn)) return false; const int e = tile_e[pm]; u.pm = pm; u.pn = pn; u.arow = pm * BM; u.brow = e * N + pn * BM; u.e = e; return true; }
};

template <bool GATHER, class Epi, class Sched>
__device__ __forceinline__ void gemm_phase(LAS unsigned char* lds, const Gemm g, const Sched& S, const Epi& E) {
    const int tid = opaque_tid(), wid = __builtin_amdgcn_readfirstlane(tid >> 6), lane = tid & 63, wr = wid >> 2, wc = wid & 3, fr = lane & 15, fq = lane >> 4;
    const int K = g.K, nt = K / BK;
    unsigned voffA[2], voffB[2]; int rowA[2], colA2[2];
#pragma unroll
    for (int i = 0; i < 2; ++i) { int R, C; stage_rc(tid * 16 + i * 8192, R, C); const int Rb = (R & ~31) + perm32(R & 31);
        voffA[i] = (unsigned)(R * K + C) * 2u; voffB[i] = (unsigned)(Rb * K + C) * 2u; rowA[i] = R; colA2[i] = C * 2; }
    unsigned gv0[2] = {0u, 0u}, gv1[2] = {0u, 0u}, gn0[2] = {0u, 0u}, gn1[2] = {0u, 0u};
#define PG8_GOFF(u_, o0, o1) do { _Pragma("unroll") for (int _i = 0; _i < 2; ++_i) { o0[_i] = (unsigned)g.rowmap[(u_).arow + rowA[_i]] * (unsigned)(K * 2) + (unsigned)colA2[_i]; o1[_i] = (unsigned)g.rowmap[(u_).arow + HALF + rowA[_i]] * (unsigned)(K * 2) + (unsigned)colA2[_i]; } } while (0)
#define PG8_STAGE_A(bufoff, kptr, half) do { if constexpr (GATHER) { if (half) PG8_STAGE(bufoff, kptr, gv1); else PG8_STAGE(bufoff, kptr, gv0); } else PG8_STAGE(bufoff, (kptr) + ((half) ? hstep : 0), voffA); } while (0)
    const size_t kstep = (size_t)(BK * 2);
    const size_t hstep = (size_t)HALF * K * 2;
    const size_t rowb = (size_t)K * 2;
    const unsigned ldsw = (unsigned)wid * 1024u;
    const int aoff = lds_byte(wr * 64 + fr, fq * 8), boff = lds_byte(wc * 32 + fr, fq * 8);
#define PG8_SA(b, h) (((b) * 2 + (h)) * HTB)
#define PG8_SB(b, h) ((4 + (b) * 2 + (h)) * HTB)
#define PG8_STAGE(bufoff, gbase, voff) do { _Pragma("unroll") for (int _i = 0; _i < 2; ++_i) \
        __builtin_amdgcn_global_load_lds((const unsigned*)((const char*)(gbase) + (voff)[_i]), (LAS unsigned*)(lds + (bufoff) + ldsw + _i * 8192), 16, 0, 0); } while (0)
#define PG8_LDA(dst, b, h) do { _Pragma("unroll") for (int m = 0; m < 4; ++m) _Pragma("unroll") for (int k = 0; k < 2; ++k) dst[m][k] = *(const LAS bf16x8*)(lds + PG8_SA(b, h) + aoff + m * 2048 + k * 1024); } while (0)
#define PG8_LDB(dst, b, h) do { _Pragma("unroll") for (int n = 0; n < 2; ++n) _Pragma("unroll") for (int k = 0; k < 2; ++k) dst[n][k] = *(const LAS bf16x8*)(lds + PG8_SB(b, h) + boff + n * 2048 + k * 1024); } while (0)
#define PG8_MMA(ai, bj, At, Bt) do { __builtin_amdgcn_s_setprio(1); _Pragma("unroll") for (int m = 0; m < 4; ++m) _Pragma("unroll") for (int n = 0; n < 2; ++n) _Pragma("unroll") for (int k = 0; k < 2; ++k) \
        acc[ai][bj][m][n] = __builtin_amdgcn_mfma_f32_16x16x32_bf16(Bt[n][k], At[m][k], acc[ai][bj][m][n], 0, 0, 0); __builtin_amdgcn_s_setprio(0); } while (0)
#define PG8_WAIT_V(n) asm volatile("s_waitcnt vmcnt(" #n ")" ::: "memory")
#define PG8_WAIT_L(n) asm volatile("s_waitcnt lgkmcnt(" #n ")" ::: "memory")
#define PG8_BAR __builtin_amdgcn_s_barrier()
#define PG8_SCHED __builtin_amdgcn_sched_barrier(0)
    Unit cur, nxt; int ui = 0;
    if (!S.next(0, cur)) return;
    f32x4 acc[2][2][4][2];
#pragma unroll
    for (int a = 0; a < 2; ++a)
#pragma unroll
        for (int b = 0; b < 2; ++b)
#pragma unroll
            for (int m = 0; m < 4; ++m)
#pragma unroll
                for (int n = 0; n < 2; ++n) acc[a][b][m][n] = (f32x4){0.f, 0.f, 0.f, 0.f};
    bf16x8 At[4][2], B0[2][2], B1[2][2];
    const char* cA = GATHER ? (const char*)g.A : (const char*)g.A + (size_t)cur.arow * rowb; const char* cB = (const char*)g.Bt + (size_t)cur.brow * rowb;
    if constexpr (GATHER) PG8_GOFF(cur, gv0, gv1);
    PG8_STAGE(PG8_SB(0, 0), cB, voffB); PG8_STAGE(PG8_SB(0, 1), cB + hstep, voffB); PG8_STAGE_A(PG8_SA(0, 0), cA, 0); PG8_STAGE_A(PG8_SA(0, 1), cA, 1);
    if (wr == 1) PG8_BAR;
    PG8_WAIT_V(2); PG8_BAR;
    PG8_STAGE(PG8_SB(1, 0), cB + kstep, voffB); PG8_STAGE_A(PG8_SA(1, 0), cA + kstep, 0); PG8_STAGE(PG8_SB(1, 1), cB + hstep + kstep, voffB);
    PG8_WAIT_V(6); PG8_BAR;
    for (;;) {
        const bool has_next = S.next(ui + 1, nxt);
        const char* nA = GATHER ? (const char*)g.A : (has_next ? (const char*)g.A + (size_t)nxt.arow * rowb : cA); const char* nB = has_next ? (const char*)g.Bt + (size_t)nxt.brow * rowb : cB;

        for (int t = 0; t < nt; t += 2) {
            const bool last = (t == nt - 2);
            if constexpr (GATHER) { if (t == nt - 4) { if (has_next) PG8_GOFF(nxt, gn0, gn1); else { gn0[0] = gv0[0]; gn0[1] = gv0[1]; gn1[0] = gv1[0]; gn1[1] = gv1[1]; } } }
            const char* a1 = cA + (size_t)(t + 1) * kstep;
            const char* a2 = last ? nA : cA + (size_t)(t + 2) * kstep; const char* b2 = last ? nB : cB + (size_t)(t + 2) * kstep;
            const char* a3 = a2 + kstep; const char* b3 = b2 + kstep;
            PG8_LDB(B0, 0, 0); PG8_LDB(B1, 0, 1); PG8_SCHED; PG8_LDA(At, 0, 0); PG8_STAGE_A(PG8_SA(1, 1), a1, 1);
            if constexpr (GATHER) { if (last) { gv0[0] = gn0[0]; gv0[1] = gn0[1]; gv1[0] = gn1[0]; gv1[1] = gn1[1]; } }
            PG8_WAIT_V(8); PG8_WAIT_L(0); PG8_BAR; PG8_MMA(0, 0, At, B0); PG8_MMA(0, 1, At, B1); PG8_BAR; PG8_SCHED;
            PG8_LDA(At, 0, 1); PG8_STAGE(PG8_SB(0, 0), b2, voffB); PG8_STAGE(PG8_SB(0, 1), b2 + hstep, voffB); PG8_STAGE_A(PG8_SA(0, 0), a2, 0);
            PG8_WAIT_V(8); PG8_WAIT_L(0); PG8_BAR; PG8_MMA(1, 0, At, B0); PG8_MMA(1, 1, At, B1); PG8_BAR; PG8_SCHED;
            PG8_LDB(B0, 1, 0); PG8_LDB(B1, 1, 1); PG8_SCHED; PG8_LDA(At, 1, 0); PG8_STAGE_A(PG8_SA(0, 1), a2, 1);
            PG8_WAIT_V(8); PG8_WAIT_L(0); PG8_BAR; PG8_MMA(0, 0, At, B0); PG8_MMA(0, 1, At, B1); PG8_BAR; PG8_SCHED;
            PG8_LDA(At, 1, 1); PG8_STAGE(PG8_SB(1, 0), b3, voffB); PG8_STAGE(PG8_SB(1, 1), b3 + hstep, voffB); PG8_STAGE_A(PG8_SA(1, 0), a3, 0);
            PG8_WAIT_V(8); PG8_WAIT_L(0); PG8_BAR; PG8_MMA(1, 0, At, B0); PG8_MMA(1, 1, At, B1); PG8_BAR; PG8_SCHED;
        }
        if (wr == 0) PG8_BAR;
        E(acc, cur, wr, wc, fr, fq);
        if (!has_next) break;
#pragma unroll
        for (int a = 0; a < 2; ++a)
#pragma unroll
            for (int b = 0; b < 2; ++b)
#pragma unroll
                for (int m = 0; m < 4; ++m)
#pragma unroll
                    for (int n = 0; n < 2; ++n) acc[a][b][m][n] = (f32x4){0.f, 0.f, 0.f, 0.f};
        cur = nxt; cA = nA; cB = nB; ++ui;
        if (wr == 1) PG8_BAR;
    }
    PG8_WAIT_V(0);
    PG8_BAR;
#undef PG8_SA
#undef PG8_SB
#undef PG8_STAGE
#undef PG8_STAGE_A
#undef PG8_GOFF
#undef PG8_LDA
#undef PG8_LDB
#undef PG8_MMA
#undef PG8_WAIT_V
#undef PG8_WAIT_L
#undef PG8_BAR
#undef PG8_SCHED
}
}

struct EpiInProj {
    bf16_t* O;
    __device__ __forceinline__ void operator()(const f32x4 (&acc)[2][2][4][2], const pg8::Unit& u, int wr, int wc, int fr, int fq) const {
        const int row0 = u.pm * 256 + wr * 64 + fr, col0 = u.pn * 256 + wc * 32 + 8 * fq;
        const float sc = (u.pn == 7 || u.pn == 8) ? QSCALE : 1.0f;
#pragma unroll
        for (int ai = 0; ai < 2; ++ai)
#pragma unroll
            for (int m = 0; m < 4; ++m) { bf16_t* rowp = O + (size_t)(row0 + ai * 128 + m * 16) * IC + col0;
#pragma unroll
                for (int bj = 0; bj < 2; ++bj) { const f32x4 v0 = acc[ai][bj][m][0] * sc, v1 = acc[ai][bj][m][1] * sc;
                    u32x4 w; w.x = cvtpk(v0[0], v0[1]); w.y = cvtpk(v0[2], v0[3]); w.z = cvtpk(v1[0], v1[1]); w.w = cvtpk(v1[2], v1[3]);
                    *(u32x4*)(rowp + bj * 128) = w; } }
    }
};
struct EpiOutProj {
    const float* x; const float* mod; float* O;
    __device__ __forceinline__ void operator()(const f32x4 (&acc)[2][2][4][2], const pg8::Unit& u, int wr, int wc, int fr, int fq) const {
        const int row0 = u.pm * 256 + wr * 64 + fr, col0 = u.pn * 256 + wc * 32 + 8 * fq;
        const int b = (u.pm * 256) / SEQ;
        const float* g1 = mod + b * 6144 + 2048;
        f32x4 gv[2][2];
#pragma unroll
        for (int bj = 0; bj < 2; ++bj)
#pragma unroll
            for (int n = 0; n < 2; ++n) gv[bj][n] = *(const f32x4*)(g1 + col0 + bj * 128 + 4 * n);
#pragma unroll
        for (int ai = 0; ai < 2; ++ai)
#pragma unroll
            for (int m = 0; m < 4; ++m) { const size_t off = (size_t)(row0 + ai * 128 + m * 16) * D + col0;
#pragma unroll
                for (int bj = 0; bj < 2; ++bj)
#pragma unroll
                    for (int n = 0; n < 2; ++n) { const f32x4 xv = *(const f32x4*)(x + off + bj * 128 + 4 * n);
                        *(f32x4*)(O + off + bj * 128 + 4 * n) = xv + gv[bj][n] * acc[ai][bj][m][n]; } }
    }
};
struct EpiMoe1 {
    const float* bgu; bf16_t* O;
    __device__ __forceinline__ void operator()(const f32x4 (&acc)[2][2][4][2], const pg8::Unit& u, int wr, int wc, int fr, int fq) const {
        const int row0 = u.pm * 256 + wr * 64 + fr, col0 = u.pn * 128 + wc * 32 + 8 * fq;
        const float* bg = bgu + (size_t)u.e * 2048 + col0;
        f32x4 bgv[2], buv[2];
#pragma unroll
        for (int n = 0; n < 2; ++n) { bgv[n] = *(const f32x4*)(bg + 4 * n); buv[n] = *(const f32x4*)(bg + 1024 + 4 * n); }
#pragma unroll
        for (int ai = 0; ai < 2; ++ai)
#pragma unroll
            for (int m = 0; m < 4; ++m) { float a[8];
#pragma unroll
                for (int n = 0; n < 2; ++n) { const f32x4 gt = acc[ai][0][m][n] + bgv[n], up = acc[ai][1][m][n] + buv[n];
#pragma unroll
                    for (int j = 0; j < 4; ++j) { const float gg = fminf(gt[j], 7.0f), uu = fminf(fmaxf(up[j], -7.0f), 7.0f);
                        a[4 * n + j] = (uu + 1.0f) * (gg * __builtin_amdgcn_rcpf(1.0f + __builtin_amdgcn_exp2f(-1.702f * LOG2E * gg))); } }
                u32x4 w; w.x = cvtpk(a[0], a[1]); w.y = cvtpk(a[2], a[3]); w.z = cvtpk(a[4], a[5]); w.w = cvtpk(a[6], a[7]);
                *(u32x4*)(O + (size_t)(row0 + ai * 128 + m * 16) * 1024 + col0) = w; }
    }
};
struct EpiMoe2 {
    const float* bdn; bf16_t* O;
    __device__ __forceinline__ void operator()(const f32x4 (&acc)[2][2][4][2], const pg8::Unit& u, int wr, int wc, int fr, int fq) const {
        const int row0 = u.pm * 256 + wr * 64 + fr, col0 = u.pn * 256 + wc * 32 + 8 * fq;
        const float* bd = bdn + (size_t)u.e * 1024 + col0;
        f32x4 bv[2][2];
#pragma unroll
        for (int bj = 0; bj < 2; ++bj)
#pragma unroll
            for (int n = 0; n < 2; ++n) bv[bj][n] = *(const f32x4*)(bd + bj * 128 + 4 * n);
#pragma unroll
        for (int ai = 0; ai < 2; ++ai)
#pragma unroll
            for (int m = 0; m < 4; ++m) { bf16_t* rowp = O + (size_t)(row0 + ai * 128 + m * 16) * 1024 + col0;
#pragma unroll
                for (int bj = 0; bj < 2; ++bj) { const f32x4 v0 = acc[ai][bj][m][0] + bv[bj][0], v1 = acc[ai][bj][m][1] + bv[bj][1];
                    u32x4 w; w.x = cvtpk(v0[0], v0[1]); w.y = cvtpk(v0[2], v0[3]); w.z = cvtpk(v1[0], v1[1]); w.w = cvtpk(v1[2], v1[3]);
                    *(u32x4*)(rowp + bj * 128) = w; } }
    }
};

__device__ __forceinline__ void phase_mod(const Params& p, unsigned char* lds, int G) {
    const int tid = opaque_tid(), lane = tid & 63, wave = tid >> 6;
    float* sc = (float*)lds;
    const float* c = p.in[I_C];
    for (int i = tid; i < 8192; i += NTHREADS) { const int b = i & 7, k = i >> 3; const float cv = c[b * 1024 + k]; sc[k * 8 + b] = cv / (1.0f + __expf(-cv)); }
    __syncthreads();
    float* mod = (float*)(p.ws + WS_MOD);
    const float* mw = p.in[I_MODW]; const float* mb = p.in[I_MODB];
    for (int item = wave * G + (int)blockIdx.x; item < 192; item += NWAVES * G) {
        const int col = item * 32 + (lane & 31), kh = lane >> 5;
        float acc[8];
#pragma unroll
        for (int b = 0; b < 8; ++b) acc[b] = 0.f;
        const float* wp = mw + (size_t)(kh * 512) * 6144 + col;
        const float* sp = sc + (kh * 512) * 8;
#pragma unroll 8
        for (int k = 0; k < 512; ++k) { const float wv = wp[(size_t)k * 6144]; const f32x4 s0 = *(const f32x4*)(sp + k * 8), s1 = *(const f32x4*)(sp + k * 8 + 4);
            acc[0] += s0[0] * wv; acc[1] += s0[1] * wv; acc[2] += s0[2] * wv; acc[3] += s0[3] * wv; acc[4] += s1[0] * wv; acc[5] += s1[1] * wv; acc[6] += s1[2] * wv; acc[7] += s1[3] * wv; }
#pragma unroll
        for (int b = 0; b < 8; ++b) acc[b] += __shfl_xor(acc[b], 32);
        if (lane < 32) {
            const float bias = mb[col];
#pragma unroll
            for (int b = 0; b < 8; ++b) mod[b * 6144 + col] = acc[b] + bias;
        }
    }
    __syncthreads();
}
__device__ __forceinline__ void transpose_item(const float* W, int N, int k0, int n0, bf16_t* WT, int Kdst, int dst_row_base, bool gu_interleave, float* scr, int lane) {
#pragma unroll 4
    for (int i = 0; i < 16; ++i) { const int row = 4 * i + (lane >> 4), c4 = lane & 15;
        const f32x4 v = *(const f32x4*)(W + (size_t)(k0 + row) * N + n0 + 4 * c4);
        float* s = scr + row * 65 + 4 * c4; s[0] = v[0]; s[1] = v[1]; s[2] = v[2]; s[3] = v[3]; }
    asm volatile("s_waitcnt lgkmcnt(0)" ::: "memory");
    const int cch = lane & 7;
#pragma unroll
    for (int i = 0; i < 8; ++i) { const int n = 8 * i + (lane >> 3); const float* s = scr + (8 * cch) * 65 + n;
        u32x4 o; o.x = cvtpk(s[0], s[65]); o.y = cvtpk(s[2 * 65], s[3 * 65]); o.z = cvtpk(s[4 * 65], s[5 * 65]); o.w = cvtpk(s[6 * 65], s[7 * 65]);
        int nn = n0 + n;
        if (gu_interleave) nn = (nn < 1024) ? ((nn >> 7) * 256 + (nn & 127)) : (((nn - 1024) >> 7) * 256 + 128 + ((nn - 1024) & 127));
        *(u32x4*)(WT + (size_t)(dst_row_base + nn) * Kdst + k0 + 8 * cch) = o; }
    asm volatile("s_waitcnt lgkmcnt(0)" ::: "memory");
}
__device__ __forceinline__ void phase_convert(const Params& p, unsigned char* lds, int G) {
    const int tid = opaque_tid(), lane = tid & 63, wave = tid >> 6;
    float* scr = (float*)lds + wave * (64 * 65);
    const int gw = (int)blockIdx.x * NWAVES + wave, NGW = G * NWAVES;
    constexpr int I_IN = 16 * 52, I_OUT = 16 * 16, I_GU = 32 * 16 * 32, I_DN = 32 * 16 * 16, NITEMS = I_IN + I_OUT + I_GU + I_DN;
    bf16_t* win_t = (bf16_t*)(p.ws + WS_WIN_T); bf16_t* wout_t = (bf16_t*)(p.ws + WS_WOUT_T); bf16_t* wg_t = (bf16_t*)(p.ws + WS_WG_T); bf16_t* wd_t = (bf16_t*)(p.ws + WS_WD_T);
    for (int it = gw; it < NITEMS; it += NGW) {
        int r = it;
        if (r < I_IN) { transpose_item(p.in[I_WIN], IC, (r / 52) * 64, (r % 52) * 64, win_t, 1024, 0, false, scr, lane); continue; } r -= I_IN;
        if (r < I_OUT) { transpose_item(p.in[I_WOUT], D, (r / 16) * 64, (r % 16) * 64, wout_t, 1024, 0, false, scr, lane); continue; } r -= I_OUT;
        if (r < I_GU) { const int e = r / 512, rr = r % 512; transpose_item(p.in[I_WGU] + (size_t)e * 1024 * 2048, 2048, (rr / 32) * 64, (rr % 32) * 64, wg_t, 1024, e * 2048, true, scr, lane); continue; } r -= I_GU;
        { const int e = r / 256, rr = r % 256; transpose_item(p.in[I_WDN] + (size_t)e * 1024 * 1024, 1024, (rr / 16) * 64, (rr % 16) * 64, wd_t, 1024, e * 1024, false, scr, lane); }
    }
}

__device__ __forceinline__ void phase_norm1(const Params& p, int G) {
    const int tid = opaque_tid(), lane = tid & 63, wave = tid >> 6;
    const int gw = (int)blockIdx.x * NWAVES + wave, NGW = G * NWAVES;
    const float* x = p.in[I_X]; const float* gain = p.in[I_N1G]; const float* mod = (const float*)(p.ws + WS_MOD);
    bf16_t* h = (bf16_t*)(p.ws + WS_H);
    for (int row = gw; row < T; row += NGW) {
        const int b = row / SEQ;
        const f32x4* xr = (const f32x4*)(x + (size_t)row * D) + lane;
        f32x4 v[4]; float s = 0.f;
#pragma unroll
        for (int j = 0; j < 4; ++j) { v[j] = xr[64 * j]; s += (v[j][0] * v[j][0] + v[j][1] * v[j][1]) + (v[j][2] * v[j][2] + v[j][3] * v[j][3]); }
        const float rstd = rsqrtf(wave_sum(s) * (1.0f / D) + NORM_EPS);
        const float* sh = mod + b * 6144; const float* scl = mod + b * 6144 + 1024;
        unsigned long long* o8 = (unsigned long long*)(h + (size_t)row * D) + lane;
#pragma unroll
        for (int j = 0; j < 4; ++j) { const int k = 4 * lane + 256 * j;
            const f32x4 g = *(const f32x4*)(gain + k), s1 = *(const f32x4*)(scl + k), s0 = *(const f32x4*)(sh + k);
            const f32x4 y = (v[j] * rstd) * g * (s1 + 1.0f) + s0;
            o8[64 * j] = (unsigned long long)cvtpk(y[0], y[1]) | ((unsigned long long)cvtpk(y[2], y[3]) << 32); }
    }
}

constexpr size_t CTL_KMAX = 57344;
__device__ __forceinline__ void kmax_pass(const Params& p, int G) {
    const int tid = opaque_tid(), lane = tid & 63, wave = tid >> 6;
    const bf16_t* proj = (const bf16_t*)(p.ws + WS_PROJ);
    unsigned* km = (unsigned*)(p.ws + WS_CTL + CTL_KMAX);
    const int TPB = T / G;
    float mx = 0.f; const int tok0 = (int)blockIdx.x * TPB;
    for (int ti = wave; ti < TPB; ti += NWAVES) {
        const u32x4 kv = *(const u32x4*)(proj + (size_t)(tok0 + ti) * IC + RC + 512 + 8 * lane);
        float ss = 0.f;
#pragma unroll
        for (int j = 0; j < 4; ++j) { const float a = __uint_as_float(kv[j] << 16), bq = __uint_as_float(kv[j] & 0xffff0000u); ss += a * a + bq * bq; }
        ss += __shfl_xor(ss, 1); ss += __shfl_xor(ss, 2); ss += __shfl_xor(ss, 4);
        mx = fmaxf(mx, ss);
    }
    if ((lane & 7) == 0) atomicMax(km + (tok0 / SEQ) * 8 + (lane >> 3), __float_as_uint(mx));
}

__device__ __forceinline__ s16x4 vtr(const LAS unsigned char* pp) { typedef short v4i16_t __attribute__((ext_vector_type(4))); return __builtin_bit_cast(s16x4, __builtin_amdgcn_ds_read_tr16_b64_v4i16((LAS v4i16_t*)pp)); }
constexpr int ATT_BUF = 32768;
__device__ __forceinline__ float att_max3(float a, float b, float c) { float r; asm("v_max3_f32 %0, %1, %2, %3" : "=v"(r) : "v"(a), "v"(b), "v"(c)); return r; }
constexpr int ATT_QROWS = 128, ATT_NQB = SEQ / ATT_QROWS, ATT_UNITS = NB * 4 * ATT_NQB;
__device__ __forceinline__ void attn_unit(const Params& p, LAS unsigned char* lds, int b, int h, int qb, float lam) {
    const int tid = opaque_tid(), lane = tid & 63, wid = __builtin_amdgcn_readfirstlane(tid >> 6), r32 = lane & 31, hi = lane >> 5;
    const int c = wid & 1, qblk = wid >> 1;
    const bf16_t* proj = (const bf16_t*)(p.ws + WS_PROJ) + (size_t)b * SEQ * IC;
    const int q0 = qb * ATT_QROWS, qw0 = q0 + 32 * qblk;
    const bf16_t* Qb = proj + RC + h * 128 + c * 64;
    const bf16_t* Kb = proj + RC + 512 + h * 128;
    const bf16_t* Vb = proj + RC + 1024 + h * 128;
    const float slope = exp2f(-2.0f * (float)(h + 1)) * LOG2E;
    f32x16 o[4];
#pragma unroll
    for (int d = 0; d < 4; ++d) o[d] = f32x16{};
    f32x16 cb0;
#pragma unroll
    for (int r = 0; r < 16; ++r) cb0[r] = slope * (float)((r & 3) + 8 * (r >> 2) + 4 * hi);
    const float c32 = slope * 32.0f;
    float m_ = 0.f, l_ = 0.f;
    const int NT = (q0 + ATT_QROWS) / 64;
    const bf16_t* ksrc = Kb + (size_t)lane * IC + wid * 8;
    const int p0i = wid, p1i = wid + 8;
    const bf16_t* vsrc0 = Vb + (size_t)(16 * (p0i & 3) + (lane >> 2)) * IC + (p0i >> 2) * 32 + (lane & 3) * 8;
    const bf16_t* vsrc1 = Vb + (size_t)(16 * (p1i & 3) + (lane >> 2)) * IC + (p1i >> 2) * 32 + (lane & 3) * 8;
#define ATT_GLDS(gsrc_, ldsdst_) do { unsigned keep_; asm volatile("s_mov_b32 %0, m0\n\ts_mov_b32 m0, %2\n\ts_nop 0\n\tglobal_load_lds_dwordx4 %1, off\n\ts_mov_b32 m0, %0" : "=&s"(keep_) : "v"(gsrc_), "s"(ldsdst_) : "memory"); } while (0)
    const unsigned lds0 = (unsigned)(uintptr_t)lds;
#define ATT_DMA(t, buf) do { const size_t ro = (size_t)(t) * 64 * IC; const unsigned bb_ = (unsigned)__builtin_amdgcn_readfirstlane((int)(lds0 + (buf) * ATT_BUF + wid * 1024)); \
        ATT_GLDS(ksrc + ro, bb_); ATT_GLDS(ksrc + ro + 64, bb_ + 8192u); ATT_GLDS(vsrc0 + ro, bb_ + 16384u); ATT_GLDS(vsrc1 + ro, bb_ + 16384u + 8192u); } while (0)
    ATT_DMA(NT - 1, 0); ATT_DMA(NT - 2, 1);
    bf16x8 qr[4];
#pragma unroll
    for (int d0 = 0; d0 < 4; ++d0) qr[d0] = *(const bf16x8*)(Qb + (size_t)(qw0 + r32) * IC + d0 * 16 + hi * 8);
    float qn;
    { float q2 = 0.f;
#pragma unroll
      for (int d0 = 0; d0 < 4; ++d0)
#pragma unroll
          for (int j = 0; j < 8; ++j) { const float x = bf2f((unsigned short)qr[d0][j]); q2 += x * x; }
      q2 += __shfl_xor(q2, 32);
      qn = sqrtf(q2 * ((const float*)(p.ws + WS_CTL + CTL_KMAX))[b * 8 + h * 2 + c]) * 1.002f + 0.01f; }
    asm volatile("" : "+v"(qr[0]), "+v"(qr[1]), "+v"(qr[2]), "+v"(qr[3]));
    asm volatile("s_waitcnt vmcnt(0)" ::: "memory");
    __builtin_amdgcn_s_barrier();
    const int voff = ((lane >> 4) & 1) * 32 + (lane & 3) * 8 + (4 * hi + ((lane & 15) >> 2)) * 64;
    const int qpos = qw0 + r32;
    const bool late = wid >= 4;
    bf16x8 pf[4]; bool pend = false;
    float mtrue = -INFINITY;
    LAS unsigned* vote = (LAS unsigned*)(lds + 4 * ATT_BUF + 64);
#define ATT_PV(slot_) do { const LAS unsigned char* vb_ = lds + (slot_) * ATT_BUF + 16384 + voff; \
        _Pragma("unroll") for (int dblk = 0; dblk < 4; ++dblk) { _Pragma("unroll") for (int ks = 0; ks < 4; ++ks) { \
            const s16x4 lo = vtr(vb_ + (dblk * 4 + ks) * 1024), hh = vtr(vb_ + (dblk * 4 + ks) * 1024 + 512); \
            const bf16x8 vf = (bf16x8){lo[0], lo[1], lo[2], lo[3], hh[0], hh[1], hh[2], hh[3]}; \
            o[dblk] = __builtin_amdgcn_mfma_f32_32x32x16_bf16(vf, pf[ks], o[dblk], 0, 0, 0); } } } while (0)
    int it = 0;
    for (; it < NT; ++it) {
        const int kt = NT - 1 - it, cur = it & 3;
        const bool issued = (it + 2 < NT);
        if (issued) ATT_DMA(kt - 2, (it + 2) & 3);
        const int k0 = kt * 64;
        if (late && pend) { ATT_PV((it - 1) & 3); pend = false; }
        if (k0 <= qw0 + 31) {
            const LAS unsigned char* bb = lds + cur * ATT_BUF;
            const bool need_mask = (k0 + 63 > qw0);
            const LAS unsigned char* kb = bb + c * 8192 + hi * 1024 + r32 * 16;
            f32x16 s0 = cb0, s1 = cb0;
#pragma unroll
            for (int d0 = 0; d0 < 4; ++d0) {
                const bf16x8 a0 = *(const LAS bf16x8*)(kb + d0 * 2048), a1 = *(const LAS bf16x8*)(kb + d0 * 2048 + 512);
                s0 = __builtin_amdgcn_mfma_f32_32x32x16_bf16(a0, qr[d0], s0, 0, 0, 0);
                s1 = __builtin_amdgcn_mfma_f32_32x32x16_bf16(a1, qr[d0], s1, 0, 0, 0);
            }
            if (need_mask) {
                const int dq = k0 - qpos + 4 * hi;
#pragma unroll
                for (int r = 0; r < 16; ++r) { if (dq + ((r & 3) + 8 * (r >> 2)) > 0) s0[r] = -INFINITY; if (dq + ((r & 3) + 8 * (r >> 2)) + 32 > 0) s1[r] = -INFINITY; }
            }
            const float tb = slope * (float)(k0 - qpos);
            float rm0 = att_max3(s0[0], s0[1], s0[2]), rm1 = att_max3(s1[0], s1[1], s1[2]);
#pragma unroll
            for (int r = 3; r < 15; r += 2) { rm0 = att_max3(rm0, s0[r], s0[r + 1]); rm1 = att_max3(rm1, s1[r], s1[r + 1]); }
            float rm = att_max3(rm0, s0[15], att_max3(rm1, s1[15], -INFINITY) + c32);
            rm += tb;
            rm = fmaxf(rm, __shfl_xor(rm, 32));
            mtrue = fmaxf(mtrue, rm);
            if (__any(rm > m_ + 8.0f)) {
                const float mn = fmaxf(m_, rm);
                const float alpha = __builtin_amdgcn_exp2f(m_ - mn);
                m_ = mn; l_ *= alpha;
#pragma unroll
                for (int d = 0; d < 4; ++d)
#pragma unroll
                    for (int r = 0; r < 16; ++r) o[d][r] *= alpha;
            }
            const float off = tb - m_, off1 = off + c32;
            float ps = 0.f;
#pragma unroll
            for (int r = 0; r < 16; ++r) { s0[r] = __builtin_amdgcn_exp2f(s0[r] + off); s1[r] = __builtin_amdgcn_exp2f(s1[r] + off1); ps += s0[r] + s1[r]; }
            l_ += ps;
#pragma unroll
            for (int ks = 0; ks < 2; ++ks) {
                u32x4 w0, w1;
                w0.x = cvtpk(s0[8 * ks + 0], s0[8 * ks + 1]); w0.y = cvtpk(s0[8 * ks + 2], s0[8 * ks + 3]); w0.z = cvtpk(s0[8 * ks + 4], s0[8 * ks + 5]); w0.w = cvtpk(s0[8 * ks + 6], s0[8 * ks + 7]);
                w1.x = cvtpk(s1[8 * ks + 0], s1[8 * ks + 1]); w1.y = cvtpk(s1[8 * ks + 2], s1[8 * ks + 3]); w1.z = cvtpk(s1[8 * ks + 4], s1[8 * ks + 5]); w1.w = cvtpk(s1[8 * ks + 6], s1[8 * ks + 7]);
                pf[ks] = __builtin_bit_cast(bf16x8, w0); pf[2 + ks] = __builtin_bit_cast(bf16x8, w1);
            }
            if (late) pend = true; else ATT_PV(cur);
        }
        { const bool neg = (qn + slope * (float)(k0 - 1 - qpos) <= mtrue - 50.0f);
          if (lane == 0) vote[(it & 1) * 8 + wid] = __all(neg) ? 1u : 0u; }
        if (issued) asm volatile("s_waitcnt vmcnt(4)" ::: "memory"); else asm volatile("s_waitcnt vmcnt(0)" ::: "memory");
        asm volatile("s_waitcnt lgkmcnt(0)" ::: "memory");
        __builtin_amdgcn_s_barrier();
        { const u32x4 va = *(const LAS u32x4*)(vote + (it & 1) * 8), vb2 = *(const LAS u32x4*)(vote + (it & 1) * 8 + 4);
          if ((va.x & va.y & va.z & va.w & vb2.x & vb2.y & vb2.z & vb2.w) != 0u) { ++it; break; } }
    }
    if (late && pend) ATT_PV((it - 1) & 3);
    asm volatile("s_waitcnt vmcnt(0) lgkmcnt(0)" ::: "memory");
    __builtin_amdgcn_s_barrier();
#undef ATT_PV
#undef ATT_DMA
#undef ATT_GLDS
    l_ += __shfl_xor(l_, 32);
    LAS float* xb = (LAS float*)(lds + qblk * 16384);
    if (c == 1) {
        const float i1 = lam / l_;
#pragma unroll
        for (int d = 0; d < 4; ++d)
#pragma unroll
            for (int r = 0; r < 16; ++r) xb[(d * 16 + r) * 64 + lane] = o[d][r] * i1;
    }
    __syncthreads();
    if (c == 0) {
        const float i0 = 1.0f / l_;
        float ss = 0.f;
#pragma unroll
        for (int d = 0; d < 4; ++d)
#pragma unroll
            for (int r = 0; r < 16; ++r) { const float v = o[d][r] * i0 - xb[(d * 16 + r) * 64 + lane]; o[d][r] = v; ss += v * v; }
        ss += __shfl_xor(ss, 32);
        const float rstd = rsqrtf(ss * (1.0f / 128.0f) + NORM_EPS) * (1.0f - LAMBDA_INIT);
        const float* sg = p.in[I_SUBLN];
        bf16_t* yo = (bf16_t*)(p.ws + WS_YMIX) + (size_t)(b * SEQ + qw0 + r32) * D + RW + h * 128;
#pragma unroll
        for (int d = 0; d < 4; ++d)
#pragma unroll
            for (int g = 0; g < 4; ++g) { const int dd = 32 * d + 8 * g + 4 * hi; const f32x4 gv = *(const f32x4*)(sg + dd);
                u32x2 w; w.x = cvtpk(o[d][4 * g] * rstd * gv[0], o[d][4 * g + 1] * rstd * gv[1]); w.y = cvtpk(o[d][4 * g + 2] * rstd * gv[2], o[d][4 * g + 3] * rstd * gv[3]);
                *(u32x2*)(yo + dd) = w; }
    }
    __syncthreads();
}

constexpr int RCH = 32;
constexpr int RK_R = 0, RK_KM = 8192, RK_DEC = 16384, RK_KK = 24576, RK_BB = 32768, RK_VV = 40960, RK_GG = 49152;
constexpr int RK_AW = 57344;
constexpr int RK_AA = RK_AW + 4608;
constexpr int RK_AG = RK_AA + 4608;
constexpr int RK_BON = RK_AG + 8704;
constexpr int RK_MU = RK_BON + 128;
constexpr int RK_RAW = 77824;
constexpr int RK_IM = RK_RAW + 33 * 1024;
constexpr int RK_LSEG = RK_IM + OPREC;
constexpr int RK_END = RK_LSEG + 2048;
static_assert(RK_MU + 1792 <= RK_RAW && RK_END <= LDS_BYTES - 64 && (RK_RAW % 1024) == 0, "rwkv prep LDS map");
template <int CTRL> __device__ __forceinline__ float dpp_add(float v) { return v + __builtin_bit_cast(float, __builtin_amdgcn_update_dpp(0, __builtin_bit_cast(int, v), CTRL, 0xf, 0xf, true)); }
__device__ __forceinline__ float red16(float v) {
    v = dpp_add<0xB1>(v);
    v = dpp_add<0x4E>(v);
    v = dpp_add<0x141>(v);
    v = dpp_add<0x140>(v);
    return v;
}
__device__ __forceinline__ int rk_piece_col(int pc, int h) {
    return pc < 8 ? h * 64 + 8 * pc : (pc < 16 ? 512 + h * 64 + 8 * (pc - 8) : (pc < 24 ? 1024 + h * 64 + 8 * (pc - 16) : 1536 + 8 * (pc - 24)));
}
#define RK_BAR() do { asm volatile("s_waitcnt lgkmcnt(0)" ::: "memory"); __builtin_amdgcn_s_barrier(); asm volatile("" ::: "memory"); } while (0)
__device__ __forceinline__ void rwkv_prep(const Params& p, LAS unsigned char* lds, int b, int h, int ch0, int ch1) {
    const int tid = opaque_tid(), lane = tid & 63, wid = __builtin_amdgcn_readfirstlane(tid >> 6);
    const bf16_t* proj = (const bf16_t*)(p.ws + WS_PROJ) + (size_t)b * SEQ * IC;
    LAS float* R_ = (LAS float*)(lds + RK_R); LAS float* KM_ = (LAS float*)(lds + RK_KM); LAS float* DEC_ = (LAS float*)(lds + RK_DEC); LAS float* KK_ = (LAS float*)(lds + RK_KK);
    LAS float* BB_ = (LAS float*)(lds + RK_BB); LAS float* VV_ = (LAS float*)(lds + RK_VV); LAS float* GG_ = (LAS float*)(lds + RK_GG); LAS float* BON_ = (LAS float*)(lds + RK_BON);
    LAS float* MU_ = (LAS float*)(lds + RK_MU);
    const int dpc = lane < 56 ? lane : 55;
    const bf16_t* dsrc = proj + rk_piece_col(dpc, h);
#define RK_DMA(t0_) do { for (int rho = wid; rho < 33; rho += NWAVES) { int tok = (t0_) - 1 + rho; tok = tok < 0 ? 0 : tok; \
        __builtin_amdgcn_global_load_lds((const unsigned*)(dsrc + (size_t)tok * IC), (LAS unsigned*)(lds + RK_RAW + rho * 1024), 16, 0, 0); } } while (0)
    RK_DMA(ch0 * RCH);
    if (tid < 448) MU_[tid] = p.in[I_MU][rk_piece_col(tid >> 3, h) + (tid & 7)];
    const int ntile = wid & 3, ttile = wid >> 2, fn = lane & 15, fk = lane >> 4;
    const int ncol = h * 64 + ntile * 16 + fn;
    bf16x8 bw[2], ba[2], bg[4];
    {
        const float* wup = p.in[I_WUP]; const float* aup = p.in[I_AUP]; const float* gup = p.in[I_GUP];
#pragma unroll
        for (int ks = 0; ks < 2; ++ks) { float t[8], u[8];
#pragma unroll
            for (int j = 0; j < 8; ++j) { const int k = 32 * ks + 8 * fk + j; t[j] = wup[k * RW + ncol]; u[j] = aup[k * RW + ncol]; }
            u32x4 a, c; a.x = cvtpk(t[0], t[1]); a.y = cvtpk(t[2], t[3]); a.z = cvtpk(t[4], t[5]); a.w = cvtpk(t[6], t[7]);
            c.x = cvtpk(u[0], u[1]); c.y = cvtpk(u[2], u[3]); c.z = cvtpk(u[4], u[5]); c.w = cvtpk(u[6], u[7]);
            bw[ks] = __builtin_bit_cast(bf16x8, a); ba[ks] = __builtin_bit_cast(bf16x8, c); }
#pragma unroll
        for (int ks = 0; ks < 4; ++ks) { float t[8];
#pragma unroll
            for (int j = 0; j < 8; ++j) { const int k = 32 * ks + 8 * fk + j; t[j] = gup[k * RW + ncol]; }
            u32x4 a; a.x = cvtpk(t[0], t[1]); a.y = cvtpk(t[2], t[3]); a.z = cvtpk(t[4], t[5]); a.w = cvtpk(t[6], t[7]);
            bg[ks] = __builtin_bit_cast(bf16x8, a); }
    }
    const float w0n = p.in[I_W0][ncol], a0n = p.in[I_A0][ncol];
    const int q16 = tid & 15, tk16 = tid >> 4;
    const f32x4 kkc = *(const f32x4*)(p.in[I_KK] + h * 64 + 4 * q16), kac = *(const f32x4*)(p.in[I_KA] + h * 64 + 4 * q16), rkc = *(const f32x4*)(p.in[I_RK] + h * 64 + 4 * q16);
    const size_t hb = (size_t)(b * 8 + h) * SEQ * 64;
    float* gVS = (float*)(p.ws + WS_VS) + hb; float* gGG = p.out + (size_t)16 * 1024 * 1024 + hb; float* gBON = (float*)(p.ws + WS_BON) + (size_t)(b * 8 + h) * SEQ;
    unsigned char* gOPS = p.ws + WS_OPS + (size_t)(b * 8 + h) * (SEQ / RCH) * OPREC;
    for (int ch = ch0; ch < ch1; ++ch) {
        const int t0 = ch * RCH;
        if (ch > ch0) { if (wid == 0) asm volatile("s_waitcnt vmcnt(8)" ::: "memory"); else if (wid == 1) asm volatile("s_waitcnt vmcnt(7)" ::: "memory"); else asm volatile("s_waitcnt vmcnt(6)" ::: "memory"); } else asm volatile("s_waitcnt vmcnt(0)" ::: "memory");
        RK_BAR();
#pragma unroll
        for (int it = 0; it < 4; ++it) { const int item = tid + it * NTHREADS;
            if (item < RCH * 56) { const int tk = item / 56, pc = item - tk * 56;
                const u32x4 cv = *(const LAS u32x4*)(lds + RK_RAW + (tk + 1) * 1024 + pc * 16);
                u32x4 pv = *(const LAS u32x4*)(lds + RK_RAW + tk * 1024 + pc * 16);
                if (t0 + tk == 0) pv = (u32x4){0u, 0u, 0u, 0u};
                const f32x4 m0 = *(const LAS f32x4*)(MU_ + pc * 8), m1 = *(const LAS f32x4*)(MU_ + pc * 8 + 4);
                float xv[8];
#pragma unroll
                for (int j = 0; j < 4; ++j) { const unsigned cw = cv[j], pw = pv[j];
                    const float c0 = __uint_as_float(cw << 16), c1 = __uint_as_float(cw & 0xffff0000u), p0 = __uint_as_float(pw << 16), p1 = __uint_as_float(pw & 0xffff0000u);
                    const float ma = (j < 2) ? m0[2 * j] : m1[2 * j - 4], mb = (j < 2) ? m0[2 * j + 1] : m1[2 * j - 3];
                    xv[2 * j] = c0 + ma * (p0 - c0); xv[2 * j + 1] = c1 + mb * (p1 - c1); }
                const int seg = pc >> 3, pi = pc & 7;
                if (seg <= 2) { LAS float* dst = (seg == 0 ? R_ : (seg == 1 ? KM_ : VV_)) + tk * 64 + 8 * pi;
                    *(LAS f32x4*)dst = (f32x4){xv[0], xv[1], xv[2], xv[3]}; *(LAS f32x4*)(dst + 4) = (f32x4){xv[4], xv[5], xv[6], xv[7]}; }
                else if (seg == 3) { u32x4 w; w.x = cvtpk(tanh_fast(xv[0]), tanh_fast(xv[1])); w.y = cvtpk(tanh_fast(xv[2]), tanh_fast(xv[3])); w.z = cvtpk(tanh_fast(xv[4]), tanh_fast(xv[5])); w.w = cvtpk(tanh_fast(xv[6]), tanh_fast(xv[7]));
                    *(LAS u32x4*)(lds + RK_AW + tk * 144 + 16 * pi) = w; }
                else if (seg == 4) { u32x4 w; w.x = cvtpk(xv[0], xv[1]); w.y = cvtpk(xv[2], xv[3]); w.z = cvtpk(xv[4], xv[5]); w.w = cvtpk(xv[6], xv[7]);
                    *(LAS u32x4*)(lds + RK_AA + tk * 144 + 16 * pi) = w; }
                else { u32x4 w; w.x = cvtpk(sigmoidf_(xv[0]), sigmoidf_(xv[1])); w.y = cvtpk(sigmoidf_(xv[2]), sigmoidf_(xv[3])); w.z = cvtpk(sigmoidf_(xv[4]), sigmoidf_(xv[5])); w.w = cvtpk(sigmoidf_(xv[6]), sigmoidf_(xv[7]));
                    *(LAS u32x4*)(lds + RK_AG + tk * 272 + (pc - 40) * 16) = w; }
            } }
        __syncthreads();
        if (ch + 1 < ch1) RK_DMA(t0 + RCH);
        {
            f32x4 cw = (f32x4){0.f, 0.f, 0.f, 0.f}, ca = cw, cg2 = cw;
            const int tok = ttile * 16 + fn;
#pragma unroll
            for (int ks = 0; ks < 2; ++ks) {
                const bf16x8 aw = *(const LAS bf16x8*)(lds + RK_AW + tok * 144 + (32 * ks + 8 * fk) * 2);
                const bf16x8 aa = *(const LAS bf16x8*)(lds + RK_AA + tok * 144 + (32 * ks + 8 * fk) * 2);
                cw = __builtin_amdgcn_mfma_f32_16x16x32_bf16(aw, bw[ks], cw, 0, 0, 0);
                ca = __builtin_amdgcn_mfma_f32_16x16x32_bf16(aa, ba[ks], ca, 0, 0, 0);
            }
#pragma unroll
            for (int ks = 0; ks < 4; ++ks) {
                const bf16x8 ag = *(const LAS bf16x8*)(lds + RK_AG + tok * 272 + (32 * ks + 8 * fk) * 2);
                cg2 = __builtin_amdgcn_mfma_f32_16x16x32_bf16(ag, bg[ks], cg2, 0, 0, 0);
            }
#pragma unroll
            for (int r = 0; r < 4; ++r) { const int tk = ttile * 16 + 4 * fk + r, n = ntile * 16 + fn;
                DEC_[tk * 64 + n] = -0.6065306597126334f * sigmoidf_(cw[r] + w0n);
                BB_[tk * 64 + n] = sigmoidf_(ca[r] + a0n);
                GG_[tk * 64 + n] = cg2[r]; }
        }
        RK_BAR();
        {
            const f32x4 kp = *(const LAS f32x4*)(KM_ + tk16 * 64 + 4 * q16), av = *(const LAS f32x4*)(BB_ + tk16 * 64 + 4 * q16), rr = *(const LAS f32x4*)(R_ + tk16 * 64 + 4 * q16);
            const f32x4 kkv = kp * kkc;
            const float nrm2 = red16((kkv[0] * kkv[0] + kkv[1] * kkv[1]) + (kkv[2] * kkv[2] + kkv[3] * kkv[3]));
            const f32x4 kkn = kkv * __builtin_amdgcn_rsqf(fmaxf(nrm2, 1e-24f));
            const f32x4 kmod = kp * ((av - 1.0f) * kac + 1.0f);
            const f32x4 t = rr * kmod * rkc;
            const float bs = red16((t[0] + t[1]) + (t[2] + t[3]));
            *(LAS f32x4*)(KK_ + tk16 * 64 + 4 * q16) = kkn; *(LAS f32x4*)(BB_ + tk16 * 64 + 4 * q16) = kkn * av; *(LAS f32x4*)(KM_ + tk16 * 64 + 4 * q16) = kmod;
            if (q16 == 0) BON_[tk16] = bs;
        }
        RK_BAR();
        {
            const int d1 = tid & 63, q1 = wid;
            float lw[4], cs[4];
#pragma unroll
            for (int e = 0; e < 4; ++e) lw[e] = DEC_[(4 * q1 + e) * 64 + d1];
            cs[0] = lw[0]; cs[1] = cs[0] + lw[1]; cs[2] = cs[1] + lw[2]; cs[3] = cs[2] + lw[3];
            ((LAS float*)(lds + RK_LSEG))[q1 * 64 + d1] = cs[3];
            { const float x0 = VV_[(4 * q1) * 64 + d1], x1 = VV_[(4 * q1 + 1) * 64 + d1], x2 = VV_[(4 * q1 + 2) * 64 + d1], x3 = VV_[(4 * q1 + 3) * 64 + d1];
              u32x2 w; w.x = cvtpk(x0, x1); w.y = cvtpk(x2, x3); *(LAS u32x2*)(lds + RK_IM + OP_VT + d1 * 80 + q1 * 8) = w; }
            RK_BAR();
            float off = 0.f, tot = 0.f;
#pragma unroll
            for (int qq = 0; qq < 8; ++qq) { const float sg = ((const LAS float*)(lds + RK_LSEG))[qq * 64 + d1]; tot += sg; if (qq < q1) off += sg; }
            const float etot = __expf(tot);
            float ePprev = __expf(off);
            float bc[4], kc4[4];
#pragma unroll
            for (int e = 0; e < 4; ++e) { const int tk = 4 * q1 + e;
                const float eP = __expf(off + cs[e]), eN = __builtin_amdgcn_rcpf(eP), eE = etot * eN;
                const float kap = KK_[tk * 64 + d1], bet = BB_[tk * 64 + d1], kk_ = KM_[tk * 64 + d1], rr = R_[tk * 64 + d1];
                const unsigned w0 = cvtpk(-kap * ePprev, rr * eP), w1 = cvtpk(bet * eN, kk_ * eN);
                *(LAS unsigned short*)(lds + RK_IM + OP_AT + tk * 144 + d1 * 2) = (unsigned short)(w0 & 0xffffu); *(LAS unsigned short*)(lds + RK_IM + OP_RT + tk * 144 + d1 * 2) = (unsigned short)(w0 >> 16);
                *(LAS unsigned short*)(lds + RK_IM + OP_BH + tk * 144 + d1 * 2) = (unsigned short)(w1 & 0xffffu); *(LAS unsigned short*)(lds + RK_IM + OP_KH + tk * 144 + d1 * 2) = (unsigned short)(w1 >> 16);
                bc[e] = bet * eE; kc4[e] = kk_ * eE; ePprev = eP; }
            u32x2 wb, wk; wb.x = cvtpk(bc[0], bc[1]); wb.y = cvtpk(bc[2], bc[3]); wk.x = cvtpk(kc4[0], kc4[1]); wk.y = cvtpk(kc4[2], kc4[3]);
            *(LAS u32x2*)(lds + RK_IM + OP_BCT + d1 * 80 + q1 * 8) = wb; *(LAS u32x2*)(lds + RK_IM + OP_KCT + d1 * 80 + q1 * 8) = wk;
            if (q1 == 0) ((LAS float*)(lds + RK_IM + OP_P31))[d1] = etot;
        }
        RK_BAR();
        {
            unsigned char* rec = gOPS + (size_t)ch * OPREC;
#pragma unroll
            for (int i = 0; i < 5; ++i) { const int o = (tid + i * NTHREADS) * 16; if (o < OPREC) *(u32x4*)(rec + o) = *(const LAS u32x4*)(lds + RK_IM + o); }
            const size_t go = (size_t)t0 * 64 + tid * 4;
            *(f32x4*)(gVS + go) = *(const LAS f32x4*)(VV_ + tid * 4);
            *(f32x4*)(gGG + go) = *(const LAS f32x4*)(GG_ + tid * 4);
            if (tid < RCH) gBON[t0 + tid] = BON_[tid];
        }
    }
    asm volatile("s_waitcnt vmcnt(0)" ::: "memory");
    __syncthreads();
#undef RK_DMA
}

constexpr int CS_IN = 32768;
constexpr int CS_OP = 2 * CS_IN;
constexpr int CS_AT = 0, CS_RT = 4608, CS_BH = 9216, CS_KH = 13824, CS_BCT = 18432, CS_KCT = 23552, CS_VT = 28672, CS_P31 = 31744;
constexpr int CS_MT2 = CS_OP, CS_MT3 = CS_OP + 2560, CS_MT4 = CS_OP + 5120;
constexpr int CS_M1F = CS_OP + 7680;
constexpr int CS_XF = CS_OP + 12288;
constexpr int CS_UB = CS_OP + 16896;
constexpr int CS_SB = CS_OP + 19456;
constexpr int CS_YY = CS_OP + 24064;
constexpr int CS_END = CS_OP + 28160;
static_assert(CS_END <= LDS_BYTES - 64, "rwkv scan LDS map");
__device__ __forceinline__ int crow32(int r, int hi) { return (r & 3) + 8 * (r >> 2) + 4 * hi; }
__device__ __forceinline__ void rwkv_scan(const Params& p, LAS unsigned char* lds, int b, int h, int half) {
    const int tid = opaque_tid(), lane = tid & 63, wid = __builtin_amdgcn_readfirstlane(tid >> 6), r32 = lane & 31, hi = lane >> 5;
    const unsigned char* gOPS = p.ws + WS_OPS + (size_t)(b * 8 + h) * (SEQ / RCH) * OPREC;
    float* yraw = p.out + (size_t)b * SEQ * RW + h * 64 + half * 32;
#define RS_DMA(ch_, buf) do { LAS unsigned char* bb_ = lds + (buf) * CS_IN; const unsigned char* rec_ = gOPS + (size_t)(ch_) * OPREC; \
        for (int pc = wid; pc < 32; pc += NWAVES) { \
            const unsigned char* src_ = rec_ + (pc < 28 ? pc * 1024 : (pc < 31 ? OP_VT + half * 2560 + (pc - 28) * 1024 : OP_P31)) + lane * 16; \
            __builtin_amdgcn_global_load_lds((const unsigned*)src_, (LAS unsigned*)(bb_ + pc * 1024), 16, 0, 0); } } while (0)
    RS_DMA(0, 0);
    for (int i = tid; i < 4608 / 4; i += NTHREADS) ((LAS unsigned*)(lds + CS_SB))[i] = 0u;
    f32x16 Sacc = f32x16{};
    f32x16 Xacc = f32x16{};
    for (int ch = 0; ch < SEQ / RCH; ++ch) {
        const int t0 = ch * RCH, cur = ch & 1;
        if (wid < 4 && ch > 0) asm volatile("s_waitcnt vmcnt(1)" ::: "memory"); else asm volatile("s_waitcnt vmcnt(0)" ::: "memory");
        RK_BAR();
        if (ch + 1 < SEQ / RCH) RS_DMA(ch + 1, cur ^ 1);
        const LAS unsigned char* ib = lds + cur * CS_IN;
        if (wid < 4) {
            const LAS unsigned char* Am = ib + ((wid & 1) ? CS_KH : CS_BH) + r32 * 144 + hi * 16;
            const LAS unsigned char* Bm = ib + ((wid & 2) ? CS_RT : CS_AT) + r32 * 144 + hi * 16;
            f32x16 acc = f32x16{};
#pragma unroll
            for (int ks = 0; ks < 4; ++ks) acc = __builtin_amdgcn_mfma_f32_32x32x16_bf16(*(const LAS bf16x8*)(Am + ks * 32), *(const LAS bf16x8*)(Bm + ks * 32), acc, 0, 0, 0);
            const int lim = (wid < 2) ? r32 : r32 + 1;
#pragma unroll
            for (int rg = 0; rg < 16; ++rg) if (crow32(rg, hi) >= lim) acc[rg] = 0.f;
            if (wid == 0) {
#pragma unroll
                for (int rg = 0; rg < 16; ++rg) ((LAS float*)(lds + CS_M1F))[crow32(rg, hi) * 36 + r32] = acc[rg];
            } else {
                LAS unsigned char* Mt = lds + (wid == 1 ? CS_MT2 : (wid == 2 ? CS_MT3 : CS_MT4)) + r32 * 80 + hi * 8;
#pragma unroll
                for (int g = 0; g < 4; ++g) { u32x2 w; w.x = cvtpk(acc[4 * g], acc[4 * g + 1]); w.y = cvtpk(acc[4 * g + 2], acc[4 * g + 3]); *(LAS u32x2*)(Mt + g * 16) = w; }
            }
        } else if (wid < 6) {
            const LAS unsigned char* Am = ib + (wid == 4 ? CS_AT : CS_RT) + r32 * 144 + hi * 16;
            const LAS unsigned char* Bm = lds + CS_SB + r32 * 144 + hi * 16;
            Xacc = f32x16{};
#pragma unroll
            for (int ks = 0; ks < 4; ++ks) Xacc = __builtin_amdgcn_mfma_f32_32x32x16_bf16(*(const LAS bf16x8*)(Am + ks * 32), *(const LAS bf16x8*)(Bm + ks * 32), Xacc, 0, 0, 0);
        }
        RK_BAR();
        if (wid == 4) {
            const LAS unsigned char* Am = lds + CS_MT2 + r32 * 80 + hi * 16;
            const LAS unsigned char* Bm = ib + CS_VT + r32 * 80 + hi * 16;
#pragma unroll
            for (int ks = 0; ks < 2; ++ks) Xacc = __builtin_amdgcn_mfma_f32_32x32x16_bf16(*(const LAS bf16x8*)(Am + ks * 32), *(const LAS bf16x8*)(Bm + ks * 32), Xacc, 0, 0, 0);
#pragma unroll
            for (int g = 0; g < 4; ++g) *(LAS f32x4*)(lds + CS_XF + r32 * 144 + (8 * g + 4 * hi) * 4) = (f32x4){Xacc[4 * g], Xacc[4 * g + 1], Xacc[4 * g + 2], Xacc[4 * g + 3]};
        }
        RK_BAR();
        {
            const int v = tid >> 4, l = tid & 15;
            float m0[32], m1[32];
#pragma unroll
            for (int c4 = 0; c4 < 8; ++c4) { const f32x4 a = *(const LAS f32x4*)(lds + CS_M1F + l * 144 + c4 * 16), c = *(const LAS f32x4*)(lds + CS_M1F + (l + 16) * 144 + c4 * 16);
                m0[4 * c4] = a[0]; m0[4 * c4 + 1] = a[1]; m0[4 * c4 + 2] = a[2]; m0[4 * c4 + 3] = a[3]; m1[4 * c4] = c[0]; m1[4 * c4 + 1] = c[1]; m1[4 * c4 + 2] = c[2]; m1[4 * c4 + 3] = c[3]; }
            const float x0 = ((const LAS float*)(lds + CS_XF))[v * 36 + l], x1 = ((const LAS float*)(lds + CS_XF))[v * 36 + l + 16];
            float u0 = 0.f, u1 = 0.f;
#pragma unroll
            for (int i = 0; i < 32; ++i) {
                const float part = (i < 16) ? u0 * m0[i] : (u0 * m0[i] + u1 * m1[i]);
                const float tot = red16(part);
                if (i < 16) u0 = (l == i) ? x0 + tot : u0; else u1 = (l == i - 16) ? x1 + tot : u1;
            }
            const unsigned w = cvtpk(u0, u1);
            *(LAS unsigned short*)(lds + CS_UB + v * 80 + l * 2) = (unsigned short)(w & 0xffffu); *(LAS unsigned short*)(lds + CS_UB + v * 80 + (l + 16) * 2) = (unsigned short)(w >> 16);
        }
        RK_BAR();
        if (wid == 5) {
            const LAS unsigned char* A3 = lds + CS_MT3 + r32 * 80 + hi * 16; const LAS unsigned char* A4 = lds + CS_MT4 + r32 * 80 + hi * 16;
            const LAS unsigned char* Bu = lds + CS_UB + r32 * 80 + hi * 16; const LAS unsigned char* Bv = ib + CS_VT + r32 * 80 + hi * 16;
#pragma unroll
            for (int ks = 0; ks < 2; ++ks) { Xacc = __builtin_amdgcn_mfma_f32_32x32x16_bf16(*(const LAS bf16x8*)(A3 + ks * 32), *(const LAS bf16x8*)(Bu + ks * 32), Xacc, 0, 0, 0);
                Xacc = __builtin_amdgcn_mfma_f32_32x32x16_bf16(*(const LAS bf16x8*)(A4 + ks * 32), *(const LAS bf16x8*)(Bv + ks * 32), Xacc, 0, 0, 0); }
#pragma unroll
            for (int rg = 0; rg < 16; ++rg) ((LAS float*)(lds + CS_YY))[crow32(rg, hi) * 32 + r32] = Xacc[rg];
        } else if (wid < 2) {
#pragma unroll
            for (int g = 0; g < 4; ++g) { const f32x4 pv = *(const LAS f32x4*)(ib + CS_P31 + (32 * wid + 8 * g + 4 * hi) * 4);
                Sacc[4 * g] *= pv[0]; Sacc[4 * g + 1] *= pv[1]; Sacc[4 * g + 2] *= pv[2]; Sacc[4 * g + 3] *= pv[3]; }
            const LAS unsigned char* Ab = ib + CS_BCT + (32 * wid + r32) * 80 + hi * 16; const LAS unsigned char* Ak = ib + CS_KCT + (32 * wid + r32) * 80 + hi * 16;
            const LAS unsigned char* Bu = lds + CS_UB + r32 * 80 + hi * 16; const LAS unsigned char* Bv = ib + CS_VT + r32 * 80 + hi * 16;
#pragma unroll
            for (int ks = 0; ks < 2; ++ks) { Sacc = __builtin_amdgcn_mfma_f32_32x32x16_bf16(*(const LAS bf16x8*)(Ab + ks * 32), *(const LAS bf16x8*)(Bu + ks * 32), Sacc, 0, 0, 0);
                Sacc = __builtin_amdgcn_mfma_f32_32x32x16_bf16(*(const LAS bf16x8*)(Ak + ks * 32), *(const LAS bf16x8*)(Bv + ks * 32), Sacc, 0, 0, 0); }
#pragma unroll
            for (int g = 0; g < 4; ++g) { u32x2 w; w.x = cvtpk(Sacc[4 * g], Sacc[4 * g + 1]); w.y = cvtpk(Sacc[4 * g + 2], Sacc[4 * g + 3]); *(LAS u32x2*)(lds + CS_SB + r32 * 144 + (32 * wid + 8 * g + 4 * hi) * 2) = w; }
        }
        RK_BAR();
        if (tid < 256) { const int tk = tid >> 3, sub = tid & 7; *(f32x4*)(yraw + (size_t)(t0 + tk) * RW + sub * 4) = *(const LAS f32x4*)(lds + CS_YY + tk * 128 + sub * 16); }
    }
    asm volatile("s_waitcnt vmcnt(0)" ::: "memory");
    __syncthreads();
#undef RS_DMA
}
__device__ __forceinline__ void rwkv_finalize(const Params& p, int G) {
    const int tid = opaque_tid(), q16 = tid & 15;
    const float* yraw = p.out; const float* gGG = p.out + (size_t)16 * 1024 * 1024; const float* gVS = (const float*)(p.ws + WS_VS); const float* gBON = (const float*)(p.ws + WS_BON);
    bf16_t* ymix = (bf16_t*)(p.ws + WS_YMIX);
    for (int item = (int)blockIdx.x * (NTHREADS / 16) + (tid >> 4); item < T * 8; item += G * (NTHREADS / 16)) {
        const int tok = item >> 3, h = item & 7, b = tok / SEQ, t = tok - b * SEQ;
        const f32x4 y = *(const f32x4*)(yraw + (size_t)tok * RW + h * 64 + 4 * q16);
        const size_t ho = ((size_t)(b * 8 + h) * SEQ + t) * 64 + 4 * q16;
        const f32x4 vv = *(const f32x4*)(gVS + ho), gg = *(const f32x4*)(gGG + ho);
        const float bon = gBON[(size_t)(b * 8 + h) * SEQ + t];
        const f32x4 gng = *(const f32x4*)(p.in[I_GNG] + h * 64 + 4 * q16), gnb = *(const f32x4*)(p.in[I_GNB] + h * 64 + 4 * q16);
        const float mean = red16((y[0] + y[1]) + (y[2] + y[3])) * (1.0f / 64.0f);
        const f32x4 dl = y - mean;
        const float var = red16((dl[0] * dl[0] + dl[1] * dl[1]) + (dl[2] * dl[2] + dl[3] * dl[3])) * (1.0f / 64.0f);
        const f32x4 yn = dl * __builtin_amdgcn_rsqf(var + GN_EPS) * gng + gnb;
        const f32x4 ov = (yn + vv * bon) * gg;
        u32x2 w; w.x = cvtpk(ov[0], ov[1]); w.y = cvtpk(ov[2], ov[3]);
        *(u32x2*)(ymix + (size_t)tok * D + h * 64 + 4 * q16) = w;
    }
}
#undef RK_BAR

constexpr int RT_PITCH = 36;
__device__ __forceinline__ void phase_router(const Params& p, LAS unsigned char* lds, int G) {
    const int tid = opaque_tid(), lane = tid & 63, wave = tid >> 6;
    LAS float* wr_ = (LAS float*)lds;
    LAS int* hist = (LAS int*)(lds + 147456);
    const float* rw = p.in[I_RTW];
    for (int i = tid; i < 1024 * 8; i += NTHREADS) { const int k = i >> 3, c4 = i & 7; const f32x4 v = *(const f32x4*)(rw + k * 32 + 4 * c4);
        const int ln = (k & 255) >> 2, ii = k & 3, jj = k >> 8; *(LAS f32x4*)(wr_ + ((ii + 4 * jj) * 64 + ln) * RT_PITCH + 4 * c4) = v; }
    const float* x1 = p.out; const float* gain = p.in[I_N2G]; const float* mod = (const float*)(p.ws + WS_MOD); const float* rb = p.in[I_RTB];
    bf16_t* h2 = (bf16_t*)(p.ws + WS_H);
    int* ridx = (int*)(p.ws + WS_ROUTE); float* rwt = (float*)(p.ws + WS_ROUTE + 512 * 1024);
    int* blockcnt = (int*)(p.ws + WS_CTL + 4096);
    const int TPB = T / G;
    for (int blk = blockIdx.x; blk < G; blk += G) {
        if (tid < 32) hist[tid] = 0;
        __syncthreads();
        for (int ti = wave; ti < TPB; ti += NWAVES) {
            const int row = blk * TPB + ti; const int b = row / SEQ;
            const f32x4* xr = (const f32x4*)(x1 + (size_t)row * D) + lane;
            f32x4 v[4]; float s = 0.f;
#pragma unroll
            for (int j = 0; j < 4; ++j) { v[j] = xr[64 * j]; s += (v[j][0] * v[j][0] + v[j][1] * v[j][1]) + (v[j][2] * v[j][2] + v[j][3] * v[j][3]); }
            const float rstd = rsqrtf(wave_sum(s) * (1.0f / D) + NORM_EPS);
            const float* sh = mod + b * 6144 + 3072; const float* scl = mod + b * 6144 + 4096;
            unsigned long long* o8 = (unsigned long long*)(h2 + (size_t)row * D) + lane;
            float acc[32];
#pragma unroll
            for (int e = 0; e < 32; ++e) acc[e] = 0.f;
#pragma unroll
            for (int j = 0; j < 4; ++j) { const int k = 4 * lane + 256 * j;
                const f32x4 g = *(const f32x4*)(gain + k), s1 = *(const f32x4*)(scl + k), s0 = *(const f32x4*)(sh + k);
                const f32x4 y = (v[j] * rstd) * g * (s1 + 1.0f) + s0;
                o8[64 * j] = (unsigned long long)cvtpk(y[0], y[1]) | ((unsigned long long)cvtpk(y[2], y[3]) << 32);
#pragma unroll
                for (int i = 0; i < 4; ++i) { const LAS float* wrow = wr_ + ((i + 4 * j) * 64 + lane) * RT_PITCH; const float yv = y[i];
#pragma unroll
                    for (int c4 = 0; c4 < 8; ++c4) { const f32x4 wv = *(const LAS f32x4*)(wrow + 4 * c4);
                        acc[4 * c4 + 0] += yv * wv[0]; acc[4 * c4 + 1] += yv * wv[1]; acc[4 * c4 + 2] += yv * wv[2]; acc[4 * c4 + 3] += yv * wv[3]; } } }
            float r16[16];
#pragma unroll
            for (int e = 0; e < 16; ++e) { const bool up = (lane & 32) != 0; const float keep = up ? acc[e + 16] : acc[e], send = up ? acc[e] : acc[e + 16]; r16[e] = keep + __shfl_xor(send, 32); }
            float r8[8];
#pragma unroll
            for (int e = 0; e < 8; ++e) { const bool up = (lane & 16) != 0; const float keep = up ? r16[e + 8] : r16[e], send = up ? r16[e] : r16[e + 8]; r8[e] = keep + __shfl_xor(send, 16); }
            float r4[4];
#pragma unroll
            for (int e = 0; e < 4; ++e) { const bool up = (lane & 8) != 0; const float keep = up ? r8[e + 4] : r8[e], send = up ? r8[e] : r8[e + 4]; r4[e] = keep + __shfl_xor(send, 8); }
            float r2[2];
#pragma unroll
            for (int e = 0; e < 2; ++e) { const bool up = (lane & 4) != 0; const float keep = up ? r4[e + 2] : r4[e], send = up ? r4[e] : r4[e + 2]; r2[e] = keep + __shfl_xor(send, 4); }
            float r1;
            { const bool up = (lane & 2) != 0; const float keep = up ? r2[1] : r2[0], send = up ? r2[0] : r2[1]; r1 = keep + __shfl_xor(send, 2); }
            r1 += __shfl_xor(r1, 1);
            const int e_l = lane >> 1;
            float logit = r1 + rb[e_l];
            int sel[4]; float sv[4];
#pragma unroll
            for (int k = 0; k < 4; ++k) { const float mx = wave_max(logit); const unsigned long long bal = __ballot(logit == mx); const int ln = __ffsll((long long)bal) - 1;
                sel[k] = ln >> 1; sv[k] = mx; if (e_l == sel[k]) logit = -INFINITY; }
            const float e1 = __expf(sv[1] - sv[0]), e2 = __expf(sv[2] - sv[0]), e3 = __expf(sv[3] - sv[0]); const float inv = 1.0f / (1.0f + e1 + e2 + e3);
            if (lane == 0) { *(int4*)(ridx + (size_t)row * 4) = make_int4(sel[0], sel[1], sel[2], sel[3]); *(float4*)(rwt + (size_t)row * 4) = make_float4(inv, e1 * inv, e2 * inv, e3 * inv);
                atomicAdd((int*)&hist[sel[0]], 1); atomicAdd((int*)&hist[sel[1]], 1); atomicAdd((int*)&hist[sel[2]], 1); atomicAdd((int*)&hist[sel[3]], 1); }
        }
        __syncthreads();
        if (tid < 32) blockcnt[blk * 32 + tid] = hist[tid];
        __syncthreads();
    }
}

__device__ __forceinline__ void phase_assign(const Params& p, LAS unsigned char* lds, int G) {
    const int tid = opaque_tid(), lane = tid & 63, wave = tid >> 6;
    LAS int* part = (LAS int*)lds;
    LAS int* partb = part + 512;
    LAS int* total = partb + 512;
    LAS int* base = total + 32;
    LAS int* segst = base + 32;
    LAS int* cursor = segst + 32;
    LAS int* slotl = cursor + 32;
    const int* blockcnt = (const int*)(p.ws + WS_CTL + 4096);
    const int* ridx = (const int*)(p.ws + WS_ROUTE); int* rslot = (int*)(p.ws + WS_ROUTE + 1024 * 1024); int* tokmap = (int*)(p.ws + WS_ROUTE + 2 * 1024 * 1024);
    const bf16_t* h2 = (const bf16_t*)(p.ws + WS_H); bf16_t* xs = (bf16_t*)(p.ws + WS_PROJ);
    int* tile = (int*)(p.ws + WS_TILE);
    const int TPB = T / G; const int blk = blockIdx.x;
    { const int e = tid & 31, part_i = tid >> 5; int st = 0, sb = 0;
        for (int bb = part_i; bb < G; bb += 16) { const int c = blockcnt[bb * 32 + e]; st += c; if (bb < blk) sb += c; }
        part[part_i * 32 + e] = st; partb[part_i * 32 + e] = sb; }
    __syncthreads();
    if (tid < 32) { int st = 0, sb = 0;
#pragma unroll
        for (int i = 0; i < 16; ++i) { st += part[i * 32 + tid]; sb += partb[i * 32 + tid]; }
        total[tid] = st; base[tid] = sb; cursor[tid] = 0; }
    __syncthreads();
    if (tid == 0) { int acc = 0; for (int e = 0; e < 32; ++e) { segst[e] = acc; acc += (total[e] + 255) & ~255; }
        if (blk == 0) { int pm = 0; for (int e = 0; e < 32; ++e) { const int nt = (total[e] + 255) >> 8; for (int i = 0; i < nt; ++i) tile[16 + pm + i] = e; pm += nt; } tile[0] = pm; } }
    __syncthreads();
    if (tid < 32) base[tid] += segst[tid];
    __syncthreads();
    for (int a = tid; a < TPB * 4; a += NTHREADS) { const int tok = blk * TPB + (a >> 2); const int e = ridx[(size_t)tok * 4 + (a & 3)];
        const int rank = atomicAdd((int*)&cursor[e], 1); const int slot = base[e] + rank; rslot[(size_t)tok * 4 + (a & 3)] = slot; tokmap[slot] = tok; }
    for (int e = blk; e < 32; e += G) { const int s0 = segst[e] + total[e], s1 = segst[e] + ((total[e] + 255) & ~255);
        for (int r = s0 + tid; r < s1; r += NTHREADS) tokmap[r] = 0; }
}

__device__ __forceinline__ void phase_final(const Params& p, int G, int stage) {
    const int tid = opaque_tid(), lane = tid & 63, wave = tid >> 6;
    const int gw = (int)blockIdx.x * NWAVES + wave, NGW = G * NWAVES;
    const float* fg = p.in[I_FG]; const float* mod = (const float*)(p.ws + WS_MOD);
    const int* rslot = (const int*)(p.ws + WS_ROUTE + 1024 * 1024); const float* rwt = (const float*)(p.ws + WS_ROUTE + 512 * 1024);
    const bf16_t* Y = (const bf16_t*)(p.ws + WS_PROJ);
    const float* src = (stage >= 4) ? p.out : p.in[I_X];
    for (int row = gw; row < T; row += NGW) {
        const int b = row / SEQ;
        const f32x4* xr = (const f32x4*)(src + (size_t)row * D) + lane;
        f32x4 v[4];
#pragma unroll
        for (int j = 0; j < 4; ++j) v[j] = xr[64 * j];
        if (stage >= 9) {
            const int4 sl = *(const int4*)(rslot + (size_t)row * 4); const float4 wt = *(const float4*)(rwt + (size_t)row * 4);
            const float* g2 = mod + b * 6144 + 5120;
            const int sls[4] = {sl.x, sl.y, sl.z, sl.w}; const float wts[4] = {wt.x, wt.y, wt.z, wt.w};
#pragma unroll
            for (int j = 0; j < 4; ++j) { f32x4 m = (f32x4){0.f, 0.f, 0.f, 0.f};
#pragma unroll
                for (int k = 0; k < 4; ++k) { const u32x2 yv = *((const u32x2*)(Y + (size_t)sls[k] * D) + lane + 64 * j);
                    m[0] += wts[k] * __uint_as_float(yv.x << 16); m[1] += wts[k] * __uint_as_float(yv.x & 0xffff0000u); m[2] += wts[k] * __uint_as_float(yv.y << 16); m[3] += wts[k] * __uint_as_float(yv.y & 0xffff0000u); }
                const f32x4 g = *(const f32x4*)(g2 + 4 * lane + 256 * j); v[j] = v[j] + g * m; }
        }
        float s = 0.f;
#pragma unroll
        for (int j = 0; j < 4; ++j) s += (v[j][0] * v[j][0] + v[j][1] * v[j][1]) + (v[j][2] * v[j][2] + v[j][3] * v[j][3]);
        const float rstd = rsqrtf(wave_sum(s) * (1.0f / D) + NORM_EPS);
        f32x4* orow = (f32x4*)(p.out + (size_t)row * D) + lane;
#pragma unroll
        for (int j = 0; j < 4; ++j) { const f32x4 g = *(const f32x4*)(fg + 4 * lane + 256 * j); orow[64 * j] = v[j] * rstd * g; }
    }
}


#define XB_TMO      128
#define XB_XCNT(j)  (256  + 64 * (j))
#define XB_XSUB(j)  (1280 + 64 * (j))
#define XB_XGEN(j)  (2304 + 64 * (j))
#define XB_TOP      3328
#define XB_TOPGEN   3392
#define XCD_BAR_WORDS 3456
#define XB_SPIN_CAP (1u << 22)
__device__ __forceinline__ unsigned xb_ld(unsigned* p)              { return __hip_atomic_load(p, __ATOMIC_RELAXED, __HIP_MEMORY_SCOPE_AGENT); }
__device__ __forceinline__ unsigned xb_add(unsigned* p, unsigned v) { return __hip_atomic_fetch_add(p, v, __ATOMIC_RELAXED, __HIP_MEMORY_SCOPE_AGENT); }
__device__ __forceinline__ unsigned xb_xcc_id() { return (unsigned)__builtin_amdgcn_s_getreg((3 << 11) | 20) & 0xFu; }
#define XB_SPIN(cond, bar) do { unsigned _sp = 0; while (cond) { __builtin_amdgcn_s_sleep(1); \
    if ((++_sp & 255u) == 0u) { if (xb_ld(&(bar)[XB_TMO])) break; if (_sp > XB_SPIN_CAP) { atomicAdd(&(bar)[XB_TMO], 1u); break; } } } } while (0)
struct XcdBarrier { unsigned* bar; unsigned x; volatile LAS unsigned* st; };
__device__ __forceinline__ XcdBarrier xcd_barrier_post(unsigned* bar, volatile LAS unsigned* st) {
    XcdBarrier b; b.bar = bar; b.x = xb_xcc_id(); b.st = st;
    if (threadIdx.x == 0) (void)xb_add(&bar[XB_XCNT(b.x)], 1u);
    return b;
}
__device__ __forceinline__ void xcd_barrier_complete(unsigned* bar, unsigned x, unsigned& nloc, unsigned& nx) {
    const unsigned G = gridDim.x * gridDim.y * gridDim.z;
    unsigned sum, cnt, mine, sp = 0u;
    for (;;) {
        sum = 0u; cnt = 0u; mine = 0u;
#pragma unroll
        for (unsigned j = 0; j < 16; ++j) { const unsigned c = xb_ld(&bar[XB_XCNT(j)]); sum += c; cnt += (c > 0u) ? 1u : 0u; mine = (j == x) ? c : mine; }
        if (sum == G) break;
        __builtin_amdgcn_s_sleep(1);
        if ((++sp & 255u) == 0u) { if (xb_ld(&bar[XB_TMO])) break; if (sp > XB_SPIN_CAP) { atomicAdd(&bar[XB_TMO], 1u); break; } }
    }
    nloc = mine > 0u ? mine : 1u; nx = cnt > 0u ? cnt : 1u;
}
__device__ __forceinline__ void xcd_barrier(const XcdBarrier& b) {
    asm volatile("s_waitcnt vmcnt(0)" ::: "memory");
    __syncthreads();
    if (threadIdx.x == 0) {
        unsigned* bar = b.bar;
        __builtin_amdgcn_s_waitcnt(0);
        unsigned nloc = b.st[0], nx = b.st[1];
        if (nloc == 0u) { xcd_barrier_complete(bar, b.x, nloc, nx); b.st[0] = nloc; b.st[1] = nx; }
        const unsigned old = xb_add(&bar[XB_XSUB(b.x)], 1u);
        const unsigned gen = old / nloc;
        if (old + 1u == (gen + 1u) * nloc) {
            __builtin_amdgcn_fence(__ATOMIC_RELEASE, "agent");
            asm volatile("s_waitcnt vmcnt(0)" ::: "memory");
            const unsigned og = xb_add(&bar[XB_TOP], 1u);
            const unsigned tg = og / nx;
            if (og + 1u == (tg + 1u) * nx) xb_add(&bar[XB_TOPGEN], 1u);
            else XB_SPIN(xb_ld(&bar[XB_TOPGEN]) == tg, bar);
            __builtin_amdgcn_fence(__ATOMIC_ACQUIRE, "agent");
            xb_add(&bar[XB_XGEN(b.x)], 1u);
            asm volatile("s_waitcnt vmcnt(0)" ::: "memory");
        } else {
            XB_SPIN(xb_ld(&bar[XB_XGEN(b.x)]) == gen, bar);
            __builtin_amdgcn_fence(__ATOMIC_ACQUIRE, "agent");
            asm volatile("s_waitcnt vmcnt(0)" ::: "memory");
        }
    }
    __syncthreads();
}

__device__ __forceinline__ const Params* launder_params(const Params* q) { asm volatile("" : "+s"(q)); return q; }
__global__ void __launch_bounds__(NTHREADS, 2) hymba_fwd(Params p) {
    extern __shared__ __attribute__((aligned(16))) unsigned char lds_raw[];
    cg::grid_group grid = cg::this_grid();
    LAS unsigned char* lds = (LAS unsigned char*)lds_raw;
    const int G = gridDim.x, tid = threadIdx.x;
    constexpr int STAGE = DBG_STAGE;
    volatile LAS unsigned* xst = (volatile LAS unsigned*)(lds + LDS_BYTES - 64);
    if (tid == 0) { xst[0] = 0u; xst[1] = 0u; }
    __syncthreads();
    const XcdBarrier xbar = xcd_barrier_post((unsigned*)(p.ws + WS_CTL + 40960), xst);
#define GRID_BAR() xcd_barrier(xbar)

    phase_mod(p, lds_raw, G);
    if (STAGE >= 2) phase_convert(p, lds_raw, G);
    grid.sync();
    if (STAGE >= 2) { phase_norm1(p, G); GRID_BAR(); }
    if (STAGE >= 2) {
        pg8::Gemm g{(const bf16_t*)(p.ws + WS_H), (const bf16_t*)(p.ws + WS_WIN_T), D, nullptr};
        pg8::DenseSched S; S.o.init(T / 256, IC / 256, G, (int)blockIdx.x);
        EpiInProj E{(bf16_t*)(p.ws + WS_PROJ)};
        pg8::gemm_phase<false>(lds, g, S, E);
        GRID_BAR();
    }
    if (STAGE >= 3) {
        kmax_pass(p, G);
        for (int it = blockIdx.x; it < NB * 8 * 4; it += G) rwkv_prep(p, lds, it >> 5, (it >> 2) & 7, (it & 3) * 32, (it & 3) * 32 + 32);
        GRID_BAR();
    }
    if (STAGE >= 2) {
        if (STAGE >= 3) { for (int u = blockIdx.x; u < NB * 8 * 2; u += G) rwkv_scan(p, lds, u >> 4, (u >> 1) & 7, u & 1); }
        else {
            bf16_t* ymix = (bf16_t*)(p.ws + WS_YMIX);
            for (size_t i = (size_t)blockIdx.x * NTHREADS + tid; i < (size_t)T * 64; i += (size_t)G * NTHREADS) { const size_t row = i >> 6, c = i & 63; *(u32x4*)(ymix + row * D + c * 8) = (u32x4){0u, 0u, 0u, 0u}; }
        }
        float lam;
        { const float* q1 = p.in[I_LQ1]; const float* k1 = p.in[I_LK1]; const float* q2 = p.in[I_LQ2]; const float* k2 = p.in[I_LK2]; float s1 = 0.f, s2 = 0.f;
            for (int i = 0; i < 64; ++i) { s1 += q1[i] * k1[i]; s2 += q2[i] * k2[i]; } lam = expf(s1) - expf(s2) + LAMBDA_INIT; }
        unsigned* qhead = (unsigned*)(p.ws + WS_CTL);
        LAS unsigned* ubox = (LAS unsigned*)(lds + 4 * ATT_BUF);
        for (;;) {
            __syncthreads();
            if (tid == 0) ubox[0] = atomicAdd(qhead, 1u);
            __syncthreads();
            const unsigned u = (unsigned)__builtin_amdgcn_readfirstlane((int)ubox[0]);
            if (u >= (unsigned)ATT_UNITS) break;
            attn_unit(p, lds, (int)(u & 31u) >> 2, (int)(u & 3u), ATT_NQB - 1 - (int)(u >> 5), lam);
        }
        GRID_BAR();
        if (STAGE >= 3) { rwkv_finalize(p, G); GRID_BAR(); }
    }
    if (STAGE >= 2) {
        pg8::Gemm g{(const bf16_t*)(p.ws + WS_YMIX), (const bf16_t*)(p.ws + WS_WOUT_T), D, nullptr};
        pg8::DenseSched S; S.o.init(T / 256, D / 256, G, (int)blockIdx.x);
        EpiOutProj E{p.in[I_X], (const float*)(p.ws + WS_MOD), p.out};
        pg8::gemm_phase<false>(lds, g, S, E);
        GRID_BAR();
    }
    if (STAGE >= 9) {
        phase_router(p, lds, G);
        GRID_BAR();
        phase_assign(p, lds, G);
        GRID_BAR();
        const int* tile = (const int*)(p.ws + WS_TILE);
        const int MT = tile[0];
        {
            pg8::Gemm g{(const bf16_t*)(p.ws + WS_H), (const bf16_t*)(p.ws + WS_WG_T), D, (const int*)(p.ws + WS_ROUTE + 2 * 1024 * 1024)};
            pg8::MoeSched S; S.o.init(MT, 8, G, (int)blockIdx.x); S.tile_e = tile + 16; S.N = 2048;
            EpiMoe1 E{p.in[I_BGU], (bf16_t*)(p.ws + WS_ACT)};
            pg8::gemm_phase<true>(lds, g, S, E);
        }
        GRID_BAR();
        {
            pg8::Gemm g{(const bf16_t*)(p.ws + WS_ACT), (const bf16_t*)(p.ws + WS_WD_T), D, nullptr};
            pg8::MoeSched S; S.o.init(MT, 4, G, (int)blockIdx.x); S.tile_e = tile + 16; S.N = 1024;
            EpiMoe2 E{p.in[I_BDN], (bf16_t*)(p.ws + WS_PROJ)};
            pg8::gemm_phase<false>(lds, g, S, E);
        }
        GRID_BAR();
    }
    phase_final(p, G, STAGE >= 9 ? 9 : (STAGE >= 2 ? 4 : 0));
}

extern "C" void kernel_launch(void* const* d_in, const int* in_sizes, int n_in, void* d_out, int out_size, void* d_ws, size_t ws_size, hipStream_t stream) {
    static int grid = 0;
    if (grid == 0) {
        if (n_in != 31 || out_size != T * D || ws_size < WS_END) { fprintf(stderr, "kernel_launch: unexpected shapes (n_in %d out %d ws %zu)\n", n_in, out_size, ws_size); grid = -1; return; }
        int dev = 0, cus = 0, per_cu = 0;
        hipGetDevice(&dev);
        hipDeviceGetAttribute(&cus, hipDeviceAttributeMultiprocessorCount, dev);
        hipFuncSetAttribute((const void*)hymba_fwd, hipFuncAttributeMaxDynamicSharedMemorySize, LDS_BYTES);
        hipOccupancyMaxActiveBlocksPerMultiprocessor(&per_cu, (const void*)hymba_fwd, NTHREADS, LDS_BYTES);
        if (per_cu < 1) { fprintf(stderr, "kernel_launch: occupancy query returned %d\n", per_cu); grid = -1; return; }
        grid = cus;
        if (grid > 256) grid = 256;
        while (T % grid != 0) --grid;
        (void)hipGetLastError();
    }
    if (grid < 0) return;
    hipMemsetAsync((char*)d_ws + WS_CTL, 0, CTL_BYTES, stream);
    Params p{};
    for (int i = 0; i < 31; ++i) p.in[i] = (const float*)d_in[i];
    p.out = (float*)d_out; p.ws = (unsigned char*)d_ws;
    void* args[] = {&p};
    hipError_t e = hipLaunchCooperativeKernel((const void*)hymba_fwd, dim3(grid), dim3(NTHREADS), args, LDS_BYTES, stream);
    if (e != hipSuccess) fprintf(stderr, "cooperative launch failed: %s (grid %d)\n", hipGetErrorString(e), grid);
}
```

```cpp
#include <hip/hip_runtime.h>
#include <hip/hip_cooperative_groups.h>
#include <cstdio>
#include <cstdint>
namespace cg = cooperative_groups;

#ifndef DBG_STAGE
#define DBG_STAGE 99
#endif

#define LAS __attribute__((address_space(3)))
typedef unsigned short bf16_t;
typedef short bf16x8 __attribute__((ext_vector_type(8)));
typedef short s16x4 __attribute__((ext_vector_type(4)));
typedef float f32x4 __attribute__((ext_vector_type(4)));
typedef float f32x16 __attribute__((ext_vector_type(16)));
typedef float f32x2_t __attribute__((ext_vector_type(2)));
typedef __bf16 bf16x2_t __attribute__((ext_vector_type(2)));
typedef unsigned u32x4 __attribute__((ext_vector_type(4)));
typedef unsigned u32x2 __attribute__((ext_vector_type(2)));

constexpr int D = 1024, NB = 8, SEQ = 4096, T = NB * SEQ;
constexpr int RW = 512, RC = 1792, DC = 1536, IC = 3328;
constexpr int NE = 32, TOPK = 4, NA = T * TOPK;
constexpr int PMAX = NA + NE * 256;
constexpr float NORM_EPS = 1e-5f, GN_EPS = 64e-5f;
constexpr float LOG2E = 1.4426950408889634f;
constexpr float QSCALE = 0.125f * LOG2E;
constexpr float LAMBDA_INIT = 0.2f;
constexpr int NTHREADS = 512, NWAVES = 8;
constexpr int LDS_BYTES = 163840;

constexpr size_t MiB = 1u << 20;
constexpr size_t WS_CTL = 0;
constexpr size_t CTL_BYTES = 65536;
constexpr size_t WS_MOD = 1 * MiB;
constexpr size_t WS_TILE = 1 * MiB + 512 * 1024;
constexpr size_t WS_WIN_T = 2 * MiB;
constexpr size_t WS_WOUT_T = 9 * MiB;
constexpr size_t WS_ROUTE = 11 * MiB;
constexpr size_t WS_WG_T = 16 * MiB;
constexpr size_t WS_WD_T = 144 * MiB;
constexpr size_t WS_H = 208 * MiB;
constexpr size_t WS_YMIX = 272 * MiB;
constexpr size_t WS_PROJ = 336 * MiB;
constexpr size_t WS_ACT = 608 * MiB;
constexpr size_t WS_END = 1008 * MiB;
constexpr int OPREC = 34816;
constexpr int OP_AT = 0, OP_RT = 4608, OP_BH = 9216, OP_KH = 13824, OP_BCT = 18432, OP_KCT = 23552, OP_VT = 28672, OP_P31 = 33792;
constexpr size_t WS_OPS = WS_ACT;
constexpr size_t WS_VS = 944 * MiB;
constexpr size_t WS_BON = WS_H;

__device__ __forceinline__ unsigned cvtpk(float lo, float hi) { f32x2_t v = {lo, hi}; bf16x2_t b = __builtin_convertvector(v, bf16x2_t); return __builtin_bit_cast(unsigned, b); }
__device__ __forceinline__ float bf2f(unsigned short u) { return __uint_as_float(((unsigned)u) << 16); }
__device__ __forceinline__ float wave_sum(float v) {
#pragma unroll
    for (int o = 1; o < 64; o <<= 1) v += __shfl_xor(v, o);
    return v;
}
__device__ __forceinline__ float wave_max(float v) {
#pragma unroll
    for (int o = 1; o < 64; o <<= 1) v = fmaxf(v, __shfl_xor(v, o));
    return v;
}
__device__ __forceinline__ int opaque_tid() { int t = (int)threadIdx.x; asm volatile("" : "+v"(t)); return t; }
__device__ __forceinline__ float sigmoidf_(float x) { return __builtin_amdgcn_rcpf(1.0f + __expf(-x)); }
__device__ __forceinline__ float tanh_fast(float x) { return 1.0f - 2.0f * __builtin_amdgcn_rcpf(1.0f + __expf(2.0f * x)); }

struct Params {
    const float* in[31];
    float* out;
    unsigned char* ws;
};
enum { I_X = 0, I_C, I_MODW, I_MODB, I_N1G, I_WIN, I_MU, I_W0, I_WUP, I_A0, I_AUP, I_GUP, I_KK, I_KA, I_RK, I_GNG, I_GNB, I_LQ1, I_LK1, I_LQ2, I_LK2, I_SUBLN, I_WOUT, I_N2G, I_RTW, I_RTB, I_WGU, I_BGU, I_WDN, I_BDN, I_FG };

namespace pg8 {
constexpr int BM = 256, BK = 64, HALF = 128, HTB = HALF * BK * 2, STAGE_BYTES = 8 * HTB, NXCD = 8, WGM = 8;
__host__ __device__ __forceinline__ int lds_byte(int r, int c) { const int st = (r >> 4) * 2 + (c >> 5), rr = r & 15, cc = c & 31, ob = rr * 64 + cc * 2; return st * 1024 + (ob ^ (((ob >> 9) & 1) << 5)); }
__host__ __device__ __forceinline__ void stage_rc(int b, int& R, int& C) { const int st = b / 1024, sb = b % 1024, swz = sb ^ (((sb >> 9) & 1) << 5); R = (st >> 1) * 16 + swz / 64; C = (st & 1) * 32 + (swz % 64) / 2; }
__host__ __device__ __forceinline__ int perm32(int rho) { const int n = rho >> 4, i = rho & 15; return 8 * (i >> 2) + 4 * n + (i & 3); }

struct Unit { int pm, pn, arow, brow, e; };
struct Gemm { const bf16_t* A; const bf16_t* Bt; int K; const int* rowmap; };

struct TileOrder {
    int nM, nN, nwg, G, c;
    __device__ void init(int nM_, int nN_, int G_, int c_) { nM = nM_; nN = nN_; nwg = nM * nN; G = G_; c = c_; }
    __device__ bool map(int i, int& pm, int& pn) const {
        const long L = (long)i * G + c; if (L >= nwg) return false;
        int wgid = (int)L; { const int q = nwg / NXCD, r = nwg % NXCD, xcd = wgid % NXCD, off = wgid / NXCD; wgid = (xcd < r ? xcd * (q + 1) : r * (q + 1) + (xcd - r) * q) + off; }
        const int nig = WGM * nN, gid = wgid / nig, fm = gid * WGM, gsz = (nM - fm) < WGM ? (nM - fm) : WGM;
        pm = fm + ((wgid % nig) % gsz); pn = (wgid % nig) / gsz; return true;
    }
};
struct DenseSched {
    TileOrder o;
    __device__ bool next(int i, Unit& u) const { int pm, pn; if (!o.map(i, pm, pn)) return false; u.pm = pm; u.pn = pn; u.arow = pm * BM; u.brow = pn * BM; u.e = 0; return true; }
};
struct MoeSched {
    TileOrder o; const int* tile_e; int N;
    __device__ bool next(int i, Unit& u) const { int pm, pn; if (!o.map(i, pm, pn)) return false; const int e = tile_e[pm]; u.pm = pm; u.pn = pn; u.arow = pm * BM; u.brow = e * N + pn * BM; u.e = e; return true; }
};

typedef int v4i_t __attribute__((ext_vector_type(4)));
typedef int v8i_t __attribute__((ext_vector_type(8)));
__device__ __forceinline__ v8i_t cat8(bf16x8 a, bf16x8 b) { return __builtin_shufflevector(__builtin_bit_cast(v4i_t, a), __builtin_bit_cast(v4i_t, b), 0, 1, 2, 3, 4, 5, 6, 7); }
__device__ __forceinline__ void mfma_fp8_tied(f32x4& acc, v8i_t a, v8i_t b) { asm volatile("v_mfma_f32_16x16x128_f8f6f4 %0, %1, %2, %0" : "+v"(acc) : "v"(a), "v"(b)); }
template <bool GATHER, bool FP8, class Epi, class Sched>
__device__ __forceinline__ void gemm_phase(LAS unsigned char* lds, const Gemm g, const Sched& S, const Epi& E) {
    const int tid = opaque_tid(), wid = __builtin_amdgcn_readfirstlane(tid >> 6), lane = tid & 63, wr = wid >> 2, wc = wid & 3, fr = lane & 15, fq = lane >> 4;
    const int K = g.K, nt = K / BK;
    unsigned voffA[2], voffB[2]; int rowA[2], colA2[2];
#pragma unroll
    for (int i = 0; i < 2; ++i) { int R, C; stage_rc(tid * 16 + i * 8192, R, C); const int Rb = (R & ~31) + perm32(R & 31);
        voffA[i] = (unsigned)(R * K + C) * 2u; voffB[i] = (unsigned)(Rb * K + C) * 2u; rowA[i] = R; colA2[i] = C * 2; }
    unsigned gv0[2] = {0u, 0u}, gv1[2] = {0u, 0u}, gn0[2] = {0u, 0u}, gn1[2] = {0u, 0u};
#define PG8_GOFF(u_, o0, o1) do { _Pragma("unroll") for (int _i = 0; _i < 2; ++_i) { o0[_i] = (unsigned)g.rowmap[(u_).arow + rowA[_i]] * (unsigned)(K * 2) + (unsigned)colA2[_i]; o1[_i] = (unsigned)g.rowmap[(u_).arow + HALF + rowA[_i]] * (unsigned)(K * 2) + (unsigned)colA2[_i]; } } while (0)
#define PG8_STAGE_A(bufoff, kptr, half) do { if constexpr (GATHER) { if (half) PG8_STAGE(bufoff, kptr, gv1); else PG8_STAGE(bufoff, kptr, gv0); } else PG8_STAGE(bufoff, (kptr) + ((half) ? hstep : 0), voffA); } while (0)
    const size_t kstep = (size_t)(BK * 2);
    const size_t hstep = (size_t)HALF * K * 2;
    const size_t rowb = (size_t)K * 2;
    const unsigned ldsw = (unsigned)wid * 1024u;
    const int aoff = lds_byte(wr * 64 + fr, fq * 8), boff = lds_byte(wc * 32 + fr, fq * 8);
#define PG8_SA(b, h) (((b) * 2 + (h)) * HTB)
#define PG8_SB(b, h) ((4 + (b) * 2 + (h)) * HTB)
#define PG8_STAGE(bufoff, gbase, voff) do { _Pragma("unroll") for (int _i = 0; _i < 2; ++_i) \
        __builtin_amdgcn_global_load_lds((const unsigned*)((const char*)(gbase) + (voff)[_i]), (LAS unsigned*)(lds + (bufoff) + ldsw + _i * 8192), 16, 0, 0); } while (0)
#define PG8_LDA(dst, b, h) do { _Pragma("unroll") for (int m = 0; m < 4; ++m) _Pragma("unroll") for (int k = 0; k < 2; ++k) dst[m][k] = *(const LAS bf16x8*)(lds + PG8_SA(b, h) + aoff + m * 2048 + k * 1024); } while (0)
#define PG8_LDB(dst, b, h) do { _Pragma("unroll") for (int n = 0; n < 2; ++n) _Pragma("unroll") for (int k = 0; k < 2; ++k) dst[n][k] = *(const LAS bf16x8*)(lds + PG8_SB(b, h) + boff + n * 2048 + k * 1024); } while (0)
#define PG8_MMA(ai, bj, At, Bt) do { __builtin_amdgcn_s_setprio(1); _Pragma("unroll") for (int m = 0; m < 4; ++m) _Pragma("unroll") for (int n = 0; n < 2; ++n) { \
        if constexpr (FP8) mfma_fp8_tied(acc[ai][bj][m][n], cat8(Bt[n][0], Bt[n][1]), cat8(At[m][0], At[m][1])); \
        else { _Pragma("unroll") for (int k = 0; k < 2; ++k) acc[ai][bj][m][n] = __builtin_amdgcn_mfma_f32_16x16x32_bf16(Bt[n][k], At[m][k], acc[ai][bj][m][n], 0, 0, 0); } } __builtin_amdgcn_s_setprio(0); } while (0)
#define PG8_WAIT_V(n) asm volatile("s_waitcnt vmcnt(" #n ")" ::: "memory")
#define PG8_WAIT_L(n) asm volatile("s_waitcnt lgkmcnt(" #n ")" ::: "memory")
#define PG8_BAR __builtin_amdgcn_s_barrier()
#define PG8_SCHED __builtin_amdgcn_sched_barrier(0)
    Unit cur, nxt; int ui = 0;
    if (!S.next(0, cur)) return;
    f32x4 acc[2][2][4][2];
#pragma unroll
    for (int a = 0; a < 2; ++a)
#pragma unroll
        for (int b = 0; b < 2; ++b)
#pragma unroll
            for (int m = 0; m < 4; ++m)
#pragma unroll
                for (int n = 0; n < 2; ++n) acc[a][b][m][n] = (f32x4){0.f, 0.f, 0.f, 0.f};
    bf16x8 At[4][2], B0[2][2], B1[2][2];
    const char* cA = GATHER ? (const char*)g.A : (const char*)g.A + (size_t)cur.arow * rowb; const char* cB = (const char*)g.Bt + (size_t)cur.brow * rowb;
    if constexpr (GATHER) PG8_GOFF(cur, gv0, gv1);
    PG8_STAGE(PG8_SB(0, 0), cB, voffB); PG8_STAGE(PG8_SB(0, 1), cB + hstep, voffB); PG8_STAGE_A(PG8_SA(0, 0), cA, 0); PG8_STAGE_A(PG8_SA(0, 1), cA, 1);
    if (wr == 1) PG8_BAR;
    PG8_WAIT_V(2); PG8_BAR;
    PG8_STAGE(PG8_SB(1, 0), cB + kstep, voffB); PG8_STAGE_A(PG8_SA(1, 0), cA + kstep, 0); PG8_STAGE(PG8_SB(1, 1), cB + hstep + kstep, voffB);
    PG8_WAIT_V(6); PG8_BAR;
    for (;;) {
        const bool has_next = S.next(ui + 1, nxt);
        const char* nA = GATHER ? (const char*)g.A : (has_next ? (const char*)g.A + (size_t)nxt.arow * rowb : cA); const char* nB = has_next ? (const char*)g.Bt + (size_t)nxt.brow * rowb : cB;

        for (int t = 0; t < nt; t += 2) {
            const bool last = (t == nt - 2);
            if constexpr (GATHER) { if (t == nt - 4) { if (has_next) PG8_GOFF(nxt, gn0, gn1); else { gn0[0] = gv0[0]; gn0[1] = gv0[1]; gn1[0] = gv1[0]; gn1[1] = gv1[1]; } } }
            const char* a1 = cA + (size_t)(t + 1) * kstep;
            const char* a2 = last ? nA : cA + (size_t)(t + 2) * kstep; const char* b2 = last ? nB : cB + (size_t)(t + 2) * kstep;
            const char* a3 = a2 + kstep; const char* b3 = b2 + kstep;
            PG8_LDB(B0, 0, 0); PG8_LDB(B1, 0, 1); PG8_SCHED; PG8_LDA(At, 0, 0); PG8_STAGE_A(PG8_SA(1, 1), a1, 1);
            if constexpr (GATHER) { if (last) { gv0[0] = gn0[0]; gv0[1] = gn0[1]; gv1[0] = gn1[0]; gv1[1] = gn1[1]; } }
            PG8_WAIT_V(8); PG8_WAIT_L(0); PG8_BAR; PG8_MMA(0, 0, At, B0); PG8_MMA(0, 1, At, B1); PG8_BAR; PG8_SCHED;
            PG8_LDA(At, 0, 1); PG8_STAGE(PG8_SB(0, 0), b2, voffB); PG8_STAGE(PG8_SB(0, 1), b2 + hstep, voffB); PG8_STAGE_A(PG8_SA(0, 0), a2, 0);
            PG8_WAIT_V(8); PG8_WAIT_L(0); PG8_BAR; PG8_MMA(1, 0, At, B0); PG8_MMA(1, 1, At, B1); PG8_BAR; PG8_SCHED;
            PG8_LDB(B0, 1, 0); PG8_LDB(B1, 1, 1); PG8_SCHED; PG8_LDA(At, 1, 0); PG8_STAGE_A(PG8_SA(0, 1), a2, 1);
            PG8_WAIT_V(8); PG8_WAIT_L(0); PG8_BAR; PG8_MMA(0, 0, At, B0); PG8_MMA(0, 1, At, B1); PG8_BAR; PG8_SCHED;
            PG8_LDA(At, 1, 1); PG8_STAGE(PG8_SB(1, 0), b3, voffB); PG8_STAGE(PG8_SB(1, 1), b3 + hstep, voffB); PG8_STAGE_A(PG8_SA(1, 0), a3, 0);
            PG8_WAIT_V(8); PG8_WAIT_L(0); PG8_BAR; PG8_MMA(1, 0, At, B0); PG8_MMA(1, 1, At, B1); PG8_BAR; PG8_SCHED;
        }
        if (wr == 0) PG8_BAR;
        if constexpr (FP8) asm volatile("s_nop 15\n\ts_nop 15" ::: "memory");
        E(acc, cur, wr, wc, fr, fq);
        if (!has_next) break;
#pragma unroll
        for (int a = 0; a < 2; ++a)
#pragma unroll
            for (int b = 0; b < 2; ++b)
#pragma unroll
                for (int m = 0; m < 4; ++m)
#pragma unroll
                    for (int n = 0; n < 2; ++n) acc[a][b][m][n] = (f32x4){0.f, 0.f, 0.f, 0.f};
        cur = nxt; cA = nA; cB = nB; ++ui;
        if (wr == 1) PG8_BAR;
    }
    PG8_WAIT_V(0);
    PG8_BAR;
#undef PG8_SA
#undef PG8_SB
#undef PG8_STAGE
#undef PG8_STAGE_A
#undef PG8_GOFF
#undef PG8_LDA
#undef PG8_LDB
#undef PG8_MMA
#undef PG8_WAIT_V
#undef PG8_WAIT_L
#undef PG8_BAR
#undef PG8_SCHED
}
}

struct EpiInProj {
    bf16_t* O;
    __device__ __forceinline__ void operator()(const f32x4 (&acc)[2][2][4][2], const pg8::Unit& u, int wr, int wc, int fr, int fq) const {
        const int row0 = u.pm * 256 + wr * 64 + fr, col0 = u.pn * 256 + wc * 32 + 8 * fq;
        const float sc = (u.pn == 7 || u.pn == 8) ? QSCALE : 1.0f;
#pragma unroll
        for (int ai = 0; ai < 2; ++ai)
#pragma unroll
            for (int m = 0; m < 4; ++m) { bf16_t* rowp = O + (size_t)(row0 + ai * 128 + m * 16) * IC + col0;
#pragma unroll
                for (int bj = 0; bj < 2; ++bj) { const f32x4 v0 = acc[ai][bj][m][0] * sc, v1 = acc[ai][bj][m][1] * sc;
                    u32x4 w; w.x = cvtpk(v0[0], v0[1]); w.y = cvtpk(v0[2], v0[3]); w.z = cvtpk(v1[0], v1[1]); w.w = cvtpk(v1[2], v1[3]);
                    *(u32x4*)(rowp + bj * 128) = w; } }
    }
};
struct EpiOutProj {
    const float* x; const float* mod; float* O;
    __device__ __forceinline__ void operator()(const f32x4 (&acc)[2][2][4][2], const pg8::Unit& u, int wr, int wc, int fr, int fq) const {
        const int row0 = u.pm * 256 + wr * 64 + fr, col0 = u.pn * 256 + wc * 32 + 8 * fq;
        const int b = (u.pm * 256) / SEQ;
        const float* g1 = mod + b * 6144 + 2048;
        f32x4 gv[2][2];
#pragma unroll
        for (int bj = 0; bj < 2; ++bj)
#pragma unroll
            for (int n = 0; n < 2; ++n) gv[bj][n] = *(const f32x4*)(g1 + col0 + bj * 128 + 4 * n);
#pragma unroll
        for (int ai = 0; ai < 2; ++ai)
#pragma unroll
            for (int m = 0; m < 4; ++m) { const size_t off = (size_t)(row0 + ai * 128 + m * 16) * D + col0;
#pragma unroll
                for (int bj = 0; bj < 2; ++bj)
#pragma unroll
                    for (int n = 0; n < 2; ++n) { const f32x4 xv = *(const f32x4*)(x + off + bj * 128 + 4 * n);
                        *(f32x4*)(O + off + bj * 128 + 4 * n) = xv + gv[bj][n] * acc[ai][bj][m][n]; } }
    }
};
constexpr float Q_H2 = 8.0f, Q_W = 32.0f, Q_ACT = 4.0f;
__device__ __forceinline__ unsigned cvt4_fp8(float a, float b, float c, float d) { unsigned w = 0u; w = (unsigned)__builtin_amdgcn_cvt_pk_fp8_f32(a, b, (int)w, false); w = (unsigned)__builtin_amdgcn_cvt_pk_fp8_f32(c, d, (int)w, true); return w; }
struct EpiMoe1 {
    const float* bgu; unsigned char* O;
    __device__ __forceinline__ void operator()(const f32x4 (&acc)[2][2][4][2], const pg8::Unit& u, int wr, int wc, int fr, int fq) const {
        const int row0 = u.pm * 256 + wr * 64 + fr, col0 = u.pn * 128 + wc * 32 + 8 * fq;
        const float* bg = bgu + (size_t)u.e * 2048 + col0;
        constexpr float dq = 1.0f / (Q_H2 * Q_W);
        f32x4 bgv[2], buv[2];
#pragma unroll
        for (int n = 0; n < 2; ++n) { bgv[n] = *(const f32x4*)(bg + 4 * n); buv[n] = *(const f32x4*)(bg + 1024 + 4 * n); }
#pragma unroll
        for (int ai = 0; ai < 2; ++ai)
#pragma unroll
            for (int m = 0; m < 4; ++m) { float a[8];
#pragma unroll
                for (int n = 0; n < 2; ++n) { const f32x4 gt = acc[ai][0][m][n] * dq + bgv[n], up = acc[ai][1][m][n] * dq + buv[n];
#pragma unroll
                    for (int j = 0; j < 4; ++j) { const float gg = fminf(gt[j], 7.0f), uu = fminf(fmaxf(up[j], -7.0f), 7.0f);
                        a[4 * n + j] = Q_ACT * (uu + 1.0f) * (gg * __builtin_amdgcn_rcpf(1.0f + __builtin_amdgcn_exp2f(-1.702f * LOG2E * gg))); } }
                u32x2 w; w.x = cvt4_fp8(a[0], a[1], a[2], a[3]); w.y = cvt4_fp8(a[4], a[5], a[6], a[7]);
                *(u32x2*)(O + (size_t)(row0 + ai * 128 + m * 16) * 1024 + col0) = w; }
    }
};
struct EpiMoe2 {
    const float* bdn; bf16_t* O;
    __device__ __forceinline__ void operator()(const f32x4 (&acc)[2][2][4][2], const pg8::Unit& u, int wr, int wc, int fr, int fq) const {
        const int row0 = u.pm * 256 + wr * 64 + fr, col0 = u.pn * 256 + wc * 32 + 8 * fq;
        const float* bd = bdn + (size_t)u.e * 1024 + col0;
        constexpr float dq = 1.0f / (Q_ACT * Q_W);
        f32x4 bv[2][2];
#pragma unroll
        for (int bj = 0; bj < 2; ++bj)
#pragma unroll
            for (int n = 0; n < 2; ++n) bv[bj][n] = *(const f32x4*)(bd + bj * 128 + 4 * n);
#pragma unroll
        for (int ai = 0; ai < 2; ++ai)
#pragma unroll
            for (int m = 0; m < 4; ++m) { bf16_t* rowp = O + (size_t)(row0 + ai * 128 + m * 16) * 1024 + col0;
#pragma unroll
                for (int bj = 0; bj < 2; ++bj) { const f32x4 v0 = acc[ai][bj][m][0] * dq + bv[bj][0], v1 = acc[ai][bj][m][1] * dq + bv[bj][1];
                    u32x4 w; w.x = cvtpk(v0[0], v0[1]); w.y = cvtpk(v0[2], v0[3]); w.z = cvtpk(v1[0], v1[1]); w.w = cvtpk(v1[2], v1[3]);
                    *(u32x4*)(rowp + bj * 128) = w; } }
    }
};

__device__ __forceinline__ void phase_mod(const Params& p, unsigned char* lds, int G) {
    const int tid = opaque_tid(), lane = tid & 63, wave = tid >> 6;
    float* sc = (float*)lds;
    const float* c = p.in[I_C];
    for (int i = tid; i < 8192; i += NTHREADS) { const int b = i & 7, k = i >> 3; const float cv = c[b * 1024 + k]; sc[k * 8 + b] = cv / (1.0f + __expf(-cv)); }
    __syncthreads();
    float* mod = (float*)(p.ws + WS_MOD);
    const float* mw = p.in[I_MODW]; const float* mb = p.in[I_MODB];
    for (int item = wave * G + (int)blockIdx.x; item < 192; item += NWAVES * G) {
        const int col = item * 32 + (lane & 31), kh = lane >> 5;
        float acc[8];
#pragma unroll
        for (int b = 0; b < 8; ++b) acc[b] = 0.f;
        const float* wp = mw + (size_t)(kh * 512) * 6144 + col;
        const float* sp = sc + (kh * 512) * 8;
#pragma unroll 8
        for (int k = 0; k < 512; ++k) { const float wv = wp[(size_t)k * 6144]; const f32x4 s0 = *(const f32x4*)(sp + k * 8), s1 = *(const f32x4*)(sp + k * 8 + 4);
            acc[0] += s0[0] * wv; acc[1] += s0[1] * wv; acc[2] += s0[2] * wv; acc[3] += s0[3] * wv; acc[4] += s1[0] * wv; acc[5] += s1[1] * wv; acc[6] += s1[2] * wv; acc[7] += s1[3] * wv; }
#pragma unroll
        for (int b = 0; b < 8; ++b) acc[b] += __shfl_xor(acc[b], 32);
        if (lane < 32) {
            const float bias = mb[col];
#pragma unroll
            for (int b = 0; b < 8; ++b) mod[b * 6144 + col] = acc[b] + bias;
        }
    }
    __syncthreads();
}
__device__ __forceinline__ void transpose_item(const float* W, int N, int k0, int n0, bf16_t* WT, int Kdst, int dst_row_base, bool gu_interleave, float* scr, int lane) {
#pragma unroll 4
    for (int i = 0; i < 16; ++i) { const int row = 4 * i + (lane >> 4), c4 = lane & 15;
        const f32x4 v = *(const f32x4*)(W + (size_t)(k0 + row) * N + n0 + 4 * c4);
        float* s = scr + row * 65 + 4 * c4; s[0] = v[0]; s[1] = v[1]; s[2] = v[2]; s[3] = v[3]; }
    asm volatile("s_waitcnt lgkmcnt(0)" ::: "memory");
    const int cch = lane & 7;
#pragma unroll
    for (int i = 0; i < 8; ++i) { const int n = 8 * i + (lane >> 3); const float* s = scr + (8 * cch) * 65 + n;
        u32x4 o; o.x = cvtpk(s[0], s[65]); o.y = cvtpk(s[2 * 65], s[3 * 65]); o.z = cvtpk(s[4 * 65], s[5 * 65]); o.w = cvtpk(s[6 * 65], s[7 * 65]);
        int nn = n0 + n;
        if (gu_interleave) nn = (nn < 1024) ? ((nn >> 7) * 256 + (nn & 127)) : (((nn - 1024) >> 7) * 256 + 128 + ((nn - 1024) & 127));
        *(u32x4*)(WT + (size_t)(dst_row_base + nn) * Kdst + k0 + 8 * cch) = o; }
    asm volatile("s_waitcnt lgkmcnt(0)" ::: "memory");
}
__device__ __forceinline__ void transpose_item_fp8(const float* W, int N, int k0, int n0, unsigned char* WT, int dst_row_base, bool gu_interleave, float* scr, int lane) {
#pragma unroll 4
    for (int i = 0; i < 16; ++i) { const int row = 4 * i + (lane >> 4), c4 = lane & 15;
        const f32x4 v = *(const f32x4*)(W + (size_t)(k0 + row) * N + n0 + 4 * c4);
        float* s = scr + row * 65 + 4 * c4; s[0] = v[0]; s[1] = v[1]; s[2] = v[2]; s[3] = v[3]; }
    asm volatile("s_waitcnt lgkmcnt(0)" ::: "memory");
    const int cch = lane & 3;
#pragma unroll
    for (int i = 0; i < 4; ++i) { const int n = 16 * i + (lane >> 2); const float* s = scr + (16 * cch) * 65 + n;
        u32x4 o;
        o.x = cvt4_fp8(Q_W * s[0], Q_W * s[65], Q_W * s[2 * 65], Q_W * s[3 * 65]); o.y = cvt4_fp8(Q_W * s[4 * 65], Q_W * s[5 * 65], Q_W * s[6 * 65], Q_W * s[7 * 65]);
        o.z = cvt4_fp8(Q_W * s[8 * 65], Q_W * s[9 * 65], Q_W * s[10 * 65], Q_W * s[11 * 65]); o.w = cvt4_fp8(Q_W * s[12 * 65], Q_W * s[13 * 65], Q_W * s[14 * 65], Q_W * s[15 * 65]);
        int nn = n0 + n;
        if (gu_interleave) nn = (nn < 1024) ? ((nn >> 7) * 256 + (nn & 127)) : (((nn - 1024) >> 7) * 256 + 128 + ((nn - 1024) & 127));
        *(u32x4*)(WT + (size_t)(dst_row_base + nn) * 1024 + k0 + 16 * cch) = o; }
    asm volatile("s_waitcnt lgkmcnt(0)" ::: "memory");
}
__device__ __forceinline__ void phase_convert(const Params& p, unsigned char* lds, int G) {
    const int tid = opaque_tid(), lane = tid & 63, wave = tid >> 6;
    float* scr = (float*)lds + wave * (64 * 65);
    const int gw = (int)blockIdx.x * NWAVES + wave, NGW = G * NWAVES;
    constexpr int I_IN = 16 * 52, I_OUT = 16 * 16, I_GU = 32 * 16 * 32, I_DN = 32 * 16 * 16, NITEMS = I_IN + I_OUT + I_GU + I_DN;
    bf16_t* win_t = (bf16_t*)(p.ws + WS_WIN_T); bf16_t* wout_t = (bf16_t*)(p.ws + WS_WOUT_T); unsigned char* wg_t = p.ws + WS_WG_T; unsigned char* wd_t = p.ws + WS_WD_T;
    for (int it = gw; it < NITEMS; it += NGW) {
        int r = it;
        if (r < I_IN) { transpose_item(p.in[I_WIN], IC, (r / 52) * 64, (r % 52) * 64, win_t, 1024, 0, false, scr, lane); continue; } r -= I_IN;
        if (r < I_OUT) { transpose_item(p.in[I_WOUT], D, (r / 16) * 64, (r % 16) * 64, wout_t, 1024, 0, false, scr, lane); continue; } r -= I_OUT;
        if (r < I_GU) { const int e = r / 512, rr = r % 512; transpose_item_fp8(p.in[I_WGU] + (size_t)e * 1024 * 2048, 2048, (rr / 32) * 64, (rr % 32) * 64, wg_t, e * 2048, true, scr, lane); continue; } r -= I_GU;
        { const int e = r / 256, rr = r % 256; transpose_item_fp8(p.in[I_WDN] + (size_t)e * 1024 * 1024, 1024, (rr / 16) * 64, (rr % 16) * 64, wd_t, e * 1024, false, scr, lane); }
    }
}

__device__ __forceinline__ void phase_norm1(const Params& p, int G) {
    const int tid = opaque_tid(), lane = tid & 63, wave = tid >> 6;
    const int gw = (int)blockIdx.x * NWAVES + wave, NGW = G * NWAVES;
    const float* x = p.in[I_X]; const float* gain = p.in[I_N1G]; const float* mod = (const float*)(p.ws + WS_MOD);
    bf16_t* h = (bf16_t*)(p.ws + WS_H);
    for (int row = gw; row < T; row += NGW) {
        const int b = row / SEQ;
        const f32x4* xr = (const f32x4*)(x + (size_t)row * D) + lane;
        f32x4 v[4]; float s = 0.f;
#pragma unroll
        for (int j = 0; j < 4; ++j) { v[j] = xr[64 * j]; s += (v[j][0] * v[j][0] + v[j][1] * v[j][1]) + (v[j][2] * v[j][2] + v[j][3] * v[j][3]); }
        const float rstd = rsqrtf(wave_sum(s) * (1.0f / D) + NORM_EPS);
        const float* sh = mod + b * 6144; const float* scl = mod + b * 6144 + 1024;
        unsigned long long* o8 = (unsigned long long*)(h + (size_t)row * D) + lane;
#pragma unroll
        for (int j = 0; j < 4; ++j) { const int k = 4 * lane + 256 * j;
            const f32x4 g = *(const f32x4*)(gain + k), s1 = *(const f32x4*)(scl + k), s0 = *(const f32x4*)(sh + k);
            const f32x4 y = (v[j] * rstd) * g * (s1 + 1.0f) + s0;
            o8[64 * j] = (unsigned long long)cvtpk(y[0], y[1]) | ((unsigned long long)cvtpk(y[2], y[3]) << 32); }
    }
}

constexpr size_t CTL_KMAX = 57344;
__device__ __forceinline__ void kmax_pass(const Params& p, int G) {
    const int tid = opaque_tid(), lane = tid & 63, wave = tid >> 6;
    const bf16_t* proj = (const bf16_t*)(p.ws + WS_PROJ);
    unsigned* km = (unsigned*)(p.ws + WS_CTL + CTL_KMAX);
    const int TPB = T / G;
    float mx = 0.f; const int tok0 = (int)blockIdx.x * TPB;
    for (int ti = wave; ti < TPB; ti += NWAVES) {
        const u32x4 kv = *(const u32x4*)(proj + (size_t)(tok0 + ti) * IC + RC + 512 + 8 * lane);
        float ss = 0.f;
#pragma unroll
        for (int j = 0; j < 4; ++j) { const float a = __uint_as_float(kv[j] << 16), bq = __uint_as_float(kv[j] & 0xffff0000u); ss += a * a + bq * bq; }
        ss += __shfl_xor(ss, 1); ss += __shfl_xor(ss, 2); ss += __shfl_xor(ss, 4);
        mx = fmaxf(mx, ss);
    }
    if ((lane & 7) == 0) atomicMax(km + (tok0 / SEQ) * 8 + (lane >> 3), __float_as_uint(mx));
}

__device__ __forceinline__ s16x4 vtr(const LAS unsigned char* pp) { typedef short v4i16_t __attribute__((ext_vector_type(4))); return __builtin_bit_cast(s16x4, __builtin_amdgcn_ds_read_tr16_b64_v4i16((LAS v4i16_t*)pp)); }
constexpr int ATT_BUF = 32768;
__device__ __forceinline__ float att_max3(float a, float b, float c) { float r; asm("v_max3_f32 %0, %1, %2, %3" : "=v"(r) : "v"(a), "v"(b), "v"(c)); return r; }
constexpr int ATT_QROWS = 128, ATT_NQB = SEQ / ATT_QROWS, ATT_UNITS = NB * 4 * ATT_NQB;
__device__ __forceinline__ void attn_unit(const Params& p, LAS unsigned char* lds, int b, int h, int qb, float lam) {
    const int tid = opaque_tid(), lane = tid & 63, wid = __builtin_amdgcn_readfirstlane(tid >> 6), r32 = lane & 31, hi = lane >> 5;
    const int c = wid & 1, qblk = wid >> 1;
    const bf16_t* proj = (const bf16_t*)(p.ws + WS_PROJ) + (size_t)b * SEQ * IC;
    const int q0 = qb * ATT_QROWS, qw0 = q0 + 32 * qblk;
    const bf16_t* Qb = proj + RC + h * 128 + c * 64;
    const bf16_t* Kb = proj + RC + 512 + h * 128;
    const bf16_t* Vb = proj + RC + 1024 + h * 128;
    const float slope = exp2f(-2.0f * (float)(h + 1)) * LOG2E;
    f32x16 o[4];
#pragma unroll
    for (int d = 0; d < 4; ++d) o[d] = f32x16{};
    f32x16 cb0;
#pragma unroll
    for (int r = 0; r < 16; ++r) cb0[r] = slope * (float)((r & 3) + 8 * (r >> 2) + 4 * hi);
    const float c32 = slope * 32.0f;
    float m_ = 0.f, l_ = 0.f;
    const int NT = (q0 + ATT_QROWS) / 64;
    const bf16_t* ksrc = Kb + (size_t)lane * IC + wid * 8;
    const int p0i = wid, p1i = wid + 8;
    const bf16_t* vsrc0 = Vb + (size_t)(16 * (p0i & 3) + (lane >> 2)) * IC + (p0i >> 2) * 32 + (lane & 3) * 8;
    const bf16_t* vsrc1 = Vb + (size_t)(16 * (p1i & 3) + (lane >> 2)) * IC + (p1i >> 2) * 32 + (lane & 3) * 8;
#define ATT_GLDS(gsrc_, ldsdst_) do { unsigned keep_; asm volatile("s_mov_b32 %0, m0\n\ts_mov_b32 m0, %2\n\ts_nop 0\n\tglobal_load_lds_dwordx4 %1, off\n\ts_mov_b32 m0, %0" : "=&s"(keep_) : "v"(gsrc_), "s"(ldsdst_) : "memory"); } while (0)
    const unsigned lds0 = (unsigned)(uintptr_t)lds;
#define ATT_DMA(t, buf) do { const size_t ro = (size_t)(t) * 64 * IC; const unsigned bb_ = (unsigned)__builtin_amdgcn_readfirstlane((int)(lds0 + (buf) * ATT_BUF + wid * 1024)); \
        ATT_GLDS(ksrc + ro, bb_); ATT_GLDS(ksrc + ro + 64, bb_ + 8192u); ATT_GLDS(vsrc0 + ro, bb_ + 16384u); ATT_GLDS(vsrc1 + ro, bb_ + 16384u + 8192u); } while (0)
    ATT_DMA(NT - 1, 0); ATT_DMA(NT - 2, 1);
    bf16x8 qr[4];
#pragma unroll
    for (int d0 = 0; d0 < 4; ++d0) qr[d0] = *(const bf16x8*)(Qb + (size_t)(qw0 + r32) * IC + d0 * 16 + hi * 8);
    float qn;
    { float q2 = 0.f;
#pragma unroll
      for (int d0 = 0; d0 < 4; ++d0)
#pragma unroll
          for (int j = 0; j < 8; ++j) { const float x = bf2f((unsigned short)qr[d0][j]); q2 += x * x; }
      q2 += __shfl_xor(q2, 32);
      qn = sqrtf(q2 * ((const float*)(p.ws + WS_CTL + CTL_KMAX))[b * 8 + h * 2 + c]) * 1.002f + 0.01f; }
    asm volatile("" : "+v"(qr[0]), "+v"(qr[1]), "+v"(qr[2]), "+v"(qr[3]));
    asm volatile("s_waitcnt vmcnt(0)" ::: "memory");
    __builtin_amdgcn_s_barrier();
    const int voff = ((lane >> 4) & 1) * 32 + (lane & 3) * 8 + (4 * hi + ((lane & 15) >> 2)) * 64;
    const int qpos = qw0 + r32;
    const bool late = wid >= 4;
    bf16x8 pf[4]; bool pend = false;
    float mtrue = -INFINITY;
    LAS unsigned* vote = (LAS unsigned*)(lds + 4 * ATT_BUF + 64);
#define ATT_PV(slot_) do { const LAS unsigned char* vb_ = lds + (slot_) * ATT_BUF + 16384 + voff; \
        _Pragma("unroll") for (int dblk = 0; dblk < 4; ++dblk) { _Pragma("unroll") for (int ks = 0; ks < 4; ++ks) { \
            const s16x4 lo = vtr(vb_ + (dblk * 4 + ks) * 1024), hh = vtr(vb_ + (dblk * 4 + ks) * 1024 + 512); \
            const bf16x8 vf = (bf16x8){lo[0], lo[1], lo[2], lo[3], hh[0], hh[1], hh[2], hh[3]}; \
            o[dblk] = __builtin_amdgcn_mfma_f32_32x32x16_bf16(vf, pf[ks], o[dblk], 0, 0, 0); } } } while (0)
    int it = 0;
    for (; it < NT; ++it) {
        const int kt = NT - 1 - it, cur = it & 3;
        const bool issued = (it + 2 < NT);
        if (issued) ATT_DMA(kt - 2, (it + 2) & 3);
        const int k0 = kt * 64;
        if (late && pend) { ATT_PV((it - 1) & 3); pend = false; }
        if (k0 <= qw0 + 31) {
            const LAS unsigned char* bb = lds + cur * ATT_BUF;
            const bool need_mask = (k0 + 63 > qw0);
            const LAS unsigned char* kb = bb + c * 8192 + hi * 1024 + r32 * 16;
            f32x16 s0 = cb0, s1 = cb0;
#pragma unroll
            for (int d0 = 0; d0 < 4; ++d0) {
                const bf16x8 a0 = *(const LAS bf16x8*)(kb + d0 * 2048), a1 = *(const LAS bf16x8*)(kb + d0 * 2048 + 512);
                s0 = __builtin_amdgcn_mfma_f32_32x32x16_bf16(a0, qr[d0], s0, 0, 0, 0);
                s1 = __builtin_amdgcn_mfma_f32_32x32x16_bf16(a1, qr[d0], s1, 0, 0, 0);
            }
            if (need_mask) {
                const int dq = k0 - qpos + 4 * hi;
#pragma unroll
                for (int r = 0; r < 16; ++r) { if (dq + ((r & 3) + 8 * (r >> 2)) > 0) s0[r] = -INFINITY; if (dq + ((r & 3) + 8 * (r >> 2)) + 32 > 0) s1[r] = -INFINITY; }
            }
            const float tb = slope * (float)(k0 - qpos);
            float rm0 = att_max3(s0[0], s0[1], s0[2]), rm1 = att_max3(s1[0], s1[1], s1[2]);
#pragma unroll
            for (int r = 3; r < 15; r += 2) { rm0 = att_max3(rm0, s0[r], s0[r + 1]); rm1 = att_max3(rm1, s1[r], s1[r + 1]); }
            float rm = att_max3(rm0, s0[15], att_max3(rm1, s1[15], -INFINITY) + c32);
            rm += tb;
            rm = fmaxf(rm, __shfl_xor(rm, 32));
            mtrue = fmaxf(mtrue, rm);
            if (__any(rm > m_ + 8.0f)) {
                const float mn = fmaxf(m_, rm);
                const float alpha = __builtin_amdgcn_exp2f(m_ - mn);
                m_ = mn; l_ *= alpha;
#pragma unroll
                for (int d = 0; d < 4; ++d)
#pragma unroll
                    for (int r = 0; r < 16; ++r) o[d][r] *= alpha;
            }
            const float off = tb - m_, off1 = off + c32;
            float ps = 0.f;
#pragma unroll
            for (int r = 0; r < 16; ++r) { s0[r] = __builtin_amdgcn_exp2f(s0[r] + off); s1[r] = __builtin_amdgcn_exp2f(s1[r] + off1); ps += s0[r] + s1[r]; }
            l_ += ps;
#pragma unroll
            for (int ks = 0; ks < 2; ++ks) {
                u32x4 w0, w1;
                w0.x = cvtpk(s0[8 * ks + 0], s0[8 * ks + 1]); w0.y = cvtpk(s0[8 * ks + 2], s0[8 * ks + 3]); w0.z = cvtpk(s0[8 * ks + 4], s0[8 * ks + 5]); w0.w = cvtpk(s0[8 * ks + 6], s0[8 * ks + 7]);
                w1.x = cvtpk(s1[8 * ks + 0], s1[8 * ks + 1]); w1.y = cvtpk(s1[8 * ks + 2], s1[8 * ks + 3]); w1.z = cvtpk(s1[8 * ks + 4], s1[8 * ks + 5]); w1.w = cvtpk(s1[8 * ks + 6], s1[8 * ks + 7]);
                pf[ks] = __builtin_bit_cast(bf16x8, w0); pf[2 + ks] = __builtin_bit_cast(bf16x8, w1);
            }
            if (late) pend = true; else ATT_PV(cur);
        }
        { const bool neg = (qn + slope * (float)(k0 - 1 - qpos) <= mtrue - 50.0f);
          if (lane == 0) vote[(it & 1) * 8 + wid] = __all(neg) ? 1u : 0u; }
        if (issued) asm volatile("s_waitcnt vmcnt(4)" ::: "memory"); else asm volatile("s_waitcnt vmcnt(0)" ::: "memory");
        asm volatile("s_waitcnt lgkmcnt(0)" ::: "memory");
        __builtin_amdgcn_s_barrier();
        { const u32x4 va = *(const LAS u32x4*)(vote + (it & 1) * 8), vb2 = *(const LAS u32x4*)(vote + (it & 1) * 8 + 4);
          if ((va.x & va.y & va.z & va.w & vb2.x & vb2.y & vb2.z & vb2.w) != 0u) { ++it; break; } }
    }
    if (late && pend) ATT_PV((it - 1) & 3);
    asm volatile("s_waitcnt vmcnt(0) lgkmcnt(0)" ::: "memory");
    __builtin_amdgcn_s_barrier();
#undef ATT_PV
#undef ATT_DMA
#undef ATT_GLDS
    l_ += __shfl_xor(l_, 32);
    LAS float* xb = (LAS float*)(lds + qblk * 16384);
    if (c == 1) {
        const float i1 = lam / l_;
#pragma unroll
        for (int d = 0; d < 4; ++d)
#pragma unroll
            for (int r = 0; r < 16; ++r) xb[(d * 16 + r) * 64 + lane] = o[d][r] * i1;
    }
    __syncthreads();
    if (c == 0) {
        const float i0 = 1.0f / l_;
        float ss = 0.f;
#pragma unroll
        for (int d = 0; d < 4; ++d)
#pragma unroll
            for (int r = 0; r < 16; ++r) { const float v = o[d][r] * i0 - xb[(d * 16 + r) * 64 + lane]; o[d][r] = v; ss += v * v; }
        ss += __shfl_xor(ss, 32);
        const float rstd = rsqrtf(ss * (1.0f / 128.0f) + NORM_EPS) * (1.0f - LAMBDA_INIT);
        const float* sg = p.in[I_SUBLN];
        bf16_t* yo = (bf16_t*)(p.ws + WS_YMIX) + (size_t)(b * SEQ + qw0 + r32) * D + RW + h * 128;
#pragma unroll
        for (int d = 0; d < 4; ++d)
#pragma unroll
            for (int g = 0; g < 4; ++g) { const int dd = 32 * d + 8 * g + 4 * hi; const f32x4 gv = *(const f32x4*)(sg + dd);
                u32x2 w; w.x = cvtpk(o[d][4 * g] * rstd * gv[0], o[d][4 * g + 1] * rstd * gv[1]); w.y = cvtpk(o[d][4 * g + 2] * rstd * gv[2], o[d][4 * g + 3] * rstd * gv[3]);
                *(u32x2*)(yo + dd) = w; }
    }
    __syncthreads();
}

constexpr int RCH = 32;
constexpr int RK_R = 0, RK_KM = 8192, RK_DEC = 16384, RK_KK = 24576, RK_BB = 32768, RK_VV = 40960, RK_GG = 49152;
constexpr int RK_AW = 57344;
constexpr int RK_AA = RK_AW + 4608;
constexpr int RK_AG = RK_AA + 4608;
constexpr int RK_BON = RK_AG + 8704;
constexpr int RK_MU = RK_BON + 128;
constexpr int RK_RAW = 77824;
constexpr int RK_IM = RK_RAW + 33 * 1024;
constexpr int RK_LSEG = RK_IM + OPREC;
constexpr int RK_END = RK_LSEG + 2048;
static_assert(RK_MU + 1792 <= RK_RAW && RK_END <= LDS_BYTES - 64 && (RK_RAW % 1024) == 0, "rwkv prep LDS map");
template <int CTRL> __device__ __forceinline__ float dpp_add(float v) { return v + __builtin_bit_cast(float, __builtin_amdgcn_update_dpp(0, __builtin_bit_cast(int, v), CTRL, 0xf, 0xf, true)); }
__device__ __forceinline__ float red16(float v) {
    v = dpp_add<0xB1>(v);
    v = dpp_add<0x4E>(v);
    v = dpp_add<0x141>(v);
    v = dpp_add<0x140>(v);
    return v;
}
__device__ __forceinline__ int rk_piece_col(int pc, int h) {
    return pc < 8 ? h * 64 + 8 * pc : (pc < 16 ? 512 + h * 64 + 8 * (pc - 8) : (pc < 24 ? 1024 + h * 64 + 8 * (pc - 16) : 1536 + 8 * (pc - 24)));
}
#define RK_BAR() do { asm volatile("s_waitcnt lgkmcnt(0)" ::: "memory"); __builtin_amdgcn_s_barrier(); asm volatile("" ::: "memory"); } while (0)
__device__ __forceinline__ void rwkv_prep(const Params& p, LAS unsigned char* lds, int b, int h, int ch0, int ch1) {
    const int tid = opaque_tid(), lane = tid & 63, wid = __builtin_amdgcn_readfirstlane(tid >> 6);
    const bf16_t* proj = (const bf16_t*)(p.ws + WS_PROJ) + (size_t)b * SEQ * IC;
    LAS float* R_ = (LAS float*)(lds + RK_R); LAS float* KM_ = (LAS float*)(lds + RK_KM); LAS float* DEC_ = (LAS float*)(lds + RK_DEC); LAS float* KK_ = (LAS float*)(lds + RK_KK);
    LAS float* BB_ = (LAS float*)(lds + RK_BB); LAS float* VV_ = (LAS float*)(lds + RK_VV); LAS float* GG_ = (LAS float*)(lds + RK_GG); LAS float* BON_ = (LAS float*)(lds + RK_BON);
    LAS float* MU_ = (LAS float*)(lds + RK_MU);
    const int dpc = lane < 56 ? lane : 55;
    const bf16_t* dsrc = proj + rk_piece_col(dpc, h);
#define RK_DMA(t0_) do { for (int rho = wid; rho < 33; rho += NWAVES) { int tok = (t0_) - 1 + rho; tok = tok < 0 ? 0 : tok; \
        __builtin_amdgcn_global_load_lds((const unsigned*)(dsrc + (size_t)tok * IC), (LAS unsigned*)(lds + RK_RAW + rho * 1024), 16, 0, 0); } } while (0)
    RK_DMA(ch0 * RCH);
    if (tid < 448) MU_[tid] = p.in[I_MU][rk_piece_col(tid >> 3, h) + (tid & 7)];
    const int ntile = wid & 3, ttile = wid >> 2, fn = lane & 15, fk = lane >> 4;
    const int ncol = h * 64 + ntile * 16 + fn;
    bf16x8 bw[2], ba[2], bg[4];
    {
        const float* wup = p.in[I_WUP]; const float* aup = p.in[I_AUP]; const float* gup = p.in[I_GUP];
#pragma unroll
        for (int ks = 0; ks < 2; ++ks) { float t[8], u[8];
#pragma unroll
            for (int j = 0; j < 8; ++j) { const int k = 32 * ks + 8 * fk + j; t[j] = wup[k * RW + ncol]; u[j] = aup[k * RW + ncol]; }
            u32x4 a, c; a.x = cvtpk(t[0], t[1]); a.y = cvtpk(t[2], t[3]); a.z = cvtpk(t[4], t[5]); a.w = cvtpk(t[6], t[7]);
            c.x = cvtpk(u[0], u[1]); c.y = cvtpk(u[2], u[3]); c.z = cvtpk(u[4], u[5]); c.w = cvtpk(u[6], u[7]);
            bw[ks] = __builtin_bit_cast(bf16x8, a); ba[ks] = __builtin_bit_cast(bf16x8, c); }
#pragma unroll
        for (int ks = 0; ks < 4; ++ks) { float t[8];
#pragma unroll
            for (int j = 0; j < 8; ++j) { const int k = 32 * ks + 8 * fk + j; t[j] = gup[k * RW + ncol]; }
            u32x4 a; a.x = cvtpk(t[0], t[1]); a.y = cvtpk(t[2], t[3]); a.z = cvtpk(t[4], t[5]); a.w = cvtpk(t[6], t[7]);
            bg[ks] = __builtin_bit_cast(bf16x8, a); }
    }
    const float w0n = p.in[I_W0][ncol], a0n = p.in[I_A0][ncol];
    const int q16 = tid & 15, tk16 = tid >> 4;
    const f32x4 kkc = *(const f32x4*)(p.in[I_KK] + h * 64 + 4 * q16), kac = *(const f32x4*)(p.in[I_KA] + h * 64 + 4 * q16), rkc = *(const f32x4*)(p.in[I_RK] + h * 64 + 4 * q16);
    const size_t hb = (size_t)(b * 8 + h) * SEQ * 64;
    float* gVS = (float*)(p.ws + WS_VS) + hb; float* gGG = p.out + (size_t)16 * 1024 * 1024 + hb; float* gBON = (float*)(p.ws + WS_BON) + (size_t)(b * 8 + h) * SEQ;
    unsigned char* gOPS = p.ws + WS_OPS + (size_t)(b * 8 + h) * (SEQ / RCH) * OPREC;
    for (int ch = ch0; ch < ch1; ++ch) {
        const int t0 = ch * RCH;
        if (ch > ch0) { if (wid == 0) asm volatile("s_waitcnt vmcnt(8)" ::: "memory"); else if (wid == 1) asm volatile("s_waitcnt vmcnt(7)" ::: "memory"); else asm volatile("s_waitcnt vmcnt(6)" ::: "memory"); } else asm volatile("s_waitcnt vmcnt(0)" ::: "memory");
        RK_BAR();
#pragma unroll
        for (int it = 0; it < 4; ++it) { const int item = tid + it * NTHREADS;
            if (item < RCH * 56) { const int tk = item / 56, pc = item - tk * 56;
                const u32x4 cv = *(const LAS u32x4*)(lds + RK_RAW + (tk + 1) * 1024 + pc * 16);
                u32x4 pv = *(const LAS u32x4*)(lds + RK_RAW + tk * 1024 + pc * 16);
                if (t0 + tk == 0) pv = (u32x4){0u, 0u, 0u, 0u};
                const f32x4 m0 = *(const LAS f32x4*)(MU_ + pc * 8), m1 = *(const LAS f32x4*)(MU_ + pc * 8 + 4);
                float xv[8];
#pragma unroll
                for (int j = 0; j < 4; ++j) { const unsigned cw = cv[j], pw = pv[j];
                    const float c0 = __uint_as_float(cw << 16), c1 = __uint_as_float(cw & 0xffff0000u), p0 = __uint_as_float(pw << 16), p1 = __uint_as_float(pw & 0xffff0000u);
                    const float ma = (j < 2) ? m0[2 * j] : m1[2 * j - 4], mb = (j < 2) ? m0[2 * j + 1] : m1[2 * j - 3];
                    xv[2 * j] = c0 + ma * (p0 - c0); xv[2 * j + 1] = c1 + mb * (p1 - c1); }
                const int seg = pc >> 3, pi = pc & 7;
                if (seg <= 2) { LAS float* dst = (seg == 0 ? R_ : (seg == 1 ? KM_ : VV_)) + tk * 64 + 8 * pi;
                    *(LAS f32x4*)dst = (f32x4){xv[0], xv[1], xv[2], xv[3]}; *(LAS f32x4*)(dst + 4) = (f32x4){xv[4], xv[5], xv[6], xv[7]}; }
                else if (seg == 3) { u32x4 w; w.x = cvtpk(tanh_fast(xv[0]), tanh_fast(xv[1])); w.y = cvtpk(tanh_fast(xv[2]), tanh_fast(xv[3])); w.z = cvtpk(tanh_fast(xv[4]), tanh_fast(xv[5])); w.w = cvtpk(tanh_fast(xv[6]), tanh_fast(xv[7]));
                    *(LAS u32x4*)(lds + RK_AW + tk * 144 + 16 * pi) = w; }
                else if (seg == 4) { u32x4 w; w.x = cvtpk(xv[0], xv[1]); w.y = cvtpk(xv[2], xv[3]); w.z = cvtpk(xv[4], xv[5]); w.w = cvtpk(xv[6], xv[7]);
                    *(LAS u32x4*)(lds + RK_AA + tk * 144 + 16 * pi) = w; }
                else { u32x4 w; w.x = cvtpk(sigmoidf_(xv[0]), sigmoidf_(xv[1])); w.y = cvtpk(sigmoidf_(xv[2]), sigmoidf_(xv[3])); w.z = cvtpk(sigmoidf_(xv[4]), sigmoidf_(xv[5])); w.w = cvtpk(sigmoidf_(xv[6]), sigmoidf_(xv[7]));
                    *(LAS u32x4*)(lds + RK_AG + tk * 272 + (pc - 40) * 16) = w; }
            } }
        __syncthreads();
        if (ch + 1 < ch1) RK_DMA(t0 + RCH);
        {
            f32x4 cw = (f32x4){0.f, 0.f, 0.f, 0.f}, ca = cw, cg2 = cw;
            const int tok = ttile * 16 + fn;
#pragma unroll
            for (int ks = 0; ks < 2; ++ks) {
                const bf16x8 aw = *(const LAS bf16x8*)(lds + RK_AW + tok * 144 + (32 * ks + 8 * fk) * 2);
                const bf16x8 aa = *(const LAS bf16x8*)(lds + RK_AA + tok * 144 + (32 * ks + 8 * fk) * 2);
                cw = __builtin_amdgcn_mfma_f32_16x16x32_bf16(aw, bw[ks], cw, 0, 0, 0);
                ca = __builtin_amdgcn_mfma_f32_16x16x32_bf16(aa, ba[ks], ca, 0, 0, 0);
            }
#pragma unroll
            for (int ks = 0; ks < 4; ++ks) {
                const bf16x8 ag = *(const LAS bf16x8*)(lds + RK_AG + tok * 272 + (32 * ks + 8 * fk) * 2);
                cg2 = __builtin_amdgcn_mfma_f32_16x16x32_bf16(ag, bg[ks], cg2, 0, 0, 0);
            }
#pragma unroll
            for (int r = 0; r < 4; ++r) { const int tk = ttile * 16 + 4 * fk + r, n = ntile * 16 + fn;
                DEC_[tk * 64 + n] = -0.6065306597126334f * sigmoidf_(cw[r] + w0n);
                BB_[tk * 64 + n] = sigmoidf_(ca[r] + a0n);
                GG_[tk * 64 + n] = cg2[r]; }
        }
        RK_BAR();
        {
            const f32x4 kp = *(const LAS f32x4*)(KM_ + tk16 * 64 + 4 * q16), av = *(const LAS f32x4*)(BB_ + tk16 * 64 + 4 * q16), rr = *(const LAS f32x4*)(R_ + tk16 * 64 + 4 * q16);
            const f32x4 kkv = kp * kkc;
            const float nrm2 = red16((kkv[0] * kkv[0] + kkv[1] * kkv[1]) + (kkv[2] * kkv[2] + kkv[3] * kkv[3]));
            const f32x4 kkn = kkv * __builtin_amdgcn_rsqf(fmaxf(nrm2, 1e-24f));
            const f32x4 kmod = kp * ((av - 1.0f) * kac + 1.0f);
            const f32x4 t = rr * kmod * rkc;
            const float bs = red16((t[0] + t[1]) + (t[2] + t[3]));
            *(LAS f32x4*)(KK_ + tk16 * 64 + 4 * q16) = kkn; *(LAS f32x4*)(BB_ + tk16 * 64 + 4 * q16) = kkn * av; *(LAS f32x4*)(KM_ + tk16 * 64 + 4 * q16) = kmod;
            if (q16 == 0) BON_[tk16] = bs;
        }
        RK_BAR();
        {
            const int d1 = tid & 63, q1 = wid;
            float lw[4], cs[4];
#pragma unroll
            for (int e = 0; e < 4; ++e) lw[e] = DEC_[(4 * q1 + e) * 64 + d1];
            cs[0] = lw[0]; cs[1] = cs[0] + lw[1]; cs[2] = cs[1] + lw[2]; cs[3] = cs[2] + lw[3];
            ((LAS float*)(lds + RK_LSEG))[q1 * 64 + d1] = cs[3];
            { const float x0 = VV_[(4 * q1) * 64 + d1], x1 = VV_[(4 * q1 + 1) * 64 + d1], x2 = VV_[(4 * q1 + 2) * 64 + d1], x3 = VV_[(4 * q1 + 3) * 64 + d1];
              u32x2 w; w.x = cvtpk(x0, x1); w.y = cvtpk(x2, x3); *(LAS u32x2*)(lds + RK_IM + OP_VT + d1 * 80 + q1 * 8) = w; }
            RK_BAR();
            float off = 0.f, tot = 0.f;
#pragma unroll
            for (int qq = 0; qq < 8; ++qq) { const float sg = ((const LAS float*)(lds + RK_LSEG))[qq * 64 + d1]; tot += sg; if (qq < q1) off += sg; }
            const float etot = __expf(tot);
            float ePprev = __expf(off);
            float bc[4], kc4[4];
#pragma unroll
            for (int e = 0; e < 4; ++e) { const int tk = 4 * q1 + e;
                const float eP = __expf(off + cs[e]), eN = __builtin_amdgcn_rcpf(eP), eE = etot * eN;
                const float kap = KK_[tk * 64 + d1], bet = BB_[tk * 64 + d1], kk_ = KM_[tk * 64 + d1], rr = R_[tk * 64 + d1];
                const unsigned w0 = cvtpk(-kap * ePprev, rr * eP), w1 = cvtpk(bet * eN, kk_ * eN);
                *(LAS unsigned short*)(lds + RK_IM + OP_AT + tk * 144 + d1 * 2) = (unsigned short)(w0 & 0xffffu); *(LAS unsigned short*)(lds + RK_IM + OP_RT + tk * 144 + d1 * 2) = (unsigned short)(w0 >> 16);
                *(LAS unsigned short*)(lds + RK_IM + OP_BH + tk * 144 + d1 * 2) = (unsigned short)(w1 & 0xffffu); *(LAS unsigned short*)(lds + RK_IM + OP_KH + tk * 144 + d1 * 2) = (unsigned short)(w1 >> 16);
                bc[e] = bet * eE; kc4[e] = kk_ * eE; ePprev = eP; }
            u32x2 wb, wk; wb.x = cvtpk(bc[0], bc[1]); wb.y = cvtpk(bc[2], bc[3]); wk.x = cvtpk(kc4[0], kc4[1]); wk.y = cvtpk(kc4[2], kc4[3]);
            *(LAS u32x2*)(lds + RK_IM + OP_BCT + d1 * 80 + q1 * 8) = wb; *(LAS u32x2*)(lds + RK_IM + OP_KCT + d1 * 80 + q1 * 8) = wk;
            if (q1 == 0) ((LAS float*)(lds + RK_IM + OP_P31))[d1] = etot;
        }
        RK_BAR();
        {
            unsigned char* rec = gOPS + (size_t)ch * OPREC;
#pragma unroll
            for (int i = 0; i < 5; ++i) { const int o = (tid + i * NTHREADS) * 16; if (o < OPREC) *(u32x4*)(rec + o) = *(const LAS u32x4*)(lds + RK_IM + o); }
            const size_t go = (size_t)t0 * 64 + tid * 4;
            *(f32x4*)(gVS + go) = *(const LAS f32x4*)(VV_ + tid * 4);
            *(f32x4*)(gGG + go) = *(const LAS f32x4*)(GG_ + tid * 4);
            if (tid < RCH) gBON[t0 + tid] = BON_[tid];
        }
    }
    asm volatile("s_waitcnt vmcnt(0)" ::: "memory");
    __syncthreads();
#undef RK_DMA
}

constexpr int CS_IN = 32768;
constexpr int CS_OP = 2 * CS_IN;
constexpr int CS_AT = 0, CS_RT = 4608, CS_BH = 9216, CS_KH = 13824, CS_BCT = 18432, CS_KCT = 23552, CS_VT = 28672, CS_P31 = 31744;
constexpr int CS_MT2 = CS_OP, CS_MT3 = CS_OP + 2560, CS_MT4 = CS_OP + 5120;
constexpr int CS_M1F = CS_OP + 7680;
constexpr int CS_XF = CS_OP + 12288;
constexpr int CS_UB = CS_OP + 16896;
constexpr int CS_SB = CS_OP + 19456;
constexpr int CS_YY = CS_OP + 24064;
constexpr int CS_END = CS_OP + 28160;
static_assert(CS_END <= LDS_BYTES - 64, "rwkv scan LDS map");
__device__ __forceinline__ int crow32(int r, int hi) { return (r & 3) + 8 * (r >> 2) + 4 * hi; }
__device__ __forceinline__ void rwkv_scan(const Params& p, LAS unsigned char* lds, int b, int h, int half) {
    const int tid = opaque_tid(), lane = tid & 63, wid = __builtin_amdgcn_readfirstlane(tid >> 6), r32 = lane & 31, hi = lane >> 5;
    const unsigned char* gOPS = p.ws + WS_OPS + (size_t)(b * 8 + h) * (SEQ / RCH) * OPREC;
    float* yraw = p.out + (size_t)b * SEQ * RW + h * 64 + half * 32;
#define RS_DMA(ch_, buf) do { LAS unsigned char* bb_ = lds + (buf) * CS_IN; const unsigned char* rec_ = gOPS + (size_t)(ch_) * OPREC; \
        for (int pc = wid; pc < 32; pc += NWAVES) { \
            const unsigned char* src_ = rec_ + (pc < 28 ? pc * 1024 : (pc < 31 ? OP_VT + half * 2560 + (pc - 28) * 1024 : OP_P31)) + lane * 16; \
            __builtin_amdgcn_global_load_lds((const unsigned*)src_, (LAS unsigned*)(bb_ + pc * 1024), 16, 0, 0); } } while (0)
    RS_DMA(0, 0);
    for (int i = tid; i < 4608 / 4; i += NTHREADS) ((LAS unsigned*)(lds + CS_SB))[i] = 0u;
    f32x16 Sacc = f32x16{};
    f32x16 Xacc = f32x16{};
    for (int ch = 0; ch < SEQ / RCH; ++ch) {
        const int t0 = ch * RCH, cur = ch & 1;
        if (wid < 4 && ch > 0) asm volatile("s_waitcnt vmcnt(1)" ::: "memory"); else asm volatile("s_waitcnt vmcnt(0)" ::: "memory");
        RK_BAR();
        if (ch + 1 < SEQ / RCH) RS_DMA(ch + 1, cur ^ 1);
        const LAS unsigned char* ib = lds + cur * CS_IN;
        if (wid < 4) {
            const LAS unsigned char* Am = ib + ((wid & 1) ? CS_KH : CS_BH) + r32 * 144 + hi * 16;
            const LAS unsigned char* Bm = ib + ((wid & 2) ? CS_RT : CS_AT) + r32 * 144 + hi * 16;
            f32x16 acc = f32x16{};
#pragma unroll
            for (int ks = 0; ks < 4; ++ks) acc = __builtin_amdgcn_mfma_f32_32x32x16_bf16(*(const LAS bf16x8*)(Am + ks * 32), *(const LAS bf16x8*)(Bm + ks * 32), acc, 0, 0, 0);
            const int lim = (wid < 2) ? r32 : r32 + 1;
#pragma unroll
            for (int rg = 0; rg < 16; ++rg) if (crow32(rg, hi) >= lim) acc[rg] = 0.f;
            if (wid == 0) {
#pragma unroll
                for (int rg = 0; rg < 16; ++rg) ((LAS float*)(lds + CS_M1F))[crow32(rg, hi) * 36 + r32] = acc[rg];
            } else {
                LAS unsigned char* Mt = lds + (wid == 1 ? CS_MT2 : (wid == 2 ? CS_MT3 : CS_MT4)) + r32 * 80 + hi * 8;
#pragma unroll
                for (int g = 0; g < 4; ++g) { u32x2 w; w.x = cvtpk(acc[4 * g], acc[4 * g + 1]); w.y = cvtpk(acc[4 * g + 2], acc[4 * g + 3]); *(LAS u32x2*)(Mt + g * 16) = w; }
            }
        } else if (wid < 6) {
            const LAS unsigned char* Am = ib + (wid == 4 ? CS_AT : CS_RT) + r32 * 144 + hi * 16;
            const LAS unsigned char* Bm = lds + CS_SB + r32 * 144 + hi * 16;
            Xacc = f32x16{};
#pragma unroll
            for (int ks = 0; ks < 4; ++ks) Xacc = __builtin_amdgcn_mfma_f32_32x32x16_bf16(*(const LAS bf16x8*)(Am + ks * 32), *(const LAS bf16x8*)(Bm + ks * 32), Xacc, 0, 0, 0);
        }
        RK_BAR();
        if (wid == 4) {
            const LAS unsigned char* Am = lds + CS_MT2 + r32 * 80 + hi * 16;
            const LAS unsigned char* Bm = ib + CS_VT + r32 * 80 + hi * 16;
#pragma unroll
            for (int ks = 0; ks < 2; ++ks) Xacc = __builtin_amdgcn_mfma_f32_32x32x16_bf16(*(const LAS bf16x8*)(Am + ks * 32), *(const LAS bf16x8*)(Bm + ks * 32), Xacc, 0, 0, 0);
#pragma unroll
            for (int g = 0; g < 4; ++g) *(LAS f32x4*)(lds + CS_XF + r32 * 144 + (8 * g + 4 * hi) * 4) = (f32x4){Xacc[4 * g], Xacc[4 * g + 1], Xacc[4 * g + 2], Xacc[4 * g + 3]};
        }
        RK_BAR();
        {
            const int v = tid >> 4, l = tid & 15;
            float m0[32], m1[32];
#pragma unroll
            for (int c4 = 0; c4 < 8; ++c4) { const f32x4 a = *(const LAS f32x4*)(lds + CS_M1F + l * 144 + c4 * 16), c = *(const LAS f32x4*)(lds + CS_M1F + (l + 16) * 144 + c4 * 16);
                m0[4 * c4] = a[0]; m0[4 * c4 + 1] = a[1]; m0[4 * c4 + 2] = a[2]; m0[4 * c4 + 3] = a[3]; m1[4 * c4] = c[0]; m1[4 * c4 + 1] = c[1]; m1[4 * c4 + 2] = c[2]; m1[4 * c4 + 3] = c[3]; }
            const float x0 = ((const LAS float*)(lds + CS_XF))[v * 36 + l], x1 = ((const LAS float*)(lds + CS_XF))[v * 36 + l + 16];
            float u0 = 0.f, u1 = 0.f;
#pragma unroll
            for (int i = 0; i < 32; ++i) {
                const float part = (i < 16) ? u0 * m0[i] : (u0 * m0[i] + u1 * m1[i]);
                const float tot = red16(part);
                if (i < 16) u0 = (l == i) ? x0 + tot : u0; else u1 = (l == i - 16) ? x1 + tot : u1;
            }
            const unsigned w = cvtpk(u0, u1);
            *(LAS unsigned short*)(lds + CS_UB + v * 80 + l * 2) = (unsigned short)(w & 0xffffu); *(LAS unsigned short*)(lds + CS_UB + v * 80 + (l + 16) * 2) = (unsigned short)(w >> 16);
        }
        RK_BAR();
        if (wid == 5) {
            const LAS unsigned char* A3 = lds + CS_MT3 + r32 * 80 + hi * 16; const LAS unsigned char* A4 = lds + CS_MT4 + r32 * 80 + hi * 16;
            const LAS unsigned char* Bu = lds + CS_UB + r32 * 80 + hi * 16; const LAS unsigned char* Bv = ib + CS_VT + r32 * 80 + hi * 16;
#pragma unroll
            for (int ks = 0; ks < 2; ++ks) { Xacc = __builtin_amdgcn_mfma_f32_32x32x16_bf16(*(const LAS bf16x8*)(A3 + ks * 32), *(const LAS bf16x8*)(Bu + ks * 32), Xacc, 0, 0, 0);
                Xacc = __builtin_amdgcn_mfma_f32_32x32x16_bf16(*(const LAS bf16x8*)(A4 + ks * 32), *(const LAS bf16x8*)(Bv + ks * 32), Xacc, 0, 0, 0); }
#pragma unroll
            for (int rg = 0; rg < 16; ++rg) ((LAS float*)(lds + CS_YY))[crow32(rg, hi) * 32 + r32] = Xacc[rg];
        } else if (wid < 2) {
#pragma unroll
            for (int g = 0; g < 4; ++g) { const f32x4 pv = *(const LAS f32x4*)(ib + CS_P31 + (32 * wid + 8 * g + 4 * hi) * 4);
                Sacc[4 * g] *= pv[0]; Sacc[4 * g + 1] *= pv[1]; Sacc[4 * g + 2] *= pv[2]; Sacc[4 * g + 3] *= pv[3]; }
            const LAS unsigned char* Ab = ib + CS_BCT + (32 * wid + r32) * 80 + hi * 16; const LAS unsigned char* Ak = ib + CS_KCT + (32 * wid + r32) * 80 + hi * 16;
            const LAS unsigned char* Bu = lds + CS_UB + r32 * 80 + hi * 16; const LAS unsigned char* Bv = ib + CS_VT + r32 * 80 + hi * 16;
#pragma unroll
            for (int ks = 0; ks < 2; ++ks) { Sacc = __builtin_amdgcn_mfma_f32_32x32x16_bf16(*(const LAS bf16x8*)(Ab + ks * 32), *(const LAS bf16x8*)(Bu + ks * 32), Sacc, 0, 0, 0);
                Sacc = __builtin_amdgcn_mfma_f32_32x32x16_bf16(*(const LAS bf16x8*)(Ak + ks * 32), *(const LAS bf16x8*)(Bv + ks * 32), Sacc, 0, 0, 0); }
#pragma unroll
            for (int g = 0; g < 4; ++g) { u32x2 w; w.x = cvtpk(Sacc[4 * g], Sacc[4 * g + 1]); w.y = cvtpk(Sacc[4 * g + 2], Sacc[4 * g + 3]); *(LAS u32x2*)(lds + CS_SB + r32 * 144 + (32 * wid + 8 * g + 4 * hi) * 2) = w; }
        }
        RK_BAR();
        if (tid < 256) { const int tk = tid >> 3, sub = tid & 7; *(f32x4*)(yraw + (size_t)(t0 + tk) * RW + sub * 4) = *(const LAS f32x4*)(lds + CS_YY + tk * 128 + sub * 16); }
    }
    asm volatile("s_waitcnt vmcnt(0)" ::: "memory");
    __syncthreads();
#undef RS_DMA
}
__device__ __forceinline__ void rwkv_finalize(const Params& p, int G) {
    const int tid = opaque_tid(), q16 = tid & 15;
    const float* yraw = p.out; const float* gGG = p.out + (size_t)16 * 1024 * 1024; const float* gVS = (const float*)(p.ws + WS_VS); const float* gBON = (const float*)(p.ws + WS_BON);
    bf16_t* ymix = (bf16_t*)(p.ws + WS_YMIX);
    for (int item = (int)blockIdx.x * (NTHREADS / 16) + (tid >> 4); item < T * 8; item += G * (NTHREADS / 16)) {
        const int tok = item >> 3, h = item & 7, b = tok / SEQ, t = tok - b * SEQ;
        const f32x4 y = *(const f32x4*)(yraw + (size_t)tok * RW + h * 64 + 4 * q16);
        const size_t ho = ((size_t)(b * 8 + h) * SEQ + t) * 64 + 4 * q16;
        const f32x4 vv = *(const f32x4*)(gVS + ho), gg = *(const f32x4*)(gGG + ho);
        const float bon = gBON[(size_t)(b * 8 + h) * SEQ + t];
        const f32x4 gng = *(const f32x4*)(p.in[I_GNG] + h * 64 + 4 * q16), gnb = *(const f32x4*)(p.in[I_GNB] + h * 64 + 4 * q16);
        const float mean = red16((y[0] + y[1]) + (y[2] + y[3])) * (1.0f / 64.0f);
        const f32x4 dl = y - mean;
        const float var = red16((dl[0] * dl[0] + dl[1] * dl[1]) + (dl[2] * dl[2] + dl[3] * dl[3])) * (1.0f / 64.0f);
        const f32x4 yn = dl * __builtin_amdgcn_rsqf(var + GN_EPS) * gng + gnb;
        const f32x4 ov = (yn + vv * bon) * gg;
        u32x2 w; w.x = cvtpk(ov[0], ov[1]); w.y = cvtpk(ov[2], ov[3]);
        *(u32x2*)(ymix + (size_t)tok * D + h * 64 + 4 * q16) = w;
    }
}
#undef RK_BAR

constexpr int RT_PITCH = 36;
__device__ __forceinline__ void phase_router(const Params& p, LAS unsigned char* lds, int G) {
    const int tid = opaque_tid(), lane = tid & 63, wave = tid >> 6;
    LAS float* wr_ = (LAS float*)lds;
    LAS int* hist = (LAS int*)(lds + 147456);
    const float* rw = p.in[I_RTW];
    for (int i = tid; i < 1024 * 8; i += NTHREADS) { const int k = i >> 3, c4 = i & 7; const f32x4 v = *(const f32x4*)(rw + k * 32 + 4 * c4);
        const int ln = (k & 255) >> 2, ii = k & 3, jj = k >> 8; *(LAS f32x4*)(wr_ + ((ii + 4 * jj) * 64 + ln) * RT_PITCH + 4 * c4) = v; }
    const float* x1 = p.out; const float* gain = p.in[I_N2G]; const float* mod = (const float*)(p.ws + WS_MOD); const float* rb = p.in[I_RTB];
    unsigned char* h2q = p.ws + WS_H;
    int* ridx = (int*)(p.ws + WS_ROUTE); float* rwt = (float*)(p.ws + WS_ROUTE + 512 * 1024);
    int* blockcnt = (int*)(p.ws + WS_CTL + 4096);
    const int TPB = T / G;
    for (int blk = blockIdx.x; blk < G; blk += G) {
        if (tid < 32) hist[tid] = 0;
        __syncthreads();
        for (int ti = wave; ti < TPB; ti += NWAVES) {
            const int row = blk * TPB + ti; const int b = row / SEQ;
            const f32x4* xr = (const f32x4*)(x1 + (size_t)row * D) + lane;
            f32x4 v[4]; float s = 0.f;
#pragma unroll
            for (int j = 0; j < 4; ++j) { v[j] = xr[64 * j]; s += (v[j][0] * v[j][0] + v[j][1] * v[j][1]) + (v[j][2] * v[j][2] + v[j][3] * v[j][3]); }
            const float rstd = rsqrtf(wave_sum(s) * (1.0f / D) + NORM_EPS);
            const float* sh = mod + b * 6144 + 3072; const float* scl = mod + b * 6144 + 4096;
            unsigned* o4 = (unsigned*)(h2q + (size_t)row * D) + lane;
            float acc[32];
#pragma unroll
            for (int e = 0; e < 32; ++e) acc[e] = 0.f;
#pragma unroll
            for (int j = 0; j < 4; ++j) { const int k = 4 * lane + 256 * j;
                const f32x4 g = *(const f32x4*)(gain + k), s1 = *(const f32x4*)(scl + k), s0 = *(const f32x4*)(sh + k);
                const f32x4 y = (v[j] * rstd) * g * (s1 + 1.0f) + s0;
                o4[64 * j] = cvt4_fp8(Q_H2 * y[0], Q_H2 * y[1], Q_H2 * y[2], Q_H2 * y[3]);
#pragma unroll
                for (int i = 0; i < 4; ++i) { const LAS float* wrow = wr_ + ((i + 4 * j) * 64 + lane) * RT_PITCH; const float yv = y[i];
#pragma unroll
                    for (int c4 = 0; c4 < 8; ++c4) { const f32x4 wv = *(const LAS f32x4*)(wrow + 4 * c4);
                        acc[4 * c4 + 0] += yv * wv[0]; acc[4 * c4 + 1] += yv * wv[1]; acc[4 * c4 + 2] += yv * wv[2]; acc[4 * c4 + 3] += yv * wv[3]; } } }
            float r16[16];
#pragma unroll
            for (int e = 0; e < 16; ++e) { const bool up = (lane & 32) != 0; const float keep = up ? acc[e + 16] : acc[e], send = up ? acc[e] : acc[e + 16]; r16[e] = keep + __shfl_xor(send, 32); }
            float r8[8];
#pragma unroll
            for (int e = 0; e < 8; ++e) { const bool up = (lane & 16) != 0; const float keep = up ? r16[e + 8] : r16[e], send = up ? r16[e] : r16[e + 8]; r8[e] = keep + __shfl_xor(send, 16); }
            float r4[4];
#pragma unroll
            for (int e = 0; e < 4; ++e) { const bool up = (lane & 8) != 0; const float keep = up ? r8[e + 4] : r8[e], send = up ? r8[e] : r8[e + 4]; r4[e] = keep + __shfl_xor(send, 8); }
            float r2[2];
#pragma unroll
            for (int e = 0; e < 2; ++e) { const bool up = (lane & 4) != 0; const float keep = up ? r4[e + 2] : r4[e], send = up ? r4[e] : r4[e + 2]; r2[e] = keep + __shfl_xor(send, 4); }
            float r1;
            { const bool up = (lane & 2) != 0; const float keep = up ? r2[1] : r2[0], send = up ? r2[0] : r2[1]; r1 = keep + __shfl_xor(send, 2); }
            r1 += __shfl_xor(r1, 1);
            const int e_l = lane >> 1;
            float logit = r1 + rb[e_l];
            int sel[4]; float sv[4];
#pragma unroll
            for (int k = 0; k < 4; ++k) { const float mx = wave_max(logit); const unsigned long long bal = __ballot(logit == mx); const int ln = __ffsll((long long)bal) - 1;
                sel[k] = ln >> 1; sv[k] = mx; if (e_l == sel[k]) logit = -INFINITY; }
            const float e1 = __expf(sv[1] - sv[0]), e2 = __expf(sv[2] - sv[0]), e3 = __expf(sv[3] - sv[0]); const float inv = 1.0f / (1.0f + e1 + e2 + e3);
            if (lane == 0) { *(int4*)(ridx + (size_t)row * 4) = make_int4(sel[0], sel[1], sel[2], sel[3]); *(float4*)(rwt + (size_t)row * 4) = make_float4(inv, e1 * inv, e2 * inv, e3 * inv);
                atomicAdd((int*)&hist[sel[0]], 1); atomicAdd((int*)&hist[sel[1]], 1); atomicAdd((int*)&hist[sel[2]], 1); atomicAdd((int*)&hist[sel[3]], 1); }
        }
        __syncthreads();
        if (tid < 32) blockcnt[blk * 32 + tid] = hist[tid];
        __syncthreads();
    }
}

__device__ __forceinline__ void phase_assign(const Params& p, LAS unsigned char* lds, int G) {
    const int tid = opaque_tid(), lane = tid & 63, wave = tid >> 6;
    LAS int* part = (LAS int*)lds;
    LAS int* partb = part + 512;
    LAS int* total = partb + 512;
    LAS int* base = total + 32;
    LAS int* segst = base + 32;
    LAS int* cursor = segst + 32;
    LAS int* slotl = cursor + 32;
    const int* blockcnt = (const int*)(p.ws + WS_CTL + 4096);
    const int* ridx = (const int*)(p.ws + WS_ROUTE); int* rslot = (int*)(p.ws + WS_ROUTE + 1024 * 1024); int* tokmap = (int*)(p.ws + WS_ROUTE + 2 * 1024 * 1024);
    const bf16_t* h2 = (const bf16_t*)(p.ws + WS_H); bf16_t* xs = (bf16_t*)(p.ws + WS_PROJ);
    int* tile = (int*)(p.ws + WS_TILE);
    const int TPB = T / G; const int blk = blockIdx.x;
    { const int e = tid & 31, part_i = tid >> 5; int st = 0, sb = 0;
        for (int bb = part_i; bb < G; bb += 16) { const int c = blockcnt[bb * 32 + e]; st += c; if (bb < blk) sb += c; }
        part[part_i * 32 + e] = st; partb[part_i * 32 + e] = sb; }
    __syncthreads();
    if (tid < 32) { int st = 0, sb = 0;
#pragma unroll
        for (int i = 0; i < 16; ++i) { st += part[i * 32 + tid]; sb += partb[i * 32 + tid]; }
        total[tid] = st; base[tid] = sb; cursor[tid] = 0; }
    __syncthreads();
    if (tid == 0) { int acc = 0; for (int e = 0; e < 32; ++e) { segst[e] = acc; acc += (total[e] + 255) & ~255; }
        if (blk == 0) { int pm = 0; for (int e = 0; e < 32; ++e) { const int nt = (total[e] + 255) >> 8; for (int i = 0; i < nt; ++i) tile[16 + pm + i] = e; pm += nt; } tile[0] = pm; } }
    __syncthreads();
    if (tid < 32) base[tid] += segst[tid];
    __syncthreads();
    for (int a = tid; a < TPB * 4; a += NTHREADS) { const int tok = blk * TPB + (a >> 2); const int e = ridx[(size_t)tok * 4 + (a & 3)];
        const int rank = atomicAdd((int*)&cursor[e], 1); const int slot = base[e] + rank; rslot[(size_t)tok * 4 + (a & 3)] = slot; tokmap[slot] = tok; }
    for (int e = blk; e < 32; e += G) { const int s0 = segst[e] + total[e], s1 = segst[e] + ((total[e] + 255) & ~255);
        for (int r = s0 + tid; r < s1; r += NTHREADS) tokmap[r] = 0; }
}

__device__ __forceinline__ void phase_final(const Params& p, int G, int stage) {
    const int tid = opaque_tid(), lane = tid & 63, wave = tid >> 6;
    const int gw = (int)blockIdx.x * NWAVES + wave, NGW = G * NWAVES;
    const float* fg = p.in[I_FG]; const float* mod = (const float*)(p.ws + WS_MOD);
    const int* rslot = (const int*)(p.ws + WS_ROUTE + 1024 * 1024); const float* rwt = (const float*)(p.ws + WS_ROUTE + 512 * 1024);
    const bf16_t* Y = (const bf16_t*)(p.ws + WS_PROJ);
    const float* src = (stage >= 4) ? p.out : p.in[I_X];
    for (int row = gw; row < T; row += NGW) {
        const int b = row / SEQ;
        const f32x4* xr = (const f32x4*)(src + (size_t)row * D) + lane;
        f32x4 v[4];
#pragma unroll
        for (int j = 0; j < 4; ++j) v[j] = xr[64 * j];
        if (stage >= 9) {
            const int4 sl = *(const int4*)(rslot + (size_t)row * 4); const float4 wt = *(const float4*)(rwt + (size_t)row * 4);
            const float* g2 = mod + b * 6144 + 5120;
            const int sls[4] = {sl.x, sl.y, sl.z, sl.w}; const float wts[4] = {wt.x, wt.y, wt.z, wt.w};
#pragma unroll
            for (int j = 0; j < 4; ++j) { f32x4 m = (f32x4){0.f, 0.f, 0.f, 0.f};
#pragma unroll
                for (int k = 0; k < 4; ++k) { const u32x2 yv = *((const u32x2*)(Y + (size_t)sls[k] * D) + lane + 64 * j);
                    m[0] += wts[k] * __uint_as_float(yv.x << 16); m[1] += wts[k] * __uint_as_float(yv.x & 0xffff0000u); m[2] += wts[k] * __uint_as_float(yv.y << 16); m[3] += wts[k] * __uint_as_float(yv.y & 0xffff0000u); }
                const f32x4 g = *(const f32x4*)(g2 + 4 * lane + 256 * j); v[j] = v[j] + g * m; }
        }
        float s = 0.f;
#pragma unroll
        for (int j = 0; j < 4; ++j) s += (v[j][0] * v[j][0] + v[j][1] * v[j][1]) + (v[j][2] * v[j][2] + v[j][3] * v[j][3]);
        const float rstd = rsqrtf(wave_sum(s) * (1.0f / D) + NORM_EPS);
        f32x4* orow = (f32x4*)(p.out + (size_t)row * D) + lane;
#pragma unroll
        for (int j = 0; j < 4; ++j) { const f32x4 g = *(const f32x4*)(fg + 4 * lane + 256 * j); orow[64 * j] = v[j] * rstd * g; }
    }
}


#define XB_TMO      128
#define XB_XCNT(j)  (256  + 64 * (j))
#define XB_XSUB(j)  (1280 + 64 * (j))
#define XB_XGEN(j)  (2304 + 64 * (j))
#define XB_TOP      3328
#define XB_TOPGEN   3392
#define XCD_BAR_WORDS 3456
#define XB_SPIN_CAP (1u << 22)
__device__ __forceinline__ unsigned xb_ld(unsigned* p)              { return __hip_atomic_load(p, __ATOMIC_RELAXED, __HIP_MEMORY_SCOPE_AGENT); }
__device__ __forceinline__ unsigned xb_add(unsigned* p, unsigned v) { return __hip_atomic_fetch_add(p, v, __ATOMIC_RELAXED, __HIP_MEMORY_SCOPE_AGENT); }
__device__ __forceinline__ unsigned xb_xcc_id() { return (unsigned)__builtin_amdgcn_s_getreg((3 << 11) | 20) & 0xFu; }
#define XB_SPIN(cond, bar) do { unsigned _sp = 0; while (cond) { __builtin_amdgcn_s_sleep(1); \
    if ((++_sp & 255u) == 0u) { if (xb_ld(&(bar)[XB_TMO])) break; if (_sp > XB_SPIN_CAP) { atomicAdd(&(bar)[XB_TMO], 1u); break; } } } } while (0)
struct XcdBarrier { unsigned* bar; unsigned x; volatile LAS unsigned* st; };
__device__ __forceinline__ XcdBarrier xcd_barrier_post(unsigned* bar, volatile LAS unsigned* st) {
    XcdBarrier b; b.bar = bar; b.x = xb_xcc_id(); b.st = st;
    if (threadIdx.x == 0) (void)xb_add(&bar[XB_XCNT(b.x)], 1u);
    return b;
}
__device__ __forceinline__ void xcd_barrier_complete(unsigned* bar, unsigned x, unsigned& nloc, unsigned& nx) {
    const unsigned G = gridDim.x * gridDim.y * gridDim.z;
    unsigned sum, cnt, mine, sp = 0u;
    for (;;) {
        sum = 0u; cnt = 0u; mine = 0u;
#pragma unroll
        for (unsigned j = 0; j < 16; ++j) { const unsigned c = xb_ld(&bar[XB_XCNT(j)]); sum += c; cnt += (c > 0u) ? 1u : 0u; mine = (j == x) ? c : mine; }
        if (sum == G) break;
        __builtin_amdgcn_s_sleep(1);
        if ((++sp & 255u) == 0u) { if (xb_ld(&bar[XB_TMO])) break; if (sp > XB_SPIN_CAP) { atomicAdd(&bar[XB_TMO], 1u); break; } }
    }
    nloc = mine > 0u ? mine : 1u; nx = cnt > 0u ? cnt : 1u;
}
__device__ __forceinline__ void xcd_barrier(const XcdBarrier& b) {
    asm volatile("s_waitcnt vmcnt(0)" ::: "memory");
    __syncthreads();
    if (threadIdx.x == 0) {
        unsigned* bar = b.bar;
        __builtin_amdgcn_s_waitcnt(0);
        unsigned nloc = b.st[0], nx = b.st[1];
        if (nloc == 0u) { xcd_barrier_complete(bar, b.x, nloc, nx); b.st[0] = nloc; b.st[1] = nx; }
        const unsigned old = xb_add(&bar[XB_XSUB(b.x)], 1u);
        const unsigned gen = old / nloc;
        if (old + 1u == (gen + 1u) * nloc) {
            __builtin_amdgcn_fence(__ATOMIC_RELEASE, "agent");
            asm volatile("s_waitcnt vmcnt(0)" ::: "memory");
            const unsigned og = xb_add(&bar[XB_TOP], 1u);
            const unsigned tg = og / nx;
            if (og + 1u == (tg + 1u) * nx) xb_add(&bar[XB_TOPGEN], 1u);
            else XB_SPIN(xb_ld(&bar[XB_TOPGEN]) == tg, bar);
            __builtin_amdgcn_fence(__ATOMIC_ACQUIRE, "agent");
            xb_add(&bar[XB_XGEN(b.x)], 1u);
            asm volatile("s_waitcnt vmcnt(0)" ::: "memory");
        } else {
            XB_SPIN(xb_ld(&bar[XB_XGEN(b.x)]) == gen, bar);
            __builtin_amdgcn_fence(__ATOMIC_ACQUIRE, "agent");
            asm volatile("s_waitcnt vmcnt(0)" ::: "memory");
        }
    }
    __syncthreads();
}

__device__ __forceinline__ const Params* launder_params(const Params* q) { asm volatile("" : "+s"(q)); return q; }
__global__ void __launch_bounds__(NTHREADS, 2) hymba_fwd(Params p) {
    extern __shared__ __attribute__((aligned(16))) unsigned char lds_raw[];
    cg::grid_group grid = cg::this_grid();
    LAS unsigned char* lds = (LAS unsigned char*)lds_raw;
    const int G = gridDim.x, tid = threadIdx.x;
    constexpr int STAGE = DBG_STAGE;
    volatile LAS unsigned* xst = (volatile LAS unsigned*)(lds + LDS_BYTES - 64);
    if (tid == 0) { xst[0] = 0u; xst[1] = 0u; }
    __syncthreads();
    const XcdBarrier xbar = xcd_barrier_post((unsigned*)(p.ws + WS_CTL + 40960), xst);
#define GRID_BAR() xcd_barrier(xbar)

    phase_mod(p, lds_raw, G);
    if (STAGE >= 2) phase_convert(p, lds_raw, G);
    grid.sync();
    if (STAGE >= 2) { phase_norm1(p, G); GRID_BAR(); }
    if (STAGE >= 2) {
        pg8::Gemm g{(const bf16_t*)(p.ws + WS_H), (const bf16_t*)(p.ws + WS_WIN_T), D, nullptr};
        pg8::DenseSched S; S.o.init(T / 256, IC / 256, G, (int)blockIdx.x);
        EpiInProj E{(bf16_t*)(p.ws + WS_PROJ)};
        pg8::gemm_phase<false, false>(lds, g, S, E);
        GRID_BAR();
    }
    if (STAGE >= 3) {
        kmax_pass(p, G);
        for (int it = blockIdx.x; it < NB * 8 * 4; it += G) rwkv_prep(p, lds, it >> 5, (it >> 2) & 7, (it & 3) * 32, (it & 3) * 32 + 32);
        GRID_BAR();
    }
    if (STAGE >= 2) {
        if (STAGE >= 3) { for (int u = blockIdx.x; u < NB * 8 * 2; u += G) rwkv_scan(p, lds, u >> 4, (u >> 1) & 7, u & 1); }
        else {
            bf16_t* ymix = (bf16_t*)(p.ws + WS_YMIX);
            for (size_t i = (size_t)blockIdx.x * NTHREADS + tid; i < (size_t)T * 64; i += (size_t)G * NTHREADS) { const size_t row = i >> 6, c = i & 63; *(u32x4*)(ymix + row * D + c * 8) = (u32x4){0u, 0u, 0u, 0u}; }
        }
        float lam;
        { const float* q1 = p.in[I_LQ1]; const float* k1 = p.in[I_LK1]; const float* q2 = p.in[I_LQ2]; const float* k2 = p.in[I_LK2]; float s1 = 0.f, s2 = 0.f;
            for (int i = 0; i < 64; ++i) { s1 += q1[i] * k1[i]; s2 += q2[i] * k2[i]; } lam = expf(s1) - expf(s2) + LAMBDA_INIT; }
        unsigned* qhead = (unsigned*)(p.ws + WS_CTL);
        LAS unsigned* ubox = (LAS unsigned*)(lds + 4 * ATT_BUF);
        for (;;) {
            __syncthreads();
            if (tid == 0) ubox[0] = atomicAdd(qhead, 1u);
            __syncthreads();
            const unsigned u = (unsigned)__builtin_amdgcn_readfirstlane((int)ubox[0]);
            if (u >= (unsigned)ATT_UNITS) break;
            attn_unit(p, lds, (int)(u & 31u) >> 2, (int)(u & 3u), ATT_NQB - 1 - (int)(u >> 5), lam);
        }
        GRID_BAR();
        if (STAGE >= 3) { rwkv_finalize(p, G); GRID_BAR(); }
    }
    if (STAGE >= 2) {
        pg8::Gemm g{(const bf16_t*)(p.ws + WS_YMIX), (const bf16_t*)(p.ws + WS_WOUT_T), D, nullptr};
        pg8::DenseSched S; S.o.init(T / 256, D / 256, G, (int)blockIdx.x);
        EpiOutProj E{p.in[I_X], (const float*)(p.ws + WS_MOD), p.out};
        pg8::gemm_phase<false, false>(lds, g, S, E);
        GRID_BAR();
    }
    if (STAGE >= 9) {
        phase_router(p, lds, G);
        GRID_BAR();
        phase_assign(p, lds, G);
        GRID_BAR();
        const int* tile = (const int*)(p.ws + WS_TILE);
        const int MT = tile[0];
        {
            pg8::Gemm g{(const bf16_t*)(p.ws + WS_H), (const bf16_t*)(p.ws + WS_WG_T), D / 2, (const int*)(p.ws + WS_ROUTE + 2 * 1024 * 1024)};
            pg8::MoeSched S; S.o.init(MT, 8, G, (int)blockIdx.x); S.tile_e = tile + 16; S.N = 2048;
            EpiMoe1 E{p.in[I_BGU], p.ws + WS_ACT};
            pg8::gemm_phase<true, true>(lds, g, S, E);
        }
        GRID_BAR();
        {
            pg8::Gemm g{(const bf16_t*)(p.ws + WS_ACT), (const bf16_t*)(p.ws + WS_WD_T), D / 2, nullptr};
            pg8::MoeSched S; S.o.init(MT, 4, G, (int)blockIdx.x); S.tile_e = tile + 16; S.N = 1024;
            EpiMoe2 E{p.in[I_BDN], (bf16_t*)(p.ws + WS_PROJ)};
            pg8::gemm_phase<false, true>(lds, g, S, E);
        }
        GRID_BAR();
    }
    phase_final(p, G, STAGE >= 9 ? 9 : (STAGE >= 2 ? 4 : 0));
}

extern "C" void kernel_launch(void* const* d_in, const int* in_sizes, int n_in, void* d_out, int out_size, void* d_ws, size_t ws_size, hipStream_t stream) {
    static int grid = 0;
    if (grid == 0) {
        if (n_in != 31 || out_size != T * D || ws_size < WS_END) { fprintf(stderr, "kernel_launch: unexpected shapes (n_in %d out %d ws %zu)\n", n_in, out_size, ws_size); grid = -1; return; }
        int dev = 0, cus = 0, per_cu = 0;
        hipGetDevice(&dev);
        hipDeviceGetAttribute(&cus, hipDeviceAttributeMultiprocessorCount, dev);
        hipFuncSetAttribute((const void*)hymba_fwd, hipFuncAttributeMaxDynamicSharedMemorySize, LDS_BYTES);
        hipOccupancyMaxActiveBlocksPerMultiprocessor(&per_cu, (const void*)hymba_fwd, NTHREADS, LDS_BYTES);
        if (per_cu < 1) { fprintf(stderr, "kernel_launch: occupancy query returned %d\n", per_cu); grid = -1; return; }
        grid = cus;
        if (grid > 256) grid = 256;
        while (T % grid != 0) --grid;
        (void)hipGetLastError();
    }
    if (grid < 0) return;
    hipMemsetAsync((char*)d_ws + WS_CTL, 0, CTL_BYTES, stream);
    Params p{};
    for (int i = 0; i < 31; ++i) p.in[i] = (const float*)d_in[i];
    p.out = (float*)d_out; p.ws = (unsigned char*)d_ws;
    void* args[] = {&p};
    hipError_t e = hipLaunchCooperativeKernel((const void*)hymba_fwd, dim3(grid), dim3(NTHREADS), args, LDS_BYTES, stream);
    if (e != hipSuccess) fprintf(stderr, "cooperative launch failed: %s (grid %d)\n", hipGetErrorString(e), grid);
}
```

```cpp
#include <hip/hip_runtime.h>
#include <hip/hip_cooperative_groups.h>
#include <cstdio>
#include <cstdint>
namespace cg = cooperative_groups;

#ifndef DBG_STAGE
#define DBG_STAGE 99
#endif

#define LAS __attribute__((address_space(3)))
typedef unsigned short bf16_t;
typedef short bf16x8 __attribute__((ext_vector_type(8)));
typedef short s16x4 __attribute__((ext_vector_type(4)));
typedef float f32x4 __attribute__((ext_vector_type(4)));
typedef float f32x16 __attribute__((ext_vector_type(16)));
typedef float f32x2_t __attribute__((ext_vector_type(2)));
typedef __bf16 bf16x2_t __attribute__((ext_vector_type(2)));
typedef unsigned u32x4 __attribute__((ext_vector_type(4)));
typedef unsigned u32x2 __attribute__((ext_vector_type(2)));

constexpr int D = 1024, NB = 8, SEQ = 4096, T = NB * SEQ;
constexpr int RW = 512, RC = 1792, DC = 1536, IC = 3328;
constexpr int NE = 32, TOPK = 4, NA = T * TOPK;
constexpr int PMAX = NA + NE * 256;
constexpr float NORM_EPS = 1e-5f, GN_EPS = 64e-5f;
constexpr float LOG2E = 1.4426950408889634f;
constexpr float QSCALE = 0.125f * LOG2E;
constexpr float LAMBDA_INIT = 0.2f;
constexpr int NTHREADS = 512, NWAVES = 8;
constexpr int LDS_BYTES = 163840;

constexpr size_t MiB = 1u << 20;
constexpr size_t WS_CTL = 0;
constexpr size_t CTL_BYTES = 65536;
constexpr size_t WS_MOD = 1 * MiB;
constexpr size_t WS_TILE = 1 * MiB + 512 * 1024;
constexpr size_t WS_WIN_T = 2 * MiB;
constexpr size_t WS_WOUT_T = 9 * MiB;
constexpr size_t WS_ROUTE = 11 * MiB;
constexpr size_t WS_WG_T = 16 * MiB;
constexpr size_t WS_WD_T = 144 * MiB;
constexpr size_t WS_H = 208 * MiB;
constexpr size_t WS_YMIX = 272 * MiB;
constexpr size_t WS_PROJ = 336 * MiB;
constexpr size_t WS_ACT = 608 * MiB;
constexpr size_t WS_END = 1008 * MiB;
constexpr int OPREC = 34816;
constexpr int OP_AT = 0, OP_RT = 4608, OP_BH = 9216, OP_KH = 13824, OP_BCT = 18432, OP_KCT = 23552, OP_VT = 28672, OP_P31 = 33792;
constexpr size_t WS_OPS = WS_ACT;
constexpr size_t WS_VS = 944 * MiB;
constexpr size_t WS_BON = WS_H;

__device__ __forceinline__ unsigned cvtpk(float lo, float hi) { f32x2_t v = {lo, hi}; bf16x2_t b = __builtin_convertvector(v, bf16x2_t); return __builtin_bit_cast(unsigned, b); }
__device__ __forceinline__ float bf2f(unsigned short u) { return __uint_as_float(((unsigned)u) << 16); }
__device__ __forceinline__ float wave_sum(float v) {
#pragma unroll
    for (int o = 1; o < 64; o <<= 1) v += __shfl_xor(v, o);
    return v;
}
__device__ __forceinline__ float wave_max(float v) {
#pragma unroll
    for (int o = 1; o < 64; o <<= 1) v = fmaxf(v, __shfl_xor(v, o));
    return v;
}
__device__ __forceinline__ int opaque_tid() { int t = (int)threadIdx.x; asm volatile("" : "+v"(t)); return t; }
__device__ __forceinline__ float sigmoidf_(float x) { return __builtin_amdgcn_rcpf(1.0f + __expf(-x)); }
__device__ __forceinline__ float tanh_fast(float x) { return 1.0f - 2.0f * __builtin_amdgcn_rcpf(1.0f + __expf(2.0f * x)); }

struct Params {
    const float* in[31];
    float* out;
    unsigned char* ws;
};
enum { I_X = 0, I_C, I_MODW, I_MODB, I_N1G, I_WIN, I_MU, I_W0, I_WUP, I_A0, I_AUP, I_GUP, I_KK, I_KA, I_RK, I_GNG, I_GNB, I_LQ1, I_LK1, I_LQ2, I_LK2, I_SUBLN, I_WOUT, I_N2G, I_RTW, I_RTB, I_WGU, I_BGU, I_WDN, I_BDN, I_FG };

namespace pg8 {
constexpr int BM = 256, BK = 64, HALF = 128, HTB = HALF * BK * 2, STAGE_BYTES = 8 * HTB, NXCD = 8, WGM = 8;
__host__ __device__ __forceinline__ int lds_byte(int r, int c) { const int st = (r >> 4) * 2 + (c >> 5), rr = r & 15, cc = c & 31, ob = rr * 64 + cc * 2; return st * 1024 + (ob ^ (((ob >> 9) & 1) << 5)); }
__host__ __device__ __forceinline__ void stage_rc(int b, int& R, int& C) { const int st = b / 1024, sb = b % 1024, swz = sb ^ (((sb >> 9) & 1) << 5); R = (st >> 1) * 16 + swz / 64; C = (st & 1) * 32 + (swz % 64) / 2; }
__host__ __device__ __forceinline__ int perm32(int rho) { const int n = rho >> 4, i = rho & 15; return 8 * (i >> 2) + 4 * n + (i & 3); }

struct Unit { int pm, pn, arow, brow, e; };
struct Gemm { const bf16_t* A; const bf16_t* Bt; int K; const int* rowmap; };

struct TileOrder {
    int nM, nN, nwg, G, c;
    __device__ void init(int nM_, int nN_, int G_, int c_) { nM = nM_; nN = nN_; nwg = nM * nN; G = G_; c = c_; }
    __device__ bool map(int i, int& pm, int& pn) const {
        const long L = (long)i * G + c; if (L >= nwg) return false;
        int wgid = (int)L; { const int q = nwg / NXCD, r = nwg % NXCD, xcd = wgid % NXCD, off = wgid / NXCD; wgid = (xcd < r ? xcd * (q + 1) : r * (q + 1) + (xcd - r) * q) + off; }
        const int nig = WGM * nN, gid = wgid / nig, fm = gid * WGM, gsz = (nM - fm) < WGM ? (nM - fm) : WGM;
        pm = fm + ((wgid % nig) % gsz); pn = (wgid % nig) / gsz; return true;
    }
};
struct DenseSched {
    TileOrder o;
    __device__ bool next(int i, Unit& u) const { int pm, pn; if (!o.map(i, pm, pn)) return false; u.pm = pm; u.pn = pn; u.arow = pm * BM; u.brow = pn * BM; u.e = 0; return true; }
};
struct MoeSched {
    TileOrder o; const int* tile_e; int N;
    __device__ bool next(int i, Unit& u) const { int pm, pn; if (!o.map(i, pm, pn)) return false; const int e = tile_e[pm]; u.pm = pm; u.pn = pn; u.arow = pm * BM; u.brow = e * N + pn * BM; u.e = e; return true; }
};

typedef int v4i_t __attribute__((ext_vector_type(4)));
typedef int v8i_t __attribute__((ext_vector_type(8)));
__device__ __forceinline__ v8i_t cat8(bf16x8 a, bf16x8 b) { return __builtin_shufflevector(__builtin_bit_cast(v4i_t, a), __builtin_bit_cast(v4i_t, b), 0, 1, 2, 3, 4, 5, 6, 7); }
__device__ __forceinline__ void mfma_fp8_tied(f32x4& acc, v8i_t a, v8i_t b) { asm volatile("v_mfma_f32_16x16x128_f8f6f4 %0, %1, %2, %0" : "+v"(acc) : "v"(a), "v"(b)); }
template <bool GATHER, bool FP8, class Epi, class Sched>
__device__ __forceinline__ void gemm_phase(LAS unsigned char* lds, const Gemm g, const Sched& S, const Epi& E) {
    const int tid = opaque_tid(), wid = __builtin_amdgcn_readfirstlane(tid >> 6), lane = tid & 63, wr = wid >> 2, wc = wid & 3, fr = lane & 15, fq = lane >> 4;
    const int K = g.K, nt = K / BK;
    unsigned voffA[2], voffB[2]; int rowA[2], colA2[2];
#pragma unroll
    for (int i = 0; i < 2; ++i) { int R, C; stage_rc(tid * 16 + i * 8192, R, C); const int Rb = (R & ~31) + perm32(R & 31);
        voffA[i] = (unsigned)(R * K + C) * 2u; voffB[i] = (unsigned)(Rb * K + C) * 2u; rowA[i] = R; colA2[i] = C * 2; }
    unsigned gv0[2] = {0u, 0u}, gv1[2] = {0u, 0u}, gn0[2] = {0u, 0u}, gn1[2] = {0u, 0u};
#define PG8_GOFF(u_, o0, o1) do { _Pragma("unroll") for (int _i = 0; _i < 2; ++_i) { o0[_i] = (unsigned)g.rowmap[(u_).arow + rowA[_i]] * (unsigned)(K * 2) + (unsigned)colA2[_i]; o1[_i] = (unsigned)g.rowmap[(u_).arow + HALF + rowA[_i]] * (unsigned)(K * 2) + (unsigned)colA2[_i]; } } while (0)
#define PG8_STAGE_A(bufoff, kptr, half) do { if constexpr (GATHER) { if (half) PG8_STAGE(bufoff, kptr, gv1); else PG8_STAGE(bufoff, kptr, gv0); } else PG8_STAGE(bufoff, (kptr) + ((half) ? hstep : 0), voffA); } while (0)
    const size_t kstep = (size_t)(BK * 2);
    const size_t hstep = (size_t)HALF * K * 2;
    const size_t rowb = (size_t)K * 2;
    const unsigned ldsw = (unsigned)wid * 1024u;
    const int aoff = lds_byte(wr * 64 + fr, fq * 8), boff = lds_byte(wc * 32 + fr, fq * 8);
#define PG8_SA(b, h) (((b) * 2 + (h)) * HTB)
#define PG8_SB(b, h) ((4 + (b) * 2 + (h)) * HTB)
#define PG8_STAGE(bufoff, gbase, voff) do { _Pragma("unroll") for (int _i = 0; _i < 2; ++_i) \
        __builtin_amdgcn_global_load_lds((const unsigned*)((const char*)(gbase) + (voff)[_i]), (LAS unsigned*)(lds + (bufoff) + ldsw + _i * 8192), 16, 0, 0); } while (0)
#define PG8_LDA(dst, b, h) do { _Pragma("unroll") for (int m = 0; m < 4; ++m) _Pragma("unroll") for (int k = 0; k < 2; ++k) dst[m][k] = *(const LAS bf16x8*)(lds + PG8_SA(b, h) + aoff + m * 2048 + k * 1024); } while (0)
#define PG8_LDB(dst, b, h) do { _Pragma("unroll") for (int n = 0; n < 2; ++n) _Pragma("unroll") for (int k = 0; k < 2; ++k) dst[n][k] = *(const LAS bf16x8*)(lds + PG8_SB(b, h) + boff + n * 2048 + k * 1024); } while (0)
#define PG8_MMA(ai, bj, At, Bt) do { __builtin_amdgcn_s_setprio(1); _Pragma("unroll") for (int m = 0; m < 4; ++m) _Pragma("unroll") for (int n = 0; n < 2; ++n) { \
        if constexpr (FP8) mfma_fp8_tied(acc[ai][bj][m][n], cat8(Bt[n][0], Bt[n][1]), cat8(At[m][0], At[m][1])); \
        else { _Pragma("unroll") for (int k = 0; k < 2; ++k) acc[ai][bj][m][n] = __builtin_amdgcn_mfma_f32_16x16x32_bf16(Bt[n][k], At[m][k], acc[ai][bj][m][n], 0, 0, 0); } } __builtin_amdgcn_s_setprio(0); } while (0)
#define PG8_WAIT_V(n) asm volatile("s_waitcnt vmcnt(" #n ")" ::: "memory")
#define PG8_WAIT_L(n) asm volatile("s_waitcnt lgkmcnt(" #n ")" ::: "memory")
#define PG8_BAR __builtin_amdgcn_s_barrier()
#define PG8_SCHED __builtin_amdgcn_sched_barrier(0)
    Unit cur, nxt; int ui = 0;
    if (!S.next(0, cur)) return;
    f32x4 acc[2][2][4][2];
#pragma unroll
    for (int a = 0; a < 2; ++a)
#pragma unroll
        for (int b = 0; b < 2; ++b)
#pragma unroll
            for (int m = 0; m < 4; ++m)
#pragma unroll
                for (int n = 0; n < 2; ++n) acc[a][b][m][n] = (f32x4){0.f, 0.f, 0.f, 0.f};
    bf16x8 At[4][2], B0[2][2], B1[2][2];
    const char* cA = GATHER ? (const char*)g.A : (const char*)g.A + (size_t)cur.arow * rowb; const char* cB = (const char*)g.Bt + (size_t)cur.brow * rowb;
    if constexpr (GATHER) PG8_GOFF(cur, gv0, gv1);
    PG8_STAGE(PG8_SB(0, 0), cB, voffB); PG8_STAGE(PG8_SB(0, 1), cB + hstep, voffB); PG8_STAGE_A(PG8_SA(0, 0), cA, 0); PG8_STAGE_A(PG8_SA(0, 1), cA, 1);
    if (wr == 1) PG8_BAR;
    PG8_WAIT_V(2); PG8_BAR;
    PG8_STAGE(PG8_SB(1, 0), cB + kstep, voffB); PG8_STAGE_A(PG8_SA(1, 0), cA + kstep, 0); PG8_STAGE(PG8_SB(1, 1), cB + hstep + kstep, voffB);
    PG8_WAIT_V(6); PG8_BAR;
    for (;;) {
        const bool has_next = S.next(ui + 1, nxt);
        const char* nA = GATHER ? (const char*)g.A : (has_next ? (const char*)g.A + (size_t)nxt.arow * rowb : cA); const char* nB = has_next ? (const char*)g.Bt + (size_t)nxt.brow * rowb : cB;

        for (int t = 0; t < nt; t += 2) {
            const bool last = (t == nt - 2);
            if constexpr (GATHER) { if (t == nt - 4) { if (has_next) PG8_GOFF(nxt, gn0, gn1); else { gn0[0] = gv0[0]; gn0[1] = gv0[1]; gn1[0] = gv1[0]; gn1[1] = gv1[1]; } } }
            const char* a1 = cA + (size_t)(t + 1) * kstep;
            const char* a2 = last ? nA : cA + (size_t)(t + 2) * kstep; const char* b2 = last ? nB : cB + (size_t)(t + 2) * kstep;
            const char* a3 = a2 + kstep; const char* b3 = b2 + kstep;
            PG8_LDB(B0, 0, 0); PG8_LDB(B1, 0, 1); PG8_SCHED; PG8_LDA(At, 0, 0); PG8_STAGE_A(PG8_SA(1, 1), a1, 1);
            if constexpr (GATHER) { if (last) { gv0[0] = gn0[0]; gv0[1] = gn0[1]; gv1[0] = gn1[0]; gv1[1] = gn1[1]; } }
            PG8_WAIT_V(8); PG8_WAIT_L(0); PG8_BAR; PG8_MMA(0, 0, At, B0); PG8_MMA(0, 1, At, B1); PG8_BAR; PG8_SCHED;
            PG8_LDA(At, 0, 1); PG8_STAGE(PG8_SB(0, 0), b2, voffB); PG8_STAGE(PG8_SB(0, 1), b2 + hstep, voffB); PG8_STAGE_A(PG8_SA(0, 0), a2, 0);
            PG8_WAIT_V(8); PG8_WAIT_L(0); PG8_BAR; PG8_MMA(1, 0, At, B0); PG8_MMA(1, 1, At, B1); PG8_BAR; PG8_SCHED;
            PG8_LDB(B0, 1, 0); PG8_LDB(B1, 1, 1); PG8_SCHED; PG8_LDA(At, 1, 0); PG8_STAGE_A(PG8_SA(0, 1), a2, 1);
            PG8_WAIT_V(8); PG8_WAIT_L(0); PG8_BAR; PG8_MMA(0, 0, At, B0); PG8_MMA(0, 1, At, B1); PG8_BAR; PG8_SCHED;
            PG8_LDA(At, 1, 1); PG8_STAGE(PG8_SB(1, 0), b3, voffB); PG8_STAGE(PG8_SB(1, 1), b3 + hstep, voffB); PG8_STAGE_A(PG8_SA(1, 0), a3, 0);
            PG8_WAIT_V(8); PG8_WAIT_L(0); PG8_BAR; PG8_MMA(1, 0, At, B0); PG8_MMA(1, 1, At, B1); PG8_BAR; PG8_SCHED;
        }
        if (wr == 0) PG8_BAR;
        if constexpr (FP8) asm volatile("s_nop 15\n\ts_nop 15" ::: "memory");
        E(acc, cur, wr, wc, fr, fq);
        if (!has_next) break;
#pragma unroll
        for (int a = 0; a < 2; ++a)
#pragma unroll
            for (int b = 0; b < 2; ++b)
#pragma unroll
                for (int m = 0; m < 4; ++m)
#pragma unroll
                    for (int n = 0; n < 2; ++n) acc[a][b][m][n] = (f32x4){0.f, 0.f, 0.f, 0.f};
        cur = nxt; cA = nA; cB = nB; ++ui;
        if (wr == 1) PG8_BAR;
    }
    PG8_WAIT_V(0);
    PG8_BAR;
#undef PG8_SA
#undef PG8_SB
#undef PG8_STAGE
#undef PG8_STAGE_A
#undef PG8_GOFF
#undef PG8_LDA
#undef PG8_LDB
#undef PG8_MMA
#undef PG8_WAIT_V
#undef PG8_WAIT_L
#undef PG8_BAR
#undef PG8_SCHED
}
}

struct EpiInProj {
    bf16_t* O;
    __device__ __forceinline__ void operator()(const f32x4 (&acc)[2][2][4][2], const pg8::Unit& u, int wr, int wc, int fr, int fq) const {
        const int row0 = u.pm * 256 + wr * 64 + fr, col0 = u.pn * 256 + wc * 32 + 8 * fq;
        const float sc = (u.pn == 7 || u.pn == 8) ? QSCALE : 1.0f;
#pragma unroll
        for (int ai = 0; ai < 2; ++ai)
#pragma unroll
            for (int m = 0; m < 4; ++m) { bf16_t* rowp = O + (size_t)(row0 + ai * 128 + m * 16) * IC + col0;
#pragma unroll
                for (int bj = 0; bj < 2; ++bj) { const f32x4 v0 = acc[ai][bj][m][0] * sc, v1 = acc[ai][bj][m][1] * sc;
                    u32x4 w; w.x = cvtpk(v0[0], v0[1]); w.y = cvtpk(v0[2], v0[3]); w.z = cvtpk(v1[0], v1[1]); w.w = cvtpk(v1[2], v1[3]);
                    *(u32x4*)(rowp + bj * 128) = w; } }
    }
};
struct EpiOutProj {
    const float* x; const float* mod; float* O;
    __device__ __forceinline__ void operator()(const f32x4 (&acc)[2][2][4][2], const pg8::Unit& u, int wr, int wc, int fr, int fq) const {
        const int row0 = u.pm * 256 + wr * 64 + fr, col0 = u.pn * 256 + wc * 32 + 8 * fq;
        const int b = (u.pm * 256) / SEQ;
        const float* g1 = mod + b * 6144 + 2048;
        f32x4 gv[2][2];
#pragma unroll
        for (int bj = 0; bj < 2; ++bj)
#pragma unroll
            for (int n = 0; n < 2; ++n) gv[bj][n] = *(const f32x4*)(g1 + col0 + bj * 128 + 4 * n);
#pragma unroll
        for (int ai = 0; ai < 2; ++ai)
#pragma unroll
            for (int m = 0; m < 4; ++m) { const size_t off = (size_t)(row0 + ai * 128 + m * 16) * D + col0;
#pragma unroll
                for (int bj = 0; bj < 2; ++bj)
#pragma unroll
                    for (int n = 0; n < 2; ++n) { const f32x4 xv = *(const f32x4*)(x + off + bj * 128 + 4 * n);
                        *(f32x4*)(O + off + bj * 128 + 4 * n) = xv + gv[bj][n] * acc[ai][bj][m][n]; } }
    }
};
constexpr float Q_H2 = 8.0f, Q_W = 32.0f, Q_ACT = 4.0f;
__device__ __forceinline__ unsigned cvt4_fp8(float a, float b, float c, float d) { unsigned w = 0u; w = (unsigned)__builtin_amdgcn_cvt_pk_fp8_f32(a, b, (int)w, false); w = (unsigned)__builtin_amdgcn_cvt_pk_fp8_f32(c, d, (int)w, true); return w; }
struct EpiMoe1 {
    const float* bgu; unsigned char* O;
    __device__ __forceinline__ void operator()(const f32x4 (&acc)[2][2][4][2], const pg8::Unit& u, int wr, int wc, int fr, int fq) const {
        const int row0 = u.pm * 256 + wr * 64 + fr, col0 = u.pn * 128 + wc * 32 + 8 * fq;
        const float* bg = bgu + (size_t)u.e * 2048 + col0;
        constexpr float dq = 1.0f / (Q_H2 * Q_W);
        f32x4 bgv[2], buv[2];
#pragma unroll
        for (int n = 0; n < 2; ++n) { bgv[n] = *(const f32x4*)(bg + 4 * n); buv[n] = *(const f32x4*)(bg + 1024 + 4 * n); }
#pragma unroll
        for (int ai = 0; ai < 2; ++ai)
#pragma unroll
            for (int m = 0; m < 4; ++m) { float a[8];
#pragma unroll
                for (int n = 0; n < 2; ++n) { const f32x4 gt = acc[ai][0][m][n] * dq + bgv[n], up = acc[ai][1][m][n] * dq + buv[n];
#pragma unroll
                    for (int j = 0; j < 4; ++j) { const float gg = fminf(gt[j], 7.0f), uu = fminf(fmaxf(up[j], -7.0f), 7.0f);
                        a[4 * n + j] = Q_ACT * (uu + 1.0f) * (gg * __builtin_amdgcn_rcpf(1.0f + __builtin_amdgcn_exp2f(-1.702f * LOG2E * gg))); } }
                u32x2 w; w.x = cvt4_fp8(a[0], a[1], a[2], a[3]); w.y = cvt4_fp8(a[4], a[5], a[6], a[7]);
                *(u32x2*)(O + (size_t)(row0 + ai * 128 + m * 16) * 1024 + col0) = w; }
    }
};
struct EpiMoe2 {
    const float* bdn; bf16_t* O;
    __device__ __forceinline__ void operator()(const f32x4 (&acc)[2][2][4][2], const pg8::Unit& u, int wr, int wc, int fr, int fq) const {
        const int row0 = u.pm * 256 + wr * 64 + fr, col0 = u.pn * 256 + wc * 32 + 8 * fq;
        const float* bd = bdn + (size_t)u.e * 1024 + col0;
        constexpr float dq = 1.0f / (Q_ACT * Q_W);
        f32x4 bv[2][2];
#pragma unroll
        for (int bj = 0; bj < 2; ++bj)
#pragma unroll
            for (int n = 0; n < 2; ++n) bv[bj][n] = *(const f32x4*)(bd + bj * 128 + 4 * n);
#pragma unroll
        for (int ai = 0; ai < 2; ++ai)
#pragma unroll
            for (int m = 0; m < 4; ++m) { bf16_t* rowp = O + (size_t)(row0 + ai * 128 + m * 16) * 1024 + col0;
#pragma unroll
                for (int bj = 0; bj < 2; ++bj) { const f32x4 v0 = acc[ai][bj][m][0] * dq + bv[bj][0], v1 = acc[ai][bj][m][1] * dq + bv[bj][1];
                    u32x4 w; w.x = cvtpk(v0[0], v0[1]); w.y = cvtpk(v0[2], v0[3]); w.z = cvtpk(v1[0], v1[1]); w.w = cvtpk(v1[2], v1[3]);
                    *(u32x4*)(rowp + bj * 128) = w; } }
    }
};

__device__ __forceinline__ void phase_mod(const Params& p, unsigned char* lds, int G) {
    const int tid = opaque_tid(), lane = tid & 63, wave = tid >> 6;
    float* sc = (float*)lds;
    const float* c = p.in[I_C];
    for (int i = tid; i < 8192; i += NTHREADS) { const int b = i & 7, k = i >> 3; const float cv = c[b * 1024 + k]; sc[k * 8 + b] = cv / (1.0f + __expf(-cv)); }
    __syncthreads();
    float* mod = (float*)(p.ws + WS_MOD);
    const float* mw = p.in[I_MODW]; const float* mb = p.in[I_MODB];
    for (int item = wave * G + (int)blockIdx.x; item < 192; item += NWAVES * G) {
        const int col = item * 32 + (lane & 31), kh = lane >> 5;
        float acc[8];
#pragma unroll
        for (int b = 0; b < 8; ++b) acc[b] = 0.f;
        const float* wp = mw + (size_t)(kh * 512) * 6144 + col;
        const float* sp = sc + (kh * 512) * 8;
#pragma unroll 8
        for (int k = 0; k < 512; ++k) { const float wv = wp[(size_t)k * 6144]; const f32x4 s0 = *(const f32x4*)(sp + k * 8), s1 = *(const f32x4*)(sp + k * 8 + 4);
            acc[0] += s0[0] * wv; acc[1] += s0[1] * wv; acc[2] += s0[2] * wv; acc[3] += s0[3] * wv; acc[4] += s1[0] * wv; acc[5] += s1[1] * wv; acc[6] += s1[2] * wv; acc[7] += s1[3] * wv; }
#pragma unroll
        for (int b = 0; b < 8; ++b) acc[b] += __shfl_xor(acc[b], 32);
        if (lane < 32) {
            const float bias = mb[col];
#pragma unroll
            for (int b = 0; b < 8; ++b) mod[b * 6144 + col] = acc[b] + bias;
        }
    }
    __syncthreads();
}
__device__ __forceinline__ void transpose_item(const float* W, int N, int k0, int n0, bf16_t* WT, int Kdst, int dst_row_base, bool gu_interleave, float* scr, int lane) {
#pragma unroll 4
    for (int i = 0; i < 16; ++i) { const int row = 4 * i + (lane >> 4), c4 = lane & 15;
        const f32x4 v = *(const f32x4*)(W + (size_t)(k0 + row) * N + n0 + 4 * c4);
        float* s = scr + row * 65 + 4 * c4; s[0] = v[0]; s[1] = v[1]; s[2] = v[2]; s[3] = v[3]; }
    asm volatile("s_waitcnt lgkmcnt(0)" ::: "memory");
    const int cch = lane & 7;
#pragma unroll
    for (int i = 0; i < 8; ++i) { const int n = 8 * i + (lane >> 3); const float* s = scr + (8 * cch) * 65 + n;
        u32x4 o; o.x = cvtpk(s[0], s[65]); o.y = cvtpk(s[2 * 65], s[3 * 65]); o.z = cvtpk(s[4 * 65], s[5 * 65]); o.w = cvtpk(s[6 * 65], s[7 * 65]);
        int nn = n0 + n;
        if (gu_interleave) nn = (nn < 1024) ? ((nn >> 7) * 256 + (nn & 127)) : (((nn - 1024) >> 7) * 256 + 128 + ((nn - 1024) & 127));
        *(u32x4*)(WT + (size_t)(dst_row_base + nn) * Kdst + k0 + 8 * cch) = o; }
    asm volatile("s_waitcnt lgkmcnt(0)" ::: "memory");
}
__device__ __forceinline__ void transpose_item_fp8(const float* W, int N, int k0, int n0, unsigned char* WT, int dst_row_base, bool gu_interleave, float* scr, int lane) {
#pragma unroll 4
    for (int i = 0; i < 16; ++i) { const int row = 4 * i + (lane >> 4), c4 = lane & 15;
        const f32x4 v = *(const f32x4*)(W + (size_t)(k0 + row) * N + n0 + 4 * c4);
        float* s = scr + row * 65 + 4 * c4; s[0] = v[0]; s[1] = v[1]; s[2] = v[2]; s[3] = v[3]; }
    asm volatile("s_waitcnt lgkmcnt(0)" ::: "memory");
    const int cch = lane & 3;
#pragma unroll
    for (int i = 0; i < 4; ++i) { const int n = 16 * i + (lane >> 2); const float* s = scr + (16 * cch) * 65 + n;
        u32x4 o;
        o.x = cvt4_fp8(Q_W * s[0], Q_W * s[65], Q_W * s[2 * 65], Q_W * s[3 * 65]); o.y = cvt4_fp8(Q_W * s[4 * 65], Q_W * s[5 * 65], Q_W * s[6 * 65], Q_W * s[7 * 65]);
        o.z = cvt4_fp8(Q_W * s[8 * 65], Q_W * s[9 * 65], Q_W * s[10 * 65], Q_W * s[11 * 65]); o.w = cvt4_fp8(Q_W * s[12 * 65], Q_W * s[13 * 65], Q_W * s[14 * 65], Q_W * s[15 * 65]);
        int nn = n0 + n;
        if (gu_interleave) nn = (nn < 1024) ? ((nn >> 7) * 256 + (nn & 127)) : (((nn - 1024) >> 7) * 256 + 128 + ((nn - 1024) & 127));
        *(u32x4*)(WT + (size_t)(dst_row_base + nn) * 1024 + k0 + 16 * cch) = o; }
    asm volatile("s_waitcnt lgkmcnt(0)" ::: "memory");
}
__device__ __forceinline__ void phase_convert(const Params& p, unsigned char* lds, int G) {
    const int tid = opaque_tid(), lane = tid & 63, wave = tid >> 6;
    float* scr = (float*)lds + wave * (64 * 65);
    const int gw = (int)blockIdx.x * NWAVES + wave, NGW = G * NWAVES;
    constexpr int I_IN = 16 * 52, I_OUT = 16 * 16, I_GU = 32 * 16 * 32, I_DN = 32 * 16 * 16, NITEMS = I_IN + I_OUT + I_GU + I_DN;
    bf16_t* win_t = (bf16_t*)(p.ws + WS_WIN_T); bf16_t* wout_t = (bf16_t*)(p.ws + WS_WOUT_T); unsigned char* wg_t = p.ws + WS_WG_T; unsigned char* wd_t = p.ws + WS_WD_T;
    for (int it = gw; it < NITEMS; it += NGW) {
        int r = it;
        if (r < I_IN) { transpose_item(p.in[I_WIN], IC, (r / 52) * 64, (r % 52) * 64, win_t, 1024, 0, false, scr, lane); continue; } r -= I_IN;
        if (r < I_OUT) { transpose_item(p.in[I_WOUT], D, (r / 16) * 64, (r % 16) * 64, wout_t, 1024, 0, false, scr, lane); continue; } r -= I_OUT;
        if (r < I_GU) { const int e = r / 512, rr = r % 512; transpose_item_fp8(p.in[I_WGU] + (size_t)e * 1024 * 2048, 2048, (rr / 32) * 64, (rr % 32) * 64, wg_t, e * 2048, true, scr, lane); continue; } r -= I_GU;
        { const int e = r / 256, rr = r % 256; transpose_item_fp8(p.in[I_WDN] + (size_t)e * 1024 * 1024, 1024, (rr / 16) * 64, (rr % 16) * 64, wd_t, e * 1024, false, scr, lane); }
    }
}

__device__ __forceinline__ void phase_norm1(const Params& p, int G) {
    const int tid = opaque_tid(), lane = tid & 63, wave = tid >> 6;
    const int gw = (int)blockIdx.x * NWAVES + wave, NGW = G * NWAVES;
    const float* x = p.in[I_X]; const float* gain = p.in[I_N1G]; const float* mod = (const float*)(p.ws + WS_MOD);
    bf16_t* h = (bf16_t*)(p.ws + WS_H);
    for (int row = gw; row < T; row += NGW) {
        const int b = row / SEQ;
        const f32x4* xr = (const f32x4*)(x + (size_t)row * D) + lane;
        f32x4 v[4]; float s = 0.f;
#pragma unroll
        for (int j = 0; j < 4; ++j) { v[j] = xr[64 * j]; s += (v[j][0] * v[j][0] + v[j][1] * v[j][1]) + (v[j][2] * v[j][2] + v[j][3] * v[j][3]); }
        const float rstd = rsqrtf(wave_sum(s) * (1.0f / D) + NORM_EPS);
        const float* sh = mod + b * 6144; const float* scl = mod + b * 6144 + 1024;
        unsigned long long* o8 = (unsigned long long*)(h + (size_t)row * D) + lane;
#pragma unroll
        for (int j = 0; j < 4; ++j) { const int k = 4 * lane + 256 * j;
            const f32x4 g = *(const f32x4*)(gain + k), s1 = *(const f32x4*)(scl + k), s0 = *(const f32x4*)(sh + k);
            const f32x4 y = (v[j] * rstd) * g * (s1 + 1.0f) + s0;
            o8[64 * j] = (unsigned long long)cvtpk(y[0], y[1]) | ((unsigned long long)cvtpk(y[2], y[3]) << 32); }
    }
}

constexpr size_t CTL_KMAX = 57344;
__device__ __forceinline__ void kmax_pass(const Params& p, int G) {
    const int tid = opaque_tid(), lane = tid & 63, wave = tid >> 6;
    const bf16_t* proj = (const bf16_t*)(p.ws + WS_PROJ);
    unsigned* km = (unsigned*)(p.ws + WS_CTL + CTL_KMAX);
    const int TPB = T / G;
    float mx = 0.f; const int tok0 = (int)blockIdx.x * TPB;
    for (int ti = wave; ti < TPB; ti += NWAVES) {
        const u32x4 kv = *(const u32x4*)(proj + (size_t)(tok0 + ti) * IC + RC + 512 + 8 * lane);
        float ss = 0.f;
#pragma unroll
        for (int j = 0; j < 4; ++j) { const float a = __uint_as_float(kv[j] << 16), bq = __uint_as_float(kv[j] & 0xffff0000u); ss += a * a + bq * bq; }
        ss += __shfl_xor(ss, 1); ss += __shfl_xor(ss, 2); ss += __shfl_xor(ss, 4);
        mx = fmaxf(mx, ss);
    }
    if ((lane & 7) == 0) atomicMax(km + (tok0 / SEQ) * 8 + (lane >> 3), __float_as_uint(mx));
}

__device__ __forceinline__ s16x4 vtr(const LAS unsigned char* pp) { typedef short v4i16_t __attribute__((ext_vector_type(4))); return __builtin_bit_cast(s16x4, __builtin_amdgcn_ds_read_tr16_b64_v4i16((LAS v4i16_t*)pp)); }
constexpr int ATT_BUF = 32768;
__device__ __forceinline__ float att_max3(float a, float b, float c) { float r; asm("v_max3_f32 %0, %1, %2, %3" : "=v"(r) : "v"(a), "v"(b), "v"(c)); return r; }
constexpr int ATT_QROWS = 128, ATT_NQB = SEQ / ATT_QROWS, ATT_UNITS = NB * 4 * ATT_NQB;
__device__ __forceinline__ void attn_unit(const Params& p, LAS unsigned char* lds, int b, int h, int qb, float lam) {
    const int tid = opaque_tid(), lane = tid & 63, wid = __builtin_amdgcn_readfirstlane(tid >> 6), r32 = lane & 31, hi = lane >> 5;
    const int c = wid & 1, qblk = wid >> 1;
    const bf16_t* proj = (const bf16_t*)(p.ws + WS_PROJ) + (size_t)b * SEQ * IC;
    const int q0 = qb * ATT_QROWS, qw0 = q0 + 32 * qblk;
    const bf16_t* Qb = proj + RC + h * 128 + c * 64;
    const bf16_t* Kb = proj + RC + 512 + h * 128;
    const bf16_t* Vb = proj + RC + 1024 + h * 128;
    const float slope = exp2f(-2.0f * (float)(h + 1)) * LOG2E;
    f32x16 o[4];
#pragma unroll
    for (int d = 0; d < 4; ++d) o[d] = f32x16{};
    f32x16 cb0;
#pragma unroll
    for (int r = 0; r < 16; ++r) cb0[r] = slope * (float)((r & 3) + 8 * (r >> 2) + 4 * hi);
    const float c32 = slope * 32.0f;
    float m_ = 0.f, l_ = 0.f;
    const int NT = (q0 + ATT_QROWS) / 64;
    const bf16_t* ksrc = Kb + (size_t)lane * IC + wid * 8;
    const int p0i = wid, p1i = wid + 8;
    const bf16_t* vsrc0 = Vb + (size_t)(16 * (p0i & 3) + (lane >> 2)) * IC + (p0i >> 2) * 32 + (lane & 3) * 8;
    const bf16_t* vsrc1 = Vb + (size_t)(16 * (p1i & 3) + (lane >> 2)) * IC + (p1i >> 2) * 32 + (lane & 3) * 8;
#define ATT_GLDS(gsrc_, ldsdst_) do { unsigned keep_; asm volatile("s_mov_b32 %0, m0\n\ts_mov_b32 m0, %2\n\ts_nop 0\n\tglobal_load_lds_dwordx4 %1, off\n\ts_mov_b32 m0, %0" : "=&s"(keep_) : "v"(gsrc_), "s"(ldsdst_) : "memory"); } while (0)
    const unsigned lds0 = (unsigned)(uintptr_t)lds;
#define ATT_DMA(t, buf) do { const size_t ro = (size_t)(t) * 64 * IC; const unsigned bb_ = (unsigned)__builtin_amdgcn_readfirstlane((int)(lds0 + (buf) * ATT_BUF + wid * 1024)); \
        ATT_GLDS(ksrc + ro, bb_); ATT_GLDS(ksrc + ro + 64, bb_ + 8192u); ATT_GLDS(vsrc0 + ro, bb_ + 16384u); ATT_GLDS(vsrc1 + ro, bb_ + 16384u + 8192u); } while (0)
    ATT_DMA(NT - 1, 0); ATT_DMA(NT - 2, 1);
    bf16x8 qr[4];
#pragma unroll
    for (int d0 = 0; d0 < 4; ++d0) qr[d0] = *(const bf16x8*)(Qb + (size_t)(qw0 + r32) * IC + d0 * 16 + hi * 8);
    float qn;
    { float q2 = 0.f;
#pragma unroll
      for (int d0 = 0; d0 < 4; ++d0)
#pragma unroll
          for (int j = 0; j < 8; ++j) { const float x = bf2f((unsigned short)qr[d0][j]); q2 += x * x; }
      q2 += __shfl_xor(q2, 32);
      qn = sqrtf(q2 * ((const float*)(p.ws + WS_CTL + CTL_KMAX))[b * 8 + h * 2 + c]) * 1.002f + 0.01f; }
    asm volatile("" : "+v"(qr[0]), "+v"(qr[1]), "+v"(qr[2]), "+v"(qr[3]));
    asm volatile("s_waitcnt vmcnt(0)" ::: "memory");
    __builtin_amdgcn_s_barrier();
    const int voff = ((lane >> 4) & 1) * 32 + (lane & 3) * 8 + (4 * hi + ((lane & 15) >> 2)) * 64;
    const int qpos = qw0 + r32;
    const bool late = wid >= 4;
    bf16x8 pf[4]; bool pend = false;
    float mtrue = -INFINITY;
    LAS unsigned* vote = (LAS unsigned*)(lds + 4 * ATT_BUF + 64);
#define ATT_PV(slot_) do { const LAS unsigned char* vb_ = lds + (slot_) * ATT_BUF + 16384 + voff; \
        _Pragma("unroll") for (int dblk = 0; dblk < 4; ++dblk) { _Pragma("unroll") for (int ks = 0; ks < 4; ++ks) { \
            const s16x4 lo = vtr(vb_ + (dblk * 4 + ks) * 1024), hh = vtr(vb_ + (dblk * 4 + ks) * 1024 + 512); \
            const bf16x8 vf = (bf16x8){lo[0], lo[1], lo[2], lo[3], hh[0], hh[1], hh[2], hh[3]}; \
            o[dblk] = __builtin_amdgcn_mfma_f32_32x32x16_bf16(vf, pf[ks], o[dblk], 0, 0, 0); } } } while (0)
    int it = 0;
    for (; it < NT; ++it) {
        const int kt = NT - 1 - it, cur = it & 3;
        const bool issued = (it + 2 < NT);
        if (issued) ATT_DMA(kt - 2, (it + 2) & 3);
        const int k0 = kt * 64;
        if (late && pend) { ATT_PV((it - 1) & 3); pend = false; }
        if (k0 <= qw0 + 31) {
            const LAS unsigned char* bb = lds + cur * ATT_BUF;
            const bool need_mask = (k0 + 63 > qw0);
            const LAS unsigned char* kb = bb + c * 8192 + hi * 1024 + r32 * 16;
            f32x16 s0 = cb0, s1 = cb0;
#pragma unroll
            for (int d0 = 0; d0 < 4; ++d0) {
                const bf16x8 a0 = *(const LAS bf16x8*)(kb + d0 * 2048), a1 = *(const LAS bf16x8*)(kb + d0 * 2048 + 512);
                s0 = __builtin_amdgcn_mfma_f32_32x32x16_bf16(a0, qr[d0], s0, 0, 0, 0);
                s1 = __builtin_amdgcn_mfma_f32_32x32x16_bf16(a1, qr[d0], s1, 0, 0, 0);
            }
            if (need_mask) {
                const int dq = k0 - qpos + 4 * hi;
#pragma unroll
                for (int r = 0; r < 16; ++r) { if (dq + ((r & 3) + 8 * (r >> 2)) > 0) s0[r] = -INFINITY; if (dq + ((r & 3) + 8 * (r >> 2)) + 32 > 0) s1[r] = -INFINITY; }
            }
            const float tb = slope * (float)(k0 - qpos);
            float rm0 = att_max3(s0[0], s0[1], s0[2]), rm1 = att_max3(s1[0], s1[1], s1[2]);
#pragma unroll
            for (int r = 3; r < 15; r += 2) { rm0 = att_max3(rm0, s0[r], s0[r + 1]); rm1 = att_max3(rm1, s1[r], s1[r + 1]); }
            float rm = att_max3(rm0, s0[15], att_max3(rm1, s1[15], -INFINITY) + c32);
            rm += tb;
            rm = fmaxf(rm, __shfl_xor(rm, 32));
            mtrue = fmaxf(mtrue, rm);
            if (__any(rm > m_ + 8.0f)) {
                const float mn = fmaxf(m_, rm);
                const float alpha = __builtin_amdgcn_exp2f(m_ - mn);
                m_ = mn; l_ *= alpha;
#pragma unroll
                for (int d = 0; d < 4; ++d)
#pragma unroll
                    for (int r = 0; r < 16; ++r) o[d][r] *= alpha;
            }
            const float off = tb - m_, off1 = off + c32;
            float ps = 0.f;
#pragma unroll
            for (int r = 0; r < 16; ++r) { s0[r] = __builtin_amdgcn_exp2f(s0[r] + off); s1[r] = __builtin_amdgcn_exp2f(s1[r] + off1); ps += s0[r] + s1[r]; }
            l_ += ps;
#pragma unroll
            for (int ks = 0; ks < 2; ++ks) {
                u32x4 w0, w1;
                w0.x = cvtpk(s0[8 * ks + 0], s0[8 * ks + 1]); w0.y = cvtpk(s0[8 * ks + 2], s0[8 * ks + 3]); w0.z = cvtpk(s0[8 * ks + 4], s0[8 * ks + 5]); w0.w = cvtpk(s0[8 * ks + 6], s0[8 * ks + 7]);
                w1.x = cvtpk(s1[8 * ks + 0], s1[8 * ks + 1]); w1.y = cvtpk(s1[8 * ks + 2], s1[8 * ks + 3]); w1.z = cvtpk(s1[8 * ks + 4], s1[8 * ks + 5]); w1.w = cvtpk(s1[8 * ks + 6], s1[8 * ks + 7]);
                pf[ks] = __builtin_bit_cast(bf16x8, w0); pf[2 + ks] = __builtin_bit_cast(bf16x8, w1);
            }
            if (late) pend = true; else ATT_PV(cur);
        }
        { const bool neg = (qn + slope * (float)(k0 - 1 - qpos) <= mtrue - 50.0f);
          if (lane == 0) vote[(it & 1) * 8 + wid] = __all(neg) ? 1u : 0u; }
        if (issued) asm volatile("s_waitcnt vmcnt(4)" ::: "memory"); else asm volatile("s_waitcnt vmcnt(0)" ::: "memory");
        asm volatile("s_waitcnt lgkmcnt(0)" ::: "memory");
        __builtin_amdgcn_s_barrier();
        { const u32x4 va = *(const LAS u32x4*)(vote + (it & 1) * 8), vb2 = *(const LAS u32x4*)(vote + (it & 1) * 8 + 4);
          if ((va.x & va.y & va.z & va.w & vb2.x & vb2.y & vb2.z & vb2.w) != 0u) { ++it; break; } }
    }
    if (late && pend) ATT_PV((it - 1) & 3);
    asm volatile("s_waitcnt vmcnt(0) lgkmcnt(0)" ::: "memory");
    __builtin_amdgcn_s_barrier();
#undef ATT_PV
#undef ATT_DMA
#undef ATT_GLDS
    l_ += __shfl_xor(l_, 32);
    LAS float* xb = (LAS float*)(lds + qblk * 16384);
    if (c == 1) {
        const float i1 = lam / l_;
#pragma unroll
        for (int d = 0; d < 4; ++d)
#pragma unroll
            for (int r = 0; r < 16; ++r) xb[(d * 16 + r) * 64 + lane] = o[d][r] * i1;
    }
    __syncthreads();
    if (c == 0) {
        const float i0 = 1.0f / l_;
        float ss = 0.f;
#pragma unroll
        for (int d = 0; d < 4; ++d)
#pragma unroll
            for (int r = 0; r < 16; ++r) { const float v = o[d][r] * i0 - xb[(d * 16 + r) * 64 + lane]; o[d][r] = v; ss += v * v; }
        ss += __shfl_xor(ss, 32);
        const float rstd = rsqrtf(ss * (1.0f / 128.0f) + NORM_EPS) * (1.0f - LAMBDA_INIT);
        const float* sg = p.in[I_SUBLN];
        bf16_t* yo = (bf16_t*)(p.ws + WS_YMIX) + (size_t)(b * SEQ + qw0 + r32) * D + RW + h * 128;
#pragma unroll
        for (int d = 0; d < 4; ++d)
#pragma unroll
            for (int g = 0; g < 4; ++g) { const int dd = 32 * d + 8 * g + 4 * hi; const f32x4 gv = *(const f32x4*)(sg + dd);
                u32x2 w; w.x = cvtpk(o[d][4 * g] * rstd * gv[0], o[d][4 * g + 1] * rstd * gv[1]); w.y = cvtpk(o[d][4 * g + 2] * rstd * gv[2], o[d][4 * g + 3] * rstd * gv[3]);
                *(u32x2*)(yo + dd) = w; }
    }
    __syncthreads();
}

constexpr int RCH = 32;
constexpr int RK_R = 0, RK_KM = 8192, RK_DEC = 16384, RK_KK = 24576, RK_BB = 32768, RK_VV = 40960, RK_GG = 49152;
constexpr int RK_AW = 57344;
constexpr int RK_AA = RK_AW + 4608;
constexpr int RK_AG = RK_AA + 4608;
constexpr int RK_BON = RK_AG + 8704;
constexpr int RK_MU = RK_BON + 128;
constexpr int RK_RAW = 77824;
constexpr int RK_IM = RK_RAW + 33 * 1024;
constexpr int RK_LSEG = RK_IM + OPREC;
constexpr int RK_END = RK_LSEG + 2048;
static_assert(RK_MU + 1792 <= RK_RAW && RK_END <= LDS_BYTES - 64 && (RK_RAW % 1024) == 0, "rwkv prep LDS map");
template <int CTRL> __device__ __forceinline__ float dpp_add(float v) { return v + __builtin_bit_cast(float, __builtin_amdgcn_update_dpp(0, __builtin_bit_cast(int, v), CTRL, 0xf, 0xf, true)); }
__device__ __forceinline__ float red16(float v) {
    v = dpp_add<0xB1>(v);
    v = dpp_add<0x4E>(v);
    v = dpp_add<0x141>(v);
    v = dpp_add<0x140>(v);
    return v;
}
__device__ __forceinline__ int rk_piece_col(int pc, int h) {
    return pc < 8 ? h * 64 + 8 * pc : (pc < 16 ? 512 + h * 64 + 8 * (pc - 8) : (pc < 24 ? 1024 + h * 64 + 8 * (pc - 16) : 1536 + 8 * (pc - 24)));
}
#define RK_BAR() do { asm volatile("s_waitcnt lgkmcnt(0)" ::: "memory"); __builtin_amdgcn_s_barrier(); asm volatile("" ::: "memory"); } while (0)
__device__ __forceinline__ void rwkv_prep(const Params& p, LAS unsigned char* lds, int b, int h, int ch0, int ch1) {
    const int tid = opaque_tid(), lane = tid & 63, wid = __builtin_amdgcn_readfirstlane(tid >> 6);
    const bf16_t* proj = (const bf16_t*)(p.ws + WS_PROJ) + (size_t)b * SEQ * IC;
    LAS float* R_ = (LAS float*)(lds + RK_R); LAS float* KM_ = (LAS float*)(lds + RK_KM); LAS float* DEC_ = (LAS float*)(lds + RK_DEC); LAS float* KK_ = (LAS float*)(lds + RK_KK);
    LAS float* BB_ = (LAS float*)(lds + RK_BB); LAS float* VV_ = (LAS float*)(lds + RK_VV); LAS float* GG_ = (LAS float*)(lds + RK_GG); LAS float* BON_ = (LAS float*)(lds + RK_BON);
    LAS float* MU_ = (LAS float*)(lds + RK_MU);
    const int dpc = lane < 56 ? lane : 55;
    const bf16_t* dsrc = proj + rk_piece_col(dpc, h);
#define RK_DMA(t0_) do { for (int rho = wid; rho < 33; rho += NWAVES) { int tok = (t0_) - 1 + rho; tok = tok < 0 ? 0 : tok; \
        __builtin_amdgcn_global_load_lds((const unsigned*)(dsrc + (size_t)tok * IC), (LAS unsigned*)(lds + RK_RAW + rho * 1024), 16, 0, 0); } } while (0)
    RK_DMA(ch0 * RCH);
    if (tid < 448) MU_[tid] = p.in[I_MU][rk_piece_col(tid >> 3, h) + (tid & 7)];
    const int ntile = wid & 3, ttile = wid >> 2, fn = lane & 15, fk = lane >> 4;
    const int ncol = h * 64 + ntile * 16 + fn;
    bf16x8 bw[2], ba[2], bg[4];
    {
        const float* wup = p.in[I_WUP]; const float* aup = p.in[I_AUP]; const float* gup = p.in[I_GUP];
#pragma unroll
        for (int ks = 0; ks < 2; ++ks) { float t[8], u[8];
#pragma unroll
            for (int j = 0; j < 8; ++j) { const int k = 32 * ks + 8 * fk + j; t[j] = wup[k * RW + ncol]; u[j] = aup[k * RW + ncol]; }
            u32x4 a, c; a.x = cvtpk(t[0], t[1]); a.y = cvtpk(t[2], t[3]); a.z = cvtpk(t[4], t[5]); a.w = cvtpk(t[6], t[7]);
            c.x = cvtpk(u[0], u[1]); c.y = cvtpk(u[2], u[3]); c.z = cvtpk(u[4], u[5]); c.w = cvtpk(u[6], u[7]);
            bw[ks] = __builtin_bit_cast(bf16x8, a); ba[ks] = __builtin_bit_cast(bf16x8, c); }
#pragma unroll
        for (int ks = 0; ks < 4; ++ks) { float t[8];
#pragma unroll
            for (int j = 0; j < 8; ++j) { const int k = 32 * ks + 8 * fk + j; t[j] = gup[k * RW + ncol]; }
            u32x4 a; a.x = cvtpk(t[0], t[1]); a.y = cvtpk(t[2], t[3]); a.z = cvtpk(t[4], t[5]); a.w = cvtpk(t[6], t[7]);
            bg[ks] = __builtin_bit_cast(bf16x8, a); }
    }
    const float w0n = p.in[I_W0][ncol], a0n = p.in[I_A0][ncol];
    const int q16 = tid & 15, tk16 = tid >> 4;
    const f32x4 kkc = *(const f32x4*)(p.in[I_KK] + h * 64 + 4 * q16), kac = *(const f32x4*)(p.in[I_KA] + h * 64 + 4 * q16), rkc = *(const f32x4*)(p.in[I_RK] + h * 64 + 4 * q16);
    const size_t hb = (size_t)(b * 8 + h) * SEQ * 64;
    float* gVS = (float*)(p.ws + WS_VS) + hb; float* gGG = p.out + (size_t)16 * 1024 * 1024 + hb; float* gBON = (float*)(p.ws + WS_BON) + (size_t)(b * 8 + h) * SEQ;
    unsigned char* gOPS = p.ws + WS_OPS + (size_t)(b * 8 + h) * (SEQ / RCH) * OPREC;
    for (int ch = ch0; ch < ch1; ++ch) {
        const int t0 = ch * RCH;
        if (ch > ch0) { if (wid == 0) asm volatile("s_waitcnt vmcnt(8)" ::: "memory"); else if (wid == 1) asm volatile("s_waitcnt vmcnt(7)" ::: "memory"); else asm volatile("s_waitcnt vmcnt(6)" ::: "memory"); } else asm volatile("s_waitcnt vmcnt(0)" ::: "memory");
        RK_BAR();
#pragma unroll
        for (int it = 0; it < 4; ++it) { const int item = tid + it * NTHREADS;
            if (item < RCH * 56) { const int tk = item / 56, pc = item - tk * 56;
                const u32x4 cv = *(const LAS u32x4*)(lds + RK_RAW + (tk + 1) * 1024 + pc * 16);
                u32x4 pv = *(const LAS u32x4*)(lds + RK_RAW + tk * 1024 + pc * 16);
                if (t0 + tk == 0) pv = (u32x4){0u, 0u, 0u, 0u};
                const f32x4 m0 = *(const LAS f32x4*)(MU_ + pc * 8), m1 = *(const LAS f32x4*)(MU_ + pc * 8 + 4);
                float xv[8];
#pragma unroll
                for (int j = 0; j < 4; ++j) { const unsigned cw = cv[j], pw = pv[j];
                    const float c0 = __uint_as_float(cw << 16), c1 = __uint_as_float(cw & 0xffff0000u), p0 = __uint_as_float(pw << 16), p1 = __uint_as_float(pw & 0xffff0000u);
                    const float ma = (j < 2) ? m0[2 * j] : m1[2 * j - 4], mb = (j < 2) ? m0[2 * j + 1] : m1[2 * j - 3];
                    xv[2 * j] = c0 + ma * (p0 - c0); xv[2 * j + 1] = c1 + mb * (p1 - c1); }
                const int seg = pc >> 3, pi = pc & 7;
                if (seg <= 2) { LAS float* dst = (seg == 0 ? R_ : (seg == 1 ? KM_ : VV_)) + tk * 64 + 8 * pi;
                    *(LAS f32x4*)dst = (f32x4){xv[0], xv[1], xv[2], xv[3]}; *(LAS f32x4*)(dst + 4) = (f32x4){xv[4], xv[5], xv[6], xv[7]}; }
                else if (seg == 3) { u32x4 w; w.x = cvtpk(tanh_fast(xv[0]), tanh_fast(xv[1])); w.y = cvtpk(tanh_fast(xv[2]), tanh_fast(xv[3])); w.z = cvtpk(tanh_fast(xv[4]), tanh_fast(xv[5])); w.w = cvtpk(tanh_fast(xv[6]), tanh_fast(xv[7]));
                    *(LAS u32x4*)(lds + RK_AW + tk * 144 + 16 * pi) = w; }
                else if (seg == 4) { u32x4 w; w.x = cvtpk(xv[0], xv[1]); w.y = cvtpk(xv[2], xv[3]); w.z = cvtpk(xv[4], xv[5]); w.w = cvtpk(xv[6], xv[7]);
                    *(LAS u32x4*)(lds + RK_AA + tk * 144 + 16 * pi) = w; }
                else { u32x4 w; w.x = cvtpk(sigmoidf_(xv[0]), sigmoidf_(xv[1])); w.y = cvtpk(sigmoidf_(xv[2]), sigmoidf_(xv[3])); w.z = cvtpk(sigmoidf_(xv[4]), sigmoidf_(xv[5])); w.w = cvtpk(sigmoidf_(xv[6]), sigmoidf_(xv[7]));
                    *(LAS u32x4*)(lds + RK_AG + tk * 272 + (pc - 40) * 16) = w; }
            } }
        __syncthreads();
        if (ch + 1 < ch1) RK_DMA(t0 + RCH);
        {
            f32x4 cw = (f32x4){0.f, 0.f, 0.f, 0.f}, ca = cw, cg2 = cw;
            const int tok = ttile * 16 + fn;
#pragma unroll
            for (int ks = 0; ks < 2; ++ks) {
                const bf16x8 aw = *(const LAS bf16x8*)(lds + RK_AW + tok * 144 + (32 * ks + 8 * fk) * 2);
                const bf16x8 aa = *(const LAS bf16x8*)(lds + RK_AA + tok * 144 + (32 * ks + 8 * fk) * 2);
                cw = __builtin_amdgcn_mfma_f32_16x16x32_bf16(aw, bw[ks], cw, 0, 0, 0);
                ca = __builtin_amdgcn_mfma_f32_16x16x32_bf16(aa, ba[ks], ca, 0, 0, 0);
            }
#pragma unroll
            for (int ks = 0; ks < 4; ++ks) {
                const bf16x8 ag = *(const LAS bf16x8*)(lds + RK_AG + tok * 272 + (32 * ks + 8 * fk) * 2);
                cg2 = __builtin_amdgcn_mfma_f32_16x16x32_bf16(ag, bg[ks], cg2, 0, 0, 0);
            }
#pragma unroll
            for (int r = 0; r < 4; ++r) { const int tk = ttile * 16 + 4 * fk + r, n = ntile * 16 + fn;
                DEC_[tk * 64 + n] = -0.6065306597126334f * sigmoidf_(cw[r] + w0n);
                BB_[tk * 64 + n] = sigmoidf_(ca[r] + a0n);
                GG_[tk * 64 + n] = cg2[r]; }
        }
        RK_BAR();
        {
            const f32x4 kp = *(const LAS f32x4*)(KM_ + tk16 * 64 + 4 * q16), av = *(const LAS f32x4*)(BB_ + tk16 * 64 + 4 * q16), rr = *(const LAS f32x4*)(R_ + tk16 * 64 + 4 * q16);
            const f32x4 kkv = kp * kkc;
            const float nrm2 = red16((kkv[0] * kkv[0] + kkv[1] * kkv[1]) + (kkv[2] * kkv[2] + kkv[3] * kkv[3]));
            const f32x4 kkn = kkv * __builtin_amdgcn_rsqf(fmaxf(nrm2, 1e-24f));
            const f32x4 kmod = kp * ((av - 1.0f) * kac + 1.0f);
            const f32x4 t = rr * kmod * rkc;
            const float bs = red16((t[0] + t[1]) + (t[2] + t[3]));
            *(LAS f32x4*)(KK_ + tk16 * 64 + 4 * q16) = kkn; *(LAS f32x4*)(BB_ + tk16 * 64 + 4 * q16) = kkn * av; *(LAS f32x4*)(KM_ + tk16 * 64 + 4 * q16) = kmod;
            if (q16 == 0) BON_[tk16] = bs;
        }
        RK_BAR();
        {
            const int d1 = tid & 63, q1 = wid;
            float lw[4], cs[4];
#pragma unroll
            for (int e = 0; e < 4; ++e) lw[e] = DEC_[(4 * q1 + e) * 64 + d1];
            cs[0] = lw[0]; cs[1] = cs[0] + lw[1]; cs[2] = cs[1] + lw[2]; cs[3] = cs[2] + lw[3];
            ((LAS float*)(lds + RK_LSEG))[q1 * 64 + d1] = cs[3];
            { const float x0 = VV_[(4 * q1) * 64 + d1], x1 = VV_[(4 * q1 + 1) * 64 + d1], x2 = VV_[(4 * q1 + 2) * 64 + d1], x3 = VV_[(4 * q1 + 3) * 64 + d1];
              u32x2 w; w.x = cvtpk(x0, x1); w.y = cvtpk(x2, x3); *(LAS u32x2*)(lds + RK_IM + OP_VT + d1 * 80 + q1 * 8) = w; }
            RK_BAR();
            float off = 0.f, tot = 0.f;
#pragma unroll
            for (int qq = 0; qq < 8; ++qq) { const float sg = ((const LAS float*)(lds + RK_LSEG))[qq * 64 + d1]; tot += sg; if (qq < q1) off += sg; }
            const float etot = __expf(tot);
            float ePprev = __expf(off);
            float bc[4], kc4[4];
#pragma unroll
            for (int e = 0; e < 4; ++e) { const int tk = 4 * q1 + e;
                const float eP = __expf(off + cs[e]), eN = __builtin_amdgcn_rcpf(eP), eE = etot * eN;
                const float kap = KK_[tk * 64 + d1], bet = BB_[tk * 64 + d1], kk_ = KM_[tk * 64 + d1], rr = R_[tk * 64 + d1];
                const unsigned w0 = cvtpk(-kap * ePprev, rr * eP), w1 = cvtpk(bet * eN, kk_ * eN);
                *(LAS unsigned short*)(lds + RK_IM + OP_AT + tk * 144 + d1 * 2) = (unsigned short)(w0 & 0xffffu); *(LAS unsigned short*)(lds + RK_IM + OP_RT + tk * 144 + d1 * 2) = (unsigned short)(w0 >> 16);
                *(LAS unsigned short*)(lds + RK_IM + OP_BH + tk * 144 + d1 * 2) = (unsigned short)(w1 & 0xffffu); *(LAS unsigned short*)(lds + RK_IM + OP_KH + tk * 144 + d1 * 2) = (unsigned short)(w1 >> 16);
                bc[e] = bet * eE; kc4[e] = kk_ * eE; ePprev = eP; }
            u32x2 wb, wk; wb.x = cvtpk(bc[0], bc[1]); wb.y = cvtpk(bc[2], bc[3]); wk.x = cvtpk(kc4[0], kc4[1]); wk.y = cvtpk(kc4[2], kc4[3]);
            *(LAS u32x2*)(lds + RK_IM + OP_BCT + d1 * 80 + q1 * 8) = wb; *(LAS u32x2*)(lds + RK_IM + OP_KCT + d1 * 80 + q1 * 8) = wk;
            if (q1 == 0) ((LAS float*)(lds + RK_IM + OP_P31))[d1] = etot;
        }
        RK_BAR();
        {
            unsigned char* rec = gOPS + (size_t)ch * OPREC;
#pragma unroll
            for (int i = 0; i < 5; ++i) { const int o = (tid + i * NTHREADS) * 16; if (o < OPREC) *(u32x4*)(rec + o) = *(const LAS u32x4*)(lds + RK_IM + o); }
            const size_t go = (size_t)t0 * 64 + tid * 4;
            *(f32x4*)(gVS + go) = *(const LAS f32x4*)(VV_ + tid * 4);
            *(f32x4*)(gGG + go) = *(const LAS f32x4*)(GG_ + tid * 4);
            if (tid < RCH) gBON[t0 + tid] = BON_[tid];
        }
    }
    asm volatile("s_waitcnt vmcnt(0)" ::: "memory");
    __syncthreads();
#undef RK_DMA
}

constexpr int CS_IN = 32768;
constexpr int CS_OP = 2 * CS_IN;
constexpr int CS_AT = 0, CS_RT = 4608, CS_BH = 9216, CS_KH = 13824, CS_BCT = 18432, CS_KCT = 23552, CS_VT = 28672, CS_P31 = 31744;
constexpr int CS_MT2 = CS_OP, CS_MT3 = CS_OP + 2560, CS_MT4 = CS_OP + 5120;
constexpr int CS_M1F = CS_OP + 7680;
constexpr int CS_XF = CS_OP + 12288;
constexpr int CS_UB = CS_OP + 16896;
constexpr int CS_SB = CS_OP + 19456;
constexpr int CS_YY = CS_OP + 24064;
constexpr int CS_END = CS_OP + 28160;
static_assert(CS_END <= LDS_BYTES - 64, "rwkv scan LDS map");
__device__ __forceinline__ int crow32(int r, int hi) { return (r & 3) + 8 * (r >> 2) + 4 * hi; }
__device__ __forceinline__ void rwkv_scan(const Params& p, LAS unsigned char* lds, int b, int h, int half) {
    const int tid = opaque_tid(), lane = tid & 63, wid = __builtin_amdgcn_readfirstlane(tid >> 6), r32 = lane & 31, hi = lane >> 5;
    const unsigned char* gOPS = p.ws + WS_OPS + (size_t)(b * 8 + h) * (SEQ / RCH) * OPREC;
    float* yraw = p.out + (size_t)b * SEQ * RW + h * 64 + half * 32;
#define RS_DMA(ch_, buf) do { LAS unsigned char* bb_ = lds + (buf) * CS_IN; const unsigned char* rec_ = gOPS + (size_t)(ch_) * OPREC; \
        for (int pc = wid; pc < 32; pc += NWAVES) { \
            const unsigned char* src_ = rec_ + (pc < 28 ? pc * 1024 : (pc < 31 ? OP_VT + half * 2560 + (pc - 28) * 1024 : OP_P31)) + lane * 16; \
            __builtin_amdgcn_global_load_lds((const unsigned*)src_, (LAS unsigned*)(bb_ + pc * 1024), 16, 0, 0); } } while (0)
    RS_DMA(0, 0);
    for (int i = tid; i < 4608 / 4; i += NTHREADS) ((LAS unsigned*)(lds + CS_SB))[i] = 0u;
    f32x16 Sacc = f32x16{};
    f32x16 Xacc = f32x16{};
    for (int ch = 0; ch < SEQ / RCH; ++ch) {
        const int t0 = ch * RCH, cur = ch & 1;
        if (wid < 4 && ch > 0) asm volatile("s_waitcnt vmcnt(1)" ::: "memory"); else asm volatile("s_waitcnt vmcnt(0)" ::: "memory");
        RK_BAR();
        if (ch + 1 < SEQ / RCH) RS_DMA(ch + 1, cur ^ 1);
        const LAS unsigned char* ib = lds + cur * CS_IN;
        if (wid < 4) {
            const LAS unsigned char* Am = ib + ((wid & 1) ? CS_KH : CS_BH) + r32 * 144 + hi * 16;
            const LAS unsigned char* Bm = ib + ((wid & 2) ? CS_RT : CS_AT) + r32 * 144 + hi * 16;
            f32x16 acc = f32x16{};
#pragma unroll
            for (int ks = 0; ks < 4; ++ks) acc = __builtin_amdgcn_mfma_f32_32x32x16_bf16(*(const LAS bf16x8*)(Am + ks * 32), *(const LAS bf16x8*)(Bm + ks * 32), acc, 0, 0, 0);
            const int lim = (wid < 2) ? r32 : r32 + 1;
#pragma unroll
            for (int rg = 0; rg < 16; ++rg) if (crow32(rg, hi) >= lim) acc[rg] = 0.f;
            if (wid == 0) {
#pragma unroll
                for (int rg = 0; rg < 16; ++rg) ((LAS float*)(lds + CS_M1F))[crow32(rg, hi) * 36 + r32] = acc[rg];
            } else {
                LAS unsigned char* Mt = lds + (wid == 1 ? CS_MT2 : (wid == 2 ? CS_MT3 : CS_MT4)) + r32 * 80 + hi * 8;
#pragma unroll
                for (int g = 0; g < 4; ++g) { u32x2 w; w.x = cvtpk(acc[4 * g], acc[4 * g + 1]); w.y = cvtpk(acc[4 * g + 2], acc[4 * g + 3]); *(LAS u32x2*)(Mt + g * 16) = w; }
            }
        } else if (wid < 6) {
            const LAS unsigned char* Am = ib + (wid == 4 ? CS_AT : CS_RT) + r32 * 144 + hi * 16;
            const LAS unsigned char* Bm = lds + CS_SB + r32 * 144 + hi * 16;
            Xacc = f32x16{};
#pragma unroll
            for (int ks = 0; ks < 4; ++ks) Xacc = __builtin_amdgcn_mfma_f32_32x32x16_bf16(*(const LAS bf16x8*)(Am + ks * 32), *(const LAS bf16x8*)(Bm + ks * 32), Xacc, 0, 0, 0);
        }
        RK_BAR();
        if (wid == 4) {
            const LAS unsigned char* Am = lds + CS_MT2 + r32 * 80 + hi * 16;
            const LAS unsigned char* Bm = ib + CS_VT + r32 * 80 + hi * 16;
#pragma unroll
            for (int ks = 0; ks < 2; ++ks) Xacc = __builtin_amdgcn_mfma_f32_32x32x16_bf16(*(const LAS bf16x8*)(Am + ks * 32), *(const LAS bf16x8*)(Bm + ks * 32), Xacc, 0, 0, 0);
#pragma unroll
            for (int g = 0; g < 4; ++g) *(LAS f32x4*)(lds + CS_XF + r32 * 144 + (8 * g + 4 * hi) * 4) = (f32x4){Xacc[4 * g], Xacc[4 * g + 1], Xacc[4 * g + 2], Xacc[4 * g + 3]};
        }
        RK_BAR();
        {
            const int v = tid >> 4, l = tid & 15;
            float m0[32], m1[32];
#pragma unroll
            for (int c4 = 0; c4 < 8; ++c4) { const f32x4 a = *(const LAS f32x4*)(lds + CS_M1F + l * 144 + c4 * 16), c = *(const LAS f32x4*)(lds + CS_M1F + (l + 16) * 144 + c4 * 16);
                m0[4 * c4] = a[0]; m0[4 * c4 + 1] = a[1]; m0[4 * c4 + 2] = a[2]; m0[4 * c4 + 3] = a[3]; m1[4 * c4] = c[0]; m1[4 * c4 + 1] = c[1]; m1[4 * c4 + 2] = c[2]; m1[4 * c4 + 3] = c[3]; }
            const float x0 = ((const LAS float*)(lds + CS_XF))[v * 36 + l], x1 = ((const LAS float*)(lds + CS_XF))[v * 36 + l + 16];
            float u0 = 0.f, u1 = 0.f;
#pragma unroll
            for (int i = 0; i < 32; ++i) {
                const float part = (i < 16) ? u0 * m0[i] : (u0 * m0[i] + u1 * m1[i]);
                const float tot = red16(part);
                if (i < 16) u0 = (l == i) ? x0 + tot : u0; else u1 = (l == i - 16) ? x1 + tot : u1;
            }
            const unsigned w = cvtpk(u0, u1);
            *(LAS unsigned short*)(lds + CS_UB + v * 80 + l * 2) = (unsigned short)(w & 0xffffu); *(LAS unsigned short*)(lds + CS_UB + v * 80 + (l + 16) * 2) = (unsigned short)(w >> 16);
        }
        RK_BAR();
        if (wid == 5) {
            const LAS unsigned char* A3 = lds + CS_MT3 + r32 * 80 + hi * 16; const LAS unsigned char* A4 = lds + CS_MT4 + r32 * 80 + hi * 16;
            const LAS unsigned char* Bu = lds + CS_UB + r32 * 80 + hi * 16; const LAS unsigned char* Bv = ib + CS_VT + r32 * 80 + hi * 16;
#pragma unroll
            for (int ks = 0; ks < 2; ++ks) { Xacc = __builtin_amdgcn_mfma_f32_32x32x16_bf16(*(const LAS bf16x8*)(A3 + ks * 32), *(const LAS bf16x8*)(Bu + ks * 32), Xacc, 0, 0, 0);
                Xacc = __builtin_amdgcn_mfma_f32_32x32x16_bf16(*(const LAS bf16x8*)(A4 + ks * 32), *(const LAS bf16x8*)(Bv + ks * 32), Xacc, 0, 0, 0); }
#pragma unroll
            for (int rg = 0; rg < 16; ++rg) ((LAS float*)(lds + CS_YY))[crow32(rg, hi) * 32 + r32] = Xacc[rg];
        } else if (wid < 2) {
#pragma unroll
            for (int g = 0; g < 4; ++g) { const f32x4 pv = *(const LAS f32x4*)(ib + CS_P31 + (32 * wid + 8 * g + 4 * hi) * 4);
                Sacc[4 * g] *= pv[0]; Sacc[4 * g + 1] *= pv[1]; Sacc[4 * g + 2] *= pv[2]; Sacc[4 * g + 3] *= pv[3]; }
            const LAS unsigned char* Ab = ib + CS_BCT + (32 * wid + r32) * 80 + hi * 16; const LAS unsigned char* Ak = ib + CS_KCT + (32 * wid + r32) * 80 + hi * 16;
            const LAS unsigned char* Bu = lds + CS_UB + r32 * 80 + hi * 16; const LAS unsigned char* Bv = ib + CS_VT + r32 * 80 + hi * 16;
#pragma unroll
            for (int ks = 0; ks < 2; ++ks) { Sacc = __builtin_amdgcn_mfma_f32_32x32x16_bf16(*(const LAS bf16x8*)(Ab + ks * 32), *(const LAS bf16x8*)(Bu + ks * 32), Sacc, 0, 0, 0);
                Sacc = __builtin_amdgcn_mfma_f32_32x32x16_bf16(*(const LAS bf16x8*)(Ak + ks * 32), *(const LAS bf16x8*)(Bv + ks * 32), Sacc, 0, 0, 0); }
#pragma unroll
            for (int g = 0; g < 4; ++g) { u32x2 w; w.x = cvtpk(Sacc[4 * g], Sacc[4 * g + 1]); w.y = cvtpk(Sacc[4 * g + 2], Sacc[4 * g + 3]); *(LAS u32x2*)(lds + CS_SB + r32 * 144 + (32 * wid + 8 * g + 4 * hi) * 2) = w; }
        }
        RK_BAR();
        if (tid < 256) { const int tk = tid >> 3, sub = tid & 7; *(f32x4*)(yraw + (size_t)(t0 + tk) * RW + sub * 4) = *(const LAS f32x4*)(lds + CS_YY + tk * 128 + sub * 16); }
    }
    asm volatile("s_waitcnt vmcnt(0)" ::: "memory");
    __syncthreads();
#undef RS_DMA
}
__device__ __forceinline__ void rwkv_finalize(const Params& p, int G) {
    const int tid = opaque_tid(), q16 = tid & 15;
    const float* yraw = p.out; const float* gGG = p.out + (size_t)16 * 1024 * 1024; const float* gVS = (const float*)(p.ws + WS_VS); const float* gBON = (const float*)(p.ws + WS_BON);
    bf16_t* ymix = (bf16_t*)(p.ws + WS_YMIX);
    for (int item = (int)blockIdx.x * (NTHREADS / 16) + (tid >> 4); item < T * 8; item += G * (NTHREADS / 16)) {
        const int tok = item >> 3, h = item & 7, b = tok / SEQ, t = tok - b * SEQ;
        const f32x4 y = *(const f32x4*)(yraw + (size_t)tok * RW + h * 64 + 4 * q16);
        const size_t ho = ((size_t)(b * 8 + h) * SEQ + t) * 64 + 4 * q16;
        const f32x4 vv = *(const f32x4*)(gVS + ho), gg = *(const f32x4*)(gGG + ho);
        const float bon = gBON[(size_t)(b * 8 + h) * SEQ + t];
        const f32x4 gng = *(const f32x4*)(p.in[I_GNG] + h * 64 + 4 * q16), gnb = *(const f32x4*)(p.in[I_GNB] + h * 64 + 4 * q16);
        const float mean = red16((y[0] + y[1]) + (y[2] + y[3])) * (1.0f / 64.0f);
        const f32x4 dl = y - mean;
        const float var = red16((dl[0] * dl[0] + dl[1] * dl[1]) + (dl[2] * dl[2] + dl[3] * dl[3])) * (1.0f / 64.0f);
        const f32x4 yn = dl * __builtin_amdgcn_rsqf(var + GN_EPS) * gng + gnb;
        const f32x4 ov = (yn + vv * bon) * gg;
        u32x2 w; w.x = cvtpk(ov[0], ov[1]); w.y = cvtpk(ov[2], ov[3]);
        *(u32x2*)(ymix + (size_t)tok * D + h * 64 + 4 * q16) = w;
    }
}
#undef RK_BAR

constexpr int RT_WT = 0;
constexpr int RT_LG = 131584;
constexpr int RT_GS = RT_LG + 16896;
constexpr int RT_RS = RT_GS + 8192;
constexpr int RT_HIST = RT_RS + 512;
static_assert(RT_HIST + 128 <= LDS_BYTES - 64, "router LDS map");
__device__ __forceinline__ void phase_router(const Params& p, LAS unsigned char* lds, int G) {
    const int tid = opaque_tid(), lane = tid & 63, wave = __builtin_amdgcn_readfirstlane(tid >> 6);
    LAS float* wt = (LAS float*)(lds + RT_WT); LAS float* lg = (LAS float*)(lds + RT_LG); LAS float* gs = (LAS float*)(lds + RT_GS); LAS float* shl = gs + 1024;
    LAS float* rsl = (LAS float*)(lds + RT_RS); LAS int* hist = (LAS int*)(lds + RT_HIST);
    const float* rw = p.in[I_RTW];
    const float* x1 = p.out; const float* gain = p.in[I_N2G]; const float* mod = (const float*)(p.ws + WS_MOD); const float* rb = p.in[I_RTB];
    unsigned char* h2q = p.ws + WS_H;
    int* ridx = (int*)(p.ws + WS_ROUTE); float* rwt = (float*)(p.ws + WS_ROUTE + 512 * 1024);
    int* blockcnt = (int*)(p.ws + WS_CTL + 4096);
    const int TPB = T / G;
    const int blk = blockIdx.x, tok0 = blk * TPB, b = tok0 / SEQ;
    for (int i = tid; i < 1024 * 8; i += NTHREADS) { const int k = i >> 3, c4 = i & 7; const f32x4 v = *(const f32x4*)(rw + k * 32 + 4 * c4);
        wt[(4 * c4 + 0) * 1028 + k] = v[0]; wt[(4 * c4 + 1) * 1028 + k] = v[1]; wt[(4 * c4 + 2) * 1028 + k] = v[2]; wt[(4 * c4 + 3) * 1028 + k] = v[3]; }
    for (int k = tid; k < 1024; k += NTHREADS) { gs[k] = gain[k] * (1.0f + mod[b * 6144 + 4096 + k]); shl[k] = mod[b * 6144 + 3072 + k]; }
    if (tid < 32) hist[tid] = 0;
    __syncthreads();
    for (int t0 = 0; t0 < TPB; t0 += 128) {
        for (int ti = wave; ti < 128 && t0 + ti < TPB; ti += 4 * NWAVES) {
            f32x4 v[4][4];
#pragma unroll
            for (int q = 0; q < 4; ++q) { const int tq = ti + q * NWAVES; if (tq < 128 && t0 + tq < TPB) { const f32x4* xr = (const f32x4*)(x1 + (size_t)(tok0 + t0 + tq) * D) + lane;
#pragma unroll
                for (int j = 0; j < 4; ++j) v[q][j] = xr[64 * j]; } }
#pragma unroll
            for (int q = 0; q < 4; ++q) { const int tq = ti + q * NWAVES; if (tq < 128 && t0 + tq < TPB) {
                const int row = tok0 + t0 + tq; float s = 0.f;
#pragma unroll
                for (int j = 0; j < 4; ++j) s += (v[q][j][0] * v[q][j][0] + v[q][j][1] * v[q][j][1]) + (v[q][j][2] * v[q][j][2] + v[q][j][3] * v[q][j][3]);
                const float rstd = rsqrtf(wave_sum(s) * (1.0f / D) + NORM_EPS);
                if (lane == 0) rsl[tq] = rstd;
                unsigned* o4 = (unsigned*)(h2q + (size_t)row * D) + lane;
#pragma unroll
                for (int j = 0; j < 4; ++j) { const int k = 4 * lane + 256 * j; const f32x4 g4 = *(const LAS f32x4*)(gs + k), s4 = *(const LAS f32x4*)(shl + k);
                    const f32x4 y = (v[q][j] * rstd) * g4 + s4;
                    o4[64 * j] = cvt4_fp8(Q_H2 * y[0], Q_H2 * y[1], Q_H2 * y[2], Q_H2 * y[3]); } } }
        }
        __syncthreads();
        {
            const int tile = wave & 3, kq = wave >> 2, i = lane & 31, hh = lane >> 5;
            const int kb = 512 * hh + 256 * kq;
            const int trow = t0 + tile * 32 + i;
            const float rstd = rsl[trow - t0];
            const float* xr = x1 + (size_t)(tok0 + trow) * D + kb;
            const LAS float* wrow = wt + i * 1028 + kb;
            f32x16 acc = f32x16{};
#pragma unroll 4
            for (int s4 = 0; s4 < 256; s4 += 4) {
                const f32x4 xv = *(const f32x4*)(xr + s4), g4 = *(const LAS f32x4*)(gs + kb + s4), sh4 = *(const LAS f32x4*)(shl + kb + s4), w4 = *(const LAS f32x4*)(wrow + s4);
                const f32x4 a4 = (xv * rstd) * g4 + sh4;
                acc = __builtin_amdgcn_mfma_f32_32x32x2f32(a4[0], w4[0], acc, 0, 0, 0);
                acc = __builtin_amdgcn_mfma_f32_32x32x2f32(a4[1], w4[1], acc, 0, 0, 0);
                acc = __builtin_amdgcn_mfma_f32_32x32x2f32(a4[2], w4[2], acc, 0, 0, 0);
                acc = __builtin_amdgcn_mfma_f32_32x32x2f32(a4[3], w4[3], acc, 0, 0, 0);
            }
            __syncthreads();
            LAS float* part = (LAS float*)(lds + RT_WT) + tile * 1024;
            if (kq == 1) {
#pragma unroll
                for (int r = 0; r < 16; ++r) part[r * 64 + lane] = acc[r];
            }
            __syncthreads();
            if (kq == 0) {
                const float bias = rb[i];
#pragma unroll
                for (int r = 0; r < 16; ++r) { const int tk = tile * 32 + (r & 3) + 8 * (r >> 2) + 4 * hh; lg[tk * 33 + i] = acc[r] + part[r * 64 + lane] + bias; }
            }
        }
        __syncthreads();
        if (tid < 128 && t0 + tid < TPB) {
            const int row = tok0 + t0 + tid; const LAS float* lr = lg + tid * 33;
            float v0 = -INFINITY, v1 = -INFINITY, v2 = -INFINITY, v3 = -INFINITY; int i0 = 0, i1 = 0, i2 = 0, i3 = 0;
#pragma unroll
            for (int e = 0; e < 32; ++e) { const float x = lr[e];
                if (x > v0) { v3 = v2; i3 = i2; v2 = v1; i2 = i1; v1 = v0; i1 = i0; v0 = x; i0 = e; }
                else if (x > v1) { v3 = v2; i3 = i2; v2 = v1; i2 = i1; v1 = x; i1 = e; }
                else if (x > v2) { v3 = v2; i3 = i2; v2 = x; i2 = e; }
                else if (x > v3) { v3 = x; i3 = e; } }
            const float e1 = __expf(v1 - v0), e2 = __expf(v2 - v0), e3 = __expf(v3 - v0); const float inv = 1.0f / (1.0f + e1 + e2 + e3);
            *(int4*)(ridx + (size_t)row * 4) = make_int4(i0, i1, i2, i3); *(float4*)(rwt + (size_t)row * 4) = make_float4(inv, e1 * inv, e2 * inv, e3 * inv);
            atomicAdd((int*)&hist[i0], 1); atomicAdd((int*)&hist[i1], 1); atomicAdd((int*)&hist[i2], 1); atomicAdd((int*)&hist[i3], 1);
        }
        __syncthreads();
        if (t0 + 128 < TPB) {
            for (int i = tid; i < 1024 * 8; i += NTHREADS) { const int k = i >> 3, c4 = i & 7; const f32x4 v = *(const f32x4*)(rw + k * 32 + 4 * c4);
                wt[(4 * c4 + 0) * 1028 + k] = v[0]; wt[(4 * c4 + 1) * 1028 + k] = v[1]; wt[(4 * c4 + 2) * 1028 + k] = v[2]; wt[(4 * c4 + 3) * 1028 + k] = v[3]; }
            __syncthreads();
        }
    }
    if (tid < 32) blockcnt[blk * 32 + tid] = hist[tid];
    __syncthreads();
}

__device__ __forceinline__ void phase_assign(const Params& p, LAS unsigned char* lds, int G) {
    const int tid = opaque_tid(), lane = tid & 63, wave = tid >> 6;
    LAS int* part = (LAS int*)lds;
    LAS int* partb = part + 512;
    LAS int* total = partb + 512;
    LAS int* base = total + 32;
    LAS int* segst = base + 32;
    LAS int* cursor = segst + 32;
    LAS int* slotl = cursor + 32;
    const int* blockcnt = (const int*)(p.ws + WS_CTL + 4096);
    const int* ridx = (const int*)(p.ws + WS_ROUTE); int* rslot = (int*)(p.ws + WS_ROUTE + 1024 * 1024); int* tokmap = (int*)(p.ws + WS_ROUTE + 2 * 1024 * 1024);
    const bf16_t* h2 = (const bf16_t*)(p.ws + WS_H); bf16_t* xs = (bf16_t*)(p.ws + WS_PROJ);
    int* tile = (int*)(p.ws + WS_TILE);
    const int TPB = T / G; const int blk = blockIdx.x;
    { const int e = tid & 31, part_i = tid >> 5; int st = 0, sb = 0;
        for (int bb = part_i; bb < G; bb += 16) { const int c = blockcnt[bb * 32 + e]; st += c; if (bb < blk) sb += c; }
        part[part_i * 32 + e] = st; partb[part_i * 32 + e] = sb; }
    __syncthreads();
    if (tid < 32) { int st = 0, sb = 0;
#pragma unroll
        for (int i = 0; i < 16; ++i) { st += part[i * 32 + tid]; sb += partb[i * 32 + tid]; }
        total[tid] = st; base[tid] = sb; cursor[tid] = 0; }
    __syncthreads();
    if (tid == 0) { int acc = 0; for (int e = 0; e < 32; ++e) { segst[e] = acc; acc += (total[e] + 255) & ~255; }
        if (blk == 0) { int pm = 0; for (int e = 0; e < 32; ++e) { const int nt = (total[e] + 255) >> 8; for (int i = 0; i < nt; ++i) tile[16 + pm + i] = e; pm += nt; } tile[0] = pm; } }
    __syncthreads();
    if (tid < 32) base[tid] += segst[tid];
    __syncthreads();
    for (int a = tid; a < TPB * 4; a += NTHREADS) { const int tok = blk * TPB + (a >> 2); const int e = ridx[(size_t)tok * 4 + (a & 3)];
        const int rank = atomicAdd((int*)&cursor[e], 1); const int slot = base[e] + rank; rslot[(size_t)tok * 4 + (a & 3)] = slot; tokmap[slot] = tok; }
    for (int e = blk; e < 32; e += G) { const int s0 = segst[e] + total[e], s1 = segst[e] + ((total[e] + 255) & ~255);
        for (int r = s0 + tid; r < s1; r += NTHREADS) tokmap[r] = 0; }
}

__device__ __forceinline__ void phase_final(const Params& p, int G, int stage) {
    const int tid = opaque_tid(), lane = tid & 63, wave = tid >> 6;
    const int gw = (int)blockIdx.x * NWAVES + wave, NGW = G * NWAVES;
    const float* fg = p.in[I_FG]; const float* mod = (const float*)(p.ws + WS_MOD);
    const int* rslot = (const int*)(p.ws + WS_ROUTE + 1024 * 1024); const float* rwt = (const float*)(p.ws + WS_ROUTE + 512 * 1024);
    const bf16_t* Y = (const bf16_t*)(p.ws + WS_PROJ);
    const float* src = (stage >= 4) ? p.out : p.in[I_X];
    for (int row = gw; row < T; row += NGW) {
        const int b = row / SEQ;
        const f32x4* xr = (const f32x4*)(src + (size_t)row * D) + lane;
        f32x4 v[4];
#pragma unroll
        for (int j = 0; j < 4; ++j) v[j] = xr[64 * j];
        if (stage >= 9) {
            const int4 sl = *(const int4*)(rslot + (size_t)row * 4); const float4 wt = *(const float4*)(rwt + (size_t)row * 4);
            const float* g2 = mod + b * 6144 + 5120;
            const int sls[4] = {sl.x, sl.y, sl.z, sl.w}; const float wts[4] = {wt.x, wt.y, wt.z, wt.w};
#pragma unroll
            for (int j = 0; j < 4; ++j) { f32x4 m = (f32x4){0.f, 0.f, 0.f, 0.f};
#pragma unroll
                for (int k = 0; k < 4; ++k) { const u32x2 yv = *((const u32x2*)(Y + (size_t)sls[k] * D) + lane + 64 * j);
                    m[0] += wts[k] * __uint_as_float(yv.x << 16); m[1] += wts[k] * __uint_as_float(yv.x & 0xffff0000u); m[2] += wts[k] * __uint_as_float(yv.y << 16); m[3] += wts[k] * __uint_as_float(yv.y & 0xffff0000u); }
                const f32x4 g = *(const f32x4*)(g2 + 4 * lane + 256 * j); v[j] = v[j] + g * m; }
        }
        float s = 0.f;
#pragma unroll
        for (int j = 0; j < 4; ++j) s += (v[j][0] * v[j][0] + v[j][1] * v[j][1]) + (v[j][2] * v[j][2] + v[j][3] * v[j][3]);
        const float rstd = rsqrtf(wave_sum(s) * (1.0f / D) + NORM_EPS);
        f32x4* orow = (f32x4*)(p.out + (size_t)row * D) + lane;
#pragma unroll
        for (int j = 0; j < 4; ++j) { const f32x4 g = *(const f32x4*)(fg + 4 * lane + 256 * j); orow[64 * j] = v[j] * rstd * g; }
    }
}


#define XB_TMO      128
#define XB_XCNT(j)  (256  + 64 * (j))
#define XB_XSUB(j)  (1280 + 64 * (j))
#define XB_XGEN(j)  (2304 + 64 * (j))
#define XB_TOP      3328
#define XB_TOPGEN   3392
#define XCD_BAR_WORDS 3456
#define XB_SPIN_CAP (1u << 22)
__device__ __forceinline__ unsigned xb_ld(unsigned* p)              { return __hip_atomic_load(p, __ATOMIC_RELAXED, __HIP_MEMORY_SCOPE_AGENT); }
__device__ __forceinline__ unsigned xb_add(unsigned* p, unsigned v) { return __hip_atomic_fetch_add(p, v, __ATOMIC_RELAXED, __HIP_MEMORY_SCOPE_AGENT); }
__device__ __forceinline__ unsigned xb_xcc_id() { return (unsigned)__builtin_amdgcn_s_getreg((3 << 11) | 20) & 0xFu; }
#define XB_SPIN(cond, bar) do { unsigned _sp = 0; while (cond) { __builtin_amdgcn_s_sleep(1); \
    if ((++_sp & 255u) == 0u) { if (xb_ld(&(bar)[XB_TMO])) break; if (_sp > XB_SPIN_CAP) { atomicAdd(&(bar)[XB_TMO], 1u); break; } } } } while (0)
struct XcdBarrier { unsigned* bar; unsigned x; volatile LAS unsigned* st; };
__device__ __forceinline__ XcdBarrier xcd_barrier_post(unsigned* bar, volatile LAS unsigned* st) {
    XcdBarrier b; b.bar = bar; b.x = xb_xcc_id(); b.st = st;
    if (threadIdx.x == 0) (void)xb_add(&bar[XB_XCNT(b.x)], 1u);
    return b;
}
__device__ __forceinline__ void xcd_barrier_complete(unsigned* bar, unsigned x, unsigned& nloc, unsigned& nx) {
    const unsigned G = gridDim.x * gridDim.y * gridDim.z;
    unsigned sum, cnt, mine, sp = 0u;
    for (;;) {
        sum = 0u; cnt = 0u; mine = 0u;
#pragma unroll
        for (unsigned j = 0; j < 16; ++j) { const unsigned c = xb_ld(&bar[XB_XCNT(j)]); sum += c; cnt += (c > 0u) ? 1u : 0u; mine = (j == x) ? c : mine; }
        if (sum == G) break;
        __builtin_amdgcn_s_sleep(1);
        if ((++sp & 255u) == 0u) { if (xb_ld(&bar[XB_TMO])) break; if (sp > XB_SPIN_CAP) { atomicAdd(&bar[XB_TMO], 1u); break; } }
    }
    nloc = mine > 0u ? mine : 1u; nx = cnt > 0u ? cnt : 1u;
}
__device__ __forceinline__ void xcd_barrier(const XcdBarrier& b) {
    asm volatile("s_waitcnt vmcnt(0)" ::: "memory");
    __syncthreads();
    if (threadIdx.x == 0) {
        unsigned* bar = b.bar;
        __builtin_amdgcn_s_waitcnt(0);
        unsigned nloc = b.st[0], nx = b.st[1];
        if (nloc == 0u) { xcd_barrier_complete(bar, b.x, nloc, nx); b.st[0] = nloc; b.st[1] = nx; }
        const unsigned old = xb_add(&bar[XB_XSUB(b.x)], 1u);
        const unsigned gen = old / nloc;
        if (old + 1u == (gen + 1u) * nloc) {
            __builtin_amdgcn_fence(__ATOMIC_RELEASE, "agent");
            asm volatile("s_waitcnt vmcnt(0)" ::: "memory");
            const unsigned og = xb_add(&bar[XB_TOP], 1u);
            const unsigned tg = og / nx;
            if (og + 1u == (tg + 1u) * nx) xb_add(&bar[XB_TOPGEN], 1u);
            else XB_SPIN(xb_ld(&bar[XB_TOPGEN]) == tg, bar);
            __builtin_amdgcn_fence(__ATOMIC_ACQUIRE, "agent");
            xb_add(&bar[XB_XGEN(b.x)], 1u);
            asm volatile("s_waitcnt vmcnt(0)" ::: "memory");
        } else {
            XB_SPIN(xb_ld(&bar[XB_XGEN(b.x)]) == gen, bar);
            __builtin_amdgcn_fence(__ATOMIC_ACQUIRE, "agent");
            asm volatile("s_waitcnt vmcnt(0)" ::: "memory");
        }
    }
    __syncthreads();
}

__device__ __forceinline__ const Params* launder_params(const Params* q) { asm volatile("" : "+s"(q)); return q; }
__global__ void __launch_bounds__(NTHREADS, 2) hymba_fwd(Params p) {
    extern __shared__ __attribute__((aligned(16))) unsigned char lds_raw[];
    cg::grid_group grid = cg::this_grid();
    LAS unsigned char* lds = (LAS unsigned char*)lds_raw;
    const int G = gridDim.x, tid = threadIdx.x;
    constexpr int STAGE = DBG_STAGE;
    volatile LAS unsigned* xst = (volatile LAS unsigned*)(lds + LDS_BYTES - 64);
    if (tid == 0) { xst[0] = 0u; xst[1] = 0u; }
    __syncthreads();
    const XcdBarrier xbar = xcd_barrier_post((unsigned*)(p.ws + WS_CTL + 40960), xst);
#define GRID_BAR() xcd_barrier(xbar)

    phase_mod(p, lds_raw, G);
    if (STAGE >= 2) phase_convert(p, lds_raw, G);
    grid.sync();
    if (STAGE >= 2) { phase_norm1(p, G); GRID_BAR(); }
    if (STAGE >= 2) {
        pg8::Gemm g{(const bf16_t*)(p.ws + WS_H), (const bf16_t*)(p.ws + WS_WIN_T), D, nullptr};
        pg8::DenseSched S; S.o.init(T / 256, IC / 256, G, (int)blockIdx.x);
        EpiInProj E{(bf16_t*)(p.ws + WS_PROJ)};
        pg8::gemm_phase<false, false>(lds, g, S, E);
        GRID_BAR();
    }
    if (STAGE >= 3) {
        kmax_pass(p, G);
        for (int it = blockIdx.x; it < NB * 8 * 4; it += G) rwkv_prep(p, lds, it >> 5, (it >> 2) & 7, (it & 3) * 32, (it & 3) * 32 + 32);
        GRID_BAR();
    }
    if (STAGE >= 2) {
        if (STAGE >= 3) { for (int u = blockIdx.x; u < NB * 8 * 2; u += G) rwkv_scan(p, lds, u >> 4, (u >> 1) & 7, u & 1); }
        else {
            bf16_t* ymix = (bf16_t*)(p.ws + WS_YMIX);
            for (size_t i = (size_t)blockIdx.x * NTHREADS + tid; i < (size_t)T * 64; i += (size_t)G * NTHREADS) { const size_t row = i >> 6, c = i & 63; *(u32x4*)(ymix + row * D + c * 8) = (u32x4){0u, 0u, 0u, 0u}; }
        }
        float lam;
        { const float* q1 = p.in[I_LQ1]; const float* k1 = p.in[I_LK1]; const float* q2 = p.in[I_LQ2]; const float* k2 = p.in[I_LK2]; float s1 = 0.f, s2 = 0.f;
            for (int i = 0; i < 64; ++i) { s1 += q1[i] * k1[i]; s2 += q2[i] * k2[i]; } lam = expf(s1) - expf(s2) + LAMBDA_INIT; }
        unsigned* qhead = (unsigned*)(p.ws + WS_CTL);
        LAS unsigned* ubox = (LAS unsigned*)(lds + 4 * ATT_BUF);
        for (;;) {
            __syncthreads();
            if (tid == 0) ubox[0] = atomicAdd(qhead, 1u);
            __syncthreads();
            const unsigned u = (unsigned)__builtin_amdgcn_readfirstlane((int)ubox[0]);
            if (u >= (unsigned)ATT_UNITS) break;
            attn_unit(p, lds, (int)(u & 31u) >> 2, (int)(u & 3u), ATT_NQB - 1 - (int)(u >> 5), lam);
        }
        GRID_BAR();
        if (STAGE >= 3) { rwkv_finalize(p, G); GRID_BAR(); }
    }
    if (STAGE >= 2) {
        pg8::Gemm g{(const bf16_t*)(p.ws + WS_YMIX), (const bf16_t*)(p.ws + WS_WOUT_T), D, nullptr};
        pg8::DenseSched S; S.o.init(T / 256, D / 256, G, (int)blockIdx.x);
        EpiOutProj E{p.in[I_X], (const float*)(p.ws + WS_MOD), p.out};
        pg8::gemm_phase<false, false>(lds, g, S, E);
        GRID_BAR();
    }
    if (STAGE >= 9) {
        phase_router(p, lds, G);
        GRID_BAR();
        phase_assign(p, lds, G);
        GRID_BAR();
        const int* tile = (const int*)(p.ws + WS_TILE);
        const int MT = tile[0];
        {
            pg8::Gemm g{(const bf16_t*)(p.ws + WS_H), (const bf16_t*)(p.ws + WS_WG_T), D / 2, (const int*)(p.ws + WS_ROUTE + 2 * 1024 * 1024)};
            pg8::MoeSched S; S.o.init(MT, 8, G, (int)blockIdx.x); S.tile_e = tile + 16; S.N = 2048;
            EpiMoe1 E{p.in[I_BGU], p.ws + WS_ACT};
            pg8::gemm_phase<true, true>(lds, g, S, E);
        }
        GRID_BAR();
        {
            pg8::Gemm g{(const bf16_t*)(p.ws + WS_ACT), (const bf16_t*)(p.ws + WS_WD_T), D / 2, nullptr};
            pg8::MoeSched S; S.o.init(MT, 4, G, (int)blockIdx.x); S.tile_e = tile + 16; S.N = 1024;
            EpiMoe2 E{p.in[I_BDN], (bf16_t*)(p.ws + WS_PROJ)};
            pg8::gemm_phase<false, true>(lds, g, S, E);
        }
        GRID_BAR();
    }
    phase_final(p, G, STAGE >= 9 ? 9 : (STAGE >= 2 ? 4 : 0));
}

extern "C" void kernel_launch(void* const* d_in, const int* in_sizes, int n_in, void* d_out, int out_size, void* d_ws, size_t ws_size, hipStream_t stream) {
    static int grid = 0;
    if (grid == 0) {
        if (n_in != 31 || out_size != T * D || ws_size < WS_END) { fprintf(stderr, "kernel_launch: unexpected shapes (n_in %d out %d ws %zu)\n", n_in, out_size, ws_size); grid = -1; return; }
        int dev = 0, cus = 0, per_cu = 0;
        hipGetDevice(&dev);
        hipDeviceGetAttribute(&cus, hipDeviceAttributeMultiprocessorCount, dev);
        hipFuncSetAttribute((const void*)hymba_fwd, hipFuncAttributeMaxDynamicSharedMemorySize, LDS_BYTES);
        hipOccupancyMaxActiveBlocksPerMultiprocessor(&per_cu, (const void*)hymba_fwd, NTHREADS, LDS_BYTES);
        if (per_cu < 1) { fprintf(stderr, "kernel_launch: occupancy query returned %d\n", per_cu); grid = -1; return; }
        grid = cus;
        if (grid > 256) grid = 256;
        while (T % grid != 0) --grid;
        (void)hipGetLastError();
    }
    if (grid < 0) return;
    hipMemsetAsync((char*)d_ws + WS_CTL, 0, CTL_BYTES, stream);
    Params p{};
    for (int i = 0; i < 31; ++i) p.in[i] = (const float*)d_in[i];
    p.out = (float*)d_out; p.ws = (unsigned char*)d_ws;
    void* args[] = {&p};
    hipError_t e = hipLaunchCooperativeKernel((const void*)hymba_fwd, dim3(grid), dim3(NTHREADS), args, LDS_BYTES, stream);
    if (e != hipSuccess) fprintf(stderr, "cooperative launch failed: %s (grid %d)\n", hipGetErrorString(e), grid);
}
```

```cpp
#include <hip/hip_runtime.h>
#include <hip/hip_cooperative_groups.h>
#include <cstdio>
#include <cstdint>
namespace cg = cooperative_groups;

#ifndef DBG_STAGE
#define DBG_STAGE 99
#endif

#define LAS __attribute__((address_space(3)))
typedef unsigned short bf16_t;
typedef short bf16x8 __attribute__((ext_vector_type(8)));
typedef short s16x4 __attribute__((ext_vector_type(4)));
typedef float f32x4 __attribute__((ext_vector_type(4)));
typedef float f32x16 __attribute__((ext_vector_type(16)));
typedef float f32x2_t __attribute__((ext_vector_type(2)));
typedef __bf16 bf16x2_t __attribute__((ext_vector_type(2)));
typedef unsigned u32x4 __attribute__((ext_vector_type(4)));
typedef unsigned u32x2 __attribute__((ext_vector_type(2)));

constexpr int D = 1024, NB = 8, SEQ = 4096, T = NB * SEQ;
constexpr int RW = 512, RC = 1792, DC = 1536, IC = 3328;
constexpr int NE = 32, TOPK = 4, NA = T * TOPK;
constexpr int PMAX = NA + NE * 256;
constexpr float NORM_EPS = 1e-5f, GN_EPS = 64e-5f;
constexpr float LOG2E = 1.4426950408889634f;
constexpr float QSCALE = 0.125f * LOG2E;
constexpr float LAMBDA_INIT = 0.2f;
constexpr int NTHREADS = 512, NWAVES = 8;
constexpr int LDS_BYTES = 163840;

constexpr size_t MiB = 1u << 20;
constexpr size_t WS_CTL = 0;
constexpr size_t CTL_BYTES = 65536;
constexpr size_t WS_MOD = 1 * MiB;
constexpr size_t WS_TILE = 1 * MiB + 512 * 1024;
constexpr size_t WS_WIN_T = 2 * MiB;
constexpr size_t WS_WOUT_T = 9 * MiB;
constexpr size_t WS_ROUTE = 11 * MiB;
constexpr size_t WS_WG_T = 16 * MiB;
constexpr size_t WS_WD_T = 144 * MiB;
constexpr size_t WS_H = 208 * MiB;
constexpr size_t WS_YMIX = 272 * MiB;
constexpr size_t WS_PROJ = 336 * MiB;
constexpr size_t WS_ACT = 608 * MiB;
constexpr size_t WS_END = 1008 * MiB;
constexpr int OPREC = 34816;
constexpr int OP_AT = 0, OP_RT = 4608, OP_BH = 9216, OP_KH = 13824, OP_BCT = 18432, OP_KCT = 23552, OP_VT = 28672, OP_P31 = 33792;
constexpr size_t WS_OPS = WS_ACT;
constexpr size_t WS_VS = 944 * MiB;
constexpr size_t WS_BON = WS_H;

__device__ __forceinline__ unsigned cvtpk(float lo, float hi) { f32x2_t v = {lo, hi}; bf16x2_t b = __builtin_convertvector(v, bf16x2_t); return __builtin_bit_cast(unsigned, b); }
__device__ __forceinline__ float bf2f(unsigned short u) { return __uint_as_float(((unsigned)u) << 16); }
__device__ __forceinline__ float wave_sum(float v) {
#pragma unroll
    for (int o = 1; o < 64; o <<= 1) v += __shfl_xor(v, o);
    return v;
}
__device__ __forceinline__ float wave_max(float v) {
#pragma unroll
    for (int o = 1; o < 64; o <<= 1) v = fmaxf(v, __shfl_xor(v, o));
    return v;
}
__device__ __forceinline__ int opaque_tid() { int t = (int)threadIdx.x; asm volatile("" : "+v"(t)); return t; }
__device__ __forceinline__ float sigmoidf_(float x) { return __builtin_amdgcn_rcpf(1.0f + __expf(-x)); }
__device__ __forceinline__ float tanh_fast(float x) { return 1.0f - 2.0f * __builtin_amdgcn_rcpf(1.0f + __expf(2.0f * x)); }

struct Params {
    const float* in[31];
    float* out;
    unsigned char* ws;
};
enum { I_X = 0, I_C, I_MODW, I_MODB, I_N1G, I_WIN, I_MU, I_W0, I_WUP, I_A0, I_AUP, I_GUP, I_KK, I_KA, I_RK, I_GNG, I_GNB, I_LQ1, I_LK1, I_LQ2, I_LK2, I_SUBLN, I_WOUT, I_N2G, I_RTW, I_RTB, I_WGU, I_BGU, I_WDN, I_BDN, I_FG };

namespace pg8 {
constexpr int BM = 256, BK = 64, HALF = 128, HTB = HALF * BK * 2, STAGE_BYTES = 8 * HTB, NXCD = 8, WGM = 8;
__host__ __device__ __forceinline__ int lds_byte(int r, int c) { const int st = (r >> 4) * 2 + (c >> 5), rr = r & 15, cc = c & 31, ob = rr * 64 + cc * 2; return st * 1024 + (ob ^ (((ob >> 9) & 1) << 5)); }
__host__ __device__ __forceinline__ void stage_rc(int b, int& R, int& C) { const int st = b / 1024, sb = b % 1024, swz = sb ^ (((sb >> 9) & 1) << 5); R = (st >> 1) * 16 + swz / 64; C = (st & 1) * 32 + (swz % 64) / 2; }
__host__ __device__ __forceinline__ int perm32(int rho) { const int n = rho >> 4, i = rho & 15; return 8 * (i >> 2) + 4 * n + (i & 3); }

struct Unit { int pm, pn, arow, brow, e; };
struct Gemm { const bf16_t* A; const bf16_t* Bt; int K; const int* rowmap; };

struct TileOrder {
    int nM, nN, nwg, G, c;
    __device__ void init(int nM_, int nN_, int G_, int c_) { nM = nM_; nN = nN_; nwg = nM * nN; G = G_; c = c_; }
    __device__ bool map(int i, int& pm, int& pn) const {
        const long L = (long)i * G + c; if (L >= nwg) return false;
        int wgid = (int)L; { const int q = nwg / NXCD, r = nwg % NXCD, xcd = wgid % NXCD, off = wgid / NXCD; wgid = (xcd < r ? xcd * (q + 1) : r * (q + 1) + (xcd - r) * q) + off; }
        const int nig = WGM * nN, gid = wgid / nig, fm = gid * WGM, gsz = (nM - fm) < WGM ? (nM - fm) : WGM;
        pm = fm + ((wgid % nig) % gsz); pn = (wgid % nig) / gsz; return true;
    }
};
struct DenseSched {
    TileOrder o;
    __device__ bool next(int i, Unit& u) const { int pm, pn; if (!o.map(i, pm, pn)) return false; u.pm = pm; u.pn = pn; u.arow = pm * BM; u.brow = pn * BM; u.e = 0; return true; }
};
struct MoeSched {
    TileOrder o; const int* tile_e; int N;
    __device__ bool next(int i, Unit& u) const { int pm, pn; if (!o.map(i, pm, pn)) return false; const int e = tile_e[pm]; u.pm = pm; u.pn = pn; u.arow = pm * BM; u.brow = e * N + pn * BM; u.e = e; return true; }
};

typedef int v4i_t __attribute__((ext_vector_type(4)));
typedef int v8i_t __attribute__((ext_vector_type(8)));
__device__ __forceinline__ v8i_t cat8(bf16x8 a, bf16x8 b) { return __builtin_shufflevector(__builtin_bit_cast(v4i_t, a), __builtin_bit_cast(v4i_t, b), 0, 1, 2, 3, 4, 5, 6, 7); }
__device__ __forceinline__ void mfma_fp8_tied(f32x4& acc, v8i_t a, v8i_t b) { asm volatile("v_mfma_f32_16x16x128_f8f6f4 %0, %1, %2, %0" : "+v"(acc) : "v"(a), "v"(b)); }
template <bool GATHER, bool FP8, class Epi, class Sched>
__device__ __forceinline__ void gemm_phase(LAS unsigned char* lds, const Gemm g, const Sched& S, const Epi& E) {
    const int tid = opaque_tid(), wid = __builtin_amdgcn_readfirstlane(tid >> 6), lane = tid & 63, wr = wid >> 2, wc = wid & 3, fr = lane & 15, fq = lane >> 4;
    const int K = g.K, nt = K / BK;
    unsigned voffA[2], voffB[2]; int rowA[2], colA2[2];
#pragma unroll
    for (int i = 0; i < 2; ++i) { int R, C; stage_rc(tid * 16 + i * 8192, R, C); const int Rb = (R & ~31) + perm32(R & 31);
        voffA[i] = (unsigned)(R * K + C) * 2u; voffB[i] = (unsigned)(Rb * K + C) * 2u; rowA[i] = R; colA2[i] = C * 2; }
    unsigned gv0[2] = {0u, 0u}, gv1[2] = {0u, 0u}, gn0[2] = {0u, 0u}, gn1[2] = {0u, 0u};
#define PG8_GOFF(u_, o0, o1) do { _Pragma("unroll") for (int _i = 0; _i < 2; ++_i) { o0[_i] = (unsigned)g.rowmap[(u_).arow + rowA[_i]] * (unsigned)(K * 2) + (unsigned)colA2[_i]; o1[_i] = (unsigned)g.rowmap[(u_).arow + HALF + rowA[_i]] * (unsigned)(K * 2) + (unsigned)colA2[_i]; } } while (0)
#define PG8_STAGE_A(bufoff, kptr, half) do { if constexpr (GATHER) { if (half) PG8_STAGE(bufoff, kptr, gv1); else PG8_STAGE(bufoff, kptr, gv0); } else PG8_STAGE(bufoff, (kptr) + ((half) ? hstep : 0), voffA); } while (0)
    const size_t kstep = (size_t)(BK * 2);
    const size_t hstep = (size_t)HALF * K * 2;
    const size_t rowb = (size_t)K * 2;
    const unsigned ldsw = (unsigned)wid * 1024u;
    const int aoff = lds_byte(wr * 64 + fr, fq * 8), boff = lds_byte(wc * 32 + fr, fq * 8);
#define PG8_SA(b, h) (((b) * 2 + (h)) * HTB)
#define PG8_SB(b, h) ((4 + (b) * 2 + (h)) * HTB)
#define PG8_STAGE(bufoff, gbase, voff) do { _Pragma("unroll") for (int _i = 0; _i < 2; ++_i) \
        __builtin_amdgcn_global_load_lds((const unsigned*)((const char*)(gbase) + (voff)[_i]), (LAS unsigned*)(lds + (bufoff) + ldsw + _i * 8192), 16, 0, 0); } while (0)
#define PG8_LDA(dst, b, h) do { _Pragma("unroll") for (int m = 0; m < 4; ++m) _Pragma("unroll") for (int k = 0; k < 2; ++k) dst[m][k] = *(const LAS bf16x8*)(lds + PG8_SA(b, h) + aoff + m * 2048 + k * 1024); } while (0)
#define PG8_LDB(dst, b, h) do { _Pragma("unroll") for (int n = 0; n < 2; ++n) _Pragma("unroll") for (int k = 0; k < 2; ++k) dst[n][k] = *(const LAS bf16x8*)(lds + PG8_SB(b, h) + boff + n * 2048 + k * 1024); } while (0)
#define PG8_MMA(ai, bj, At, Bt) do { __builtin_amdgcn_s_setprio(1); _Pragma("unroll") for (int m = 0; m < 4; ++m) _Pragma("unroll") for (int n = 0; n < 2; ++n) { \
        if constexpr (FP8) mfma_fp8_tied(acc[ai][bj][m][n], cat8(Bt[n][0], Bt[n][1]), cat8(At[m][0], At[m][1])); \
        else { _Pragma("unroll") for (int k = 0; k < 2; ++k) acc[ai][bj][m][n] = __builtin_amdgcn_mfma_f32_16x16x32_bf16(Bt[n][k], At[m][k], acc[ai][bj][m][n], 0, 0, 0); } } __builtin_amdgcn_s_setprio(0); } while (0)
#define PG8_WAIT_V(n) asm volatile("s_waitcnt vmcnt(" #n ")" ::: "memory")
#define PG8_WAIT_L(n) asm volatile("s_waitcnt lgkmcnt(" #n ")" ::: "memory")
#define PG8_BAR __builtin_amdgcn_s_barrier()
#define PG8_SCHED __builtin_amdgcn_sched_barrier(0)
    Unit cur, nxt; int ui = 0;
    if (!S.next(0, cur)) return;
    f32x4 acc[2][2][4][2];
#pragma unroll
    for (int a = 0; a < 2; ++a)
#pragma unroll
        for (int b = 0; b < 2; ++b)
#pragma unroll
            for (int m = 0; m < 4; ++m)
#pragma unroll
                for (int n = 0; n < 2; ++n) acc[a][b][m][n] = (f32x4){0.f, 0.f, 0.f, 0.f};
    bf16x8 At[4][2], B0[2][2], B1[2][2];
    const char* cA = GATHER ? (const char*)g.A : (const char*)g.A + (size_t)cur.arow * rowb; const char* cB = (const char*)g.Bt + (size_t)cur.brow * rowb;
    if constexpr (GATHER) PG8_GOFF(cur, gv0, gv1);
    PG8_STAGE(PG8_SB(0, 0), cB, voffB); PG8_STAGE(PG8_SB(0, 1), cB + hstep, voffB); PG8_STAGE_A(PG8_SA(0, 0), cA, 0); PG8_STAGE_A(PG8_SA(0, 1), cA, 1);
    if (wr == 1) PG8_BAR;
    PG8_WAIT_V(2); PG8_BAR;
    PG8_STAGE(PG8_SB(1, 0), cB + kstep, voffB); PG8_STAGE_A(PG8_SA(1, 0), cA + kstep, 0); PG8_STAGE(PG8_SB(1, 1), cB + hstep + kstep, voffB);
    PG8_WAIT_V(6); PG8_BAR;
    for (;;) {
        const bool has_next = S.next(ui + 1, nxt);
        const char* nA = GATHER ? (const char*)g.A : (has_next ? (const char*)g.A + (size_t)nxt.arow * rowb : cA); const char* nB = has_next ? (const char*)g.Bt + (size_t)nxt.brow * rowb : cB;

        for (int t = 0; t < nt; t += 2) {
            const bool last = (t == nt - 2);
            if constexpr (GATHER) { if (t == nt - 4) { if (has_next) PG8_GOFF(nxt, gn0, gn1); else { gn0[0] = gv0[0]; gn0[1] = gv0[1]; gn1[0] = gv1[0]; gn1[1] = gv1[1]; } } }
            const char* a1 = cA + (size_t)(t + 1) * kstep;
            const char* a2 = last ? nA : cA + (size_t)(t + 2) * kstep; const char* b2 = last ? nB : cB + (size_t)(t + 2) * kstep;
            const char* a3 = a2 + kstep; const char* b3 = b2 + kstep;
            PG8_LDB(B0, 0, 0); PG8_LDB(B1, 0, 1); PG8_SCHED; PG8_LDA(At, 0, 0); PG8_STAGE_A(PG8_SA(1, 1), a1, 1);
            if constexpr (GATHER) { if (last) { gv0[0] = gn0[0]; gv0[1] = gn0[1]; gv1[0] = gn1[0]; gv1[1] = gn1[1]; } }
            PG8_WAIT_V(8); PG8_WAIT_L(0); PG8_BAR; PG8_MMA(0, 0, At, B0); PG8_MMA(0, 1, At, B1); PG8_BAR; PG8_SCHED;
            PG8_LDA(At, 0, 1); PG8_STAGE(PG8_SB(0, 0), b2, voffB); PG8_STAGE(PG8_SB(0, 1), b2 + hstep, voffB); PG8_STAGE_A(PG8_SA(0, 0), a2, 0);
            PG8_WAIT_V(8); PG8_WAIT_L(0); PG8_BAR; PG8_MMA(1, 0, At, B0); PG8_MMA(1, 1, At, B1); PG8_BAR; PG8_SCHED;
            PG8_LDB(B0, 1, 0); PG8_LDB(B1, 1, 1); PG8_SCHED; PG8_LDA(At, 1, 0); PG8_STAGE_A(PG8_SA(0, 1), a2, 1);
            PG8_WAIT_V(8); PG8_WAIT_L(0); PG8_BAR; PG8_MMA(0, 0, At, B0); PG8_MMA(0, 1, At, B1); PG8_BAR; PG8_SCHED;
            PG8_LDA(At, 1, 1); PG8_STAGE(PG8_SB(1, 0), b3, voffB); PG8_STAGE(PG8_SB(1, 1), b3 + hstep, voffB); PG8_STAGE_A(PG8_SA(1, 0), a3, 0);
            PG8_WAIT_V(8); PG8_WAIT_L(0); PG8_BAR; PG8_MMA(1, 0, At, B0); PG8_MMA(1, 1, At, B1); PG8_BAR; PG8_SCHED;
        }
        if (wr == 0) PG8_BAR;
        if constexpr (FP8) asm volatile("s_nop 15\n\ts_nop 15" ::: "memory");
        E(acc, cur, wr, wc, fr, fq);
        if (!has_next) break;
#pragma unroll
        for (int a = 0; a < 2; ++a)
#pragma unroll
            for (int b = 0; b < 2; ++b)
#pragma unroll
                for (int m = 0; m < 4; ++m)
#pragma unroll
                    for (int n = 0; n < 2; ++n) acc[a][b][m][n] = (f32x4){0.f, 0.f, 0.f, 0.f};
        cur = nxt; cA = nA; cB = nB; ++ui;
        if (wr == 1) PG8_BAR;
    }
    PG8_WAIT_V(0);
    PG8_BAR;
#undef PG8_SA
#undef PG8_SB
#undef PG8_STAGE
#undef PG8_STAGE_A
#undef PG8_GOFF
#undef PG8_LDA
#undef PG8_LDB
#undef PG8_MMA
#undef PG8_WAIT_V
#undef PG8_WAIT_L
#undef PG8_BAR
#undef PG8_SCHED
}
}

struct EpiInProj {
    bf16_t* O;
    __device__ __forceinline__ void operator()(const f32x4 (&acc)[2][2][4][2], const pg8::Unit& u, int wr, int wc, int fr, int fq) const {
        const int row0 = u.pm * 256 + wr * 64 + fr, col0 = u.pn * 256 + wc * 32 + 8 * fq;
        const float sc = (u.pn == 7 || u.pn == 8) ? QSCALE : 1.0f;
#pragma unroll
        for (int ai = 0; ai < 2; ++ai)
#pragma unroll
            for (int m = 0; m < 4; ++m) { bf16_t* rowp = O + (size_t)(row0 + ai * 128 + m * 16) * IC + col0;
#pragma unroll
                for (int bj = 0; bj < 2; ++bj) { const f32x4 v0 = acc[ai][bj][m][0] * sc, v1 = acc[ai][bj][m][1] * sc;
                    u32x4 w; w.x = cvtpk(v0[0], v0[1]); w.y = cvtpk(v0[2], v0[3]); w.z = cvtpk(v1[0], v1[1]); w.w = cvtpk(v1[2], v1[3]);
                    *(u32x4*)(rowp + bj * 128) = w; } }
    }
};
struct EpiOutProj {
    const float* x; const float* mod; float* O;
    __device__ __forceinline__ void operator()(const f32x4 (&acc)[2][2][4][2], const pg8::Unit& u, int wr, int wc, int fr, int fq) const {
        const int row0 = u.pm * 256 + wr * 64 + fr, col0 = u.pn * 256 + wc * 32 + 8 * fq;
        const int b = (u.pm * 256) / SEQ;
        const float* g1 = mod + b * 6144 + 2048;
        f32x4 gv[2][2];
#pragma unroll
        for (int bj = 0; bj < 2; ++bj)
#pragma unroll
            for (int n = 0; n < 2; ++n) gv[bj][n] = *(const f32x4*)(g1 + col0 + bj * 128 + 4 * n);
#pragma unroll
        for (int ai = 0; ai < 2; ++ai)
#pragma unroll
            for (int m = 0; m < 4; ++m) { const size_t off = (size_t)(row0 + ai * 128 + m * 16) * D + col0;
#pragma unroll
                for (int bj = 0; bj < 2; ++bj)
#pragma unroll
                    for (int n = 0; n < 2; ++n) { const f32x4 xv = *(const f32x4*)(x + off + bj * 128 + 4 * n);
                        *(f32x4*)(O + off + bj * 128 + 4 * n) = xv + gv[bj][n] * acc[ai][bj][m][n]; } }
    }
};
constexpr float Q_H2 = 8.0f, Q_W = 32.0f, Q_ACT = 4.0f;
__device__ __forceinline__ unsigned cvt4_fp8(float a, float b, float c, float d) { unsigned w = 0u; w = (unsigned)__builtin_amdgcn_cvt_pk_fp8_f32(a, b, (int)w, false); w = (unsigned)__builtin_amdgcn_cvt_pk_fp8_f32(c, d, (int)w, true); return w; }
struct EpiMoe1 {
    const float* bgu; unsigned char* O;
    __device__ __forceinline__ void operator()(const f32x4 (&acc)[2][2][4][2], const pg8::Unit& u, int wr, int wc, int fr, int fq) const {
        const int row0 = u.pm * 256 + wr * 64 + fr, col0 = u.pn * 128 + wc * 32 + 8 * fq;
        const float* bg = bgu + (size_t)u.e * 2048 + col0;
        constexpr float dq = 1.0f / (Q_H2 * Q_W);
        f32x4 bgv[2], buv[2];
#pragma unroll
        for (int n = 0; n < 2; ++n) { bgv[n] = *(const f32x4*)(bg + 4 * n); buv[n] = *(const f32x4*)(bg + 1024 + 4 * n); }
#pragma unroll
        for (int ai = 0; ai < 2; ++ai)
#pragma unroll
            for (int m = 0; m < 4; ++m) { float a[8];
#pragma unroll
                for (int n = 0; n < 2; ++n) { const f32x4 gt = acc[ai][0][m][n] * dq + bgv[n], up = acc[ai][1][m][n] * dq + buv[n];
#pragma unroll
                    for (int j = 0; j < 4; ++j) { const float gg = fminf(gt[j], 7.0f), uu = fminf(fmaxf(up[j], -7.0f), 7.0f);
                        a[4 * n + j] = Q_ACT * (uu + 1.0f) * (gg * __builtin_amdgcn_rcpf(1.0f + __builtin_amdgcn_exp2f(-1.702f * LOG2E * gg))); } }
                u32x2 w; w.x = cvt4_fp8(a[0], a[1], a[2], a[3]); w.y = cvt4_fp8(a[4], a[5], a[6], a[7]);
                *(u32x2*)(O + (size_t)(row0 + ai * 128 + m * 16) * 1024 + col0) = w; }
    }
};
struct EpiMoe2 {
    const float* bdn; bf16_t* O;
    __device__ __forceinline__ void operator()(const f32x4 (&acc)[2][2][4][2], const pg8::Unit& u, int wr, int wc, int fr, int fq) const {
        const int row0 = u.pm * 256 + wr * 64 + fr, col0 = u.pn * 256 + wc * 32 + 8 * fq;
        const float* bd = bdn + (size_t)u.e * 1024 + col0;
        constexpr float dq = 1.0f / (Q_ACT * Q_W);
        f32x4 bv[2][2];
#pragma unroll
        for (int bj = 0; bj < 2; ++bj)
#pragma unroll
            for (int n = 0; n < 2; ++n) bv[bj][n] = *(const f32x4*)(bd + bj * 128 + 4 * n);
#pragma unroll
        for (int ai = 0; ai < 2; ++ai)
#pragma unroll
            for (int m = 0; m < 4; ++m) { bf16_t* rowp = O + (size_t)(row0 + ai * 128 + m * 16) * 1024 + col0;
#pragma unroll
                for (int bj = 0; bj < 2; ++bj) { const f32x4 v0 = acc[ai][bj][m][0] * dq + bv[bj][0], v1 = acc[ai][bj][m][1] * dq + bv[bj][1];
                    u32x4 w; w.x = cvtpk(v0[0], v0[1]); w.y = cvtpk(v0[2], v0[3]); w.z = cvtpk(v1[0], v1[1]); w.w = cvtpk(v1[2], v1[3]);
                    *(u32x4*)(rowp + bj * 128) = w; } }
    }
};

__device__ __forceinline__ void phase_mod(const Params& p, unsigned char* lds, int G) {
    const int tid = opaque_tid(), lane = tid & 63, wave = tid >> 6;
    float* sc = (float*)lds;
    float* part = (float*)lds + 8192;
    const float* c = p.in[I_C];
    for (int i = tid; i < 8192; i += NTHREADS) { const int b = i & 7, k = i >> 3; const float cv = c[b * 1024 + k]; sc[k * 8 + b] = cv / (1.0f + __expf(-cv)); }
    __syncthreads();
    float* mod = (float*)(p.ws + WS_MOD);
    const float* mw = p.in[I_MODW]; const float* mb = p.in[I_MODB];
    for (int cg = (int)blockIdx.x; cg < 256; cg += G) {
        const int cc = lane & 31, kh = lane >> 5, k0 = wave * 128 + kh * 64, col = cg * 24 + (cc < 24 ? cc : 0);
        float acc[8];
#pragma unroll
        for (int b = 0; b < 8; ++b) acc[b] = 0.f;
        const float* wp = mw + (size_t)k0 * 6144 + col;
        const float* sp = sc + k0 * 8;
#pragma unroll 1
        for (int k = 0; k < 64; k += 16) { float wv[16];
#pragma unroll
            for (int u = 0; u < 16; ++u) wv[u] = wp[(size_t)(k + u) * 6144];
#pragma unroll
            for (int u = 0; u < 16; ++u) { const f32x4 s0 = *(const f32x4*)(sp + (k + u) * 8), s1 = *(const f32x4*)(sp + (k + u) * 8 + 4);
                acc[0] += s0[0] * wv[u]; acc[1] += s0[1] * wv[u]; acc[2] += s0[2] * wv[u]; acc[3] += s0[3] * wv[u]; acc[4] += s1[0] * wv[u]; acc[5] += s1[1] * wv[u]; acc[6] += s1[2] * wv[u]; acc[7] += s1[3] * wv[u]; } }
#pragma unroll
        for (int b = 0; b < 8; ++b) acc[b] += __shfl_xor(acc[b], 32);
        if (lane < 24) {
#pragma unroll
            for (int b = 0; b < 8; ++b) part[(wave * 24 + lane) * 8 + b] = acc[b]; }
        __syncthreads();
        if (tid < 192) { const int cl = tid >> 3, b = tid & 7; float sum = mb[cg * 24 + cl];
#pragma unroll
            for (int w = 0; w < 8; ++w) sum += part[(w * 24 + cl) * 8 + b];
            mod[b * 6144 + cg * 24 + cl] = sum; }
        __syncthreads();
    }
}
__device__ __forceinline__ void transpose_item(const float* W, int N, int k0, int n0, bf16_t* WT, int Kdst, int dst_row_base, bool gu_interleave, float* scr, int lane) {
#pragma unroll 4
    for (int i = 0; i < 16; ++i) { const int row = 4 * i + (lane >> 4), c4 = lane & 15;
        const f32x4 v = *(const f32x4*)(W + (size_t)(k0 + row) * N + n0 + 4 * c4);
        float* s = scr + row * 65 + 4 * c4; s[0] = v[0]; s[1] = v[1]; s[2] = v[2]; s[3] = v[3]; }
    asm volatile("s_waitcnt lgkmcnt(0)" ::: "memory");
    const int cch = lane & 7;
#pragma unroll
    for (int i = 0; i < 8; ++i) { const int n = 8 * i + (lane >> 3); const float* s = scr + (8 * cch) * 65 + n;
        u32x4 o; o.x = cvtpk(s[0], s[65]); o.y = cvtpk(s[2 * 65], s[3 * 65]); o.z = cvtpk(s[4 * 65], s[5 * 65]); o.w = cvtpk(s[6 * 65], s[7 * 65]);
        int nn = n0 + n;
        if (gu_interleave) nn = (nn < 1024) ? ((nn >> 7) * 256 + (nn & 127)) : (((nn - 1024) >> 7) * 256 + 128 + ((nn - 1024) & 127));
        *(u32x4*)(WT + (size_t)(dst_row_base + nn) * Kdst + k0 + 8 * cch) = o; }
    asm volatile("s_waitcnt lgkmcnt(0)" ::: "memory");
}
struct CvtItem { const float* src; unsigned char* dst; int N; };
__device__ __forceinline__ CvtItem cvt_item(const Params& p, int r, int lane) {
    CvtItem c; constexpr int I_GU = 32 * 512;
    const int nq = lane & 7, kq = lane >> 3;
    if (r < I_GU) { const int e = r >> 9, rr = r & 511, k0 = (rr >> 6) * 128, n0 = (rr & 63) * 32; c.N = 2048;
        c.src = p.in[I_WGU] + (size_t)e * 1024 * 2048 + (size_t)(k0 + kq) * 2048 + n0 + 4 * nq;
        const int nn = n0 + 4 * nq, nd = (nn < 1024) ? ((nn >> 7) * 256 + (nn & 127)) : (((nn - 1024) >> 7) * 256 + 128 + ((nn - 1024) & 127));
        c.dst = p.ws + WS_WG_T + ((size_t)(e * 2048 + nd)) * 1024 + k0 + 16 * kq; }
    else { const int q = r - I_GU, e = q >> 8, rr = q & 255, k0 = (rr >> 5) * 128, n0 = (rr & 31) * 32; c.N = 1024;
        c.src = p.in[I_WDN] + (size_t)e * 1024 * 1024 + (size_t)(k0 + kq) * 1024 + n0 + 4 * nq;
        c.dst = p.ws + WS_WD_T + ((size_t)(e * 1024 + n0 + 4 * nq)) * 1024 + k0 + 16 * kq; }
    return c;
}
__device__ __forceinline__ void phase_convert(const Params& p, unsigned char* lds, int G) {
    const int tid = opaque_tid(), lane = tid & 63, wave = tid >> 6;
    float* scr = (float*)lds + wave * (64 * 65);
    const int gw = (int)blockIdx.x * NWAVES + wave, NGW = G * NWAVES;
    constexpr int I_IN = 16 * 52, I_OUT = 16 * 16, NF = 32 * 512 + 32 * 256;
    bf16_t* win_t = (bf16_t*)(p.ws + WS_WIN_T); bf16_t* wout_t = (bf16_t*)(p.ws + WS_WOUT_T);
    for (int it = gw; it < I_IN + I_OUT; it += NGW) {
        if (it < I_IN) transpose_item(p.in[I_WIN], IC, (it / 52) * 64, (it % 52) * 64, win_t, 1024, 0, false, scr, lane);
        else { const int r = it - I_IN; transpose_item(p.in[I_WOUT], D, (r / 16) * 64, (r % 16) * 64, wout_t, 1024, 0, false, scr, lane); }
    }
    unsigned* sq = (unsigned*)scr;
    const int wr_off = (lane >> 3) * 9 + (lane & 7), rd_off = (16 * (lane >> 3)) * 9 + (lane & 7);
    int r = gw;
    if (r >= NF) return;
    CvtItem cur = cvt_item(p, r, lane);
    f32x4 v[16];
#pragma unroll
    for (int i = 0; i < 16; ++i) v[i] = *(const f32x4*)(cur.src + (size_t)(8 * i) * cur.N);
    for (;;) {
#pragma unroll
        for (int i = 0; i < 16; ++i) sq[wr_off + 8 * i * 9] = cvt4_fp8(Q_W * v[i][0], Q_W * v[i][1], Q_W * v[i][2], Q_W * v[i][3]);
        asm volatile("" ::: "memory");
        const int rn = r + NGW; const bool more = rn < NF;
        unsigned char* dst = cur.dst;
        if (more) { cur = cvt_item(p, rn, lane);
#pragma unroll
            for (int i = 0; i < 16; ++i) v[i] = *(const f32x4*)(cur.src + (size_t)(8 * i) * cur.N); }
        asm volatile("s_waitcnt lgkmcnt(0)" ::: "memory");
        unsigned d[16];
#pragma unroll
        for (int j = 0; j < 16; ++j) d[j] = sq[rd_off + j * 9];
        u32x4 o[4];
#pragma unroll
        for (int g = 0; g < 4; ++g) { const unsigned d0 = d[4 * g], d1 = d[4 * g + 1], d2 = d[4 * g + 2], d3 = d[4 * g + 3];
            const unsigned x = __builtin_amdgcn_perm(d1, d0, 0x05010400u), y = __builtin_amdgcn_perm(d1, d0, 0x07030602u), z = __builtin_amdgcn_perm(d3, d2, 0x05010400u), w = __builtin_amdgcn_perm(d3, d2, 0x07030602u);
            o[0][g] = __builtin_amdgcn_perm(z, x, 0x05040100u); o[1][g] = __builtin_amdgcn_perm(z, x, 0x07060302u); o[2][g] = __builtin_amdgcn_perm(w, y, 0x05040100u); o[3][g] = __builtin_amdgcn_perm(w, y, 0x07060302u); }
#pragma unroll
        for (int nn = 0; nn < 4; ++nn) *(u32x4*)(dst + (size_t)nn * 1024) = o[nn];
        asm volatile("" ::: "memory");
        if (!more) break;
        r = rn;
    }
}

__device__ __forceinline__ void phase_norm1(const Params& p, int G) {
    const int tid = opaque_tid(), lane = tid & 63, wave = tid >> 6;
    const int gw = (int)blockIdx.x * NWAVES + wave, NGW = G * NWAVES;
    const float* x = p.in[I_X]; const float* gain = p.in[I_N1G]; const float* mod = (const float*)(p.ws + WS_MOD);
    bf16_t* h = (bf16_t*)(p.ws + WS_H);
    for (int row = gw; row < T; row += NGW) {
        const int b = row / SEQ;
        const f32x4* xr = (const f32x4*)(x + (size_t)row * D) + lane;
        f32x4 v[4]; float s = 0.f;
#pragma unroll
        for (int j = 0; j < 4; ++j) { v[j] = xr[64 * j]; s += (v[j][0] * v[j][0] + v[j][1] * v[j][1]) + (v[j][2] * v[j][2] + v[j][3] * v[j][3]); }
        const float rstd = rsqrtf(wave_sum(s) * (1.0f / D) + NORM_EPS);
        const float* sh = mod + b * 6144; const float* scl = mod + b * 6144 + 1024;
        unsigned long long* o8 = (unsigned long long*)(h + (size_t)row * D) + lane;
#pragma unroll
        for (int j = 0; j < 4; ++j) { const int k = 4 * lane + 256 * j;
            const f32x4 g = *(const f32x4*)(gain + k), s1 = *(const f32x4*)(scl + k), s0 = *(const f32x4*)(sh + k);
            const f32x4 y = (v[j] * rstd) * g * (s1 + 1.0f) + s0;
            o8[64 * j] = (unsigned long long)cvtpk(y[0], y[1]) | ((unsigned long long)cvtpk(y[2], y[3]) << 32); }
    }
}

constexpr size_t CTL_KMAX = 57344;
__device__ __forceinline__ void kmax_pass(const Params& p, int G) {
    const int tid = opaque_tid(), lane = tid & 63, wave = tid >> 6;
    const bf16_t* proj = (const bf16_t*)(p.ws + WS_PROJ);
    unsigned* km = (unsigned*)(p.ws + WS_CTL + CTL_KMAX);
    const int TPB = T / G;
    float mx = 0.f; const int tok0 = (int)blockIdx.x * TPB;
    for (int ti = wave; ti < TPB; ti += NWAVES) {
        const u32x4 kv = *(const u32x4*)(proj + (size_t)(tok0 + ti) * IC + RC + 512 + 8 * lane);
        float ss = 0.f;
#pragma unroll
        for (int j = 0; j < 4; ++j) { const float a = __uint_as_float(kv[j] << 16), bq = __uint_as_float(kv[j] & 0xffff0000u); ss += a * a + bq * bq; }
        ss += __shfl_xor(ss, 1); ss += __shfl_xor(ss, 2); ss += __shfl_xor(ss, 4);
        mx = fmaxf(mx, ss);
    }
    if ((lane & 7) == 0) atomicMax(km + (tok0 / SEQ) * 8 + (lane >> 3), __float_as_uint(mx));
}

__device__ __forceinline__ s16x4 vtr(const LAS unsigned char* pp) { typedef short v4i16_t __attribute__((ext_vector_type(4))); return __builtin_bit_cast(s16x4, __builtin_amdgcn_ds_read_tr16_b64_v4i16((LAS v4i16_t*)pp)); }
constexpr int ATT_BUF = 32768;
__device__ __forceinline__ float att_max3(float a, float b, float c) { float r; asm("v_max3_f32 %0, %1, %2, %3" : "=v"(r) : "v"(a), "v"(b), "v"(c)); return r; }
constexpr int ATT_QROWS = 128, ATT_NQB = SEQ / ATT_QROWS, ATT_UNITS = NB * 4 * ATT_NQB;
__device__ __forceinline__ void attn_unit(const Params& p, LAS unsigned char* lds, int b, int h, int qb, float lam) {
    const int tid = opaque_tid(), lane = tid & 63, wid = __builtin_amdgcn_readfirstlane(tid >> 6), r32 = lane & 31, hi = lane >> 5;
    const int c = wid & 1, qblk = wid >> 1;
    const bf16_t* proj = (const bf16_t*)(p.ws + WS_PROJ) + (size_t)b * SEQ * IC;
    const int q0 = qb * ATT_QROWS, qw0 = q0 + 32 * qblk;
    const bf16_t* Qb = proj + RC + h * 128 + c * 64;
    const bf16_t* Kb = proj + RC + 512 + h * 128;
    const bf16_t* Vb = proj + RC + 1024 + h * 128;
    const float slope = exp2f(-2.0f * (float)(h + 1)) * LOG2E;
    f32x16 o[4];
#pragma unroll
    for (int d = 0; d < 4; ++d) o[d] = f32x16{};
    f32x16 cb0;
#pragma unroll
    for (int r = 0; r < 16; ++r) cb0[r] = slope * (float)((r & 3) + 8 * (r >> 2) + 4 * hi);
    const float c32 = slope * 32.0f;
    float m_ = 0.f, l_ = 0.f;
    const int NT = (q0 + ATT_QROWS) / 64;
    const bf16_t* ksrc = Kb + (size_t)lane * IC + wid * 8;
    const int p0i = wid, p1i = wid + 8;
    const bf16_t* vsrc0 = Vb + (size_t)(16 * (p0i & 3) + (lane >> 2)) * IC + (p0i >> 2) * 32 + (lane & 3) * 8;
    const bf16_t* vsrc1 = Vb + (size_t)(16 * (p1i & 3) + (lane >> 2)) * IC + (p1i >> 2) * 32 + (lane & 3) * 8;
#define ATT_GLDS(gsrc_, ldsdst_) do { unsigned keep_; asm volatile("s_mov_b32 %0, m0\n\ts_mov_b32 m0, %2\n\ts_nop 0\n\tglobal_load_lds_dwordx4 %1, off\n\ts_mov_b32 m0, %0" : "=&s"(keep_) : "v"(gsrc_), "s"(ldsdst_) : "memory"); } while (0)
    const unsigned lds0 = (unsigned)(uintptr_t)lds;
#define ATT_DMA(t, buf) do { const size_t ro = (size_t)(t) * 64 * IC; const unsigned bb_ = (unsigned)__builtin_amdgcn_readfirstlane((int)(lds0 + (buf) * ATT_BUF + wid * 1024)); \
        ATT_GLDS(ksrc + ro, bb_); ATT_GLDS(ksrc + ro + 64, bb_ + 8192u); ATT_GLDS(vsrc0 + ro, bb_ + 16384u); ATT_GLDS(vsrc1 + ro, bb_ + 16384u + 8192u); } while (0)
    ATT_DMA(NT - 1, 0); ATT_DMA(NT - 2, 1);
    bf16x8 qr[4];
#pragma unroll
    for (int d0 = 0; d0 < 4; ++d0) qr[d0] = *(const bf16x8*)(Qb + (size_t)(qw0 + r32) * IC + d0 * 16 + hi * 8);
    float qn;
    { float q2 = 0.f;
#pragma unroll
      for (int d0 = 0; d0 < 4; ++d0)
#pragma unroll
          for (int j = 0; j < 8; ++j) { const float x = bf2f((unsigned short)qr[d0][j]); q2 += x * x; }
      q2 += __shfl_xor(q2, 32);
      qn = sqrtf(q2 * ((const float*)(p.ws + WS_CTL + CTL_KMAX))[b * 8 + h * 2 + c]) * 1.002f + 0.01f; }
    asm volatile("" : "+v"(qr[0]), "+v"(qr[1]), "+v"(qr[2]), "+v"(qr[3]));
    asm volatile("s_waitcnt vmcnt(0)" ::: "memory");
    __builtin_amdgcn_s_barrier();
    const int voff = ((lane >> 4) & 1) * 32 + (lane & 3) * 8 + (4 * hi + ((lane & 15) >> 2)) * 64;
    const int qpos = qw0 + r32;
    const bool late = wid >= 4;
    bf16x8 pf[4]; bool pend = false;
    float mtrue = -INFINITY;
    LAS unsigned* vote = (LAS unsigned*)(lds + 4 * ATT_BUF + 64);
#define ATT_PV(slot_) do { const LAS unsigned char* vb_ = lds + (slot_) * ATT_BUF + 16384 + voff; \
        _Pragma("unroll") for (int dblk = 0; dblk < 4; ++dblk) { _Pragma("unroll") for (int ks = 0; ks < 4; ++ks) { \
            const s16x4 lo = vtr(vb_ + (dblk * 4 + ks) * 1024), hh = vtr(vb_ + (dblk * 4 + ks) * 1024 + 512); \
            const bf16x8 vf = (bf16x8){lo[0], lo[1], lo[2], lo[3], hh[0], hh[1], hh[2], hh[3]}; \
            o[dblk] = __builtin_amdgcn_mfma_f32_32x32x16_bf16(vf, pf[ks], o[dblk], 0, 0, 0); } } } while (0)
    int it = 0;
    for (; it < NT; ++it) {
        const int kt = NT - 1 - it, cur = it & 3;
        const bool issued = (it + 2 < NT);
        if (issued) ATT_DMA(kt - 2, (it + 2) & 3);
        const int k0 = kt * 64;
        if (late && pend) { ATT_PV((it - 1) & 3); pend = false; }
        if (k0 <= qw0 + 31) {
            const LAS unsigned char* bb = lds + cur * ATT_BUF;
            const bool need_mask = (k0 + 63 > qw0);
            const LAS unsigned char* kb = bb + c * 8192 + hi * 1024 + r32 * 16;
            f32x16 s0 = cb0, s1 = cb0;
#pragma unroll
            for (int d0 = 0; d0 < 4; ++d0) {
                const bf16x8 a0 = *(const LAS bf16x8*)(kb + d0 * 2048), a1 = *(const LAS bf16x8*)(kb + d0 * 2048 + 512);
                s0 = __builtin_amdgcn_mfma_f32_32x32x16_bf16(a0, qr[d0], s0, 0, 0, 0);
                s1 = __builtin_amdgcn_mfma_f32_32x32x16_bf16(a1, qr[d0], s1, 0, 0, 0);
            }
            if (need_mask) {
                const int dq = k0 - qpos + 4 * hi;
#pragma unroll
                for (int r = 0; r < 16; ++r) { if (dq + ((r & 3) + 8 * (r >> 2)) > 0) s0[r] = -INFINITY; if (dq + ((r & 3) + 8 * (r >> 2)) + 32 > 0) s1[r] = -INFINITY; }
            }
            const float tb = slope * (float)(k0 - qpos);
            float rm0 = att_max3(s0[0], s0[1], s0[2]), rm1 = att_max3(s1[0], s1[1], s1[2]);
#pragma unroll
            for (int r = 3; r < 15; r += 2) { rm0 = att_max3(rm0, s0[r], s0[r + 1]); rm1 = att_max3(rm1, s1[r], s1[r + 1]); }
            float rm = att_max3(rm0, s0[15], att_max3(rm1, s1[15], -INFINITY) + c32);
            rm += tb;
            rm = fmaxf(rm, __shfl_xor(rm, 32));
            mtrue = fmaxf(mtrue, rm);
            if (__any(rm > m_ + 8.0f)) {
                const float mn = fmaxf(m_, rm);
                const float alpha = __builtin_amdgcn_exp2f(m_ - mn);
                m_ = mn; l_ *= alpha;
#pragma unroll
                for (int d = 0; d < 4; ++d)
#pragma unroll
                    for (int r = 0; r < 16; ++r) o[d][r] *= alpha;
            }
            const float off = tb - m_, off1 = off + c32;
            float ps = 0.f;
#pragma unroll
            for (int r = 0; r < 16; ++r) { s0[r] = __builtin_amdgcn_exp2f(s0[r] + off); s1[r] = __builtin_amdgcn_exp2f(s1[r] + off1); ps += s0[r] + s1[r]; }
            l_ += ps;
#pragma unroll
            for (int ks = 0; ks < 2; ++ks) {
                u32x4 w0, w1;
                w0.x = cvtpk(s0[8 * ks + 0], s0[8 * ks + 1]); w0.y = cvtpk(s0[8 * ks + 2], s0[8 * ks + 3]); w0.z = cvtpk(s0[8 * ks + 4], s0[8 * ks + 5]); w0.w = cvtpk(s0[8 * ks + 6], s0[8 * ks + 7]);
                w1.x = cvtpk(s1[8 * ks + 0], s1[8 * ks + 1]); w1.y = cvtpk(s1[8 * ks + 2], s1[8 * ks + 3]); w1.z = cvtpk(s1[8 * ks + 4], s1[8 * ks + 5]); w1.w = cvtpk(s1[8 * ks + 6], s1[8 * ks + 7]);
                pf[ks] = __builtin_bit_cast(bf16x8, w0); pf[2 + ks] = __builtin_bit_cast(bf16x8, w1);
            }
            if (late) pend = true; else ATT_PV(cur);
        }
        { const bool neg = (qn + slope * (float)(k0 - 1 - qpos) <= mtrue - 50.0f);
          if (lane == 0) vote[(it & 1) * 8 + wid] = __all(neg) ? 1u : 0u; }
        if (issued) asm volatile("s_waitcnt vmcnt(4)" ::: "memory"); else asm volatile("s_waitcnt vmcnt(0)" ::: "memory");
        asm volatile("s_waitcnt lgkmcnt(0)" ::: "memory");
        __builtin_amdgcn_s_barrier();
        { const u32x4 va = *(const LAS u32x4*)(vote + (it & 1) * 8), vb2 = *(const LAS u32x4*)(vote + (it & 1) * 8 + 4);
          if ((va.x & va.y & va.z & va.w & vb2.x & vb2.y & vb2.z & vb2.w) != 0u) { ++it; break; } }
    }
    if (late && pend) ATT_PV((it - 1) & 3);
    asm volatile("s_waitcnt vmcnt(0) lgkmcnt(0)" ::: "memory");
    __builtin_amdgcn_s_barrier();
#undef ATT_PV
#undef ATT_DMA
#undef ATT_GLDS
    l_ += __shfl_xor(l_, 32);
    LAS float* xb = (LAS float*)(lds + qblk * 16384);
    if (c == 1) {
        const float i1 = lam / l_;
#pragma unroll
        for (int d = 0; d < 4; ++d)
#pragma unroll
            for (int r = 0; r < 16; ++r) xb[(d * 16 + r) * 64 + lane] = o[d][r] * i1;
    }
    __syncthreads();
    if (c == 0) {
        const float i0 = 1.0f / l_;
        float ss = 0.f;
#pragma unroll
        for (int d = 0; d < 4; ++d)
#pragma unroll
            for (int r = 0; r < 16; ++r) { const float v = o[d][r] * i0 - xb[(d * 16 + r) * 64 + lane]; o[d][r] = v; ss += v * v; }
        ss += __shfl_xor(ss, 32);
        const float rstd = rsqrtf(ss * (1.0f / 128.0f) + NORM_EPS) * (1.0f - LAMBDA_INIT);
        const float* sg = p.in[I_SUBLN];
        bf16_t* yo = (bf16_t*)(p.ws + WS_YMIX) + (size_t)(b * SEQ + qw0 + r32) * D + RW + h * 128;
#pragma unroll
        for (int d = 0; d < 4; ++d)
#pragma unroll
            for (int g = 0; g < 4; ++g) { const int dd = 32 * d + 8 * g + 4 * hi; const f32x4 gv = *(const f32x4*)(sg + dd);
                u32x2 w; w.x = cvtpk(o[d][4 * g] * rstd * gv[0], o[d][4 * g + 1] * rstd * gv[1]); w.y = cvtpk(o[d][4 * g + 2] * rstd * gv[2], o[d][4 * g + 3] * rstd * gv[3]);
                *(u32x2*)(yo + dd) = w; }
    }
    __syncthreads();
}

constexpr int RCH = 32;
constexpr int RK_R = 0, RK_KM = 8192, RK_DEC = 16384, RK_KK = 24576, RK_BB = 32768, RK_VV = 40960, RK_GG = 49152;
constexpr int RK_AW = 57344;
constexpr int RK_AA = RK_AW + 4608;
constexpr int RK_AG = RK_AA + 4608;
constexpr int RK_BON = RK_AG + 8704;
constexpr int RK_MU = RK_BON + 128;
constexpr int RK_RAW = 77824;
constexpr int RK_IM = RK_RAW + 33 * 1024;
constexpr int RK_LSEG = RK_IM + OPREC;
constexpr int RK_END = RK_LSEG + 2048;
static_assert(RK_MU + 1792 <= RK_RAW && RK_END <= LDS_BYTES - 64 && (RK_RAW % 1024) == 0, "rwkv prep LDS map");
template <int CTRL> __device__ __forceinline__ float dpp_add(float v) { return v + __builtin_bit_cast(float, __builtin_amdgcn_update_dpp(0, __builtin_bit_cast(int, v), CTRL, 0xf, 0xf, true)); }
__device__ __forceinline__ float red16(float v) {
    v = dpp_add<0xB1>(v);
    v = dpp_add<0x4E>(v);
    v = dpp_add<0x141>(v);
    v = dpp_add<0x140>(v);
    return v;
}
__device__ __forceinline__ int rk_piece_col(int pc, int h) {
    return pc < 8 ? h * 64 + 8 * pc : (pc < 16 ? 512 + h * 64 + 8 * (pc - 8) : (pc < 24 ? 1024 + h * 64 + 8 * (pc - 16) : 1536 + 8 * (pc - 24)));
}
#define RK_BAR() do { asm volatile("s_waitcnt lgkmcnt(0)" ::: "memory"); __builtin_amdgcn_s_barrier(); asm volatile("" ::: "memory"); } while (0)
__device__ __forceinline__ void rwkv_prep(const Params& p, LAS unsigned char* lds, int b, int h, int ch0, int ch1) {
    const int tid = opaque_tid(), lane = tid & 63, wid = __builtin_amdgcn_readfirstlane(tid >> 6);
    const bf16_t* proj = (const bf16_t*)(p.ws + WS_PROJ) + (size_t)b * SEQ * IC;
    LAS float* R_ = (LAS float*)(lds + RK_R); LAS float* KM_ = (LAS float*)(lds + RK_KM); LAS float* DEC_ = (LAS float*)(lds + RK_DEC); LAS float* KK_ = (LAS float*)(lds + RK_KK);
    LAS float* BB_ = (LAS float*)(lds + RK_BB); LAS float* VV_ = (LAS float*)(lds + RK_VV); LAS float* GG_ = (LAS float*)(lds + RK_GG); LAS float* BON_ = (LAS float*)(lds + RK_BON);
    LAS float* MU_ = (LAS float*)(lds + RK_MU);
    const int dpc = lane < 56 ? lane : 55;
    const bf16_t* dsrc = proj + rk_piece_col(dpc, h);
#define RK_DMA(t0_) do { for (int rho = wid; rho < 33; rho += NWAVES) { int tok = (t0_) - 1 + rho; tok = tok < 0 ? 0 : tok; \
        __builtin_amdgcn_global_load_lds((const unsigned*)(dsrc + (size_t)tok * IC), (LAS unsigned*)(lds + RK_RAW + rho * 1024), 16, 0, 0); } } while (0)
    RK_DMA(ch0 * RCH);
    if (tid < 448) MU_[tid] = p.in[I_MU][rk_piece_col(tid >> 3, h) + (tid & 7)];
    const int ntile = wid & 3, ttile = wid >> 2, fn = lane & 15, fk = lane >> 4;
    const int ncol = h * 64 + ntile * 16 + fn;
    bf16x8 bw[2], ba[2], bg[4];
    {
        const float* wup = p.in[I_WUP]; const float* aup = p.in[I_AUP]; const float* gup = p.in[I_GUP];
#pragma unroll
        for (int ks = 0; ks < 2; ++ks) { float t[8], u[8];
#pragma unroll
            for (int j = 0; j < 8; ++j) { const int k = 32 * ks + 8 * fk + j; t[j] = wup[k * RW + ncol]; u[j] = aup[k * RW + ncol]; }
            u32x4 a, c; a.x = cvtpk(t[0], t[1]); a.y = cvtpk(t[2], t[3]); a.z = cvtpk(t[4], t[5]); a.w = cvtpk(t[6], t[7]);
            c.x = cvtpk(u[0], u[1]); c.y = cvtpk(u[2], u[3]); c.z = cvtpk(u[4], u[5]); c.w = cvtpk(u[6], u[7]);
            bw[ks] = __builtin_bit_cast(bf16x8, a); ba[ks] = __builtin_bit_cast(bf16x8, c); }
#pragma unroll
        for (int ks = 0; ks < 4; ++ks) { float t[8];
#pragma unroll
            for (int j = 0; j < 8; ++j) { const int k = 32 * ks + 8 * fk + j; t[j] = gup[k * RW + ncol]; }
            u32x4 a; a.x = cvtpk(t[0], t[1]); a.y = cvtpk(t[2], t[3]); a.z = cvtpk(t[4], t[5]); a.w = cvtpk(t[6], t[7]);
            bg[ks] = __builtin_bit_cast(bf16x8, a); }
    }
    const float w0n = p.in[I_W0][ncol], a0n = p.in[I_A0][ncol];
    const int q16 = tid & 15, tk16 = tid >> 4;
    const f32x4 kkc = *(const f32x4*)(p.in[I_KK] + h * 64 + 4 * q16), kac = *(const f32x4*)(p.in[I_KA] + h * 64 + 4 * q16), rkc = *(const f32x4*)(p.in[I_RK] + h * 64 + 4 * q16);
    const size_t hb = (size_t)(b * 8 + h) * SEQ * 64;
    float* gVS = (float*)(p.ws + WS_VS) + hb; float* gGG = p.out + (size_t)16 * 1024 * 1024 + hb; float* gBON = (float*)(p.ws + WS_BON) + (size_t)(b * 8 + h) * SEQ;
    unsigned char* gOPS = p.ws + WS_OPS + (size_t)(b * 8 + h) * (SEQ / RCH) * OPREC;
    for (int ch = ch0; ch < ch1; ++ch) {
        const int t0 = ch * RCH;
        if (ch > ch0) { if (wid == 0) asm volatile("s_waitcnt vmcnt(8)" ::: "memory"); else if (wid == 1) asm volatile("s_waitcnt vmcnt(7)" ::: "memory"); else asm volatile("s_waitcnt vmcnt(6)" ::: "memory"); } else asm volatile("s_waitcnt vmcnt(0)" ::: "memory");
        RK_BAR();
#pragma unroll
        for (int it = 0; it < 4; ++it) { const int item = tid + it * NTHREADS;
            if (item < RCH * 56) { const int tk = item / 56, pc = item - tk * 56;
                const u32x4 cv = *(const LAS u32x4*)(lds + RK_RAW + (tk + 1) * 1024 + pc * 16);
                u32x4 pv = *(const LAS u32x4*)(lds + RK_RAW + tk * 1024 + pc * 16);
                if (t0 + tk == 0) pv = (u32x4){0u, 0u, 0u, 0u};
                const f32x4 m0 = *(const LAS f32x4*)(MU_ + pc * 8), m1 = *(const LAS f32x4*)(MU_ + pc * 8 + 4);
                float xv[8];
#pragma unroll
                for (int j = 0; j < 4; ++j) { const unsigned cw = cv[j], pw = pv[j];
                    const float c0 = __uint_as_float(cw << 16), c1 = __uint_as_float(cw & 0xffff0000u), p0 = __uint_as_float(pw << 16), p1 = __uint_as_float(pw & 0xffff0000u);
                    const float ma = (j < 2) ? m0[2 * j] : m1[2 * j - 4], mb = (j < 2) ? m0[2 * j + 1] : m1[2 * j - 3];
                    xv[2 * j] = c0 + ma * (p0 - c0); xv[2 * j + 1] = c1 + mb * (p1 - c1); }
                const int seg = pc >> 3, pi = pc & 7;
                if (seg <= 2) { LAS float* dst = (seg == 0 ? R_ : (seg == 1 ? KM_ : VV_)) + tk * 64 + 8 * pi;
                    *(LAS f32x4*)dst = (f32x4){xv[0], xv[1], xv[2], xv[3]}; *(LAS f32x4*)(dst + 4) = (f32x4){xv[4], xv[5], xv[6], xv[7]}; }
                else if (seg == 3) { u32x4 w; w.x = cvtpk(tanh_fast(xv[0]), tanh_fast(xv[1])); w.y = cvtpk(tanh_fast(xv[2]), tanh_fast(xv[3])); w.z = cvtpk(tanh_fast(xv[4]), tanh_fast(xv[5])); w.w = cvtpk(tanh_fast(xv[6]), tanh_fast(xv[7]));
                    *(LAS u32x4*)(lds + RK_AW + tk * 144 + 16 * pi) = w; }
                else if (seg == 4) { u32x4 w; w.x = cvtpk(xv[0], xv[1]); w.y = cvtpk(xv[2], xv[3]); w.z = cvtpk(xv[4], xv[5]); w.w = cvtpk(xv[6], xv[7]);
                    *(LAS u32x4*)(lds + RK_AA + tk * 144 + 16 * pi) = w; }
                else { u32x4 w; w.x = cvtpk(sigmoidf_(xv[0]), sigmoidf_(xv[1])); w.y = cvtpk(sigmoidf_(xv[2]), sigmoidf_(xv[3])); w.z = cvtpk(sigmoidf_(xv[4]), sigmoidf_(xv[5])); w.w = cvtpk(sigmoidf_(xv[6]), sigmoidf_(xv[7]));
                    *(LAS u32x4*)(lds + RK_AG + tk * 272 + (pc - 40) * 16) = w; }
            } }
        __syncthreads();
        if (ch + 1 < ch1) RK_DMA(t0 + RCH);
        {
            f32x4 cw = (f32x4){0.f, 0.f, 0.f, 0.f}, ca = cw, cg2 = cw;
            const int tok = ttile * 16 + fn;
#pragma unroll
            for (int ks = 0; ks < 2; ++ks) {
                const bf16x8 aw = *(const LAS bf16x8*)(lds + RK_AW + tok * 144 + (32 * ks + 8 * fk) * 2);
                const bf16x8 aa = *(const LAS bf16x8*)(lds + RK_AA + tok * 144 + (32 * ks + 8 * fk) * 2);
                cw = __builtin_amdgcn_mfma_f32_16x16x32_bf16(aw, bw[ks], cw, 0, 0, 0);
                ca = __builtin_amdgcn_mfma_f32_16x16x32_bf16(aa, ba[ks], ca, 0, 0, 0);
            }
#pragma unroll
            for (int ks = 0; ks < 4; ++ks) {
                const bf16x8 ag = *(const LAS bf16x8*)(lds + RK_AG + tok * 272 + (32 * ks + 8 * fk) * 2);
                cg2 = __builtin_amdgcn_mfma_f32_16x16x32_bf16(ag, bg[ks], cg2, 0, 0, 0);
            }
#pragma unroll
            for (int r = 0; r < 4; ++r) { const int tk = ttile * 16 + 4 * fk + r, n = ntile * 16 + fn;
                DEC_[tk * 64 + n] = -0.6065306597126334f * sigmoidf_(cw[r] + w0n);
                BB_[tk * 64 + n] = sigmoidf_(ca[r] + a0n);
                GG_[tk * 64 + n] = cg2[r]; }
        }
        RK_BAR();
        {
            const f32x4 kp = *(const LAS f32x4*)(KM_ + tk16 * 64 + 4 * q16), av = *(const LAS f32x4*)(BB_ + tk16 * 64 + 4 * q16), rr = *(const LAS f32x4*)(R_ + tk16 * 64 + 4 * q16);
            const f32x4 kkv = kp * kkc;
            const float nrm2 = red16((kkv[0] * kkv[0] + kkv[1] * kkv[1]) + (kkv[2] * kkv[2] + kkv[3] * kkv[3]));
            const f32x4 kkn = kkv * __builtin_amdgcn_rsqf(fmaxf(nrm2, 1e-24f));
            const f32x4 kmod = kp * ((av - 1.0f) * kac + 1.0f);
            const f32x4 t = rr * kmod * rkc;
            const float bs = red16((t[0] + t[1]) + (t[2] + t[3]));
            *(LAS f32x4*)(KK_ + tk16 * 64 + 4 * q16) = kkn; *(LAS f32x4*)(BB_ + tk16 * 64 + 4 * q16) = kkn * av; *(LAS f32x4*)(KM_ + tk16 * 64 + 4 * q16) = kmod;
            if (q16 == 0) BON_[tk16] = bs;
        }
        RK_BAR();
        {
            const int d1 = tid & 63, q1 = wid;
            float lw[4], cs[4];
#pragma unroll
            for (int e = 0; e < 4; ++e) lw[e] = DEC_[(4 * q1 + e) * 64 + d1];
            cs[0] = lw[0]; cs[1] = cs[0] + lw[1]; cs[2] = cs[1] + lw[2]; cs[3] = cs[2] + lw[3];
            ((LAS float*)(lds + RK_LSEG))[q1 * 64 + d1] = cs[3];
            { const float x0 = VV_[(4 * q1) * 64 + d1], x1 = VV_[(4 * q1 + 1) * 64 + d1], x2 = VV_[(4 * q1 + 2) * 64 + d1], x3 = VV_[(4 * q1 + 3) * 64 + d1];
              u32x2 w; w.x = cvtpk(x0, x1); w.y = cvtpk(x2, x3); *(LAS u32x2*)(lds + RK_IM + OP_VT + d1 * 80 + q1 * 8) = w; }
            RK_BAR();
            float off = 0.f, tot = 0.f;
#pragma unroll
            for (int qq = 0; qq < 8; ++qq) { const float sg = ((const LAS float*)(lds + RK_LSEG))[qq * 64 + d1]; tot += sg; if (qq < q1) off += sg; }
            const float etot = __expf(tot);
            float ePprev = __expf(off);
            float bc[4], kc4[4];
#pragma unroll
            for (int e = 0; e < 4; ++e) { const int tk = 4 * q1 + e;
                const float eP = __expf(off + cs[e]), eN = __builtin_amdgcn_rcpf(eP), eE = etot * eN;
                const float kap = KK_[tk * 64 + d1], bet = BB_[tk * 64 + d1], kk_ = KM_[tk * 64 + d1], rr = R_[tk * 64 + d1];
                const unsigned w0 = cvtpk(-kap * ePprev, rr * eP), w1 = cvtpk(bet * eN, kk_ * eN);
                *(LAS unsigned short*)(lds + RK_IM + OP_AT + tk * 144 + d1 * 2) = (unsigned short)(w0 & 0xffffu); *(LAS unsigned short*)(lds + RK_IM + OP_RT + tk * 144 + d1 * 2) = (unsigned short)(w0 >> 16);
                *(LAS unsigned short*)(lds + RK_IM + OP_BH + tk * 144 + d1 * 2) = (unsigned short)(w1 & 0xffffu); *(LAS unsigned short*)(lds + RK_IM + OP_KH + tk * 144 + d1 * 2) = (unsigned short)(w1 >> 16);
                bc[e] = bet * eE; kc4[e] = kk_ * eE; ePprev = eP; }
            u32x2 wb, wk; wb.x = cvtpk(bc[0], bc[1]); wb.y = cvtpk(bc[2], bc[3]); wk.x = cvtpk(kc4[0], kc4[1]); wk.y = cvtpk(kc4[2], kc4[3]);
            *(LAS u32x2*)(lds + RK_IM + OP_BCT + d1 * 80 + q1 * 8) = wb; *(LAS u32x2*)(lds + RK_IM + OP_KCT + d1 * 80 + q1 * 8) = wk;
            if (q1 == 0) ((LAS float*)(lds + RK_IM + OP_P31))[d1] = etot;
        }
        RK_BAR();
        {
            unsigned char* rec = gOPS + (size_t)ch * OPREC;
#pragma unroll
            for (int i = 0; i < 5; ++i) { const int o = (tid + i * NTHREADS) * 16; if (o < OPREC) *(u32x4*)(rec + o) = *(const LAS u32x4*)(lds + RK_IM + o); }
            const size_t go = (size_t)t0 * 64 + tid * 4;
            *(f32x4*)(gVS + go) = *(const LAS f32x4*)(VV_ + tid * 4);
            *(f32x4*)(gGG + go) = *(const LAS f32x4*)(GG_ + tid * 4);
            if (tid < RCH) gBON[t0 + tid] = BON_[tid];
        }
    }
    asm volatile("s_waitcnt vmcnt(0)" ::: "memory");
    __syncthreads();
#undef RK_DMA
}

constexpr int CS_IN = 32768;
constexpr int CS_OP = 2 * CS_IN;
constexpr int CS_AT = 0, CS_RT = 4608, CS_BH = 9216, CS_KH = 13824, CS_BCT = 18432, CS_KCT = 23552, CS_VT = 28672, CS_P31 = 31744;
constexpr int CS_MT2 = CS_OP, CS_MT3 = CS_OP + 2560, CS_MT4 = CS_OP + 5120;
constexpr int CS_M1F = CS_OP + 7680;
constexpr int CS_XF = CS_OP + 12288;
constexpr int CS_UB = CS_OP + 16896;
constexpr int CS_SB = CS_OP + 19456;
constexpr int CS_YY = CS_OP + 24064;
constexpr int CS_END = CS_OP + 28160;
static_assert(CS_END <= LDS_BYTES - 64, "rwkv scan LDS map");
__device__ __forceinline__ int crow32(int r, int hi) { return (r & 3) + 8 * (r >> 2) + 4 * hi; }
__device__ __forceinline__ void rwkv_scan(const Params& p, LAS unsigned char* lds, int b, int h, int half) {
    const int tid = opaque_tid(), lane = tid & 63, wid = __builtin_amdgcn_readfirstlane(tid >> 6), r32 = lane & 31, hi = lane >> 5;
    const unsigned char* gOPS = p.ws + WS_OPS + (size_t)(b * 8 + h) * (SEQ / RCH) * OPREC;
    float* yraw = p.out + (size_t)b * SEQ * RW + h * 64 + half * 32;
#define RS_DMA(ch_, buf) do { LAS unsigned char* bb_ = lds + (buf) * CS_IN; const unsigned char* rec_ = gOPS + (size_t)(ch_) * OPREC; \
        for (int pc = wid; pc < 32; pc += NWAVES) { \
            const unsigned char* src_ = rec_ + (pc < 28 ? pc * 1024 : (pc < 31 ? OP_VT + half * 2560 + (pc - 28) * 1024 : OP_P31)) + lane * 16; \
            __builtin_amdgcn_global_load_lds((const unsigned*)src_, (LAS unsigned*)(bb_ + pc * 1024), 16, 0, 0); } } while (0)
    RS_DMA(0, 0);
    for (int i = tid; i < 4608 / 4; i += NTHREADS) ((LAS unsigned*)(lds + CS_SB))[i] = 0u;
    f32x16 Sacc = f32x16{};
    f32x16 Xacc = f32x16{};
    for (int ch = 0; ch < SEQ / RCH; ++ch) {
        const int t0 = ch * RCH, cur = ch & 1;
        if (wid < 4 && ch > 0) asm volatile("s_waitcnt vmcnt(1)" ::: "memory"); else asm volatile("s_waitcnt vmcnt(0)" ::: "memory");
        RK_BAR();
        if (ch + 1 < SEQ / RCH) RS_DMA(ch + 1, cur ^ 1);
        const LAS unsigned char* ib = lds + cur * CS_IN;
        if (wid < 4) {
            const LAS unsigned char* Am = ib + ((wid & 1) ? CS_KH : CS_BH) + r32 * 144 + hi * 16;
            const LAS unsigned char* Bm = ib + ((wid & 2) ? CS_RT : CS_AT) + r32 * 144 + hi * 16;
            f32x16 acc = f32x16{};
#pragma unroll
            for (int ks = 0; ks < 4; ++ks) acc = __builtin_amdgcn_mfma_f32_32x32x16_bf16(*(const LAS bf16x8*)(Am + ks * 32), *(const LAS bf16x8*)(Bm + ks * 32), acc, 0, 0, 0);
            const int lim = (wid < 2) ? r32 : r32 + 1;
#pragma unroll
            for (int rg = 0; rg < 16; ++rg) if (crow32(rg, hi) >= lim) acc[rg] = 0.f;
            if (wid == 0) {
#pragma unroll
                for (int rg = 0; rg < 16; ++rg) ((LAS float*)(lds + CS_M1F))[crow32(rg, hi) * 36 + r32] = acc[rg];
            } else {
                LAS unsigned char* Mt = lds + (wid == 1 ? CS_MT2 : (wid == 2 ? CS_MT3 : CS_MT4)) + r32 * 80 + hi * 8;
#pragma unroll
                for (int g = 0; g < 4; ++g) { u32x2 w; w.x = cvtpk(acc[4 * g], acc[4 * g + 1]); w.y = cvtpk(acc[4 * g + 2], acc[4 * g + 3]); *(LAS u32x2*)(Mt + g * 16) = w; }
            }
        } else if (wid < 6) {
            const LAS unsigned char* Am = ib + (wid == 4 ? CS_AT : CS_RT) + r32 * 144 + hi * 16;
            const LAS unsigned char* Bm = lds + CS_SB + r32 * 144 + hi * 16;
            Xacc = f32x16{};
#pragma unroll
            for (int ks = 0; ks < 4; ++ks) Xacc = __builtin_amdgcn_mfma_f32_32x32x16_bf16(*(const LAS bf16x8*)(Am + ks * 32), *(const LAS bf16x8*)(Bm + ks * 32), Xacc, 0, 0, 0);
        }
        RK_BAR();
        if (wid == 4) {
            const LAS unsigned char* Am = lds + CS_MT2 + r32 * 80 + hi * 16;
            const LAS unsigned char* Bm = ib + CS_VT + r32 * 80 + hi * 16;
#pragma unroll
            for (int ks = 0; ks < 2; ++ks) Xacc = __builtin_amdgcn_mfma_f32_32x32x16_bf16(*(const LAS bf16x8*)(Am + ks * 32), *(const LAS bf16x8*)(Bm + ks * 32), Xacc, 0, 0, 0);
#pragma unroll
            for (int g = 0; g < 4; ++g) *(LAS f32x4*)(lds + CS_XF + r32 * 144 + (8 * g + 4 * hi) * 4) = (f32x4){Xacc[4 * g], Xacc[4 * g + 1], Xacc[4 * g + 2], Xacc[4 * g + 3]};
        }
        RK_BAR();
        {
            const int v = tid >> 4, l = tid & 15;
            float m0[32], m1[32];
#pragma unroll
            for (int c4 = 0; c4 < 8; ++c4) { const f32x4 a = *(const LAS f32x4*)(lds + CS_M1F + l * 144 + c4 * 16), c = *(const LAS f32x4*)(lds + CS_M1F + (l + 16) * 144 + c4 * 16);
                m0[4 * c4] = a[0]; m0[4 * c4 + 1] = a[1]; m0[4 * c4 + 2] = a[2]; m0[4 * c4 + 3] = a[3]; m1[4 * c4] = c[0]; m1[4 * c4 + 1] = c[1]; m1[4 * c4 + 2] = c[2]; m1[4 * c4 + 3] = c[3]; }
            const float x0 = ((const LAS float*)(lds + CS_XF))[v * 36 + l], x1 = ((const LAS float*)(lds + CS_XF))[v * 36 + l + 16];
            float u0 = 0.f, u1 = 0.f;
#pragma unroll
            for (int i = 0; i < 32; ++i) {
                const float part = (i < 16) ? u0 * m0[i] : (u0 * m0[i] + u1 * m1[i]);
                const float tot = red16(part);
                if (i < 16) u0 = (l == i) ? x0 + tot : u0; else u1 = (l == i - 16) ? x1 + tot : u1;
            }
            const unsigned w = cvtpk(u0, u1);
            *(LAS unsigned short*)(lds + CS_UB + v * 80 + l * 2) = (unsigned short)(w & 0xffffu); *(LAS unsigned short*)(lds + CS_UB + v * 80 + (l + 16) * 2) = (unsigned short)(w >> 16);
        }
        RK_BAR();
        if (wid == 5) {
            const LAS unsigned char* A3 = lds + CS_MT3 + r32 * 80 + hi * 16; const LAS unsigned char* A4 = lds + CS_MT4 + r32 * 80 + hi * 16;
            const LAS unsigned char* Bu = lds + CS_UB + r32 * 80 + hi * 16; const LAS unsigned char* Bv = ib + CS_VT + r32 * 80 + hi * 16;
#pragma unroll
            for (int ks = 0; ks < 2; ++ks) { Xacc = __builtin_amdgcn_mfma_f32_32x32x16_bf16(*(const LAS bf16x8*)(A3 + ks * 32), *(const LAS bf16x8*)(Bu + ks * 32), Xacc, 0, 0, 0);
                Xacc = __builtin_amdgcn_mfma_f32_32x32x16_bf16(*(const LAS bf16x8*)(A4 + ks * 32), *(const LAS bf16x8*)(Bv + ks * 32), Xacc, 0, 0, 0); }
#pragma unroll
            for (int rg = 0; rg < 16; ++rg) ((LAS float*)(lds + CS_YY))[crow32(rg, hi) * 32 + r32] = Xacc[rg];
        } else if (wid < 2) {
#pragma unroll
            for (int g = 0; g < 4; ++g) { const f32x4 pv = *(const LAS f32x4*)(ib + CS_P31 + (32 * wid + 8 * g + 4 * hi) * 4);
                Sacc[4 * g] *= pv[0]; Sacc[4 * g + 1] *= pv[1]; Sacc[4 * g + 2] *= pv[2]; Sacc[4 * g + 3] *= pv[3]; }
            const LAS unsigned char* Ab = ib + CS_BCT + (32 * wid + r32) * 80 + hi * 16; const LAS unsigned char* Ak = ib + CS_KCT + (32 * wid + r32) * 80 + hi * 16;
            const LAS unsigned char* Bu = lds + CS_UB + r32 * 80 + hi * 16; const LAS unsigned char* Bv = ib + CS_VT + r32 * 80 + hi * 16;
#pragma unroll
            for (int ks = 0; ks < 2; ++ks) { Sacc = __builtin_amdgcn_mfma_f32_32x32x16_bf16(*(const LAS bf16x8*)(Ab + ks * 32), *(const LAS bf16x8*)(Bu + ks * 32), Sacc, 0, 0, 0);
                Sacc = __builtin_amdgcn_mfma_f32_32x32x16_bf16(*(const LAS bf16x8*)(Ak + ks * 32), *(const LAS bf16x8*)(Bv + ks * 32), Sacc, 0, 0, 0); }
#pragma unroll
            for (int g = 0; g < 4; ++g) { u32x2 w; w.x = cvtpk(Sacc[4 * g], Sacc[4 * g + 1]); w.y = cvtpk(Sacc[4 * g + 2], Sacc[4 * g + 3]); *(LAS u32x2*)(lds + CS_SB + r32 * 144 + (32 * wid + 8 * g + 4 * hi) * 2) = w; }
        }
        RK_BAR();
        if (tid < 256) { const int tk = tid >> 3, sub = tid & 7; *(f32x4*)(yraw + (size_t)(t0 + tk) * RW + sub * 4) = *(const LAS f32x4*)(lds + CS_YY + tk * 128 + sub * 16); }
    }
    asm volatile("s_waitcnt vmcnt(0)" ::: "memory");
    __syncthreads();
#undef RS_DMA
}
__device__ __forceinline__ void rwkv_finalize(const Params& p, int G) {
    const int tid = opaque_tid(), q16 = tid & 15;
    const float* yraw = p.out; const float* gGG = p.out + (size_t)16 * 1024 * 1024; const float* gVS = (const float*)(p.ws + WS_VS); const float* gBON = (const float*)(p.ws + WS_BON);
    bf16_t* ymix = (bf16_t*)(p.ws + WS_YMIX);
    for (int item = (int)blockIdx.x * (NTHREADS / 16) + (tid >> 4); item < T * 8; item += G * (NTHREADS / 16)) {
        const int tok = item >> 3, h = item & 7, b = tok / SEQ, t = tok - b * SEQ;
        const f32x4 y = *(const f32x4*)(yraw + (size_t)tok * RW + h * 64 + 4 * q16);
        const size_t ho = ((size_t)(b * 8 + h) * SEQ + t) * 64 + 4 * q16;
        const f32x4 vv = *(const f32x4*)(gVS + ho), gg = *(const f32x4*)(gGG + ho);
        const float bon = gBON[(size_t)(b * 8 + h) * SEQ + t];
        const f32x4 gng = *(const f32x4*)(p.in[I_GNG] + h * 64 + 4 * q16), gnb = *(const f32x4*)(p.in[I_GNB] + h * 64 + 4 * q16);
        const float mean = red16((y[0] + y[1]) + (y[2] + y[3])) * (1.0f / 64.0f);
        const f32x4 dl = y - mean;
        const float var = red16((dl[0] * dl[0] + dl[1] * dl[1]) + (dl[2] * dl[2] + dl[3] * dl[3])) * (1.0f / 64.0f);
        const f32x4 yn = dl * __builtin_amdgcn_rsqf(var + GN_EPS) * gng + gnb;
        const f32x4 ov = (yn + vv * bon) * gg;
        u32x2 w; w.x = cvtpk(ov[0], ov[1]); w.y = cvtpk(ov[2], ov[3]);
        *(u32x2*)(ymix + (size_t)tok * D + h * 64 + 4 * q16) = w;
    }
}
#undef RK_BAR

constexpr int RT_X = 0;
constexpr int RT_LG = 131584;
constexpr int RT_GS = RT_LG + 16896;
constexpr int RT_RS = RT_GS + 8192;
constexpr int RT_HIST = RT_RS + 512;
constexpr int RT_CE = RT_HIST + 128;
static_assert(RT_CE + 1024 <= LDS_BYTES - 64, "router LDS map");
__device__ __forceinline__ int rt_swz(int k) { const int g = k >> 2; return ((g ^ ((g >> 4) & 3)) << 2) | (k & 3); }
__device__ __forceinline__ void phase_router(const Params& p, LAS unsigned char* lds, int G) {
    const int tid = opaque_tid(), lane = tid & 63, wave = __builtin_amdgcn_readfirstlane(tid >> 6);
    LAS float* xt = (LAS float*)(lds + RT_X); LAS float* lg = (LAS float*)(lds + RT_LG); LAS float* gs = (LAS float*)(lds + RT_GS); LAS float* shl = gs + 1024;
    LAS float* rsl = (LAS float*)(lds + RT_RS); LAS int* hist = (LAS int*)(lds + RT_HIST); LAS float* cew = (LAS float*)(lds + RT_CE);
    const float* rw = p.in[I_RTW];
    const float* x1 = p.out; const float* gain = p.in[I_N2G]; const float* mod = (const float*)(p.ws + WS_MOD); const float* rb = p.in[I_RTB];
    unsigned char* h2q = p.ws + WS_H;
    int* ridx = (int*)(p.ws + WS_ROUTE); float* rwt = (float*)(p.ws + WS_ROUTE + 512 * 1024);
    int* blockcnt = (int*)(p.ws + WS_CTL + 4096);
    const int TPB = T / G;
    const int blk = blockIdx.x, tok0 = blk * TPB, b = tok0 / SEQ;
    for (int k = tid; k < 1024; k += NTHREADS) { gs[rt_swz(k)] = gain[k] * (1.0f + mod[b * 6144 + 4096 + k]); shl[rt_swz(k)] = mod[b * 6144 + 3072 + k]; }
    if (tid < 32) hist[tid] = 0;
    __syncthreads();
    const int j = lane & 31, hh = lane >> 5, kb = 128 * wave + 64 * hh;
    float breg[64];
    { float cpart = 0.f;
#pragma unroll
        for (int s_ = 0; s_ < 64; ++s_) { const float w = rw[(size_t)(kb + s_) * 32 + j]; cpart += shl[rt_swz(kb + s_)] * w; breg[s_] = w * gs[rt_swz(kb + s_)]; }
        cpart += __shfl_xor(cpart, 32);
        if (lane < 32) cew[wave * 32 + lane] = cpart; }
    const int xsw = (2 * wave + hh) & 3;
    for (int t0 = 0; t0 < TPB; t0 += 128) {
        f32x4 v[16];
#define RT_LOAD(tl_) do { _Pragma("unroll") for (int q = 0; q < 4; ++q) { const int tq = t0 + 32 * (tl_) + 4 * wave + q; const f32x4* xr = (const f32x4*)(x1 + (size_t)(tok0 + (tq < TPB ? tq : 0)) * D) + lane; \
            _Pragma("unroll") for (int jj = 0; jj < 4; ++jj) v[4 * q + jj] = xr[64 * jj]; } } while (0)
        RT_LOAD(0);
#pragma unroll
        for (int tl = 0; tl < 4; ++tl) {
#pragma unroll
            for (int q = 0; q < 4; ++q) { float s = 0.f;
#pragma unroll
                for (int jj = 0; jj < 4; ++jj) { const f32x4 t = v[4 * q + jj]; s += (t[0] * t[0] + t[1] * t[1]) + (t[2] * t[2] + t[3] * t[3]); }
                const float rstd = rsqrtf(wave_sum(s) * (1.0f / D) + NORM_EPS);
                if (lane == 0) rsl[32 * tl + 4 * wave + q] = rstd;
#pragma unroll
                for (int jj = 0; jj < 4; ++jj) { const int g = lane + 64 * jj; *(LAS f32x4*)(xt + (4 * wave + q) * 1028 + 4 * (g ^ ((g >> 4) & 3))) = v[4 * q + jj]; } }
            __syncthreads();
            if (tl < 3) RT_LOAD(tl + 1);
            f32x16 acc = f32x16{};
            { const LAS float* arow = xt + (lane & 31) * 1028 + kb;
#pragma unroll
                for (int c = 0; c < 16; ++c) { const f32x4 a4 = *(const LAS f32x4*)(arow + 4 * (c ^ xsw));
                    acc = __builtin_amdgcn_mfma_f32_32x32x2f32(a4[0], breg[4 * c + 0], acc, 0, 0, 0);
                    acc = __builtin_amdgcn_mfma_f32_32x32x2f32(a4[1], breg[4 * c + 1], acc, 0, 0, 0);
                    acc = __builtin_amdgcn_mfma_f32_32x32x2f32(a4[2], breg[4 * c + 2], acc, 0, 0, 0);
                    acc = __builtin_amdgcn_mfma_f32_32x32x2f32(a4[3], breg[4 * c + 3], acc, 0, 0, 0); } }
            { const int hsw = (lane >> 2) & 3;
#pragma unroll
                for (int q = 0; q < 4; ++q) { const int tq = t0 + 32 * tl + 4 * wave + q; const float rstd = rsl[32 * tl + 4 * wave + q]; u32x4 o;
#pragma unroll
                    for (int u = 0; u < 4; ++u) { const int go = 4 * ((4 * lane + u) ^ hsw);
                        const f32x4 xv = *(const LAS f32x4*)(xt + (4 * wave + q) * 1028 + go), g4 = *(const LAS f32x4*)(gs + go), s4 = *(const LAS f32x4*)(shl + go);
                        const f32x4 y = (xv * rstd) * g4 + s4;
                        o[u] = cvt4_fp8(Q_H2 * y[0], Q_H2 * y[1], Q_H2 * y[2], Q_H2 * y[3]); }
                    if (tq < TPB) *(u32x4*)(h2q + (size_t)(tok0 + tq) * D + 16 * lane) = o; } }
            __syncthreads();
            { LAS float* part = (LAS float*)(lds + RT_X);
#pragma unroll
                for (int r = 0; r < 16; ++r) part[wave * 1024 + r * 64 + lane] = acc[r];
                __syncthreads();
                const int e = tid & 31; float ce = rb[e];
#pragma unroll
                for (int w = 0; w < 8; ++w) ce += cew[w * 32 + e];
#pragma unroll
                for (int q = 0; q < 2; ++q) { const int idx = tid + 512 * q; float sum = 0.f;
#pragma unroll
                    for (int w = 0; w < 8; ++w) sum += part[w * 1024 + idx];
                    const int r = idx >> 6, tk = 32 * tl + (r & 3) + 8 * (r >> 2) + 4 * ((idx >> 5) & 1);
                    lg[tk * 33 + e] = rsl[tk] * sum + ce; }
                __syncthreads(); }
        }
#undef RT_LOAD
        if (tid < 128 && t0 + tid < TPB) {
            const int row = tok0 + t0 + tid; const LAS float* lr = lg + tid * 33;
            float v0 = -INFINITY, v1 = -INFINITY, v2 = -INFINITY, v3 = -INFINITY; int i0 = 0, i1 = 0, i2 = 0, i3 = 0;
#pragma unroll
            for (int e = 0; e < 32; ++e) { const float x = lr[e];
                if (x > v0) { v3 = v2; i3 = i2; v2 = v1; i2 = i1; v1 = v0; i1 = i0; v0 = x; i0 = e; }
                else if (x > v1) { v3 = v2; i3 = i2; v2 = v1; i2 = i1; v1 = x; i1 = e; }
                else if (x > v2) { v3 = v2; i3 = i2; v2 = x; i2 = e; }
                else if (x > v3) { v3 = x; i3 = e; } }
            const float e1 = __expf(v1 - v0), e2 = __expf(v2 - v0), e3 = __expf(v3 - v0); const float inv = 1.0f / (1.0f + e1 + e2 + e3);
            *(int4*)(ridx + (size_t)row * 4) = make_int4(i0, i1, i2, i3); *(float4*)(rwt + (size_t)row * 4) = make_float4(inv, e1 * inv, e2 * inv, e3 * inv);
            atomicAdd((int*)&hist[i0], 1); atomicAdd((int*)&hist[i1], 1); atomicAdd((int*)&hist[i2], 1); atomicAdd((int*)&hist[i3], 1);
        }
        __syncthreads();
    }
    if (tid < 32) blockcnt[blk * 32 + tid] = hist[tid];
    __syncthreads();
}

__device__ __forceinline__ void phase_assign(const Params& p, LAS unsigned char* lds, int G) {
    const int tid = opaque_tid(), lane = tid & 63, wave = tid >> 6;
    LAS int* part = (LAS int*)lds;
    LAS int* partb = part + 512;
    LAS int* total = partb + 512;
    LAS int* base = total + 32;
    LAS int* segst = base + 32;
    LAS int* cursor = segst + 32;
    LAS int* slotl = cursor + 32;
    const int* blockcnt = (const int*)(p.ws + WS_CTL + 4096);
    const int* ridx = (const int*)(p.ws + WS_ROUTE); int* rslot = (int*)(p.ws + WS_ROUTE + 1024 * 1024); int* tokmap = (int*)(p.ws + WS_ROUTE + 2 * 1024 * 1024);
    const bf16_t* h2 = (const bf16_t*)(p.ws + WS_H); bf16_t* xs = (bf16_t*)(p.ws + WS_PROJ);
    int* tile = (int*)(p.ws + WS_TILE);
    const int TPB = T / G; const int blk = blockIdx.x;
    { const int e = tid & 31, part_i = tid >> 5; int st = 0, sb = 0;
        for (int bb = part_i; bb < G; bb += 16) { const int c = blockcnt[bb * 32 + e]; st += c; if (bb < blk) sb += c; }
        part[part_i * 32 + e] = st; partb[part_i * 32 + e] = sb; }
    __syncthreads();
    if (tid < 32) { int st = 0, sb = 0;
#pragma unroll
        for (int i = 0; i < 16; ++i) { st += part[i * 32 + tid]; sb += partb[i * 32 + tid]; }
        total[tid] = st; base[tid] = sb; cursor[tid] = 0; }
    __syncthreads();
    if (tid == 0) { int acc = 0; for (int e = 0; e < 32; ++e) { segst[e] = acc; acc += (total[e] + 255) & ~255; }
        if (blk == 0) { int pm = 0; for (int e = 0; e < 32; ++e) { const int nt = (total[e] + 255) >> 8; for (int i = 0; i < nt; ++i) tile[16 + pm + i] = e; pm += nt; } tile[0] = pm; } }
    __syncthreads();
    if (tid < 32) base[tid] += segst[tid];
    __syncthreads();
    for (int a = tid; a < TPB * 4; a += NTHREADS) { const int tok = blk * TPB + (a >> 2); const int e = ridx[(size_t)tok * 4 + (a & 3)];
        const int rank = atomicAdd((int*)&cursor[e], 1); const int slot = base[e] + rank; rslot[(size_t)tok * 4 + (a & 3)] = slot; tokmap[slot] = tok; }
    for (int e = blk; e < 32; e += G) { const int s0 = segst[e] + total[e], s1 = segst[e] + ((total[e] + 255) & ~255);
        for (int r = s0 + tid; r < s1; r += NTHREADS) tokmap[r] = 0; }
}

__device__ __forceinline__ void phase_final(const Params& p, int G, int stage) {
    const int tid = opaque_tid(), lane = tid & 63, wave = tid >> 6;
    const int gw = (int)blockIdx.x * NWAVES + wave, NGW = G * NWAVES;
    const float* fg = p.in[I_FG]; const float* mod = (const float*)(p.ws + WS_MOD);
    const int* rslot = (const int*)(p.ws + WS_ROUTE + 1024 * 1024); const float* rwt = (const float*)(p.ws + WS_ROUTE + 512 * 1024);
    const bf16_t* Y = (const bf16_t*)(p.ws + WS_PROJ);
    const float* src = (stage >= 4) ? p.out : p.in[I_X];
    for (int row = gw; row < T; row += NGW) {
        const int b = row / SEQ;
        const f32x4* xr = (const f32x4*)(src + (size_t)row * D) + lane;
        f32x4 v[4];
#pragma unroll
        for (int j = 0; j < 4; ++j) v[j] = xr[64 * j];
        if (stage >= 9) {
            const int4 sl = *(const int4*)(rslot + (size_t)row * 4); const float4 wt = *(const float4*)(rwt + (size_t)row * 4);
            const float* g2 = mod + b * 6144 + 5120;
            const int sls[4] = {sl.x, sl.y, sl.z, sl.w}; const float wts[4] = {wt.x, wt.y, wt.z, wt.w};
#pragma unroll
            for (int j = 0; j < 4; ++j) { f32x4 m = (f32x4){0.f, 0.f, 0.f, 0.f};
#pragma unroll
                for (int k = 0; k < 4; ++k) { const u32x2 yv = *((const u32x2*)(Y + (size_t)sls[k] * D) + lane + 64 * j);
                    m[0] += wts[k] * __uint_as_float(yv.x << 16); m[1] += wts[k] * __uint_as_float(yv.x & 0xffff0000u); m[2] += wts[k] * __uint_as_float(yv.y << 16); m[3] += wts[k] * __uint_as_float(yv.y & 0xffff0000u); }
                const f32x4 g = *(const f32x4*)(g2 + 4 * lane + 256 * j); v[j] = v[j] + g * m; }
        }
        float s = 0.f;
#pragma unroll
        for (int j = 0; j < 4; ++j) s += (v[j][0] * v[j][0] + v[j][1] * v[j][1]) + (v[j][2] * v[j][2] + v[j][3] * v[j][3]);
        const float rstd = rsqrtf(wave_sum(s) * (1.0f / D) + NORM_EPS);
        f32x4* orow = (f32x4*)(p.out + (size_t)row * D) + lane;
#pragma unroll
        for (int j = 0; j < 4; ++j) { const f32x4 g = *(const f32x4*)(fg + 4 * lane + 256 * j); orow[64 * j] = v[j] * rstd * g; }
    }
}


#define XB_TMO      128
#define XB_XCNT(j)  (256  + 64 * (j))
#define XB_XSUB(j)  (1280 + 64 * (j))
#define XB_XGEN(j)  (2304 + 64 * (j))
#define XB_TOP      3328
#define XB_TOPGEN   3392
#define XCD_BAR_WORDS 3456
#define XB_SPIN_CAP (1u << 22)
__device__ __forceinline__ unsigned xb_ld(unsigned* p)              { return __hip_atomic_load(p, __ATOMIC_RELAXED, __HIP_MEMORY_SCOPE_AGENT); }
__device__ __forceinline__ unsigned xb_add(unsigned* p, unsigned v) { return __hip_atomic_fetch_add(p, v, __ATOMIC_RELAXED, __HIP_MEMORY_SCOPE_AGENT); }
__device__ __forceinline__ unsigned xb_xcc_id() { return (unsigned)__builtin_amdgcn_s_getreg((3 << 11) | 20) & 0xFu; }
#define XB_SPIN(cond, bar) do { unsigned _sp = 0; while (cond) { __builtin_amdgcn_s_sleep(1); \
    if ((++_sp & 255u) == 0u) { if (xb_ld(&(bar)[XB_TMO])) break; if (_sp > XB_SPIN_CAP) { atomicAdd(&(bar)[XB_TMO], 1u); break; } } } } while (0)
struct XcdBarrier { unsigned* bar; unsigned x; volatile LAS unsigned* st; };
__device__ __forceinline__ XcdBarrier xcd_barrier_post(unsigned* bar, volatile LAS unsigned* st) {
    XcdBarrier b; b.bar = bar; b.x = xb_xcc_id(); b.st = st;
    if (threadIdx.x == 0) (void)xb_add(&bar[XB_XCNT(b.x)], 1u);
    return b;
}
__device__ __forceinline__ void xcd_barrier_complete(unsigned* bar, unsigned x, unsigned& nloc, unsigned& nx) {
    const unsigned G = gridDim.x * gridDim.y * gridDim.z;
    unsigned sum, cnt, mine, sp = 0u;
    for (;;) {
        sum = 0u; cnt = 0u; mine = 0u;
#pragma unroll
        for (unsigned j = 0; j < 16; ++j) { const unsigned c = xb_ld(&bar[XB_XCNT(j)]); sum += c; cnt += (c > 0u) ? 1u : 0u; mine = (j == x) ? c : mine; }
        if (sum == G) break;
        __builtin_amdgcn_s_sleep(1);
        if ((++sp & 255u) == 0u) { if (xb_ld(&bar[XB_TMO])) break; if (sp > XB_SPIN_CAP) { atomicAdd(&bar[XB_TMO], 1u); break; } }
    }
    nloc = mine > 0u ? mine : 1u; nx = cnt > 0u ? cnt : 1u;
}
__device__ __forceinline__ void xcd_barrier(const XcdBarrier& b) {
    asm volatile("s_waitcnt vmcnt(0)" ::: "memory");
    __syncthreads();
    if (threadIdx.x == 0) {
        unsigned* bar = b.bar;
        __builtin_amdgcn_s_waitcnt(0);
        unsigned nloc = b.st[0], nx = b.st[1];
        if (nloc == 0u) { xcd_barrier_complete(bar, b.x, nloc, nx); b.st[0] = nloc; b.st[1] = nx; }
        const unsigned old = xb_add(&bar[XB_XSUB(b.x)], 1u);
        const unsigned gen = old / nloc;
        if (old + 1u == (gen + 1u) * nloc) {
            __builtin_amdgcn_fence(__ATOMIC_RELEASE, "agent");
            asm volatile("s_waitcnt vmcnt(0)" ::: "memory");
            const unsigned og = xb_add(&bar[XB_TOP], 1u);
            const unsigned tg = og / nx;
            if (og + 1u == (tg + 1u) * nx) xb_add(&bar[XB_TOPGEN], 1u);
            else XB_SPIN(xb_ld(&bar[XB_TOPGEN]) == tg, bar);
            __builtin_amdgcn_fence(__ATOMIC_ACQUIRE, "agent");
            xb_add(&bar[XB_XGEN(b.x)], 1u);
            asm volatile("s_waitcnt vmcnt(0)" ::: "memory");
        } else {
            XB_SPIN(xb_ld(&bar[XB_XGEN(b.x)]) == gen, bar);
            __builtin_amdgcn_fence(__ATOMIC_ACQUIRE, "agent");
            asm volatile("s_waitcnt vmcnt(0)" ::: "memory");
        }
    }
    __syncthreads();
}

__device__ __forceinline__ const Params* launder_params(const Params* q) { asm volatile("" : "+s"(q)); return q; }
__global__ void __launch_bounds__(NTHREADS, 2) hymba_fwd(Params p) {
    extern __shared__ __attribute__((aligned(16))) unsigned char lds_raw[];
    cg::grid_group grid = cg::this_grid();
    LAS unsigned char* lds = (LAS unsigned char*)lds_raw;
    const int G = gridDim.x, tid = threadIdx.x;
    constexpr int STAGE = DBG_STAGE;
    volatile LAS unsigned* xst = (volatile LAS unsigned*)(lds + LDS_BYTES - 64);
    if (tid == 0) { xst[0] = 0u; xst[1] = 0u; }
    __syncthreads();
    const XcdBarrier xbar = xcd_barrier_post((unsigned*)(p.ws + WS_CTL + 40960), xst);
#define GRID_BAR() xcd_barrier(xbar)

    phase_mod(p, lds_raw, G);
    if (STAGE >= 2) phase_convert(p, lds_raw, G);
    grid.sync();
    if (STAGE >= 2) { phase_norm1(p, G); GRID_BAR(); }
    if (STAGE >= 2) {
        pg8::Gemm g{(const bf16_t*)(p.ws + WS_H), (const bf16_t*)(p.ws + WS_WIN_T), D, nullptr};
        pg8::DenseSched S; S.o.init(T / 256, IC / 256, G, (int)blockIdx.x);
        EpiInProj E{(bf16_t*)(p.ws + WS_PROJ)};
        pg8::gemm_phase<false, false>(lds, g, S, E);
        GRID_BAR();
    }
    if (STAGE >= 3) {
        kmax_pass(p, G);
        for (int it = blockIdx.x; it < NB * 8 * 4; it += G) rwkv_prep(p, lds, it >> 5, (it >> 2) & 7, (it & 3) * 32, (it & 3) * 32 + 32);
        GRID_BAR();
    }
    if (STAGE >= 2) {
        if (STAGE >= 3) { for (int u = blockIdx.x; u < NB * 8 * 2; u += G) rwkv_scan(p, lds, u >> 4, (u >> 1) & 7, u & 1); }
        else {
            bf16_t* ymix = (bf16_t*)(p.ws + WS_YMIX);
            for (size_t i = (size_t)blockIdx.x * NTHREADS + tid; i < (size_t)T * 64; i += (size_t)G * NTHREADS) { const size_t row = i >> 6, c = i & 63; *(u32x4*)(ymix + row * D + c * 8) = (u32x4){0u, 0u, 0u, 0u}; }
        }
        float lam;
        { const float* q1 = p.in[I_LQ1]; const float* k1 = p.in[I_LK1]; const float* q2 = p.in[I_LQ2]; const float* k2 = p.in[I_LK2]; float s1 = 0.f, s2 = 0.f;
            for (int i = 0; i < 64; ++i) { s1 += q1[i] * k1[i]; s2 += q2[i] * k2[i]; } lam = expf(s1) - expf(s2) + LAMBDA_INIT; }
        unsigned* qhead = (unsigned*)(p.ws + WS_CTL);
        LAS unsigned* ubox = (LAS unsigned*)(lds + 4 * ATT_BUF);
        for (;;) {
            __syncthreads();
            if (tid == 0) ubox[0] = atomicAdd(qhead, 1u);
            __syncthreads();
            const unsigned u = (unsigned)__builtin_amdgcn_readfirstlane((int)ubox[0]);
            if (u >= (unsigned)ATT_UNITS) break;
            attn_unit(p, lds, (int)(u & 31u) >> 2, (int)(u & 3u), ATT_NQB - 1 - (int)(u >> 5), lam);
        }
        GRID_BAR();
        if (STAGE >= 3) { rwkv_finalize(p, G); GRID_BAR(); }
    }
    if (STAGE >= 2) {
        pg8::Gemm g{(const bf16_t*)(p.ws + WS_YMIX), (const bf16_t*)(p.ws + WS_WOUT_T), D, nullptr};
        pg8::DenseSched S; S.o.init(T / 256, D / 256, G, (int)blockIdx.x);
        EpiOutProj E{p.in[I_X], (const float*)(p.ws + WS_MOD), p.out};
        pg8::gemm_phase<false, false>(lds, g, S, E);
        GRID_BAR();
    }
    if (STAGE >= 9) {
        phase_router(p, lds, G);
        GRID_BAR();
        phase_assign(p, lds, G);
        GRID_BAR();
        const int* tile = (const int*)(p.ws + WS_TILE);
        const int MT = tile[0];
        {
            pg8::Gemm g{(const bf16_t*)(p.ws + WS_H), (const bf16_t*)(p.ws + WS_WG_T), D / 2, (const int*)(p.ws + WS_ROUTE + 2 * 1024 * 1024)};
            pg8::MoeSched S; S.o.init(MT, 8, G, (int)blockIdx.x); S.tile_e = tile + 16; S.N = 2048;
            EpiMoe1 E{p.in[I_BGU], p.ws + WS_ACT};
            pg8::gemm_phase<true, true>(lds, g, S, E);
        }
        GRID_BAR();
        {
            pg8::Gemm g{(const bf16_t*)(p.ws + WS_ACT), (const bf16_t*)(p.ws + WS_WD_T), D / 2, nullptr};
            pg8::MoeSched S; S.o.init(MT, 4, G, (int)blockIdx.x); S.tile_e = tile + 16; S.N = 1024;
            EpiMoe2 E{p.in[I_BDN], (bf16_t*)(p.ws + WS_PROJ)};
            pg8::gemm_phase<false, true>(lds, g, S, E);
        }
        GRID_BAR();
    }
    phase_final(p, G, STAGE >= 9 ? 9 : (STAGE >= 2 ? 4 : 0));
}

extern "C" void kernel_launch(void* const* d_in, const int* in_sizes, int n_in, void* d_out, int out_size, void* d_ws, size_t ws_size, hipStream_t stream) {
    static int grid = 0;
    if (grid == 0) {
        if (n_in != 31 || out_size != T * D || ws_size < WS_END) { fprintf(stderr, "kernel_launch: unexpected shapes (n_in %d out %d ws %zu)\n", n_in, out_size, ws_size); grid = -1; return; }
        int dev = 0, cus = 0, per_cu = 0;
        hipGetDevice(&dev);
        hipDeviceGetAttribute(&cus, hipDeviceAttributeMultiprocessorCount, dev);
        hipFuncSetAttribute((const void*)hymba_fwd, hipFuncAttributeMaxDynamicSharedMemorySize, LDS_BYTES);
        hipOccupancyMaxActiveBlocksPerMultiprocessor(&per_cu, (const void*)hymba_fwd, NTHREADS, LDS_BYTES);
        if (per_cu < 1) { fprintf(stderr, "kernel_launch: occupancy query returned %d\n", per_cu); grid = -1; return; }
        grid = cus;
        if (grid > 256) grid = 256;
        while (T % grid != 0) --grid;
        (void)hipGetLastError();
    }
    if (grid < 0) return;
    hipMemsetAsync((char*)d_ws + WS_CTL, 0, CTL_BYTES, stream);
    Params p{};
    for (int i = 0; i < 31; ++i) p.in[i] = (const float*)d_in[i];
    p.out = (float*)d_out; p.ws = (unsigned char*)d_ws;
    void* args[] = {&p};
    hipError_t e = hipLaunchCooperativeKernel((const void*)hymba_fwd, dim3(grid), dim3(NTHREADS), args, LDS_BYTES, stream);
    if (e != hipSuccess) fprintf(stderr, "cooperative launch failed: %s (grid %d)\n", hipGetErrorString(e), grid);
}
```

```cpp
#include <hip/hip_runtime.h>
#include <hip/hip_cooperative_groups.h>
#include <cstdio>
#include <cstdint>
namespace cg = cooperative_groups;

#ifndef DBG_STAGE
#define DBG_STAGE 99
#endif

#define LAS __attribute__((address_space(3)))
typedef unsigned short bf16_t;
typedef short bf16x8 __attribute__((ext_vector_type(8)));
typedef short s16x4 __attribute__((ext_vector_type(4)));
typedef float f32x4 __attribute__((ext_vector_type(4)));
typedef float f32x16 __attribute__((ext_vector_type(16)));
typedef float f32x2_t __attribute__((ext_vector_type(2)));
typedef __bf16 bf16x2_t __attribute__((ext_vector_type(2)));
typedef unsigned u32x4 __attribute__((ext_vector_type(4)));
typedef unsigned u32x2 __attribute__((ext_vector_type(2)));

constexpr int D = 1024, NB = 8, SEQ = 4096, T = NB * SEQ;
constexpr int RW = 512, RC = 1792, DC = 1536, IC = 3328;
constexpr int NE = 32, TOPK = 4, NA = T * TOPK;
constexpr int PMAX = NA + NE * 256;
constexpr float NORM_EPS = 1e-5f, GN_EPS = 64e-5f;
constexpr float LOG2E = 1.4426950408889634f;
constexpr float QSCALE = 0.125f * LOG2E;
constexpr float LAMBDA_INIT = 0.2f;
constexpr int NTHREADS = 512, NWAVES = 8;
constexpr int LDS_BYTES = 163840;

constexpr size_t MiB = 1u << 20;
constexpr size_t WS_CTL = 0;
constexpr size_t CTL_BYTES = 65536;
constexpr size_t WS_MOD = 1 * MiB;
constexpr size_t WS_TILE = 1 * MiB + 512 * 1024;
constexpr size_t WS_WIN_T = 2 * MiB;
constexpr size_t WS_WOUT_T = 9 * MiB;
constexpr size_t WS_ROUTE = 11 * MiB;
constexpr size_t WS_WG_T = 16 * MiB;
constexpr size_t WS_WD_T = 144 * MiB;
constexpr size_t WS_H = 208 * MiB;
constexpr size_t WS_YMIX = 272 * MiB;
constexpr size_t WS_PROJ = 336 * MiB;
constexpr size_t WS_ACT = 608 * MiB;
constexpr size_t WS_END = 1008 * MiB;
constexpr int OPREC = 34816;
constexpr int OP_AT = 0, OP_RT = 4608, OP_BH = 9216, OP_KH = 13824, OP_BCT = 18432, OP_KCT = 23552, OP_VT = 28672, OP_P31 = 33792;
constexpr size_t WS_OPS = WS_ACT;
constexpr size_t WS_VS = 944 * MiB;
constexpr size_t WS_BON = WS_H;

__device__ __forceinline__ unsigned cvtpk(float lo, float hi) { f32x2_t v = {lo, hi}; bf16x2_t b = __builtin_convertvector(v, bf16x2_t); return __builtin_bit_cast(unsigned, b); }
__device__ __forceinline__ float bf2f(unsigned short u) { return __uint_as_float(((unsigned)u) << 16); }
__device__ __forceinline__ float wave_sum(float v) {
#pragma unroll
    for (int o = 1; o < 64; o <<= 1) v += __shfl_xor(v, o);
    return v;
}
__device__ __forceinline__ float wave_max(float v) {
#pragma unroll
    for (int o = 1; o < 64; o <<= 1) v = fmaxf(v, __shfl_xor(v, o));
    return v;
}
__device__ __forceinline__ int opaque_tid() { int t = (int)threadIdx.x; asm volatile("" : "+v"(t)); return t; }
__device__ __forceinline__ float sigmoidf_(float x) { return __builtin_amdgcn_rcpf(1.0f + __expf(-x)); }
__device__ __forceinline__ float tanh_fast(float x) { return 1.0f - 2.0f * __builtin_amdgcn_rcpf(1.0f + __expf(2.0f * x)); }

struct Params {
    const float* in[31];
    float* out;
    unsigned char* ws;
};
enum { I_X = 0, I_C, I_MODW, I_MODB, I_N1G, I_WIN, I_MU, I_W0, I_WUP, I_A0, I_AUP, I_GUP, I_KK, I_KA, I_RK, I_GNG, I_GNB, I_LQ1, I_LK1, I_LQ2, I_LK2, I_SUBLN, I_WOUT, I_N2G, I_RTW, I_RTB, I_WGU, I_BGU, I_WDN, I_BDN, I_FG };

namespace pg8 {
constexpr int BM = 256, BK = 64, HALF = 128, HTB = HALF * BK * 2, STAGE_BYTES = 8 * HTB, NXCD = 8, WGM = 8;
__host__ __device__ __forceinline__ int lds_byte(int r, int c) { const int st = (r >> 4) * 2 + (c >> 5), rr = r & 15, cc = c & 31, ob = rr * 64 + cc * 2; return st * 1024 + (ob ^ (((ob >> 9) & 1) << 5)); }
__host__ __device__ __forceinline__ void stage_rc(int b, int& R, int& C) { const int st = b / 1024, sb = b % 1024, swz = sb ^ (((sb >> 9) & 1) << 5); R = (st >> 1) * 16 + swz / 64; C = (st & 1) * 32 + (swz % 64) / 2; }
__host__ __device__ __forceinline__ int perm32(int rho) { const int n = rho >> 4, i = rho & 15; return 8 * (i >> 2) + 4 * n + (i & 3); }

struct Unit { int pm, pn, arow, brow, e; };
struct Gemm { const bf16_t* A; const bf16_t* Bt; int K; const int* rowmap; };

struct TileOrder {
    int nM, nN, nwg, G, c;
    __device__ void init(int nM_, int nN_, int G_, int c_) { nM = nM_; nN = nN_; nwg = nM * nN; G = G_; c = c_; }
    __device__ bool map(int i, int& pm, int& pn) const {
        const long L = (long)i * G + c; if (L >= nwg) return false;
        int wgid = (int)L; { const int q = nwg / NXCD, r = nwg % NXCD, xcd = wgid % NXCD, off = wgid / NXCD; wgid = (xcd < r ? xcd * (q + 1) : r * (q + 1) + (xcd - r) * q) + off; }
        const int nig = WGM * nN, gid = wgid / nig, fm = gid * WGM, gsz = (nM - fm) < WGM ? (nM - fm) : WGM;
        pm = fm + ((wgid % nig) % gsz); pn = (wgid % nig) / gsz; return true;
    }
};
struct DenseSched {
    TileOrder o;
    __device__ bool next(int i, Unit& u) const { int pm, pn; if (!o.map(i, pm, pn)) return false; u.pm = pm; u.pn = pn; u.arow = pm * BM; u.brow = pn * BM; u.e = 0; return true; }
};
struct MoeSched {
    TileOrder o; const int* tile_e; int N;
    __device__ bool next(int i, Unit& u) const { int pm, pn; if (!o.map(i, pm, pn)) return false; const int e = tile_e[pm]; u.pm = pm; u.pn = pn; u.arow = pm * BM; u.brow = e * N + pn * BM; u.e = e; return true; }
};

typedef int v4i_t __attribute__((ext_vector_type(4)));
typedef int v8i_t __attribute__((ext_vector_type(8)));
__device__ __forceinline__ v8i_t cat8(bf16x8 a, bf16x8 b) { return __builtin_shufflevector(__builtin_bit_cast(v4i_t, a), __builtin_bit_cast(v4i_t, b), 0, 1, 2, 3, 4, 5, 6, 7); }
__device__ __forceinline__ void mfma_fp8_tied(f32x4& acc, v8i_t a, v8i_t b) { asm volatile("v_mfma_f32_16x16x128_f8f6f4 %0, %1, %2, %0" : "+v"(acc) : "v"(a), "v"(b)); }
template <bool GATHER, bool FP8, class Epi, class Sched>
__device__ __forceinline__ void gemm_phase(LAS unsigned char* lds, const Gemm g, const Sched& S, const Epi& E) {
    const int tid = opaque_tid(), wid = __builtin_amdgcn_readfirstlane(tid >> 6), lane = tid & 63, wr = wid >> 2, wc = wid & 3, fr = lane & 15, fq = lane >> 4;
    const int K = g.K, nt = K / BK;
    unsigned voffA[2], voffB[2]; int rowA[2], colA2[2];
#pragma unroll
    for (int i = 0; i < 2; ++i) { int R, C; stage_rc(tid * 16 + i * 8192, R, C); const int Rb = (R & ~31) + perm32(R & 31);
        voffA[i] = (unsigned)(R * K + C) * 2u; voffB[i] = (unsigned)(Rb * K + C) * 2u; rowA[i] = R; colA2[i] = C * 2; }
    unsigned gv0[2] = {0u, 0u}, gv1[2] = {0u, 0u}, gn0[2] = {0u, 0u}, gn1[2] = {0u, 0u};
#define PG8_GOFF(u_, o0, o1) do { _Pragma("unroll") for (int _i = 0; _i < 2; ++_i) { o0[_i] = (unsigned)g.rowmap[(u_).arow + rowA[_i]] * (unsigned)(K * 2) + (unsigned)colA2[_i]; o1[_i] = (unsigned)g.rowmap[(u_).arow + HALF + rowA[_i]] * (unsigned)(K * 2) + (unsigned)colA2[_i]; } } while (0)
#define PG8_STAGE_A(bufoff, kptr, half) do { if constexpr (GATHER) { if (half) PG8_STAGE(bufoff, kptr, gv1); else PG8_STAGE(bufoff, kptr, gv0); } else PG8_STAGE(bufoff, (kptr) + ((half) ? hstep : 0), voffA); } while (0)
    const size_t kstep = (size_t)(BK * 2);
    const size_t hstep = (size_t)HALF * K * 2;
    const size_t rowb = (size_t)K * 2;
    const unsigned ldsw = (unsigned)wid * 1024u;
    const int aoff = lds_byte(wr * 64 + fr, fq * 8), boff = lds_byte(wc * 32 + fr, fq * 8);
#define PG8_SA(b, h) (((b) * 2 + (h)) * HTB)
#define PG8_SB(b, h) ((4 + (b) * 2 + (h)) * HTB)
#define PG8_STAGE(bufoff, gbase, voff) do { _Pragma("unroll") for (int _i = 0; _i < 2; ++_i) \
        __builtin_amdgcn_global_load_lds((const unsigned*)((const char*)(gbase) + (voff)[_i]), (LAS unsigned*)(lds + (bufoff) + ldsw + _i * 8192), 16, 0, 0); } while (0)
#define PG8_LDA(dst, b, h) do { _Pragma("unroll") for (int m = 0; m < 4; ++m) _Pragma("unroll") for (int k = 0; k < 2; ++k) dst[m][k] = *(const LAS bf16x8*)(lds + PG8_SA(b, h) + aoff + m * 2048 + k * 1024); } while (0)
#define PG8_LDB(dst, b, h) do { _Pragma("unroll") for (int n = 0; n < 2; ++n) _Pragma("unroll") for (int k = 0; k < 2; ++k) dst[n][k] = *(const LAS bf16x8*)(lds + PG8_SB(b, h) + boff + n * 2048 + k * 1024); } while (0)
#define PG8_MMA(ai, bj, At, Bt) do { __builtin_amdgcn_s_setprio(1); _Pragma("unroll") for (int m = 0; m < 4; ++m) _Pragma("unroll") for (int n = 0; n < 2; ++n) { \
        if constexpr (FP8) mfma_fp8_tied(acc[ai][bj][m][n], cat8(Bt[n][0], Bt[n][1]), cat8(At[m][0], At[m][1])); \
        else { _Pragma("unroll") for (int k = 0; k < 2; ++k) acc[ai][bj][m][n] = __builtin_amdgcn_mfma_f32_16x16x32_bf16(Bt[n][k], At[m][k], acc[ai][bj][m][n], 0, 0, 0); } } __builtin_amdgcn_s_setprio(0); } while (0)
#define PG8_WAIT_V(n) asm volatile("s_waitcnt vmcnt(" #n ")" ::: "memory")
#define PG8_WAIT_L(n) asm volatile("s_waitcnt lgkmcnt(" #n ")" ::: "memory")
#define PG8_BAR __builtin_amdgcn_s_barrier()
#define PG8_SCHED __builtin_amdgcn_sched_barrier(0)
    Unit cur, nxt; int ui = 0;
    if (!S.next(0, cur)) return;
    f32x4 acc[2][2][4][2];
#pragma unroll
    for (int a = 0; a < 2; ++a)
#pragma unroll
        for (int b = 0; b < 2; ++b)
#pragma unroll
            for (int m = 0; m < 4; ++m)
#pragma unroll
                for (int n = 0; n < 2; ++n) acc[a][b][m][n] = (f32x4){0.f, 0.f, 0.f, 0.f};
    bf16x8 At[4][2], B0[2][2], B1[2][2];
    const char* cA = GATHER ? (const char*)g.A : (const char*)g.A + (size_t)cur.arow * rowb; const char* cB = (const char*)g.Bt + (size_t)cur.brow * rowb;
    if constexpr (GATHER) PG8_GOFF(cur, gv0, gv1);
    PG8_STAGE(PG8_SB(0, 0), cB, voffB); PG8_STAGE(PG8_SB(0, 1), cB + hstep, voffB); PG8_STAGE_A(PG8_SA(0, 0), cA, 0); PG8_STAGE_A(PG8_SA(0, 1), cA, 1);
    if (wr == 1) PG8_BAR;
    PG8_WAIT_V(2); PG8_BAR;
    PG8_STAGE(PG8_SB(1, 0), cB + kstep, voffB); PG8_STAGE_A(PG8_SA(1, 0), cA + kstep, 0); PG8_STAGE(PG8_SB(1, 1), cB + hstep + kstep, voffB);
    PG8_WAIT_V(6); PG8_BAR;
    for (;;) {
        const bool has_next = S.next(ui + 1, nxt);
        const char* nA = GATHER ? (const char*)g.A : (has_next ? (const char*)g.A + (size_t)nxt.arow * rowb : cA); const char* nB = has_next ? (const char*)g.Bt + (size_t)nxt.brow * rowb : cB;

        for (int t = 0; t < nt; t += 2) {
            const bool last = (t == nt - 2);
            if constexpr (GATHER) { if (t == nt - 4) { if (has_next) PG8_GOFF(nxt, gn0, gn1); else { gn0[0] = gv0[0]; gn0[1] = gv0[1]; gn1[0] = gv1[0]; gn1[1] = gv1[1]; } } }
            const char* a1 = cA + (size_t)(t + 1) * kstep;
            const char* a2 = last ? nA : cA + (size_t)(t + 2) * kstep; const char* b2 = last ? nB : cB + (size_t)(t + 2) * kstep;
            const char* a3 = a2 + kstep; const char* b3 = b2 + kstep;
            PG8_LDB(B0, 0, 0); PG8_LDB(B1, 0, 1); PG8_SCHED; PG8_LDA(At, 0, 0); PG8_STAGE_A(PG8_SA(1, 1), a1, 1);
            if constexpr (GATHER) { if (last) { gv0[0] = gn0[0]; gv0[1] = gn0[1]; gv1[0] = gn1[0]; gv1[1] = gn1[1]; } }
            PG8_WAIT_V(8); PG8_WAIT_L(0); PG8_BAR; PG8_MMA(0, 0, At, B0); PG8_MMA(0, 1, At, B1); PG8_BAR; PG8_SCHED;
            PG8_LDA(At, 0, 1); PG8_STAGE(PG8_SB(0, 0), b2, voffB); PG8_STAGE(PG8_SB(0, 1), b2 + hstep, voffB); PG8_STAGE_A(PG8_SA(0, 0), a2, 0);
            PG8_WAIT_V(8); PG8_WAIT_L(0); PG8_BAR; PG8_MMA(1, 0, At, B0); PG8_MMA(1, 1, At, B1); PG8_BAR; PG8_SCHED;
            PG8_LDB(B0, 1, 0); PG8_LDB(B1, 1, 1); PG8_SCHED; PG8_LDA(At, 1, 0); PG8_STAGE_A(PG8_SA(0, 1), a2, 1);
            PG8_WAIT_V(8); PG8_WAIT_L(0); PG8_BAR; PG8_MMA(0, 0, At, B0); PG8_MMA(0, 1, At, B1); PG8_BAR; PG8_SCHED;
            PG8_LDA(At, 1, 1); PG8_STAGE(PG8_SB(1, 0), b3, voffB); PG8_STAGE(PG8_SB(1, 1), b3 + hstep, voffB); PG8_STAGE_A(PG8_SA(1, 0), a3, 0);
            PG8_WAIT_V(8); PG8_WAIT_L(0); PG8_BAR; PG8_MMA(1, 0, At, B0); PG8_MMA(1, 1, At, B1); PG8_BAR; PG8_SCHED;
        }
        if (wr == 0) PG8_BAR;
        if constexpr (FP8) asm volatile("s_nop 15\n\ts_nop 15" ::: "memory");
        E(acc, cur, wr, wc, fr, fq);
        if (!has_next) break;
#pragma unroll
        for (int a = 0; a < 2; ++a)
#pragma unroll
            for (int b = 0; b < 2; ++b)
#pragma unroll
                for (int m = 0; m < 4; ++m)
#pragma unroll
                    for (int n = 0; n < 2; ++n) acc[a][b][m][n] = (f32x4){0.f, 0.f, 0.f, 0.f};
        cur = nxt; cA = nA; cB = nB; ++ui;
        if (wr == 1) PG8_BAR;
    }
    PG8_WAIT_V(0);
    PG8_BAR;
#undef PG8_SA
#undef PG8_SB
#undef PG8_STAGE
#undef PG8_STAGE_A
#undef PG8_GOFF
#undef PG8_LDA
#undef PG8_LDB
#undef PG8_MMA
#undef PG8_WAIT_V
#undef PG8_WAIT_L
#undef PG8_BAR
#undef PG8_SCHED
}
}

struct EpiInProj {
    bf16_t* O;
    __device__ __forceinline__ void operator()(const f32x4 (&acc)[2][2][4][2], const pg8::Unit& u, int wr, int wc, int fr, int fq) const {
        const int row0 = u.pm * 256 + wr * 64 + fr, col0 = u.pn * 256 + wc * 32 + 8 * fq;
        const float sc = (u.pn == 7 || u.pn == 8) ? QSCALE : 1.0f;
#pragma unroll
        for (int ai = 0; ai < 2; ++ai)
#pragma unroll
            for (int m = 0; m < 4; ++m) { bf16_t* rowp = O + (size_t)(row0 + ai * 128 + m * 16) * IC + col0;
#pragma unroll
                for (int bj = 0; bj < 2; ++bj) { const f32x4 v0 = acc[ai][bj][m][0] * sc, v1 = acc[ai][bj][m][1] * sc;
                    u32x4 w; w.x = cvtpk(v0[0], v0[1]); w.y = cvtpk(v0[2], v0[3]); w.z = cvtpk(v1[0], v1[1]); w.w = cvtpk(v1[2], v1[3]);
                    *(u32x4*)(rowp + bj * 128) = w; } }
    }
};
struct EpiOutProj {
    const float* x; const float* mod; float* O;
    __device__ __forceinline__ void operator()(const f32x4 (&acc)[2][2][4][2], const pg8::Unit& u, int wr, int wc, int fr, int fq) const {
        const int row0 = u.pm * 256 + wr * 64 + fr, col0 = u.pn * 256 + wc * 32 + 8 * fq;
        const int b = (u.pm * 256) / SEQ;
        const float* g1 = mod + b * 6144 + 2048;
        f32x4 gv[2][2];
#pragma unroll
        for (int bj = 0; bj < 2; ++bj)
#pragma unroll
            for (int n = 0; n < 2; ++n) gv[bj][n] = *(const f32x4*)(g1 + col0 + bj * 128 + 4 * n);
#pragma unroll
        for (int ai = 0; ai < 2; ++ai)
#pragma unroll
            for (int m = 0; m < 4; ++m) { const size_t off = (size_t)(row0 + ai * 128 + m * 16) * D + col0;
#pragma unroll
                for (int bj = 0; bj < 2; ++bj)
#pragma unroll
                    for (int n = 0; n < 2; ++n) { const f32x4 xv = *(const f32x4*)(x + off + bj * 128 + 4 * n);
                        *(f32x4*)(O + off + bj * 128 + 4 * n) = xv + gv[bj][n] * acc[ai][bj][m][n]; } }
    }
};
constexpr float Q_H2 = 8.0f, Q_W = 32.0f, Q_ACT = 4.0f;
__device__ __forceinline__ unsigned cvt4_fp8(float a, float b, float c, float d) { unsigned w = 0u; w = (unsigned)__builtin_amdgcn_cvt_pk_fp8_f32(a, b, (int)w, false); w = (unsigned)__builtin_amdgcn_cvt_pk_fp8_f32(c, d, (int)w, true); return w; }
struct EpiMoe1 {
    const float* bgu; unsigned char* O;
    __device__ __forceinline__ void operator()(const f32x4 (&acc)[2][2][4][2], const pg8::Unit& u, int wr, int wc, int fr, int fq) const {
        const int row0 = u.pm * 256 + wr * 64 + fr, col0 = u.pn * 128 + wc * 32 + 8 * fq;
        const float* bg = bgu + (size_t)u.e * 2048 + col0;
        constexpr float dq = 1.0f / (Q_H2 * Q_W);
        f32x4 bgv[2], buv[2];
#pragma unroll
        for (int n = 0; n < 2; ++n) { bgv[n] = *(const f32x4*)(bg + 4 * n); buv[n] = *(const f32x4*)(bg + 1024 + 4 * n); }
#pragma unroll
        for (int ai = 0; ai < 2; ++ai)
#pragma unroll
            for (int m = 0; m < 4; ++m) { float a[8];
#pragma unroll
                for (int n = 0; n < 2; ++n) { const f32x4 gt = acc[ai][0][m][n] * dq + bgv[n], up = acc[ai][1][m][n] * dq + buv[n];
#pragma unroll
                    for (int j = 0; j < 4; ++j) { const float gg = fminf(gt[j], 7.0f), uu = fminf(fmaxf(up[j], -7.0f), 7.0f);
                        a[4 * n + j] = Q_ACT * (uu + 1.0f) * (gg * __builtin_amdgcn_rcpf(1.0f + __builtin_amdgcn_exp2f(-1.702f * LOG2E * gg))); } }
                u32x2 w; w.x = cvt4_fp8(a[0], a[1], a[2], a[3]); w.y = cvt4_fp8(a[4], a[5], a[6], a[7]);
                *(u32x2*)(O + (size_t)(row0 + ai * 128 + m * 16) * 1024 + col0) = w; }
    }
};
struct EpiMoe2 {
    const float* bdn; bf16_t* O;
    __device__ __forceinline__ void operator()(const f32x4 (&acc)[2][2][4][2], const pg8::Unit& u, int wr, int wc, int fr, int fq) const {
        const int row0 = u.pm * 256 + wr * 64 + fr, col0 = u.pn * 256 + wc * 32 + 8 * fq;
        const float* bd = bdn + (size_t)u.e * 1024 + col0;
        constexpr float dq = 1.0f / (Q_ACT * Q_W);
        f32x4 bv[2][2];
#pragma unroll
        for (int bj = 0; bj < 2; ++bj)
#pragma unroll
            for (int n = 0; n < 2; ++n) bv[bj][n] = *(const f32x4*)(bd + bj * 128 + 4 * n);
#pragma unroll
        for (int ai = 0; ai < 2; ++ai)
#pragma unroll
            for (int m = 0; m < 4; ++m) { bf16_t* rowp = O + (size_t)(row0 + ai * 128 + m * 16) * 1024 + col0;
#pragma unroll
                for (int bj = 0; bj < 2; ++bj) { const f32x4 v0 = acc[ai][bj][m][0] * dq + bv[bj][0], v1 = acc[ai][bj][m][1] * dq + bv[bj][1];
                    u32x4 w; w.x = cvtpk(v0[0], v0[1]); w.y = cvtpk(v0[2], v0[3]); w.z = cvtpk(v1[0], v1[1]); w.w = cvtpk(v1[2], v1[3]);
                    *(u32x4*)(rowp + bj * 128) = w; } }
    }
};

__device__ __forceinline__ void phase_mod(const Params& p, unsigned char* lds, int G) {
    const int tid = opaque_tid(), lane = tid & 63, wave = tid >> 6;
    float* sc = (float*)lds;
    float* part = (float*)lds + 8192;
    const float* c = p.in[I_C];
    for (int i = tid; i < 8192; i += NTHREADS) { const int b = i & 7, k = i >> 3; const float cv = c[b * 1024 + k]; sc[k * 8 + b] = cv / (1.0f + __expf(-cv)); }
    __syncthreads();
    float* mod = (float*)(p.ws + WS_MOD);
    const float* mw = p.in[I_MODW]; const float* mb = p.in[I_MODB];
    for (int cg = (int)blockIdx.x; cg < 256; cg += G) {
        const int cc = lane & 31, kh = lane >> 5, k0 = wave * 128 + kh * 64, col = cg * 24 + (cc < 24 ? cc : 0);
        float acc[8];
#pragma unroll
        for (int b = 0; b < 8; ++b) acc[b] = 0.f;
        const float* wp = mw + (size_t)k0 * 6144 + col;
        const float* sp = sc + k0 * 8;
#pragma unroll 1
        for (int k = 0; k < 64; k += 16) { float wv[16];
#pragma unroll
            for (int u = 0; u < 16; ++u) wv[u] = wp[(size_t)(k + u) * 6144];
#pragma unroll
            for (int u = 0; u < 16; ++u) { const f32x4 s0 = *(const f32x4*)(sp + (k + u) * 8), s1 = *(const f32x4*)(sp + (k + u) * 8 + 4);
                acc[0] += s0[0] * wv[u]; acc[1] += s0[1] * wv[u]; acc[2] += s0[2] * wv[u]; acc[3] += s0[3] * wv[u]; acc[4] += s1[0] * wv[u]; acc[5] += s1[1] * wv[u]; acc[6] += s1[2] * wv[u]; acc[7] += s1[3] * wv[u]; } }
#pragma unroll
        for (int b = 0; b < 8; ++b) acc[b] += __shfl_xor(acc[b], 32);
        if (lane < 24) {
#pragma unroll
            for (int b = 0; b < 8; ++b) part[(wave * 24 + lane) * 8 + b] = acc[b]; }
        __syncthreads();
        if (tid < 192) { const int cl = tid >> 3, b = tid & 7; float sum = mb[cg * 24 + cl];
#pragma unroll
            for (int w = 0; w < 8; ++w) sum += part[(w * 24 + cl) * 8 + b];
            mod[b * 6144 + cg * 24 + cl] = sum; }
        __syncthreads();
    }
}
__device__ __forceinline__ void transpose_item(const float* W, int N, int k0, int n0, bf16_t* WT, int Kdst, int dst_row_base, bool gu_interleave, float* scr, int lane) {
#pragma unroll 4
    for (int i = 0; i < 16; ++i) { const int row = 4 * i + (lane >> 4), c4 = lane & 15;
        const f32x4 v = *(const f32x4*)(W + (size_t)(k0 + row) * N + n0 + 4 * c4);
        float* s = scr + row * 65 + 4 * c4; s[0] = v[0]; s[1] = v[1]; s[2] = v[2]; s[3] = v[3]; }
    asm volatile("s_waitcnt lgkmcnt(0)" ::: "memory");
    const int cch = lane & 7;
#pragma unroll
    for (int i = 0; i < 8; ++i) { const int n = 8 * i + (lane >> 3); const float* s = scr + (8 * cch) * 65 + n;
        u32x4 o; o.x = cvtpk(s[0], s[65]); o.y = cvtpk(s[2 * 65], s[3 * 65]); o.z = cvtpk(s[4 * 65], s[5 * 65]); o.w = cvtpk(s[6 * 65], s[7 * 65]);
        int nn = n0 + n;
        if (gu_interleave) nn = (nn < 1024) ? ((nn >> 7) * 256 + (nn & 127)) : (((nn - 1024) >> 7) * 256 + 128 + ((nn - 1024) & 127));
        *(u32x4*)(WT + (size_t)(dst_row_base + nn) * Kdst + k0 + 8 * cch) = o; }
    asm volatile("s_waitcnt lgkmcnt(0)" ::: "memory");
}
struct CvtItem { const float* src; unsigned char* dst; int N; };
__device__ __forceinline__ CvtItem cvt_item(const Params& p, int r, int lane) {
    CvtItem c; constexpr int I_GU = 32 * 512;
    const int nq = lane & 7, kq = lane >> 3;
    if (r < I_GU) { const int e = r >> 9, rr = r & 511, k0 = (rr >> 6) * 128, n0 = (rr & 63) * 32; c.N = 2048;
        c.src = p.in[I_WGU] + (size_t)e * 1024 * 2048 + (size_t)(k0 + kq) * 2048 + n0 + 4 * nq;
        const int nn = n0 + 4 * nq, nd = (nn < 1024) ? ((nn >> 7) * 256 + (nn & 127)) : (((nn - 1024) >> 7) * 256 + 128 + ((nn - 1024) & 127));
        c.dst = p.ws + WS_WG_T + ((size_t)(e * 2048 + nd)) * 1024 + k0 + 16 * kq; }
    else { const int q = r - I_GU, e = q >> 8, rr = q & 255, k0 = (rr >> 5) * 128, n0 = (rr & 31) * 32; c.N = 1024;
        c.src = p.in[I_WDN] + (size_t)e * 1024 * 1024 + (size_t)(k0 + kq) * 1024 + n0 + 4 * nq;
        c.dst = p.ws + WS_WD_T + ((size_t)(e * 1024 + n0 + 4 * nq)) * 1024 + k0 + 16 * kq; }
    return c;
}
__device__ __forceinline__ void phase_convert(const Params& p, unsigned char* lds, int G, int part) {
    const int tid = opaque_tid(), lane = tid & 63, wave = tid >> 6;
    float* scr = (float*)lds + wave * (64 * 65);
    const int gw = (int)blockIdx.x * NWAVES + wave, NGW = G * NWAVES;
    constexpr int I_IN = 16 * 52, I_OUT = 16 * 16, NF = 32 * 512 + 32 * 256;
    bf16_t* win_t = (bf16_t*)(p.ws + WS_WIN_T); bf16_t* wout_t = (bf16_t*)(p.ws + WS_WOUT_T);
    if (part == 0) {
    for (int it = gw; it < I_IN + I_OUT; it += NGW) {
        if (it < I_IN) transpose_item(p.in[I_WIN], IC, (it / 52) * 64, (it % 52) * 64, win_t, 1024, 0, false, scr, lane);
        else { const int r = it - I_IN; transpose_item(p.in[I_WOUT], D, (r / 16) * 64, (r % 16) * 64, wout_t, 1024, 0, false, scr, lane); }
    }
    return; }
    unsigned* sq = (unsigned*)scr;
    const int wr_off = (lane >> 3) * 9 + (lane & 7), rd_off = (16 * (lane >> 3)) * 9 + (lane & 7);
    int r = gw;
    if (r >= NF) return;
    CvtItem cur = cvt_item(p, r, lane);
    f32x4 v[16];
#pragma unroll
    for (int i = 0; i < 16; ++i) v[i] = *(const f32x4*)(cur.src + (size_t)(8 * i) * cur.N);
    for (;;) {
#pragma unroll
        for (int i = 0; i < 16; ++i) sq[wr_off + 8 * i * 9] = cvt4_fp8(Q_W * v[i][0], Q_W * v[i][1], Q_W * v[i][2], Q_W * v[i][3]);
        asm volatile("" ::: "memory");
        const int rn = r + NGW; const bool more = rn < NF;
        unsigned char* dst = cur.dst;
        if (more) { cur = cvt_item(p, rn, lane);
#pragma unroll
            for (int i = 0; i < 16; ++i) v[i] = *(const f32x4*)(cur.src + (size_t)(8 * i) * cur.N); }
        asm volatile("s_waitcnt lgkmcnt(0)" ::: "memory");
        unsigned d[16];
#pragma unroll
        for (int j = 0; j < 16; ++j) d[j] = sq[rd_off + j * 9];
        u32x4 o[4];
#pragma unroll
        for (int g = 0; g < 4; ++g) { const unsigned d0 = d[4 * g], d1 = d[4 * g + 1], d2 = d[4 * g + 2], d3 = d[4 * g + 3];
            const unsigned x = __builtin_amdgcn_perm(d1, d0, 0x05010400u), y = __builtin_amdgcn_perm(d1, d0, 0x07030602u), z = __builtin_amdgcn_perm(d3, d2, 0x05010400u), w = __builtin_amdgcn_perm(d3, d2, 0x07030602u);
            o[0][g] = __builtin_amdgcn_perm(z, x, 0x05040100u); o[1][g] = __builtin_amdgcn_perm(z, x, 0x07060302u); o[2][g] = __builtin_amdgcn_perm(w, y, 0x05040100u); o[3][g] = __builtin_amdgcn_perm(w, y, 0x07060302u); }
#pragma unroll
        for (int nn = 0; nn < 4; ++nn) *(u32x4*)(dst + (size_t)nn * 1024) = o[nn];
        asm volatile("" ::: "memory");
        if (!more) break;
        r = rn;
    }
}

__device__ __forceinline__ void phase_norm1(const Params& p, int G) {
    const int tid = opaque_tid(), lane = tid & 63, wave = tid >> 6;
    const int gw = (int)blockIdx.x * NWAVES + wave, NGW = G * NWAVES;
    const float* x = p.in[I_X]; const float* gain = p.in[I_N1G]; const float* mod = (const float*)(p.ws + WS_MOD);
    bf16_t* h = (bf16_t*)(p.ws + WS_H);
    for (int row = gw; row < T; row += NGW) {
        const int b = row / SEQ;
        const f32x4* xr = (const f32x4*)(x + (size_t)row * D) + lane;
        f32x4 v[4]; float s = 0.f;
#pragma unroll
        for (int j = 0; j < 4; ++j) { v[j] = xr[64 * j]; s += (v[j][0] * v[j][0] + v[j][1] * v[j][1]) + (v[j][2] * v[j][2] + v[j][3] * v[j][3]); }
        const float rstd = rsqrtf(wave_sum(s) * (1.0f / D) + NORM_EPS);
        const float* sh = mod + b * 6144; const float* scl = mod + b * 6144 + 1024;
        unsigned long long* o8 = (unsigned long long*)(h + (size_t)row * D) + lane;
#pragma unroll
        for (int j = 0; j < 4; ++j) { const int k = 4 * lane + 256 * j;
            const f32x4 g = *(const f32x4*)(gain + k), s1 = *(const f32x4*)(scl + k), s0 = *(const f32x4*)(sh + k);
            const f32x4 y = (v[j] * rstd) * g * (s1 + 1.0f) + s0;
            o8[64 * j] = (unsigned long long)cvtpk(y[0], y[1]) | ((unsigned long long)cvtpk(y[2], y[3]) << 32); }
    }
}

constexpr size_t CTL_KMAX = 57344;
__device__ __forceinline__ void kmax_pass(const Params& p, int G) {
    const int tid = opaque_tid(), lane = tid & 63, wave = tid >> 6;
    const bf16_t* proj = (const bf16_t*)(p.ws + WS_PROJ);
    unsigned* km = (unsigned*)(p.ws + WS_CTL + CTL_KMAX);
    const int TPB = T / G;
    float mx = 0.f; const int tok0 = (int)blockIdx.x * TPB;
    for (int ti = wave; ti < TPB; ti += NWAVES) {
        const u32x4 kv = *(const u32x4*)(proj + (size_t)(tok0 + ti) * IC + RC + 512 + 8 * lane);
        float ss = 0.f;
#pragma unroll
        for (int j = 0; j < 4; ++j) { const float a = __uint_as_float(kv[j] << 16), bq = __uint_as_float(kv[j] & 0xffff0000u); ss += a * a + bq * bq; }
        ss += __shfl_xor(ss, 1); ss += __shfl_xor(ss, 2); ss += __shfl_xor(ss, 4);
        mx = fmaxf(mx, ss);
    }
    if ((lane & 7) == 0) atomicMax(km + (tok0 / SEQ) * 8 + (lane >> 3), __float_as_uint(mx));
}

__device__ __forceinline__ s16x4 vtr(const LAS unsigned char* pp) { typedef short v4i16_t __attribute__((ext_vector_type(4))); return __builtin_bit_cast(s16x4, __builtin_amdgcn_ds_read_tr16_b64_v4i16((LAS v4i16_t*)pp)); }
constexpr int ATT_BUF = 32768;
__device__ __forceinline__ float att_max3(float a, float b, float c) { float r; asm("v_max3_f32 %0, %1, %2, %3" : "=v"(r) : "v"(a), "v"(b), "v"(c)); return r; }
constexpr int ATT_QROWS = 128, ATT_NQB = SEQ / ATT_QROWS, ATT_UNITS = NB * 4 * ATT_NQB;
__device__ __forceinline__ void attn_unit(const Params& p, LAS unsigned char* lds, int b, int h, int qb, float lam) {
    const int tid = opaque_tid(), lane = tid & 63, wid = __builtin_amdgcn_readfirstlane(tid >> 6), r32 = lane & 31, hi = lane >> 5;
    const int c = wid & 1, qblk = wid >> 1;
    const bf16_t* proj = (const bf16_t*)(p.ws + WS_PROJ) + (size_t)b * SEQ * IC;
    const int q0 = qb * ATT_QROWS, qw0 = q0 + 32 * qblk;
    const bf16_t* Qb = proj + RC + h * 128 + c * 64;
    const bf16_t* Kb = proj + RC + 512 + h * 128;
    const bf16_t* Vb = proj + RC + 1024 + h * 128;
    const float slope = exp2f(-2.0f * (float)(h + 1)) * LOG2E;
    f32x16 o[4];
#pragma unroll
    for (int d = 0; d < 4; ++d) o[d] = f32x16{};
    f32x16 cb0;
#pragma unroll
    for (int r = 0; r < 16; ++r) cb0[r] = slope * (float)((r & 3) + 8 * (r >> 2) + 4 * hi);
    const float c32 = slope * 32.0f;
    float m_ = 0.f, l_ = 0.f;
    const int NT = (q0 + ATT_QROWS) / 64;
    const bf16_t* ksrc = Kb + (size_t)lane * IC + wid * 8;
    const int p0i = wid, p1i = wid + 8;
    const bf16_t* vsrc0 = Vb + (size_t)(16 * (p0i & 3) + (lane >> 2)) * IC + (p0i >> 2) * 32 + (lane & 3) * 8;
    const bf16_t* vsrc1 = Vb + (size_t)(16 * (p1i & 3) + (lane >> 2)) * IC + (p1i >> 2) * 32 + (lane & 3) * 8;
#define ATT_GLDS(gsrc_, ldsdst_) do { unsigned keep_; asm volatile("s_mov_b32 %0, m0\n\ts_mov_b32 m0, %2\n\ts_nop 0\n\tglobal_load_lds_dwordx4 %1, off\n\ts_mov_b32 m0, %0" : "=&s"(keep_) : "v"(gsrc_), "s"(ldsdst_) : "memory"); } while (0)
    const unsigned lds0 = (unsigned)(uintptr_t)lds;
#define ATT_DMA(t, buf) do { const size_t ro = (size_t)(t) * 64 * IC; const unsigned bb_ = (unsigned)__builtin_amdgcn_readfirstlane((int)(lds0 + (buf) * ATT_BUF + wid * 1024)); \
        ATT_GLDS(ksrc + ro, bb_); ATT_GLDS(ksrc + ro + 64, bb_ + 8192u); ATT_GLDS(vsrc0 + ro, bb_ + 16384u); ATT_GLDS(vsrc1 + ro, bb_ + 16384u + 8192u); } while (0)
    ATT_DMA(NT - 1, 0); ATT_DMA(NT - 2, 1);
    bf16x8 qr[4];
#pragma unroll
    for (int d0 = 0; d0 < 4; ++d0) qr[d0] = *(const bf16x8*)(Qb + (size_t)(qw0 + r32) * IC + d0 * 16 + hi * 8);
    float qn;
    { float q2 = 0.f;
#pragma unroll
      for (int d0 = 0; d0 < 4; ++d0)
#pragma unroll
          for (int j = 0; j < 8; ++j) { const float x = bf2f((unsigned short)qr[d0][j]); q2 += x * x; }
      q2 += __shfl_xor(q2, 32);
      qn = sqrtf(q2 * ((const float*)(p.ws + WS_CTL + CTL_KMAX))[b * 8 + h * 2 + c]) * 1.002f + 0.01f; }
    asm volatile("" : "+v"(qr[0]), "+v"(qr[1]), "+v"(qr[2]), "+v"(qr[3]));
    asm volatile("s_waitcnt vmcnt(0)" ::: "memory");
    __builtin_amdgcn_s_barrier();
    const int voff = ((lane >> 4) & 1) * 32 + (lane & 3) * 8 + (4 * hi + ((lane & 15) >> 2)) * 64;
    const int qpos = qw0 + r32;
    const bool late = wid >= 4;
    bf16x8 pf[4]; bool pend = false;
    float mtrue = -INFINITY;
    LAS unsigned* vote = (LAS unsigned*)(lds + 4 * ATT_BUF + 64);
#define ATT_PV(slot_) do { const LAS unsigned char* vb_ = lds + (slot_) * ATT_BUF + 16384 + voff; \
        _Pragma("unroll") for (int dblk = 0; dblk < 4; ++dblk) { _Pragma("unroll") for (int ks = 0; ks < 4; ++ks) { \
            const s16x4 lo = vtr(vb_ + (dblk * 4 + ks) * 1024), hh = vtr(vb_ + (dblk * 4 + ks) * 1024 + 512); \
            const bf16x8 vf = (bf16x8){lo[0], lo[1], lo[2], lo[3], hh[0], hh[1], hh[2], hh[3]}; \
            o[dblk] = __builtin_amdgcn_mfma_f32_32x32x16_bf16(vf, pf[ks], o[dblk], 0, 0, 0); } } } while (0)
    int it = 0;
    for (; it < NT; ++it) {
        const int kt = NT - 1 - it, cur = it & 3;
        const bool issued = (it + 2 < NT);
        if (issued) ATT_DMA(kt - 2, (it + 2) & 3);
        const int k0 = kt * 64;
        if (late && pend) { ATT_PV((it - 1) & 3); pend = false; }
        if (k0 <= qw0 + 31) {
            const LAS unsigned char* bb = lds + cur * ATT_BUF;
            const bool need_mask = (k0 + 63 > qw0);
            const LAS unsigned char* kb = bb + c * 8192 + hi * 1024 + r32 * 16;
            f32x16 s0 = cb0, s1 = cb0;
#pragma unroll
            for (int d0 = 0; d0 < 4; ++d0) {
                const bf16x8 a0 = *(const LAS bf16x8*)(kb + d0 * 2048), a1 = *(const LAS bf16x8*)(kb + d0 * 2048 + 512);
                s0 = __builtin_amdgcn_mfma_f32_32x32x16_bf16(a0, qr[d0], s0, 0, 0, 0);
                s1 = __builtin_amdgcn_mfma_f32_32x32x16_bf16(a1, qr[d0], s1, 0, 0, 0);
            }
            if (need_mask) {
                const int dq = k0 - qpos + 4 * hi;
#pragma unroll
                for (int r = 0; r < 16; ++r) { if (dq + ((r & 3) + 8 * (r >> 2)) > 0) s0[r] = -INFINITY; if (dq + ((r & 3) + 8 * (r >> 2)) + 32 > 0) s1[r] = -INFINITY; }
            }
            const float tb = slope * (float)(k0 - qpos);
            float rm0 = att_max3(s0[0], s0[1], s0[2]), rm1 = att_max3(s1[0], s1[1], s1[2]);
#pragma unroll
            for (int r = 3; r < 15; r += 2) { rm0 = att_max3(rm0, s0[r], s0[r + 1]); rm1 = att_max3(rm1, s1[r], s1[r + 1]); }
            float rm = att_max3(rm0, s0[15], att_max3(rm1, s1[15], -INFINITY) + c32);
            rm += tb;
            rm = fmaxf(rm, __shfl_xor(rm, 32));
            mtrue = fmaxf(mtrue, rm);
            if (__any(rm > m_ + 8.0f)) {
                const float mn = fmaxf(m_, rm);
                const float alpha = __builtin_amdgcn_exp2f(m_ - mn);
                m_ = mn; l_ *= alpha;
#pragma unroll
                for (int d = 0; d < 4; ++d)
#pragma unroll
                    for (int r = 0; r < 16; ++r) o[d][r] *= alpha;
            }
            const float off = tb - m_, off1 = off + c32;
            float ps = 0.f;
#pragma unroll
            for (int r = 0; r < 16; ++r) { s0[r] = __builtin_amdgcn_exp2f(s0[r] + off); s1[r] = __builtin_amdgcn_exp2f(s1[r] + off1); ps += s0[r] + s1[r]; }
            l_ += ps;
#pragma unroll
            for (int ks = 0; ks < 2; ++ks) {
                u32x4 w0, w1;
                w0.x = cvtpk(s0[8 * ks + 0], s0[8 * ks + 1]); w0.y = cvtpk(s0[8 * ks + 2], s0[8 * ks + 3]); w0.z = cvtpk(s0[8 * ks + 4], s0[8 * ks + 5]); w0.w = cvtpk(s0[8 * ks + 6], s0[8 * ks + 7]);
                w1.x = cvtpk(s1[8 * ks + 0], s1[8 * ks + 1]); w1.y = cvtpk(s1[8 * ks + 2], s1[8 * ks + 3]); w1.z = cvtpk(s1[8 * ks + 4], s1[8 * ks + 5]); w1.w = cvtpk(s1[8 * ks + 6], s1[8 * ks + 7]);
                pf[ks] = __builtin_bit_cast(bf16x8, w0); pf[2 + ks] = __builtin_bit_cast(bf16x8, w1);
            }
            if (late) pend = true; else ATT_PV(cur);
        }
        { const bool neg = (qn + slope * (float)(k0 - 1 - qpos) <= mtrue - 50.0f);
          if (lane == 0) vote[(it & 1) * 8 + wid] = __all(neg) ? 1u : 0u; }
        if (issued) asm volatile("s_waitcnt vmcnt(4)" ::: "memory"); else asm volatile("s_waitcnt vmcnt(0)" ::: "memory");
        asm volatile("s_waitcnt lgkmcnt(0)" ::: "memory");
        __builtin_amdgcn_s_barrier();
        { const u32x4 va = *(const LAS u32x4*)(vote + (it & 1) * 8), vb2 = *(const LAS u32x4*)(vote + (it & 1) * 8 + 4);
          if ((va.x & va.y & va.z & va.w & vb2.x & vb2.y & vb2.z & vb2.w) != 0u) { ++it; break; } }
    }
    if (late && pend) ATT_PV((it - 1) & 3);
    asm volatile("s_waitcnt vmcnt(0) lgkmcnt(0)" ::: "memory");
    __builtin_amdgcn_s_barrier();
#undef ATT_PV
#undef ATT_DMA
#undef ATT_GLDS
    l_ += __shfl_xor(l_, 32);
    LAS float* xb = (LAS float*)(lds + qblk * 16384);
    if (c == 1) {
        const float i1 = lam / l_;
#pragma unroll
        for (int d = 0; d < 4; ++d)
#pragma unroll
            for (int r = 0; r < 16; ++r) xb[(d * 16 + r) * 64 + lane] = o[d][r] * i1;
    }
    __syncthreads();
    if (c == 0) {
        const float i0 = 1.0f / l_;
        float ss = 0.f;
#pragma unroll
        for (int d = 0; d < 4; ++d)
#pragma unroll
            for (int r = 0; r < 16; ++r) { const float v = o[d][r] * i0 - xb[(d * 16 + r) * 64 + lane]; o[d][r] = v; ss += v * v; }
        ss += __shfl_xor(ss, 32);
        const float rstd = rsqrtf(ss * (1.0f / 128.0f) + NORM_EPS) * (1.0f - LAMBDA_INIT);
        const float* sg = p.in[I_SUBLN];
        bf16_t* yo = (bf16_t*)(p.ws + WS_YMIX) + (size_t)(b * SEQ + qw0 + r32) * D + RW + h * 128;
#pragma unroll
        for (int d = 0; d < 4; ++d)
#pragma unroll
            for (int g = 0; g < 4; ++g) { const int dd = 32 * d + 8 * g + 4 * hi; const f32x4 gv = *(const f32x4*)(sg + dd);
                u32x2 w; w.x = cvtpk(o[d][4 * g] * rstd * gv[0], o[d][4 * g + 1] * rstd * gv[1]); w.y = cvtpk(o[d][4 * g + 2] * rstd * gv[2], o[d][4 * g + 3] * rstd * gv[3]);
                *(u32x2*)(yo + dd) = w; }
    }
    __syncthreads();
}

constexpr int RCH = 32;
constexpr int RK_R = 0, RK_KM = 8192, RK_DEC = 16384, RK_KK = 24576, RK_BB = 32768, RK_VV = 40960, RK_GG = 49152;
constexpr int RK_AW = 57344;
constexpr int RK_AA = RK_AW + 4608;
constexpr int RK_AG = RK_AA + 4608;
constexpr int RK_BON = RK_AG + 8704;
constexpr int RK_MU = RK_BON + 128;
constexpr int RK_RAW = 77824;
constexpr int RK_IM = RK_RAW + 33 * 1024;
constexpr int RK_LSEG = RK_IM + OPREC;
constexpr int RK_END = RK_LSEG + 2048;
static_assert(RK_MU + 1792 <= RK_RAW && RK_END <= LDS_BYTES - 64 && (RK_RAW % 1024) == 0, "rwkv prep LDS map");
template <int CTRL> __device__ __forceinline__ float dpp_add(float v) { return v + __builtin_bit_cast(float, __builtin_amdgcn_update_dpp(0, __builtin_bit_cast(int, v), CTRL, 0xf, 0xf, true)); }
__device__ __forceinline__ float red16(float v) {
    v = dpp_add<0xB1>(v);
    v = dpp_add<0x4E>(v);
    v = dpp_add<0x141>(v);
    v = dpp_add<0x140>(v);
    return v;
}
__device__ __forceinline__ int rk_piece_col(int pc, int h) {
    return pc < 8 ? h * 64 + 8 * pc : (pc < 16 ? 512 + h * 64 + 8 * (pc - 8) : (pc < 24 ? 1024 + h * 64 + 8 * (pc - 16) : 1536 + 8 * (pc - 24)));
}
#define RK_BAR() do { asm volatile("s_waitcnt lgkmcnt(0)" ::: "memory"); __builtin_amdgcn_s_barrier(); asm volatile("" ::: "memory"); } while (0)
__device__ __forceinline__ void rwkv_prep(const Params& p, LAS unsigned char* lds, int b, int h, int ch0, int ch1) {
    const int tid = opaque_tid(), lane = tid & 63, wid = __builtin_amdgcn_readfirstlane(tid >> 6);
    const bf16_t* proj = (const bf16_t*)(p.ws + WS_PROJ) + (size_t)b * SEQ * IC;
    LAS float* R_ = (LAS float*)(lds + RK_R); LAS float* KM_ = (LAS float*)(lds + RK_KM); LAS float* DEC_ = (LAS float*)(lds + RK_DEC); LAS float* KK_ = (LAS float*)(lds + RK_KK);
    LAS float* BB_ = (LAS float*)(lds + RK_BB); LAS float* VV_ = (LAS float*)(lds + RK_VV); LAS float* GG_ = (LAS float*)(lds + RK_GG); LAS float* BON_ = (LAS float*)(lds + RK_BON);
    LAS float* MU_ = (LAS float*)(lds + RK_MU);
    const int dpc = lane < 56 ? lane : 55;
    const bf16_t* dsrc = proj + rk_piece_col(dpc, h);
#define RK_DMA(t0_) do { for (int rho = wid; rho < 33; rho += NWAVES) { int tok = (t0_) - 1 + rho; tok = tok < 0 ? 0 : tok; \
        __builtin_amdgcn_global_load_lds((const unsigned*)(dsrc + (size_t)tok * IC), (LAS unsigned*)(lds + RK_RAW + rho * 1024), 16, 0, 0); } } while (0)
    RK_DMA(ch0 * RCH);
    if (tid < 448) MU_[tid] = p.in[I_MU][rk_piece_col(tid >> 3, h) + (tid & 7)];
    const int ntile = wid & 3, ttile = wid >> 2, fn = lane & 15, fk = lane >> 4;
    const int ncol = h * 64 + ntile * 16 + fn;
    bf16x8 bw[2], ba[2], bg[4];
    {
        const float* wup = p.in[I_WUP]; const float* aup = p.in[I_AUP]; const float* gup = p.in[I_GUP];
#pragma unroll
        for (int ks = 0; ks < 2; ++ks) { float t[8], u[8];
#pragma unroll
            for (int j = 0; j < 8; ++j) { const int k = 32 * ks + 8 * fk + j; t[j] = wup[k * RW + ncol]; u[j] = aup[k * RW + ncol]; }
            u32x4 a, c; a.x = cvtpk(t[0], t[1]); a.y = cvtpk(t[2], t[3]); a.z = cvtpk(t[4], t[5]); a.w = cvtpk(t[6], t[7]);
            c.x = cvtpk(u[0], u[1]); c.y = cvtpk(u[2], u[3]); c.z = cvtpk(u[4], u[5]); c.w = cvtpk(u[6], u[7]);
            bw[ks] = __builtin_bit_cast(bf16x8, a); ba[ks] = __builtin_bit_cast(bf16x8, c); }
#pragma unroll
        for (int ks = 0; ks < 4; ++ks) { float t[8];
#pragma unroll
            for (int j = 0; j < 8; ++j) { const int k = 32 * ks + 8 * fk + j; t[j] = gup[k * RW + ncol]; }
            u32x4 a; a.x = cvtpk(t[0], t[1]); a.y = cvtpk(t[2], t[3]); a.z = cvtpk(t[4], t[5]); a.w = cvtpk(t[6], t[7]);
            bg[ks] = __builtin_bit_cast(bf16x8, a); }
    }
    const float w0n = p.in[I_W0][ncol], a0n = p.in[I_A0][ncol];
    const int q16 = tid & 15, tk16 = tid >> 4;
    const f32x4 kkc = *(const f32x4*)(p.in[I_KK] + h * 64 + 4 * q16), kac = *(const f32x4*)(p.in[I_KA] + h * 64 + 4 * q16), rkc = *(const f32x4*)(p.in[I_RK] + h * 64 + 4 * q16);
    const size_t hb = (size_t)(b * 8 + h) * SEQ * 64;
    float* gVS = (float*)(p.ws + WS_VS) + hb; float* gGG = p.out + (size_t)16 * 1024 * 1024 + hb; float* gBON = (float*)(p.ws + WS_BON) + (size_t)(b * 8 + h) * SEQ;
    unsigned char* gOPS = p.ws + WS_OPS + (size_t)(b * 8 + h) * (SEQ / RCH) * OPREC;
    for (int ch = ch0; ch < ch1; ++ch) {
        const int t0 = ch * RCH;
        if (ch > ch0) { if (wid == 0) asm volatile("s_waitcnt vmcnt(8)" ::: "memory"); else if (wid == 1) asm volatile("s_waitcnt vmcnt(7)" ::: "memory"); else asm volatile("s_waitcnt vmcnt(6)" ::: "memory"); } else asm volatile("s_waitcnt vmcnt(0)" ::: "memory");
        RK_BAR();
#pragma unroll
        for (int it = 0; it < 4; ++it) { const int item = tid + it * NTHREADS;
            if (item < RCH * 56) { const int tk = item / 56, pc = item - tk * 56;
                const u32x4 cv = *(const LAS u32x4*)(lds + RK_RAW + (tk + 1) * 1024 + pc * 16);
                u32x4 pv = *(const LAS u32x4*)(lds + RK_RAW + tk * 1024 + pc * 16);
                if (t0 + tk == 0) pv = (u32x4){0u, 0u, 0u, 0u};
                const f32x4 m0 = *(const LAS f32x4*)(MU_ + pc * 8), m1 = *(const LAS f32x4*)(MU_ + pc * 8 + 4);
                float xv[8];
#pragma unroll
                for (int j = 0; j < 4; ++j) { const unsigned cw = cv[j], pw = pv[j];
                    const float c0 = __uint_as_float(cw << 16), c1 = __uint_as_float(cw & 0xffff0000u), p0 = __uint_as_float(pw << 16), p1 = __uint_as_float(pw & 0xffff0000u);
                    const float ma = (j < 2) ? m0[2 * j] : m1[2 * j - 4], mb = (j < 2) ? m0[2 * j + 1] : m1[2 * j - 3];
                    xv[2 * j] = c0 + ma * (p0 - c0); xv[2 * j + 1] = c1 + mb * (p1 - c1); }
                const int seg = pc >> 3, pi = pc & 7;
                if (seg <= 2) { LAS float* dst = (seg == 0 ? R_ : (seg == 1 ? KM_ : VV_)) + tk * 64 + 8 * pi;
                    *(LAS f32x4*)dst = (f32x4){xv[0], xv[1], xv[2], xv[3]}; *(LAS f32x4*)(dst + 4) = (f32x4){xv[4], xv[5], xv[6], xv[7]}; }
                else if (seg == 3) { u32x4 w; w.x = cvtpk(tanh_fast(xv[0]), tanh_fast(xv[1])); w.y = cvtpk(tanh_fast(xv[2]), tanh_fast(xv[3])); w.z = cvtpk(tanh_fast(xv[4]), tanh_fast(xv[5])); w.w = cvtpk(tanh_fast(xv[6]), tanh_fast(xv[7]));
                    *(LAS u32x4*)(lds + RK_AW + tk * 144 + 16 * pi) = w; }
                else if (seg == 4) { u32x4 w; w.x = cvtpk(xv[0], xv[1]); w.y = cvtpk(xv[2], xv[3]); w.z = cvtpk(xv[4], xv[5]); w.w = cvtpk(xv[6], xv[7]);
                    *(LAS u32x4*)(lds + RK_AA + tk * 144 + 16 * pi) = w; }
                else { u32x4 w; w.x = cvtpk(sigmoidf_(xv[0]), sigmoidf_(xv[1])); w.y = cvtpk(sigmoidf_(xv[2]), sigmoidf_(xv[3])); w.z = cvtpk(sigmoidf_(xv[4]), sigmoidf_(xv[5])); w.w = cvtpk(sigmoidf_(xv[6]), sigmoidf_(xv[7]));
                    *(LAS u32x4*)(lds + RK_AG + tk * 272 + (pc - 40) * 16) = w; }
            } }
        __syncthreads();
        if (ch + 1 < ch1) RK_DMA(t0 + RCH);
        {
            f32x4 cw = (f32x4){0.f, 0.f, 0.f, 0.f}, ca = cw, cg2 = cw;
            const int tok = ttile * 16 + fn;
#pragma unroll
            for (int ks = 0; ks < 2; ++ks) {
                const bf16x8 aw = *(const LAS bf16x8*)(lds + RK_AW + tok * 144 + (32 * ks + 8 * fk) * 2);
                const bf16x8 aa = *(const LAS bf16x8*)(lds + RK_AA + tok * 144 + (32 * ks + 8 * fk) * 2);
                cw = __builtin_amdgcn_mfma_f32_16x16x32_bf16(aw, bw[ks], cw, 0, 0, 0);
                ca = __builtin_amdgcn_mfma_f32_16x16x32_bf16(aa, ba[ks], ca, 0, 0, 0);
            }
#pragma unroll
            for (int ks = 0; ks < 4; ++ks) {
                const bf16x8 ag = *(const LAS bf16x8*)(lds + RK_AG + tok * 272 + (32 * ks + 8 * fk) * 2);
                cg2 = __builtin_amdgcn_mfma_f32_16x16x32_bf16(ag, bg[ks], cg2, 0, 0, 0);
            }
#pragma unroll
            for (int r = 0; r < 4; ++r) { const int tk = ttile * 16 + 4 * fk + r, n = ntile * 16 + fn;
                DEC_[tk * 64 + n] = -0.6065306597126334f * sigmoidf_(cw[r] + w0n);
                BB_[tk * 64 + n] = sigmoidf_(ca[r] + a0n);
                GG_[tk * 64 + n] = cg2[r]; }
        }
        RK_BAR();
        {
            const f32x4 kp = *(const LAS f32x4*)(KM_ + tk16 * 64 + 4 * q16), av = *(const LAS f32x4*)(BB_ + tk16 * 64 + 4 * q16), rr = *(const LAS f32x4*)(R_ + tk16 * 64 + 4 * q16);
            const f32x4 kkv = kp * kkc;
            const float nrm2 = red16((kkv[0] * kkv[0] + kkv[1] * kkv[1]) + (kkv[2] * kkv[2] + kkv[3] * kkv[3]));
            const f32x4 kkn = kkv * __builtin_amdgcn_rsqf(fmaxf(nrm2, 1e-24f));
            const f32x4 kmod = kp * ((av - 1.0f) * kac + 1.0f);
            const f32x4 t = rr * kmod * rkc;
            const float bs = red16((t[0] + t[1]) + (t[2] + t[3]));
            *(LAS f32x4*)(KK_ + tk16 * 64 + 4 * q16) = kkn; *(LAS f32x4*)(BB_ + tk16 * 64 + 4 * q16) = kkn * av; *(LAS f32x4*)(KM_ + tk16 * 64 + 4 * q16) = kmod;
            if (q16 == 0) BON_[tk16] = bs;
        }
        RK_BAR();
        {
            const int d1 = tid & 63, q1 = wid;
            float lw[4], cs[4];
#pragma unroll
            for (int e = 0; e < 4; ++e) lw[e] = DEC_[(4 * q1 + e) * 64 + d1];
            cs[0] = lw[0]; cs[1] = cs[0] + lw[1]; cs[2] = cs[1] + lw[2]; cs[3] = cs[2] + lw[3];
            ((LAS float*)(lds + RK_LSEG))[q1 * 64 + d1] = cs[3];
            { const float x0 = VV_[(4 * q1) * 64 + d1], x1 = VV_[(4 * q1 + 1) * 64 + d1], x2 = VV_[(4 * q1 + 2) * 64 + d1], x3 = VV_[(4 * q1 + 3) * 64 + d1];
              u32x2 w; w.x = cvtpk(x0, x1); w.y = cvtpk(x2, x3); *(LAS u32x2*)(lds + RK_IM + OP_VT + d1 * 80 + q1 * 8) = w; }
            RK_BAR();
            float off = 0.f, tot = 0.f;
#pragma unroll
            for (int qq = 0; qq < 8; ++qq) { const float sg = ((const LAS float*)(lds + RK_LSEG))[qq * 64 + d1]; tot += sg; if (qq < q1) off += sg; }
            const float etot = __expf(tot);
            float ePprev = __expf(off);
            float bc[4], kc4[4];
#pragma unroll
            for (int e = 0; e < 4; ++e) { const int tk = 4 * q1 + e;
                const float eP = __expf(off + cs[e]), eN = __builtin_amdgcn_rcpf(eP), eE = etot * eN;
                const float kap = KK_[tk * 64 + d1], bet = BB_[tk * 64 + d1], kk_ = KM_[tk * 64 + d1], rr = R_[tk * 64 + d1];
                const unsigned w0 = cvtpk(-kap * ePprev, rr * eP), w1 = cvtpk(bet * eN, kk_ * eN);
                *(LAS unsigned short*)(lds + RK_IM + OP_AT + tk * 144 + d1 * 2) = (unsigned short)(w0 & 0xffffu); *(LAS unsigned short*)(lds + RK_IM + OP_RT + tk * 144 + d1 * 2) = (unsigned short)(w0 >> 16);
                *(LAS unsigned short*)(lds + RK_IM + OP_BH + tk * 144 + d1 * 2) = (unsigned short)(w1 & 0xffffu); *(LAS unsigned short*)(lds + RK_IM + OP_KH + tk * 144 + d1 * 2) = (unsigned short)(w1 >> 16);
                bc[e] = bet * eE; kc4[e] = kk_ * eE; ePprev = eP; }
            u32x2 wb, wk; wb.x = cvtpk(bc[0], bc[1]); wb.y = cvtpk(bc[2], bc[3]); wk.x = cvtpk(kc4[0], kc4[1]); wk.y = cvtpk(kc4[2], kc4[3]);
            *(LAS u32x2*)(lds + RK_IM + OP_BCT + d1 * 80 + q1 * 8) = wb; *(LAS u32x2*)(lds + RK_IM + OP_KCT + d1 * 80 + q1 * 8) = wk;
            if (q1 == 0) ((LAS float*)(lds + RK_IM + OP_P31))[d1] = etot;
        }
        RK_BAR();
        {
            unsigned char* rec = gOPS + (size_t)ch * OPREC;
#pragma unroll
            for (int i = 0; i < 5; ++i) { const int o = (tid + i * NTHREADS) * 16; if (o < OPREC) *(u32x4*)(rec + o) = *(const LAS u32x4*)(lds + RK_IM + o); }
            const size_t go = (size_t)t0 * 64 + tid * 4;
            *(f32x4*)(gVS + go) = *(const LAS f32x4*)(VV_ + tid * 4);
            *(f32x4*)(gGG + go) = *(const LAS f32x4*)(GG_ + tid * 4);
            if (tid < RCH) gBON[t0 + tid] = BON_[tid];
        }
    }
    asm volatile("s_waitcnt vmcnt(0)" ::: "memory");
    __syncthreads();
#undef RK_DMA
}

constexpr int CS_IN = 32768;
constexpr int CS_OP = 2 * CS_IN;
constexpr int CS_AT = 0, CS_RT = 4608, CS_BH = 9216, CS_KH = 13824, CS_BCT = 18432, CS_KCT = 23552, CS_VT = 28672, CS_P31 = 31744;
constexpr int CS_MT2 = CS_OP, CS_MT3 = CS_OP + 2560, CS_MT4 = CS_OP + 5120;
constexpr int CS_M1F = CS_OP + 7680;
constexpr int CS_XF = CS_OP + 12288;
constexpr int CS_UB = CS_OP + 16896;
constexpr int CS_SB = CS_OP + 19456;
constexpr int CS_YY = CS_OP + 24064;
constexpr int CS_END = CS_OP + 28160;
static_assert(CS_END <= LDS_BYTES - 64, "rwkv scan LDS map");
__device__ __forceinline__ int crow32(int r, int hi) { return (r & 3) + 8 * (r >> 2) + 4 * hi; }
__device__ __forceinline__ void rwkv_scan(const Params& p, LAS unsigned char* lds, int b, int h, int half) {
    const int tid = opaque_tid(), lane = tid & 63, wid = __builtin_amdgcn_readfirstlane(tid >> 6), r32 = lane & 31, hi = lane >> 5;
    const unsigned char* gOPS = p.ws + WS_OPS + (size_t)(b * 8 + h) * (SEQ / RCH) * OPREC;
    float* yraw = p.out + (size_t)b * SEQ * RW + h * 64 + half * 32;
#define RS_DMA(ch_, buf) do { LAS unsigned char* bb_ = lds + (buf) * CS_IN; const unsigned char* rec_ = gOPS + (size_t)(ch_) * OPREC; \
        for (int pc = wid; pc < 32; pc += NWAVES) { \
            const unsigned char* src_ = rec_ + (pc < 28 ? pc * 1024 : (pc < 31 ? OP_VT + half * 2560 + (pc - 28) * 1024 : OP_P31)) + lane * 16; \
            __builtin_amdgcn_global_load_lds((const unsigned*)src_, (LAS unsigned*)(bb_ + pc * 1024), 16, 0, 0); } } while (0)
    RS_DMA(0, 0);
    for (int i = tid; i < 4608 / 4; i += NTHREADS) ((LAS unsigned*)(lds + CS_SB))[i] = 0u;
    f32x16 Sacc = f32x16{};
    f32x16 Xacc = f32x16{};
    for (int ch = 0; ch < SEQ / RCH; ++ch) {
        const int t0 = ch * RCH, cur = ch & 1;
        if (wid < 4 && ch > 0) asm volatile("s_waitcnt vmcnt(1)" ::: "memory"); else asm volatile("s_waitcnt vmcnt(0)" ::: "memory");
        RK_BAR();
        if (ch + 1 < SEQ / RCH) RS_DMA(ch + 1, cur ^ 1);
        const LAS unsigned char* ib = lds + cur * CS_IN;
        if (wid < 4) {
            const LAS unsigned char* Am = ib + ((wid & 1) ? CS_KH : CS_BH) + r32 * 144 + hi * 16;
            const LAS unsigned char* Bm = ib + ((wid & 2) ? CS_RT : CS_AT) + r32 * 144 + hi * 16;
            f32x16 acc = f32x16{};
#pragma unroll
            for (int ks = 0; ks < 4; ++ks) acc = __builtin_amdgcn_mfma_f32_32x32x16_bf16(*(const LAS bf16x8*)(Am + ks * 32), *(const LAS bf16x8*)(Bm + ks * 32), acc, 0, 0, 0);
            const int lim = (wid < 2) ? r32 : r32 + 1;
#pragma unroll
            for (int rg = 0; rg < 16; ++rg) if (crow32(rg, hi) >= lim) acc[rg] = 0.f;
            if (wid == 0) {
#pragma unroll
                for (int rg = 0; rg < 16; ++rg) ((LAS float*)(lds + CS_M1F))[crow32(rg, hi) * 36 + r32] = acc[rg];
            } else {
                LAS unsigned char* Mt = lds + (wid == 1 ? CS_MT2 : (wid == 2 ? CS_MT3 : CS_MT4)) + r32 * 80 + hi * 8;
#pragma unroll
                for (int g = 0; g < 4; ++g) { u32x2 w; w.x = cvtpk(acc[4 * g], acc[4 * g + 1]); w.y = cvtpk(acc[4 * g + 2], acc[4 * g + 3]); *(LAS u32x2*)(Mt + g * 16) = w; }
            }
        } else if (wid < 6) {
            const LAS unsigned char* Am = ib + (wid == 4 ? CS_AT : CS_RT) + r32 * 144 + hi * 16;
            const LAS unsigned char* Bm = lds + CS_SB + r32 * 144 + hi * 16;
            Xacc = f32x16{};
#pragma unroll
            for (int ks = 0; ks < 4; ++ks) Xacc = __builtin_amdgcn_mfma_f32_32x32x16_bf16(*(const LAS bf16x8*)(Am + ks * 32), *(const LAS bf16x8*)(Bm + ks * 32), Xacc, 0, 0, 0);
        }
        RK_BAR();
        if (wid == 4) {
            const LAS unsigned char* Am = lds + CS_MT2 + r32 * 80 + hi * 16;
            const LAS unsigned char* Bm = ib + CS_VT + r32 * 80 + hi * 16;
#pragma unroll
            for (int ks = 0; ks < 2; ++ks) Xacc = __builtin_amdgcn_mfma_f32_32x32x16_bf16(*(const LAS bf16x8*)(Am + ks * 32), *(const LAS bf16x8*)(Bm + ks * 32), Xacc, 0, 0, 0);
#pragma unroll
            for (int g = 0; g < 4; ++g) *(LAS f32x4*)(lds + CS_XF + r32 * 144 + (8 * g + 4 * hi) * 4) = (f32x4){Xacc[4 * g], Xacc[4 * g + 1], Xacc[4 * g + 2], Xacc[4 * g + 3]};
        }
        RK_BAR();
        {
            const int v = tid >> 4, l = tid & 15;
            float m0[32], m1[32];
#pragma unroll
            for (int c4 = 0; c4 < 8; ++c4) { const f32x4 a = *(const LAS f32x4*)(lds + CS_M1F + l * 144 + c4 * 16), c = *(const LAS f32x4*)(lds + CS_M1F + (l + 16) * 144 + c4 * 16);
                m0[4 * c4] = a[0]; m0[4 * c4 + 1] = a[1]; m0[4 * c4 + 2] = a[2]; m0[4 * c4 + 3] = a[3]; m1[4 * c4] = c[0]; m1[4 * c4 + 1] = c[1]; m1[4 * c4 + 2] = c[2]; m1[4 * c4 + 3] = c[3]; }
            const float x0 = ((const LAS float*)(lds + CS_XF))[v * 36 + l], x1 = ((const LAS float*)(lds + CS_XF))[v * 36 + l + 16];
            float u0 = 0.f, u1 = 0.f;
#pragma unroll
            for (int i = 0; i < 32; ++i) {
                const float part = (i < 16) ? u0 * m0[i] : (u0 * m0[i] + u1 * m1[i]);
                const float tot = red16(part);
                if (i < 16) u0 = (l == i) ? x0 + tot : u0; else u1 = (l == i - 16) ? x1 + tot : u1;
            }
            const unsigned w = cvtpk(u0, u1);
            *(LAS unsigned short*)(lds + CS_UB + v * 80 + l * 2) = (unsigned short)(w & 0xffffu); *(LAS unsigned short*)(lds + CS_UB + v * 80 + (l + 16) * 2) = (unsigned short)(w >> 16);
        }
        RK_BAR();
        if (wid == 5) {
            const LAS unsigned char* A3 = lds + CS_MT3 + r32 * 80 + hi * 16; const LAS unsigned char* A4 = lds + CS_MT4 + r32 * 80 + hi * 16;
            const LAS unsigned char* Bu = lds + CS_UB + r32 * 80 + hi * 16; const LAS unsigned char* Bv = ib + CS_VT + r32 * 80 + hi * 16;
#pragma unroll
            for (int ks = 0; ks < 2; ++ks) { Xacc = __builtin_amdgcn_mfma_f32_32x32x16_bf16(*(const LAS bf16x8*)(A3 + ks * 32), *(const LAS bf16x8*)(Bu + ks * 32), Xacc, 0, 0, 0);
                Xacc = __builtin_amdgcn_mfma_f32_32x32x16_bf16(*(const LAS bf16x8*)(A4 + ks * 32), *(const LAS bf16x8*)(Bv + ks * 32), Xacc, 0, 0, 0); }
#pragma unroll
            for (int rg = 0; rg < 16; ++rg) ((LAS float*)(lds + CS_YY))[crow32(rg, hi) * 32 + r32] = Xacc[rg];
        } else if (wid < 2) {
#pragma unroll
            for (int g = 0; g < 4; ++g) { const f32x4 pv = *(const LAS f32x4*)(ib + CS_P31 + (32 * wid + 8 * g + 4 * hi) * 4);
                Sacc[4 * g] *= pv[0]; Sacc[4 * g + 1] *= pv[1]; Sacc[4 * g + 2] *= pv[2]; Sacc[4 * g + 3] *= pv[3]; }
            const LAS unsigned char* Ab = ib + CS_BCT + (32 * wid + r32) * 80 + hi * 16; const LAS unsigned char* Ak = ib + CS_KCT + (32 * wid + r32) * 80 + hi * 16;
            const LAS unsigned char* Bu = lds + CS_UB + r32 * 80 + hi * 16; const LAS unsigned char* Bv = ib + CS_VT + r32 * 80 + hi * 16;
#pragma unroll
            for (int ks = 0; ks < 2; ++ks) { Sacc = __builtin_amdgcn_mfma_f32_32x32x16_bf16(*(const LAS bf16x8*)(Ab + ks * 32), *(const LAS bf16x8*)(Bu + ks * 32), Sacc, 0, 0, 0);
                Sacc = __builtin_amdgcn_mfma_f32_32x32x16_bf16(*(const LAS bf16x8*)(Ak + ks * 32), *(const LAS bf16x8*)(Bv + ks * 32), Sacc, 0, 0, 0); }
#pragma unroll
            for (int g = 0; g < 4; ++g) { u32x2 w; w.x = cvtpk(Sacc[4 * g], Sacc[4 * g + 1]); w.y = cvtpk(Sacc[4 * g + 2], Sacc[4 * g + 3]); *(LAS u32x2*)(lds + CS_SB + r32 * 144 + (32 * wid + 8 * g + 4 * hi) * 2) = w; }
        }
        RK_BAR();
        if (tid < 256) { const int tk = tid >> 3, sub = tid & 7; *(f32x4*)(yraw + (size_t)(t0 + tk) * RW + sub * 4) = *(const LAS f32x4*)(lds + CS_YY + tk * 128 + sub * 16); }
    }
    asm volatile("s_waitcnt vmcnt(0)" ::: "memory");
    __syncthreads();
#undef RS_DMA
}
__device__ __forceinline__ void rwkv_finalize(const Params& p, int G) {
    const int tid = opaque_tid(), q16 = tid & 15;
    const float* yraw = p.out; const float* gGG = p.out + (size_t)16 * 1024 * 1024; const float* gVS = (const float*)(p.ws + WS_VS); const float* gBON = (const float*)(p.ws + WS_BON);
    bf16_t* ymix = (bf16_t*)(p.ws + WS_YMIX);
    for (int item = (int)blockIdx.x * (NTHREADS / 16) + (tid >> 4); item < T * 8; item += G * (NTHREADS / 16)) {
        const int tok = item >> 3, h = item & 7, b = tok / SEQ, t = tok - b * SEQ;
        const f32x4 y = *(const f32x4*)(yraw + (size_t)tok * RW + h * 64 + 4 * q16);
        const size_t ho = ((size_t)(b * 8 + h) * SEQ + t) * 64 + 4 * q16;
        const f32x4 vv = *(const f32x4*)(gVS + ho), gg = *(const f32x4*)(gGG + ho);
        const float bon = gBON[(size_t)(b * 8 + h) * SEQ + t];
        const f32x4 gng = *(const f32x4*)(p.in[I_GNG] + h * 64 + 4 * q16), gnb = *(const f32x4*)(p.in[I_GNB] + h * 64 + 4 * q16);
        const float mean = red16((y[0] + y[1]) + (y[2] + y[3])) * (1.0f / 64.0f);
        const f32x4 dl = y - mean;
        const float var = red16((dl[0] * dl[0] + dl[1] * dl[1]) + (dl[2] * dl[2] + dl[3] * dl[3])) * (1.0f / 64.0f);
        const f32x4 yn = dl * __builtin_amdgcn_rsqf(var + GN_EPS) * gng + gnb;
        const f32x4 ov = (yn + vv * bon) * gg;
        u32x2 w; w.x = cvtpk(ov[0], ov[1]); w.y = cvtpk(ov[2], ov[3]);
        *(u32x2*)(ymix + (size_t)tok * D + h * 64 + 4 * q16) = w;
    }
}
#undef RK_BAR

constexpr int RT_X = 0;
constexpr int RT_LG = 131584;
constexpr int RT_GS = RT_LG + 16896;
constexpr int RT_RS = RT_GS + 8192;
constexpr int RT_HIST = RT_RS + 512;
constexpr int RT_CE = RT_HIST + 128;
static_assert(RT_CE + 1024 <= LDS_BYTES - 64, "router LDS map");
__device__ __forceinline__ int rt_swz(int k) { const int g = k >> 2; return ((g ^ ((g >> 4) & 3)) << 2) | (k & 3); }
__device__ __forceinline__ void phase_router(const Params& p, LAS unsigned char* lds, int G) {
    const int tid = opaque_tid(), lane = tid & 63, wave = __builtin_amdgcn_readfirstlane(tid >> 6);
    LAS float* xt = (LAS float*)(lds + RT_X); LAS float* lg = (LAS float*)(lds + RT_LG); LAS float* gs = (LAS float*)(lds + RT_GS); LAS float* shl = gs + 1024;
    LAS float* rsl = (LAS float*)(lds + RT_RS); LAS int* hist = (LAS int*)(lds + RT_HIST); LAS float* cew = (LAS float*)(lds + RT_CE);
    const float* rw = p.in[I_RTW];
    const float* x1 = p.out; const float* gain = p.in[I_N2G]; const float* mod = (const float*)(p.ws + WS_MOD); const float* rb = p.in[I_RTB];
    unsigned char* h2q = p.ws + WS_H;
    int* ridx = (int*)(p.ws + WS_ROUTE); float* rwt = (float*)(p.ws + WS_ROUTE + 512 * 1024);
    int* blockcnt = (int*)(p.ws + WS_CTL + 4096);
    const int TPB = T / G;
    const int blk = blockIdx.x, tok0 = blk * TPB, b = tok0 / SEQ;
    for (int k = tid; k < 1024; k += NTHREADS) { gs[rt_swz(k)] = gain[k] * (1.0f + mod[b * 6144 + 4096 + k]); shl[rt_swz(k)] = mod[b * 6144 + 3072 + k]; }
    if (tid < 32) hist[tid] = 0;
    __syncthreads();
    const int j = lane & 31, hh = lane >> 5, kb = 128 * wave + 64 * hh;
    float breg[64];
    { float cpart = 0.f;
#pragma unroll
        for (int s_ = 0; s_ < 64; ++s_) { const float w = rw[(size_t)(kb + s_) * 32 + j]; cpart += shl[rt_swz(kb + s_)] * w; breg[s_] = w * gs[rt_swz(kb + s_)]; }
        cpart += __shfl_xor(cpart, 32);
        if (lane < 32) cew[wave * 32 + lane] = cpart; }
    const int xsw = (2 * wave + hh) & 3;
    for (int t0 = 0; t0 < TPB; t0 += 128) {
        f32x4 v[16];
#define RT_LOAD(tl_) do { _Pragma("unroll") for (int q = 0; q < 4; ++q) { const int tq = t0 + 32 * (tl_) + 4 * wave + q; const f32x4* xr = (const f32x4*)(x1 + (size_t)(tok0 + (tq < TPB ? tq : 0)) * D) + lane; \
            _Pragma("unroll") for (int jj = 0; jj < 4; ++jj) v[4 * q + jj] = xr[64 * jj]; } } while (0)
        RT_LOAD(0);
#pragma unroll
        for (int tl = 0; tl < 4; ++tl) {
#pragma unroll
            for (int q = 0; q < 4; ++q) { float s = 0.f;
#pragma unroll
                for (int jj = 0; jj < 4; ++jj) { const f32x4 t = v[4 * q + jj]; s += (t[0] * t[0] + t[1] * t[1]) + (t[2] * t[2] + t[3] * t[3]); }
                const float rstd = rsqrtf(wave_sum(s) * (1.0f / D) + NORM_EPS);
                if (lane == 0) rsl[32 * tl + 4 * wave + q] = rstd;
#pragma unroll
                for (int jj = 0; jj < 4; ++jj) { const int g = lane + 64 * jj; *(LAS f32x4*)(xt + (4 * wave + q) * 1028 + 4 * (g ^ ((g >> 4) & 3))) = v[4 * q + jj]; } }
            __syncthreads();
            if (tl < 3) RT_LOAD(tl + 1);
            f32x16 acc = f32x16{};
            { const LAS float* arow = xt + (lane & 31) * 1028 + kb;
#pragma unroll
                for (int c = 0; c < 16; ++c) { const f32x4 a4 = *(const LAS f32x4*)(arow + 4 * (c ^ xsw));
                    acc = __builtin_amdgcn_mfma_f32_32x32x2f32(a4[0], breg[4 * c + 0], acc, 0, 0, 0);
                    acc = __builtin_amdgcn_mfma_f32_32x32x2f32(a4[1], breg[4 * c + 1], acc, 0, 0, 0);
                    acc = __builtin_amdgcn_mfma_f32_32x32x2f32(a4[2], breg[4 * c + 2], acc, 0, 0, 0);
                    acc = __builtin_amdgcn_mfma_f32_32x32x2f32(a4[3], breg[4 * c + 3], acc, 0, 0, 0); } }
            { const int hsw = (lane >> 2) & 3;
#pragma unroll
                for (int q = 0; q < 4; ++q) { const int tq = t0 + 32 * tl + 4 * wave + q; const float rstd = rsl[32 * tl + 4 * wave + q]; u32x4 o;
#pragma unroll
                    for (int u = 0; u < 4; ++u) { const int go = 4 * ((4 * lane + u) ^ hsw);
                        const f32x4 xv = *(const LAS f32x4*)(xt + (4 * wave + q) * 1028 + go), g4 = *(const LAS f32x4*)(gs + go), s4 = *(const LAS f32x4*)(shl + go);
                        const f32x4 y = (xv * rstd) * g4 + s4;
                        o[u] = cvt4_fp8(Q_H2 * y[0], Q_H2 * y[1], Q_H2 * y[2], Q_H2 * y[3]); }
                    if (tq < TPB) *(u32x4*)(h2q + (size_t)(tok0 + tq) * D + 16 * lane) = o; } }
            __syncthreads();
            { LAS float* part = (LAS float*)(lds + RT_X);
#pragma unroll
                for (int r = 0; r < 16; ++r) part[wave * 1024 + r * 64 + lane] = acc[r];
                __syncthreads();
                const int e = tid & 31; float ce = rb[e];
#pragma unroll
                for (int w = 0; w < 8; ++w) ce += cew[w * 32 + e];
#pragma unroll
                for (int q = 0; q < 2; ++q) { const int idx = tid + 512 * q; float sum = 0.f;
#pragma unroll
                    for (int w = 0; w < 8; ++w) sum += part[w * 1024 + idx];
                    const int r = idx >> 6, tk = 32 * tl + (r & 3) + 8 * (r >> 2) + 4 * ((idx >> 5) & 1);
                    lg[tk * 33 + e] = rsl[tk] * sum + ce; }
                __syncthreads(); }
        }
#undef RT_LOAD
        if (tid < 128 && t0 + tid < TPB) {
            const int row = tok0 + t0 + tid; const LAS float* lr = lg + tid * 33;
            float v0 = -INFINITY, v1 = -INFINITY, v2 = -INFINITY, v3 = -INFINITY; int i0 = 0, i1 = 0, i2 = 0, i3 = 0;
#pragma unroll
            for (int e = 0; e < 32; ++e) { const float x = lr[e];
                if (x > v0) { v3 = v2; i3 = i2; v2 = v1; i2 = i1; v1 = v0; i1 = i0; v0 = x; i0 = e; }
                else if (x > v1) { v3 = v2; i3 = i2; v2 = v1; i2 = i1; v1 = x; i1 = e; }
                else if (x > v2) { v3 = v2; i3 = i2; v2 = x; i2 = e; }
                else if (x > v3) { v3 = x; i3 = e; } }
            const float e1 = __expf(v1 - v0), e2 = __expf(v2 - v0), e3 = __expf(v3 - v0); const float inv = 1.0f / (1.0f + e1 + e2 + e3);
            *(int4*)(ridx + (size_t)row * 4) = make_int4(i0, i1, i2, i3); *(float4*)(rwt + (size_t)row * 4) = make_float4(inv, e1 * inv, e2 * inv, e3 * inv);
            atomicAdd((int*)&hist[i0], 1); atomicAdd((int*)&hist[i1], 1); atomicAdd((int*)&hist[i2], 1); atomicAdd((int*)&hist[i3], 1);
        }
        __syncthreads();
    }
    if (tid < 32) blockcnt[blk * 32 + tid] = hist[tid];
    __syncthreads();
}

__device__ __forceinline__ void phase_assign(const Params& p, LAS unsigned char* lds, int G) {
    const int tid = opaque_tid(), lane = tid & 63, wave = tid >> 6;
    LAS int* part = (LAS int*)lds;
    LAS int* partb = part + 512;
    LAS int* total = partb + 512;
    LAS int* base = total + 32;
    LAS int* segst = base + 32;
    LAS int* cursor = segst + 32;
    LAS int* slotl = cursor + 32;
    const int* blockcnt = (const int*)(p.ws + WS_CTL + 4096);
    const int* ridx = (const int*)(p.ws + WS_ROUTE); int* rslot = (int*)(p.ws + WS_ROUTE + 1024 * 1024); int* tokmap = (int*)(p.ws + WS_ROUTE + 2 * 1024 * 1024);
    const bf16_t* h2 = (const bf16_t*)(p.ws + WS_H); bf16_t* xs = (bf16_t*)(p.ws + WS_PROJ);
    int* tile = (int*)(p.ws + WS_TILE);
    const int TPB = T / G; const int blk = blockIdx.x;
    { const int e = tid & 31, part_i = tid >> 5; int st = 0, sb = 0;
        for (int bb = part_i; bb < G; bb += 16) { const int c = blockcnt[bb * 32 + e]; st += c; if (bb < blk) sb += c; }
        part[part_i * 32 + e] = st; partb[part_i * 32 + e] = sb; }
    __syncthreads();
    if (tid < 32) { int st = 0, sb = 0;
#pragma unroll
        for (int i = 0; i < 16; ++i) { st += part[i * 32 + tid]; sb += partb[i * 32 + tid]; }
        total[tid] = st; base[tid] = sb; cursor[tid] = 0; }
    __syncthreads();
    if (tid == 0) { int acc = 0; for (int e = 0; e < 32; ++e) { segst[e] = acc; acc += (total[e] + 255) & ~255; }
        if (blk == 0) { int pm = 0; for (int e = 0; e < 32; ++e) { const int nt = (total[e] + 255) >> 8; for (int i = 0; i < nt; ++i) tile[16 + pm + i] = e; pm += nt; } tile[0] = pm; } }
    __syncthreads();
    if (tid < 32) base[tid] += segst[tid];
    __syncthreads();
    for (int a = tid; a < TPB * 4; a += NTHREADS) { const int tok = blk * TPB + (a >> 2); const int e = ridx[(size_t)tok * 4 + (a & 3)];
        const int rank = atomicAdd((int*)&cursor[e], 1); const int slot = base[e] + rank; rslot[(size_t)tok * 4 + (a & 3)] = slot; tokmap[slot] = tok; }
    for (int e = blk; e < 32; e += G) { const int s0 = segst[e] + total[e], s1 = segst[e] + ((total[e] + 255) & ~255);
        for (int r = s0 + tid; r < s1; r += NTHREADS) tokmap[r] = 0; }
}

__device__ __forceinline__ void phase_final(const Params& p, int G, int stage) {
    const int tid = opaque_tid(), lane = tid & 63, wave = tid >> 6;
    const int gw = (int)blockIdx.x * NWAVES + wave, NGW = G * NWAVES;
    const float* fg = p.in[I_FG]; const float* mod = (const float*)(p.ws + WS_MOD);
    const int* rslot = (const int*)(p.ws + WS_ROUTE + 1024 * 1024); const float* rwt = (const float*)(p.ws + WS_ROUTE + 512 * 1024);
    const bf16_t* Y = (const bf16_t*)(p.ws + WS_PROJ);
    const float* src = (stage >= 4) ? p.out : p.in[I_X];
    for (int row = gw; row < T; row += NGW) {
        const int b = row / SEQ;
        const f32x4* xr = (const f32x4*)(src + (size_t)row * D) + lane;
        f32x4 v[4];
#pragma unroll
        for (int j = 0; j < 4; ++j) v[j] = xr[64 * j];
        if (stage >= 9) {
            const int4 sl = *(const int4*)(rslot + (size_t)row * 4); const float4 wt = *(const float4*)(rwt + (size_t)row * 4);
            const float* g2 = mod + b * 6144 + 5120;
            const int sls[4] = {sl.x, sl.y, sl.z, sl.w}; const float wts[4] = {wt.x, wt.y, wt.z, wt.w};
#pragma unroll
            for (int j = 0; j < 4; ++j) { f32x4 m = (f32x4){0.f, 0.f, 0.f, 0.f};
#pragma unroll
                for (int k = 0; k < 4; ++k) { const u32x2 yv = *((const u32x2*)(Y + (size_t)sls[k] * D) + lane + 64 * j);
                    m[0] += wts[k] * __uint_as_float(yv.x << 16); m[1] += wts[k] * __uint_as_float(yv.x & 0xffff0000u); m[2] += wts[k] * __uint_as_float(yv.y << 16); m[3] += wts[k] * __uint_as_float(yv.y & 0xffff0000u); }
                const f32x4 g = *(const f32x4*)(g2 + 4 * lane + 256 * j); v[j] = v[j] + g * m; }
        }
        float s = 0.f;
#pragma unroll
        for (int j = 0; j < 4; ++j) s += (v[j][0] * v[j][0] + v[j][1] * v[j][1]) + (v[j][2] * v[j][2] + v[j][3] * v[j][3]);
        const float rstd = rsqrtf(wave_sum(s) * (1.0f / D) + NORM_EPS);
        f32x4* orow = (f32x4*)(p.out + (size_t)row * D) + lane;
#pragma unroll
        for (int j = 0; j < 4; ++j) { const f32x4 g = *(const f32x4*)(fg + 4 * lane + 256 * j); orow[64 * j] = v[j] * rstd * g; }
    }
}


#define XB_TMO      128
#define XB_XCNT(j)  (256  + 64 * (j))
#define XB_XSUB(j)  (1280 + 64 * (j))
#define XB_XGEN(j)  (2304 + 64 * (j))
#define XB_TOP      3328
#define XB_TOPGEN   3392
#define XCD_BAR_WORDS 3456
#define XB_SPIN_CAP (1u << 22)
__device__ __forceinline__ unsigned xb_ld(unsigned* p)              { return __hip_atomic_load(p, __ATOMIC_RELAXED, __HIP_MEMORY_SCOPE_AGENT); }
__device__ __forceinline__ unsigned xb_add(unsigned* p, unsigned v) { return __hip_atomic_fetch_add(p, v, __ATOMIC_RELAXED, __HIP_MEMORY_SCOPE_AGENT); }
__device__ __forceinline__ unsigned xb_xcc_id() { return (unsigned)__builtin_amdgcn_s_getreg((3 << 11) | 20) & 0xFu; }
#define XB_SPIN(cond, bar) do { unsigned _sp = 0; while (cond) { __builtin_amdgcn_s_sleep(1); \
    if ((++_sp & 255u) == 0u) { if (xb_ld(&(bar)[XB_TMO])) break; if (_sp > XB_SPIN_CAP) { atomicAdd(&(bar)[XB_TMO], 1u); break; } } } } while (0)
struct XcdBarrier { unsigned* bar; unsigned x; volatile LAS unsigned* st; };
__device__ __forceinline__ XcdBarrier xcd_barrier_post(unsigned* bar, volatile LAS unsigned* st) {
    XcdBarrier b; b.bar = bar; b.x = xb_xcc_id(); b.st = st;
    if (threadIdx.x == 0) (void)xb_add(&bar[XB_XCNT(b.x)], 1u);
    return b;
}
__device__ __forceinline__ void xcd_barrier_complete(unsigned* bar, unsigned x, unsigned& nloc, unsigned& nx) {
    const unsigned G = gridDim.x * gridDim.y * gridDim.z;
    unsigned sum, cnt, mine, sp = 0u;
    for (;;) {
        sum = 0u; cnt = 0u; mine = 0u;
#pragma unroll
        for (unsigned j = 0; j < 16; ++j) { const unsigned c = xb_ld(&bar[XB_XCNT(j)]); sum += c; cnt += (c > 0u) ? 1u : 0u; mine = (j == x) ? c : mine; }
        if (sum == G) break;
        __builtin_amdgcn_s_sleep(1);
        if ((++sp & 255u) == 0u) { if (xb_ld(&bar[XB_TMO])) break; if (sp > XB_SPIN_CAP) { atomicAdd(&bar[XB_TMO], 1u); break; } }
    }
    nloc = mine > 0u ? mine : 1u; nx = cnt > 0u ? cnt : 1u;
}
__device__ __forceinline__ void xcd_barrier(const XcdBarrier& b) {
    asm volatile("s_waitcnt vmcnt(0)" ::: "memory");
    __syncthreads();
    if (threadIdx.x == 0) {
        unsigned* bar = b.bar;
        __builtin_amdgcn_s_waitcnt(0);
        unsigned nloc = b.st[0], nx = b.st[1];
        if (nloc == 0u) { xcd_barrier_complete(bar, b.x, nloc, nx); b.st[0] = nloc; b.st[1] = nx; }
        const unsigned old = xb_add(&bar[XB_XSUB(b.x)], 1u);
        const unsigned gen = old / nloc;
        if (old + 1u == (gen + 1u) * nloc) {
            __builtin_amdgcn_fence(__ATOMIC_RELEASE, "agent");
            asm volatile("s_waitcnt vmcnt(0)" ::: "memory");
            const unsigned og = xb_add(&bar[XB_TOP], 1u);
            const unsigned tg = og / nx;
            if (og + 1u == (tg + 1u) * nx) xb_add(&bar[XB_TOPGEN], 1u);
            else XB_SPIN(xb_ld(&bar[XB_TOPGEN]) == tg, bar);
            __builtin_amdgcn_fence(__ATOMIC_ACQUIRE, "agent");
            xb_add(&bar[XB_XGEN(b.x)], 1u);
            asm volatile("s_waitcnt vmcnt(0)" ::: "memory");
        } else {
            XB_SPIN(xb_ld(&bar[XB_XGEN(b.x)]) == gen, bar);
            __builtin_amdgcn_fence(__ATOMIC_ACQUIRE, "agent");
            asm volatile("s_waitcnt vmcnt(0)" ::: "memory");
        }
    }
    __syncthreads();
}

__device__ __forceinline__ const Params* launder_params(const Params* q) { asm volatile("" : "+s"(q)); return q; }
__global__ void __launch_bounds__(NTHREADS, 2) hymba_fwd(Params p) {
    extern __shared__ __attribute__((aligned(16))) unsigned char lds_raw[];
    cg::grid_group grid = cg::this_grid();
    LAS unsigned char* lds = (LAS unsigned char*)lds_raw;
    const int G = gridDim.x, tid = threadIdx.x;
    constexpr int STAGE = DBG_STAGE;
    volatile LAS unsigned* xst = (volatile LAS unsigned*)(lds + LDS_BYTES - 64);
    if (tid == 0) { xst[0] = 0u; xst[1] = 0u; }
    __syncthreads();
    const XcdBarrier xbar = xcd_barrier_post((unsigned*)(p.ws + WS_CTL + 40960), xst);
#define GRID_BAR() xcd_barrier(xbar)

    phase_mod(p, lds_raw, G);
    if (STAGE >= 2) phase_convert(p, lds_raw, G, 0);
    grid.sync();
    if (STAGE >= 2) { phase_norm1(p, G); GRID_BAR(); }
    if (STAGE >= 2) {
        pg8::Gemm g{(const bf16_t*)(p.ws + WS_H), (const bf16_t*)(p.ws + WS_WIN_T), D, nullptr};
        pg8::DenseSched S; S.o.init(T / 256, IC / 256, G, (int)blockIdx.x);
        EpiInProj E{(bf16_t*)(p.ws + WS_PROJ)};
        pg8::gemm_phase<false, false>(lds, g, S, E);
        GRID_BAR();
    }
    if (STAGE >= 3) {
        kmax_pass(p, G);
        for (int it = blockIdx.x; it < NB * 8 * 4; it += G) rwkv_prep(p, lds, it >> 5, (it >> 2) & 7, (it & 3) * 32, (it & 3) * 32 + 32);
        GRID_BAR();
    }
    if (STAGE >= 2) {
        if (STAGE >= 3) { for (int u = blockIdx.x; u < NB * 8 * 2; u += G) rwkv_scan(p, lds, u >> 4, (u >> 1) & 7, u & 1); }
        else {
            bf16_t* ymix = (bf16_t*)(p.ws + WS_YMIX);
            for (size_t i = (size_t)blockIdx.x * NTHREADS + tid; i < (size_t)T * 64; i += (size_t)G * NTHREADS) { const size_t row = i >> 6, c = i & 63; *(u32x4*)(ymix + row * D + c * 8) = (u32x4){0u, 0u, 0u, 0u}; }
        }
        float lam;
        { const float* q1 = p.in[I_LQ1]; const float* k1 = p.in[I_LK1]; const float* q2 = p.in[I_LQ2]; const float* k2 = p.in[I_LK2]; float s1 = 0.f, s2 = 0.f;
            for (int i = 0; i < 64; ++i) { s1 += q1[i] * k1[i]; s2 += q2[i] * k2[i]; } lam = expf(s1) - expf(s2) + LAMBDA_INIT; }
        unsigned* qhead = (unsigned*)(p.ws + WS_CTL);
        LAS unsigned* ubox = (LAS unsigned*)(lds + 4 * ATT_BUF);
        for (;;) {
            __syncthreads();
            if (tid == 0) ubox[0] = atomicAdd(qhead, 1u);
            __syncthreads();
            const unsigned u = (unsigned)__builtin_amdgcn_readfirstlane((int)ubox[0]);
            if (u >= (unsigned)ATT_UNITS) break;
            attn_unit(p, lds, (int)(u & 31u) >> 2, (int)(u & 3u), ATT_NQB - 1 - (int)(u >> 5), lam);
        }
        GRID_BAR();
        if (STAGE >= 3) { rwkv_finalize(p, G); GRID_BAR(); }
    }
    if (STAGE >= 2) {
        pg8::Gemm g{(const bf16_t*)(p.ws + WS_YMIX), (const bf16_t*)(p.ws + WS_WOUT_T), D, nullptr};
        pg8::DenseSched S; S.o.init(T / 256, D / 256, G, (int)blockIdx.x);
        EpiOutProj E{p.in[I_X], (const float*)(p.ws + WS_MOD), p.out};
        pg8::gemm_phase<false, false>(lds, g, S, E);
        GRID_BAR();
    }
    if (STAGE >= 9) {
        phase_router(p, lds, G);
        GRID_BAR();
        phase_assign(p, lds, G);
        __syncthreads();
        phase_convert(p, lds_raw, G, 1);
        GRID_BAR();
        const int* tile = (const int*)(p.ws + WS_TILE);
        const int MT = tile[0];
        {
            pg8::Gemm g{(const bf16_t*)(p.ws + WS_H), (const bf16_t*)(p.ws + WS_WG_T), D / 2, (const int*)(p.ws + WS_ROUTE + 2 * 1024 * 1024)};
            pg8::MoeSched S; S.o.init(MT, 8, G, (int)blockIdx.x); S.tile_e = tile + 16; S.N = 2048;
            EpiMoe1 E{p.in[I_BGU], p.ws + WS_ACT};
            pg8::gemm_phase<true, true>(lds, g, S, E);
        }
        GRID_BAR();
        {
            pg8::Gemm g{(const bf16_t*)(p.ws + WS_ACT), (const bf16_t*)(p.ws + WS_WD_T), D / 2, nullptr};
            pg8::MoeSched S; S.o.init(MT, 4, G, (int)blockIdx.x); S.tile_e = tile + 16; S.N = 1024;
            EpiMoe2 E{p.in[I_BDN], (bf16_t*)(p.ws + WS_PROJ)};
            pg8::gemm_phase<false, true>(lds, g, S, E);
        }
        GRID_BAR();
    }
    phase_final(p, G, STAGE >= 9 ? 9 : (STAGE >= 2 ? 4 : 0));
}

extern "C" void kernel_launch(void* const* d_in, const int* in_sizes, int n_in, void* d_out, int out_size, void* d_ws, size_t ws_size, hipStream_t stream) {
    static int grid = 0;
    if (grid == 0) {
        if (n_in != 31 || out_size != T * D || ws_size < WS_END) { fprintf(stderr, "kernel_launch: unexpected shapes (n_in %d out %d ws %zu)\n", n_in, out_size, ws_size); grid = -1; return; }
        int dev = 0, cus = 0, per_cu = 0;
        hipGetDevice(&dev);
        hipDeviceGetAttribute(&cus, hipDeviceAttributeMultiprocessorCount, dev);
        hipFuncSetAttribute((const void*)hymba_fwd, hipFuncAttributeMaxDynamicSharedMemorySize, LDS_BYTES);
        hipOccupancyMaxActiveBlocksPerMultiprocessor(&per_cu, (const void*)hymba_fwd, NTHREADS, LDS_BYTES);
        if (per_cu < 1) { fprintf(stderr, "kernel_launch: occupancy query returned %d\n", per_cu); grid = -1; return; }
        grid = cus;
        if (grid > 256) grid = 256;
        while (T % grid != 0) --grid;
        (void)hipGetLastError();
    }
    if (grid < 0) return;
    hipMemsetAsync((char*)d_ws + WS_CTL, 0, CTL_BYTES, stream);
    Params p{};
    for (int i = 0; i < 31; ++i) p.in[i] = (const float*)d_in[i];
    p.out = (float*)d_out; p.ws = (unsigned char*)d_ws;
    void* args[] = {&p};
    hipError_t e = hipLaunchCooperativeKernel((const void*)hymba_fwd, dim3(grid), dim3(NTHREADS), args, LDS_BYTES, stream);
    if (e != hipSuccess) fprintf(stderr, "cooperative launch failed: %s (grid %d)\n", hipGetErrorString(e), grid);
}
```

```cpp
#include <hip/hip_runtime.h>
#include <hip/hip_cooperative_groups.h>
#include <cstdio>
#include <cstdint>
namespace cg = cooperative_groups;

#ifndef DBG_STAGE
#define DBG_STAGE 99
#endif

#define LAS __attribute__((address_space(3)))
typedef unsigned short bf16_t;
typedef short bf16x8 __attribute__((ext_vector_type(8)));
typedef short s16x4 __attribute__((ext_vector_type(4)));
typedef float f32x4 __attribute__((ext_vector_type(4)));
typedef float f32x16 __attribute__((ext_vector_type(16)));
typedef float f32x2_t __attribute__((ext_vector_type(2)));
typedef __bf16 bf16x2_t __attribute__((ext_vector_type(2)));
typedef unsigned u32x4 __attribute__((ext_vector_type(4)));
typedef unsigned u32x2 __attribute__((ext_vector_type(2)));

constexpr int D = 1024, NB = 8, SEQ = 4096, T = NB * SEQ;
constexpr int RW = 512, RC = 1792, DC = 1536, IC = 3328;
constexpr int NE = 32, TOPK = 4, NA = T * TOPK;
constexpr int PMAX = NA + NE * 256;
constexpr float NORM_EPS = 1e-5f, GN_EPS = 64e-5f;
constexpr float LOG2E = 1.4426950408889634f;
constexpr float QSCALE = 0.125f * LOG2E;
constexpr float LAMBDA_INIT = 0.2f;
constexpr int NTHREADS = 512, NWAVES = 8;
constexpr int LDS_BYTES = 163840;

constexpr size_t MiB = 1u << 20;
constexpr size_t WS_CTL = 0;
constexpr size_t CTL_BYTES = 65536;
constexpr size_t WS_MOD = 1 * MiB;
constexpr size_t WS_TILE = 1 * MiB + 512 * 1024;
constexpr size_t WS_WIN_T = 2 * MiB;
constexpr size_t WS_WOUT_T = 9 * MiB;
constexpr size_t WS_ROUTE = 11 * MiB;
constexpr size_t WS_WG_T = 16 * MiB;
constexpr size_t WS_WD_T = 144 * MiB;
constexpr size_t WS_H = 208 * MiB;
constexpr size_t WS_YMIX = 272 * MiB;
constexpr size_t WS_PROJ = 336 * MiB;
constexpr size_t WS_ACT = 608 * MiB;
constexpr size_t WS_END = 1008 * MiB;
constexpr int OPREC = 34816;
constexpr int OP_AT = 0, OP_RT = 4608, OP_BH = 9216, OP_KH = 13824, OP_BCT = 18432, OP_KCT = 23552, OP_VT = 28672, OP_P31 = 33792;
constexpr size_t WS_OPS = WS_ACT;
constexpr size_t WS_VS = 944 * MiB;
constexpr size_t WS_BON = WS_H;

__device__ __forceinline__ unsigned cvtpk(float lo, float hi) { f32x2_t v = {lo, hi}; bf16x2_t b = __builtin_convertvector(v, bf16x2_t); return __builtin_bit_cast(unsigned, b); }
__device__ __forceinline__ float bf2f(unsigned short u) { return __uint_as_float(((unsigned)u) << 16); }
__device__ __forceinline__ float wave_sum(float v) {
#pragma unroll
    for (int o = 1; o < 64; o <<= 1) v += __shfl_xor(v, o);
    return v;
}
__device__ __forceinline__ float wave_max(float v) {
#pragma unroll
    for (int o = 1; o < 64; o <<= 1) v = fmaxf(v, __shfl_xor(v, o));
    return v;
}
__device__ __forceinline__ int opaque_tid() { int t = (int)threadIdx.x; asm volatile("" : "+v"(t)); return t; }
__device__ __forceinline__ float sigmoidf_(float x) { return __builtin_amdgcn_rcpf(1.0f + __expf(-x)); }
__device__ __forceinline__ float tanh_fast(float x) { return 1.0f - 2.0f * __builtin_amdgcn_rcpf(1.0f + __expf(2.0f * x)); }

struct Params {
    const float* in[31];
    float* out;
    unsigned char* ws;
};
enum { I_X = 0, I_C, I_MODW, I_MODB, I_N1G, I_WIN, I_MU, I_W0, I_WUP, I_A0, I_AUP, I_GUP, I_KK, I_KA, I_RK, I_GNG, I_GNB, I_LQ1, I_LK1, I_LQ2, I_LK2, I_SUBLN, I_WOUT, I_N2G, I_RTW, I_RTB, I_WGU, I_BGU, I_WDN, I_BDN, I_FG };

namespace pg8 {
constexpr int BM = 256, BK = 64, HALF = 128, HTB = HALF * BK * 2, STAGE_BYTES = 8 * HTB, NXCD = 8, WGM = 8;
__host__ __device__ __forceinline__ int lds_byte(int r, int c) { const int st = (r >> 4) * 2 + (c >> 5), rr = r & 15, cc = c & 31, ob = rr * 64 + cc * 2; return st * 1024 + (ob ^ (((ob >> 9) & 1) << 5)); }
__host__ __device__ __forceinline__ void stage_rc(int b, int& R, int& C) { const int st = b / 1024, sb = b % 1024, swz = sb ^ (((sb >> 9) & 1) << 5); R = (st >> 1) * 16 + swz / 64; C = (st & 1) * 32 + (swz % 64) / 2; }
__host__ __device__ __forceinline__ int perm32(int rho) { const int n = rho >> 4, i = rho & 15; return 8 * (i >> 2) + 4 * n + (i & 3); }

struct Unit { int pm, pn, arow, brow, e; };
struct Gemm { const bf16_t* A; const bf16_t* Bt; int K; const int* rowmap; };

struct TileOrder {
    int nM, nN, nwg, G, c;
    __device__ void init(int nM_, int nN_, int G_, int c_) { nM = nM_; nN = nN_; nwg = nM * nN; G = G_; c = c_; }
    __device__ bool map(int i, int& pm, int& pn) const {
        const long L = (long)i * G + c; if (L >= nwg) return false;
        int wgid = (int)L; { const int q = nwg / NXCD, r = nwg % NXCD, xcd = wgid % NXCD, off = wgid / NXCD; wgid = (xcd < r ? xcd * (q + 1) : r * (q + 1) + (xcd - r) * q) + off; }
        const int nig = WGM * nN, gid = wgid / nig, fm = gid * WGM, gsz = (nM - fm) < WGM ? (nM - fm) : WGM;
        pm = fm + ((wgid % nig) % gsz); pn = (wgid % nig) / gsz; return true;
    }
};
struct DenseSched {
    TileOrder o;
    __device__ bool next(int i, Unit& u) const { int pm, pn; if (!o.map(i, pm, pn)) return false; u.pm = pm; u.pn = pn; u.arow = pm * BM; u.brow = pn * BM; u.e = 0; return true; }
};
struct MoeSched {
    TileOrder o; const int* tile_e; int N;
    __device__ bool next(int i, Unit& u) const { int pm, pn; if (!o.map(i, pm, pn)) return false; const int e = tile_e[pm]; u.pm = pm; u.pn = pn; u.arow = pm * BM; u.brow = e * N + pn * BM; u.e = e; return true; }
};

typedef int v4i_t __attribute__((ext_vector_type(4)));
typedef int v8i_t __attribute__((ext_vector_type(8)));
__device__ __forceinline__ v8i_t cat8(bf16x8 a, bf16x8 b) { return __builtin_shufflevector(__builtin_bit_cast(v4i_t, a), __builtin_bit_cast(v4i_t, b), 0, 1, 2, 3, 4, 5, 6, 7); }
__device__ __forceinline__ void mfma_fp8_tied(f32x4& acc, v8i_t a, v8i_t b) { asm volatile("v_mfma_f32_16x16x128_f8f6f4 %0, %1, %2, %0" : "+v"(acc) : "v"(a), "v"(b)); }
template <bool GATHER, bool FP8, class Epi, class Sched>
__device__ __forceinline__ void gemm_phase(LAS unsigned char* lds, const Gemm g, const Sched& S, const Epi& E) {
    const int tid = opaque_tid(), wid = __builtin_amdgcn_readfirstlane(tid >> 6), lane = tid & 63, wr = wid >> 2, wc = wid & 3, fr = lane & 15, fq = lane >> 4;
    const int K = g.K, nt = K / BK;
    unsigned voffA[2], voffB[2]; int rowA[2], colA2[2];
#pragma unroll
    for (int i = 0; i < 2; ++i) { int R, C; stage_rc(tid * 16 + i * 8192, R, C); const int Rb = (R & ~31) + perm32(R & 31);
        voffA[i] = (unsigned)(R * K + C) * 2u; voffB[i] = (unsigned)(Rb * K + C) * 2u; rowA[i] = R; colA2[i] = C * 2; }
    unsigned gv0[2] = {0u, 0u}, gv1[2] = {0u, 0u}, gn0[2] = {0u, 0u}, gn1[2] = {0u, 0u};
#define PG8_GOFF(u_, o0, o1) do { _Pragma("unroll") for (int _i = 0; _i < 2; ++_i) { o0[_i] = (unsigned)g.rowmap[(u_).arow + rowA[_i]] * (unsigned)(K * 2) + (unsigned)colA2[_i]; o1[_i] = (unsigned)g.rowmap[(u_).arow + HALF + rowA[_i]] * (unsigned)(K * 2) + (unsigned)colA2[_i]; } } while (0)
#define PG8_STAGE_A(bufoff, kptr, half) do { if constexpr (GATHER) { if (half) PG8_STAGE(bufoff, kptr, gv1); else PG8_STAGE(bufoff, kptr, gv0); } else PG8_STAGE(bufoff, (kptr) + ((half) ? hstep : 0), voffA); } while (0)
    const size_t kstep = (size_t)(BK * 2);
    const size_t hstep = (size_t)HALF * K * 2;
    const size_t rowb = (size_t)K * 2;
    const unsigned ldsw = (unsigned)wid * 1024u;
    const int aoff = lds_byte(wr * 64 + fr, fq * 8), boff = lds_byte(wc * 32 + fr, fq * 8);
#define PG8_SA(b, h) (((b) * 2 + (h)) * HTB)
#define PG8_SB(b, h) ((4 + (b) * 2 + (h)) * HTB)
#define PG8_STAGE(bufoff, gbase, voff) do { _Pragma("unroll") for (int _i = 0; _i < 2; ++_i) \
        __builtin_amdgcn_global_load_lds((const unsigned*)((const char*)(gbase) + (voff)[_i]), (LAS unsigned*)(lds + (bufoff) + ldsw + _i * 8192), 16, 0, 0); } while (0)
#define PG8_LDA(dst, b, h) do { _Pragma("unroll") for (int m = 0; m < 4; ++m) _Pragma("unroll") for (int k = 0; k < 2; ++k) dst[m][k] = *(const LAS bf16x8*)(lds + PG8_SA(b, h) + aoff + m * 2048 + k * 1024); } while (0)
#define PG8_LDB(dst, b, h) do { _Pragma("unroll") for (int n = 0; n < 2; ++n) _Pragma("unroll") for (int k = 0; k < 2; ++k) dst[n][k] = *(const LAS bf16x8*)(lds + PG8_SB(b, h) + boff + n * 2048 + k * 1024); } while (0)
#define PG8_MMA(ai, bj, At, Bt) do { __builtin_amdgcn_s_setprio(1); _Pragma("unroll") for (int m = 0; m < 4; ++m) _Pragma("unroll") for (int n = 0; n < 2; ++n) { \
        if constexpr (FP8) mfma_fp8_tied(acc[ai][bj][m][n], cat8(Bt[n][0], Bt[n][1]), cat8(At[m][0], At[m][1])); \
        else { _Pragma("unroll") for (int k = 0; k < 2; ++k) acc[ai][bj][m][n] = __builtin_amdgcn_mfma_f32_16x16x32_bf16(Bt[n][k], At[m][k], acc[ai][bj][m][n], 0, 0, 0); } } __builtin_amdgcn_s_setprio(0); } while (0)
#define PG8_WAIT_V(n) asm volatile("s_waitcnt vmcnt(" #n ")" ::: "memory")
#define PG8_WAIT_L(n) asm volatile("s_waitcnt lgkmcnt(" #n ")" ::: "memory")
#define PG8_BAR __builtin_amdgcn_s_barrier()
#define PG8_SCHED __builtin_amdgcn_sched_barrier(0)
    Unit cur, nxt; int ui = 0;
    if (!S.next(0, cur)) return;
    f32x4 acc[2][2][4][2];
#pragma unroll
    for (int a = 0; a < 2; ++a)
#pragma unroll
        for (int b = 0; b < 2; ++b)
#pragma unroll
            for (int m = 0; m < 4; ++m)
#pragma unroll
                for (int n = 0; n < 2; ++n) acc[a][b][m][n] = (f32x4){0.f, 0.f, 0.f, 0.f};
    bf16x8 At[4][2], B0[2][2], B1[2][2];
    const char* cA = GATHER ? (const char*)g.A : (const char*)g.A + (size_t)cur.arow * rowb; const char* cB = (const char*)g.Bt + (size_t)cur.brow * rowb;
    if constexpr (GATHER) PG8_GOFF(cur, gv0, gv1);
    PG8_STAGE(PG8_SB(0, 0), cB, voffB); PG8_STAGE(PG8_SB(0, 1), cB + hstep, voffB); PG8_STAGE_A(PG8_SA(0, 0), cA, 0); PG8_STAGE_A(PG8_SA(0, 1), cA, 1);
    if (wr == 1) PG8_BAR;
    PG8_WAIT_V(2); PG8_BAR;
    PG8_STAGE(PG8_SB(1, 0), cB + kstep, voffB); PG8_STAGE_A(PG8_SA(1, 0), cA + kstep, 0); PG8_STAGE(PG8_SB(1, 1), cB + hstep + kstep, voffB);
    PG8_WAIT_V(6); PG8_BAR;
    for (;;) {
        const bool has_next = S.next(ui + 1, nxt);
        const char* nA = GATHER ? (const char*)g.A : (has_next ? (const char*)g.A + (size_t)nxt.arow * rowb : cA); const char* nB = has_next ? (const char*)g.Bt + (size_t)nxt.brow * rowb : cB;

        for (int t = 0; t < nt; t += 2) {
            const bool last = (t == nt - 2);
            if constexpr (GATHER) { if (t == nt - 4) { if (has_next) PG8_GOFF(nxt, gn0, gn1); else { gn0[0] = gv0[0]; gn0[1] = gv0[1]; gn1[0] = gv1[0]; gn1[1] = gv1[1]; } } }
            const char* a1 = cA + (size_t)(t + 1) * kstep;
            const char* a2 = last ? nA : cA + (size_t)(t + 2) * kstep; const char* b2 = last ? nB : cB + (size_t)(t + 2) * kstep;
            const char* a3 = a2 + kstep; const char* b3 = b2 + kstep;
            PG8_LDB(B0, 0, 0); PG8_LDB(B1, 0, 1); PG8_SCHED; PG8_LDA(At, 0, 0); PG8_STAGE_A(PG8_SA(1, 1), a1, 1);
            if constexpr (GATHER) { if (last) { gv0[0] = gn0[0]; gv0[1] = gn0[1]; gv1[0] = gn1[0]; gv1[1] = gn1[1]; } }
            PG8_WAIT_V(8); PG8_WAIT_L(0); PG8_BAR; PG8_MMA(0, 0, At, B0); PG8_MMA(0, 1, At, B1); PG8_BAR; PG8_SCHED;
            PG8_LDA(At, 0, 1); PG8_STAGE(PG8_SB(0, 0), b2, voffB); PG8_STAGE(PG8_SB(0, 1), b2 + hstep, voffB); PG8_STAGE_A(PG8_SA(0, 0), a2, 0);
            PG8_WAIT_V(8); PG8_WAIT_L(0); PG8_BAR; PG8_MMA(1, 0, At, B0); PG8_MMA(1, 1, At, B1); PG8_BAR; PG8_SCHED;
            PG8_LDB(B0, 1, 0); PG8_LDB(B1, 1, 1); PG8_SCHED; PG8_LDA(At, 1, 0); PG8_STAGE_A(PG8_SA(0, 1), a2, 1);
            PG8_WAIT_V(8); PG8_WAIT_L(0); PG8_BAR; PG8_MMA(0, 0, At, B0); PG8_MMA(0, 1, At, B1); PG8_BAR; PG8_SCHED;
            PG8_LDA(At, 1, 1); PG8_STAGE(PG8_SB(1, 0), b3, voffB); PG8_STAGE(PG8_SB(1, 1), b3 + hstep, voffB); PG8_STAGE_A(PG8_SA(1, 0), a3, 0);
            PG8_WAIT_V(8); PG8_WAIT_L(0); PG8_BAR; PG8_MMA(1, 0, At, B0); PG8_MMA(1, 1, At, B1); PG8_BAR; PG8_SCHED;
        }
        if (wr == 0) PG8_BAR;
        if constexpr (FP8) asm volatile("s_nop 15\n\ts_nop 15" ::: "memory");
        E(acc, cur, wr, wc, fr, fq);
        if (!has_next) break;
#pragma unroll
        for (int a = 0; a < 2; ++a)
#pragma unroll
            for (int b = 0; b < 2; ++b)
#pragma unroll
                for (int m = 0; m < 4; ++m)
#pragma unroll
                    for (int n = 0; n < 2; ++n) acc[a][b][m][n] = (f32x4){0.f, 0.f, 0.f, 0.f};
        cur = nxt; cA = nA; cB = nB; ++ui;
        if (wr == 1) PG8_BAR;
    }
    PG8_WAIT_V(0);
    PG8_BAR;
#undef PG8_SA
#undef PG8_SB
#undef PG8_STAGE
#undef PG8_STAGE_A
#undef PG8_GOFF
#undef PG8_LDA
#undef PG8_LDB
#undef PG8_MMA
#undef PG8_WAIT_V
#undef PG8_WAIT_L
#undef PG8_BAR
#undef PG8_SCHED
}
}

constexpr float Q_H2 = 8.0f, Q_W = 32.0f, Q_ACT = 4.0f;
__device__ __forceinline__ unsigned cvt4_fp8(float a, float b, float c, float d) { unsigned w = 0u; w = (unsigned)__builtin_amdgcn_cvt_pk_fp8_f32(a, b, (int)w, false); w = (unsigned)__builtin_amdgcn_cvt_pk_fp8_f32(c, d, (int)w, true); return w; }
struct EpiInProj {
    bf16_t* O;
    __device__ __forceinline__ void operator()(const f32x4 (&acc)[2][2][4][2], const pg8::Unit& u, int wr, int wc, int fr, int fq) const {
        const int row0 = u.pm * 256 + wr * 64 + fr, col0 = u.pn * 256 + wc * 32 + 8 * fq;
        const float sc = ((u.pn == 7 || u.pn == 8) ? QSCALE : 1.0f) * (1.0f / (Q_H2 * Q_W));
#pragma unroll
        for (int ai = 0; ai < 2; ++ai)
#pragma unroll
            for (int m = 0; m < 4; ++m) { bf16_t* rowp = O + (size_t)(row0 + ai * 128 + m * 16) * IC + col0;
#pragma unroll
                for (int bj = 0; bj < 2; ++bj) { const f32x4 v0 = acc[ai][bj][m][0] * sc, v1 = acc[ai][bj][m][1] * sc;
                    u32x4 w; w.x = cvtpk(v0[0], v0[1]); w.y = cvtpk(v0[2], v0[3]); w.z = cvtpk(v1[0], v1[1]); w.w = cvtpk(v1[2], v1[3]);
                    *(u32x4*)(rowp + bj * 128) = w; } }
    }
};
struct EpiOutProj {
    const float* x; const float* mod; float* O;
    __device__ __forceinline__ void operator()(const f32x4 (&acc)[2][2][4][2], const pg8::Unit& u, int wr, int wc, int fr, int fq) const {
        const int row0 = u.pm * 256 + wr * 64 + fr, col0 = u.pn * 256 + wc * 32 + 8 * fq;
        const int b = (u.pm * 256) / SEQ;
        const float* g1 = mod + b * 6144 + 2048;
        f32x4 gv[2][2];
#pragma unroll
        for (int bj = 0; bj < 2; ++bj)
#pragma unroll
            for (int n = 0; n < 2; ++n) gv[bj][n] = *(const f32x4*)(g1 + col0 + bj * 128 + 4 * n);
#pragma unroll
        for (int ai = 0; ai < 2; ++ai)
#pragma unroll
            for (int m = 0; m < 4; ++m) { const size_t off = (size_t)(row0 + ai * 128 + m * 16) * D + col0;
#pragma unroll
                for (int bj = 0; bj < 2; ++bj)
#pragma unroll
                    for (int n = 0; n < 2; ++n) { const f32x4 xv = *(const f32x4*)(x + off + bj * 128 + 4 * n);
                        *(f32x4*)(O + off + bj * 128 + 4 * n) = xv + gv[bj][n] * acc[ai][bj][m][n]; } }
    }
};
struct EpiMoe1 {
    const float* bgu; unsigned char* O;
    __device__ __forceinline__ void operator()(const f32x4 (&acc)[2][2][4][2], const pg8::Unit& u, int wr, int wc, int fr, int fq) const {
        const int row0 = u.pm * 256 + wr * 64 + fr, col0 = u.pn * 128 + wc * 32 + 8 * fq;
        const float* bg = bgu + (size_t)u.e * 2048 + col0;
        constexpr float dq = 1.0f / (Q_H2 * Q_W);
        f32x4 bgv[2], buv[2];
#pragma unroll
        for (int n = 0; n < 2; ++n) { bgv[n] = *(const f32x4*)(bg + 4 * n); buv[n] = *(const f32x4*)(bg + 1024 + 4 * n); }
#pragma unroll
        for (int ai = 0; ai < 2; ++ai)
#pragma unroll
            for (int m = 0; m < 4; ++m) { float a[8];
#pragma unroll
                for (int n = 0; n < 2; ++n) { const f32x4 gt = acc[ai][0][m][n] * dq + bgv[n], up = acc[ai][1][m][n] * dq + buv[n];
#pragma unroll
                    for (int j = 0; j < 4; ++j) { const float gg = fminf(gt[j], 7.0f), uu = fminf(fmaxf(up[j], -7.0f), 7.0f);
                        a[4 * n + j] = Q_ACT * (uu + 1.0f) * (gg * __builtin_amdgcn_rcpf(1.0f + __builtin_amdgcn_exp2f(-1.702f * LOG2E * gg))); } }
                u32x2 w; w.x = cvt4_fp8(a[0], a[1], a[2], a[3]); w.y = cvt4_fp8(a[4], a[5], a[6], a[7]);
                *(u32x2*)(O + (size_t)(row0 + ai * 128 + m * 16) * 1024 + col0) = w; }
    }
};
struct EpiMoe2 {
    const float* bdn; bf16_t* O;
    __device__ __forceinline__ void operator()(const f32x4 (&acc)[2][2][4][2], const pg8::Unit& u, int wr, int wc, int fr, int fq) const {
        const int row0 = u.pm * 256 + wr * 64 + fr, col0 = u.pn * 256 + wc * 32 + 8 * fq;
        const float* bd = bdn + (size_t)u.e * 1024 + col0;
        constexpr float dq = 1.0f / (Q_ACT * Q_W);
        f32x4 bv[2][2];
#pragma unroll
        for (int bj = 0; bj < 2; ++bj)
#pragma unroll
            for (int n = 0; n < 2; ++n) bv[bj][n] = *(const f32x4*)(bd + bj * 128 + 4 * n);
#pragma unroll
        for (int ai = 0; ai < 2; ++ai)
#pragma unroll
            for (int m = 0; m < 4; ++m) { bf16_t* rowp = O + (size_t)(row0 + ai * 128 + m * 16) * 1024 + col0;
#pragma unroll
                for (int bj = 0; bj < 2; ++bj) { const f32x4 v0 = acc[ai][bj][m][0] * dq + bv[bj][0], v1 = acc[ai][bj][m][1] * dq + bv[bj][1];
                    u32x4 w; w.x = cvtpk(v0[0], v0[1]); w.y = cvtpk(v0[2], v0[3]); w.z = cvtpk(v1[0], v1[1]); w.w = cvtpk(v1[2], v1[3]);
                    *(u32x4*)(rowp + bj * 128) = w; } }
    }
};

__device__ __forceinline__ void phase_mod(const Params& p, unsigned char* lds, int G) {
    const int tid = opaque_tid(), lane = tid & 63, wave = tid >> 6;
    float* sc = (float*)lds;
    float* part = (float*)lds + 8192;
    const float* c = p.in[I_C];
    for (int i = tid; i < 8192; i += NTHREADS) { const int b = i & 7, k = i >> 3; const float cv = c[b * 1024 + k]; sc[k * 8 + b] = cv / (1.0f + __expf(-cv)); }
    __syncthreads();
    float* mod = (float*)(p.ws + WS_MOD);
    const float* mw = p.in[I_MODW]; const float* mb = p.in[I_MODB];
    for (int cg = (int)blockIdx.x; cg < 256; cg += G) {
        const int cc = lane & 31, kh = lane >> 5, k0 = wave * 128 + kh * 64, col = cg * 24 + (cc < 24 ? cc : 0);
        float acc[8];
#pragma unroll
        for (int b = 0; b < 8; ++b) acc[b] = 0.f;
        const float* wp = mw + (size_t)k0 * 6144 + col;
        const float* sp = sc + k0 * 8;
#pragma unroll 1
        for (int k = 0; k < 64; k += 16) { float wv[16];
#pragma unroll
            for (int u = 0; u < 16; ++u) wv[u] = wp[(size_t)(k + u) * 6144];
#pragma unroll
            for (int u = 0; u < 16; ++u) { const f32x4 s0 = *(const f32x4*)(sp + (k + u) * 8), s1 = *(const f32x4*)(sp + (k + u) * 8 + 4);
                acc[0] += s0[0] * wv[u]; acc[1] += s0[1] * wv[u]; acc[2] += s0[2] * wv[u]; acc[3] += s0[3] * wv[u]; acc[4] += s1[0] * wv[u]; acc[5] += s1[1] * wv[u]; acc[6] += s1[2] * wv[u]; acc[7] += s1[3] * wv[u]; } }
#pragma unroll
        for (int b = 0; b < 8; ++b) acc[b] += __shfl_xor(acc[b], 32);
        if (lane < 24) {
#pragma unroll
            for (int b = 0; b < 8; ++b) part[(wave * 24 + lane) * 8 + b] = acc[b]; }
        __syncthreads();
        if (tid < 192) { const int cl = tid >> 3, b = tid & 7; float sum = mb[cg * 24 + cl];
#pragma unroll
            for (int w = 0; w < 8; ++w) sum += part[(w * 24 + cl) * 8 + b];
            mod[b * 6144 + cg * 24 + cl] = sum; }
        __syncthreads();
    }
}
__device__ __forceinline__ void transpose_item(const float* W, int N, int k0, int n0, bf16_t* WT, int Kdst, int dst_row_base, bool gu_interleave, float* scr, int lane) {
#pragma unroll 4
    for (int i = 0; i < 16; ++i) { const int row = 4 * i + (lane >> 4), c4 = lane & 15;
        const f32x4 v = *(const f32x4*)(W + (size_t)(k0 + row) * N + n0 + 4 * c4);
        float* s = scr + row * 65 + 4 * c4; s[0] = v[0]; s[1] = v[1]; s[2] = v[2]; s[3] = v[3]; }
    asm volatile("s_waitcnt lgkmcnt(0)" ::: "memory");
    const int cch = lane & 7;
#pragma unroll
    for (int i = 0; i < 8; ++i) { const int n = 8 * i + (lane >> 3); const float* s = scr + (8 * cch) * 65 + n;
        u32x4 o; o.x = cvtpk(s[0], s[65]); o.y = cvtpk(s[2 * 65], s[3 * 65]); o.z = cvtpk(s[4 * 65], s[5 * 65]); o.w = cvtpk(s[6 * 65], s[7 * 65]);
        int nn = n0 + n;
        if (gu_interleave) nn = (nn < 1024) ? ((nn >> 7) * 256 + (nn & 127)) : (((nn - 1024) >> 7) * 256 + 128 + ((nn - 1024) & 127));
        *(u32x4*)(WT + (size_t)(dst_row_base + nn) * Kdst + k0 + 8 * cch) = o; }
    asm volatile("s_waitcnt lgkmcnt(0)" ::: "memory");
}
struct CvtItem { const float* src; unsigned char* dst; int N; };
__device__ __forceinline__ CvtItem cvt_item(const Params& p, int r, int lane) {
    CvtItem c; constexpr int I_GU = 32 * 512;
    const int nq = lane & 7, kq = lane >> 3;
    if (r < I_GU) { const int e = r >> 9, rr = r & 511, k0 = (rr >> 6) * 128, n0 = (rr & 63) * 32; c.N = 2048;
        c.src = p.in[I_WGU] + (size_t)e * 1024 * 2048 + (size_t)(k0 + kq) * 2048 + n0 + 4 * nq;
        const int nn = n0 + 4 * nq, nd = (nn < 1024) ? ((nn >> 7) * 256 + (nn & 127)) : (((nn - 1024) >> 7) * 256 + 128 + ((nn - 1024) & 127));
        c.dst = p.ws + WS_WG_T + ((size_t)(e * 2048 + nd)) * 1024 + k0 + 16 * kq; }
    else if (r < I_GU + 32 * 256) { const int q = r - I_GU, e = q >> 8, rr = q & 255, k0 = (rr >> 5) * 128, n0 = (rr & 31) * 32; c.N = 1024;
        c.src = p.in[I_WDN] + (size_t)e * 1024 * 1024 + (size_t)(k0 + kq) * 1024 + n0 + 4 * nq;
        c.dst = p.ws + WS_WD_T + ((size_t)(e * 1024 + n0 + 4 * nq)) * 1024 + k0 + 16 * kq; }
    else { const int q = r - (I_GU + 32 * 256), k0 = (q / 104) * 128, n0 = (q % 104) * 32; c.N = IC;
        c.src = p.in[I_WIN] + (size_t)(k0 + kq) * IC + n0 + 4 * nq;
        c.dst = p.ws + WS_WIN_T + ((size_t)(n0 + 4 * nq)) * 1024 + k0 + 16 * kq; }
    return c;
}
__device__ __forceinline__ void phase_convert(const Params& p, unsigned char* lds, int G, int part) {
    const int tid = opaque_tid(), lane = tid & 63, wave = tid >> 6;
    float* scr = (float*)lds + wave * (64 * 65);
    const int gw = (int)blockIdx.x * NWAVES + wave, NGW = G * NWAVES;
    constexpr int I_OUT = 16 * 16, NFE = 32 * 512 + 32 * 256;
    bf16_t* wout_t = (bf16_t*)(p.ws + WS_WOUT_T);
    if (part == 0) {
    for (int it = gw; it < I_OUT; it += NGW) transpose_item(p.in[I_WOUT], D, (it / 16) * 64, (it % 16) * 64, wout_t, 1024, 0, false, scr, lane);
    }
    unsigned* sq = (unsigned*)scr;
    const int wr_off = (lane >> 3) * 9 + (lane & 7), rd_off = (16 * (lane >> 3)) * 9 + (lane & 7);
    const int NF = (part == 0) ? NFE + 8 * 104 : NFE;
    int r = (part == 0) ? NFE + gw : gw;
    if (r >= NF) return;
    CvtItem cur = cvt_item(p, r, lane);
    f32x4 v[16];
#pragma unroll
    for (int i = 0; i < 16; ++i) v[i] = *(const f32x4*)(cur.src + (size_t)(8 * i) * cur.N);
    for (;;) {
#pragma unroll
        for (int i = 0; i < 16; ++i) sq[wr_off + 8 * i * 9] = cvt4_fp8(Q_W * v[i][0], Q_W * v[i][1], Q_W * v[i][2], Q_W * v[i][3]);
        asm volatile("" ::: "memory");
        const int rn = r + NGW; const bool more = rn < NF;
        unsigned char* dst = cur.dst;
        if (more) { cur = cvt_item(p, rn, lane);
#pragma unroll
            for (int i = 0; i < 16; ++i) v[i] = *(const f32x4*)(cur.src + (size_t)(8 * i) * cur.N); }
        asm volatile("s_waitcnt lgkmcnt(0)" ::: "memory");
        unsigned d[16];
#pragma unroll
        for (int j = 0; j < 16; ++j) d[j] = sq[rd_off + j * 9];
        u32x4 o[4];
#pragma unroll
        for (int g = 0; g < 4; ++g) { const unsigned d0 = d[4 * g], d1 = d[4 * g + 1], d2 = d[4 * g + 2], d3 = d[4 * g + 3];
            const unsigned x = __builtin_amdgcn_perm(d1, d0, 0x05010400u), y = __builtin_amdgcn_perm(d1, d0, 0x07030602u), z = __builtin_amdgcn_perm(d3, d2, 0x05010400u), w = __builtin_amdgcn_perm(d3, d2, 0x07030602u);
            o[0][g] = __builtin_amdgcn_perm(z, x, 0x05040100u); o[1][g] = __builtin_amdgcn_perm(z, x, 0x07060302u); o[2][g] = __builtin_amdgcn_perm(w, y, 0x05040100u); o[3][g] = __builtin_amdgcn_perm(w, y, 0x07060302u); }
#pragma unroll
        for (int nn = 0; nn < 4; ++nn) *(u32x4*)(dst + (size_t)nn * 1024) = o[nn];
        asm volatile("" ::: "memory");
        if (!more) break;
        r = rn;
    }
}

__device__ __forceinline__ void phase_norm1(const Params& p, int G) {
    const int tid = opaque_tid(), lane = tid & 63, wave = tid >> 6;
    const int gw = (int)blockIdx.x * NWAVES + wave, NGW = G * NWAVES;
    const float* x = p.in[I_X]; const float* gain = p.in[I_N1G]; const float* mod = (const float*)(p.ws + WS_MOD);
    bf16_t* h = (bf16_t*)(p.ws + WS_H);
    for (int row = gw; row < T; row += NGW) {
        const int b = row / SEQ;
        const f32x4* xr = (const f32x4*)(x + (size_t)row * D) + lane;
        f32x4 v[4]; float s = 0.f;
#pragma unroll
        for (int j = 0; j < 4; ++j) { v[j] = xr[64 * j]; s += (v[j][0] * v[j][0] + v[j][1] * v[j][1]) + (v[j][2] * v[j][2] + v[j][3] * v[j][3]); }
        const float rstd = rsqrtf(wave_sum(s) * (1.0f / D) + NORM_EPS);
        const float* sh = mod + b * 6144; const float* scl = mod + b * 6144 + 1024;
        unsigned* o4 = (unsigned*)((unsigned char*)h + (size_t)row * D) + lane;
#pragma unroll
        for (int j = 0; j < 4; ++j) { const int k = 4 * lane + 256 * j;
            const f32x4 g = *(const f32x4*)(gain + k), s1 = *(const f32x4*)(scl + k), s0 = *(const f32x4*)(sh + k);
            const f32x4 y = (v[j] * rstd) * g * (s1 + 1.0f) + s0;
            o4[64 * j] = cvt4_fp8(Q_H2 * y[0], Q_H2 * y[1], Q_H2 * y[2], Q_H2 * y[3]); }
    }
}

constexpr size_t CTL_KMAX = 57344;
__device__ __forceinline__ void kmax_pass(const Params& p, int G) {
    const int tid = opaque_tid(), lane = tid & 63, wave = tid >> 6;
    const bf16_t* proj = (const bf16_t*)(p.ws + WS_PROJ);
    unsigned* km = (unsigned*)(p.ws + WS_CTL + CTL_KMAX);
    const int TPB = T / G;
    float mx = 0.f; const int tok0 = (int)blockIdx.x * TPB;
    for (int ti = wave; ti < TPB; ti += NWAVES) {
        const u32x4 kv = *(const u32x4*)(proj + (size_t)(tok0 + ti) * IC + RC + 512 + 8 * lane);
        float ss = 0.f;
#pragma unroll
        for (int j = 0; j < 4; ++j) { const float a = __uint_as_float(kv[j] << 16), bq = __uint_as_float(kv[j] & 0xffff0000u); ss += a * a + bq * bq; }
        ss += __shfl_xor(ss, 1); ss += __shfl_xor(ss, 2); ss += __shfl_xor(ss, 4);
        mx = fmaxf(mx, ss);
    }
    if ((lane & 7) == 0) atomicMax(km + (tok0 / SEQ) * 8 + (lane >> 3), __float_as_uint(mx));
}

__device__ __forceinline__ s16x4 vtr(const LAS unsigned char* pp) { typedef short v4i16_t __attribute__((ext_vector_type(4))); return __builtin_bit_cast(s16x4, __builtin_amdgcn_ds_read_tr16_b64_v4i16((LAS v4i16_t*)pp)); }
constexpr int ATT_BUF = 32768;
__device__ __forceinline__ float att_max3(float a, float b, float c) { float r; asm("v_max3_f32 %0, %1, %2, %3" : "=v"(r) : "v"(a), "v"(b), "v"(c)); return r; }
constexpr int ATT_QROWS = 128, ATT_NQB = SEQ / ATT_QROWS, ATT_UNITS = NB * 4 * ATT_NQB;
__device__ __forceinline__ void attn_unit(const Params& p, LAS unsigned char* lds, int b, int h, int qb, float lam) {
    const int tid = opaque_tid(), lane = tid & 63, wid = __builtin_amdgcn_readfirstlane(tid >> 6), r32 = lane & 31, hi = lane >> 5;
    const int c = wid & 1, qblk = wid >> 1;
    const bf16_t* proj = (const bf16_t*)(p.ws + WS_PROJ) + (size_t)b * SEQ * IC;
    const int q0 = qb * ATT_QROWS, qw0 = q0 + 32 * qblk;
    const bf16_t* Qb = proj + RC + h * 128 + c * 64;
    const bf16_t* Kb = proj + RC + 512 + h * 128;
    const bf16_t* Vb = proj + RC + 1024 + h * 128;
    const float slope = exp2f(-2.0f * (float)(h + 1)) * LOG2E;
    f32x16 o[4];
#pragma unroll
    for (int d = 0; d < 4; ++d) o[d] = f32x16{};
    f32x16 cb0;
#pragma unroll
    for (int r = 0; r < 16; ++r) cb0[r] = slope * (float)((r & 3) + 8 * (r >> 2) + 4 * hi);
    const float c32 = slope * 32.0f;
    float m_ = 0.f, l_ = 0.f;
    const int NT = (q0 + ATT_QROWS) / 64;
    const bf16_t* ksrc = Kb + (size_t)lane * IC + wid * 8;
    const int p0i = wid, p1i = wid + 8;
    const bf16_t* vsrc0 = Vb + (size_t)(16 * (p0i & 3) + (lane >> 2)) * IC + (p0i >> 2) * 32 + (lane & 3) * 8;
    const bf16_t* vsrc1 = Vb + (size_t)(16 * (p1i & 3) + (lane >> 2)) * IC + (p1i >> 2) * 32 + (lane & 3) * 8;
#define ATT_GLDS(gsrc_, ldsdst_) do { unsigned keep_; asm volatile("s_mov_b32 %0, m0\n\ts_mov_b32 m0, %2\n\ts_nop 0\n\tglobal_load_lds_dwordx4 %1, off\n\ts_mov_b32 m0, %0" : "=&s"(keep_) : "v"(gsrc_), "s"(ldsdst_) : "memory"); } while (0)
    const unsigned lds0 = (unsigned)(uintptr_t)lds;
#define ATT_DMA(t, buf) do { const size_t ro = (size_t)(t) * 64 * IC; const unsigned bb_ = (unsigned)__builtin_amdgcn_readfirstlane((int)(lds0 + (buf) * ATT_BUF + wid * 1024)); \
        ATT_GLDS(ksrc + ro, bb_); ATT_GLDS(ksrc + ro + 64, bb_ + 8192u); ATT_GLDS(vsrc0 + ro, bb_ + 16384u); ATT_GLDS(vsrc1 + ro, bb_ + 16384u + 8192u); } while (0)
    ATT_DMA(NT - 1, 0); ATT_DMA(NT - 2, 1);
    bf16x8 qr[4];
#pragma unroll
    for (int d0 = 0; d0 < 4; ++d0) qr[d0] = *(const bf16x8*)(Qb + (size_t)(qw0 + r32) * IC + d0 * 16 + hi * 8);
    float qn;
    { float q2 = 0.f;
#pragma unroll
      for (int d0 = 0; d0 < 4; ++d0)
#pragma unroll
          for (int j = 0; j < 8; ++j) { const float x = bf2f((unsigned short)qr[d0][j]); q2 += x * x; }
      q2 += __shfl_xor(q2, 32);
      qn = sqrtf(q2 * ((const float*)(p.ws + WS_CTL + CTL_KMAX))[b * 8 + h * 2 + c]) * 1.002f + 0.01f; }
    asm volatile("" : "+v"(qr[0]), "+v"(qr[1]), "+v"(qr[2]), "+v"(qr[3]));
    asm volatile("s_waitcnt vmcnt(0)" ::: "memory");
    __builtin_amdgcn_s_barrier();
    const int voff = ((lane >> 4) & 1) * 32 + (lane & 3) * 8 + (4 * hi + ((lane & 15) >> 2)) * 64;
    const int qpos = qw0 + r32;
    const bool late = wid >= 4;
    bf16x8 pf[4]; bool pend = false;
    float mtrue = -INFINITY;
    LAS unsigned* vote = (LAS unsigned*)(lds + 4 * ATT_BUF + 64);
#define ATT_PV(slot_) do { const LAS unsigned char* vb_ = lds + (slot_) * ATT_BUF + 16384 + voff; \
        _Pragma("unroll") for (int dblk = 0; dblk < 4; ++dblk) { _Pragma("unroll") for (int ks = 0; ks < 4; ++ks) { \
            const s16x4 lo = vtr(vb_ + (dblk * 4 + ks) * 1024), hh = vtr(vb_ + (dblk * 4 + ks) * 1024 + 512); \
            const bf16x8 vf = (bf16x8){lo[0], lo[1], lo[2], lo[3], hh[0], hh[1], hh[2], hh[3]}; \
            o[dblk] = __builtin_amdgcn_mfma_f32_32x32x16_bf16(vf, pf[ks], o[dblk], 0, 0, 0); } } } while (0)
    int it = 0;
    for (; it < NT; ++it) {
        const int kt = NT - 1 - it, cur = it & 3;
        const bool issued = (it + 2 < NT);
        if (issued) ATT_DMA(kt - 2, (it + 2) & 3);
        const int k0 = kt * 64;
        if (late && pend) { ATT_PV((it - 1) & 3); pend = false; }
        if (k0 <= qw0 + 31) {
            const LAS unsigned char* bb = lds + cur * ATT_BUF;
            const bool need_mask = (k0 + 63 > qw0);
            const LAS unsigned char* kb = bb + c * 8192 + hi * 1024 + r32 * 16;
            f32x16 s0 = cb0, s1 = cb0;
#pragma unroll
            for (int d0 = 0; d0 < 4; ++d0) {
                const bf16x8 a0 = *(const LAS bf16x8*)(kb + d0 * 2048), a1 = *(const LAS bf16x8*)(kb + d0 * 2048 + 512);
                s0 = __builtin_amdgcn_mfma_f32_32x32x16_bf16(a0, qr[d0], s0, 0, 0, 0);
                s1 = __builtin_amdgcn_mfma_f32_32x32x16_bf16(a1, qr[d0], s1, 0, 0, 0);
            }
            if (need_mask) {
                const int dq = k0 - qpos + 4 * hi;
#pragma unroll
                for (int r = 0; r < 16; ++r) { if (dq + ((r & 3) + 8 * (r >> 2)) > 0) s0[r] = -INFINITY; if (dq + ((r & 3) + 8 * (r >> 2)) + 32 > 0) s1[r] = -INFINITY; }
            }
            const float tb = slope * (float)(k0 - qpos);
            float rm0 = att_max3(s0[0], s0[1], s0[2]), rm1 = att_max3(s1[0], s1[1], s1[2]);
#pragma unroll
            for (int r = 3; r < 15; r += 2) { rm0 = att_max3(rm0, s0[r], s0[r + 1]); rm1 = att_max3(rm1, s1[r], s1[r + 1]); }
            float rm = att_max3(rm0, s0[15], att_max3(rm1, s1[15], -INFINITY) + c32);
            rm += tb;
            rm = fmaxf(rm, __shfl_xor(rm, 32));
            mtrue = fmaxf(mtrue, rm);
            if (__any(rm > m_ + 8.0f)) {
                const float mn = fmaxf(m_, rm);
                const float alpha = __builtin_amdgcn_exp2f(m_ - mn);
                m_ = mn; l_ *= alpha;
#pragma unroll
                for (int d = 0; d < 4; ++d)
#pragma unroll
                    for (int r = 0; r < 16; ++r) o[d][r] *= alpha;
            }
            const float off = tb - m_, off1 = off + c32;
            float ps = 0.f;
#pragma unroll
            for (int r = 0; r < 16; ++r) { s0[r] = __builtin_amdgcn_exp2f(s0[r] + off); s1[r] = __builtin_amdgcn_exp2f(s1[r] + off1); ps += s0[r] + s1[r]; }
            l_ += ps;
#pragma unroll
            for (int ks = 0; ks < 2; ++ks) {
                u32x4 w0, w1;
                w0.x = cvtpk(s0[8 * ks + 0], s0[8 * ks + 1]); w0.y = cvtpk(s0[8 * ks + 2], s0[8 * ks + 3]); w0.z = cvtpk(s0[8 * ks + 4], s0[8 * ks + 5]); w0.w = cvtpk(s0[8 * ks + 6], s0[8 * ks + 7]);
                w1.x = cvtpk(s1[8 * ks + 0], s1[8 * ks + 1]); w1.y = cvtpk(s1[8 * ks + 2], s1[8 * ks + 3]); w1.z = cvtpk(s1[8 * ks + 4], s1[8 * ks + 5]); w1.w = cvtpk(s1[8 * ks + 6], s1[8 * ks + 7]);
                pf[ks] = __builtin_bit_cast(bf16x8, w0); pf[2 + ks] = __builtin_bit_cast(bf16x8, w1);
            }
            if (late) pend = true; else ATT_PV(cur);
        }
        { const bool neg = (qn + slope * (float)(k0 - 1 - qpos) <= mtrue - 50.0f);
          if (lane == 0) vote[(it & 1) * 8 + wid] = __all(neg) ? 1u : 0u; }
        if (issued) asm volatile("s_waitcnt vmcnt(4)" ::: "memory"); else asm volatile("s_waitcnt vmcnt(0)" ::: "memory");
        asm volatile("s_waitcnt lgkmcnt(0)" ::: "memory");
        __builtin_amdgcn_s_barrier();
        { const u32x4 va = *(const LAS u32x4*)(vote + (it & 1) * 8), vb2 = *(const LAS u32x4*)(vote + (it & 1) * 8 + 4);
          if ((va.x & va.y & va.z & va.w & vb2.x & vb2.y & vb2.z & vb2.w) != 0u) { ++it; break; } }
    }
    if (late && pend) ATT_PV((it - 1) & 3);
    asm volatile("s_waitcnt vmcnt(0) lgkmcnt(0)" ::: "memory");
    __builtin_amdgcn_s_barrier();
#undef ATT_PV
#undef ATT_DMA
#undef ATT_GLDS
    l_ += __shfl_xor(l_, 32);
    LAS float* xb = (LAS float*)(lds + qblk * 16384);
    if (c == 1) {
        const float i1 = lam / l_;
#pragma unroll
        for (int d = 0; d < 4; ++d)
#pragma unroll
            for (int r = 0; r < 16; ++r) xb[(d * 16 + r) * 64 + lane] = o[d][r] * i1;
    }
    __syncthreads();
    if (c == 0) {
        const float i0 = 1.0f / l_;
        float ss = 0.f;
#pragma unroll
        for (int d = 0; d < 4; ++d)
#pragma unroll
            for (int r = 0; r < 16; ++r) { const float v = o[d][r] * i0 - xb[(d * 16 + r) * 64 + lane]; o[d][r] = v; ss += v * v; }
        ss += __shfl_xor(ss, 32);
        const float rstd = rsqrtf(ss * (1.0f / 128.0f) + NORM_EPS) * (1.0f - LAMBDA_INIT);
        const float* sg = p.in[I_SUBLN];
        bf16_t* yo = (bf16_t*)(p.ws + WS_YMIX) + (size_t)(b * SEQ + qw0 + r32) * D + RW + h * 128;
#pragma unroll
        for (int d = 0; d < 4; ++d)
#pragma unroll
            for (int g = 0; g < 4; ++g) { const int dd = 32 * d + 8 * g + 4 * hi; const f32x4 gv = *(const f32x4*)(sg + dd);
                u32x2 w; w.x = cvtpk(o[d][4 * g] * rstd * gv[0], o[d][4 * g + 1] * rstd * gv[1]); w.y = cvtpk(o[d][4 * g + 2] * rstd * gv[2], o[d][4 * g + 3] * rstd * gv[3]);
                *(u32x2*)(yo + dd) = w; }
    }
    __syncthreads();
}

constexpr int RCH = 32;
constexpr int RK_R = 0, RK_KM = 8192, RK_DEC = 16384, RK_KK = 24576, RK_BB = 32768, RK_VV = 40960, RK_GG = 49152;
constexpr int RK_AW = 57344;
constexpr int RK_AA = RK_AW + 4608;
constexpr int RK_AG = RK_AA + 4608;
constexpr int RK_BON = RK_AG + 8704;
constexpr int RK_MU = RK_BON + 128;
constexpr int RK_RAW = 77824;
constexpr int RK_IM = RK_RAW + 33 * 1024;
constexpr int RK_LSEG = RK_IM + OPREC;
constexpr int RK_END = RK_LSEG + 2048;
static_assert(RK_MU + 1792 <= RK_RAW && RK_END <= LDS_BYTES - 64 && (RK_RAW % 1024) == 0, "rwkv prep LDS map");
template <int CTRL> __device__ __forceinline__ float dpp_add(float v) { return v + __builtin_bit_cast(float, __builtin_amdgcn_update_dpp(0, __builtin_bit_cast(int, v), CTRL, 0xf, 0xf, true)); }
__device__ __forceinline__ float red16(float v) {
    v = dpp_add<0xB1>(v);
    v = dpp_add<0x4E>(v);
    v = dpp_add<0x141>(v);
    v = dpp_add<0x140>(v);
    return v;
}
__device__ __forceinline__ int rk_piece_col(int pc, int h) {
    return pc < 8 ? h * 64 + 8 * pc : (pc < 16 ? 512 + h * 64 + 8 * (pc - 8) : (pc < 24 ? 1024 + h * 64 + 8 * (pc - 16) : 1536 + 8 * (pc - 24)));
}
#define RK_BAR() do { asm volatile("s_waitcnt lgkmcnt(0)" ::: "memory"); __builtin_amdgcn_s_barrier(); asm volatile("" ::: "memory"); } while (0)
__device__ __forceinline__ void rwkv_prep(const Params& p, LAS unsigned char* lds, int b, int h, int ch0, int ch1) {
    const int tid = opaque_tid(), lane = tid & 63, wid = __builtin_amdgcn_readfirstlane(tid >> 6);
    const bf16_t* proj = (const bf16_t*)(p.ws + WS_PROJ) + (size_t)b * SEQ * IC;
    LAS float* R_ = (LAS float*)(lds + RK_R); LAS float* KM_ = (LAS float*)(lds + RK_KM); LAS float* DEC_ = (LAS float*)(lds + RK_DEC); LAS float* KK_ = (LAS float*)(lds + RK_KK);
    LAS float* BB_ = (LAS float*)(lds + RK_BB); LAS float* VV_ = (LAS float*)(lds + RK_VV); LAS float* GG_ = (LAS float*)(lds + RK_GG); LAS float* BON_ = (LAS float*)(lds + RK_BON);
    LAS float* MU_ = (LAS float*)(lds + RK_MU);
    const int dpc = lane < 56 ? lane : 55;
    const bf16_t* dsrc = proj + rk_piece_col(dpc, h);
#define RK_DMA(t0_) do { for (int rho = wid; rho < 33; rho += NWAVES) { int tok = (t0_) - 1 + rho; tok = tok < 0 ? 0 : tok; \
        __builtin_amdgcn_global_load_lds((const unsigned*)(dsrc + (size_t)tok * IC), (LAS unsigned*)(lds + RK_RAW + rho * 1024), 16, 0, 0); } } while (0)
    RK_DMA(ch0 * RCH);
    if (tid < 448) MU_[tid] = p.in[I_MU][rk_piece_col(tid >> 3, h) + (tid & 7)];
    const int ntile = wid & 3, ttile = wid >> 2, fn = lane & 15, fk = lane >> 4;
    const int ncol = h * 64 + ntile * 16 + fn;
    bf16x8 bw[2], ba[2], bg[4];
    {
        const float* wup = p.in[I_WUP]; const float* aup = p.in[I_AUP]; const float* gup = p.in[I_GUP];
#pragma unroll
        for (int ks = 0; ks < 2; ++ks) { float t[8], u[8];
#pragma unroll
            for (int j = 0; j < 8; ++j) { const int k = 32 * ks + 8 * fk + j; t[j] = wup[k * RW + ncol]; u[j] = aup[k * RW + ncol]; }
            u32x4 a, c; a.x = cvtpk(t[0], t[1]); a.y = cvtpk(t[2], t[3]); a.z = cvtpk(t[4], t[5]); a.w = cvtpk(t[6], t[7]);
            c.x = cvtpk(u[0], u[1]); c.y = cvtpk(u[2], u[3]); c.z = cvtpk(u[4], u[5]); c.w = cvtpk(u[6], u[7]);
            bw[ks] = __builtin_bit_cast(bf16x8, a); ba[ks] = __builtin_bit_cast(bf16x8, c); }
#pragma unroll
        for (int ks = 0; ks < 4; ++ks) { float t[8];
#pragma unroll
            for (int j = 0; j < 8; ++j) { const int k = 32 * ks + 8 * fk + j; t[j] = gup[k * RW + ncol]; }
            u32x4 a; a.x = cvtpk(t[0], t[1]); a.y = cvtpk(t[2], t[3]); a.z = cvtpk(t[4], t[5]); a.w = cvtpk(t[6], t[7]);
            bg[ks] = __builtin_bit_cast(bf16x8, a); }
    }
    const float w0n = p.in[I_W0][ncol], a0n = p.in[I_A0][ncol];
    const int q16 = tid & 15, tk16 = tid >> 4;
    const f32x4 kkc = *(const f32x4*)(p.in[I_KK] + h * 64 + 4 * q16), kac = *(const f32x4*)(p.in[I_KA] + h * 64 + 4 * q16), rkc = *(const f32x4*)(p.in[I_RK] + h * 64 + 4 * q16);
    const size_t hb = (size_t)(b * 8 + h) * SEQ * 64;
    float* gVS = (float*)(p.ws + WS_VS) + hb; float* gGG = p.out + (size_t)16 * 1024 * 1024 + hb; float* gBON = (float*)(p.ws + WS_BON) + (size_t)(b * 8 + h) * SEQ;
    unsigned char* gOPS = p.ws + WS_OPS + (size_t)(b * 8 + h) * (SEQ / RCH) * OPREC;
    for (int ch = ch0; ch < ch1; ++ch) {
        const int t0 = ch * RCH;
        if (ch > ch0) { if (wid == 0) asm volatile("s_waitcnt vmcnt(8)" ::: "memory"); else if (wid == 1) asm volatile("s_waitcnt vmcnt(7)" ::: "memory"); else asm volatile("s_waitcnt vmcnt(6)" ::: "memory"); } else asm volatile("s_waitcnt vmcnt(0)" ::: "memory");
        RK_BAR();
#pragma unroll
        for (int it = 0; it < 4; ++it) { const int item = tid + it * NTHREADS;
            if (item < RCH * 56) { const int tk = item / 56, pc = item - tk * 56;
                const u32x4 cv = *(const LAS u32x4*)(lds + RK_RAW + (tk + 1) * 1024 + pc * 16);
                u32x4 pv = *(const LAS u32x4*)(lds + RK_RAW + tk * 1024 + pc * 16);
                if (t0 + tk == 0) pv = (u32x4){0u, 0u, 0u, 0u};
                const f32x4 m0 = *(const LAS f32x4*)(MU_ + pc * 8), m1 = *(const LAS f32x4*)(MU_ + pc * 8 + 4);
                float xv[8];
#pragma unroll
                for (int j = 0; j < 4; ++j) { const unsigned cw = cv[j], pw = pv[j];
                    const float c0 = __uint_as_float(cw << 16), c1 = __uint_as_float(cw & 0xffff0000u), p0 = __uint_as_float(pw << 16), p1 = __uint_as_float(pw & 0xffff0000u);
                    const float ma = (j < 2) ? m0[2 * j] : m1[2 * j - 4], mb = (j < 2) ? m0[2 * j + 1] : m1[2 * j - 3];
                    xv[2 * j] = c0 + ma * (p0 - c0); xv[2 * j + 1] = c1 + mb * (p1 - c1); }
                const int seg = pc >> 3, pi = pc & 7;
                if (seg <= 2) { LAS float* dst = (seg == 0 ? R_ : (seg == 1 ? KM_ : VV_)) + tk * 64 + 8 * pi;
                    *(LAS f32x4*)dst = (f32x4){xv[0], xv[1], xv[2], xv[3]}; *(LAS f32x4*)(dst + 4) = (f32x4){xv[4], xv[5], xv[6], xv[7]}; }
                else if (seg == 3) { u32x4 w; w.x = cvtpk(tanh_fast(xv[0]), tanh_fast(xv[1])); w.y = cvtpk(tanh_fast(xv[2]), tanh_fast(xv[3])); w.z = cvtpk(tanh_fast(xv[4]), tanh_fast(xv[5])); w.w = cvtpk(tanh_fast(xv[6]), tanh_fast(xv[7]));
                    *(LAS u32x4*)(lds + RK_AW + tk * 144 + 16 * pi) = w; }
                else if (seg == 4) { u32x4 w; w.x = cvtpk(xv[0], xv[1]); w.y = cvtpk(xv[2], xv[3]); w.z = cvtpk(xv[4], xv[5]); w.w = cvtpk(xv[6], xv[7]);
                    *(LAS u32x4*)(lds + RK_AA + tk * 144 + 16 * pi) = w; }
                else { u32x4 w; w.x = cvtpk(sigmoidf_(xv[0]), sigmoidf_(xv[1])); w.y = cvtpk(sigmoidf_(xv[2]), sigmoidf_(xv[3])); w.z = cvtpk(sigmoidf_(xv[4]), sigmoidf_(xv[5])); w.w = cvtpk(sigmoidf_(xv[6]), sigmoidf_(xv[7]));
                    *(LAS u32x4*)(lds + RK_AG + tk * 272 + (pc - 40) * 16) = w; }
            } }
        __syncthreads();
        if (ch + 1 < ch1) RK_DMA(t0 + RCH);
        {
            f32x4 cw = (f32x4){0.f, 0.f, 0.f, 0.f}, ca = cw, cg2 = cw;
            const int tok = ttile * 16 + fn;
#pragma unroll
            for (int ks = 0; ks < 2; ++ks) {
                const bf16x8 aw = *(const LAS bf16x8*)(lds + RK_AW + tok * 144 + (32 * ks + 8 * fk) * 2);
                const bf16x8 aa = *(const LAS bf16x8*)(lds + RK_AA + tok * 144 + (32 * ks + 8 * fk) * 2);
                cw = __builtin_amdgcn_mfma_f32_16x16x32_bf16(aw, bw[ks], cw, 0, 0, 0);
                ca = __builtin_amdgcn_mfma_f32_16x16x32_bf16(aa, ba[ks], ca, 0, 0, 0);
            }
#pragma unroll
            for (int ks = 0; ks < 4; ++ks) {
                const bf16x8 ag = *(const LAS bf16x8*)(lds + RK_AG + tok * 272 + (32 * ks + 8 * fk) * 2);
                cg2 = __builtin_amdgcn_mfma_f32_16x16x32_bf16(ag, bg[ks], cg2, 0, 0, 0);
            }
#pragma unroll
            for (int r = 0; r < 4; ++r) { const int tk = ttile * 16 + 4 * fk + r, n = ntile * 16 + fn;
                DEC_[tk * 64 + n] = -0.6065306597126334f * sigmoidf_(cw[r] + w0n);
                BB_[tk * 64 + n] = sigmoidf_(ca[r] + a0n);
                GG_[tk * 64 + n] = cg2[r]; }
        }
        RK_BAR();
        {
            const f32x4 kp = *(const LAS f32x4*)(KM_ + tk16 * 64 + 4 * q16), av = *(const LAS f32x4*)(BB_ + tk16 * 64 + 4 * q16), rr = *(const LAS f32x4*)(R_ + tk16 * 64 + 4 * q16);
            const f32x4 kkv = kp * kkc;
            const float nrm2 = red16((kkv[0] * kkv[0] + kkv[1] * kkv[1]) + (kkv[2] * kkv[2] + kkv[3] * kkv[3]));
            const f32x4 kkn = kkv * __builtin_amdgcn_rsqf(fmaxf(nrm2, 1e-24f));
            const f32x4 kmod = kp * ((av - 1.0f) * kac + 1.0f);
            const f32x4 t = rr * kmod * rkc;
            const float bs = red16((t[0] + t[1]) + (t[2] + t[3]));
            *(LAS f32x4*)(KK_ + tk16 * 64 + 4 * q16) = kkn; *(LAS f32x4*)(BB_ + tk16 * 64 + 4 * q16) = kkn * av; *(LAS f32x4*)(KM_ + tk16 * 64 + 4 * q16) = kmod;
            if (q16 == 0) BON_[tk16] = bs;
        }
        RK_BAR();
        {
            const int d1 = tid & 63, q1 = wid;
            float lw[4], cs[4];
#pragma unroll
            for (int e = 0; e < 4; ++e) lw[e] = DEC_[(4 * q1 + e) * 64 + d1];
            cs[0] = lw[0]; cs[1] = cs[0] + lw[1]; cs[2] = cs[1] + lw[2]; cs[3] = cs[2] + lw[3];
            ((LAS float*)(lds + RK_LSEG))[q1 * 64 + d1] = cs[3];
            { const float x0 = VV_[(4 * q1) * 64 + d1], x1 = VV_[(4 * q1 + 1) * 64 + d1], x2 = VV_[(4 * q1 + 2) * 64 + d1], x3 = VV_[(4 * q1 + 3) * 64 + d1];
              u32x2 w; w.x = cvtpk(x0, x1); w.y = cvtpk(x2, x3); *(LAS u32x2*)(lds + RK_IM + OP_VT + d1 * 80 + q1 * 8) = w; }
            RK_BAR();
            float off = 0.f, tot = 0.f;
#pragma unroll
            for (int qq = 0; qq < 8; ++qq) { const float sg = ((const LAS float*)(lds + RK_LSEG))[qq * 64 + d1]; tot += sg; if (qq < q1) off += sg; }
            const float etot = __expf(tot);
            float ePprev = __expf(off);
            float bc[4], kc4[4];
#pragma unroll
            for (int e = 0; e < 4; ++e) { const int tk = 4 * q1 + e;
                const float eP = __expf(off + cs[e]), eN = __builtin_amdgcn_rcpf(eP), eE = etot * eN;
                const float kap = KK_[tk * 64 + d1], bet = BB_[tk * 64 + d1], kk_ = KM_[tk * 64 + d1], rr = R_[tk * 64 + d1];
                const unsigned w0 = cvtpk(-kap * ePprev, rr * eP), w1 = cvtpk(bet * eN, kk_ * eN);
                *(LAS unsigned short*)(lds + RK_IM + OP_AT + tk * 144 + d1 * 2) = (unsigned short)(w0 & 0xffffu); *(LAS unsigned short*)(lds + RK_IM + OP_RT + tk * 144 + d1 * 2) = (unsigned short)(w0 >> 16);
                *(LAS unsigned short*)(lds + RK_IM + OP_BH + tk * 144 + d1 * 2) = (unsigned short)(w1 & 0xffffu); *(LAS unsigned short*)(lds + RK_IM + OP_KH + tk * 144 + d1 * 2) = (unsigned short)(w1 >> 16);
                bc[e] = bet * eE; kc4[e] = kk_ * eE; ePprev = eP; }
            u32x2 wb, wk; wb.x = cvtpk(bc[0], bc[1]); wb.y = cvtpk(bc[2], bc[3]); wk.x = cvtpk(kc4[0], kc4[1]); wk.y = cvtpk(kc4[2], kc4[3]);
            *(LAS u32x2*)(lds + RK_IM + OP_BCT + d1 * 80 + q1 * 8) = wb; *(LAS u32x2*)(lds + RK_IM + OP_KCT + d1 * 80 + q1 * 8) = wk;
            if (q1 == 0) ((LAS float*)(lds + RK_IM + OP_P31))[d1] = etot;
        }
        RK_BAR();
        {
            unsigned char* rec = gOPS + (size_t)ch * OPREC;
#pragma unroll
            for (int i = 0; i < 5; ++i) { const int o = (tid + i * NTHREADS) * 16; if (o < OPREC) *(u32x4*)(rec + o) = *(const LAS u32x4*)(lds + RK_IM + o); }
            const size_t go = (size_t)t0 * 64 + tid * 4;
            *(f32x4*)(gVS + go) = *(const LAS f32x4*)(VV_ + tid * 4);
            *(f32x4*)(gGG + go) = *(const LAS f32x4*)(GG_ + tid * 4);
            if (tid < RCH) gBON[t0 + tid] = BON_[tid];
        }
    }
    asm volatile("s_waitcnt vmcnt(0)" ::: "memory");
    __syncthreads();
#undef RK_DMA
}

constexpr int CS_IN = 32768;
constexpr int CS_OP = 2 * CS_IN;
constexpr int CS_AT = 0, CS_RT = 4608, CS_BH = 9216, CS_KH = 13824, CS_BCT = 18432, CS_KCT = 23552, CS_VT = 28672, CS_P31 = 31744;
constexpr int CS_MT2 = CS_OP, CS_MT3 = CS_OP + 2560, CS_MT4 = CS_OP + 5120;
constexpr int CS_M1F = CS_OP + 7680;
constexpr int CS_XF = CS_OP + 12288;
constexpr int CS_UB = CS_OP + 16896;
constexpr int CS_SB = CS_OP + 19456;
constexpr int CS_YY = CS_OP + 24064;
constexpr int CS_END = CS_OP + 28160;
static_assert(CS_END <= LDS_BYTES - 64, "rwkv scan LDS map");
__device__ __forceinline__ int crow32(int r, int hi) { return (r & 3) + 8 * (r >> 2) + 4 * hi; }
__device__ __forceinline__ void rwkv_scan(const Params& p, LAS unsigned char* lds, int b, int h, int half) {
    const int tid = opaque_tid(), lane = tid & 63, wid = __builtin_amdgcn_readfirstlane(tid >> 6), r32 = lane & 31, hi = lane >> 5;
    const unsigned char* gOPS = p.ws + WS_OPS + (size_t)(b * 8 + h) * (SEQ / RCH) * OPREC;
    float* yraw = p.out + (size_t)b * SEQ * RW + h * 64 + half * 32;
#define RS_DMA(ch_, buf) do { LAS unsigned char* bb_ = lds + (buf) * CS_IN; const unsigned char* rec_ = gOPS + (size_t)(ch_) * OPREC; \
        for (int pc = wid; pc < 32; pc += NWAVES) { \
            const unsigned char* src_ = rec_ + (pc < 28 ? pc * 1024 : (pc < 31 ? OP_VT + half * 2560 + (pc - 28) * 1024 : OP_P31)) + lane * 16; \
            __builtin_amdgcn_global_load_lds((const unsigned*)src_, (LAS unsigned*)(bb_ + pc * 1024), 16, 0, 0); } } while (0)
    RS_DMA(0, 0);
    for (int i = tid; i < 4608 / 4; i += NTHREADS) ((LAS unsigned*)(lds + CS_SB))[i] = 0u;
    f32x16 Sacc = f32x16{};
    f32x16 Xacc = f32x16{};
    for (int ch = 0; ch < SEQ / RCH; ++ch) {
        const int t0 = ch * RCH, cur = ch & 1;
        if (wid < 4 && ch > 0) asm volatile("s_waitcnt vmcnt(1)" ::: "memory"); else asm volatile("s_waitcnt vmcnt(0)" ::: "memory");
        RK_BAR();
        if (ch + 1 < SEQ / RCH) RS_DMA(ch + 1, cur ^ 1);
        const LAS unsigned char* ib = lds + cur * CS_IN;
        if (wid < 4) {
            const LAS unsigned char* Am = ib + ((wid & 1) ? CS_KH : CS_BH) + r32 * 144 + hi * 16;
            const LAS unsigned char* Bm = ib + ((wid & 2) ? CS_RT : CS_AT) + r32 * 144 + hi * 16;
            f32x16 acc = f32x16{};
#pragma unroll
            for (int ks = 0; ks < 4; ++ks) acc = __builtin_amdgcn_mfma_f32_32x32x16_bf16(*(const LAS bf16x8*)(Am + ks * 32), *(const LAS bf16x8*)(Bm + ks * 32), acc, 0, 0, 0);
            const int lim = (wid < 2) ? r32 : r32 + 1;
#pragma unroll
            for (int rg = 0; rg < 16; ++rg) if (crow32(rg, hi) >= lim) acc[rg] = 0.f;
            if (wid == 0) {
#pragma unroll
                for (int rg = 0; rg < 16; ++rg) ((LAS float*)(lds + CS_M1F))[crow32(rg, hi) * 36 + r32] = acc[rg];
            } else {
                LAS unsigned char* Mt = lds + (wid == 1 ? CS_MT2 : (wid == 2 ? CS_MT3 : CS_MT4)) + r32 * 80 + hi * 8;
#pragma unroll
                for (int g = 0; g < 4; ++g) { u32x2 w; w.x = cvtpk(acc[4 * g], acc[4 * g + 1]); w.y = cvtpk(acc[4 * g + 2], acc[4 * g + 3]); *(LAS u32x2*)(Mt + g * 16) = w; }
            }
        } else if (wid < 6) {
            const LAS unsigned char* Am = ib + (wid == 4 ? CS_AT : CS_RT) + r32 * 144 + hi * 16;
            const LAS unsigned char* Bm = lds + CS_SB + r32 * 144 + hi * 16;
            Xacc = f32x16{};
#pragma unroll
            for (int ks = 0; ks < 4; ++ks) Xacc = __builtin_amdgcn_mfma_f32_32x32x16_bf16(*(const LAS bf16x8*)(Am + ks * 32), *(const LAS bf16x8*)(Bm + ks * 32), Xacc, 0, 0, 0);
        }
        RK_BAR();
        if (wid == 4) {
            const LAS unsigned char* Am = lds + CS_MT2 + r32 * 80 + hi * 16;
            const LAS unsigned char* Bm = ib + CS_VT + r32 * 80 + hi * 16;
#pragma unroll
            for (int ks = 0; ks < 2; ++ks) Xacc = __builtin_amdgcn_mfma_f32_32x32x16_bf16(*(const LAS bf16x8*)(Am + ks * 32), *(const LAS bf16x8*)(Bm + ks * 32), Xacc, 0, 0, 0);
#pragma unroll
            for (int g = 0; g < 4; ++g) *(LAS f32x4*)(lds + CS_XF + r32 * 144 + (8 * g + 4 * hi) * 4) = (f32x4){Xacc[4 * g], Xacc[4 * g + 1], Xacc[4 * g + 2], Xacc[4 * g + 3]};
        }
        RK_BAR();
        {
            const int v = tid >> 4, l = tid & 15;
            float m0[32], m1[32];
#pragma unroll
            for (int c4 = 0; c4 < 8; ++c4) { const f32x4 a = *(const LAS f32x4*)(lds + CS_M1F + l * 144 + c4 * 16), c = *(const LAS f32x4*)(lds + CS_M1F + (l + 16) * 144 + c4 * 16);
                m0[4 * c4] = a[0]; m0[4 * c4 + 1] = a[1]; m0[4 * c4 + 2] = a[2]; m0[4 * c4 + 3] = a[3]; m1[4 * c4] = c[0]; m1[4 * c4 + 1] = c[1]; m1[4 * c4 + 2] = c[2]; m1[4 * c4 + 3] = c[3]; }
            const float x0 = ((const LAS float*)(lds + CS_XF))[v * 36 + l], x1 = ((const LAS float*)(lds + CS_XF))[v * 36 + l + 16];
            float u0 = 0.f, u1 = 0.f;
#pragma unroll
            for (int i = 0; i < 32; ++i) {
                const float part = (i < 16) ? u0 * m0[i] : (u0 * m0[i] + u1 * m1[i]);
                const float tot = red16(part);
                if (i < 16) u0 = (l == i) ? x0 + tot : u0; else u1 = (l == i - 16) ? x1 + tot : u1;
            }
            const unsigned w = cvtpk(u0, u1);
            *(LAS unsigned short*)(lds + CS_UB + v * 80 + l * 2) = (unsigned short)(w & 0xffffu); *(LAS unsigned short*)(lds + CS_UB + v * 80 + (l + 16) * 2) = (unsigned short)(w >> 16);
        }
        RK_BAR();
        if (wid == 5) {
            const LAS unsigned char* A3 = lds + CS_MT3 + r32 * 80 + hi * 16; const LAS unsigned char* A4 = lds + CS_MT4 + r32 * 80 + hi * 16;
            const LAS unsigned char* Bu = lds + CS_UB + r32 * 80 + hi * 16; const LAS unsigned char* Bv = ib + CS_VT + r32 * 80 + hi * 16;
#pragma unroll
            for (int ks = 0; ks < 2; ++ks) { Xacc = __builtin_amdgcn_mfma_f32_32x32x16_bf16(*(const LAS bf16x8*)(A3 + ks * 32), *(const LAS bf16x8*)(Bu + ks * 32), Xacc, 0, 0, 0);
                Xacc = __builtin_amdgcn_mfma_f32_32x32x16_bf16(*(const LAS bf16x8*)(A4 + ks * 32), *(const LAS bf16x8*)(Bv + ks * 32), Xacc, 0, 0, 0); }
#pragma unroll
            for (int rg = 0; rg < 16; ++rg) ((LAS float*)(lds + CS_YY))[crow32(rg, hi) * 32 + r32] = Xacc[rg];
        } else if (wid < 2) {
#pragma unroll
            for (int g = 0; g < 4; ++g) { const f32x4 pv = *(const LAS f32x4*)(ib + CS_P31 + (32 * wid + 8 * g + 4 * hi) * 4);
                Sacc[4 * g] *= pv[0]; Sacc[4 * g + 1] *= pv[1]; Sacc[4 * g + 2] *= pv[2]; Sacc[4 * g + 3] *= pv[3]; }
            const LAS unsigned char* Ab = ib + CS_BCT + (32 * wid + r32) * 80 + hi * 16; const LAS unsigned char* Ak = ib + CS_KCT + (32 * wid + r32) * 80 + hi * 16;
            const LAS unsigned char* Bu = lds + CS_UB + r32 * 80 + hi * 16; const LAS unsigned char* Bv = ib + CS_VT + r32 * 80 + hi * 16;
#pragma unroll
            for (int ks = 0; ks < 2; ++ks) { Sacc = __builtin_amdgcn_mfma_f32_32x32x16_bf16(*(const LAS bf16x8*)(Ab + ks * 32), *(const LAS bf16x8*)(Bu + ks * 32), Sacc, 0, 0, 0);
                Sacc = __builtin_amdgcn_mfma_f32_32x32x16_bf16(*(const LAS bf16x8*)(Ak + ks * 32), *(const LAS bf16x8*)(Bv + ks * 32), Sacc, 0, 0, 0); }
#pragma unroll
            for (int g = 0; g < 4; ++g) { u32x2 w; w.x = cvtpk(Sacc[4 * g], Sacc[4 * g + 1]); w.y = cvtpk(Sacc[4 * g + 2], Sacc[4 * g + 3]); *(LAS u32x2*)(lds + CS_SB + r32 * 144 + (32 * wid + 8 * g + 4 * hi) * 2) = w; }
        }
        RK_BAR();
        if (tid < 256) { const int tk = tid >> 3, sub = tid & 7; *(f32x4*)(yraw + (size_t)(t0 + tk) * RW + sub * 4) = *(const LAS f32x4*)(lds + CS_YY + tk * 128 + sub * 16); }
    }
    asm volatile("s_waitcnt vmcnt(0)" ::: "memory");
    __syncthreads();
#undef RS_DMA
}
__device__ __forceinline__ void rwkv_finalize(const Params& p, int G) {
    const int tid = opaque_tid(), q16 = tid & 15;
    const float* yraw = p.out; const float* gGG = p.out + (size_t)16 * 1024 * 1024; const float* gVS = (const float*)(p.ws + WS_VS); const float* gBON = (const float*)(p.ws + WS_BON);
    bf16_t* ymix = (bf16_t*)(p.ws + WS_YMIX);
    for (int item = (int)blockIdx.x * (NTHREADS / 16) + (tid >> 4); item < T * 8; item += G * (NTHREADS / 16)) {
        const int tok = item >> 3, h = item & 7, b = tok / SEQ, t = tok - b * SEQ;
        const f32x4 y = *(const f32x4*)(yraw + (size_t)tok * RW + h * 64 + 4 * q16);
        const size_t ho = ((size_t)(b * 8 + h) * SEQ + t) * 64 + 4 * q16;
        const f32x4 vv = *(const f32x4*)(gVS + ho), gg = *(const f32x4*)(gGG + ho);
        const float bon = gBON[(size_t)(b * 8 + h) * SEQ + t];
        const f32x4 gng = *(const f32x4*)(p.in[I_GNG] + h * 64 + 4 * q16), gnb = *(const f32x4*)(p.in[I_GNB] + h * 64 + 4 * q16);
        const float mean = red16((y[0] + y[1]) + (y[2] + y[3])) * (1.0f / 64.0f);
        const f32x4 dl = y - mean;
        const float var = red16((dl[0] * dl[0] + dl[1] * dl[1]) + (dl[2] * dl[2] + dl[3] * dl[3])) * (1.0f / 64.0f);
        const f32x4 yn = dl * __builtin_amdgcn_rsqf(var + GN_EPS) * gng + gnb;
        const f32x4 ov = (yn + vv * bon) * gg;
        u32x2 w; w.x = cvtpk(ov[0], ov[1]); w.y = cvtpk(ov[2], ov[3]);
        *(u32x2*)(ymix + (size_t)tok * D + h * 64 + 4 * q16) = w;
    }
}
#undef RK_BAR

constexpr int RT_X = 0;
constexpr int RT_LG = 131584;
constexpr int RT_GS = RT_LG + 16896;
constexpr int RT_RS = RT_GS + 8192;
constexpr int RT_HIST = RT_RS + 512;
constexpr int RT_CE = RT_HIST + 128;
static_assert(RT_CE + 1024 <= LDS_BYTES - 64, "router LDS map");
__device__ __forceinline__ int rt_swz(int k) { const int g = k >> 2; return ((g ^ ((g >> 4) & 3)) << 2) | (k & 3); }
__device__ __forceinline__ void phase_router(const Params& p, LAS unsigned char* lds, int G) {
    const int tid = opaque_tid(), lane = tid & 63, wave = __builtin_amdgcn_readfirstlane(tid >> 6);
    LAS float* xt = (LAS float*)(lds + RT_X); LAS float* lg = (LAS float*)(lds + RT_LG); LAS float* gs = (LAS float*)(lds + RT_GS); LAS float* shl = gs + 1024;
    LAS float* rsl = (LAS float*)(lds + RT_RS); LAS int* hist = (LAS int*)(lds + RT_HIST); LAS float* cew = (LAS float*)(lds + RT_CE);
    const float* rw = p.in[I_RTW];
    const float* x1 = p.out; const float* gain = p.in[I_N2G]; const float* mod = (const float*)(p.ws + WS_MOD); const float* rb = p.in[I_RTB];
    unsigned char* h2q = p.ws + WS_H;
    int* ridx = (int*)(p.ws + WS_ROUTE); float* rwt = (float*)(p.ws + WS_ROUTE + 512 * 1024);
    int* blockcnt = (int*)(p.ws + WS_CTL + 4096);
    const int TPB = T / G;
    const int blk = blockIdx.x, tok0 = blk * TPB, b = tok0 / SEQ;
    for (int k = tid; k < 1024; k += NTHREADS) { gs[rt_swz(k)] = gain[k] * (1.0f + mod[b * 6144 + 4096 + k]); shl[rt_swz(k)] = mod[b * 6144 + 3072 + k]; }
    if (tid < 32) hist[tid] = 0;
    __syncthreads();
    const int j = lane & 31, hh = lane >> 5, kb = 128 * wave + 64 * hh;
    float breg[64];
    { float cpart = 0.f;
#pragma unroll
        for (int s_ = 0; s_ < 64; ++s_) { const float w = rw[(size_t)(kb + s_) * 32 + j]; cpart += shl[rt_swz(kb + s_)] * w; breg[s_] = w * gs[rt_swz(kb + s_)]; }
        cpart += __shfl_xor(cpart, 32);
        if (lane < 32) cew[wave * 32 + lane] = cpart; }
    const int xsw = (2 * wave + hh) & 3;
    for (int t0 = 0; t0 < TPB; t0 += 128) {
        f32x4 v[16];
#define RT_LOAD(tl_) do { _Pragma("unroll") for (int q = 0; q < 4; ++q) { const int tq = t0 + 32 * (tl_) + 4 * wave + q; const f32x4* xr = (const f32x4*)(x1 + (size_t)(tok0 + (tq < TPB ? tq : 0)) * D) + lane; \
            _Pragma("unroll") for (int jj = 0; jj < 4; ++jj) v[4 * q + jj] = xr[64 * jj]; } } while (0)
        RT_LOAD(0);
#pragma unroll
        for (int tl = 0; tl < 4; ++tl) {
#pragma unroll
            for (int q = 0; q < 4; ++q) { float s = 0.f;
#pragma unroll
                for (int jj = 0; jj < 4; ++jj) { const f32x4 t = v[4 * q + jj]; s += (t[0] * t[0] + t[1] * t[1]) + (t[2] * t[2] + t[3] * t[3]); }
                const float rstd = rsqrtf(wave_sum(s) * (1.0f / D) + NORM_EPS);
                if (lane == 0) rsl[32 * tl + 4 * wave + q] = rstd;
#pragma unroll
                for (int jj = 0; jj < 4; ++jj) { const int g = lane + 64 * jj; *(LAS f32x4*)(xt + (4 * wave + q) * 1028 + 4 * (g ^ ((g >> 4) & 3))) = v[4 * q + jj]; } }
            __syncthreads();
            if (tl < 3) RT_LOAD(tl + 1);
            f32x16 acc = f32x16{};
            { const LAS float* arow = xt + (lane & 31) * 1028 + kb;
#pragma unroll
                for (int c = 0; c < 16; ++c) { const f32x4 a4 = *(const LAS f32x4*)(arow + 4 * (c ^ xsw));
                    acc = __builtin_amdgcn_mfma_f32_32x32x2f32(a4[0], breg[4 * c + 0], acc, 0, 0, 0);
                    acc = __builtin_amdgcn_mfma_f32_32x32x2f32(a4[1], breg[4 * c + 1], acc, 0, 0, 0);
                    acc = __builtin_amdgcn_mfma_f32_32x32x2f32(a4[2], breg[4 * c + 2], acc, 0, 0, 0);
                    acc = __builtin_amdgcn_mfma_f32_32x32x2f32(a4[3], breg[4 * c + 3], acc, 0, 0, 0); } }
            { const int hsw = (lane >> 2) & 3;
#pragma unroll
                for (int q = 0; q < 4; ++q) { const int tq = t0 + 32 * tl + 4 * wave + q; const float rstd = rsl[32 * tl + 4 * wave + q]; u32x4 o;
#pragma unroll
                    for (int u = 0; u < 4; ++u) { const int go = 4 * ((4 * lane + u) ^ hsw);
                        const f32x4 xv = *(const LAS f32x4*)(xt + (4 * wave + q) * 1028 + go), g4 = *(const LAS f32x4*)(gs + go), s4 = *(const LAS f32x4*)(shl + go);
                        const f32x4 y = (xv * rstd) * g4 + s4;
                        o[u] = cvt4_fp8(Q_H2 * y[0], Q_H2 * y[1], Q_H2 * y[2], Q_H2 * y[3]); }
                    if (tq < TPB) *(u32x4*)(h2q + (size_t)(tok0 + tq) * D + 16 * lane) = o; } }
            __syncthreads();
            { LAS float* part = (LAS float*)(lds + RT_X);
#pragma unroll
                for (int r = 0; r < 16; ++r) part[wave * 1024 + r * 64 + lane] = acc[r];
                __syncthreads();
                const int e = tid & 31; float ce = rb[e];
#pragma unroll
                for (int w = 0; w < 8; ++w) ce += cew[w * 32 + e];
#pragma unroll
                for (int q = 0; q < 2; ++q) { const int idx = tid + 512 * q; float sum = 0.f;
#pragma unroll
                    for (int w = 0; w < 8; ++w) sum += part[w * 1024 + idx];
                    const int r = idx >> 6, tk = 32 * tl + (r & 3) + 8 * (r >> 2) + 4 * ((idx >> 5) & 1);
                    lg[tk * 33 + e] = rsl[tk] * sum + ce; }
                __syncthreads(); }
        }
#undef RT_LOAD
        if (tid < 128 && t0 + tid < TPB) {
            const int row = tok0 + t0 + tid; const LAS float* lr = lg + tid * 33;
            float v0 = -INFINITY, v1 = -INFINITY, v2 = -INFINITY, v3 = -INFINITY; int i0 = 0, i1 = 0, i2 = 0, i3 = 0;
#pragma unroll
            for (int e = 0; e < 32; ++e) { const float x = lr[e];
                if (x > v0) { v3 = v2; i3 = i2; v2 = v1; i2 = i1; v1 = v0; i1 = i0; v0 = x; i0 = e; }
                else if (x > v1) { v3 = v2; i3 = i2; v2 = v1; i2 = i1; v1 = x; i1 = e; }
                else if (x > v2) { v3 = v2; i3 = i2; v2 = x; i2 = e; }
                else if (x > v3) { v3 = x; i3 = e; } }
            const float e1 = __expf(v1 - v0), e2 = __expf(v2 - v0), e3 = __expf(v3 - v0); const float inv = 1.0f / (1.0f + e1 + e2 + e3);
            *(int4*)(ridx + (size_t)row * 4) = make_int4(i0, i1, i2, i3); *(float4*)(rwt + (size_t)row * 4) = make_float4(inv, e1 * inv, e2 * inv, e3 * inv);
            atomicAdd((int*)&hist[i0], 1); atomicAdd((int*)&hist[i1], 1); atomicAdd((int*)&hist[i2], 1); atomicAdd((int*)&hist[i3], 1);
        }
        __syncthreads();
    }
    if (tid < 32) blockcnt[blk * 32 + tid] = hist[tid];
    __syncthreads();
}

__device__ __forceinline__ void phase_assign(const Params& p, LAS unsigned char* lds, int G) {
    const int tid = opaque_tid(), lane = tid & 63, wave = tid >> 6;
    LAS int* part = (LAS int*)lds;
    LAS int* partb = part + 512;
    LAS int* total = partb + 512;
    LAS int* base = total + 32;
    LAS int* segst = base + 32;
    LAS int* cursor = segst + 32;
    LAS int* slotl = cursor + 32;
    const int* blockcnt = (const int*)(p.ws + WS_CTL + 4096);
    const int* ridx = (const int*)(p.ws + WS_ROUTE); int* rslot = (int*)(p.ws + WS_ROUTE + 1024 * 1024); int* tokmap = (int*)(p.ws + WS_ROUTE + 2 * 1024 * 1024);
    const bf16_t* h2 = (const bf16_t*)(p.ws + WS_H); bf16_t* xs = (bf16_t*)(p.ws + WS_PROJ);
    int* tile = (int*)(p.ws + WS_TILE);
    const int TPB = T / G; const int blk = blockIdx.x;
    { const int e = tid & 31, part_i = tid >> 5; int st = 0, sb = 0;
        for (int bb = part_i; bb < G; bb += 16) { const int c = blockcnt[bb * 32 + e]; st += c; if (bb < blk) sb += c; }
        part[part_i * 32 + e] = st; partb[part_i * 32 + e] = sb; }
    __syncthreads();
    if (tid < 32) { int st = 0, sb = 0;
#pragma unroll
        for (int i = 0; i < 16; ++i) { st += part[i * 32 + tid]; sb += partb[i * 32 + tid]; }
        total[tid] = st; base[tid] = sb; cursor[tid] = 0; }
    __syncthreads();
    if (tid == 0) { int acc = 0; for (int e = 0; e < 32; ++e) { segst[e] = acc; acc += (total[e] + 255) & ~255; }
        if (blk == 0) { int pm = 0; for (int e = 0; e < 32; ++e) { const int nt = (total[e] + 255) >> 8; for (int i = 0; i < nt; ++i) tile[16 + pm + i] = e; pm += nt; } tile[0] = pm; } }
    __syncthreads();
    if (tid < 32) base[tid] += segst[tid];
    __syncthreads();
    for (int a = tid; a < TPB * 4; a += NTHREADS) { const int tok = blk * TPB + (a >> 2); const int e = ridx[(size_t)tok * 4 + (a & 3)];
        const int rank = atomicAdd((int*)&cursor[e], 1); const int slot = base[e] + rank; rslot[(size_t)tok * 4 + (a & 3)] = slot; tokmap[slot] = tok; }
    for (int e = blk; e < 32; e += G) { const int s0 = segst[e] + total[e], s1 = segst[e] + ((total[e] + 255) & ~255);
        for (int r = s0 + tid; r < s1; r += NTHREADS) tokmap[r] = 0; }
}

__device__ __forceinline__ void phase_final(const Params& p, int G, int stage) {
    const int tid = opaque_tid(), lane = tid & 63, wave = tid >> 6;
    const int gw = (int)blockIdx.x * NWAVES + wave, NGW = G * NWAVES;
    const float* fg = p.in[I_FG]; const float* mod = (const float*)(p.ws + WS_MOD);
    const int* rslot = (const int*)(p.ws + WS_ROUTE + 1024 * 1024); const float* rwt = (const float*)(p.ws + WS_ROUTE + 512 * 1024);
    const bf16_t* Y = (const bf16_t*)(p.ws + WS_PROJ);
    const float* src = (stage >= 4) ? p.out : p.in[I_X];
    for (int row = gw; row < T; row += NGW) {
        const int b = row / SEQ;
        const f32x4* xr = (const f32x4*)(src + (size_t)row * D) + lane;
        f32x4 v[4];
#pragma unroll
        for (int j = 0; j < 4; ++j) v[j] = xr[64 * j];
        if (stage >= 9) {
            const int4 sl = *(const int4*)(rslot + (size_t)row * 4); const float4 wt = *(const float4*)(rwt + (size_t)row * 4);
            const float* g2 = mod + b * 6144 + 5120;
            const int sls[4] = {sl.x, sl.y, sl.z, sl.w}; const float wts[4] = {wt.x, wt.y, wt.z, wt.w};
#pragma unroll
            for (int j = 0; j < 4; ++j) { f32x4 m = (f32x4){0.f, 0.f, 0.f, 0.f};
#pragma unroll
                for (int k = 0; k < 4; ++k) { const u32x2 yv = *((const u32x2*)(Y + (size_t)sls[k] * D) + lane + 64 * j);
                    m[0] += wts[k] * __uint_as_float(yv.x << 16); m[1] += wts[k] * __uint_as_float(yv.x & 0xffff0000u); m[2] += wts[k] * __uint_as_float(yv.y << 16); m[3] += wts[k] * __uint_as_float(yv.y & 0xffff0000u); }
                const f32x4 g = *(const f32x4*)(g2 + 4 * lane + 256 * j); v[j] = v[j] + g * m; }
        }
        float s = 0.f;
#pragma unroll
        for (int j = 0; j < 4; ++j) s += (v[j][0] * v[j][0] + v[j][1] * v[j][1]) + (v[j][2] * v[j][2] + v[j][3] * v[j][3]);
        const float rstd = rsqrtf(wave_sum(s) * (1.0f / D) + NORM_EPS);
        f32x4* orow = (f32x4*)(p.out + (size_t)row * D) + lane;
#pragma unroll
        for (int j = 0; j < 4; ++j) { const f32x4 g = *(const f32x4*)(fg + 4 * lane + 256 * j); orow[64 * j] = v[j] * rstd * g; }
    }
}


#define XB_TMO      128
#define XB_XCNT(j)  (256  + 64 * (j))
#define XB_XSUB(j)  (1280 + 64 * (j))
#define XB_XGEN(j)  (2304 + 64 * (j))
#define XB_TOP      3328
#define XB_TOPGEN   3392
#define XCD_BAR_WORDS 3456
#define XB_SPIN_CAP (1u << 22)
__device__ __forceinline__ unsigned xb_ld(unsigned* p)              { return __hip_atomic_load(p, __ATOMIC_RELAXED, __HIP_MEMORY_SCOPE_AGENT); }
__device__ __forceinline__ unsigned xb_add(unsigned* p, unsigned v) { return __hip_atomic_fetch_add(p, v, __ATOMIC_RELAXED, __HIP_MEMORY_SCOPE_AGENT); }
__device__ __forceinline__ unsigned xb_xcc_id() { return (unsigned)__builtin_amdgcn_s_getreg((3 << 11) | 20) & 0xFu; }
#define XB_SPIN(cond, bar) do { unsigned _sp = 0; while (cond) { __builtin_amdgcn_s_sleep(1); \
    if ((++_sp & 255u) == 0u) { if (xb_ld(&(bar)[XB_TMO])) break; if (_sp > XB_SPIN_CAP) { atomicAdd(&(bar)[XB_TMO], 1u); break; } } } } while (0)
struct XcdBarrier { unsigned* bar; unsigned x; volatile LAS unsigned* st; };
__device__ __forceinline__ XcdBarrier xcd_barrier_post(unsigned* bar, volatile LAS unsigned* st) {
    XcdBarrier b; b.bar = bar; b.x = xb_xcc_id(); b.st = st;
    if (threadIdx.x == 0) (void)xb_add(&bar[XB_XCNT(b.x)], 1u);
    return b;
}
__device__ __forceinline__ void xcd_barrier_complete(unsigned* bar, unsigned x, unsigned& nloc, unsigned& nx) {
    const unsigned G = gridDim.x * gridDim.y * gridDim.z;
    unsigned sum, cnt, mine, sp = 0u;
    for (;;) {
        sum = 0u; cnt = 0u; mine = 0u;
#pragma unroll
        for (unsigned j = 0; j < 16; ++j) { const unsigned c = xb_ld(&bar[XB_XCNT(j)]); sum += c; cnt += (c > 0u) ? 1u : 0u; mine = (j == x) ? c : mine; }
        if (sum == G) break;
        __builtin_amdgcn_s_sleep(1);
        if ((++sp & 255u) == 0u) { if (xb_ld(&bar[XB_TMO])) break; if (sp > XB_SPIN_CAP) { atomicAdd(&bar[XB_TMO], 1u); break; } }
    }
    nloc = mine > 0u ? mine : 1u; nx = cnt > 0u ? cnt : 1u;
}
__device__ __forceinline__ void xcd_barrier(const XcdBarrier& b) {
    asm volatile("s_waitcnt vmcnt(0)" ::: "memory");
    __syncthreads();
    if (threadIdx.x == 0) {
        unsigned* bar = b.bar;
        __builtin_amdgcn_s_waitcnt(0);
        unsigned nloc = b.st[0], nx = b.st[1];
        if (nloc == 0u) { xcd_barrier_complete(bar, b.x, nloc, nx); b.st[0] = nloc; b.st[1] = nx; }
        const unsigned old = xb_add(&bar[XB_XSUB(b.x)], 1u);
        const unsigned gen = old / nloc;
        if (old + 1u == (gen + 1u) * nloc) {
            __builtin_amdgcn_fence(__ATOMIC_RELEASE, "agent");
            asm volatile("s_waitcnt vmcnt(0)" ::: "memory");
            const unsigned og = xb_add(&bar[XB_TOP], 1u);
            const unsigned tg = og / nx;
            if (og + 1u == (tg + 1u) * nx) xb_add(&bar[XB_TOPGEN], 1u);
            else XB_SPIN(xb_ld(&bar[XB_TOPGEN]) == tg, bar);
            __builtin_amdgcn_fence(__ATOMIC_ACQUIRE, "agent");
            xb_add(&bar[XB_XGEN(b.x)], 1u);
            asm volatile("s_waitcnt vmcnt(0)" ::: "memory");
        } else {
            XB_SPIN(xb_ld(&bar[XB_XGEN(b.x)]) == gen, bar);
            __builtin_amdgcn_fence(__ATOMIC_ACQUIRE, "agent");
            asm volatile("s_waitcnt vmcnt(0)" ::: "memory");
        }
    }
    __syncthreads();
}

__device__ __forceinline__ const Params* launder_params(const Params* q) { asm volatile("" : "+s"(q)); return q; }
__global__ void __launch_bounds__(NTHREADS, 2) hymba_fwd(Params p) {
    extern __shared__ __attribute__((aligned(16))) unsigned char lds_raw[];
    cg::grid_group grid = cg::this_grid();
    LAS unsigned char* lds = (LAS unsigned char*)lds_raw;
    const int G = gridDim.x, tid = threadIdx.x;
    constexpr int STAGE = DBG_STAGE;
    volatile LAS unsigned* xst = (volatile LAS unsigned*)(lds + LDS_BYTES - 64);
    if (tid == 0) { xst[0] = 0u; xst[1] = 0u; }
    __syncthreads();
    const XcdBarrier xbar = xcd_barrier_post((unsigned*)(p.ws + WS_CTL + 40960), xst);
#define GRID_BAR() xcd_barrier(xbar)

    phase_mod(p, lds_raw, G);
    if (STAGE >= 2) phase_convert(p, lds_raw, G, 0);
    grid.sync();
    if (STAGE >= 2) { phase_norm1(p, G); GRID_BAR(); }
    if (STAGE >= 2) {
        pg8::Gemm g{(const bf16_t*)(p.ws + WS_H), (const bf16_t*)(p.ws + WS_WIN_T), D / 2, nullptr};
        pg8::DenseSched S; S.o.init(T / 256, IC / 256, G, (int)blockIdx.x);
        EpiInProj E{(bf16_t*)(p.ws + WS_PROJ)};
        pg8::gemm_phase<false, true>(lds, g, S, E);
        GRID_BAR();
    }
    if (STAGE >= 3) {
        kmax_pass(p, G);
        for (int it = blockIdx.x; it < NB * 8 * 4; it += G) rwkv_prep(p, lds, it >> 5, (it >> 2) & 7, (it & 3) * 32, (it & 3) * 32 + 32);
        GRID_BAR();
    }
    if (STAGE >= 2) {
        if (STAGE >= 3) { for (int u = blockIdx.x; u < NB * 8 * 2; u += G) rwkv_scan(p, lds, u >> 4, (u >> 1) & 7, u & 1); }
        else {
            bf16_t* ymix = (bf16_t*)(p.ws + WS_YMIX);
            for (size_t i = (size_t)blockIdx.x * NTHREADS + tid; i < (size_t)T * 64; i += (size_t)G * NTHREADS) { const size_t row = i >> 6, c = i & 63; *(u32x4*)(ymix + row * D + c * 8) = (u32x4){0u, 0u, 0u, 0u}; }
        }
        float lam;
        { const float* q1 = p.in[I_LQ1]; const float* k1 = p.in[I_LK1]; const float* q2 = p.in[I_LQ2]; const float* k2 = p.in[I_LK2]; float s1 = 0.f, s2 = 0.f;
            for (int i = 0; i < 64; ++i) { s1 += q1[i] * k1[i]; s2 += q2[i] * k2[i]; } lam = expf(s1) - expf(s2) + LAMBDA_INIT; }
        unsigned* qhead = (unsigned*)(p.ws + WS_CTL);
        LAS unsigned* ubox = (LAS unsigned*)(lds + 4 * ATT_BUF);
        for (;;) {
            __syncthreads();
            if (tid == 0) ubox[0] = atomicAdd(qhead, 1u);
            __syncthreads();
            const unsigned u = (unsigned)__builtin_amdgcn_readfirstlane((int)ubox[0]);
            if (u >= (unsigned)ATT_UNITS) break;
            attn_unit(p, lds, (int)(u & 31u) >> 2, (int)(u & 3u), ATT_NQB - 1 - (int)(u >> 5), lam);
        }
        GRID_BAR();
        if (STAGE >= 3) { rwkv_finalize(p, G); GRID_BAR(); }
    }
    if (STAGE >= 2) {
        pg8::Gemm g{(const bf16_t*)(p.ws + WS_YMIX), (const bf16_t*)(p.ws + WS_WOUT_T), D, nullptr};
        pg8::DenseSched S; S.o.init(T / 256, D / 256, G, (int)blockIdx.x);
        EpiOutProj E{p.in[I_X], (const float*)(p.ws + WS_MOD), p.out};
        pg8::gemm_phase<false, false>(lds, g, S, E);
        GRID_BAR();
    }
    if (STAGE >= 9) {
        phase_router(p, lds, G);
        GRID_BAR();
        phase_assign(p, lds, G);
        __syncthreads();
        phase_convert(p, lds_raw, G, 1);
        GRID_BAR();
        const int* tile = (const int*)(p.ws + WS_TILE);
        const int MT = tile[0];
        {
            pg8::Gemm g{(const bf16_t*)(p.ws + WS_H), (const bf16_t*)(p.ws + WS_WG_T), D / 2, (const int*)(p.ws + WS_ROUTE + 2 * 1024 * 1024)};
            pg8::MoeSched S; S.o.init(MT, 8, G, (int)blockIdx.x); S.tile_e = tile + 16; S.N = 2048;
            EpiMoe1 E{p.in[I_BGU], p.ws + WS_ACT};
            pg8::gemm_phase<true, true>(lds, g, S, E);
        }
        GRID_BAR();
        {
            pg8::Gemm g{(const bf16_t*)(p.ws + WS_ACT), (const bf16_t*)(p.ws + WS_WD_T), D / 2, nullptr};
            pg8::MoeSched S; S.o.init(MT, 4, G, (int)blockIdx.x); S.tile_e = tile + 16; S.N = 1024;
            EpiMoe2 E{p.in[I_BDN], (bf16_t*)(p.ws + WS_PROJ)};
            pg8::gemm_phase<false, true>(lds, g, S, E);
        }
        GRID_BAR();
    }
    phase_final(p, G, STAGE >= 9 ? 9 : (STAGE >= 2 ? 4 : 0));
}

extern "C" void kernel_launch(void* const* d_in, const int* in_sizes, int n_in, void* d_out, int out_size, void* d_ws, size_t ws_size, hipStream_t stream) {
    static int grid = 0;
    if (grid == 0) {
        if (n_in != 31 || out_size != T * D || ws_size < WS_END) { fprintf(stderr, "kernel_launch: unexpected shapes (n_in %d out %d ws %zu)\n", n_in, out_size, ws_size); grid = -1; return; }
        int dev = 0, cus = 0, per_cu = 0;
        hipGetDevice(&dev);
        hipDeviceGetAttribute(&cus, hipDeviceAttributeMultiprocessorCount, dev);
        hipFuncSetAttribute((const void*)hymba_fwd, hipFuncAttributeMaxDynamicSharedMemorySize, LDS_BYTES);
        hipOccupancyMaxActiveBlocksPerMultiprocessor(&per_cu, (const void*)hymba_fwd, NTHREADS, LDS_BYTES);
        if (per_cu < 1) { fprintf(stderr, "kernel_launch: occupancy query returned %d\n", per_cu); grid = -1; return; }
        grid = cus;
        if (grid > 256) grid = 256;
        while (T % grid != 0) --grid;
        (void)hipGetLastError();
    }
    if (grid < 0) return;
    hipMemsetAsync((char*)d_ws + WS_CTL, 0, CTL_BYTES, stream);
    Params p{};
    for (int i = 0; i < 31; ++i) p.in[i] = (const float*)d_in[i];
    p.out = (float*)d_out; p.ws = (unsigned char*)d_ws;
    void* args[] = {&p};
    hipError_t e = hipLaunchCooperativeKernel((const void*)hymba_fwd, dim3(grid), dim3(NTHREADS), args, LDS_BYTES, stream);
    if (e != hipSuccess) fprintf(stderr, "cooperative launch failed: %s (grid %d)\n", hipGetErrorString(e), grid);
}
```

```cpp
#include <hip/hip_runtime.h>
#include <hip/hip_cooperative_groups.h>
#include <cstdio>
#include <cstdint>
namespace cg = cooperative_groups;

#ifndef DBG_STAGE
#define DBG_STAGE 99
#endif

#define LAS __attribute__((address_space(3)))
typedef unsigned short bf16_t;
typedef short bf16x8 __attribute__((ext_vector_type(8)));
typedef short s16x4 __attribute__((ext_vector_type(4)));
typedef float f32x4 __attribute__((ext_vector_type(4)));
typedef float f32x16 __attribute__((ext_vector_type(16)));
typedef float f32x2_t __attribute__((ext_vector_type(2)));
typedef __bf16 bf16x2_t __attribute__((ext_vector_type(2)));
typedef unsigned u32x4 __attribute__((ext_vector_type(4)));
typedef unsigned u32x2 __attribute__((ext_vector_type(2)));

constexpr int D = 1024, NB = 8, SEQ = 4096, T = NB * SEQ;
constexpr int RW = 512, RC = 1792, DC = 1536, IC = 3328;
constexpr int NE = 32, TOPK = 4, NA = T * TOPK;
constexpr int PMAX = NA + NE * 256;
constexpr float NORM_EPS = 1e-5f, GN_EPS = 64e-5f;
constexpr float LOG2E = 1.4426950408889634f;
constexpr float QSCALE = 0.125f * LOG2E;
constexpr float LAMBDA_INIT = 0.2f;
constexpr int NTHREADS = 512, NWAVES = 8;
constexpr int LDS_BYTES = 163840;

constexpr size_t MiB = 1u << 20;
constexpr size_t WS_CTL = 0;
constexpr size_t CTL_BYTES = 65536;
constexpr size_t WS_MOD = 1 * MiB;
constexpr size_t WS_TILE = 1 * MiB + 512 * 1024;
constexpr size_t WS_WIN_T = 2 * MiB;
constexpr size_t WS_WOUT_T = 9 * MiB;
constexpr size_t WS_ROUTE = 11 * MiB;
constexpr size_t WS_WG_T = 16 * MiB;
constexpr size_t WS_WD_T = 144 * MiB;
constexpr size_t WS_H = 208 * MiB;
constexpr size_t WS_YMIX = 272 * MiB;
constexpr size_t WS_PROJ = 336 * MiB;
constexpr size_t WS_ACT = 608 * MiB;
constexpr size_t WS_END = 1008 * MiB;
constexpr int OPREC = 34816;
constexpr int OP_AT = 0, OP_RT = 4608, OP_BH = 9216, OP_KH = 13824, OP_BCT = 18432, OP_KCT = 23552, OP_VT = 28672, OP_P31 = 33792;
constexpr size_t WS_OPS = WS_ACT;
constexpr size_t WS_VS = 944 * MiB;
constexpr size_t WS_BON = WS_H;

__device__ __forceinline__ unsigned cvtpk(float lo, float hi) { f32x2_t v = {lo, hi}; bf16x2_t b = __builtin_convertvector(v, bf16x2_t); return __builtin_bit_cast(unsigned, b); }
__device__ __forceinline__ float bf2f(unsigned short u) { return __uint_as_float(((unsigned)u) << 16); }
__device__ __forceinline__ float wave_sum(float v) {
#pragma unroll
    for (int o = 1; o < 64; o <<= 1) v += __shfl_xor(v, o);
    return v;
}
__device__ __forceinline__ float wave_max(float v) {
#pragma unroll
    for (int o = 1; o < 64; o <<= 1) v = fmaxf(v, __shfl_xor(v, o));
    return v;
}
__device__ __forceinline__ int opaque_tid() { int t = (int)threadIdx.x; asm volatile("" : "+v"(t)); return t; }
__device__ __forceinline__ float sigmoidf_(float x) { return __builtin_amdgcn_rcpf(1.0f + __expf(-x)); }
__device__ __forceinline__ float tanh_fast(float x) { return 1.0f - 2.0f * __builtin_amdgcn_rcpf(1.0f + __expf(2.0f * x)); }

struct Params {
    const float* in[31];
    float* out;
    unsigned char* ws;
};
enum { I_X = 0, I_C, I_MODW, I_MODB, I_N1G, I_WIN, I_MU, I_W0, I_WUP, I_A0, I_AUP, I_GUP, I_KK, I_KA, I_RK, I_GNG, I_GNB, I_LQ1, I_LK1, I_LQ2, I_LK2, I_SUBLN, I_WOUT, I_N2G, I_RTW, I_RTB, I_WGU, I_BGU, I_WDN, I_BDN, I_FG };

namespace pg8 {
constexpr int BM = 256, BK = 64, HALF = 128, HTB = HALF * BK * 2, STAGE_BYTES = 8 * HTB, NXCD = 8, WGM = 8;
__host__ __device__ __forceinline__ int lds_byte(int r, int c) { const int st = (r >> 4) * 2 + (c >> 5), rr = r & 15, cc = c & 31, ob = rr * 64 + cc * 2; return st * 1024 + (ob ^ (((ob >> 9) & 1) << 5)); }
__host__ __device__ __forceinline__ void stage_rc(int b, int& R, int& C) { const int st = b / 1024, sb = b % 1024, swz = sb ^ (((sb >> 9) & 1) << 5); R = (st >> 1) * 16 + swz / 64; C = (st & 1) * 32 + (swz % 64) / 2; }
__host__ __device__ __forceinline__ int perm32(int rho) { const int n = rho >> 4, i = rho & 15; return 8 * (i >> 2) + 4 * n + (i & 3); }

struct Unit { int pm, pn, arow, brow, e; };
struct Gemm { const bf16_t* A; const bf16_t* Bt; int K; const int* rowmap; };

struct TileOrder {
    int nM, nN, nwg, G, c;
    __device__ void init(int nM_, int nN_, int G_, int c_) { nM = nM_; nN = nN_; nwg = nM * nN; G = G_; c = c_; }
    __device__ bool map(int i, int& pm, int& pn) const {
        const long L = (long)i * G + c; if (L >= nwg) return false;
        int wgid = (int)L; { const int q = nwg / NXCD, r = nwg % NXCD, xcd = wgid % NXCD, off = wgid / NXCD; wgid = (xcd < r ? xcd * (q + 1) : r * (q + 1) + (xcd - r) * q) + off; }
        const int nig = WGM * nN, gid = wgid / nig, fm = gid * WGM, gsz = (nM - fm) < WGM ? (nM - fm) : WGM;
        pm = fm + ((wgid % nig) % gsz); pn = (wgid % nig) / gsz; return true;
    }
};
struct DenseSched {
    TileOrder o;
    __device__ bool next(int i, Unit& u) const { int pm, pn; if (!o.map(i, pm, pn)) return false; u.pm = pm; u.pn = pn; u.arow = pm * BM; u.brow = pn * BM; u.e = 0; return true; }
};
struct MoeSched {
    TileOrder o; const int* tile_e; int N;
    __device__ bool next(int i, Unit& u) const { int pm, pn; if (!o.map(i, pm, pn)) return false; const int e = tile_e[pm]; u.pm = pm; u.pn = pn; u.arow = pm * BM; u.brow = e * N + pn * BM; u.e = e; return true; }
};

typedef int v4i_t __attribute__((ext_vector_type(4)));
typedef int v8i_t __attribute__((ext_vector_type(8)));
__device__ __forceinline__ v8i_t cat8(bf16x8 a, bf16x8 b) { return __builtin_shufflevector(__builtin_bit_cast(v4i_t, a), __builtin_bit_cast(v4i_t, b), 0, 1, 2, 3, 4, 5, 6, 7); }
__device__ __forceinline__ void mfma_fp8_tied(f32x4& acc, v8i_t a, v8i_t b) { asm volatile("v_mfma_f32_16x16x128_f8f6f4 %0, %1, %2, %0" : "+v"(acc) : "v"(a), "v"(b)); }
template <bool GATHER, bool FP8, class Epi, class Sched>
__device__ __forceinline__ void gemm_phase(LAS unsigned char* lds, const Gemm g, const Sched& S, const Epi& E) {
    const int tid = opaque_tid(), wid = __builtin_amdgcn_readfirstlane(tid >> 6), lane = tid & 63, wr = wid >> 2, wc = wid & 3, fr = lane & 15, fq = lane >> 4;
    const int K = g.K, nt = K / BK;
    unsigned voffA[2], voffB[2]; int rowA[2], colA2[2];
#pragma unroll
    for (int i = 0; i < 2; ++i) { int R, C; stage_rc(tid * 16 + i * 8192, R, C); const int Rb = (R & ~31) + perm32(R & 31);
        voffA[i] = (unsigned)(R * K + C) * 2u; voffB[i] = (unsigned)(Rb * K + C) * 2u; rowA[i] = R; colA2[i] = C * 2; }
    unsigned gv0[2] = {0u, 0u}, gv1[2] = {0u, 0u}, gn0[2] = {0u, 0u}, gn1[2] = {0u, 0u};
#define PG8_GOFF(u_, o0, o1) do { _Pragma("unroll") for (int _i = 0; _i < 2; ++_i) { o0[_i] = (unsigned)g.rowmap[(u_).arow + rowA[_i]] * (unsigned)(K * 2) + (unsigned)colA2[_i]; o1[_i] = (unsigned)g.rowmap[(u_).arow + HALF + rowA[_i]] * (unsigned)(K * 2) + (unsigned)colA2[_i]; } } while (0)
#define PG8_STAGE_A(bufoff, kptr, half) do { if constexpr (GATHER) { if (half) PG8_STAGE(bufoff, kptr, gv1); else PG8_STAGE(bufoff, kptr, gv0); } else PG8_STAGE(bufoff, (kptr) + ((half) ? hstep : 0), voffA); } while (0)
    const size_t kstep = (size_t)(BK * 2);
    const size_t hstep = (size_t)HALF * K * 2;
    const size_t rowb = (size_t)K * 2;
    const unsigned ldsw = (unsigned)wid * 1024u;
    const int aoff = lds_byte(wr * 64 + fr, fq * 8), boff = lds_byte(wc * 32 + fr, fq * 8);
#define PG8_SA(b, h) (((b) * 2 + (h)) * HTB)
#define PG8_SB(b, h) ((4 + (b) * 2 + (h)) * HTB)
#define PG8_STAGE(bufoff, gbase, voff) do { _Pragma("unroll") for (int _i = 0; _i < 2; ++_i) \
        __builtin_amdgcn_global_load_lds((const unsigned*)((const char*)(gbase) + (voff)[_i]), (LAS unsigned*)(lds + (bufoff) + ldsw + _i * 8192), 16, 0, 0); } while (0)
#define PG8_LDA(dst, b, h) do { _Pragma("unroll") for (int m = 0; m < 4; ++m) _Pragma("unroll") for (int k = 0; k < 2; ++k) dst[m][k] = *(const LAS bf16x8*)(lds + PG8_SA(b, h) + aoff + m * 2048 + k * 1024); } while (0)
#define PG8_LDB(dst, b, h) do { _Pragma("unroll") for (int n = 0; n < 2; ++n) _Pragma("unroll") for (int k = 0; k < 2; ++k) dst[n][k] = *(const LAS bf16x8*)(lds + PG8_SB(b, h) + boff + n * 2048 + k * 1024); } while (0)
#define PG8_MMA(ai, bj, At, Bt) do { __builtin_amdgcn_s_setprio(1); _Pragma("unroll") for (int m = 0; m < 4; ++m) _Pragma("unroll") for (int n = 0; n < 2; ++n) { \
        if constexpr (FP8) mfma_fp8_tied(acc[ai][bj][m][n], cat8(Bt[n][0], Bt[n][1]), cat8(At[m][0], At[m][1])); \
        else { _Pragma("unroll") for (int k = 0; k < 2; ++k) acc[ai][bj][m][n] = __builtin_amdgcn_mfma_f32_16x16x32_bf16(Bt[n][k], At[m][k], acc[ai][bj][m][n], 0, 0, 0); } } __builtin_amdgcn_s_setprio(0); } while (0)
#define PG8_WAIT_V(n) asm volatile("s_waitcnt vmcnt(" #n ")" ::: "memory")
#define PG8_WAIT_L(n) asm volatile("s_waitcnt lgkmcnt(" #n ")" ::: "memory")
#define PG8_BAR __builtin_amdgcn_s_barrier()
#define PG8_SCHED __builtin_amdgcn_sched_barrier(0)
    Unit cur, nxt; int ui = 0;
    if (!S.next(0, cur)) return;
    f32x4 acc[2][2][4][2];
#pragma unroll
    for (int a = 0; a < 2; ++a)
#pragma unroll
        for (int b = 0; b < 2; ++b)
#pragma unroll
            for (int m = 0; m < 4; ++m)
#pragma unroll
                for (int n = 0; n < 2; ++n) acc[a][b][m][n] = (f32x4){0.f, 0.f, 0.f, 0.f};
    bf16x8 At[4][2], B0[2][2], B1[2][2];
    const char* cA = GATHER ? (const char*)g.A : (const char*)g.A + (size_t)cur.arow * rowb; const char* cB = (const char*)g.Bt + (size_t)cur.brow * rowb;
    if constexpr (GATHER) PG8_GOFF(cur, gv0, gv1);
    PG8_STAGE(PG8_SB(0, 0), cB, voffB); PG8_STAGE(PG8_SB(0, 1), cB + hstep, voffB); PG8_STAGE_A(PG8_SA(0, 0), cA, 0); PG8_STAGE_A(PG8_SA(0, 1), cA, 1);
    if (wr == 1) PG8_BAR;
    PG8_WAIT_V(2); PG8_BAR;
    PG8_STAGE(PG8_SB(1, 0), cB + kstep, voffB); PG8_STAGE_A(PG8_SA(1, 0), cA + kstep, 0); PG8_STAGE(PG8_SB(1, 1), cB + hstep + kstep, voffB);
    PG8_WAIT_V(6); PG8_BAR;
    for (;;) {
        const bool has_next = S.next(ui + 1, nxt);
        const char* nA = GATHER ? (const char*)g.A : (has_next ? (const char*)g.A + (size_t)nxt.arow * rowb : cA); const char* nB = has_next ? (const char*)g.Bt + (size_t)nxt.brow * rowb : cB;

        for (int t = 0; t < nt; t += 2) {
            const bool last = (t == nt - 2);
            if constexpr (GATHER) { if (t == nt - 4) { if (has_next) PG8_GOFF(nxt, gn0, gn1); else { gn0[0] = gv0[0]; gn0[1] = gv0[1]; gn1[0] = gv1[0]; gn1[1] = gv1[1]; } } }
            const char* a1 = cA + (size_t)(t + 1) * kstep;
            const char* a2 = last ? nA : cA + (size_t)(t + 2) * kstep; const char* b2 = last ? nB : cB + (size_t)(t + 2) * kstep;
            const char* a3 = a2 + kstep; const char* b3 = b2 + kstep;
            PG8_LDB(B0, 0, 0); PG8_LDB(B1, 0, 1); PG8_SCHED; PG8_LDA(At, 0, 0); PG8_STAGE_A(PG8_SA(1, 1), a1, 1);
            if constexpr (GATHER) { if (last) { gv0[0] = gn0[0]; gv0[1] = gn0[1]; gv1[0] = gn1[0]; gv1[1] = gn1[1]; } }
            PG8_WAIT_V(8); PG8_WAIT_L(0); PG8_BAR; PG8_MMA(0, 0, At, B0); PG8_MMA(0, 1, At, B1); PG8_BAR; PG8_SCHED;
            PG8_LDA(At, 0, 1); PG8_STAGE(PG8_SB(0, 0), b2, voffB); PG8_STAGE(PG8_SB(0, 1), b2 + hstep, voffB); PG8_STAGE_A(PG8_SA(0, 0), a2, 0);
            PG8_WAIT_V(8); PG8_WAIT_L(0); PG8_BAR; PG8_MMA(1, 0, At, B0); PG8_MMA(1, 1, At, B1); PG8_BAR; PG8_SCHED;
            PG8_LDB(B0, 1, 0); PG8_LDB(B1, 1, 1); PG8_SCHED; PG8_LDA(At, 1, 0); PG8_STAGE_A(PG8_SA(0, 1), a2, 1);
            PG8_WAIT_V(8); PG8_WAIT_L(0); PG8_BAR; PG8_MMA(0, 0, At, B0); PG8_MMA(0, 1, At, B1); PG8_BAR; PG8_SCHED;
            PG8_LDA(At, 1, 1); PG8_STAGE(PG8_SB(1, 0), b3, voffB); PG8_STAGE(PG8_SB(1, 1), b3 + hstep, voffB); PG8_STAGE_A(PG8_SA(1, 0), a3, 0);
            PG8_WAIT_V(8); PG8_WAIT_L(0); PG8_BAR; PG8_MMA(1, 0, At, B0); PG8_MMA(1, 1, At, B1); PG8_BAR; PG8_SCHED;
        }
        if (wr == 0) PG8_BAR;
        if constexpr (FP8) asm volatile("s_nop 15\n\ts_nop 15" ::: "memory");
        E(acc, cur, wr, wc, fr, fq);
        if (!has_next) break;
#pragma unroll
        for (int a = 0; a < 2; ++a)
#pragma unroll
            for (int b = 0; b < 2; ++b)
#pragma unroll
                for (int m = 0; m < 4; ++m)
#pragma unroll
                    for (int n = 0; n < 2; ++n) acc[a][b][m][n] = (f32x4){0.f, 0.f, 0.f, 0.f};
        cur = nxt; cA = nA; cB = nB; ++ui;
        if (wr == 1) PG8_BAR;
    }
    PG8_WAIT_V(0);
    PG8_BAR;
#undef PG8_SA
#undef PG8_SB
#undef PG8_STAGE
#undef PG8_STAGE_A
#undef PG8_GOFF
#undef PG8_LDA
#undef PG8_LDB
#undef PG8_MMA
#undef PG8_WAIT_V
#undef PG8_WAIT_L
#undef PG8_BAR
#undef PG8_SCHED
}
}

constexpr float Q_H2 = 8.0f, Q_W = 32.0f, Q_ACT = 4.0f;
__device__ __forceinline__ unsigned cvt4_fp8(float a, float b, float c, float d) { unsigned w = 0u; w = (unsigned)__builtin_amdgcn_cvt_pk_fp8_f32(a, b, (int)w, false); w = (unsigned)__builtin_amdgcn_cvt_pk_fp8_f32(c, d, (int)w, true); return w; }
struct EpiInProj {
    bf16_t* O;
    __device__ __forceinline__ void operator()(const f32x4 (&acc)[2][2][4][2], const pg8::Unit& u, int wr, int wc, int fr, int fq) const {
        const int row0 = u.pm * 256 + wr * 64 + fr, col0 = u.pn * 256 + wc * 32 + 8 * fq;
        const float sc = ((u.pn == 7 || u.pn == 8) ? QSCALE : 1.0f) * (1.0f / (Q_H2 * Q_W));
#pragma unroll
        for (int ai = 0; ai < 2; ++ai)
#pragma unroll
            for (int m = 0; m < 4; ++m) { bf16_t* rowp = O + (size_t)(row0 + ai * 128 + m * 16) * IC + col0;
#pragma unroll
                for (int bj = 0; bj < 2; ++bj) { const f32x4 v0 = acc[ai][bj][m][0] * sc, v1 = acc[ai][bj][m][1] * sc;
                    u32x4 w; w.x = cvtpk(v0[0], v0[1]); w.y = cvtpk(v0[2], v0[3]); w.z = cvtpk(v1[0], v1[1]); w.w = cvtpk(v1[2], v1[3]);
                    *(u32x4*)(rowp + bj * 128) = w; } }
    }
};
struct EpiOutProj {
    const float* x; const float* mod; float* O;
    __device__ __forceinline__ void operator()(const f32x4 (&acc)[2][2][4][2], const pg8::Unit& u, int wr, int wc, int fr, int fq) const {
        const int row0 = u.pm * 256 + wr * 64 + fr, col0 = u.pn * 256 + wc * 32 + 8 * fq;
        const int b = (u.pm * 256) / SEQ;
        const float* g1 = mod + b * 6144 + 2048;
        f32x4 gv[2][2];
#pragma unroll
        for (int bj = 0; bj < 2; ++bj)
#pragma unroll
            for (int n = 0; n < 2; ++n) gv[bj][n] = *(const f32x4*)(g1 + col0 + bj * 128 + 4 * n);
#pragma unroll
        for (int ai = 0; ai < 2; ++ai)
#pragma unroll
            for (int m = 0; m < 4; ++m) { const size_t off = (size_t)(row0 + ai * 128 + m * 16) * D + col0;
#pragma unroll
                for (int bj = 0; bj < 2; ++bj)
#pragma unroll
                    for (int n = 0; n < 2; ++n) { const f32x4 xv = *(const f32x4*)(x + off + bj * 128 + 4 * n);
                        *(f32x4*)(O + off + bj * 128 + 4 * n) = xv + gv[bj][n] * acc[ai][bj][m][n]; } }
    }
};
struct EpiMoe1 {
    const float* bgu; unsigned char* O;
    __device__ __forceinline__ void operator()(const f32x4 (&acc)[2][2][4][2], const pg8::Unit& u, int wr, int wc, int fr, int fq) const {
        const int row0 = u.pm * 256 + wr * 64 + fr, col0 = u.pn * 128 + wc * 32 + 8 * fq;
        const float* bg = bgu + (size_t)u.e * 2048 + col0;
        constexpr float dq = 1.0f / (Q_H2 * Q_W);
        f32x4 bgv[2], buv[2];
#pragma unroll
        for (int n = 0; n < 2; ++n) { bgv[n] = *(const f32x4*)(bg + 4 * n); buv[n] = *(const f32x4*)(bg + 1024 + 4 * n); }
#pragma unroll
        for (int ai = 0; ai < 2; ++ai)
#pragma unroll
            for (int m = 0; m < 4; ++m) { float a[8];
#pragma unroll
                for (int n = 0; n < 2; ++n) { const f32x4 gt = acc[ai][0][m][n] * dq + bgv[n], up = acc[ai][1][m][n] * dq + buv[n];
#pragma unroll
                    for (int j = 0; j < 4; ++j) { const float gg = fminf(gt[j], 7.0f), uu = fminf(fmaxf(up[j], -7.0f), 7.0f);
                        a[4 * n + j] = Q_ACT * (uu + 1.0f) * (gg * __builtin_amdgcn_rcpf(1.0f + __builtin_amdgcn_exp2f(-1.702f * LOG2E * gg))); } }
                u32x2 w; w.x = cvt4_fp8(a[0], a[1], a[2], a[3]); w.y = cvt4_fp8(a[4], a[5], a[6], a[7]);
                *(u32x2*)(O + (size_t)(row0 + ai * 128 + m * 16) * 1024 + col0) = w; }
    }
};
struct EpiMoe2 {
    const float* bdn; bf16_t* O;
    __device__ __forceinline__ void operator()(const f32x4 (&acc)[2][2][4][2], const pg8::Unit& u, int wr, int wc, int fr, int fq) const {
        const int row0 = u.pm * 256 + wr * 64 + fr, col0 = u.pn * 256 + wc * 32 + 8 * fq;
        const float* bd = bdn + (size_t)u.e * 1024 + col0;
        constexpr float dq = 1.0f / (Q_ACT * Q_W);
        f32x4 bv[2][2];
#pragma unroll
        for (int bj = 0; bj < 2; ++bj)
#pragma unroll
            for (int n = 0; n < 2; ++n) bv[bj][n] = *(const f32x4*)(bd + bj * 128 + 4 * n);
#pragma unroll
        for (int ai = 0; ai < 2; ++ai)
#pragma unroll
            for (int m = 0; m < 4; ++m) { bf16_t* rowp = O + (size_t)(row0 + ai * 128 + m * 16) * 1024 + col0;
#pragma unroll
                for (int bj = 0; bj < 2; ++bj) { const f32x4 v0 = acc[ai][bj][m][0] * dq + bv[bj][0], v1 = acc[ai][bj][m][1] * dq + bv[bj][1];
                    u32x4 w; w.x = cvtpk(v0[0], v0[1]); w.y = cvtpk(v0[2], v0[3]); w.z = cvtpk(v1[0], v1[1]); w.w = cvtpk(v1[2], v1[3]);
                    *(u32x4*)(rowp + bj * 128) = w; } }
    }
};

__device__ __forceinline__ void phase_mod(const Params& p, unsigned char* lds, int G) {
    const int tid = opaque_tid(), lane = tid & 63, wave = tid >> 6;
    float* sc = (float*)lds;
    float* part = (float*)lds + 8192;
    const float* c = p.in[I_C];
    for (int i = tid; i < 8192; i += NTHREADS) { const int b = i & 7, k = i >> 3; const float cv = c[b * 1024 + k]; sc[k * 8 + b] = cv / (1.0f + __expf(-cv)); }
    __syncthreads();
    float* mod = (float*)(p.ws + WS_MOD);
    const float* mw = p.in[I_MODW]; const float* mb = p.in[I_MODB];
    for (int cg = (int)blockIdx.x; cg < 256; cg += G) {
        const int cc = lane & 31, kh = lane >> 5, k0 = wave * 128 + kh * 64, col = cg * 24 + (cc < 24 ? cc : 0);
        float acc[8];
#pragma unroll
        for (int b = 0; b < 8; ++b) acc[b] = 0.f;
        const float* wp = mw + (size_t)k0 * 6144 + col;
        const float* sp = sc + k0 * 8;
#pragma unroll 1
        for (int k = 0; k < 64; k += 16) { float wv[16];
#pragma unroll
            for (int u = 0; u < 16; ++u) wv[u] = wp[(size_t)(k + u) * 6144];
#pragma unroll
            for (int u = 0; u < 16; ++u) { const f32x4 s0 = *(const f32x4*)(sp + (k + u) * 8), s1 = *(const f32x4*)(sp + (k + u) * 8 + 4);
                acc[0] += s0[0] * wv[u]; acc[1] += s0[1] * wv[u]; acc[2] += s0[2] * wv[u]; acc[3] += s0[3] * wv[u]; acc[4] += s1[0] * wv[u]; acc[5] += s1[1] * wv[u]; acc[6] += s1[2] * wv[u]; acc[7] += s1[3] * wv[u]; } }
#pragma unroll
        for (int b = 0; b < 8; ++b) acc[b] += __shfl_xor(acc[b], 32);
        if (lane < 24) {
#pragma unroll
            for (int b = 0; b < 8; ++b) part[(wave * 24 + lane) * 8 + b] = acc[b]; }
        __syncthreads();
        if (tid < 192) { const int cl = tid >> 3, b = tid & 7; float sum = mb[cg * 24 + cl];
#pragma unroll
            for (int w = 0; w < 8; ++w) sum += part[(w * 24 + cl) * 8 + b];
            mod[b * 6144 + cg * 24 + cl] = sum; }
        __syncthreads();
    }
}
__device__ __forceinline__ void transpose_item(const float* W, int N, int k0, int n0, bf16_t* WT, int Kdst, int dst_row_base, bool gu_interleave, float* scr, int lane) {
#pragma unroll 4
    for (int i = 0; i < 16; ++i) { const int row = 4 * i + (lane >> 4), c4 = lane & 15;
        const f32x4 v = *(const f32x4*)(W + (size_t)(k0 + row) * N + n0 + 4 * c4);
        float* s = scr + row * 65 + 4 * c4; s[0] = v[0]; s[1] = v[1]; s[2] = v[2]; s[3] = v[3]; }
    asm volatile("s_waitcnt lgkmcnt(0)" ::: "memory");
    const int cch = lane & 7;
#pragma unroll
    for (int i = 0; i < 8; ++i) { const int n = 8 * i + (lane >> 3); const float* s = scr + (8 * cch) * 65 + n;
        u32x4 o; o.x = cvtpk(s[0], s[65]); o.y = cvtpk(s[2 * 65], s[3 * 65]); o.z = cvtpk(s[4 * 65], s[5 * 65]); o.w = cvtpk(s[6 * 65], s[7 * 65]);
        int nn = n0 + n;
        if (gu_interleave) nn = (nn < 1024) ? ((nn >> 7) * 256 + (nn & 127)) : (((nn - 1024) >> 7) * 256 + 128 + ((nn - 1024) & 127));
        *(u32x4*)(WT + (size_t)(dst_row_base + nn) * Kdst + k0 + 8 * cch) = o; }
    asm volatile("s_waitcnt lgkmcnt(0)" ::: "memory");
}
struct CvtItem { const float* src; unsigned char* dst; int N; };
__device__ __forceinline__ CvtItem cvt_item(const Params& p, int r, int lane) {
    CvtItem c; constexpr int I_GU = 32 * 512;
    const int nq = lane & 7, kq = lane >> 3;
    if (r < I_GU) { const int e = r >> 9, rr = r & 511, k0 = (rr >> 6) * 128, n0 = (rr & 63) * 32; c.N = 2048;
        c.src = p.in[I_WGU] + (size_t)e * 1024 * 2048 + (size_t)(k0 + kq) * 2048 + n0 + 4 * nq;
        const int nn = n0 + 4 * nq, nd = (nn < 1024) ? ((nn >> 7) * 256 + (nn & 127)) : (((nn - 1024) >> 7) * 256 + 128 + ((nn - 1024) & 127));
        c.dst = p.ws + WS_WG_T + ((size_t)(e * 2048 + nd)) * 1024 + k0 + 16 * kq; }
    else if (r < I_GU + 32 * 256) { const int q = r - I_GU, e = q >> 8, rr = q & 255, k0 = (rr >> 5) * 128, n0 = (rr & 31) * 32; c.N = 1024;
        c.src = p.in[I_WDN] + (size_t)e * 1024 * 1024 + (size_t)(k0 + kq) * 1024 + n0 + 4 * nq;
        c.dst = p.ws + WS_WD_T + ((size_t)(e * 1024 + n0 + 4 * nq)) * 1024 + k0 + 16 * kq; }
    else { const int q = r - (I_GU + 32 * 256), k0 = (q / 104) * 128, n0 = (q % 104) * 32; c.N = IC;
        c.src = p.in[I_WIN] + (size_t)(k0 + kq) * IC + n0 + 4 * nq;
        c.dst = p.ws + WS_WIN_T + ((size_t)(n0 + 4 * nq)) * 1024 + k0 + 16 * kq; }
    return c;
}
__device__ __forceinline__ void phase_convert(const Params& p, unsigned char* lds, int G, int part) {
    const int tid = opaque_tid(), lane = tid & 63, wave = tid >> 6;
    float* scr = (float*)lds + wave * (64 * 65);
    const int gw = (int)blockIdx.x * NWAVES + wave, NGW = G * NWAVES;
    constexpr int I_OUT = 16 * 16, NFE = 32 * 512 + 32 * 256;
    bf16_t* wout_t = (bf16_t*)(p.ws + WS_WOUT_T);
    if (part == 0) {
    for (int it = gw; it < I_OUT; it += NGW) transpose_item(p.in[I_WOUT], D, (it / 16) * 64, (it % 16) * 64, wout_t, 1024, 0, false, scr, lane);
    }
    unsigned* sq = (unsigned*)scr;
    const int wr_off = (lane >> 3) * 9 + (lane & 7), rd_off = (16 * (lane >> 3)) * 9 + (lane & 7);
    const int NF = (part == 0) ? NFE + 8 * 104 : NFE;
    int r = (part == 0) ? NFE + gw : gw;
    if (r >= NF) return;
    CvtItem cur = cvt_item(p, r, lane);
    f32x4 v[16];
#pragma unroll
    for (int i = 0; i < 16; ++i) v[i] = *(const f32x4*)(cur.src + (size_t)(8 * i) * cur.N);
    for (;;) {
#pragma unroll
        for (int i = 0; i < 16; ++i) sq[wr_off + 8 * i * 9] = cvt4_fp8(Q_W * v[i][0], Q_W * v[i][1], Q_W * v[i][2], Q_W * v[i][3]);
        asm volatile("" ::: "memory");
        const int rn = r + NGW; const bool more = rn < NF;
        unsigned char* dst = cur.dst;
        if (more) { cur = cvt_item(p, rn, lane);
#pragma unroll
            for (int i = 0; i < 16; ++i) v[i] = *(const f32x4*)(cur.src + (size_t)(8 * i) * cur.N); }
        asm volatile("s_waitcnt lgkmcnt(0)" ::: "memory");
        unsigned d[16];
#pragma unroll
        for (int j = 0; j < 16; ++j) d[j] = sq[rd_off + j * 9];
        u32x4 o[4];
#pragma unroll
        for (int g = 0; g < 4; ++g) { const unsigned d0 = d[4 * g], d1 = d[4 * g + 1], d2 = d[4 * g + 2], d3 = d[4 * g + 3];
            const unsigned x = __builtin_amdgcn_perm(d1, d0, 0x05010400u), y = __builtin_amdgcn_perm(d1, d0, 0x07030602u), z = __builtin_amdgcn_perm(d3, d2, 0x05010400u), w = __builtin_amdgcn_perm(d3, d2, 0x07030602u);
            o[0][g] = __builtin_amdgcn_perm(z, x, 0x05040100u); o[1][g] = __builtin_amdgcn_perm(z, x, 0x07060302u); o[2][g] = __builtin_amdgcn_perm(w, y, 0x05040100u); o[3][g] = __builtin_amdgcn_perm(w, y, 0x07060302u); }
#pragma unroll
        for (int nn = 0; nn < 4; ++nn) *(u32x4*)(dst + (size_t)nn * 1024) = o[nn];
        asm volatile("" ::: "memory");
        if (!more) break;
        r = rn;
    }
}

__device__ __forceinline__ void phase_norm1(const Params& p, int G) {
    const int tid = opaque_tid(), lane = tid & 63, wave = tid >> 6;
    const int gw = (int)blockIdx.x * NWAVES + wave, NGW = G * NWAVES;
    const float* x = p.in[I_X]; const float* gain = p.in[I_N1G]; const float* mod = (const float*)(p.ws + WS_MOD);
    bf16_t* h = (bf16_t*)(p.ws + WS_H);
    for (int row = gw; row < T; row += NGW) {
        const int b = row / SEQ;
        const f32x4* xr = (const f32x4*)(x + (size_t)row * D) + lane;
        f32x4 v[4]; float s = 0.f;
#pragma unroll
        for (int j = 0; j < 4; ++j) { v[j] = xr[64 * j]; s += (v[j][0] * v[j][0] + v[j][1] * v[j][1]) + (v[j][2] * v[j][2] + v[j][3] * v[j][3]); }
        const float rstd = rsqrtf(wave_sum(s) * (1.0f / D) + NORM_EPS);
        const float* sh = mod + b * 6144; const float* scl = mod + b * 6144 + 1024;
        unsigned* o4 = (unsigned*)((unsigned char*)h + (size_t)row * D) + lane;
#pragma unroll
        for (int j = 0; j < 4; ++j) { const int k = 4 * lane + 256 * j;
            const f32x4 g = *(const f32x4*)(gain + k), s1 = *(const f32x4*)(scl + k), s0 = *(const f32x4*)(sh + k);
            const f32x4 y = (v[j] * rstd) * g * (s1 + 1.0f) + s0;
            o4[64 * j] = cvt4_fp8(Q_H2 * y[0], Q_H2 * y[1], Q_H2 * y[2], Q_H2 * y[3]); }
    }
}

constexpr size_t CTL_KMAX = 57344;
__device__ __forceinline__ void kmax_pass(const Params& p, int G) {
    const int tid = opaque_tid(), lane = tid & 63, wave = tid >> 6;
    const bf16_t* proj = (const bf16_t*)(p.ws + WS_PROJ);
    unsigned* km = (unsigned*)(p.ws + WS_CTL + CTL_KMAX);
    const int TPB = T / G;
    float mx = 0.f; const int tok0 = (int)blockIdx.x * TPB;
    for (int ti = wave; ti < TPB; ti += NWAVES) {
        const u32x4 kv = *(const u32x4*)(proj + (size_t)(tok0 + ti) * IC + RC + 512 + 8 * lane);
        float ss = 0.f;
#pragma unroll
        for (int j = 0; j < 4; ++j) { const float a = __uint_as_float(kv[j] << 16), bq = __uint_as_float(kv[j] & 0xffff0000u); ss += a * a + bq * bq; }
        ss += __shfl_xor(ss, 1); ss += __shfl_xor(ss, 2); ss += __shfl_xor(ss, 4);
        mx = fmaxf(mx, ss);
    }
    if ((lane & 7) == 0) atomicMax(km + (tok0 / SEQ) * 8 + (lane >> 3), __float_as_uint(mx));
}

__device__ __forceinline__ s16x4 vtr(const LAS unsigned char* pp) { typedef short v4i16_t __attribute__((ext_vector_type(4))); return __builtin_bit_cast(s16x4, __builtin_amdgcn_ds_read_tr16_b64_v4i16((LAS v4i16_t*)pp)); }
constexpr int ATT_BUF = 32768;
__device__ __forceinline__ float att_max3(float a, float b, float c) { float r; asm("v_max3_f32 %0, %1, %2, %3" : "=v"(r) : "v"(a), "v"(b), "v"(c)); return r; }
constexpr int ATT_QROWS = 128, ATT_NQB = SEQ / ATT_QROWS, ATT_UNITS = NB * 4 * ATT_NQB;
__device__ __forceinline__ void attn_unit(const Params& p, LAS unsigned char* lds, int b, int h, int qb, float lam) {
    const int tid = opaque_tid(), lane = tid & 63, wid = __builtin_amdgcn_readfirstlane(tid >> 6), r32 = lane & 31, hi = lane >> 5;
    const int c = wid & 1, qblk = wid >> 1;
    const bf16_t* proj = (const bf16_t*)(p.ws + WS_PROJ) + (size_t)b * SEQ * IC;
    const int q0 = qb * ATT_QROWS, qw0 = q0 + 32 * qblk;
    const bf16_t* Qb = proj + RC + h * 128 + c * 64;
    const bf16_t* Kb = proj + RC + 512 + h * 128;
    const bf16_t* Vb = proj + RC + 1024 + h * 128;
    const float slope = exp2f(-2.0f * (float)(h + 1)) * LOG2E;
    f32x16 o[4];
#pragma unroll
    for (int d = 0; d < 4; ++d) o[d] = f32x16{};
    f32x16 cb0;
#pragma unroll
    for (int r = 0; r < 16; ++r) cb0[r] = slope * (float)((r & 3) + 8 * (r >> 2) + 4 * hi);
    const float c32 = slope * 32.0f;
    float m_ = 0.f, l_ = 0.f;
    const int NT = (q0 + ATT_QROWS) / 64;
    const bf16_t* ksrc = Kb + (size_t)lane * IC + wid * 8;
    const int p0i = wid, p1i = wid + 8;
    const bf16_t* vsrc0 = Vb + (size_t)(16 * (p0i & 3) + (lane >> 2)) * IC + (p0i >> 2) * 32 + (lane & 3) * 8;
    const bf16_t* vsrc1 = Vb + (size_t)(16 * (p1i & 3) + (lane >> 2)) * IC + (p1i >> 2) * 32 + (lane & 3) * 8;
#define ATT_GLDS(gsrc_, ldsdst_) do { unsigned keep_; asm volatile("s_mov_b32 %0, m0\n\ts_mov_b32 m0, %2\n\ts_nop 0\n\tglobal_load_lds_dwordx4 %1, off\n\ts_mov_b32 m0, %0" : "=&s"(keep_) : "v"(gsrc_), "s"(ldsdst_) : "memory"); } while (0)
    const unsigned lds0 = (unsigned)(uintptr_t)lds;
#define ATT_DMA(t, buf) do { const size_t ro = (size_t)(t) * 64 * IC; const unsigned bb_ = (unsigned)__builtin_amdgcn_readfirstlane((int)(lds0 + (buf) * ATT_BUF + wid * 1024)); \
        ATT_GLDS(ksrc + ro, bb_); ATT_GLDS(ksrc + ro + 64, bb_ + 8192u); ATT_GLDS(vsrc0 + ro, bb_ + 16384u); ATT_GLDS(vsrc1 + ro, bb_ + 16384u + 8192u); } while (0)
    ATT_DMA(NT - 1, 0); ATT_DMA(NT - 2, 1);
    bf16x8 qr[4];
#pragma unroll
    for (int d0 = 0; d0 < 4; ++d0) qr[d0] = *(const bf16x8*)(Qb + (size_t)(qw0 + r32) * IC + d0 * 16 + hi * 8);
    float qn;
    { float q2 = 0.f;
#pragma unroll
      for (int d0 = 0; d0 < 4; ++d0)
#pragma unroll
          for (int j = 0; j < 8; ++j) { const float x = bf2f((unsigned short)qr[d0][j]); q2 += x * x; }
      q2 += __shfl_xor(q2, 32);
      qn = sqrtf(q2 * ((const float*)(p.ws + WS_CTL + CTL_KMAX))[b * 8 + h * 2 + c]) * 1.002f + 0.01f; }
    asm volatile("" : "+v"(qr[0]), "+v"(qr[1]), "+v"(qr[2]), "+v"(qr[3]));
    asm volatile("s_waitcnt vmcnt(0)" ::: "memory");
    __builtin_amdgcn_s_barrier();
    const int voff = ((lane >> 4) & 1) * 32 + (lane & 3) * 8 + (4 * hi + ((lane & 15) >> 2)) * 64;
    const int qpos = qw0 + r32;
    const bool late = wid >= 4;
    bf16x8 pf[4]; bool pend = false;
    float mtrue = -INFINITY;
    LAS unsigned* vote = (LAS unsigned*)(lds + 4 * ATT_BUF + 64);
#define ATT_PV(slot_) do { const LAS unsigned char* vb_ = lds + (slot_) * ATT_BUF + 16384 + voff; \
        _Pragma("unroll") for (int dblk = 0; dblk < 4; ++dblk) { _Pragma("unroll") for (int ks = 0; ks < 4; ++ks) { \
            const s16x4 lo = vtr(vb_ + (dblk * 4 + ks) * 1024), hh = vtr(vb_ + (dblk * 4 + ks) * 1024 + 512); \
            const bf16x8 vf = (bf16x8){lo[0], lo[1], lo[2], lo[3], hh[0], hh[1], hh[2], hh[3]}; \
            o[dblk] = __builtin_amdgcn_mfma_f32_32x32x16_bf16(vf, pf[ks], o[dblk], 0, 0, 0); } } } while (0)
    int it = 0;
    for (; it < NT; ++it) {
        const int kt = NT - 1 - it, cur = it & 3;
        const bool issued = (it + 2 < NT);
        if (issued) ATT_DMA(kt - 2, (it + 2) & 3);
        const int k0 = kt * 64;
        if (late && pend) { ATT_PV((it - 1) & 3); pend = false; }
        if (k0 <= qw0 + 31) {
            const LAS unsigned char* bb = lds + cur * ATT_BUF;
            const bool need_mask = (k0 + 63 > qw0);
            const LAS unsigned char* kb = bb + c * 8192 + hi * 1024 + r32 * 16;
            f32x16 s0 = cb0, s1 = cb0;
#pragma unroll
            for (int d0 = 0; d0 < 4; ++d0) {
                const bf16x8 a0 = *(const LAS bf16x8*)(kb + d0 * 2048), a1 = *(const LAS bf16x8*)(kb + d0 * 2048 + 512);
                s0 = __builtin_amdgcn_mfma_f32_32x32x16_bf16(a0, qr[d0], s0, 0, 0, 0);
                s1 = __builtin_amdgcn_mfma_f32_32x32x16_bf16(a1, qr[d0], s1, 0, 0, 0);
            }
            if (need_mask) {
                const int dq = k0 - qpos + 4 * hi;
#pragma unroll
                for (int r = 0; r < 16; ++r) { if (dq + ((r & 3) + 8 * (r >> 2)) > 0) s0[r] = -INFINITY; if (dq + ((r & 3) + 8 * (r >> 2)) + 32 > 0) s1[r] = -INFINITY; }
            }
            const float tb = slope * (float)(k0 - qpos);
            float rm0 = att_max3(s0[0], s0[1], s0[2]), rm1 = att_max3(s1[0], s1[1], s1[2]);
#pragma unroll
            for (int r = 3; r < 15; r += 2) { rm0 = att_max3(rm0, s0[r], s0[r + 1]); rm1 = att_max3(rm1, s1[r], s1[r + 1]); }
            float rm = att_max3(rm0, s0[15], att_max3(rm1, s1[15], -INFINITY) + c32);
            rm += tb;
            rm = fmaxf(rm, __shfl_xor(rm, 32));
            mtrue = fmaxf(mtrue, rm);
            if (__any(rm > m_ + 8.0f)) {
                const float mn = fmaxf(m_, rm);
                const float alpha = __builtin_amdgcn_exp2f(m_ - mn);
                m_ = mn; l_ *= alpha;
#pragma unroll
                for (int d = 0; d < 4; ++d)
#pragma unroll
                    for (int r = 0; r < 16; ++r) o[d][r] *= alpha;
            }
            const float off = tb - m_, off1 = off + c32;
            float ps = 0.f;
#pragma unroll
            for (int r = 0; r < 16; ++r) { s0[r] = __builtin_amdgcn_exp2f(s0[r] + off); s1[r] = __builtin_amdgcn_exp2f(s1[r] + off1); ps += s0[r] + s1[r]; }
            l_ += ps;
#pragma unroll
            for (int ks = 0; ks < 2; ++ks) {
                u32x4 w0, w1;
                w0.x = cvtpk(s0[8 * ks + 0], s0[8 * ks + 1]); w0.y = cvtpk(s0[8 * ks + 2], s0[8 * ks + 3]); w0.z = cvtpk(s0[8 * ks + 4], s0[8 * ks + 5]); w0.w = cvtpk(s0[8 * ks + 6], s0[8 * ks + 7]);
                w1.x = cvtpk(s1[8 * ks + 0], s1[8 * ks + 1]); w1.y = cvtpk(s1[8 * ks + 2], s1[8 * ks + 3]); w1.z = cvtpk(s1[8 * ks + 4], s1[8 * ks + 5]); w1.w = cvtpk(s1[8 * ks + 6], s1[8 * ks + 7]);
                pf[ks] = __builtin_bit_cast(bf16x8, w0); pf[2 + ks] = __builtin_bit_cast(bf16x8, w1);
            }
            if (late) pend = true; else ATT_PV(cur);
        }
        { const bool neg = (qn + slope * (float)(k0 - 1 - qpos) <= mtrue - 50.0f);
          if (lane == 0) vote[(it & 1) * 8 + wid] = __all(neg) ? 1u : 0u; }
        if (issued) asm volatile("s_waitcnt vmcnt(4)" ::: "memory"); else asm volatile("s_waitcnt vmcnt(0)" ::: "memory");
        asm volatile("s_waitcnt lgkmcnt(0)" ::: "memory");
        __builtin_amdgcn_s_barrier();
        { const u32x4 va = *(const LAS u32x4*)(vote + (it & 1) * 8), vb2 = *(const LAS u32x4*)(vote + (it & 1) * 8 + 4);
          if ((va.x & va.y & va.z & va.w & vb2.x & vb2.y & vb2.z & vb2.w) != 0u) { ++it; break; } }
    }
    if (late && pend) ATT_PV((it - 1) & 3);
    asm volatile("s_waitcnt vmcnt(0) lgkmcnt(0)" ::: "memory");
    __builtin_amdgcn_s_barrier();
#undef ATT_PV
#undef ATT_DMA
#undef ATT_GLDS
    l_ += __shfl_xor(l_, 32);
    LAS float* xb = (LAS float*)(lds + qblk * 16384);
    if (c == 1) {
        const float i1 = lam / l_;
#pragma unroll
        for (int d = 0; d < 4; ++d)
#pragma unroll
            for (int r = 0; r < 16; ++r) xb[(d * 16 + r) * 64 + lane] = o[d][r] * i1;
    }
    __syncthreads();
    if (c == 0) {
        const float i0 = 1.0f / l_;
        float ss = 0.f;
#pragma unroll
        for (int d = 0; d < 4; ++d)
#pragma unroll
            for (int r = 0; r < 16; ++r) { const float v = o[d][r] * i0 - xb[(d * 16 + r) * 64 + lane]; o[d][r] = v; ss += v * v; }
        ss += __shfl_xor(ss, 32);
        const float rstd = rsqrtf(ss * (1.0f / 128.0f) + NORM_EPS) * (1.0f - LAMBDA_INIT);
        const float* sg = p.in[I_SUBLN];
        bf16_t* yo = (bf16_t*)(p.ws + WS_YMIX) + (size_t)(b * SEQ + qw0 + r32) * D + RW + h * 128;
#pragma unroll
        for (int d = 0; d < 4; ++d)
#pragma unroll
            for (int g = 0; g < 4; ++g) { const int dd = 32 * d + 8 * g + 4 * hi; const f32x4 gv = *(const f32x4*)(sg + dd);
                u32x2 w; w.x = cvtpk(o[d][4 * g] * rstd * gv[0], o[d][4 * g + 1] * rstd * gv[1]); w.y = cvtpk(o[d][4 * g + 2] * rstd * gv[2], o[d][4 * g + 3] * rstd * gv[3]);
                *(u32x2*)(yo + dd) = w; }
    }
    __syncthreads();
}

constexpr int RCH = 32;
constexpr int RK_R = 0, RK_KM = 8192, RK_DEC = 16384, RK_KK = 24576, RK_BB = 32768, RK_VV = 40960, RK_GG = 49152;
constexpr int RK_AW = 57344;
constexpr int RK_AA = RK_AW + 4608;
constexpr int RK_AG = RK_AA + 4608;
constexpr int RK_BON = RK_AG + 8704;
constexpr int RK_MU = RK_BON + 128;
constexpr int RK_RAW = 77824;
constexpr int RK_IM = RK_RAW + 33 * 1024;
constexpr int RK_LSEG = RK_IM + OPREC;
constexpr int RK_END = RK_LSEG + 2048;
static_assert(RK_MU + 1792 <= RK_RAW && RK_END <= LDS_BYTES - 64 && (RK_RAW % 1024) == 0, "rwkv prep LDS map");
template <int CTRL> __device__ __forceinline__ float dpp_add(float v) { return v + __builtin_bit_cast(float, __builtin_amdgcn_update_dpp(0, __builtin_bit_cast(int, v), CTRL, 0xf, 0xf, true)); }
__device__ __forceinline__ float red16(float v) {
    v = dpp_add<0xB1>(v);
    v = dpp_add<0x4E>(v);
    v = dpp_add<0x141>(v);
    v = dpp_add<0x140>(v);
    return v;
}
__device__ __forceinline__ int rk_piece_col(int pc, int h) {
    return pc < 8 ? h * 64 + 8 * pc : (pc < 16 ? 512 + h * 64 + 8 * (pc - 8) : (pc < 24 ? 1024 + h * 64 + 8 * (pc - 16) : 1536 + 8 * (pc - 24)));
}
#define RK_BAR() do { asm volatile("s_waitcnt lgkmcnt(0)" ::: "memory"); __builtin_amdgcn_s_barrier(); asm volatile("" ::: "memory"); } while (0)
__device__ __forceinline__ void rwkv_prep(const Params& p, LAS unsigned char* lds, int b, int h, int ch0, int ch1) {
    const int tid = opaque_tid(), lane = tid & 63, wid = __builtin_amdgcn_readfirstlane(tid >> 6);
    const bf16_t* proj = (const bf16_t*)(p.ws + WS_PROJ) + (size_t)b * SEQ * IC;
    LAS float* R_ = (LAS float*)(lds + RK_R); LAS float* KM_ = (LAS float*)(lds + RK_KM); LAS float* DEC_ = (LAS float*)(lds + RK_DEC); LAS float* KK_ = (LAS float*)(lds + RK_KK);
    LAS float* BB_ = (LAS float*)(lds + RK_BB); LAS float* VV_ = (LAS float*)(lds + RK_VV); LAS float* GG_ = (LAS float*)(lds + RK_GG); LAS float* BON_ = (LAS float*)(lds + RK_BON);
    LAS float* MU_ = (LAS float*)(lds + RK_MU);
    const int dpc = lane < 56 ? lane : 55;
    const bf16_t* dsrc = proj + rk_piece_col(dpc, h);
#define RK_DMA(t0_) do { for (int rho = wid; rho < 33; rho += NWAVES) { int tok = (t0_) - 1 + rho; tok = tok < 0 ? 0 : tok; \
        __builtin_amdgcn_global_load_lds((const unsigned*)(dsrc + (size_t)tok * IC), (LAS unsigned*)(lds + RK_RAW + rho * 1024), 16, 0, 0); } } while (0)
    RK_DMA(ch0 * RCH);
    if (tid < 448) MU_[tid] = p.in[I_MU][rk_piece_col(tid >> 3, h) + (tid & 7)];
    const int ntile = wid & 3, ttile = wid >> 2, fn = lane & 15, fk = lane >> 4;
    const int ncol = h * 64 + ntile * 16 + fn;
    bf16x8 bw[2], ba[2], bg[4];
    {
        const float* wup = p.in[I_WUP]; const float* aup = p.in[I_AUP]; const float* gup = p.in[I_GUP];
#pragma unroll
        for (int ks = 0; ks < 2; ++ks) { float t[8], u[8];
#pragma unroll
            for (int j = 0; j < 8; ++j) { const int k = 32 * ks + 8 * fk + j; t[j] = wup[k * RW + ncol]; u[j] = aup[k * RW + ncol]; }
            u32x4 a, c; a.x = cvtpk(t[0], t[1]); a.y = cvtpk(t[2], t[3]); a.z = cvtpk(t[4], t[5]); a.w = cvtpk(t[6], t[7]);
            c.x = cvtpk(u[0], u[1]); c.y = cvtpk(u[2], u[3]); c.z = cvtpk(u[4], u[5]); c.w = cvtpk(u[6], u[7]);
            bw[ks] = __builtin_bit_cast(bf16x8, a); ba[ks] = __builtin_bit_cast(bf16x8, c); }
#pragma unroll
        for (int ks = 0; ks < 4; ++ks) { float t[8];
#pragma unroll
            for (int j = 0; j < 8; ++j) { const int k = 32 * ks + 8 * fk + j; t[j] = gup[k * RW + ncol]; }
            u32x4 a; a.x = cvtpk(t[0], t[1]); a.y = cvtpk(t[2], t[3]); a.z = cvtpk(t[4], t[5]); a.w = cvtpk(t[6], t[7]);
            bg[ks] = __builtin_bit_cast(bf16x8, a); }
    }
    const float w0n = p.in[I_W0][ncol], a0n = p.in[I_A0][ncol];
    const int q16 = tid & 15, tk16 = tid >> 4;
    const f32x4 kkc = *(const f32x4*)(p.in[I_KK] + h * 64 + 4 * q16), kac = *(const f32x4*)(p.in[I_KA] + h * 64 + 4 * q16), rkc = *(const f32x4*)(p.in[I_RK] + h * 64 + 4 * q16);
    const size_t hb = (size_t)(b * 8 + h) * SEQ * 64;
    float* gVS = (float*)(p.ws + WS_VS) + hb; float* gGG = p.out + (size_t)16 * 1024 * 1024 + hb; float* gBON = (float*)(p.ws + WS_BON) + (size_t)(b * 8 + h) * SEQ;
    unsigned char* gOPS = p.ws + WS_OPS + (size_t)(b * 8 + h) * (SEQ / RCH) * OPREC;
    for (int ch = ch0; ch < ch1; ++ch) {
        const int t0 = ch * RCH;
        if (ch > ch0) { if (wid == 0) asm volatile("s_waitcnt vmcnt(8)" ::: "memory"); else if (wid == 1) asm volatile("s_waitcnt vmcnt(7)" ::: "memory"); else asm volatile("s_waitcnt vmcnt(6)" ::: "memory"); } else asm volatile("s_waitcnt vmcnt(0)" ::: "memory");
        RK_BAR();
#pragma unroll
        for (int it = 0; it < 4; ++it) { const int item = tid + it * NTHREADS;
            if (item < RCH * 56) { const int tk = item / 56, pc = item - tk * 56;
                const u32x4 cv = *(const LAS u32x4*)(lds + RK_RAW + (tk + 1) * 1024 + pc * 16);
                u32x4 pv = *(const LAS u32x4*)(lds + RK_RAW + tk * 1024 + pc * 16);
                if (t0 + tk == 0) pv = (u32x4){0u, 0u, 0u, 0u};
                const f32x4 m0 = *(const LAS f32x4*)(MU_ + pc * 8), m1 = *(const LAS f32x4*)(MU_ + pc * 8 + 4);
                float xv[8];
#pragma unroll
                for (int j = 0; j < 4; ++j) { const unsigned cw = cv[j], pw = pv[j];
                    const float c0 = __uint_as_float(cw << 16), c1 = __uint_as_float(cw & 0xffff0000u), p0 = __uint_as_float(pw << 16), p1 = __uint_as_float(pw & 0xffff0000u);
                    const float ma = (j < 2) ? m0[2 * j] : m1[2 * j - 4], mb = (j < 2) ? m0[2 * j + 1] : m1[2 * j - 3];
                    xv[2 * j] = c0 + ma * (p0 - c0); xv[2 * j + 1] = c1 + mb * (p1 - c1); }
                const int seg = pc >> 3, pi = pc & 7;
                if (seg <= 2) { LAS float* dst = (seg == 0 ? R_ : (seg == 1 ? KM_ : VV_)) + tk * 64 + 8 * pi;
                    *(LAS f32x4*)dst = (f32x4){xv[0], xv[1], xv[2], xv[3]}; *(LAS f32x4*)(dst + 4) = (f32x4){xv[4], xv[5], xv[6], xv[7]}; }
                else if (seg == 3) { u32x4 w; w.x = cvtpk(tanh_fast(xv[0]), tanh_fast(xv[1])); w.y = cvtpk(tanh_fast(xv[2]), tanh_fast(xv[3])); w.z = cvtpk(tanh_fast(xv[4]), tanh_fast(xv[5])); w.w = cvtpk(tanh_fast(xv[6]), tanh_fast(xv[7]));
                    *(LAS u32x4*)(lds + RK_AW + tk * 144 + 16 * pi) = w; }
                else if (seg == 4) { u32x4 w; w.x = cvtpk(xv[0], xv[1]); w.y = cvtpk(xv[2], xv[3]); w.z = cvtpk(xv[4], xv[5]); w.w = cvtpk(xv[6], xv[7]);
                    *(LAS u32x4*)(lds + RK_AA + tk * 144 + 16 * pi) = w; }
                else { u32x4 w; w.x = cvtpk(sigmoidf_(xv[0]), sigmoidf_(xv[1])); w.y = cvtpk(sigmoidf_(xv[2]), sigmoidf_(xv[3])); w.z = cvtpk(sigmoidf_(xv[4]), sigmoidf_(xv[5])); w.w = cvtpk(sigmoidf_(xv[6]), sigmoidf_(xv[7]));
                    *(LAS u32x4*)(lds + RK_AG + tk * 272 + (pc - 40) * 16) = w; }
            } }
        __syncthreads();
        if (ch + 1 < ch1) RK_DMA(t0 + RCH);
        {
            f32x4 cw = (f32x4){0.f, 0.f, 0.f, 0.f}, ca = cw, cg2 = cw;
            const int tok = ttile * 16 + fn;
#pragma unroll
            for (int ks = 0; ks < 2; ++ks) {
                const bf16x8 aw = *(const LAS bf16x8*)(lds + RK_AW + tok * 144 + (32 * ks + 8 * fk) * 2);
                const bf16x8 aa = *(const LAS bf16x8*)(lds + RK_AA + tok * 144 + (32 * ks + 8 * fk) * 2);
                cw = __builtin_amdgcn_mfma_f32_16x16x32_bf16(aw, bw[ks], cw, 0, 0, 0);
                ca = __builtin_amdgcn_mfma_f32_16x16x32_bf16(aa, ba[ks], ca, 0, 0, 0);
            }
#pragma unroll
            for (int ks = 0; ks < 4; ++ks) {
                const bf16x8 ag = *(const LAS bf16x8*)(lds + RK_AG + tok * 272 + (32 * ks + 8 * fk) * 2);
                cg2 = __builtin_amdgcn_mfma_f32_16x16x32_bf16(ag, bg[ks], cg2, 0, 0, 0);
            }
#pragma unroll
            for (int r = 0; r < 4; ++r) { const int tk = ttile * 16 + 4 * fk + r, n = ntile * 16 + fn;
                DEC_[tk * 64 + n] = -0.6065306597126334f * sigmoidf_(cw[r] + w0n);
                BB_[tk * 64 + n] = sigmoidf_(ca[r] + a0n);
                GG_[tk * 64 + n] = cg2[r]; }
        }
        RK_BAR();
        {
            const f32x4 kp = *(const LAS f32x4*)(KM_ + tk16 * 64 + 4 * q16), av = *(const LAS f32x4*)(BB_ + tk16 * 64 + 4 * q16), rr = *(const LAS f32x4*)(R_ + tk16 * 64 + 4 * q16);
            const f32x4 kkv = kp * kkc;
            const float nrm2 = red16((kkv[0] * kkv[0] + kkv[1] * kkv[1]) + (kkv[2] * kkv[2] + kkv[3] * kkv[3]));
            const f32x4 kkn = kkv * __builtin_amdgcn_rsqf(fmaxf(nrm2, 1e-24f));
            const f32x4 kmod = kp * ((av - 1.0f) * kac + 1.0f);
            const f32x4 t = rr * kmod * rkc;
            const float bs = red16((t[0] + t[1]) + (t[2] + t[3]));
            *(LAS f32x4*)(KK_ + tk16 * 64 + 4 * q16) = kkn; *(LAS f32x4*)(BB_ + tk16 * 64 + 4 * q16) = kkn * av; *(LAS f32x4*)(KM_ + tk16 * 64 + 4 * q16) = kmod;
            if (q16 == 0) BON_[tk16] = bs;
        }
        RK_BAR();
        {
            const int d1 = tid & 63, q1 = wid;
            float lw[4], cs[4];
#pragma unroll
            for (int e = 0; e < 4; ++e) lw[e] = DEC_[(4 * q1 + e) * 64 + d1];
            cs[0] = lw[0]; cs[1] = cs[0] + lw[1]; cs[2] = cs[1] + lw[2]; cs[3] = cs[2] + lw[3];
            ((LAS float*)(lds + RK_LSEG))[q1 * 64 + d1] = cs[3];
            { const float x0 = VV_[(4 * q1) * 64 + d1], x1 = VV_[(4 * q1 + 1) * 64 + d1], x2 = VV_[(4 * q1 + 2) * 64 + d1], x3 = VV_[(4 * q1 + 3) * 64 + d1];
              u32x2 w; w.x = cvtpk(x0, x1); w.y = cvtpk(x2, x3); *(LAS u32x2*)(lds + RK_IM + OP_VT + d1 * 80 + q1 * 8) = w; }
            RK_BAR();
            float off = 0.f, tot = 0.f;
#pragma unroll
            for (int qq = 0; qq < 8; ++qq) { const float sg = ((const LAS float*)(lds + RK_LSEG))[qq * 64 + d1]; tot += sg; if (qq < q1) off += sg; }
            const float etot = __expf(tot);
            float ePprev = __expf(off);
            float bc[4], kc4[4];
#pragma unroll
            for (int e = 0; e < 4; ++e) { const int tk = 4 * q1 + e;
                const float eP = __expf(off + cs[e]), eN = __builtin_amdgcn_rcpf(eP), eE = etot * eN;
                const float kap = KK_[tk * 64 + d1], bet = BB_[tk * 64 + d1], kk_ = KM_[tk * 64 + d1], rr = R_[tk * 64 + d1];
                const unsigned w0 = cvtpk(-kap * ePprev, rr * eP), w1 = cvtpk(bet * eN, kk_ * eN);
                *(LAS unsigned short*)(lds + RK_IM + OP_AT + tk * 144 + d1 * 2) = (unsigned short)(w0 & 0xffffu); *(LAS unsigned short*)(lds + RK_IM + OP_RT + tk * 144 + d1 * 2) = (unsigned short)(w0 >> 16);
                *(LAS unsigned short*)(lds + RK_IM + OP_BH + tk * 144 + d1 * 2) = (unsigned short)(w1 & 0xffffu); *(LAS unsigned short*)(lds + RK_IM + OP_KH + tk * 144 + d1 * 2) = (unsigned short)(w1 >> 16);
                bc[e] = bet * eE; kc4[e] = kk_ * eE; ePprev = eP; }
            u32x2 wb, wk; wb.x = cvtpk(bc[0], bc[1]); wb.y = cvtpk(bc[2], bc[3]); wk.x = cvtpk(kc4[0], kc4[1]); wk.y = cvtpk(kc4[2], kc4[3]);
            *(LAS u32x2*)(lds + RK_IM + OP_BCT + d1 * 80 + q1 * 8) = wb; *(LAS u32x2*)(lds + RK_IM + OP_KCT + d1 * 80 + q1 * 8) = wk;
            if (q1 == 0) ((LAS float*)(lds + RK_IM + OP_P31))[d1] = etot;
        }
        RK_BAR();
        {
            unsigned char* rec = gOPS + (size_t)ch * OPREC;
#pragma unroll
            for (int i = 0; i < 5; ++i) { const int o = (tid + i * NTHREADS) * 16; if (o < OPREC) *(u32x4*)(rec + o) = *(const LAS u32x4*)(lds + RK_IM + o); }
            const size_t go = (size_t)t0 * 64 + tid * 4;
            *(f32x4*)(gVS + go) = *(const LAS f32x4*)(VV_ + tid * 4);
            *(f32x4*)(gGG + go) = *(const LAS f32x4*)(GG_ + tid * 4);
            if (tid < RCH) gBON[t0 + tid] = BON_[tid];
        }
    }
    asm volatile("s_waitcnt vmcnt(0)" ::: "memory");
    __syncthreads();
#undef RK_DMA
}

constexpr int CS_IN = 32768;
constexpr int CS_OP = 2 * CS_IN;
constexpr int CS_AT = 0, CS_RT = 4608, CS_BH = 9216, CS_KH = 13824, CS_BCT = 18432, CS_KCT = 23552, CS_VT = 28672, CS_P31 = 31744;
constexpr int CS_MT2 = CS_OP, CS_MT3 = CS_OP + 2560, CS_MT4 = CS_OP + 5120;
constexpr int CS_M1F = CS_OP + 7680;
constexpr int CS_XF = CS_OP + 12288;
constexpr int CS_UB = CS_OP + 16896;
constexpr int CS_SB = CS_OP + 19456;
constexpr int CS_YY = CS_OP + 24064;
constexpr int CS_END = CS_OP + 28160;
static_assert(CS_END <= LDS_BYTES - 64, "rwkv scan LDS map");
__device__ __forceinline__ int crow32(int r, int hi) { return (r & 3) + 8 * (r >> 2) + 4 * hi; }
__device__ __forceinline__ void rwkv_scan(const Params& p, LAS unsigned char* lds, int b, int h, int half) {
    const int tid = opaque_tid(), lane = tid & 63, wid = __builtin_amdgcn_readfirstlane(tid >> 6), r32 = lane & 31, hi = lane >> 5;
    const unsigned char* gOPS = p.ws + WS_OPS + (size_t)(b * 8 + h) * (SEQ / RCH) * OPREC;
    float* yraw = p.out + (size_t)b * SEQ * RW + h * 64 + half * 32;
#define RS_DMA(ch_, buf) do { LAS unsigned char* bb_ = lds + (buf) * CS_IN; const unsigned char* rec_ = gOPS + (size_t)(ch_) * OPREC; \
        for (int pc = wid; pc < 32; pc += NWAVES) { \
            const unsigned char* src_ = rec_ + (pc < 28 ? pc * 1024 : (pc < 31 ? OP_VT + half * 2560 + (pc - 28) * 1024 : OP_P31)) + lane * 16; \
            __builtin_amdgcn_global_load_lds((const unsigned*)src_, (LAS unsigned*)(bb_ + pc * 1024), 16, 0, 0); } } while (0)
    RS_DMA(0, 0);
    for (int i = tid; i < 4608 / 4; i += NTHREADS) ((LAS unsigned*)(lds + CS_SB))[i] = 0u;
    f32x16 Sacc = f32x16{};
    f32x16 Xacc = f32x16{};
    for (int ch = 0; ch < SEQ / RCH; ++ch) {
        const int t0 = ch * RCH, cur = ch & 1;
        if (wid < 4 && ch > 0) asm volatile("s_waitcnt vmcnt(1)" ::: "memory"); else asm volatile("s_waitcnt vmcnt(0)" ::: "memory");
        RK_BAR();
        if (ch + 1 < SEQ / RCH) RS_DMA(ch + 1, cur ^ 1);
        const LAS unsigned char* ib = lds + cur * CS_IN;
        if (wid < 4) {
            const LAS unsigned char* Am = ib + ((wid & 1) ? CS_KH : CS_BH) + r32 * 144 + hi * 16;
            const LAS unsigned char* Bm = ib + ((wid & 2) ? CS_RT : CS_AT) + r32 * 144 + hi * 16;
            f32x16 acc = f32x16{};
#pragma unroll
            for (int ks = 0; ks < 4; ++ks) acc = __builtin_amdgcn_mfma_f32_32x32x16_bf16(*(const LAS bf16x8*)(Am + ks * 32), *(const LAS bf16x8*)(Bm + ks * 32), acc, 0, 0, 0);
            const int lim = (wid < 2) ? r32 : r32 + 1;
#pragma unroll
            for (int rg = 0; rg < 16; ++rg) if (crow32(rg, hi) >= lim) acc[rg] = 0.f;
            if (wid == 0) {
#pragma unroll
                for (int rg = 0; rg < 16; ++rg) ((LAS float*)(lds + CS_M1F))[crow32(rg, hi) * 36 + r32] = acc[rg];
            } else {
                LAS unsigned char* Mt = lds + (wid == 1 ? CS_MT2 : (wid == 2 ? CS_MT3 : CS_MT4)) + r32 * 80 + hi * 8;
#pragma unroll
                for (int g = 0; g < 4; ++g) { u32x2 w; w.x = cvtpk(acc[4 * g], acc[4 * g + 1]); w.y = cvtpk(acc[4 * g + 2], acc[4 * g + 3]); *(LAS u32x2*)(Mt + g * 16) = w; }
            }
        } else if (wid < 6) {
            const LAS unsigned char* Am = ib + (wid == 4 ? CS_AT : CS_RT) + r32 * 144 + hi * 16;
            const LAS unsigned char* Bm = lds + CS_SB + r32 * 144 + hi * 16;
            Xacc = f32x16{};
#pragma unroll
            for (int ks = 0; ks < 4; ++ks) Xacc = __builtin_amdgcn_mfma_f32_32x32x16_bf16(*(const LAS bf16x8*)(Am + ks * 32), *(const LAS bf16x8*)(Bm + ks * 32), Xacc, 0, 0, 0);
        }
        RK_BAR();
        if (wid == 4) {
            const LAS unsigned char* Am = lds + CS_MT2 + r32 * 80 + hi * 16;
            const LAS unsigned char* Bm = ib + CS_VT + r32 * 80 + hi * 16;
#pragma unroll
            for (int ks = 0; ks < 2; ++ks) Xacc = __builtin_amdgcn_mfma_f32_32x32x16_bf16(*(const LAS bf16x8*)(Am + ks * 32), *(const LAS bf16x8*)(Bm + ks * 32), Xacc, 0, 0, 0);
#pragma unroll
            for (int g = 0; g < 4; ++g) *(LAS f32x4*)(lds + CS_XF + r32 * 144 + (8 * g + 4 * hi) * 4) = (f32x4){Xacc[4 * g], Xacc[4 * g + 1], Xacc[4 * g + 2], Xacc[4 * g + 3]};
        }
        RK_BAR();
        {
            const int v = tid >> 4, l = tid & 15;
            float m0[32], m1[32];
#pragma unroll
            for (int c4 = 0; c4 < 8; ++c4) { const f32x4 a = *(const LAS f32x4*)(lds + CS_M1F + l * 144 + c4 * 16), c = *(const LAS f32x4*)(lds + CS_M1F + (l + 16) * 144 + c4 * 16);
                m0[4 * c4] = a[0]; m0[4 * c4 + 1] = a[1]; m0[4 * c4 + 2] = a[2]; m0[4 * c4 + 3] = a[3]; m1[4 * c4] = c[0]; m1[4 * c4 + 1] = c[1]; m1[4 * c4 + 2] = c[2]; m1[4 * c4 + 3] = c[3]; }
            const float x0 = ((const LAS float*)(lds + CS_XF))[v * 36 + l], x1 = ((const LAS float*)(lds + CS_XF))[v * 36 + l + 16];
            float u0 = 0.f, u1 = 0.f;
#pragma unroll
            for (int i = 0; i < 32; ++i) {
                const float part = (i < 16) ? u0 * m0[i] : (u0 * m0[i] + u1 * m1[i]);
                const float tot = red16(part);
                if (i < 16) u0 = (l == i) ? x0 + tot : u0; else u1 = (l == i - 16) ? x1 + tot : u1;
            }
            const unsigned w = cvtpk(u0, u1);
            *(LAS unsigned short*)(lds + CS_UB + v * 80 + l * 2) = (unsigned short)(w & 0xffffu); *(LAS unsigned short*)(lds + CS_UB + v * 80 + (l + 16) * 2) = (unsigned short)(w >> 16);
        }
        RK_BAR();
        if (wid == 5) {
            const LAS unsigned char* A3 = lds + CS_MT3 + r32 * 80 + hi * 16; const LAS unsigned char* A4 = lds + CS_MT4 + r32 * 80 + hi * 16;
            const LAS unsigned char* Bu = lds + CS_UB + r32 * 80 + hi * 16; const LAS unsigned char* Bv = ib + CS_VT + r32 * 80 + hi * 16;
#pragma unroll
            for (int ks = 0; ks < 2; ++ks) { Xacc = __builtin_amdgcn_mfma_f32_32x32x16_bf16(*(const LAS bf16x8*)(A3 + ks * 32), *(const LAS bf16x8*)(Bu + ks * 32), Xacc, 0, 0, 0);
                Xacc = __builtin_amdgcn_mfma_f32_32x32x16_bf16(*(const LAS bf16x8*)(A4 + ks * 32), *(const LAS bf16x8*)(Bv + ks * 32), Xacc, 0, 0, 0); }
#pragma unroll
            for (int rg = 0; rg < 16; ++rg) ((LAS float*)(lds + CS_YY))[crow32(rg, hi) * 32 + r32] = Xacc[rg];
        } else if (wid < 2) {
#pragma unroll
            for (int g = 0; g < 4; ++g) { const f32x4 pv = *(const LAS f32x4*)(ib + CS_P31 + (32 * wid + 8 * g + 4 * hi) * 4);
                Sacc[4 * g] *= pv[0]; Sacc[4 * g + 1] *= pv[1]; Sacc[4 * g + 2] *= pv[2]; Sacc[4 * g + 3] *= pv[3]; }
            const LAS unsigned char* Ab = ib + CS_BCT + (32 * wid + r32) * 80 + hi * 16; const LAS unsigned char* Ak = ib + CS_KCT + (32 * wid + r32) * 80 + hi * 16;
            const LAS unsigned char* Bu = lds + CS_UB + r32 * 80 + hi * 16; const LAS unsigned char* Bv = ib + CS_VT + r32 * 80 + hi * 16;
#pragma unroll
            for (int ks = 0; ks < 2; ++ks) { Sacc = __builtin_amdgcn_mfma_f32_32x32x16_bf16(*(const LAS bf16x8*)(Ab + ks * 32), *(const LAS bf16x8*)(Bu + ks * 32), Sacc, 0, 0, 0);
                Sacc = __builtin_amdgcn_mfma_f32_32x32x16_bf16(*(const LAS bf16x8*)(Ak + ks * 32), *(const LAS bf16x8*)(Bv + ks * 32), Sacc, 0, 0, 0); }
#pragma unroll
            for (int g = 0; g < 4; ++g) { u32x2 w; w.x = cvtpk(Sacc[4 * g], Sacc[4 * g + 1]); w.y = cvtpk(Sacc[4 * g + 2], Sacc[4 * g + 3]); *(LAS u32x2*)(lds + CS_SB + r32 * 144 + (32 * wid + 8 * g + 4 * hi) * 2) = w; }
        }
        RK_BAR();
        if (tid < 256) { const int tk = tid >> 3, sub = tid & 7; *(f32x4*)(yraw + (size_t)(t0 + tk) * RW + sub * 4) = *(const LAS f32x4*)(lds + CS_YY + tk * 128 + sub * 16); }
    }
    asm volatile("s_waitcnt vmcnt(0)" ::: "memory");
    __syncthreads();
#undef RS_DMA
}
__device__ __forceinline__ void rwkv_finalize(const Params& p, int G) {
    const int tid = opaque_tid(), q16 = tid & 15;
    const float* yraw = p.out; const float* gGG = p.out + (size_t)16 * 1024 * 1024; const float* gVS = (const float*)(p.ws + WS_VS); const float* gBON = (const float*)(p.ws + WS_BON);
    bf16_t* ymix = (bf16_t*)(p.ws + WS_YMIX);
    for (int item = (int)blockIdx.x * (NTHREADS / 16) + (tid >> 4); item < T * 8; item += G * (NTHREADS / 16)) {
        const int tok = item >> 3, h = item & 7, b = tok / SEQ, t = tok - b * SEQ;
        const f32x4 y = *(const f32x4*)(yraw + (size_t)tok * RW + h * 64 + 4 * q16);
        const size_t ho = ((size_t)(b * 8 + h) * SEQ + t) * 64 + 4 * q16;
        const f32x4 vv = *(const f32x4*)(gVS + ho), gg = *(const f32x4*)(gGG + ho);
        const float bon = gBON[(size_t)(b * 8 + h) * SEQ + t];
        const f32x4 gng = *(const f32x4*)(p.in[I_GNG] + h * 64 + 4 * q16), gnb = *(const f32x4*)(p.in[I_GNB] + h * 64 + 4 * q16);
        const float mean = red16((y[0] + y[1]) + (y[2] + y[3])) * (1.0f / 64.0f);
        const f32x4 dl = y - mean;
        const float var = red16((dl[0] * dl[0] + dl[1] * dl[1]) + (dl[2] * dl[2] + dl[3] * dl[3])) * (1.0f / 64.0f);
        const f32x4 yn = dl * __builtin_amdgcn_rsqf(var + GN_EPS) * gng + gnb;
        const f32x4 ov = (yn + vv * bon) * gg;
        u32x2 w; w.x = cvtpk(ov[0], ov[1]); w.y = cvtpk(ov[2], ov[3]);
        *(u32x2*)(ymix + (size_t)tok * D + h * 64 + 4 * q16) = w;
    }
}
#undef RK_BAR

constexpr int RT_X = 0;
constexpr int RT_LG = 131584;
constexpr int RT_GS = RT_LG + 16896;
constexpr int RT_RS = RT_GS + 8192;
constexpr int RT_HIST = RT_RS + 512;
constexpr int RT_CE = RT_HIST + 128;
static_assert(RT_CE + 1024 <= LDS_BYTES - 64, "router LDS map");
__device__ __forceinline__ int rt_swz(int k) { const int g = k >> 2; return ((g ^ ((g >> 4) & 3)) << 2) | (k & 3); }
__device__ __forceinline__ void phase_router(const Params& p, LAS unsigned char* lds, int G) {
    const int tid = opaque_tid(), lane = tid & 63, wave = __builtin_amdgcn_readfirstlane(tid >> 6);
    LAS float* xt = (LAS float*)(lds + RT_X); LAS float* lg = (LAS float*)(lds + RT_LG); LAS float* gs = (LAS float*)(lds + RT_GS); LAS float* shl = gs + 1024;
    LAS float* rsl = (LAS float*)(lds + RT_RS); LAS int* hist = (LAS int*)(lds + RT_HIST); LAS float* cew = (LAS float*)(lds + RT_CE);
    const float* rw = p.in[I_RTW];
    const float* x1 = p.out; const float* gain = p.in[I_N2G]; const float* mod = (const float*)(p.ws + WS_MOD); const float* rb = p.in[I_RTB];
    unsigned char* h2q = p.ws + WS_H;
    int* ridx = (int*)(p.ws + WS_ROUTE); float* rwt = (float*)(p.ws + WS_ROUTE + 512 * 1024);
    int* blockcnt = (int*)(p.ws + WS_CTL + 4096);
    const int TPB = T / G;
    const int blk = blockIdx.x, tok0 = blk * TPB, b = tok0 / SEQ;
    for (int k = tid; k < 1024; k += NTHREADS) { gs[rt_swz(k)] = gain[k] * (1.0f + mod[b * 6144 + 4096 + k]); shl[rt_swz(k)] = mod[b * 6144 + 3072 + k]; }
    if (tid < 32) hist[tid] = 0;
    __syncthreads();
    const int j = lane & 31, hh = lane >> 5, kb = 128 * wave + 64 * hh;
    float breg[64];
    { float cpart = 0.f;
#pragma unroll
        for (int s_ = 0; s_ < 64; ++s_) { const float w = rw[(size_t)(kb + s_) * 32 + j]; cpart += shl[rt_swz(kb + s_)] * w; breg[s_] = w * gs[rt_swz(kb + s_)]; }
        cpart += __shfl_xor(cpart, 32);
        if (lane < 32) cew[wave * 32 + lane] = cpart; }
    const int xsw = (2 * wave + hh) & 3;
    for (int t0 = 0; t0 < TPB; t0 += 128) {
        f32x4 v[16];
#define RT_LOAD(tl_) do { _Pragma("unroll") for (int q = 0; q < 4; ++q) { const int tq = t0 + 32 * (tl_) + 4 * wave + q; const f32x4* xr = (const f32x4*)(x1 + (size_t)(tok0 + (tq < TPB ? tq : 0)) * D) + lane; \
            _Pragma("unroll") for (int jj = 0; jj < 4; ++jj) v[4 * q + jj] = xr[64 * jj]; } } while (0)
        RT_LOAD(0);
#pragma unroll
        for (int tl = 0; tl < 4; ++tl) {
#pragma unroll
            for (int q = 0; q < 4; ++q) { float s = 0.f;
#pragma unroll
                for (int jj = 0; jj < 4; ++jj) { const f32x4 t = v[4 * q + jj]; s += (t[0] * t[0] + t[1] * t[1]) + (t[2] * t[2] + t[3] * t[3]); }
                const float rstd = rsqrtf(wave_sum(s) * (1.0f / D) + NORM_EPS);
                if (lane == 0) rsl[32 * tl + 4 * wave + q] = rstd;
#pragma unroll
                for (int jj = 0; jj < 4; ++jj) { const int g = lane + 64 * jj; *(LAS f32x4*)(xt + (4 * wave + q) * 1028 + 4 * (g ^ ((g >> 4) & 3))) = v[4 * q + jj]; } }
            __syncthreads();
            if (tl < 3) RT_LOAD(tl + 1);
            f32x16 acc = f32x16{};
            { const LAS float* arow = xt + (lane & 31) * 1028 + kb;
#pragma unroll
                for (int c = 0; c < 16; ++c) { const f32x4 a4 = *(const LAS f32x4*)(arow + 4 * (c ^ xsw));
                    acc = __builtin_amdgcn_mfma_f32_32x32x2f32(a4[0], breg[4 * c + 0], acc, 0, 0, 0);
                    acc = __builtin_amdgcn_mfma_f32_32x32x2f32(a4[1], breg[4 * c + 1], acc, 0, 0, 0);
                    acc = __builtin_amdgcn_mfma_f32_32x32x2f32(a4[2], breg[4 * c + 2], acc, 0, 0, 0);
                    acc = __builtin_amdgcn_mfma_f32_32x32x2f32(a4[3], breg[4 * c + 3], acc, 0, 0, 0); } }
            { const int hsw = (lane >> 2) & 3;
#pragma unroll
                for (int q = 0; q < 4; ++q) { const int tq = t0 + 32 * tl + 4 * wave + q; const float rstd = rsl[32 * tl + 4 * wave + q]; u32x4 o;
#pragma unroll
                    for (int u = 0; u < 4; ++u) { const int go = 4 * ((4 * lane + u) ^ hsw);
                        const f32x4 xv = *(const LAS f32x4*)(xt + (4 * wave + q) * 1028 + go), g4 = *(const LAS f32x4*)(gs + go), s4 = *(const LAS f32x4*)(shl + go);
                        const f32x4 y = (xv * rstd) * g4 + s4;
                        o[u] = cvt4_fp8(Q_H2 * y[0], Q_H2 * y[1], Q_H2 * y[2], Q_H2 * y[3]); }
                    if (tq < TPB) *(u32x4*)(h2q + (size_t)(tok0 + tq) * D + 16 * lane) = o; } }
            __syncthreads();
            { LAS float* part = (LAS float*)(lds + RT_X);
#pragma unroll
                for (int r = 0; r < 16; ++r) part[wave * 1024 + r * 64 + lane] = acc[r];
                __syncthreads();
                const int e = tid & 31; float ce = rb[e];
#pragma unroll
                for (int w = 0; w < 8; ++w) ce += cew[w * 32 + e];
#pragma unroll
                for (int q = 0; q < 2; ++q) { const int idx = tid + 512 * q; float sum = 0.f;
#pragma unroll
                    for (int w = 0; w < 8; ++w) sum += part[w * 1024 + idx];
                    const int r = idx >> 6, tk = 32 * tl + (r & 3) + 8 * (r >> 2) + 4 * ((idx >> 5) & 1);
                    lg[tk * 33 + e] = rsl[tk] * sum + ce; }
                __syncthreads(); }
        }
#undef RT_LOAD
        if (tid < 128 && t0 + tid < TPB) {
            const int row = tok0 + t0 + tid; const LAS float* lr = lg + tid * 33;
            float v0 = -INFINITY, v1 = -INFINITY, v2 = -INFINITY, v3 = -INFINITY; int i0 = 0, i1 = 0, i2 = 0, i3 = 0;
#pragma unroll
            for (int e = 0; e < 32; ++e) { const float x = lr[e];
                if (x > v0) { v3 = v2; i3 = i2; v2 = v1; i2 = i1; v1 = v0; i1 = i0; v0 = x; i0 = e; }
                else if (x > v1) { v3 = v2; i3 = i2; v2 = v1; i2 = i1; v1 = x; i1 = e; }
                else if (x > v2) { v3 = v2; i3 = i2; v2 = x; i2 = e; }
                else if (x > v3) { v3 = x; i3 = e; } }
            const float e1 = __expf(v1 - v0), e2 = __expf(v2 - v0), e3 = __expf(v3 - v0); const float inv = 1.0f / (1.0f + e1 + e2 + e3);
            *(int4*)(ridx + (size_t)row * 4) = make_int4(i0, i1, i2, i3); *(float4*)(rwt + (size_t)row * 4) = make_float4(inv, e1 * inv, e2 * inv, e3 * inv);
            atomicAdd((int*)&hist[i0], 1); atomicAdd((int*)&hist[i1], 1); atomicAdd((int*)&hist[i2], 1); atomicAdd((int*)&hist[i3], 1);
        }
        __syncthreads();
    }
    if (tid < 32) blockcnt[blk * 32 + tid] = hist[tid];
    __syncthreads();
}

__device__ __forceinline__ void phase_assign(const Params& p, LAS unsigned char* lds, int G) {
    const int tid = opaque_tid(), lane = tid & 63, wave = tid >> 6;
    LAS int* part = (LAS int*)lds;
    LAS int* partb = part + 512;
    LAS int* total = partb + 512;
    LAS int* base = total + 32;
    LAS int* segst = base + 32;
    LAS int* cursor = segst + 32;
    LAS int* slotl = cursor + 32;
    const int* blockcnt = (const int*)(p.ws + WS_CTL + 4096);
    const int* ridx = (const int*)(p.ws + WS_ROUTE); int* rslot = (int*)(p.ws + WS_ROUTE + 1024 * 1024); int* tokmap = (int*)(p.ws + WS_ROUTE + 2 * 1024 * 1024);
    const bf16_t* h2 = (const bf16_t*)(p.ws + WS_H); bf16_t* xs = (bf16_t*)(p.ws + WS_PROJ);
    int* tile = (int*)(p.ws + WS_TILE);
    const int TPB = T / G; const int blk = blockIdx.x;
    { const int e = tid & 31, part_i = tid >> 5; int st = 0, sb = 0;
        for (int bb = part_i; bb < G; bb += 16) { const int c = blockcnt[bb * 32 + e]; st += c; if (bb < blk) sb += c; }
        part[part_i * 32 + e] = st; partb[part_i * 32 + e] = sb; }
    __syncthreads();
    if (tid < 32) { int st = 0, sb = 0;
#pragma unroll
        for (int i = 0; i < 16; ++i) { st += part[i * 32 + tid]; sb += partb[i * 32 + tid]; }
        total[tid] = st; base[tid] = sb; cursor[tid] = 0; }
    __syncthreads();
    if (tid == 0) { int acc = 0; for (int e = 0; e < 32; ++e) { segst[e] = acc; acc += (total[e] + 255) & ~255; }
        if (blk == 0) { int pm = 0; for (int e = 0; e < 32; ++e) { const int nt = (total[e] + 255) >> 8; for (int i = 0; i < nt; ++i) tile[16 + pm + i] = e; pm += nt; } tile[0] = pm; } }
    __syncthreads();
    if (tid < 32) base[tid] += segst[tid];
    __syncthreads();
    for (int a = tid; a < TPB * 4; a += NTHREADS) { const int tok = blk * TPB + (a >> 2); const int e = ridx[(size_t)tok * 4 + (a & 3)];
        const int rank = atomicAdd((int*)&cursor[e], 1); const int slot = base[e] + rank; rslot[(size_t)tok * 4 + (a & 3)] = slot; tokmap[slot] = tok; }
    for (int e = blk; e < 32; e += G) { const int s0 = segst[e] + total[e], s1 = segst[e] + ((total[e] + 255) & ~255);
        for (int r = s0 + tid; r < s1; r += NTHREADS) tokmap[r] = 0; }
}

__device__ __forceinline__ void phase_final(const Params& p, int G, int stage) {
    const int tid = opaque_tid(), lane = tid & 63, wave = tid >> 6;
    const int gw = (int)blockIdx.x * NWAVES + wave, NGW = G * NWAVES;
    const float* fg = p.in[I_FG]; const float* mod = (const float*)(p.ws + WS_MOD);
    const int* rslot = (const int*)(p.ws + WS_ROUTE + 1024 * 1024); const float* rwt = (const float*)(p.ws + WS_ROUTE + 512 * 1024);
    const bf16_t* Y = (const bf16_t*)(p.ws + WS_PROJ);
    const float* src = (stage >= 4) ? p.out : p.in[I_X];
    for (int row = gw; row < T; row += NGW) {
        const int b = row / SEQ;
        const f32x4* xr = (const f32x4*)(src + (size_t)row * D) + lane;
        f32x4 v[4];
#pragma unroll
        for (int j = 0; j < 4; ++j) v[j] = xr[64 * j];
        if (stage >= 9) {
            const int4 sl = *(const int4*)(rslot + (size_t)row * 4); const float4 wt = *(const float4*)(rwt + (size_t)row * 4);
            const float* g2 = mod + b * 6144 + 5120;
            const int sls[4] = {sl.x, sl.y, sl.z, sl.w}; const float wts[4] = {wt.x, wt.y, wt.z, wt.w};
#pragma unroll
            for (int j = 0; j < 4; ++j) { f32x4 m = (f32x4){0.f, 0.f, 0.f, 0.f};
#pragma unroll
                for (int k = 0; k < 4; ++k) { const u32x2 yv = *((const u32x2*)(Y + (size_t)sls[k] * D) + lane + 64 * j);
                    m[0] += wts[k] * __uint_as_float(yv.x << 16); m[1] += wts[k] * __uint_as_float(yv.x & 0xffff0000u); m[2] += wts[k] * __uint_as_float(yv.y << 16); m[3] += wts[k] * __uint_as_float(yv.y & 0xffff0000u); }
                const f32x4 g = *(const f32x4*)(g2 + 4 * lane + 256 * j); v[j] = v[j] + g * m; }
        }
        float s = 0.f;
#pragma unroll
        for (int j = 0; j < 4; ++j) s += (v[j][0] * v[j][0] + v[j][1] * v[j][1]) + (v[j][2] * v[j][2] + v[j][3] * v[j][3]);
        const float rstd = rsqrtf(wave_sum(s) * (1.0f / D) + NORM_EPS);
        f32x4* orow = (f32x4*)(p.out + (size_t)row * D) + lane;
#pragma unroll
        for (int j = 0; j < 4; ++j) { const f32x4 g = *(const f32x4*)(fg + 4 * lane + 256 * j); orow[64 * j] = v[j] * rstd * g; }
    }
}


#define XB_TMO      128
#define XB_XCNT(j)  (256  + 64 * (j))
#define XB_XSUB(j)  (1280 + 64 * (j))
#define XB_XGEN(j)  (2304 + 64 * (j))
#define XB_TOP      3328
#define XB_TOPGEN   3392
#define XCD_BAR_WORDS 3456
#define XB_SPIN_CAP (1u << 22)
__device__ __forceinline__ unsigned xb_ld(unsigned* p)              { return __hip_atomic_load(p, __ATOMIC_RELAXED, __HIP_MEMORY_SCOPE_AGENT); }
__device__ __forceinline__ unsigned xb_add(unsigned* p, unsigned v) { return __hip_atomic_fetch_add(p, v, __ATOMIC_RELAXED, __HIP_MEMORY_SCOPE_AGENT); }
__device__ __forceinline__ unsigned xb_xcc_id() { return (unsigned)__builtin_amdgcn_s_getreg((3 << 11) | 20) & 0xFu; }
#define XB_SPIN(cond, bar) do { unsigned _sp = 0; while (cond) { __builtin_amdgcn_s_sleep(1); \
    if ((++_sp & 255u) == 0u) { if (xb_ld(&(bar)[XB_TMO])) break; if (_sp > XB_SPIN_CAP) { atomicAdd(&(bar)[XB_TMO], 1u); break; } } } } while (0)
struct XcdBarrier { unsigned* bar; unsigned x; volatile LAS unsigned* st; };
__device__ __forceinline__ XcdBarrier xcd_barrier_post(unsigned* bar, volatile LAS unsigned* st) {
    XcdBarrier b; b.bar = bar; b.x = xb_xcc_id(); b.st = st;
    if (threadIdx.x == 0) (void)xb_add(&bar[XB_XCNT(b.x)], 1u);
    return b;
}
__device__ __forceinline__ void xcd_barrier_complete(unsigned* bar, unsigned x, unsigned& nloc, unsigned& nx) {
    const unsigned G = gridDim.x * gridDim.y * gridDim.z;
    unsigned sum, cnt, mine, sp = 0u;
    for (;;) {
        sum = 0u; cnt = 0u; mine = 0u;
#pragma unroll
        for (unsigned j = 0; j < 16; ++j) { const unsigned c = xb_ld(&bar[XB_XCNT(j)]); sum += c; cnt += (c > 0u) ? 1u : 0u; mine = (j == x) ? c : mine; }
        if (sum == G) break;
        __builtin_amdgcn_s_sleep(1);
        if ((++sp & 255u) == 0u) { if (xb_ld(&bar[XB_TMO])) break; if (sp > XB_SPIN_CAP) { atomicAdd(&bar[XB_TMO], 1u); break; } }
    }
    nloc = mine > 0u ? mine : 1u; nx = cnt > 0u ? cnt : 1u;
}
__device__ __forceinline__ void xcd_barrier(const XcdBarrier& b) {
    asm volatile("s_waitcnt vmcnt(0)" ::: "memory");
    __syncthreads();
    if (threadIdx.x == 0) {
        unsigned* bar = b.bar;
        __builtin_amdgcn_s_waitcnt(0);
        unsigned nloc = b.st[0], nx = b.st[1];
        if (nloc == 0u) { xcd_barrier_complete(bar, b.x, nloc, nx); b.st[0] = nloc; b.st[1] = nx; }
        const unsigned old = xb_add(&bar[XB_XSUB(b.x)], 1u);
        const unsigned gen = old / nloc;
        if (old + 1u == (gen + 1u) * nloc) {
            __builtin_amdgcn_fence(__ATOMIC_RELEASE, "agent");
            asm volatile("s_waitcnt vmcnt(0)" ::: "memory");
            const unsigned og = xb_add(&bar[XB_TOP], 1u);
            const unsigned tg = og / nx;
            if (og + 1u == (tg + 1u) * nx) xb_add(&bar[XB_TOPGEN], 1u);
            else XB_SPIN(xb_ld(&bar[XB_TOPGEN]) == tg, bar);
            __builtin_amdgcn_fence(__ATOMIC_ACQUIRE, "agent");
            xb_add(&bar[XB_XGEN(b.x)], 1u);
            asm volatile("s_waitcnt vmcnt(0)" ::: "memory");
        } else {
            XB_SPIN(xb_ld(&bar[XB_XGEN(b.x)]) == gen, bar);
            __builtin_amdgcn_fence(__ATOMIC_ACQUIRE, "agent");
            asm volatile("s_waitcnt vmcnt(0)" ::: "memory");
        }
    }
    __syncthreads();
}

__device__ __forceinline__ const Params* launder_params(const Params* q) { asm volatile("" : "+s"(q)); return q; }
__global__ void __launch_bounds__(NTHREADS, 2) hymba_fwd(Params p) {
    extern __shared__ __attribute__((aligned(16))) unsigned char lds_raw[];
    cg::grid_group grid = cg::this_grid();
    LAS unsigned char* lds = (LAS unsigned char*)lds_raw;
    const int G = gridDim.x, tid = threadIdx.x;
    constexpr int STAGE = DBG_STAGE;
    volatile LAS unsigned* xst = (volatile LAS unsigned*)(lds + LDS_BYTES - 64);
    if (tid == 0) { xst[0] = 0u; xst[1] = 0u; }
    __syncthreads();
    const XcdBarrier xbar = xcd_barrier_post((unsigned*)(p.ws + WS_CTL + 40960), xst);
#define GRID_BAR() xcd_barrier(xbar)

    phase_mod(p, lds_raw, G);
    if (G == 0x7fffffff) grid.sync();
    GRID_BAR();
    if (STAGE >= 2) { phase_norm1(p, G); phase_convert(p, lds_raw, G, 0); GRID_BAR(); }
    if (STAGE >= 2) {
        pg8::Gemm g{(const bf16_t*)(p.ws + WS_H), (const bf16_t*)(p.ws + WS_WIN_T), D / 2, nullptr};
        pg8::DenseSched S; S.o.init(T / 256, IC / 256, G, (int)blockIdx.x);
        EpiInProj E{(bf16_t*)(p.ws + WS_PROJ)};
        pg8::gemm_phase<false, true>(lds, g, S, E);
        GRID_BAR();
    }
    if (STAGE >= 3) {
        kmax_pass(p, G);
        for (int it = blockIdx.x; it < NB * 8 * 4; it += G) rwkv_prep(p, lds, it >> 5, (it >> 2) & 7, (it & 3) * 32, (it & 3) * 32 + 32);
        GRID_BAR();
    }
    if (STAGE >= 2) {
        if (STAGE >= 3) { for (int u = blockIdx.x; u < NB * 8 * 2; u += G) rwkv_scan(p, lds, u >> 4, (u >> 1) & 7, u & 1); }
        else {
            bf16_t* ymix = (bf16_t*)(p.ws + WS_YMIX);
            for (size_t i = (size_t)blockIdx.x * NTHREADS + tid; i < (size_t)T * 64; i += (size_t)G * NTHREADS) { const size_t row = i >> 6, c = i & 63; *(u32x4*)(ymix + row * D + c * 8) = (u32x4){0u, 0u, 0u, 0u}; }
        }
        float lam;
        { const float* q1 = p.in[I_LQ1]; const float* k1 = p.in[I_LK1]; const float* q2 = p.in[I_LQ2]; const float* k2 = p.in[I_LK2]; float s1 = 0.f, s2 = 0.f;
            for (int i = 0; i < 64; ++i) { s1 += q1[i] * k1[i]; s2 += q2[i] * k2[i]; } lam = expf(s1) - expf(s2) + LAMBDA_INIT; }
        unsigned* qhead = (unsigned*)(p.ws + WS_CTL);
        LAS unsigned* ubox = (LAS unsigned*)(lds + 4 * ATT_BUF);
        for (;;) {
            __syncthreads();
            if (tid == 0) ubox[0] = atomicAdd(qhead, 1u);
            __syncthreads();
            const unsigned u = (unsigned)__builtin_amdgcn_readfirstlane((int)ubox[0]);
            if (u >= (unsigned)ATT_UNITS) break;
            attn_unit(p, lds, (int)(u & 31u) >> 2, (int)(u & 3u), ATT_NQB - 1 - (int)(u >> 5), lam);
        }
        GRID_BAR();
        if (STAGE >= 3) { rwkv_finalize(p, G); GRID_BAR(); }
    }
    if (STAGE >= 2) {
        pg8::Gemm g{(const bf16_t*)(p.ws + WS_YMIX), (const bf16_t*)(p.ws + WS_WOUT_T), D, nullptr};
        pg8::DenseSched S; S.o.init(T / 256, D / 256, G, (int)blockIdx.x);
        EpiOutProj E{p.in[I_X], (const float*)(p.ws + WS_MOD), p.out};
        pg8::gemm_phase<false, false>(lds, g, S, E);
        GRID_BAR();
    }
    if (STAGE >= 9) {
        phase_router(p, lds, G);
        GRID_BAR();
        phase_assign(p, lds, G);
        __syncthreads();
        phase_convert(p, lds_raw, G, 1);
        GRID_BAR();
        const int* tile = (const int*)(p.ws + WS_TILE);
        const int MT = tile[0];
        {
            pg8::Gemm g{(const bf16_t*)(p.ws + WS_H), (const bf16_t*)(p.ws + WS_WG_T), D / 2, (const int*)(p.ws + WS_ROUTE + 2 * 1024 * 1024)};
            pg8::MoeSched S; S.o.init(MT, 8, G, (int)blockIdx.x); S.tile_e = tile + 16; S.N = 2048;
            EpiMoe1 E{p.in[I_BGU], p.ws + WS_ACT};
            pg8::gemm_phase<true, true>(lds, g, S, E);
        }
        GRID_BAR();
        {
            pg8::Gemm g{(const bf16_t*)(p.ws + WS_ACT), (const bf16_t*)(p.ws + WS_WD_T), D / 2, nullptr};
            pg8::MoeSched S; S.o.init(MT, 4, G, (int)blockIdx.x); S.tile_e = tile + 16; S.N = 1024;
            EpiMoe2 E{p.in[I_BDN], (bf16_t*)(p.ws + WS_PROJ)};
            pg8::gemm_phase<false, true>(lds, g, S, E);
        }
        GRID_BAR();
    }
    phase_final(p, G, STAGE >= 9 ? 9 : (STAGE >= 2 ? 4 : 0));
}

extern "C" void kernel_launch(void* const* d_in, const int* in_sizes, int n_in, void* d_out, int out_size, void* d_ws, size_t ws_size, hipStream_t stream) {
    static int grid = 0;
    if (grid == 0) {
        if (n_in != 31 || out_size != T * D || ws_size < WS_END) { fprintf(stderr, "kernel_launch: unexpected shapes (n_in %d out %d ws %zu)\n", n_in, out_size, ws_size); grid = -1; return; }
        int dev = 0, cus = 0, per_cu = 0;
        hipGetDevice(&dev);
        hipDeviceGetAttribute(&cus, hipDeviceAttributeMultiprocessorCount, dev);
        hipFuncSetAttribute((const void*)hymba_fwd, hipFuncAttributeMaxDynamicSharedMemorySize, LDS_BYTES);
        hipOccupancyMaxActiveBlocksPerMultiprocessor(&per_cu, (const void*)hymba_fwd, NTHREADS, LDS_BYTES);
        if (per_cu < 1) { fprintf(stderr, "kernel_launch: occupancy query returned %d\n", per_cu); grid = -1; return; }
        grid = cus;
        if (grid > 256) grid = 256;
        while (T % grid != 0) --grid;
        (void)hipGetLastError();
    }
    if (grid < 0) return;
    hipMemsetAsync((char*)d_ws + WS_CTL, 0, CTL_BYTES, stream);
    Params p{};
    for (int i = 0; i < 31; ++i) p.in[i] = (const float*)d_in[i];
    p.out = (float*)d_out; p.ws = (unsigned char*)d_ws;
    void* args[] = {&p};
    hipError_t e = hipLaunchCooperativeKernel((const void*)hymba_fwd, dim3(grid), dim3(NTHREADS), args, LDS_BYTES, stream);
    if (e != hipSuccess) fprintf(stderr, "cooperative launch failed: %s (grid %d)\n", hipGetErrorString(e), grid);
}
```

```cpp
#include <hip/hip_runtime.h>
#include <hip/hip_cooperative_groups.h>
#include <cstdio>
#include <cstdint>
namespace cg = cooperative_groups;

#ifndef DBG_STAGE
#define DBG_STAGE 99
#endif

#define LAS __attribute__((address_space(3)))
typedef unsigned short bf16_t;
typedef short bf16x8 __attribute__((ext_vector_type(8)));
typedef short s16x4 __attribute__((ext_vector_type(4)));
typedef float f32x4 __attribute__((ext_vector_type(4)));
typedef float f32x16 __attribute__((ext_vector_type(16)));
typedef float f32x2_t __attribute__((ext_vector_type(2)));
typedef __bf16 bf16x2_t __attribute__((ext_vector_type(2)));
typedef unsigned u32x4 __attribute__((ext_vector_type(4)));
typedef unsigned u32x2 __attribute__((ext_vector_type(2)));

constexpr int D = 1024, NB = 8, SEQ = 4096, T = NB * SEQ;
constexpr int RW = 512, RC = 1792, DC = 1536, IC = 3328;
constexpr int NE = 32, TOPK = 4, NA = T * TOPK;
constexpr int PMAX = NA + NE * 256;
constexpr float NORM_EPS = 1e-5f, GN_EPS = 64e-5f;
constexpr float LOG2E = 1.4426950408889634f;
constexpr float QSCALE = 0.125f * LOG2E;
constexpr float LAMBDA_INIT = 0.2f;
constexpr int NTHREADS = 512, NWAVES = 8;
constexpr int LDS_BYTES = 163840;

constexpr size_t MiB = 1u << 20;
constexpr size_t WS_CTL = 0;
constexpr size_t CTL_BYTES = 65536;
constexpr size_t WS_MOD = 1 * MiB;
constexpr size_t WS_TILE = 1 * MiB + 512 * 1024;
constexpr size_t WS_WIN_T = 2 * MiB;
constexpr size_t WS_WOUT_T = 9 * MiB;
constexpr size_t WS_ROUTE = 11 * MiB;
constexpr size_t WS_WG_T = 16 * MiB;
constexpr size_t WS_WD_T = 144 * MiB;
constexpr size_t WS_H = 208 * MiB;
constexpr size_t WS_YMIX = 272 * MiB;
constexpr size_t WS_PROJ = 336 * MiB;
constexpr size_t WS_ACT = 608 * MiB;
constexpr size_t WS_END = 1008 * MiB;
constexpr int OPREC = 34816;
constexpr int OP_AT = 0, OP_RT = 4608, OP_BH = 9216, OP_KH = 13824, OP_BCT = 18432, OP_KCT = 23552, OP_VT = 28672, OP_P31 = 33792;
constexpr size_t WS_OPS = WS_ACT;
constexpr size_t WS_VS = 944 * MiB;
constexpr size_t WS_BON = WS_H;

__device__ __forceinline__ unsigned cvtpk(float lo, float hi) { f32x2_t v = {lo, hi}; bf16x2_t b = __builtin_convertvector(v, bf16x2_t); return __builtin_bit_cast(unsigned, b); }
__device__ __forceinline__ float bf2f(unsigned short u) { return __uint_as_float(((unsigned)u) << 16); }
__device__ __forceinline__ float wave_sum(float v) {
#pragma unroll
    for (int o = 1; o < 64; o <<= 1) v += __shfl_xor(v, o);
    return v;
}
__device__ __forceinline__ float wave_max(float v) {
#pragma unroll
    for (int o = 1; o < 64; o <<= 1) v = fmaxf(v, __shfl_xor(v, o));
    return v;
}
__device__ __forceinline__ int opaque_tid() { int t = (int)threadIdx.x; asm volatile("" : "+v"(t)); return t; }
__device__ __forceinline__ float sigmoidf_(float x) { return __builtin_amdgcn_rcpf(1.0f + __expf(-x)); }
__device__ __forceinline__ float tanh_fast(float x) { return 1.0f - 2.0f * __builtin_amdgcn_rcpf(1.0f + __expf(2.0f * x)); }

struct Params {
    const float* in[31];
    float* out;
    unsigned char* ws;
};
enum { I_X = 0, I_C, I_MODW, I_MODB, I_N1G, I_WIN, I_MU, I_W0, I_WUP, I_A0, I_AUP, I_GUP, I_KK, I_KA, I_RK, I_GNG, I_GNB, I_LQ1, I_LK1, I_LQ2, I_LK2, I_SUBLN, I_WOUT, I_N2G, I_RTW, I_RTB, I_WGU, I_BGU, I_WDN, I_BDN, I_FG };

namespace pg8 {
constexpr int BM = 256, BK = 64, HALF = 128, HTB = HALF * BK * 2, STAGE_BYTES = 8 * HTB, NXCD = 8, WGM = 8;
__host__ __device__ __forceinline__ int lds_byte(int r, int c) { const int st = (r >> 4) * 2 + (c >> 5), rr = r & 15, cc = c & 31, ob = rr * 64 + cc * 2; return st * 1024 + (ob ^ (((ob >> 9) & 1) << 5)); }
__host__ __device__ __forceinline__ void stage_rc(int b, int& R, int& C) { const int st = b / 1024, sb = b % 1024, swz = sb ^ (((sb >> 9) & 1) << 5); R = (st >> 1) * 16 + swz / 64; C = (st & 1) * 32 + (swz % 64) / 2; }
__host__ __device__ __forceinline__ int perm32(int rho) { const int n = rho >> 4, i = rho & 15; return 8 * (i >> 2) + 4 * n + (i & 3); }

struct Unit { int pm, pn, arow, brow, e; };
struct Gemm { const bf16_t* A; const bf16_t* Bt; int K; const int* rowmap; };

struct TileOrder {
    int nM, nN, nwg, G, c;
    __device__ void init(int nM_, int nN_, int G_, int c_) { nM = nM_; nN = nN_; nwg = nM * nN; G = G_; c = c_; }
    __device__ bool map(int i, int& pm, int& pn) const {
        const long L = (long)i * G + c; if (L >= nwg) return false;
        int wgid = (int)L; { const int q = nwg / NXCD, r = nwg % NXCD, xcd = wgid % NXCD, off = wgid / NXCD; wgid = (xcd < r ? xcd * (q + 1) : r * (q + 1) + (xcd - r) * q) + off; }
        const int nig = WGM * nN, gid = wgid / nig, fm = gid * WGM, gsz = (nM - fm) < WGM ? (nM - fm) : WGM;
        pm = fm + ((wgid % nig) % gsz); pn = (wgid % nig) / gsz; return true;
    }
};
struct DenseSched {
    TileOrder o;
    __device__ bool next(int i, Unit& u) const { int pm, pn; if (!o.map(i, pm, pn)) return false; u.pm = pm; u.pn = pn; u.arow = pm * BM; u.brow = pn * BM; u.e = 0; return true; }
};
struct MoeSched {
    TileOrder o; const int* tile_e; int N;
    __device__ bool next(int i, Unit& u) const { int pm, pn; if (!o.map(i, pm, pn)) return false; const int e = tile_e[pm]; u.pm = pm; u.pn = pn; u.arow = pm * BM; u.brow = e * N + pn * BM; u.e = e; return true; }
};

typedef int v4i_t __attribute__((ext_vector_type(4)));
typedef int v8i_t __attribute__((ext_vector_type(8)));
__device__ __forceinline__ v8i_t cat8(bf16x8 a, bf16x8 b) { return __builtin_shufflevector(__builtin_bit_cast(v4i_t, a), __builtin_bit_cast(v4i_t, b), 0, 1, 2, 3, 4, 5, 6, 7); }
__device__ __forceinline__ void mfma_fp8_tied(f32x4& acc, v8i_t a, v8i_t b) { asm volatile("v_mfma_f32_16x16x128_f8f6f4 %0, %1, %2, %0" : "+v"(acc) : "v"(a), "v"(b)); }
template <bool GATHER, bool FP8, class Epi, class Sched>
__device__ __forceinline__ void gemm_phase(LAS unsigned char* lds, const Gemm g, const Sched& S, const Epi& E) {
    const int tid = opaque_tid(), wid = __builtin_amdgcn_readfirstlane(tid >> 6), lane = tid & 63, wr = wid >> 2, wc = wid & 3, fr = lane & 15, fq = lane >> 4;
    const int K = g.K, nt = K / BK;
    unsigned voffA[2], voffB[2]; int rowA[2], colA2[2];
#pragma unroll
    for (int i = 0; i < 2; ++i) { int R, C; stage_rc(tid * 16 + i * 8192, R, C); const int Rb = (R & ~31) + perm32(R & 31);
        voffA[i] = (unsigned)(R * K + C) * 2u; voffB[i] = (unsigned)(Rb * K + C) * 2u; rowA[i] = R; colA2[i] = C * 2; }
    unsigned gv0[2] = {0u, 0u}, gv1[2] = {0u, 0u}, gn0[2] = {0u, 0u}, gn1[2] = {0u, 0u};
#define PG8_GOFF(u_, o0, o1) do { _Pragma("unroll") for (int _i = 0; _i < 2; ++_i) { o0[_i] = (unsigned)g.rowmap[(u_).arow + rowA[_i]] * (unsigned)(K * 2) + (unsigned)colA2[_i]; o1[_i] = (unsigned)g.rowmap[(u_).arow + HALF + rowA[_i]] * (unsigned)(K * 2) + (unsigned)colA2[_i]; } } while (0)
#define PG8_STAGE_A(bufoff, kptr, half) do { if constexpr (GATHER) { if (half) PG8_STAGE(bufoff, kptr, gv1); else PG8_STAGE(bufoff, kptr, gv0); } else PG8_STAGE(bufoff, (kptr) + ((half) ? hstep : 0), voffA); } while (0)
    const size_t kstep = (size_t)(BK * 2);
    const size_t hstep = (size_t)HALF * K * 2;
    const size_t rowb = (size_t)K * 2;
    const unsigned ldsw = (unsigned)wid * 1024u;
    const int aoff = lds_byte(wr * 64 + fr, fq * 8), boff = lds_byte(wc * 32 + fr, fq * 8);
#define PG8_SA(b, h) (((b) * 2 + (h)) * HTB)
#define PG8_SB(b, h) ((4 + (b) * 2 + (h)) * HTB)
#define PG8_STAGE(bufoff, gbase, voff) do { _Pragma("unroll") for (int _i = 0; _i < 2; ++_i) \
        __builtin_amdgcn_global_load_lds((const unsigned*)((const char*)(gbase) + (voff)[_i]), (LAS unsigned*)(lds + (bufoff) + ldsw + _i * 8192), 16, 0, 0); } while (0)
#define PG8_LDA(dst, b, h) do { _Pragma("unroll") for (int m = 0; m < 4; ++m) _Pragma("unroll") for (int k = 0; k < 2; ++k) dst[m][k] = *(const LAS bf16x8*)(lds + PG8_SA(b, h) + aoff + m * 2048 + k * 1024); } while (0)
#define PG8_LDB(dst, b, h) do { _Pragma("unroll") for (int n = 0; n < 2; ++n) _Pragma("unroll") for (int k = 0; k < 2; ++k) dst[n][k] = *(const LAS bf16x8*)(lds + PG8_SB(b, h) + boff + n * 2048 + k * 1024); } while (0)
#define PG8_MMA(ai, bj, At, Bt) do { __builtin_amdgcn_s_setprio(1); _Pragma("unroll") for (int m = 0; m < 4; ++m) _Pragma("unroll") for (int n = 0; n < 2; ++n) { \
        if constexpr (FP8) mfma_fp8_tied(acc[ai][bj][m][n], cat8(Bt[n][0], Bt[n][1]), cat8(At[m][0], At[m][1])); \
        else { _Pragma("unroll") for (int k = 0; k < 2; ++k) acc[ai][bj][m][n] = __builtin_amdgcn_mfma_f32_16x16x32_bf16(Bt[n][k], At[m][k], acc[ai][bj][m][n], 0, 0, 0); } } __builtin_amdgcn_s_setprio(0); } while (0)
#define PG8_WAIT_V(n) asm volatile("s_waitcnt vmcnt(" #n ")" ::: "memory")
#define PG8_WAIT_L(n) asm volatile("s_waitcnt lgkmcnt(" #n ")" ::: "memory")
#define PG8_BAR __builtin_amdgcn_s_barrier()
#define PG8_SCHED __builtin_amdgcn_sched_barrier(0)
    Unit cur, nxt; int ui = 0;
    if (!S.next(0, cur)) return;
    f32x4 acc[2][2][4][2];
#pragma unroll
    for (int a = 0; a < 2; ++a)
#pragma unroll
        for (int b = 0; b < 2; ++b)
#pragma unroll
            for (int m = 0; m < 4; ++m)
#pragma unroll
                for (int n = 0; n < 2; ++n) acc[a][b][m][n] = (f32x4){0.f, 0.f, 0.f, 0.f};
    bf16x8 At[4][2], B0[2][2], B1[2][2];
    const char* cA = GATHER ? (const char*)g.A : (const char*)g.A + (size_t)cur.arow * rowb; const char* cB = (const char*)g.Bt + (size_t)cur.brow * rowb;
    if constexpr (GATHER) PG8_GOFF(cur, gv0, gv1);
    PG8_STAGE(PG8_SB(0, 0), cB, voffB); PG8_STAGE(PG8_SB(0, 1), cB + hstep, voffB); PG8_STAGE_A(PG8_SA(0, 0), cA, 0); PG8_STAGE_A(PG8_SA(0, 1), cA, 1);
    if (wr == 1) PG8_BAR;
    PG8_WAIT_V(2); PG8_BAR;
    PG8_STAGE(PG8_SB(1, 0), cB + kstep, voffB); PG8_STAGE_A(PG8_SA(1, 0), cA + kstep, 0); PG8_STAGE(PG8_SB(1, 1), cB + hstep + kstep, voffB);
    PG8_WAIT_V(6); PG8_BAR;
    for (;;) {
        const bool has_next = S.next(ui + 1, nxt);
        const char* nA = GATHER ? (const char*)g.A : (has_next ? (const char*)g.A + (size_t)nxt.arow * rowb : cA); const char* nB = has_next ? (const char*)g.Bt + (size_t)nxt.brow * rowb : cB;

        for (int t = 0; t < nt; t += 2) {
            const bool last = (t == nt - 2);
            if constexpr (GATHER) { if (t == nt - 4) { if (has_next) PG8_GOFF(nxt, gn0, gn1); else { gn0[0] = gv0[0]; gn0[1] = gv0[1]; gn1[0] = gv1[0]; gn1[1] = gv1[1]; } } }
            const char* a1 = cA + (size_t)(t + 1) * kstep;
            const char* a2 = last ? nA : cA + (size_t)(t + 2) * kstep; const char* b2 = last ? nB : cB + (size_t)(t + 2) * kstep;
            const char* a3 = a2 + kstep; const char* b3 = b2 + kstep;
            PG8_LDB(B0, 0, 0); PG8_LDB(B1, 0, 1); PG8_SCHED; PG8_LDA(At, 0, 0); PG8_STAGE_A(PG8_SA(1, 1), a1, 1);
            if constexpr (GATHER) { if (last) { gv0[0] = gn0[0]; gv0[1] = gn0[1]; gv1[0] = gn1[0]; gv1[1] = gn1[1]; } }
            PG8_WAIT_V(8); PG8_WAIT_L(0); PG8_BAR; PG8_MMA(0, 0, At, B0); PG8_MMA(0, 1, At, B1); PG8_BAR; PG8_SCHED;
            PG8_LDA(At, 0, 1); PG8_STAGE(PG8_SB(0, 0), b2, voffB); PG8_STAGE(PG8_SB(0, 1), b2 + hstep, voffB); PG8_STAGE_A(PG8_SA(0, 0), a2, 0);
            PG8_WAIT_V(8); PG8_WAIT_L(0); PG8_BAR; PG8_MMA(1, 0, At, B0); PG8_MMA(1, 1, At, B1); PG8_BAR; PG8_SCHED;
            PG8_LDB(B0, 1, 0); PG8_LDB(B1, 1, 1); PG8_SCHED; PG8_LDA(At, 1, 0); PG8_STAGE_A(PG8_SA(0, 1), a2, 1);
            PG8_WAIT_V(8); PG8_WAIT_L(0); PG8_BAR; PG8_MMA(0, 0, At, B0); PG8_MMA(0, 1, At, B1); PG8_BAR; PG8_SCHED;
            PG8_LDA(At, 1, 1); PG8_STAGE(PG8_SB(1, 0), b3, voffB); PG8_STAGE(PG8_SB(1, 1), b3 + hstep, voffB); PG8_STAGE_A(PG8_SA(1, 0), a3, 0);
            PG8_WAIT_V(8); PG8_WAIT_L(0); PG8_BAR; PG8_MMA(1, 0, At, B0); PG8_MMA(1, 1, At, B1); PG8_BAR; PG8_SCHED;
        }
        if (wr == 0) PG8_BAR;
        if constexpr (FP8) asm volatile("s_nop 15\n\ts_nop 15" ::: "memory");
        E(acc, cur, wr, wc, fr, fq);
        if (!has_next) break;
#pragma unroll
        for (int a = 0; a < 2; ++a)
#pragma unroll
            for (int b = 0; b < 2; ++b)
#pragma unroll
                for (int m = 0; m < 4; ++m)
#pragma unroll
                    for (int n = 0; n < 2; ++n) acc[a][b][m][n] = (f32x4){0.f, 0.f, 0.f, 0.f};
        cur = nxt; cA = nA; cB = nB; ++ui;
        if (wr == 1) PG8_BAR;
    }
    PG8_WAIT_V(0);
    PG8_BAR;
#undef PG8_SA
#undef PG8_SB
#undef PG8_STAGE
#undef PG8_STAGE_A
#undef PG8_GOFF
#undef PG8_LDA
#undef PG8_LDB
#undef PG8_MMA
#undef PG8_WAIT_V
#undef PG8_WAIT_L
#undef PG8_BAR
#undef PG8_SCHED
}
}

constexpr float Q_H2 = 8.0f, Q_W = 32.0f, Q_ACT = 4.0f;
__device__ __forceinline__ unsigned cvt4_fp8(float a, float b, float c, float d) { unsigned w = 0u; w = (unsigned)__builtin_amdgcn_cvt_pk_fp8_f32(a, b, (int)w, false); w = (unsigned)__builtin_amdgcn_cvt_pk_fp8_f32(c, d, (int)w, true); return w; }
struct EpiInProj {
    bf16_t* O;
    __device__ __forceinline__ void operator()(const f32x4 (&acc)[2][2][4][2], const pg8::Unit& u, int wr, int wc, int fr, int fq) const {
        const int row0 = u.pm * 256 + wr * 64 + fr, col0 = u.pn * 256 + wc * 32 + 8 * fq;
        const float sc = (u.pn == 7 || u.pn == 8) ? QSCALE : 1.0f;
#pragma unroll
        for (int ai = 0; ai < 2; ++ai)
#pragma unroll
            for (int m = 0; m < 4; ++m) { bf16_t* rowp = O + (size_t)(row0 + ai * 128 + m * 16) * IC + col0;
#pragma unroll
                for (int bj = 0; bj < 2; ++bj) { const f32x4 v0 = acc[ai][bj][m][0] * sc, v1 = acc[ai][bj][m][1] * sc;
                    u32x4 w; w.x = cvtpk(v0[0], v0[1]); w.y = cvtpk(v0[2], v0[3]); w.z = cvtpk(v1[0], v1[1]); w.w = cvtpk(v1[2], v1[3]);
                    *(u32x4*)(rowp + bj * 128) = w; } }
    }
};
struct EpiOutProj {
    const float* x; const float* mod; float* O;
    __device__ __forceinline__ void operator()(const f32x4 (&acc)[2][2][4][2], const pg8::Unit& u, int wr, int wc, int fr, int fq) const {
        const int row0 = u.pm * 256 + wr * 64 + fr, col0 = u.pn * 256 + wc * 32 + 8 * fq;
        const int b = (u.pm * 256) / SEQ;
        const float* g1 = mod + b * 6144 + 2048;
        f32x4 gv[2][2];
#pragma unroll
        for (int bj = 0; bj < 2; ++bj)
#pragma unroll
            for (int n = 0; n < 2; ++n) gv[bj][n] = *(const f32x4*)(g1 + col0 + bj * 128 + 4 * n);
#pragma unroll
        for (int ai = 0; ai < 2; ++ai)
#pragma unroll
            for (int m = 0; m < 4; ++m) { const size_t off = (size_t)(row0 + ai * 128 + m * 16) * D + col0;
#pragma unroll
                for (int bj = 0; bj < 2; ++bj)
#pragma unroll
                    for (int n = 0; n < 2; ++n) { const f32x4 xv = *(const f32x4*)(x + off + bj * 128 + 4 * n);
                        *(f32x4*)(O + off + bj * 128 + 4 * n) = xv + gv[bj][n] * acc[ai][bj][m][n]; } }
    }
};
struct EpiMoe1 {
    const float* bgu; unsigned char* O;
    __device__ __forceinline__ void operator()(const f32x4 (&acc)[2][2][4][2], const pg8::Unit& u, int wr, int wc, int fr, int fq) const {
        const int row0 = u.pm * 256 + wr * 64 + fr, col0 = u.pn * 128 + wc * 32 + 8 * fq;
        const float* bg = bgu + (size_t)u.e * 2048 + col0;
        constexpr float dq = 1.0f / (Q_H2 * Q_W);
        f32x4 bgv[2], buv[2];
#pragma unroll
        for (int n = 0; n < 2; ++n) { bgv[n] = *(const f32x4*)(bg + 4 * n); buv[n] = *(const f32x4*)(bg + 1024 + 4 * n); }
#pragma unroll
        for (int ai = 0; ai < 2; ++ai)
#pragma unroll
            for (int m = 0; m < 4; ++m) { float a[8];
#pragma unroll
                for (int n = 0; n < 2; ++n) { const f32x4 gt = acc[ai][0][m][n] * dq + bgv[n], up = acc[ai][1][m][n] * dq + buv[n];
#pragma unroll
                    for (int j = 0; j < 4; ++j) { const float gg = fminf(gt[j], 7.0f), uu = fminf(fmaxf(up[j], -7.0f), 7.0f);
                        a[4 * n + j] = Q_ACT * (uu + 1.0f) * (gg * __builtin_amdgcn_rcpf(1.0f + __builtin_amdgcn_exp2f(-1.702f * LOG2E * gg))); } }
                u32x2 w; w.x = cvt4_fp8(a[0], a[1], a[2], a[3]); w.y = cvt4_fp8(a[4], a[5], a[6], a[7]);
                *(u32x2*)(O + (size_t)(row0 + ai * 128 + m * 16) * 1024 + col0) = w; }
    }
};
struct EpiMoe2 {
    const float* bdn; bf16_t* O;
    __device__ __forceinline__ void operator()(const f32x4 (&acc)[2][2][4][2], const pg8::Unit& u, int wr, int wc, int fr, int fq) const {
        const int row0 = u.pm * 256 + wr * 64 + fr, col0 = u.pn * 256 + wc * 32 + 8 * fq;
        const float* bd = bdn + (size_t)u.e * 1024 + col0;
        constexpr float dq = 1.0f / (Q_ACT * Q_W);
        f32x4 bv[2][2];
#pragma unroll
        for (int bj = 0; bj < 2; ++bj)
#pragma unroll
            for (int n = 0; n < 2; ++n) bv[bj][n] = *(const f32x4*)(bd + bj * 128 + 4 * n);
#pragma unroll
        for (int ai = 0; ai < 2; ++ai)
#pragma unroll
            for (int m = 0; m < 4; ++m) { bf16_t* rowp = O + (size_t)(row0 + ai * 128 + m * 16) * 1024 + col0;
#pragma unroll
                for (int bj = 0; bj < 2; ++bj) { const f32x4 v0 = acc[ai][bj][m][0] * dq + bv[bj][0], v1 = acc[ai][bj][m][1] * dq + bv[bj][1];
                    u32x4 w; w.x = cvtpk(v0[0], v0[1]); w.y = cvtpk(v0[2], v0[3]); w.z = cvtpk(v1[0], v1[1]); w.w = cvtpk(v1[2], v1[3]);
                    *(u32x4*)(rowp + bj * 128) = w; } }
    }
};

__device__ __forceinline__ void phase_mod(const Params& p, unsigned char* lds, int G) {
    const int tid = opaque_tid(), lane = tid & 63, wave = tid >> 6;
    float* sc = (float*)lds;
    float* part = (float*)lds + 8192;
    const float* c = p.in[I_C];
    for (int i = tid; i < 8192; i += NTHREADS) { const int b = i & 7, k = i >> 3; const float cv = c[b * 1024 + k]; sc[k * 8 + b] = cv / (1.0f + __expf(-cv)); }
    __syncthreads();
    float* mod = (float*)(p.ws + WS_MOD);
    const float* mw = p.in[I_MODW]; const float* mb = p.in[I_MODB];
    for (int cg = (int)blockIdx.x; cg < 256; cg += G) {
        const int cc = lane & 31, kh = lane >> 5, k0 = wave * 128 + kh * 64, col = cg * 24 + (cc < 24 ? cc : 0);
        float acc[8];
#pragma unroll
        for (int b = 0; b < 8; ++b) acc[b] = 0.f;
        const float* wp = mw + (size_t)k0 * 6144 + col;
        const float* sp = sc + k0 * 8;
#pragma unroll 1
        for (int k = 0; k < 64; k += 16) { float wv[16];
#pragma unroll
            for (int u = 0; u < 16; ++u) wv[u] = wp[(size_t)(k + u) * 6144];
#pragma unroll
            for (int u = 0; u < 16; ++u) { const f32x4 s0 = *(const f32x4*)(sp + (k + u) * 8), s1 = *(const f32x4*)(sp + (k + u) * 8 + 4);
                acc[0] += s0[0] * wv[u]; acc[1] += s0[1] * wv[u]; acc[2] += s0[2] * wv[u]; acc[3] += s0[3] * wv[u]; acc[4] += s1[0] * wv[u]; acc[5] += s1[1] * wv[u]; acc[6] += s1[2] * wv[u]; acc[7] += s1[3] * wv[u]; } }
#pragma unroll
        for (int b = 0; b < 8; ++b) acc[b] += __shfl_xor(acc[b], 32);
        if (lane < 24) {
#pragma unroll
            for (int b = 0; b < 8; ++b) part[(wave * 24 + lane) * 8 + b] = acc[b]; }
        __syncthreads();
        if (tid < 192) { const int cl = tid >> 3, b = tid & 7; float sum = mb[cg * 24 + cl];
#pragma unroll
            for (int w = 0; w < 8; ++w) sum += part[(w * 24 + cl) * 8 + b];
            mod[b * 6144 + cg * 24 + cl] = sum; }
        __syncthreads();
    }
}
__device__ __forceinline__ void transpose_item(const float* W, int N, int k0, int n0, bf16_t* WT, int Kdst, int dst_row_base, bool gu_interleave, float* scr, int lane) {
#pragma unroll 4
    for (int i = 0; i < 16; ++i) { const int row = 4 * i + (lane >> 4), c4 = lane & 15;
        const f32x4 v = *(const f32x4*)(W + (size_t)(k0 + row) * N + n0 + 4 * c4);
        float* s = scr + row * 65 + 4 * c4; s[0] = v[0]; s[1] = v[1]; s[2] = v[2]; s[3] = v[3]; }
    asm volatile("s_waitcnt lgkmcnt(0)" ::: "memory");
    const int cch = lane & 7;
#pragma unroll
    for (int i = 0; i < 8; ++i) { const int n = 8 * i + (lane >> 3); const float* s = scr + (8 * cch) * 65 + n;
        u32x4 o; o.x = cvtpk(s[0], s[65]); o.y = cvtpk(s[2 * 65], s[3 * 65]); o.z = cvtpk(s[4 * 65], s[5 * 65]); o.w = cvtpk(s[6 * 65], s[7 * 65]);
        int nn = n0 + n;
        if (gu_interleave) nn = (nn < 1024) ? ((nn >> 7) * 256 + (nn & 127)) : (((nn - 1024) >> 7) * 256 + 128 + ((nn - 1024) & 127));
        *(u32x4*)(WT + (size_t)(dst_row_base + nn) * Kdst + k0 + 8 * cch) = o; }
    asm volatile("s_waitcnt lgkmcnt(0)" ::: "memory");
}
struct CvtItem { const float* src; unsigned char* dst; int N; };
__device__ __forceinline__ CvtItem cvt_item(const Params& p, int r, int lane) {
    CvtItem c; constexpr int I_GU = 32 * 512;
    const int nq = lane & 7, kq = lane >> 3;
    if (r < I_GU) { const int e = r >> 9, rr = r & 511, k0 = (rr >> 6) * 128, n0 = (rr & 63) * 32; c.N = 2048;
        c.src = p.in[I_WGU] + (size_t)e * 1024 * 2048 + (size_t)(k0 + kq) * 2048 + n0 + 4 * nq;
        const int nn = n0 + 4 * nq, nd = (nn < 1024) ? ((nn >> 7) * 256 + (nn & 127)) : (((nn - 1024) >> 7) * 256 + 128 + ((nn - 1024) & 127));
        c.dst = p.ws + WS_WG_T + ((size_t)(e * 2048 + nd)) * 1024 + k0 + 16 * kq; }
    else if (r < I_GU + 32 * 256) { const int q = r - I_GU, e = q >> 8, rr = q & 255, k0 = (rr >> 5) * 128, n0 = (rr & 31) * 32; c.N = 1024;
        c.src = p.in[I_WDN] + (size_t)e * 1024 * 1024 + (size_t)(k0 + kq) * 1024 + n0 + 4 * nq;
        c.dst = p.ws + WS_WD_T + ((size_t)(e * 1024 + n0 + 4 * nq)) * 1024 + k0 + 16 * kq; }
    else { const int q = r - (I_GU + 32 * 256), k0 = (q / 104) * 128, n0 = (q % 104) * 32; c.N = IC;
        c.src = p.in[I_WIN] + (size_t)(k0 + kq) * IC + n0 + 4 * nq;
        c.dst = p.ws + WS_WIN_T + ((size_t)(n0 + 4 * nq)) * 1024 + k0 + 16 * kq; }
    return c;
}
__device__ __forceinline__ void phase_convert(const Params& p, unsigned char* lds, int G, int part) {
    const int tid = opaque_tid(), lane = tid & 63, wave = tid >> 6;
    float* scr = (float*)lds + wave * (64 * 65);
    const int gw = (int)blockIdx.x * NWAVES + wave, NGW = G * NWAVES;
    constexpr int I_OUT = 16 * 16, NFE = 32 * 512 + 32 * 256;
    bf16_t* wout_t = (bf16_t*)(p.ws + WS_WOUT_T);
    if (part == 0) {
    for (int it = gw; it < 16 * 52 + I_OUT; it += NGW) {
        if (it < 16 * 52) transpose_item(p.in[I_WIN], IC, (it / 52) * 64, (it % 52) * 64, (bf16_t*)(p.ws + WS_WIN_T), 1024, 0, false, scr, lane);
        else { const int r2 = it - 16 * 52; transpose_item(p.in[I_WOUT], D, (r2 / 16) * 64, (r2 % 16) * 64, wout_t, 1024, 0, false, scr, lane); } }
    return; }
    unsigned* sq = (unsigned*)scr;
    const int wr_off = (lane >> 3) * 9 + (lane & 7), rd_off = (16 * (lane >> 3)) * 9 + (lane & 7);
    const int NF = (part == 0) ? NFE + 8 * 104 : NFE;
    int r = (part == 0) ? NFE + gw : gw;
    if (r >= NF) return;
    CvtItem cur = cvt_item(p, r, lane);
    f32x4 v[16];
#pragma unroll
    for (int i = 0; i < 16; ++i) v[i] = *(const f32x4*)(cur.src + (size_t)(8 * i) * cur.N);
    for (;;) {
#pragma unroll
        for (int i = 0; i < 16; ++i) sq[wr_off + 8 * i * 9] = cvt4_fp8(Q_W * v[i][0], Q_W * v[i][1], Q_W * v[i][2], Q_W * v[i][3]);
        asm volatile("" ::: "memory");
        const int rn = r + NGW; const bool more = rn < NF;
        unsigned char* dst = cur.dst;
        if (more) { cur = cvt_item(p, rn, lane);
#pragma unroll
            for (int i = 0; i < 16; ++i) v[i] = *(const f32x4*)(cur.src + (size_t)(8 * i) * cur.N); }
        asm volatile("s_waitcnt lgkmcnt(0)" ::: "memory");
        unsigned d[16];
#pragma unroll
        for (int j = 0; j < 16; ++j) d[j] = sq[rd_off + j * 9];
        u32x4 o[4];
#pragma unroll
        for (int g = 0; g < 4; ++g) { const unsigned d0 = d[4 * g], d1 = d[4 * g + 1], d2 = d[4 * g + 2], d3 = d[4 * g + 3];
            const unsigned x = __builtin_amdgcn_perm(d1, d0, 0x05010400u), y = __builtin_amdgcn_perm(d1, d0, 0x07030602u), z = __builtin_amdgcn_perm(d3, d2, 0x05010400u), w = __builtin_amdgcn_perm(d3, d2, 0x07030602u);
            o[0][g] = __builtin_amdgcn_perm(z, x, 0x05040100u); o[1][g] = __builtin_amdgcn_perm(z, x, 0x07060302u); o[2][g] = __builtin_amdgcn_perm(w, y, 0x05040100u); o[3][g] = __builtin_amdgcn_perm(w, y, 0x07060302u); }
#pragma unroll
        for (int nn = 0; nn < 4; ++nn) *(u32x4*)(dst + (size_t)nn * 1024) = o[nn];
        asm volatile("" ::: "memory");
        if (!more) break;
        r = rn;
    }
}

__device__ __forceinline__ void phase_norm1(const Params& p, int G) {
    const int tid = opaque_tid(), lane = tid & 63, wave = tid >> 6;
    const int gw = (int)blockIdx.x * NWAVES + wave, NGW = G * NWAVES;
    const float* x = p.in[I_X]; const float* gain = p.in[I_N1G]; const float* mod = (const float*)(p.ws + WS_MOD);
    bf16_t* h = (bf16_t*)(p.ws + WS_H);
    for (int row = gw; row < T; row += NGW) {
        const int b = row / SEQ;
        const f32x4* xr = (const f32x4*)(x + (size_t)row * D) + lane;
        f32x4 v[4]; float s = 0.f;
#pragma unroll
        for (int j = 0; j < 4; ++j) { v[j] = xr[64 * j]; s += (v[j][0] * v[j][0] + v[j][1] * v[j][1]) + (v[j][2] * v[j][2] + v[j][3] * v[j][3]); }
        const float rstd = rsqrtf(wave_sum(s) * (1.0f / D) + NORM_EPS);
        const float* sh = mod + b * 6144; const float* scl = mod + b * 6144 + 1024;
        unsigned long long* o8 = (unsigned long long*)(h + (size_t)row * D) + lane;
#pragma unroll
        for (int j = 0; j < 4; ++j) { const int k = 4 * lane + 256 * j;
            const f32x4 g = *(const f32x4*)(gain + k), s1 = *(const f32x4*)(scl + k), s0 = *(const f32x4*)(sh + k);
            const f32x4 y = (v[j] * rstd) * g * (s1 + 1.0f) + s0;
            o8[64 * j] = (unsigned long long)cvtpk(y[0], y[1]) | ((unsigned long long)cvtpk(y[2], y[3]) << 32); }
    }
}

constexpr size_t CTL_KMAX = 57344;
__device__ __forceinline__ void kmax_pass(const Params& p, int G) {
    const int tid = opaque_tid(), lane = tid & 63, wave = tid >> 6;
    const bf16_t* proj = (const bf16_t*)(p.ws + WS_PROJ);
    unsigned* km = (unsigned*)(p.ws + WS_CTL + CTL_KMAX);
    const int TPB = T / G;
    float mx = 0.f; const int tok0 = (int)blockIdx.x * TPB;
    for (int ti = wave; ti < TPB; ti += NWAVES) {
        const u32x4 kv = *(const u32x4*)(proj + (size_t)(tok0 + ti) * IC + RC + 512 + 8 * lane);
        float ss = 0.f;
#pragma unroll
        for (int j = 0; j < 4; ++j) { const float a = __uint_as_float(kv[j] << 16), bq = __uint_as_float(kv[j] & 0xffff0000u); ss += a * a + bq * bq; }
        ss += __shfl_xor(ss, 1); ss += __shfl_xor(ss, 2); ss += __shfl_xor(ss, 4);
        mx = fmaxf(mx, ss);
    }
    if ((lane & 7) == 0) atomicMax(km + (tok0 / SEQ) * 8 + (lane >> 3), __float_as_uint(mx));
}

__device__ __forceinline__ s16x4 vtr(const LAS unsigned char* pp) { typedef short v4i16_t __attribute__((ext_vector_type(4))); return __builtin_bit_cast(s16x4, __builtin_amdgcn_ds_read_tr16_b64_v4i16((LAS v4i16_t*)pp)); }
constexpr int ATT_BUF = 32768;
__device__ __forceinline__ float att_max3(float a, float b, float c) { float r; asm("v_max3_f32 %0, %1, %2, %3" : "=v"(r) : "v"(a), "v"(b), "v"(c)); return r; }
constexpr int ATT_QROWS = 128, ATT_NQB = SEQ / ATT_QROWS, ATT_UNITS = NB * 4 * ATT_NQB;
__device__ __forceinline__ void attn_unit(const Params& p, LAS unsigned char* lds, int b, int h, int qb, float lam) {
    const int tid = opaque_tid(), lane = tid & 63, wid = __builtin_amdgcn_readfirstlane(tid >> 6), r32 = lane & 31, hi = lane >> 5;
    const int c = wid & 1, qblk = wid >> 1;
    const bf16_t* proj = (const bf16_t*)(p.ws + WS_PROJ) + (size_t)b * SEQ * IC;
    const int q0 = qb * ATT_QROWS, qw0 = q0 + 32 * qblk;
    const bf16_t* Qb = proj + RC + h * 128 + c * 64;
    const bf16_t* Kb = proj + RC + 512 + h * 128;
    const bf16_t* Vb = proj + RC + 1024 + h * 128;
    const float slope = exp2f(-2.0f * (float)(h + 1)) * LOG2E;
    f32x16 o[4];
#pragma unroll
    for (int d = 0; d < 4; ++d) o[d] = f32x16{};
    f32x16 cb0;
#pragma unroll
    for (int r = 0; r < 16; ++r) cb0[r] = slope * (float)((r & 3) + 8 * (r >> 2) + 4 * hi);
    const float c32 = slope * 32.0f;
    float m_ = 0.f, l_ = 0.f;
    const int NT = (q0 + ATT_QROWS) / 64;
    const bf16_t* ksrc = Kb + (size_t)lane * IC + wid * 8;
    const int p0i = wid, p1i = wid + 8;
    const bf16_t* vsrc0 = Vb + (size_t)(16 * (p0i & 3) + (lane >> 2)) * IC + (p0i >> 2) * 32 + (lane & 3) * 8;
    const bf16_t* vsrc1 = Vb + (size_t)(16 * (p1i & 3) + (lane >> 2)) * IC + (p1i >> 2) * 32 + (lane & 3) * 8;
#define ATT_GLDS(gsrc_, ldsdst_) do { unsigned keep_; asm volatile("s_mov_b32 %0, m0\n\ts_mov_b32 m0, %2\n\ts_nop 0\n\tglobal_load_lds_dwordx4 %1, off\n\ts_mov_b32 m0, %0" : "=&s"(keep_) : "v"(gsrc_), "s"(ldsdst_) : "memory"); } while (0)
    const unsigned lds0 = (unsigned)(uintptr_t)lds;
#define ATT_DMA(t, buf) do { const size_t ro = (size_t)(t) * 64 * IC; const unsigned bb_ = (unsigned)__builtin_amdgcn_readfirstlane((int)(lds0 + (buf) * ATT_BUF + wid * 1024)); \
        ATT_GLDS(ksrc + ro, bb_); ATT_GLDS(ksrc + ro + 64, bb_ + 8192u); ATT_GLDS(vsrc0 + ro, bb_ + 16384u); ATT_GLDS(vsrc1 + ro, bb_ + 16384u + 8192u); } while (0)
    ATT_DMA(NT - 1, 0); ATT_DMA(NT - 2, 1);
    bf16x8 qr[4];
#pragma unroll
    for (int d0 = 0; d0 < 4; ++d0) qr[d0] = *(const bf16x8*)(Qb + (size_t)(qw0 + r32) * IC + d0 * 16 + hi * 8);
    float qn;
    { float q2 = 0.f;
#pragma unroll
      for (int d0 = 0; d0 < 4; ++d0)
#pragma unroll
          for (int j = 0; j < 8; ++j) { const float x = bf2f((unsigned short)qr[d0][j]); q2 += x * x; }
      q2 += __shfl_xor(q2, 32);
      qn = sqrtf(q2 * ((const float*)(p.ws + WS_CTL + CTL_KMAX))[b * 8 + h * 2 + c]) * 1.002f + 0.01f; }
    asm volatile("" : "+v"(qr[0]), "+v"(qr[1]), "+v"(qr[2]), "+v"(qr[3]));
    asm volatile("s_waitcnt vmcnt(0)" ::: "memory");
    __builtin_amdgcn_s_barrier();
    const int voff = ((lane >> 4) & 1) * 32 + (lane & 3) * 8 + (4 * hi + ((lane & 15) >> 2)) * 64;
    const int qpos = qw0 + r32;
    const bool late = wid >= 4;
    bf16x8 pf[4]; bool pend = false;
    float mtrue = -INFINITY;
    LAS unsigned* vote = (LAS unsigned*)(lds + 4 * ATT_BUF + 64);
#define ATT_PV(slot_) do { const LAS unsigned char* vb_ = lds + (slot_) * ATT_BUF + 16384 + voff; \
        _Pragma("unroll") for (int dblk = 0; dblk < 4; ++dblk) { _Pragma("unroll") for (int ks = 0; ks < 4; ++ks) { \
            const s16x4 lo = vtr(vb_ + (dblk * 4 + ks) * 1024), hh = vtr(vb_ + (dblk * 4 + ks) * 1024 + 512); \
            const bf16x8 vf = (bf16x8){lo[0], lo[1], lo[2], lo[3], hh[0], hh[1], hh[2], hh[3]}; \
            o[dblk] = __builtin_amdgcn_mfma_f32_32x32x16_bf16(vf, pf[ks], o[dblk], 0, 0, 0); } } } while (0)
    int it = 0;
    for (; it < NT; ++it) {
        const int kt = NT - 1 - it, cur = it & 3;
        const bool issued = (it + 2 < NT);
        if (issued) ATT_DMA(kt - 2, (it + 2) & 3);
        const int k0 = kt * 64;
        if (late && pend) { ATT_PV((it - 1) & 3); pend = false; }
        if (k0 <= qw0 + 31) {
            const LAS unsigned char* bb = lds + cur * ATT_BUF;
            const bool need_mask = (k0 + 63 > qw0);
            const LAS unsigned char* kb = bb + c * 8192 + hi * 1024 + r32 * 16;
            f32x16 s0 = cb0, s1 = cb0;
#pragma unroll
            for (int d0 = 0; d0 < 4; ++d0) {
                const bf16x8 a0 = *(const LAS bf16x8*)(kb + d0 * 2048), a1 = *(const LAS bf16x8*)(kb + d0 * 2048 + 512);
                s0 = __builtin_amdgcn_mfma_f32_32x32x16_bf16(a0, qr[d0], s0, 0, 0, 0);
                s1 = __builtin_amdgcn_mfma_f32_32x32x16_bf16(a1, qr[d0], s1, 0, 0, 0);
            }
            if (need_mask) {
                const int dq = k0 - qpos + 4 * hi;
#pragma unroll
                for (int r = 0; r < 16; ++r) { if (dq + ((r & 3) + 8 * (r >> 2)) > 0) s0[r] = -INFINITY; if (dq + ((r & 3) + 8 * (r >> 2)) + 32 > 0) s1[r] = -INFINITY; }
            }
            const float tb = slope * (float)(k0 - qpos);
            float rm0 = att_max3(s0[0], s0[1], s0[2]), rm1 = att_max3(s1[0], s1[1], s1[2]);
#pragma unroll
            for (int r = 3; r < 15; r += 2) { rm0 = att_max3(rm0, s0[r], s0[r + 1]); rm1 = att_max3(rm1, s1[r], s1[r + 1]); }
            float rm = att_max3(rm0, s0[15], att_max3(rm1, s1[15], -INFINITY) + c32);
            rm += tb;
            rm = fmaxf(rm, __shfl_xor(rm, 32));
            mtrue = fmaxf(mtrue, rm);
            if (__any(rm > m_ + 8.0f)) {
                const float mn = fmaxf(m_, rm);
                const float alpha = __builtin_amdgcn_exp2f(m_ - mn);
                m_ = mn; l_ *= alpha;
#pragma unroll
                for (int d = 0; d < 4; ++d)
#pragma unroll
                    for (int r = 0; r < 16; ++r) o[d][r] *= alpha;
            }
            const float off = tb - m_, off1 = off + c32;
            float ps = 0.f;
#pragma unroll
            for (int r = 0; r < 16; ++r) { s0[r] = __builtin_amdgcn_exp2f(s0[r] + off); s1[r] = __builtin_amdgcn_exp2f(s1[r] + off1); ps += s0[r] + s1[r]; }
            l_ += ps;
#pragma unroll
            for (int ks = 0; ks < 2; ++ks) {
                u32x4 w0, w1;
                w0.x = cvtpk(s0[8 * ks + 0], s0[8 * ks + 1]); w0.y = cvtpk(s0[8 * ks + 2], s0[8 * ks + 3]); w0.z = cvtpk(s0[8 * ks + 4], s0[8 * ks + 5]); w0.w = cvtpk(s0[8 * ks + 6], s0[8 * ks + 7]);
                w1.x = cvtpk(s1[8 * ks + 0], s1[8 * ks + 1]); w1.y = cvtpk(s1[8 * ks + 2], s1[8 * ks + 3]); w1.z = cvtpk(s1[8 * ks + 4], s1[8 * ks + 5]); w1.w = cvtpk(s1[8 * ks + 6], s1[8 * ks + 7]);
                pf[ks] = __builtin_bit_cast(bf16x8, w0); pf[2 + ks] = __builtin_bit_cast(bf16x8, w1);
            }
            if (late) pend = true; else ATT_PV(cur);
        }
        { const bool neg = (qn + slope * (float)(k0 - 1 - qpos) <= mtrue - 50.0f);
          if (lane == 0) vote[(it & 1) * 8 + wid] = __all(neg) ? 1u : 0u; }
        if (issued) asm volatile("s_waitcnt vmcnt(4)" ::: "memory"); else asm volatile("s_waitcnt vmcnt(0)" ::: "memory");
        asm volatile("s_waitcnt lgkmcnt(0)" ::: "memory");
        __builtin_amdgcn_s_barrier();
        { const u32x4 va = *(const LAS u32x4*)(vote + (it & 1) * 8), vb2 = *(const LAS u32x4*)(vote + (it & 1) * 8 + 4);
          if ((va.x & va.y & va.z & va.w & vb2.x & vb2.y & vb2.z & vb2.w) != 0u) { ++it; break; } }
    }
    if (late && pend) ATT_PV((it - 1) & 3);
    asm volatile("s_waitcnt vmcnt(0) lgkmcnt(0)" ::: "memory");
    __builtin_amdgcn_s_barrier();
#undef ATT_PV
#undef ATT_DMA
#undef ATT_GLDS
    l_ += __shfl_xor(l_, 32);
    LAS float* xb = (LAS float*)(lds + qblk * 16384);
    if (c == 1) {
        const float i1 = lam / l_;
#pragma unroll
        for (int d = 0; d < 4; ++d)
#pragma unroll
            for (int r = 0; r < 16; ++r) xb[(d * 16 + r) * 64 + lane] = o[d][r] * i1;
    }
    __syncthreads();
    if (c == 0) {
        const float i0 = 1.0f / l_;
        float ss = 0.f;
#pragma unroll
        for (int d = 0; d < 4; ++d)
#pragma unroll
            for (int r = 0; r < 16; ++r) { const float v = o[d][r] * i0 - xb[(d * 16 + r) * 64 + lane]; o[d][r] = v; ss += v * v; }
        ss += __shfl_xor(ss, 32);
        const float rstd = rsqrtf(ss * (1.0f / 128.0f) + NORM_EPS) * (1.0f - LAMBDA_INIT);
        const float* sg = p.in[I_SUBLN];
        bf16_t* yo = (bf16_t*)(p.ws + WS_YMIX) + (size_t)(b * SEQ + qw0 + r32) * D + RW + h * 128;
#pragma unroll
        for (int d = 0; d < 4; ++d)
#pragma unroll
            for (int g = 0; g < 4; ++g) { const int dd = 32 * d + 8 * g + 4 * hi; const f32x4 gv = *(const f32x4*)(sg + dd);
                u32x2 w; w.x = cvtpk(o[d][4 * g] * rstd * gv[0], o[d][4 * g + 1] * rstd * gv[1]); w.y = cvtpk(o[d][4 * g + 2] * rstd * gv[2], o[d][4 * g + 3] * rstd * gv[3]);
                *(u32x2*)(yo + dd) = w; }
    }
    __syncthreads();
}

constexpr int RCH = 32;
constexpr int RK_R = 0, RK_KM = 8192, RK_DEC = 16384, RK_KK = 24576, RK_BB = 32768, RK_VV = 40960, RK_GG = 49152;
constexpr int RK_AW = 57344;
constexpr int RK_AA = RK_AW + 4608;
constexpr int RK_AG = RK_AA + 4608;
constexpr int RK_BON = RK_AG + 8704;
constexpr int RK_MU = RK_BON + 128;
constexpr int RK_RAW = 77824;
constexpr int RK_IM = RK_RAW + 33 * 1024;
constexpr int RK_LSEG = RK_IM + OPREC;
constexpr int RK_END = RK_LSEG + 2048;
static_assert(RK_MU + 1792 <= RK_RAW && RK_END <= LDS_BYTES - 64 && (RK_RAW % 1024) == 0, "rwkv prep LDS map");
template <int CTRL> __device__ __forceinline__ float dpp_add(float v) { return v + __builtin_bit_cast(float, __builtin_amdgcn_update_dpp(0, __builtin_bit_cast(int, v), CTRL, 0xf, 0xf, true)); }
__device__ __forceinline__ float red16(float v) {
    v = dpp_add<0xB1>(v);
    v = dpp_add<0x4E>(v);
    v = dpp_add<0x141>(v);
    v = dpp_add<0x140>(v);
    return v;
}
__device__ __forceinline__ int rk_piece_col(int pc, int h) {
    return pc < 8 ? h * 64 + 8 * pc : (pc < 16 ? 512 + h * 64 + 8 * (pc - 8) : (pc < 24 ? 1024 + h * 64 + 8 * (pc - 16) : 1536 + 8 * (pc - 24)));
}
#define RK_BAR() do { asm volatile("s_waitcnt lgkmcnt(0)" ::: "memory"); __builtin_amdgcn_s_barrier(); asm volatile("" ::: "memory"); } while (0)
__device__ __forceinline__ void rwkv_prep(const Params& p, LAS unsigned char* lds, int b, int h, int ch0, int ch1) {
    const int tid = opaque_tid(), lane = tid & 63, wid = __builtin_amdgcn_readfirstlane(tid >> 6);
    const bf16_t* proj = (const bf16_t*)(p.ws + WS_PROJ) + (size_t)b * SEQ * IC;
    LAS float* R_ = (LAS float*)(lds + RK_R); LAS float* KM_ = (LAS float*)(lds + RK_KM); LAS float* DEC_ = (LAS float*)(lds + RK_DEC); LAS float* KK_ = (LAS float*)(lds + RK_KK);
    LAS float* BB_ = (LAS float*)(lds + RK_BB); LAS float* VV_ = (LAS float*)(lds + RK_VV); LAS float* GG_ = (LAS float*)(lds + RK_GG); LAS float* BON_ = (LAS float*)(lds + RK_BON);
    LAS float* MU_ = (LAS float*)(lds + RK_MU);
    const int dpc = lane < 56 ? lane : 55;
    const bf16_t* dsrc = proj + rk_piece_col(dpc, h);
#define RK_DMA(t0_) do { for (int rho = wid; rho < 33; rho += NWAVES) { int tok = (t0_) - 1 + rho; tok = tok < 0 ? 0 : tok; \
        __builtin_amdgcn_global_load_lds((const unsigned*)(dsrc + (size_t)tok * IC), (LAS unsigned*)(lds + RK_RAW + rho * 1024), 16, 0, 0); } } while (0)
    RK_DMA(ch0 * RCH);
    if (tid < 448) MU_[tid] = p.in[I_MU][rk_piece_col(tid >> 3, h) + (tid & 7)];
    const int ntile = wid & 3, ttile = wid >> 2, fn = lane & 15, fk = lane >> 4;
    const int ncol = h * 64 + ntile * 16 + fn;
    bf16x8 bw[2], ba[2], bg[4];
    {
        const float* wup = p.in[I_WUP]; const float* aup = p.in[I_AUP]; const float* gup = p.in[I_GUP];
#pragma unroll
        for (int ks = 0; ks < 2; ++ks) { float t[8], u[8];
#pragma unroll
            for (int j = 0; j < 8; ++j) { const int k = 32 * ks + 8 * fk + j; t[j] = wup[k * RW + ncol]; u[j] = aup[k * RW + ncol]; }
            u32x4 a, c; a.x = cvtpk(t[0], t[1]); a.y = cvtpk(t[2], t[3]); a.z = cvtpk(t[4], t[5]); a.w = cvtpk(t[6], t[7]);
            c.x = cvtpk(u[0], u[1]); c.y = cvtpk(u[2], u[3]); c.z = cvtpk(u[4], u[5]); c.w = cvtpk(u[6], u[7]);
            bw[ks] = __builtin_bit_cast(bf16x8, a); ba[ks] = __builtin_bit_cast(bf16x8, c); }
#pragma unroll
        for (int ks = 0; ks < 4; ++ks) { float t[8];
#pragma unroll
            for (int j = 0; j < 8; ++j) { const int k = 32 * ks + 8 * fk + j; t[j] = gup[k * RW + ncol]; }
            u32x4 a; a.x = cvtpk(t[0], t[1]); a.y = cvtpk(t[2], t[3]); a.z = cvtpk(t[4], t[5]); a.w = cvtpk(t[6], t[7]);
            bg[ks] = __builtin_bit_cast(bf16x8, a); }
    }
    const float w0n = p.in[I_W0][ncol], a0n = p.in[I_A0][ncol];
    const int q16 = tid & 15, tk16 = tid >> 4;
    const f32x4 kkc = *(const f32x4*)(p.in[I_KK] + h * 64 + 4 * q16), kac = *(const f32x4*)(p.in[I_KA] + h * 64 + 4 * q16), rkc = *(const f32x4*)(p.in[I_RK] + h * 64 + 4 * q16);
    const size_t hb = (size_t)(b * 8 + h) * SEQ * 64;
    bf16_t* gVS = (bf16_t*)(p.ws + WS_VS) + hb; bf16_t* gGG = (bf16_t*)(p.out + (size_t)16 * 1024 * 1024) + hb; float* gBON = (float*)(p.ws + WS_BON) + (size_t)(b * 8 + h) * SEQ;
    unsigned char* gOPS = p.ws + WS_OPS + (size_t)(b * 8 + h) * (SEQ / RCH) * OPREC;
    for (int ch = ch0; ch < ch1; ++ch) {
        const int t0 = ch * RCH;
        if (ch > ch0) { if (wid == 0) asm volatile("s_waitcnt vmcnt(8)" ::: "memory"); else if (wid == 1) asm volatile("s_waitcnt vmcnt(7)" ::: "memory"); else asm volatile("s_waitcnt vmcnt(6)" ::: "memory"); } else asm volatile("s_waitcnt vmcnt(0)" ::: "memory");
        RK_BAR();
#pragma unroll
        for (int it = 0; it < 4; ++it) { const int item = tid + it * NTHREADS;
            if (item < RCH * 56) { const int tk = item / 56, pc = item - tk * 56;
                const u32x4 cv = *(const LAS u32x4*)(lds + RK_RAW + (tk + 1) * 1024 + pc * 16);
                u32x4 pv = *(const LAS u32x4*)(lds + RK_RAW + tk * 1024 + pc * 16);
                if (t0 + tk == 0) pv = (u32x4){0u, 0u, 0u, 0u};
                const f32x4 m0 = *(const LAS f32x4*)(MU_ + pc * 8), m1 = *(const LAS f32x4*)(MU_ + pc * 8 + 4);
                float xv[8];
#pragma unroll
                for (int j = 0; j < 4; ++j) { const unsigned cw = cv[j], pw = pv[j];
                    const float c0 = __uint_as_float(cw << 16), c1 = __uint_as_float(cw & 0xffff0000u), p0 = __uint_as_float(pw << 16), p1 = __uint_as_float(pw & 0xffff0000u);
                    const float ma = (j < 2) ? m0[2 * j] : m1[2 * j - 4], mb = (j < 2) ? m0[2 * j + 1] : m1[2 * j - 3];
                    xv[2 * j] = c0 + ma * (p0 - c0); xv[2 * j + 1] = c1 + mb * (p1 - c1); }
                const int seg = pc >> 3, pi = pc & 7;
                if (seg <= 2) { LAS float* dst = (seg == 0 ? R_ : (seg == 1 ? KM_ : VV_)) + tk * 64 + 8 * pi;
                    *(LAS f32x4*)dst = (f32x4){xv[0], xv[1], xv[2], xv[3]}; *(LAS f32x4*)(dst + 4) = (f32x4){xv[4], xv[5], xv[6], xv[7]}; }
                else if (seg == 3) { u32x4 w; w.x = cvtpk(tanh_fast(xv[0]), tanh_fast(xv[1])); w.y = cvtpk(tanh_fast(xv[2]), tanh_fast(xv[3])); w.z = cvtpk(tanh_fast(xv[4]), tanh_fast(xv[5])); w.w = cvtpk(tanh_fast(xv[6]), tanh_fast(xv[7]));
                    *(LAS u32x4*)(lds + RK_AW + tk * 144 + 16 * pi) = w; }
                else if (seg == 4) { u32x4 w; w.x = cvtpk(xv[0], xv[1]); w.y = cvtpk(xv[2], xv[3]); w.z = cvtpk(xv[4], xv[5]); w.w = cvtpk(xv[6], xv[7]);
                    *(LAS u32x4*)(lds + RK_AA + tk * 144 + 16 * pi) = w; }
                else { u32x4 w; w.x = cvtpk(sigmoidf_(xv[0]), sigmoidf_(xv[1])); w.y = cvtpk(sigmoidf_(xv[2]), sigmoidf_(xv[3])); w.z = cvtpk(sigmoidf_(xv[4]), sigmoidf_(xv[5])); w.w = cvtpk(sigmoidf_(xv[6]), sigmoidf_(xv[7]));
                    *(LAS u32x4*)(lds + RK_AG + tk * 272 + (pc - 40) * 16) = w; }
            } }
        __syncthreads();
        if (ch + 1 < ch1) RK_DMA(t0 + RCH);
        {
            f32x4 cw = (f32x4){0.f, 0.f, 0.f, 0.f}, ca = cw, cg2 = cw;
            const int tok = ttile * 16 + fn;
#pragma unroll
            for (int ks = 0; ks < 2; ++ks) {
                const bf16x8 aw = *(const LAS bf16x8*)(lds + RK_AW + tok * 144 + (32 * ks + 8 * fk) * 2);
                const bf16x8 aa = *(const LAS bf16x8*)(lds + RK_AA + tok * 144 + (32 * ks + 8 * fk) * 2);
                cw = __builtin_amdgcn_mfma_f32_16x16x32_bf16(aw, bw[ks], cw, 0, 0, 0);
                ca = __builtin_amdgcn_mfma_f32_16x16x32_bf16(aa, ba[ks], ca, 0, 0, 0);
            }
#pragma unroll
            for (int ks = 0; ks < 4; ++ks) {
                const bf16x8 ag = *(const LAS bf16x8*)(lds + RK_AG + tok * 272 + (32 * ks + 8 * fk) * 2);
                cg2 = __builtin_amdgcn_mfma_f32_16x16x32_bf16(ag, bg[ks], cg2, 0, 0, 0);
            }
#pragma unroll
            for (int r = 0; r < 4; ++r) { const int tk = ttile * 16 + 4 * fk + r, n = ntile * 16 + fn;
                DEC_[tk * 64 + n] = -0.6065306597126334f * sigmoidf_(cw[r] + w0n);
                BB_[tk * 64 + n] = sigmoidf_(ca[r] + a0n);
                GG_[tk * 64 + n] = cg2[r]; }
        }
        RK_BAR();
        {
            const f32x4 kp = *(const LAS f32x4*)(KM_ + tk16 * 64 + 4 * q16), av = *(const LAS f32x4*)(BB_ + tk16 * 64 + 4 * q16), rr = *(const LAS f32x4*)(R_ + tk16 * 64 + 4 * q16);
            const f32x4 kkv = kp * kkc;
            const float nrm2 = red16((kkv[0] * kkv[0] + kkv[1] * kkv[1]) + (kkv[2] * kkv[2] + kkv[3] * kkv[3]));
            const f32x4 kkn = kkv * __builtin_amdgcn_rsqf(fmaxf(nrm2, 1e-24f));
            const f32x4 kmod = kp * ((av - 1.0f) * kac + 1.0f);
            const f32x4 t = rr * kmod * rkc;
            const float bs = red16((t[0] + t[1]) + (t[2] + t[3]));
            *(LAS f32x4*)(KK_ + tk16 * 64 + 4 * q16) = kkn; *(LAS f32x4*)(BB_ + tk16 * 64 + 4 * q16) = kkn * av; *(LAS f32x4*)(KM_ + tk16 * 64 + 4 * q16) = kmod;
            if (q16 == 0) BON_[tk16] = bs;
        }
        RK_BAR();
        {
            const int d1 = tid & 63, q1 = wid;
            float lw[4], cs[4];
#pragma unroll
            for (int e = 0; e < 4; ++e) lw[e] = DEC_[(4 * q1 + e) * 64 + d1];
            cs[0] = lw[0]; cs[1] = cs[0] + lw[1]; cs[2] = cs[1] + lw[2]; cs[3] = cs[2] + lw[3];
            ((LAS float*)(lds + RK_LSEG))[q1 * 64 + d1] = cs[3];
            { const float x0 = VV_[(4 * q1) * 64 + d1], x1 = VV_[(4 * q1 + 1) * 64 + d1], x2 = VV_[(4 * q1 + 2) * 64 + d1], x3 = VV_[(4 * q1 + 3) * 64 + d1];
              u32x2 w; w.x = cvtpk(x0, x1); w.y = cvtpk(x2, x3); *(LAS u32x2*)(lds + RK_IM + OP_VT + d1 * 80 + q1 * 8) = w; }
            RK_BAR();
            float off = 0.f, tot = 0.f;
#pragma unroll
            for (int qq = 0; qq < 8; ++qq) { const float sg = ((const LAS float*)(lds + RK_LSEG))[qq * 64 + d1]; tot += sg; if (qq < q1) off += sg; }
            const float etot = __expf(tot);
            float ePprev = __expf(off);
            float bc[4], kc4[4];
#pragma unroll
            for (int e = 0; e < 4; ++e) { const int tk = 4 * q1 + e;
                const float eP = __expf(off + cs[e]), eN = __builtin_amdgcn_rcpf(eP), eE = etot * eN;
                const float kap = KK_[tk * 64 + d1], bet = BB_[tk * 64 + d1], kk_ = KM_[tk * 64 + d1], rr = R_[tk * 64 + d1];
                const unsigned w0 = cvtpk(-kap * ePprev, rr * eP), w1 = cvtpk(bet * eN, kk_ * eN);
                *(LAS unsigned short*)(lds + RK_IM + OP_AT + tk * 144 + d1 * 2) = (unsigned short)(w0 & 0xffffu); *(LAS unsigned short*)(lds + RK_IM + OP_RT + tk * 144 + d1 * 2) = (unsigned short)(w0 >> 16);
                *(LAS unsigned short*)(lds + RK_IM + OP_BH + tk * 144 + d1 * 2) = (unsigned short)(w1 & 0xffffu); *(LAS unsigned short*)(lds + RK_IM + OP_KH + tk * 144 + d1 * 2) = (unsigned short)(w1 >> 16);
                bc[e] = bet * eE; kc4[e] = kk_ * eE; ePprev = eP; }
            u32x2 wb, wk; wb.x = cvtpk(bc[0], bc[1]); wb.y = cvtpk(bc[2], bc[3]); wk.x = cvtpk(kc4[0], kc4[1]); wk.y = cvtpk(kc4[2], kc4[3]);
            *(LAS u32x2*)(lds + RK_IM + OP_BCT + d1 * 80 + q1 * 8) = wb; *(LAS u32x2*)(lds + RK_IM + OP_KCT + d1 * 80 + q1 * 8) = wk;
            if (q1 == 0) ((LAS float*)(lds + RK_IM + OP_P31))[d1] = etot;
        }
        RK_BAR();
        {
            unsigned char* rec = gOPS + (size_t)ch * OPREC;
#pragma unroll
            for (int i = 0; i < 5; ++i) { const int o = (tid + i * NTHREADS) * 16; if (o < OPREC) *(u32x4*)(rec + o) = *(const LAS u32x4*)(lds + RK_IM + o); }
            const size_t go = (size_t)t0 * 64 + tid * 4;
            { const f32x4 a = *(const LAS f32x4*)(VV_ + tid * 4), c = *(const LAS f32x4*)(GG_ + tid * 4);
              u32x2 wa, wc; wa.x = cvtpk(a[0], a[1]); wa.y = cvtpk(a[2], a[3]); wc.x = cvtpk(c[0], c[1]); wc.y = cvtpk(c[2], c[3]);
              *(u32x2*)(gVS + go) = wa; *(u32x2*)(gGG + go) = wc; }
            if (tid < RCH) gBON[t0 + tid] = BON_[tid];
        }
    }
    asm volatile("s_waitcnt vmcnt(0)" ::: "memory");
    __syncthreads();
#undef RK_DMA
}

constexpr int CS_IN = 32768;
constexpr int CS_OP = 2 * CS_IN;
constexpr int CS_AT = 0, CS_RT = 4608, CS_BH = 9216, CS_KH = 13824, CS_BCT = 18432, CS_KCT = 23552, CS_VT = 28672, CS_P31 = 31744;
constexpr int CS_MT2 = CS_OP, CS_MT3 = CS_OP + 2560, CS_MT4 = CS_OP + 5120;
constexpr int CS_M1F = CS_OP + 7680;
constexpr int CS_XF = CS_OP + 12288;
constexpr int CS_UB = CS_OP + 16896;
constexpr int CS_SB = CS_OP + 19456;
constexpr int CS_YY = CS_OP + 24064;
constexpr int CS_END = CS_OP + 28160;
static_assert(CS_END <= LDS_BYTES - 64, "rwkv scan LDS map");
__device__ __forceinline__ int crow32(int r, int hi) { return (r & 3) + 8 * (r >> 2) + 4 * hi; }
__device__ __forceinline__ void rwkv_scan(const Params& p, LAS unsigned char* lds, int b, int h, int half) {
    const int tid = opaque_tid(), lane = tid & 63, wid = __builtin_amdgcn_readfirstlane(tid >> 6), r32 = lane & 31, hi = lane >> 5;
    const unsigned char* gOPS = p.ws + WS_OPS + (size_t)(b * 8 + h) * (SEQ / RCH) * OPREC;
    bf16_t* yraw = (bf16_t*)p.out + (size_t)b * SEQ * RW + h * 64 + half * 32;
#define RS_DMA(ch_, buf) do { LAS unsigned char* bb_ = lds + (buf) * CS_IN; const unsigned char* rec_ = gOPS + (size_t)(ch_) * OPREC; \
        for (int pc = wid; pc < 32; pc += NWAVES) { \
            const unsigned char* src_ = rec_ + (pc < 28 ? pc * 1024 : (pc < 31 ? OP_VT + half * 2560 + (pc - 28) * 1024 : OP_P31)) + lane * 16; \
            __builtin_amdgcn_global_load_lds((const unsigned*)src_, (LAS unsigned*)(bb_ + pc * 1024), 16, 0, 0); } } while (0)
    RS_DMA(0, 0);
    for (int i = tid; i < 4608 / 4; i += NTHREADS) ((LAS unsigned*)(lds + CS_SB))[i] = 0u;
    f32x16 Sacc = f32x16{};
    f32x16 Xacc = f32x16{};
    for (int ch = 0; ch < SEQ / RCH; ++ch) {
        const int t0 = ch * RCH, cur = ch & 1;
        if (wid < 4 && ch > 0) asm volatile("s_waitcnt vmcnt(1)" ::: "memory"); else asm volatile("s_waitcnt vmcnt(0)" ::: "memory");
        RK_BAR();
        if (ch + 1 < SEQ / RCH) RS_DMA(ch + 1, cur ^ 1);
        const LAS unsigned char* ib = lds + cur * CS_IN;
        if (wid < 4) {
            const LAS unsigned char* Am = ib + ((wid & 1) ? CS_KH : CS_BH) + r32 * 144 + hi * 16;
            const LAS unsigned char* Bm = ib + ((wid & 2) ? CS_RT : CS_AT) + r32 * 144 + hi * 16;
            f32x16 acc = f32x16{};
#pragma unroll
            for (int ks = 0; ks < 4; ++ks) acc = __builtin_amdgcn_mfma_f32_32x32x16_bf16(*(const LAS bf16x8*)(Am + ks * 32), *(const LAS bf16x8*)(Bm + ks * 32), acc, 0, 0, 0);
            const int lim = (wid < 2) ? r32 : r32 + 1;
#pragma unroll
            for (int rg = 0; rg < 16; ++rg) if (crow32(rg, hi) >= lim) acc[rg] = 0.f;
            if (wid == 0) {
#pragma unroll
                for (int rg = 0; rg < 16; ++rg) ((LAS float*)(lds + CS_M1F))[crow32(rg, hi) * 36 + r32] = acc[rg];
            } else {
                LAS unsigned char* Mt = lds + (wid == 1 ? CS_MT2 : (wid == 2 ? CS_MT3 : CS_MT4)) + r32 * 80 + hi * 8;
#pragma unroll
                for (int g = 0; g < 4; ++g) { u32x2 w; w.x = cvtpk(acc[4 * g], acc[4 * g + 1]); w.y = cvtpk(acc[4 * g + 2], acc[4 * g + 3]); *(LAS u32x2*)(Mt + g * 16) = w; }
            }
        } else if (wid < 6) {
            const LAS unsigned char* Am = ib + (wid == 4 ? CS_AT : CS_RT) + r32 * 144 + hi * 16;
            const LAS unsigned char* Bm = lds + CS_SB + r32 * 144 + hi * 16;
            Xacc = f32x16{};
#pragma unroll
            for (int ks = 0; ks < 4; ++ks) Xacc = __builtin_amdgcn_mfma_f32_32x32x16_bf16(*(const LAS bf16x8*)(Am + ks * 32), *(const LAS bf16x8*)(Bm + ks * 32), Xacc, 0, 0, 0);
        }
        RK_BAR();
        if (wid == 4) {
            const LAS unsigned char* Am = lds + CS_MT2 + r32 * 80 + hi * 16;
            const LAS unsigned char* Bm = ib + CS_VT + r32 * 80 + hi * 16;
#pragma unroll
            for (int ks = 0; ks < 2; ++ks) Xacc = __builtin_amdgcn_mfma_f32_32x32x16_bf16(*(const LAS bf16x8*)(Am + ks * 32), *(const LAS bf16x8*)(Bm + ks * 32), Xacc, 0, 0, 0);
#pragma unroll
            for (int g = 0; g < 4; ++g) *(LAS f32x4*)(lds + CS_XF + r32 * 144 + (8 * g + 4 * hi) * 4) = (f32x4){Xacc[4 * g], Xacc[4 * g + 1], Xacc[4 * g + 2], Xacc[4 * g + 3]};
        }
        RK_BAR();
        {
            const int v = tid >> 4, l = tid & 15;
            float m0[32], m1[32];
#pragma unroll
            for (int c4 = 0; c4 < 8; ++c4) { const f32x4 a = *(const LAS f32x4*)(lds + CS_M1F + l * 144 + c4 * 16), c = *(const LAS f32x4*)(lds + CS_M1F + (l + 16) * 144 + c4 * 16);
                m0[4 * c4] = a[0]; m0[4 * c4 + 1] = a[1]; m0[4 * c4 + 2] = a[2]; m0[4 * c4 + 3] = a[3]; m1[4 * c4] = c[0]; m1[4 * c4 + 1] = c[1]; m1[4 * c4 + 2] = c[2]; m1[4 * c4 + 3] = c[3]; }
            const float x0 = ((const LAS float*)(lds + CS_XF))[v * 36 + l], x1 = ((const LAS float*)(lds + CS_XF))[v * 36 + l + 16];
            float u0 = 0.f, u1 = 0.f;
#pragma unroll
            for (int i = 0; i < 32; ++i) {
                const float part = (i < 16) ? u0 * m0[i] : (u0 * m0[i] + u1 * m1[i]);
                const float tot = red16(part);
                if (i < 16) u0 = (l == i) ? x0 + tot : u0; else u1 = (l == i - 16) ? x1 + tot : u1;
            }
            const unsigned w = cvtpk(u0, u1);
            *(LAS unsigned short*)(lds + CS_UB + v * 80 + l * 2) = (unsigned short)(w & 0xffffu); *(LAS unsigned short*)(lds + CS_UB + v * 80 + (l + 16) * 2) = (unsigned short)(w >> 16);
        }
        RK_BAR();
        if (wid == 5) {
            const LAS unsigned char* A3 = lds + CS_MT3 + r32 * 80 + hi * 16; const LAS unsigned char* A4 = lds + CS_MT4 + r32 * 80 + hi * 16;
            const LAS unsigned char* Bu = lds + CS_UB + r32 * 80 + hi * 16; const LAS unsigned char* Bv = ib + CS_VT + r32 * 80 + hi * 16;
#pragma unroll
            for (int ks = 0; ks < 2; ++ks) { Xacc = __builtin_amdgcn_mfma_f32_32x32x16_bf16(*(const LAS bf16x8*)(A3 + ks * 32), *(const LAS bf16x8*)(Bu + ks * 32), Xacc, 0, 0, 0);
                Xacc = __builtin_amdgcn_mfma_f32_32x32x16_bf16(*(const LAS bf16x8*)(A4 + ks * 32), *(const LAS bf16x8*)(Bv + ks * 32), Xacc, 0, 0, 0); }
#pragma unroll
            for (int rg = 0; rg < 16; ++rg) ((LAS float*)(lds + CS_YY))[crow32(rg, hi) * 32 + r32] = Xacc[rg];
        } else if (wid < 2) {
#pragma unroll
            for (int g = 0; g < 4; ++g) { const f32x4 pv = *(const LAS f32x4*)(ib + CS_P31 + (32 * wid + 8 * g + 4 * hi) * 4);
                Sacc[4 * g] *= pv[0]; Sacc[4 * g + 1] *= pv[1]; Sacc[4 * g + 2] *= pv[2]; Sacc[4 * g + 3] *= pv[3]; }
            const LAS unsigned char* Ab = ib + CS_BCT + (32 * wid + r32) * 80 + hi * 16; const LAS unsigned char* Ak = ib + CS_KCT + (32 * wid + r32) * 80 + hi * 16;
            const LAS unsigned char* Bu = lds + CS_UB + r32 * 80 + hi * 16; const LAS unsigned char* Bv = ib + CS_VT + r32 * 80 + hi * 16;
#pragma unroll
            for (int ks = 0; ks < 2; ++ks) { Sacc = __builtin_amdgcn_mfma_f32_32x32x16_bf16(*(const LAS bf16x8*)(Ab + ks * 32), *(const LAS bf16x8*)(Bu + ks * 32), Sacc, 0, 0, 0);
                Sacc = __builtin_amdgcn_mfma_f32_32x32x16_bf16(*(const LAS bf16x8*)(Ak + ks * 32), *(const LAS bf16x8*)(Bv + ks * 32), Sacc, 0, 0, 0); }
#pragma unroll
            for (int g = 0; g < 4; ++g) { u32x2 w; w.x = cvtpk(Sacc[4 * g], Sacc[4 * g + 1]); w.y = cvtpk(Sacc[4 * g + 2], Sacc[4 * g + 3]); *(LAS u32x2*)(lds + CS_SB + r32 * 144 + (32 * wid + 8 * g + 4 * hi) * 2) = w; }
        }
        RK_BAR();
        if (tid < 256) { const int tk = tid >> 3, sub = tid & 7; const f32x4 yv = *(const LAS f32x4*)(lds + CS_YY + tk * 128 + sub * 16);
            u32x2 w; w.x = cvtpk(yv[0], yv[1]); w.y = cvtpk(yv[2], yv[3]); *(u32x2*)(yraw + (size_t)(t0 + tk) * RW + sub * 4) = w; }
    }
    asm volatile("s_waitcnt vmcnt(0)" ::: "memory");
    __syncthreads();
#undef RS_DMA
}
__device__ __forceinline__ void rwkv_finalize(const Params& p, int G) {
    const int tid = opaque_tid(), q16 = tid & 15;
    const bf16_t* yraw = (const bf16_t*)p.out; const bf16_t* gGG = (const bf16_t*)(p.out + (size_t)16 * 1024 * 1024); const bf16_t* gVS = (const bf16_t*)(p.ws + WS_VS); const float* gBON = (const float*)(p.ws + WS_BON);
    bf16_t* ymix = (bf16_t*)(p.ws + WS_YMIX);
    for (int item = (int)blockIdx.x * (NTHREADS / 16) + (tid >> 4); item < T * 8; item += G * (NTHREADS / 16)) {
        const int tok = item >> 3, h = item & 7, b = tok / SEQ, t = tok - b * SEQ;
        const u32x2 yw = *(const u32x2*)(yraw + (size_t)tok * RW + h * 64 + 4 * q16);
        const f32x4 y = (f32x4){__uint_as_float(yw.x << 16), __uint_as_float(yw.x & 0xffff0000u), __uint_as_float(yw.y << 16), __uint_as_float(yw.y & 0xffff0000u)};
        const size_t ho = ((size_t)(b * 8 + h) * SEQ + t) * 64 + 4 * q16;
        const u32x2 vw = *(const u32x2*)(gVS + ho), gw2 = *(const u32x2*)(gGG + ho);
        const f32x4 vv = (f32x4){__uint_as_float(vw.x << 16), __uint_as_float(vw.x & 0xffff0000u), __uint_as_float(vw.y << 16), __uint_as_float(vw.y & 0xffff0000u)};
        const f32x4 gg = (f32x4){__uint_as_float(gw2.x << 16), __uint_as_float(gw2.x & 0xffff0000u), __uint_as_float(gw2.y << 16), __uint_as_float(gw2.y & 0xffff0000u)};
        const float bon = gBON[(size_t)(b * 8 + h) * SEQ + t];
        const f32x4 gng = *(const f32x4*)(p.in[I_GNG] + h * 64 + 4 * q16), gnb = *(const f32x4*)(p.in[I_GNB] + h * 64 + 4 * q16);
        const float mean = red16((y[0] + y[1]) + (y[2] + y[3])) * (1.0f / 64.0f);
        const f32x4 dl = y - mean;
        const float var = red16((dl[0] * dl[0] + dl[1] * dl[1]) + (dl[2] * dl[2] + dl[3] * dl[3])) * (1.0f / 64.0f);
        const f32x4 yn = dl * __builtin_amdgcn_rsqf(var + GN_EPS) * gng + gnb;
        const f32x4 ov = (yn + vv * bon) * gg;
        u32x2 w; w.x = cvtpk(ov[0], ov[1]); w.y = cvtpk(ov[2], ov[3]);
        *(u32x2*)(ymix + (size_t)tok * D + h * 64 + 4 * q16) = w;
    }
}
#undef RK_BAR

constexpr int RT_X = 0;
constexpr int RT_LG = 131584;
constexpr int RT_GS = RT_LG + 16896;
constexpr int RT_RS = RT_GS + 8192;
constexpr int RT_HIST = RT_RS + 512;
constexpr int RT_CE = RT_HIST + 128;
static_assert(RT_CE + 1024 <= LDS_BYTES - 64, "router LDS map");
__device__ __forceinline__ int rt_swz(int k) { const int g = k >> 2; return ((g ^ ((g >> 4) & 3)) << 2) | (k & 3); }
__device__ __forceinline__ void phase_router(const Params& p, LAS unsigned char* lds, int G) {
    const int tid = opaque_tid(), lane = tid & 63, wave = __builtin_amdgcn_readfirstlane(tid >> 6);
    LAS float* xt = (LAS float*)(lds + RT_X); LAS float* lg = (LAS float*)(lds + RT_LG); LAS float* gs = (LAS float*)(lds + RT_GS); LAS float* shl = gs + 1024;
    LAS float* rsl = (LAS float*)(lds + RT_RS); LAS int* hist = (LAS int*)(lds + RT_HIST); LAS float* cew = (LAS float*)(lds + RT_CE);
    const float* rw = p.in[I_RTW];
    const float* x1 = p.out; const float* gain = p.in[I_N2G]; const float* mod = (const float*)(p.ws + WS_MOD); const float* rb = p.in[I_RTB];
    unsigned char* h2q = p.ws + WS_H;
    int* ridx = (int*)(p.ws + WS_ROUTE); float* rwt = (float*)(p.ws + WS_ROUTE + 512 * 1024);
    int* blockcnt = (int*)(p.ws + WS_CTL + 4096);
    const int TPB = T / G;
    const int blk = blockIdx.x, tok0 = blk * TPB, b = tok0 / SEQ;
    for (int k = tid; k < 1024; k += NTHREADS) { gs[rt_swz(k)] = gain[k] * (1.0f + mod[b * 6144 + 4096 + k]); shl[rt_swz(k)] = mod[b * 6144 + 3072 + k]; }
    if (tid < 32) hist[tid] = 0;
    __syncthreads();
    const int j = lane & 31, hh = lane >> 5, kb = 128 * wave + 64 * hh;
    float breg[64];
    { float cpart = 0.f;
#pragma unroll
        for (int s_ = 0; s_ < 64; ++s_) { const float w = rw[(size_t)(kb + s_) * 32 + j]; cpart += shl[rt_swz(kb + s_)] * w; breg[s_] = w * gs[rt_swz(kb + s_)]; }
        cpart += __shfl_xor(cpart, 32);
        if (lane < 32) cew[wave * 32 + lane] = cpart; }
    const int xsw = (2 * wave + hh) & 3;
    for (int t0 = 0; t0 < TPB; t0 += 128) {
        f32x4 v[16];
#define RT_LOAD(tl_) do { _Pragma("unroll") for (int q = 0; q < 4; ++q) { const int tq = t0 + 32 * (tl_) + 4 * wave + q; const f32x4* xr = (const f32x4*)(x1 + (size_t)(tok0 + (tq < TPB ? tq : 0)) * D) + lane; \
            _Pragma("unroll") for (int jj = 0; jj < 4; ++jj) v[4 * q + jj] = xr[64 * jj]; } } while (0)
        RT_LOAD(0);
#pragma unroll
        for (int tl = 0; tl < 4; ++tl) {
#pragma unroll
            for (int q = 0; q < 4; ++q) { float s = 0.f;
#pragma unroll
                for (int jj = 0; jj < 4; ++jj) { const f32x4 t = v[4 * q + jj]; s += (t[0] * t[0] + t[1] * t[1]) + (t[2] * t[2] + t[3] * t[3]); }
                const float rstd = rsqrtf(wave_sum(s) * (1.0f / D) + NORM_EPS);
                if (lane == 0) rsl[32 * tl + 4 * wave + q] = rstd;
#pragma unroll
                for (int jj = 0; jj < 4; ++jj) { const int g = lane + 64 * jj; *(LAS f32x4*)(xt + (4 * wave + q) * 1028 + 4 * (g ^ ((g >> 4) & 3))) = v[4 * q + jj]; } }
            __syncthreads();
            if (tl < 3) RT_LOAD(tl + 1);
            f32x16 acc = f32x16{};
            { const LAS float* arow = xt + (lane & 31) * 1028 + kb;
#pragma unroll
                for (int c = 0; c < 16; ++c) { const f32x4 a4 = *(const LAS f32x4*)(arow + 4 * (c ^ xsw));
                    acc = __builtin_amdgcn_mfma_f32_32x32x2f32(a4[0], breg[4 * c + 0], acc, 0, 0, 0);
                    acc = __builtin_amdgcn_mfma_f32_32x32x2f32(a4[1], breg[4 * c + 1], acc, 0, 0, 0);
                    acc = __builtin_amdgcn_mfma_f32_32x32x2f32(a4[2], breg[4 * c + 2], acc, 0, 0, 0);
                    acc = __builtin_amdgcn_mfma_f32_32x32x2f32(a4[3], breg[4 * c + 3], acc, 0, 0, 0); } }
            { const int hsw = (lane >> 2) & 3;
#pragma unroll
                for (int q = 0; q < 4; ++q) { const int tq = t0 + 32 * tl + 4 * wave + q; const float rstd = rsl[32 * tl + 4 * wave + q]; u32x4 o;
#pragma unroll
                    for (int u = 0; u < 4; ++u) { const int go = 4 * ((4 * lane + u) ^ hsw);
                        const f32x4 xv = *(const LAS f32x4*)(xt + (4 * wave + q) * 1028 + go), g4 = *(const LAS f32x4*)(gs + go), s4 = *(const LAS f32x4*)(shl + go);
                        const f32x4 y = (xv * rstd) * g4 + s4;
                        o[u] = cvt4_fp8(Q_H2 * y[0], Q_H2 * y[1], Q_H2 * y[2], Q_H2 * y[3]); }
                    if (tq < TPB) *(u32x4*)(h2q + (size_t)(tok0 + tq) * D + 16 * lane) = o; } }
            __syncthreads();
            { LAS float* part = (LAS float*)(lds + RT_X);
#pragma unroll
                for (int r = 0; r < 16; ++r) part[wave * 1024 + r * 64 + lane] = acc[r];
                __syncthreads();
                const int e = tid & 31; float ce = rb[e];
#pragma unroll
                for (int w = 0; w < 8; ++w) ce += cew[w * 32 + e];
#pragma unroll
                for (int q = 0; q < 2; ++q) { const int idx = tid + 512 * q; float sum = 0.f;
#pragma unroll
                    for (int w = 0; w < 8; ++w) sum += part[w * 1024 + idx];
                    const int r = idx >> 6, tk = 32 * tl + (r & 3) + 8 * (r >> 2) + 4 * ((idx >> 5) & 1);
                    lg[tk * 33 + e] = rsl[tk] * sum + ce; }
                __syncthreads(); }
        }
#undef RT_LOAD
        if (tid < 128 && t0 + tid < TPB) {
            const int row = tok0 + t0 + tid; const LAS float* lr = lg + tid * 33;
            float v0 = -INFINITY, v1 = -INFINITY, v2 = -INFINITY, v3 = -INFINITY; int i0 = 0, i1 = 0, i2 = 0, i3 = 0;
#pragma unroll
            for (int e = 0; e < 32; ++e) { const float x = lr[e];
                if (x > v0) { v3 = v2; i3 = i2; v2 = v1; i2 = i1; v1 = v0; i1 = i0; v0 = x; i0 = e; }
                else if (x > v1) { v3 = v2; i3 = i2; v2 = v1; i2 = i1; v1 = x; i1 = e; }
                else if (x > v2) { v3 = v2; i3 = i2; v2 = x; i2 = e; }
                else if (x > v3) { v3 = x; i3 = e; } }
            const float e1 = __expf(v1 - v0), e2 = __expf(v2 - v0), e3 = __expf(v3 - v0); const float inv = 1.0f / (1.0f + e1 + e2 + e3);
            *(int4*)(ridx + (size_t)row * 4) = make_int4(i0, i1, i2, i3); *(float4*)(rwt + (size_t)row * 4) = make_float4(inv, e1 * inv, e2 * inv, e3 * inv);
            atomicAdd((int*)&hist[i0], 1); atomicAdd((int*)&hist[i1], 1); atomicAdd((int*)&hist[i2], 1); atomicAdd((int*)&hist[i3], 1);
        }
        __syncthreads();
    }
    if (tid < 32) blockcnt[blk * 32 + tid] = hist[tid];
    __syncthreads();
}

__device__ __forceinline__ void phase_assign(const Params& p, LAS unsigned char* lds, int G) {
    const int tid = opaque_tid(), lane = tid & 63, wave = tid >> 6;
    LAS int* part = (LAS int*)lds;
    LAS int* partb = part + 512;
    LAS int* total = partb + 512;
    LAS int* base = total + 32;
    LAS int* segst = base + 32;
    LAS int* cursor = segst + 32;
    LAS int* slotl = cursor + 32;
    const int* blockcnt = (const int*)(p.ws + WS_CTL + 4096);
    const int* ridx = (const int*)(p.ws + WS_ROUTE); int* rslot = (int*)(p.ws + WS_ROUTE + 1024 * 1024); int* tokmap = (int*)(p.ws + WS_ROUTE + 2 * 1024 * 1024);
    const bf16_t* h2 = (const bf16_t*)(p.ws + WS_H); bf16_t* xs = (bf16_t*)(p.ws + WS_PROJ);
    int* tile = (int*)(p.ws + WS_TILE);
    const int TPB = T / G; const int blk = blockIdx.x;
    { const int e = tid & 31, part_i = tid >> 5; int st = 0, sb = 0;
        for (int bb = part_i; bb < G; bb += 16) { const int c = blockcnt[bb * 32 + e]; st += c; if (bb < blk) sb += c; }
        part[part_i * 32 + e] = st; partb[part_i * 32 + e] = sb; }
    __syncthreads();
    if (tid < 32) { int st = 0, sb = 0;
#pragma unroll
        for (int i = 0; i < 16; ++i) { st += part[i * 32 + tid]; sb += partb[i * 32 + tid]; }
        total[tid] = st; base[tid] = sb; cursor[tid] = 0; }
    __syncthreads();
    if (tid == 0) { int acc = 0; for (int e = 0; e < 32; ++e) { segst[e] = acc; acc += (total[e] + 255) & ~255; }
        if (blk == 0) { int pm = 0; for (int e = 0; e < 32; ++e) { const int nt = (total[e] + 255) >> 8; for (int i = 0; i < nt; ++i) tile[16 + pm + i] = e; pm += nt; } tile[0] = pm; } }
    __syncthreads();
    if (tid < 32) base[tid] += segst[tid];
    __syncthreads();
    for (int a = tid; a < TPB * 4; a += NTHREADS) { const int tok = blk * TPB + (a >> 2); const int e = ridx[(size_t)tok * 4 + (a & 3)];
        const int rank = atomicAdd((int*)&cursor[e], 1); const int slot = base[e] + rank; rslot[(size_t)tok * 4 + (a & 3)] = slot; tokmap[slot] = tok; }
    for (int e = blk; e < 32; e += G) { const int s0 = segst[e] + total[e], s1 = segst[e] + ((total[e] + 255) & ~255);
        for (int r = s0 + tid; r < s1; r += NTHREADS) tokmap[r] = 0; }
}

__device__ __forceinline__ void phase_final(const Params& p, int G, int stage) {
    const int tid = opaque_tid(), lane = tid & 63, wave = tid >> 6;
    const int gw = (int)blockIdx.x * NWAVES + wave, NGW = G * NWAVES;
    const float* fg = p.in[I_FG]; const float* mod = (const float*)(p.ws + WS_MOD);
    const int* rslot = (const int*)(p.ws + WS_ROUTE + 1024 * 1024); const float* rwt = (const float*)(p.ws + WS_ROUTE + 512 * 1024);
    const bf16_t* Y = (const bf16_t*)(p.ws + WS_PROJ);
    const float* src = (stage >= 4) ? p.out : p.in[I_X];
    for (int row = gw; row < T; row += NGW) {
        const int b = row / SEQ;
        const f32x4* xr = (const f32x4*)(src + (size_t)row * D) + lane;
        f32x4 v[4];
#pragma unroll
        for (int j = 0; j < 4; ++j) v[j] = xr[64 * j];
        if (stage >= 9) {
            const int4 sl = *(const int4*)(rslot + (size_t)row * 4); const float4 wt = *(const float4*)(rwt + (size_t)row * 4);
            const float* g2 = mod + b * 6144 + 5120;
            const int sls[4] = {sl.x, sl.y, sl.z, sl.w}; const float wts[4] = {wt.x, wt.y, wt.z, wt.w};
#pragma unroll
            for (int j = 0; j < 4; ++j) { f32x4 m = (f32x4){0.f, 0.f, 0.f, 0.f};
#pragma unroll
                for (int k = 0; k < 4; ++k) { const u32x2 yv = *((const u32x2*)(Y + (size_t)sls[k] * D) + lane + 64 * j);
                    m[0] += wts[k] * __uint_as_float(yv.x << 16); m[1] += wts[k] * __uint_as_float(yv.x & 0xffff0000u); m[2] += wts[k] * __uint_as_float(yv.y << 16); m[3] += wts[k] * __uint_as_float(yv.y & 0xffff0000u); }
                const f32x4 g = *(const f32x4*)(g2 + 4 * lane + 256 * j); v[j] = v[j] + g * m; }
        }
        float s = 0.f;
#pragma unroll
        for (int j = 0; j < 4; ++j) s += (v[j][0] * v[j][0] + v[j][1] * v[j][1]) + (v[j][2] * v[j][2] + v[j][3] * v[j][3]);
        const float rstd = rsqrtf(wave_sum(s) * (1.0f / D) + NORM_EPS);
        f32x4* orow = (f32x4*)(p.out + (size_t)row * D) + lane;
#pragma unroll
        for (int j = 0; j < 4; ++j) { const f32x4 g = *(const f32x4*)(fg + 4 * lane + 256 * j); orow[64 * j] = v[j] * rstd * g; }
    }
}


#define XB_TMO      128
#define XB_XCNT(j)  (256  + 64 * (j))
#define XB_XSUB(j)  (1280 + 64 * (j))
#define XB_XGEN(j)  (2304 + 64 * (j))
#define XB_TOP      3328
#define XB_TOPGEN   3392
#define XCD_BAR_WORDS 3456
#define XB_SPIN_CAP (1u << 22)
__device__ __forceinline__ unsigned xb_ld(unsigned* p)              { return __hip_atomic_load(p, __ATOMIC_RELAXED, __HIP_MEMORY_SCOPE_AGENT); }
__device__ __forceinline__ unsigned xb_add(unsigned* p, unsigned v) { return __hip_atomic_fetch_add(p, v, __ATOMIC_RELAXED, __HIP_MEMORY_SCOPE_AGENT); }
__device__ __forceinline__ unsigned xb_xcc_id() { return (unsigned)__builtin_amdgcn_s_getreg((3 << 11) | 20) & 0xFu; }
#define XB_SPIN(cond, bar) do { unsigned _sp = 0; while (cond) { __builtin_amdgcn_s_sleep(1); \
    if ((++_sp & 255u) == 0u) { if (xb_ld(&(bar)[XB_TMO])) break; if (_sp > XB_SPIN_CAP) { atomicAdd(&(bar)[XB_TMO], 1u); break; } } } } while (0)
struct XcdBarrier { unsigned* bar; unsigned x; volatile LAS unsigned* st; };
__device__ __forceinline__ XcdBarrier xcd_barrier_post(unsigned* bar, volatile LAS unsigned* st) {
    XcdBarrier b; b.bar = bar; b.x = xb_xcc_id(); b.st = st;
    if (threadIdx.x == 0) (void)xb_add(&bar[XB_XCNT(b.x)], 1u);
    return b;
}
__device__ __forceinline__ void xcd_barrier_complete(unsigned* bar, unsigned x, unsigned& nloc, unsigned& nx) {
    const unsigned G = gridDim.x * gridDim.y * gridDim.z;
    unsigned sum, cnt, mine, sp = 0u;
    for (;;) {
        sum = 0u; cnt = 0u; mine = 0u;
#pragma unroll
        for (unsigned j = 0; j < 16; ++j) { const unsigned c = xb_ld(&bar[XB_XCNT(j)]); sum += c; cnt += (c > 0u) ? 1u : 0u; mine = (j == x) ? c : mine; }
        if (sum == G) break;
        __builtin_amdgcn_s_sleep(1);
        if ((++sp & 255u) == 0u) { if (xb_ld(&bar[XB_TMO])) break; if (sp > XB_SPIN_CAP) { atomicAdd(&bar[XB_TMO], 1u); break; } }
    }
    nloc = mine > 0u ? mine : 1u; nx = cnt > 0u ? cnt : 1u;
}
__device__ __forceinline__ void xcd_barrier(const XcdBarrier& b) {
    asm volatile("s_waitcnt vmcnt(0)" ::: "memory");
    __syncthreads();
    if (threadIdx.x == 0) {
        unsigned* bar = b.bar;
        __builtin_amdgcn_s_waitcnt(0);
        unsigned nloc = b.st[0], nx = b.st[1];
        if (nloc == 0u) { xcd_barrier_complete(bar, b.x, nloc, nx); b.st[0] = nloc; b.st[1] = nx; }
        const unsigned old = xb_add(&bar[XB_XSUB(b.x)], 1u);
        const unsigned gen = old / nloc;
        if (old + 1u == (gen + 1u) * nloc) {
            __builtin_amdgcn_fence(__ATOMIC_RELEASE, "agent");
            asm volatile("s_waitcnt vmcnt(0)" ::: "memory");
            const unsigned og = xb_add(&bar[XB_TOP], 1u);
            const unsigned tg = og / nx;
            if (og + 1u == (tg + 1u) * nx) xb_add(&bar[XB_TOPGEN], 1u);
            else XB_SPIN(xb_ld(&bar[XB_TOPGEN]) == tg, bar);
            __builtin_amdgcn_fence(__ATOMIC_ACQUIRE, "agent");
            xb_add(&bar[XB_XGEN(b.x)], 1u);
            asm volatile("s_waitcnt vmcnt(0)" ::: "memory");
        } else {
            XB_SPIN(xb_ld(&bar[XB_XGEN(b.x)]) == gen, bar);
            __builtin_amdgcn_fence(__ATOMIC_ACQUIRE, "agent");
            asm volatile("s_waitcnt vmcnt(0)" ::: "memory");
        }
    }
    __syncthreads();
}

__device__ __forceinline__ const Params* launder_params(const Params* q) { asm volatile("" : "+s"(q)); return q; }
__global__ void __launch_bounds__(NTHREADS, 2) hymba_fwd(Params p) {
    extern __shared__ __attribute__((aligned(16))) unsigned char lds_raw[];
    cg::grid_group grid = cg::this_grid();
    LAS unsigned char* lds = (LAS unsigned char*)lds_raw;
    const int G = gridDim.x, tid = threadIdx.x;
    constexpr int STAGE = DBG_STAGE;
    volatile LAS unsigned* xst = (volatile LAS unsigned*)(lds + LDS_BYTES - 64);
    if (tid == 0) { xst[0] = 0u; xst[1] = 0u; }
    __syncthreads();
    const XcdBarrier xbar = xcd_barrier_post((unsigned*)(p.ws + WS_CTL + 40960), xst);
#define GRID_BAR() xcd_barrier(xbar)

    phase_mod(p, lds_raw, G);
    if (G == 0x7fffffff) grid.sync();
    GRID_BAR();
    if (STAGE >= 2) { phase_norm1(p, G); phase_convert(p, lds_raw, G, 0); GRID_BAR(); }
    if (STAGE >= 2) {
        pg8::Gemm g{(const bf16_t*)(p.ws + WS_H), (const bf16_t*)(p.ws + WS_WIN_T), D, nullptr};
        pg8::DenseSched S; S.o.init(T / 256, IC / 256, G, (int)blockIdx.x);
        EpiInProj E{(bf16_t*)(p.ws + WS_PROJ)};
        pg8::gemm_phase<false, false>(lds, g, S, E);
        GRID_BAR();
    }
    if (STAGE >= 3) {
        kmax_pass(p, G);
        for (int it = blockIdx.x; it < NB * 8 * 4; it += G) rwkv_prep(p, lds, it >> 5, (it >> 2) & 7, (it & 3) * 32, (it & 3) * 32 + 32);
        GRID_BAR();
    }
    if (STAGE >= 2) {
        if (STAGE >= 3) { for (int u = blockIdx.x; u < NB * 8 * 2; u += G) rwkv_scan(p, lds, u >> 4, (u >> 1) & 7, u & 1); }
        else {
            bf16_t* ymix = (bf16_t*)(p.ws + WS_YMIX);
            for (size_t i = (size_t)blockIdx.x * NTHREADS + tid; i < (size_t)T * 64; i += (size_t)G * NTHREADS) { const size_t row = i >> 6, c = i & 63; *(u32x4*)(ymix + row * D + c * 8) = (u32x4){0u, 0u, 0u, 0u}; }
        }
        float lam;
        { const float* q1 = p.in[I_LQ1]; const float* k1 = p.in[I_LK1]; const float* q2 = p.in[I_LQ2]; const float* k2 = p.in[I_LK2]; float s1 = 0.f, s2 = 0.f;
            for (int i = 0; i < 64; ++i) { s1 += q1[i] * k1[i]; s2 += q2[i] * k2[i]; } lam = expf(s1) - expf(s2) + LAMBDA_INIT; }
        unsigned* qhead = (unsigned*)(p.ws + WS_CTL);
        LAS unsigned* ubox = (LAS unsigned*)(lds + 4 * ATT_BUF);
        for (;;) {
            __syncthreads();
            if (tid == 0) ubox[0] = atomicAdd(qhead, 1u);
            __syncthreads();
            const unsigned u = (unsigned)__builtin_amdgcn_readfirstlane((int)ubox[0]);
            if (u >= (unsigned)ATT_UNITS) break;
            attn_unit(p, lds, (int)(u & 31u) >> 2, (int)(u & 3u), ATT_NQB - 1 - (int)(u >> 5), lam);
        }
        GRID_BAR();
        if (STAGE >= 3) { rwkv_finalize(p, G); GRID_BAR(); }
    }
    if (STAGE >= 2) {
        pg8::Gemm g{(const bf16_t*)(p.ws + WS_YMIX), (const bf16_t*)(p.ws + WS_WOUT_T), D, nullptr};
        pg8::DenseSched S; S.o.init(T / 256, D / 256, G, (int)blockIdx.x);
        EpiOutProj E{p.in[I_X], (const float*)(p.ws + WS_MOD), p.out};
        pg8::gemm_phase<false, false>(lds, g, S, E);
        GRID_BAR();
    }
    if (STAGE >= 9) {
        phase_router(p, lds, G);
        GRID_BAR();
        phase_assign(p, lds, G);
        __syncthreads();
        phase_convert(p, lds_raw, G, 1);
        GRID_BAR();
        const int* tile = (const int*)(p.ws + WS_TILE);
        const int MT = tile[0];
        {
            pg8::Gemm g{(const bf16_t*)(p.ws + WS_H), (const bf16_t*)(p.ws + WS_WG_T), D / 2, (const int*)(p.ws + WS_ROUTE + 2 * 1024 * 1024)};
            pg8::MoeSched S; S.o.init(MT, 8, G, (int)blockIdx.x); S.tile_e = tile + 16; S.N = 2048;
            EpiMoe1 E{p.in[I_BGU], p.ws + WS_ACT};
            pg8::gemm_phase<true, true>(lds, g, S, E);
        }
        GRID_BAR();
        {
            pg8::Gemm g{(const bf16_t*)(p.ws + WS_ACT), (const bf16_t*)(p.ws + WS_WD_T), D / 2, nullptr};
            pg8::MoeSched S; S.o.init(MT, 4, G, (int)blockIdx.x); S.tile_e = tile + 16; S.N = 1024;
            EpiMoe2 E{p.in[I_BDN], (bf16_t*)(p.ws + WS_PROJ)};
            pg8::gemm_phase<false, true>(lds, g, S, E);
        }
        GRID_BAR();
    }
    phase_final(p, G, STAGE >= 9 ? 9 : (STAGE >= 2 ? 4 : 0));
}

extern "C" void kernel_launch(void* const* d_in, const int* in_sizes, int n_in, void* d_out, int out_size, void* d_ws, size_t ws_size, hipStream_t stream) {
    static int grid = 0;
    if (grid == 0) {
        if (n_in != 31 || out_size != T * D || ws_size < WS_END) { fprintf(stderr, "kernel_launch: unexpected shapes (n_in %d out %d ws %zu)\n", n_in, out_size, ws_size); grid = -1; return; }
        int dev = 0, cus = 0, per_cu = 0;
        hipGetDevice(&dev);
        hipDeviceGetAttribute(&cus, hipDeviceAttributeMultiprocessorCount, dev);
        hipFuncSetAttribute((const void*)hymba_fwd, hipFuncAttributeMaxDynamicSharedMemorySize, LDS_BYTES);
        hipOccupancyMaxActiveBlocksPerMultiprocessor(&per_cu, (const void*)hymba_fwd, NTHREADS, LDS_BYTES);
        if (per_cu < 1) { fprintf(stderr, "kernel_launch: occupancy query returned %d\n", per_cu); grid = -1; return; }
        grid = cus;
        if (grid > 256) grid = 256;
        while (T % grid != 0) --grid;
        (void)hipGetLastError();
    }
    if (grid < 0) return;
    hipMemsetAsync((char*)d_ws + WS_CTL, 0, CTL_BYTES, stream);
    Params p{};
    for (int i = 0; i < 31; ++i) p.in[i] = (const float*)d_in[i];
    p.out = (float*)d_out; p.ws = (unsigned char*)d_ws;
    void* args[] = {&p};
    hipError_t e = hipLaunchCooperativeKernel((const void*)hymba_fwd, dim3(grid), dim3(NTHREADS), args, LDS_BYTES, stream);
    if (e != hipSuccess) fprintf(stderr, "cooperative launch failed: %s (grid %d)\n", hipGetErrorString(e), grid);
}
```

```cpp
#include <hip/hip_runtime.h>
#include <hip/hip_cooperative_groups.h>
#include <cstdio>
#include <cstdint>
namespace cg = cooperative_groups;

#ifndef DBG_STAGE
#define DBG_STAGE 99
#endif

#define LAS __attribute__((address_space(3)))
typedef unsigned short bf16_t;
typedef short bf16x8 __attribute__((ext_vector_type(8)));
typedef short s16x4 __attribute__((ext_vector_type(4)));
typedef float f32x4 __attribute__((ext_vector_type(4)));
typedef float f32x16 __attribute__((ext_vector_type(16)));
typedef float f32x2_t __attribute__((ext_vector_type(2)));
typedef __bf16 bf16x2_t __attribute__((ext_vector_type(2)));
typedef unsigned u32x4 __attribute__((ext_vector_type(4)));
typedef unsigned u32x2 __attribute__((ext_vector_type(2)));

constexpr int D = 1024, NB = 8, SEQ = 4096, T = NB * SEQ;
constexpr int RW = 512, RC = 1792, DC = 1536, IC = 3328;
constexpr int NE = 32, TOPK = 4, NA = T * TOPK;
constexpr int PMAX = NA + NE * 256;
constexpr float NORM_EPS = 1e-5f, GN_EPS = 64e-5f;
constexpr float LOG2E = 1.4426950408889634f;
constexpr float QSCALE = 0.125f * LOG2E;
constexpr float LAMBDA_INIT = 0.2f;
constexpr int NTHREADS = 512, NWAVES = 8;
constexpr int LDS_BYTES = 163840;

constexpr size_t MiB = 1u << 20;
constexpr size_t WS_CTL = 0;
constexpr size_t CTL_BYTES = 65536;
constexpr size_t WS_MOD = 1 * MiB;
constexpr size_t WS_TILE = 1 * MiB + 512 * 1024;
constexpr size_t WS_WIN_T = 2 * MiB;
constexpr size_t WS_WOUT_T = 9 * MiB;
constexpr size_t WS_ROUTE = 11 * MiB;
constexpr size_t WS_WG_T = 16 * MiB;
constexpr size_t WS_WD_T = 144 * MiB;
constexpr size_t WS_H = 208 * MiB;
constexpr size_t WS_YMIX = 272 * MiB;
constexpr size_t WS_PROJ = 336 * MiB;
constexpr size_t WS_ACT = 608 * MiB;
constexpr size_t WS_END = 1008 * MiB;
constexpr int OPREC = 34816;
constexpr int OP_AT = 0, OP_RT = 4608, OP_BH = 9216, OP_KH = 13824, OP_BCT = 18432, OP_KCT = 23552, OP_VT = 28672, OP_P31 = 33792;
constexpr size_t WS_OPS = WS_ACT;
constexpr size_t WS_VS = 944 * MiB;
constexpr size_t WS_BON = WS_H;

__device__ __forceinline__ unsigned cvtpk(float lo, float hi) { f32x2_t v = {lo, hi}; bf16x2_t b = __builtin_convertvector(v, bf16x2_t); return __builtin_bit_cast(unsigned, b); }
__device__ __forceinline__ float bf2f(unsigned short u) { return __uint_as_float(((unsigned)u) << 16); }
__device__ __forceinline__ float wave_sum(float v) {
#pragma unroll
    for (int o = 1; o < 64; o <<= 1) v += __shfl_xor(v, o);
    return v;
}
__device__ __forceinline__ float wave_max(float v) {
#pragma unroll
    for (int o = 1; o < 64; o <<= 1) v = fmaxf(v, __shfl_xor(v, o));
    return v;
}
__device__ __forceinline__ int opaque_tid() { int t = (int)threadIdx.x; asm volatile("" : "+v"(t)); return t; }
__device__ __forceinline__ float sigmoidf_(float x) { return __builtin_amdgcn_rcpf(1.0f + __expf(-x)); }
__device__ __forceinline__ float tanh_fast(float x) { return 1.0f - 2.0f * __builtin_amdgcn_rcpf(1.0f + __expf(2.0f * x)); }

struct Params {
    const float* in[31];
    float* out;
    unsigned char* ws;
};
enum { I_X = 0, I_C, I_MODW, I_MODB, I_N1G, I_WIN, I_MU, I_W0, I_WUP, I_A0, I_AUP, I_GUP, I_KK, I_KA, I_RK, I_GNG, I_GNB, I_LQ1, I_LK1, I_LQ2, I_LK2, I_SUBLN, I_WOUT, I_N2G, I_RTW, I_RTB, I_WGU, I_BGU, I_WDN, I_BDN, I_FG };

namespace pg8 {
constexpr int BM = 256, BK = 64, HALF = 128, HTB = HALF * BK * 2, STAGE_BYTES = 8 * HTB, NXCD = 8, WGM = 8;
__host__ __device__ __forceinline__ int lds_byte(int r, int c) { const int st = (r >> 4) * 2 + (c >> 5), rr = r & 15, cc = c & 31, ob = rr * 64 + cc * 2; return st * 1024 + (ob ^ (((ob >> 9) & 1) << 5)); }
__host__ __device__ __forceinline__ void stage_rc(int b, int& R, int& C) { const int st = b / 1024, sb = b % 1024, swz = sb ^ (((sb >> 9) & 1) << 5); R = (st >> 1) * 16 + swz / 64; C = (st & 1) * 32 + (swz % 64) / 2; }
__host__ __device__ __forceinline__ int perm32(int rho) { const int n = rho >> 4, i = rho & 15; return 8 * (i >> 2) + 4 * n + (i & 3); }

struct Unit { int pm, pn, arow, brow, e; };
struct Gemm { const bf16_t* A; const bf16_t* Bt; int K; const int* rowmap; };

struct TileOrder {
    int nM, nN, nwg, G, c;
    __device__ void init(int nM_, int nN_, int G_, int c_) { nM = nM_; nN = nN_; nwg = nM * nN; G = G_; c = c_; }
    __device__ bool map(int i, int& pm, int& pn) const {
        const long L = (long)i * G + c; if (L >= nwg) return false;
        int wgid = (int)L; { const int q = nwg / NXCD, r = nwg % NXCD, xcd = wgid % NXCD, off = wgid / NXCD; wgid = (xcd < r ? xcd * (q + 1) : r * (q + 1) + (xcd - r) * q) + off; }
        const int nig = WGM * nN, gid = wgid / nig, fm = gid * WGM, gsz = (nM - fm) < WGM ? (nM - fm) : WGM;
        pm = fm + ((wgid % nig) % gsz); pn = (wgid % nig) / gsz; return true;
    }
};
struct DenseSched {
    TileOrder o;
    __device__ bool next(int i, Unit& u) const { int pm, pn; if (!o.map(i, pm, pn)) return false; u.pm = pm; u.pn = pn; u.arow = pm * BM; u.brow = pn * BM; u.e = 0; return true; }
};
struct MoeSched {
    TileOrder o; const int* tile_e; int N;
    __device__ bool next(int i, Unit& u) const { int pm, pn; if (!o.map(i, pm, pn)) return false; const int e = tile_e[pm]; u.pm = pm; u.pn = pn; u.arow = pm * BM; u.brow = e * N + pn * BM; u.e = e; return true; }
};

typedef int v4i_t __attribute__((ext_vector_type(4)));
typedef int v8i_t __attribute__((ext_vector_type(8)));
__device__ __forceinline__ v8i_t cat8(bf16x8 a, bf16x8 b) { return __builtin_shufflevector(__builtin_bit_cast(v4i_t, a), __builtin_bit_cast(v4i_t, b), 0, 1, 2, 3, 4, 5, 6, 7); }
__device__ __forceinline__ void mfma_fp8_tied(f32x4& acc, v8i_t a, v8i_t b) { asm volatile("v_mfma_f32_16x16x128_f8f6f4 %0, %1, %2, %0" : "+v"(acc) : "v"(a), "v"(b)); }
template <bool GATHER, bool FP8, class Epi, class Sched>
__device__ __forceinline__ void gemm_phase(LAS unsigned char* lds, const Gemm g, const Sched& S, const Epi& E) {
    const int tid = opaque_tid(), wid = __builtin_amdgcn_readfirstlane(tid >> 6), lane = tid & 63, wr = wid >> 2, wc = wid & 3, fr = lane & 15, fq = lane >> 4;
    const int K = g.K, nt = K / BK;
    unsigned voffA[2], voffB[2]; int rowA[2], colA2[2];
#pragma unroll
    for (int i = 0; i < 2; ++i) { int R, C; stage_rc(tid * 16 + i * 8192, R, C); const int Rb = (R & ~31) + perm32(R & 31);
        voffA[i] = (unsigned)(R * K + C) * 2u; voffB[i] = (unsigned)(Rb * K + C) * 2u; rowA[i] = R; colA2[i] = C * 2; }
    unsigned gv0[2] = {0u, 0u}, gv1[2] = {0u, 0u}, gn0[2] = {0u, 0u}, gn1[2] = {0u, 0u};
#define PG8_GOFF(u_, o0, o1) do { _Pragma("unroll") for (int _i = 0; _i < 2; ++_i) { o0[_i] = (unsigned)g.rowmap[(u_).arow + rowA[_i]] * (unsigned)(K * 2) + (unsigned)colA2[_i]; o1[_i] = (unsigned)g.rowmap[(u_).arow + HALF + rowA[_i]] * (unsigned)(K * 2) + (unsigned)colA2[_i]; } } while (0)
#define PG8_STAGE_A(bufoff, kptr, half) do { if constexpr (GATHER) { if (half) PG8_STAGE(bufoff, kptr, gv1); else PG8_STAGE(bufoff, kptr, gv0); } else PG8_STAGE(bufoff, (kptr) + ((half) ? hstep : 0), voffA); } while (0)
    const size_t kstep = (size_t)(BK * 2);
    const size_t hstep = (size_t)HALF * K * 2;
    const size_t rowb = (size_t)K * 2;
    const unsigned ldsw = (unsigned)wid * 1024u;
    const int aoff = lds_byte(wr * 64 + fr, fq * 8), boff = lds_byte(wc * 32 + fr, fq * 8);
#define PG8_SA(b, h) (((b) * 2 + (h)) * HTB)
#define PG8_SB(b, h) ((4 + (b) * 2 + (h)) * HTB)
#define PG8_STAGE(bufoff, gbase, voff) do { _Pragma("unroll") for (int _i = 0; _i < 2; ++_i) \
        __builtin_amdgcn_global_load_lds((const unsigned*)((const char*)(gbase) + (voff)[_i]), (LAS unsigned*)(lds + (bufoff) + ldsw + _i * 8192), 16, 0, 0); } while (0)
#define PG8_LDA(dst, b, h) do { _Pragma("unroll") for (int m = 0; m < 4; ++m) _Pragma("unroll") for (int k = 0; k < 2; ++k) dst[m][k] = *(const LAS bf16x8*)(lds + PG8_SA(b, h) + aoff + m * 2048 + k * 1024); } while (0)
#define PG8_LDB(dst, b, h) do { _Pragma("unroll") for (int n = 0; n < 2; ++n) _Pragma("unroll") for (int k = 0; k < 2; ++k) dst[n][k] = *(const LAS bf16x8*)(lds + PG8_SB(b, h) + boff + n * 2048 + k * 1024); } while (0)
#define PG8_MMA(ai, bj, At, Bt) do { __builtin_amdgcn_s_setprio(1); _Pragma("unroll") for (int m = 0; m < 4; ++m) _Pragma("unroll") for (int n = 0; n < 2; ++n) { \
        if constexpr (FP8) mfma_fp8_tied(acc[ai][bj][m][n], cat8(Bt[n][0], Bt[n][1]), cat8(At[m][0], At[m][1])); \
        else { _Pragma("unroll") for (int k = 0; k < 2; ++k) acc[ai][bj][m][n] = __builtin_amdgcn_mfma_f32_16x16x32_bf16(Bt[n][k], At[m][k], acc[ai][bj][m][n], 0, 0, 0); } } __builtin_amdgcn_s_setprio(0); } while (0)
#define PG8_WAIT_V(n) asm volatile("s_waitcnt vmcnt(" #n ")" ::: "memory")
#define PG8_WAIT_L(n) asm volatile("s_waitcnt lgkmcnt(" #n ")" ::: "memory")
#define PG8_BAR __builtin_amdgcn_s_barrier()
#define PG8_SCHED __builtin_amdgcn_sched_barrier(0)
    Unit cur, nxt; int ui = 0;
    if (!S.next(0, cur)) return;
    f32x4 acc[2][2][4][2];
#pragma unroll
    for (int a = 0; a < 2; ++a)
#pragma unroll
        for (int b = 0; b < 2; ++b)
#pragma unroll
            for (int m = 0; m < 4; ++m)
#pragma unroll
                for (int n = 0; n < 2; ++n) acc[a][b][m][n] = (f32x4){0.f, 0.f, 0.f, 0.f};
    bf16x8 At[4][2], B0[2][2], B1[2][2];
    const char* cA = GATHER ? (const char*)g.A : (const char*)g.A + (size_t)cur.arow * rowb; const char* cB = (const char*)g.Bt + (size_t)cur.brow * rowb;
    if constexpr (GATHER) PG8_GOFF(cur, gv0, gv1);
    PG8_STAGE(PG8_SB(0, 0), cB, voffB); PG8_STAGE(PG8_SB(0, 1), cB + hstep, voffB); PG8_STAGE_A(PG8_SA(0, 0), cA, 0); PG8_STAGE_A(PG8_SA(0, 1), cA, 1);
    if (wr == 1) PG8_BAR;
    PG8_WAIT_V(2); PG8_BAR;
    PG8_STAGE(PG8_SB(1, 0), cB + kstep, voffB); PG8_STAGE_A(PG8_SA(1, 0), cA + kstep, 0); PG8_STAGE(PG8_SB(1, 1), cB + hstep + kstep, voffB);
    PG8_WAIT_V(6); PG8_BAR;
    for (;;) {
        const bool has_next = S.next(ui + 1, nxt);
        const char* nA = GATHER ? (const char*)g.A : (has_next ? (const char*)g.A + (size_t)nxt.arow * rowb : cA); const char* nB = has_next ? (const char*)g.Bt + (size_t)nxt.brow * rowb : cB;

        for (int t = 0; t < nt; t += 2) {
            const bool last = (t == nt - 2);
            if constexpr (GATHER) { if (t == nt - 4) { if (has_next) PG8_GOFF(nxt, gn0, gn1); else { gn0[0] = gv0[0]; gn0[1] = gv0[1]; gn1[0] = gv1[0]; gn1[1] = gv1[1]; } } }
            const char* a1 = cA + (size_t)(t + 1) * kstep;
            const char* a2 = last ? nA : cA + (size_t)(t + 2) * kstep; const char* b2 = last ? nB : cB + (size_t)(t + 2) * kstep;
            const char* a3 = a2 + kstep; const char* b3 = b2 + kstep;
            PG8_LDB(B0, 0, 0); PG8_LDB(B1, 0, 1); PG8_SCHED; PG8_LDA(At, 0, 0); PG8_STAGE_A(PG8_SA(1, 1), a1, 1);
            if constexpr (GATHER) { if (last) { gv0[0] = gn0[0]; gv0[1] = gn0[1]; gv1[0] = gn1[0]; gv1[1] = gn1[1]; } }
            PG8_WAIT_V(8); PG8_WAIT_L(0); PG8_BAR; PG8_MMA(0, 0, At, B0); PG8_MMA(0, 1, At, B1); PG8_BAR; PG8_SCHED;
            PG8_LDA(At, 0, 1); PG8_STAGE(PG8_SB(0, 0), b2, voffB); PG8_STAGE(PG8_SB(0, 1), b2 + hstep, voffB); PG8_STAGE_A(PG8_SA(0, 0), a2, 0);
            PG8_WAIT_V(8); PG8_WAIT_L(0); PG8_BAR; PG8_MMA(1, 0, At, B0); PG8_MMA(1, 1, At, B1); PG8_BAR; PG8_SCHED;
            PG8_LDB(B0, 1, 0); PG8_LDB(B1, 1, 1); PG8_SCHED; PG8_LDA(At, 1, 0); PG8_STAGE_A(PG8_SA(0, 1), a2, 1);
            PG8_WAIT_V(8); PG8_WAIT_L(0); PG8_BAR; PG8_MMA(0, 0, At, B0); PG8_MMA(0, 1, At, B1); PG8_BAR; PG8_SCHED;
            PG8_LDA(At, 1, 1); PG8_STAGE(PG8_SB(1, 0), b3, voffB); PG8_STAGE(PG8_SB(1, 1), b3 + hstep, voffB); PG8_STAGE_A(PG8_SA(1, 0), a3, 0);
            PG8_WAIT_V(8); PG8_WAIT_L(0); PG8_BAR; PG8_MMA(1, 0, At, B0); PG8_MMA(1, 1, At, B1); PG8_BAR; PG8_SCHED;
        }
        if (wr == 0) PG8_BAR;
        if constexpr (FP8) asm volatile("s_nop 15\n\ts_nop 15" ::: "memory");
        E(acc, cur, wr, wc, fr, fq);
        if (!has_next) break;
#pragma unroll
        for (int a = 0; a < 2; ++a)
#pragma unroll
            for (int b = 0; b < 2; ++b)
#pragma unroll
                for (int m = 0; m < 4; ++m)
#pragma unroll
                    for (int n = 0; n < 2; ++n) acc[a][b][m][n] = (f32x4){0.f, 0.f, 0.f, 0.f};
        cur = nxt; cA = nA; cB = nB; ++ui;
        if (wr == 1) PG8_BAR;
    }
    PG8_WAIT_V(0);
    PG8_BAR;
#undef PG8_SA
#undef PG8_SB
#undef PG8_STAGE
#undef PG8_STAGE_A
#undef PG8_GOFF
#undef PG8_LDA
#undef PG8_LDB
#undef PG8_MMA
#undef PG8_WAIT_V
#undef PG8_WAIT_L
#undef PG8_BAR
#undef PG8_SCHED
}
}

constexpr float Q_H2 = 8.0f, Q_W = 32.0f, Q_ACT = 4.0f;
__device__ __forceinline__ unsigned cvt4_fp8(float a, float b, float c, float d) { unsigned w = 0u; w = (unsigned)__builtin_amdgcn_cvt_pk_fp8_f32(a, b, (int)w, false); w = (unsigned)__builtin_amdgcn_cvt_pk_fp8_f32(c, d, (int)w, true); return w; }
struct EpiInProj {
    bf16_t* O;
    __device__ __forceinline__ void operator()(const f32x4 (&acc)[2][2][4][2], const pg8::Unit& u, int wr, int wc, int fr, int fq) const {
        const int row0 = u.pm * 256 + wr * 64 + fr, col0 = u.pn * 256 + wc * 32 + 8 * fq;
        const float sc = ((u.pn == 7 || u.pn == 8) ? QSCALE : 1.0f) * (1.0f / (Q_H2 * Q_W));
#pragma unroll
        for (int ai = 0; ai < 2; ++ai)
#pragma unroll
            for (int m = 0; m < 4; ++m) { bf16_t* rowp = O + (size_t)(row0 + ai * 128 + m * 16) * IC + col0;
#pragma unroll
                for (int bj = 0; bj < 2; ++bj) { const f32x4 v0 = acc[ai][bj][m][0] * sc, v1 = acc[ai][bj][m][1] * sc;
                    u32x4 w; w.x = cvtpk(v0[0], v0[1]); w.y = cvtpk(v0[2], v0[3]); w.z = cvtpk(v1[0], v1[1]); w.w = cvtpk(v1[2], v1[3]);
                    *(u32x4*)(rowp + bj * 128) = w; } }
    }
};
struct EpiOutProj {
    const float* x; const float* mod; float* O;
    __device__ __forceinline__ void operator()(const f32x4 (&acc)[2][2][4][2], const pg8::Unit& u, int wr, int wc, int fr, int fq) const {
        const int row0 = u.pm * 256 + wr * 64 + fr, col0 = u.pn * 256 + wc * 32 + 8 * fq;
        const int b = (u.pm * 256) / SEQ;
        const float* g1 = mod + b * 6144 + 2048;
        f32x4 gv[2][2];
#pragma unroll
        for (int bj = 0; bj < 2; ++bj)
#pragma unroll
            for (int n = 0; n < 2; ++n) gv[bj][n] = *(const f32x4*)(g1 + col0 + bj * 128 + 4 * n);
#pragma unroll
        for (int ai = 0; ai < 2; ++ai)
#pragma unroll
            for (int m = 0; m < 4; ++m) { const size_t off = (size_t)(row0 + ai * 128 + m * 16) * D + col0;
#pragma unroll
                for (int bj = 0; bj < 2; ++bj)
#pragma unroll
                    for (int n = 0; n < 2; ++n) { const f32x4 xv = *(const f32x4*)(x + off + bj * 128 + 4 * n);
                        *(f32x4*)(O + off + bj * 128 + 4 * n) = xv + gv[bj][n] * acc[ai][bj][m][n]; } }
    }
};
struct EpiMoe1 {
    const float* bgu; unsigned char* O;
    __device__ __forceinline__ void operator()(const f32x4 (&acc)[2][2][4][2], const pg8::Unit& u, int wr, int wc, int fr, int fq) const {
        const int row0 = u.pm * 256 + wr * 64 + fr, col0 = u.pn * 128 + wc * 32 + 8 * fq;
        const float* bg = bgu + (size_t)u.e * 2048 + col0;
        constexpr float dq = 1.0f / (Q_H2 * Q_W);
        f32x4 bgv[2], buv[2];
#pragma unroll
        for (int n = 0; n < 2; ++n) { bgv[n] = *(const f32x4*)(bg + 4 * n); buv[n] = *(const f32x4*)(bg + 1024 + 4 * n); }
#pragma unroll
        for (int ai = 0; ai < 2; ++ai)
#pragma unroll
            for (int m = 0; m < 4; ++m) { float a[8];
#pragma unroll
                for (int n = 0; n < 2; ++n) { const f32x4 gt = acc[ai][0][m][n] * dq + bgv[n], up = acc[ai][1][m][n] * dq + buv[n];
#pragma unroll
                    for (int j = 0; j < 4; ++j) { const float gg = fminf(gt[j], 7.0f), uu = fminf(fmaxf(up[j], -7.0f), 7.0f);
                        a[4 * n + j] = Q_ACT * (uu + 1.0f) * (gg * __builtin_amdgcn_rcpf(1.0f + __builtin_amdgcn_exp2f(-1.702f * LOG2E * gg))); } }
                u32x2 w; w.x = cvt4_fp8(a[0], a[1], a[2], a[3]); w.y = cvt4_fp8(a[4], a[5], a[6], a[7]);
                *(u32x2*)(O + (size_t)(row0 + ai * 128 + m * 16) * 1024 + col0) = w; }
    }
};
struct EpiMoe2 {
    const float* bdn; bf16_t* O;
    __device__ __forceinline__ void operator()(const f32x4 (&acc)[2][2][4][2], const pg8::Unit& u, int wr, int wc, int fr, int fq) const {
        const int row0 = u.pm * 256 + wr * 64 + fr, col0 = u.pn * 256 + wc * 32 + 8 * fq;
        const float* bd = bdn + (size_t)u.e * 1024 + col0;
        constexpr float dq = 1.0f / (Q_ACT * Q_W);
        f32x4 bv[2][2];
#pragma unroll
        for (int bj = 0; bj < 2; ++bj)
#pragma unroll
            for (int n = 0; n < 2; ++n) bv[bj][n] = *(const f32x4*)(bd + bj * 128 + 4 * n);
#pragma unroll
        for (int ai = 0; ai < 2; ++ai)
#pragma unroll
            for (int m = 0; m < 4; ++m) { bf16_t* rowp = O + (size_t)(row0 + ai * 128 + m * 16) * 1024 + col0;
#pragma unroll
                for (int bj = 0; bj < 2; ++bj) { const f32x4 v0 = acc[ai][bj][m][0] * dq + bv[bj][0], v1 = acc[ai][bj][m][1] * dq + bv[bj][1];
                    u32x4 w; w.x = cvtpk(v0[0], v0[1]); w.y = cvtpk(v0[2], v0[3]); w.z = cvtpk(v1[0], v1[1]); w.w = cvtpk(v1[2], v1[3]);
                    *(u32x4*)(rowp + bj * 128) = w; } }
    }
};

__device__ __forceinline__ void phase_mod(const Params& p, unsigned char* lds, int G) {
    const int tid = opaque_tid(), lane = tid & 63, wave = tid >> 6;
    float* sc = (float*)lds;
    float* part = (float*)lds + 8192;
    const float* c = p.in[I_C];
    for (int i = tid; i < 8192; i += NTHREADS) { const int b = i & 7, k = i >> 3; const float cv = c[b * 1024 + k]; sc[k * 8 + b] = cv / (1.0f + __expf(-cv)); }
    __syncthreads();
    float* mod = (float*)(p.ws + WS_MOD);
    const float* mw = p.in[I_MODW]; const float* mb = p.in[I_MODB];
    for (int cg = (int)blockIdx.x; cg < 256; cg += G) {
        const int cc = lane & 31, kh = lane >> 5, k0 = wave * 128 + kh * 64, col = cg * 24 + (cc < 24 ? cc : 0);
        float acc[8];
#pragma unroll
        for (int b = 0; b < 8; ++b) acc[b] = 0.f;
        const float* wp = mw + (size_t)k0 * 6144 + col;
        const float* sp = sc + k0 * 8;
#pragma unroll 1
        for (int k = 0; k < 64; k += 16) { float wv[16];
#pragma unroll
            for (int u = 0; u < 16; ++u) wv[u] = wp[(size_t)(k + u) * 6144];
#pragma unroll
            for (int u = 0; u < 16; ++u) { const f32x4 s0 = *(const f32x4*)(sp + (k + u) * 8), s1 = *(const f32x4*)(sp + (k + u) * 8 + 4);
                acc[0] += s0[0] * wv[u]; acc[1] += s0[1] * wv[u]; acc[2] += s0[2] * wv[u]; acc[3] += s0[3] * wv[u]; acc[4] += s1[0] * wv[u]; acc[5] += s1[1] * wv[u]; acc[6] += s1[2] * wv[u]; acc[7] += s1[3] * wv[u]; } }
#pragma unroll
        for (int b = 0; b < 8; ++b) acc[b] += __shfl_xor(acc[b], 32);
        if (lane < 24) {
#pragma unroll
            for (int b = 0; b < 8; ++b) part[(wave * 24 + lane) * 8 + b] = acc[b]; }
        __syncthreads();
        if (tid < 192) { const int cl = tid >> 3, b = tid & 7; float sum = mb[cg * 24 + cl];
#pragma unroll
            for (int w = 0; w < 8; ++w) sum += part[(w * 24 + cl) * 8 + b];
            mod[b * 6144 + cg * 24 + cl] = sum; }
        __syncthreads();
    }
}
__device__ __forceinline__ void transpose_item(const float* W, int N, int k0, int n0, bf16_t* WT, int Kdst, int dst_row_base, bool gu_interleave, float* scr, int lane) {
#pragma unroll 4
    for (int i = 0; i < 16; ++i) { const int row = 4 * i + (lane >> 4), c4 = lane & 15;
        const f32x4 v = *(const f32x4*)(W + (size_t)(k0 + row) * N + n0 + 4 * c4);
        float* s = scr + row * 65 + 4 * c4; s[0] = v[0]; s[1] = v[1]; s[2] = v[2]; s[3] = v[3]; }
    asm volatile("s_waitcnt lgkmcnt(0)" ::: "memory");
    const int cch = lane & 7;
#pragma unroll
    for (int i = 0; i < 8; ++i) { const int n = 8 * i + (lane >> 3); const float* s = scr + (8 * cch) * 65 + n;
        u32x4 o; o.x = cvtpk(s[0], s[65]); o.y = cvtpk(s[2 * 65], s[3 * 65]); o.z = cvtpk(s[4 * 65], s[5 * 65]); o.w = cvtpk(s[6 * 65], s[7 * 65]);
        int nn = n0 + n;
        if (gu_interleave) nn = (nn < 1024) ? ((nn >> 7) * 256 + (nn & 127)) : (((nn - 1024) >> 7) * 256 + 128 + ((nn - 1024) & 127));
        *(u32x4*)(WT + (size_t)(dst_row_base + nn) * Kdst + k0 + 8 * cch) = o; }
    asm volatile("s_waitcnt lgkmcnt(0)" ::: "memory");
}
struct CvtItem { const float* src; unsigned char* dst; int N; };
__device__ __forceinline__ CvtItem cvt_item(const Params& p, int r, int lane) {
    CvtItem c; constexpr int I_GU = 32 * 512;
    const int nq = lane & 7, kq = lane >> 3;
    if (r < I_GU) { const int e = r >> 9, rr = r & 511, k0 = (rr >> 6) * 128, n0 = (rr & 63) * 32; c.N = 2048;
        c.src = p.in[I_WGU] + (size_t)e * 1024 * 2048 + (size_t)(k0 + kq) * 2048 + n0 + 4 * nq;
        const int nn = n0 + 4 * nq, nd = (nn < 1024) ? ((nn >> 7) * 256 + (nn & 127)) : (((nn - 1024) >> 7) * 256 + 128 + ((nn - 1024) & 127));
        c.dst = p.ws + WS_WG_T + ((size_t)(e * 2048 + nd)) * 1024 + k0 + 16 * kq; }
    else if (r < I_GU + 32 * 256) { const int q = r - I_GU, e = q >> 8, rr = q & 255, k0 = (rr >> 5) * 128, n0 = (rr & 31) * 32; c.N = 1024;
        c.src = p.in[I_WDN] + (size_t)e * 1024 * 1024 + (size_t)(k0 + kq) * 1024 + n0 + 4 * nq;
        c.dst = p.ws + WS_WD_T + ((size_t)(e * 1024 + n0 + 4 * nq)) * 1024 + k0 + 16 * kq; }
    else { const int q = r - (I_GU + 32 * 256), k0 = (q / 104) * 128, n0 = (q % 104) * 32; c.N = IC;
        c.src = p.in[I_WIN] + (size_t)(k0 + kq) * IC + n0 + 4 * nq;
        c.dst = p.ws + WS_WIN_T + ((size_t)(n0 + 4 * nq)) * 1024 + k0 + 16 * kq; }
    return c;
}
__device__ __forceinline__ void phase_convert(const Params& p, unsigned char* lds, int G, int part) {
    const int tid = opaque_tid(), lane = tid & 63, wave = tid >> 6;
    float* scr = (float*)lds + wave * (64 * 65);
    const int gw = (int)blockIdx.x * NWAVES + wave, NGW = G * NWAVES;
    constexpr int I_OUT = 16 * 16, NFE = 32 * 512 + 32 * 256;
    bf16_t* wout_t = (bf16_t*)(p.ws + WS_WOUT_T);
    if (part == 0) {
    for (int it = gw; it < I_OUT; it += NGW) transpose_item(p.in[I_WOUT], D, (it / 16) * 64, (it % 16) * 64, wout_t, 1024, 0, false, scr, lane);
    }
    unsigned* sq = (unsigned*)scr;
    const int wr_off = (lane >> 3) * 9 + (lane & 7), rd_off = (16 * (lane >> 3)) * 9 + (lane & 7);
    const int NF = (part == 0) ? NFE + 8 * 104 : NFE;
    int r = (part == 0) ? NFE + gw : gw;
    if (r >= NF) return;
    CvtItem cur = cvt_item(p, r, lane);
    f32x4 v[16];
#pragma unroll
    for (int i = 0; i < 16; ++i) v[i] = *(const f32x4*)(cur.src + (size_t)(8 * i) * cur.N);
    for (;;) {
#pragma unroll
        for (int i = 0; i < 16; ++i) sq[wr_off + 8 * i * 9] = cvt4_fp8(Q_W * v[i][0], Q_W * v[i][1], Q_W * v[i][2], Q_W * v[i][3]);
        asm volatile("" ::: "memory");
        const int rn = r + NGW; const bool more = rn < NF;
        unsigned char* dst = cur.dst;
        if (more) { cur = cvt_item(p, rn, lane);
#pragma unroll
            for (int i = 0; i < 16; ++i) v[i] = *(const f32x4*)(cur.src + (size_t)(8 * i) * cur.N); }
        asm volatile("s_waitcnt lgkmcnt(0)" ::: "memory");
        unsigned d[16];
#pragma unroll
        for (int j = 0; j < 16; ++j) d[j] = sq[rd_off + j * 9];
        u32x4 o[4];
#pragma unroll
        for (int g = 0; g < 4; ++g) { const unsigned d0 = d[4 * g], d1 = d[4 * g + 1], d2 = d[4 * g + 2], d3 = d[4 * g + 3];
            const unsigned x = __builtin_amdgcn_perm(d1, d0, 0x05010400u), y = __builtin_amdgcn_perm(d1, d0, 0x07030602u), z = __builtin_amdgcn_perm(d3, d2, 0x05010400u), w = __builtin_amdgcn_perm(d3, d2, 0x07030602u);
            o[0][g] = __builtin_amdgcn_perm(z, x, 0x05040100u); o[1][g] = __builtin_amdgcn_perm(z, x, 0x07060302u); o[2][g] = __builtin_amdgcn_perm(w, y, 0x05040100u); o[3][g] = __builtin_amdgcn_perm(w, y, 0x07060302u); }
#pragma unroll
        for (int nn = 0; nn < 4; ++nn) *(u32x4*)(dst + (size_t)nn * 1024) = o[nn];
        asm volatile("" ::: "memory");
        if (!more) break;
        r = rn;
    }
}

__device__ __forceinline__ void phase_norm1(const Params& p, int G) {
    const int tid = opaque_tid(), lane = tid & 63, wave = tid >> 6;
    const int gw = (int)blockIdx.x * NWAVES + wave, NGW = G * NWAVES;
    const float* x = p.in[I_X]; const float* gain = p.in[I_N1G]; const float* mod = (const float*)(p.ws + WS_MOD);
    bf16_t* h = (bf16_t*)(p.ws + WS_H);
    for (int row = gw; row < T; row += NGW) {
        const int b = row / SEQ;
        const f32x4* xr = (const f32x4*)(x + (size_t)row * D) + lane;
        f32x4 v[4]; float s = 0.f;
#pragma unroll
        for (int j = 0; j < 4; ++j) { v[j] = xr[64 * j]; s += (v[j][0] * v[j][0] + v[j][1] * v[j][1]) + (v[j][2] * v[j][2] + v[j][3] * v[j][3]); }
        const float rstd = rsqrtf(wave_sum(s) * (1.0f / D) + NORM_EPS);
        const float* sh = mod + b * 6144; const float* scl = mod + b * 6144 + 1024;
        unsigned* o4 = (unsigned*)((unsigned char*)h + (size_t)row * D) + lane;
#pragma unroll
        for (int j = 0; j < 4; ++j) { const int k = 4 * lane + 256 * j;
            const f32x4 g = *(const f32x4*)(gain + k), s1 = *(const f32x4*)(scl + k), s0 = *(const f32x4*)(sh + k);
            const f32x4 y = (v[j] * rstd) * g * (s1 + 1.0f) + s0;
            o4[64 * j] = cvt4_fp8(Q_H2 * y[0], Q_H2 * y[1], Q_H2 * y[2], Q_H2 * y[3]); }
    }
}

constexpr size_t CTL_KMAX = 57344;
__device__ __forceinline__ void kmax_pass(const Params& p, int G) {
    const int tid = opaque_tid(), lane = tid & 63, wave = tid >> 6;
    const bf16_t* proj = (const bf16_t*)(p.ws + WS_PROJ);
    unsigned* km = (unsigned*)(p.ws + WS_CTL + CTL_KMAX);
    const int TPB = T / G;
    float mx = 0.f; const int tok0 = (int)blockIdx.x * TPB;
    for (int ti = wave; ti < TPB; ti += NWAVES) {
        const u32x4 kv = *(const u32x4*)(proj + (size_t)(tok0 + ti) * IC + RC + 512 + 8 * lane);
        float ss = 0.f;
#pragma unroll
        for (int j = 0; j < 4; ++j) { const float a = __uint_as_float(kv[j] << 16), bq = __uint_as_float(kv[j] & 0xffff0000u); ss += a * a + bq * bq; }
        ss += __shfl_xor(ss, 1); ss += __shfl_xor(ss, 2); ss += __shfl_xor(ss, 4);
        mx = fmaxf(mx, ss);
    }
    if ((lane & 7) == 0) atomicMax(km + (tok0 / SEQ) * 8 + (lane >> 3), __float_as_uint(mx));
}

__device__ __forceinline__ s16x4 vtr(const LAS unsigned char* pp) { typedef short v4i16_t __attribute__((ext_vector_type(4))); return __builtin_bit_cast(s16x4, __builtin_amdgcn_ds_read_tr16_b64_v4i16((LAS v4i16_t*)pp)); }
constexpr int ATT_BUF = 32768;
__device__ __forceinline__ float att_max3(float a, float b, float c) { float r; asm("v_max3_f32 %0, %1, %2, %3" : "=v"(r) : "v"(a), "v"(b), "v"(c)); return r; }
constexpr int ATT_QROWS = 128, ATT_NQB = SEQ / ATT_QROWS, ATT_UNITS = NB * 4 * ATT_NQB;
__device__ __forceinline__ void attn_unit(const Params& p, LAS unsigned char* lds, int b, int h, int qb, float lam) {
    const int tid = opaque_tid(), lane = tid & 63, wid = __builtin_amdgcn_readfirstlane(tid >> 6), r32 = lane & 31, hi = lane >> 5;
    const int c = wid & 1, qblk = wid >> 1;
    const bf16_t* proj = (const bf16_t*)(p.ws + WS_PROJ) + (size_t)b * SEQ * IC;
    const int q0 = qb * ATT_QROWS, qw0 = q0 + 32 * qblk;
    const bf16_t* Qb = proj + RC + h * 128 + c * 64;
    const bf16_t* Kb = proj + RC + 512 + h * 128;
    const bf16_t* Vb = proj + RC + 1024 + h * 128;
    const float slope = exp2f(-2.0f * (float)(h + 1)) * LOG2E;
    f32x16 o[4];
#pragma unroll
    for (int d = 0; d < 4; ++d) o[d] = f32x16{};
    f32x16 cb0;
#pragma unroll
    for (int r = 0; r < 16; ++r) cb0[r] = slope * (float)((r & 3) + 8 * (r >> 2) + 4 * hi);
    const float c32 = slope * 32.0f;
    float m_ = 0.f, l_ = 0.f;
    const int NT = (q0 + ATT_QROWS) / 64;
    const bf16_t* ksrc = Kb + (size_t)lane * IC + wid * 8;
    const int p0i = wid, p1i = wid + 8;
    const bf16_t* vsrc0 = Vb + (size_t)(16 * (p0i & 3) + (lane >> 2)) * IC + (p0i >> 2) * 32 + (lane & 3) * 8;
    const bf16_t* vsrc1 = Vb + (size_t)(16 * (p1i & 3) + (lane >> 2)) * IC + (p1i >> 2) * 32 + (lane & 3) * 8;
#define ATT_GLDS(gsrc_, ldsdst_) do { unsigned keep_; asm volatile("s_mov_b32 %0, m0\n\ts_mov_b32 m0, %2\n\ts_nop 0\n\tglobal_load_lds_dwordx4 %1, off\n\ts_mov_b32 m0, %0" : "=&s"(keep_) : "v"(gsrc_), "s"(ldsdst_) : "memory"); } while (0)
    const unsigned lds0 = (unsigned)(uintptr_t)lds;
#define ATT_DMA(t, buf) do { const size_t ro = (size_t)(t) * 64 * IC; const unsigned bb_ = (unsigned)__builtin_amdgcn_readfirstlane((int)(lds0 + (buf) * ATT_BUF + wid * 1024)); \
        ATT_GLDS(ksrc + ro, bb_); ATT_GLDS(ksrc + ro + 64, bb_ + 8192u); ATT_GLDS(vsrc0 + ro, bb_ + 16384u); ATT_GLDS(vsrc1 + ro, bb_ + 16384u + 8192u); } while (0)
    ATT_DMA(NT - 1, 0); ATT_DMA(NT - 2, 1);
    bf16x8 qr[4];
#pragma unroll
    for (int d0 = 0; d0 < 4; ++d0) qr[d0] = *(const bf16x8*)(Qb + (size_t)(qw0 + r32) * IC + d0 * 16 + hi * 8);
    float qn;
    { float q2 = 0.f;
#pragma unroll
      for (int d0 = 0; d0 < 4; ++d0)
#pragma unroll
          for (int j = 0; j < 8; ++j) { const float x = bf2f((unsigned short)qr[d0][j]); q2 += x * x; }
      q2 += __shfl_xor(q2, 32);
      qn = sqrtf(q2 * ((const float*)(p.ws + WS_CTL + CTL_KMAX))[b * 8 + h * 2 + c]) * 1.002f + 0.01f; }
    asm volatile("" : "+v"(qr[0]), "+v"(qr[1]), "+v"(qr[2]), "+v"(qr[3]));
    asm volatile("s_waitcnt vmcnt(0)" ::: "memory");
    __builtin_amdgcn_s_barrier();
    const int voff = ((lane >> 4) & 1) * 32 + (lane & 3) * 8 + (4 * hi + ((lane & 15) >> 2)) * 64;
    const int qpos = qw0 + r32;
    const bool late = wid >= 4;
    bf16x8 pf[4]; bool pend = false;
    float mtrue = -INFINITY;
    LAS unsigned* vote = (LAS unsigned*)(lds + 4 * ATT_BUF + 64);
#define ATT_PV(slot_) do { const LAS unsigned char* vb_ = lds + (slot_) * ATT_BUF + 16384 + voff; \
        _Pragma("unroll") for (int dblk = 0; dblk < 4; ++dblk) { _Pragma("unroll") for (int ks = 0; ks < 4; ++ks) { \
            const s16x4 lo = vtr(vb_ + (dblk * 4 + ks) * 1024), hh = vtr(vb_ + (dblk * 4 + ks) * 1024 + 512); \
            const bf16x8 vf = (bf16x8){lo[0], lo[1], lo[2], lo[3], hh[0], hh[1], hh[2], hh[3]}; \
            o[dblk] = __builtin_amdgcn_mfma_f32_32x32x16_bf16(vf, pf[ks], o[dblk], 0, 0, 0); } } } while (0)
    int it = 0;
    for (; it < NT; ++it) {
        const int kt = NT - 1 - it, cur = it & 3;
        const bool issued = (it + 2 < NT);
        if (issued) ATT_DMA(kt - 2, (it + 2) & 3);
        const int k0 = kt * 64;
        if (late && pend) { ATT_PV((it - 1) & 3); pend = false; }
        if (k0 <= qw0 + 31) {
            const LAS unsigned char* bb = lds + cur * ATT_BUF;
            const bool need_mask = (k0 + 63 > qw0);
            const LAS unsigned char* kb = bb + c * 8192 + hi * 1024 + r32 * 16;
            f32x16 s0 = cb0, s1 = cb0;
#pragma unroll
            for (int d0 = 0; d0 < 4; ++d0) {
                const bf16x8 a0 = *(const LAS bf16x8*)(kb + d0 * 2048), a1 = *(const LAS bf16x8*)(kb + d0 * 2048 + 512);
                s0 = __builtin_amdgcn_mfma_f32_32x32x16_bf16(a0, qr[d0], s0, 0, 0, 0);
                s1 = __builtin_amdgcn_mfma_f32_32x32x16_bf16(a1, qr[d0], s1, 0, 0, 0);
            }
            if (need_mask) {
                const int dq = k0 - qpos + 4 * hi;
#pragma unroll
                for (int r = 0; r < 16; ++r) { if (dq + ((r & 3) + 8 * (r >> 2)) > 0) s0[r] = -INFINITY; if (dq + ((r & 3) + 8 * (r >> 2)) + 32 > 0) s1[r] = -INFINITY; }
            }
            const float tb = slope * (float)(k0 - qpos);
            float rm0 = att_max3(s0[0], s0[1], s0[2]), rm1 = att_max3(s1[0], s1[1], s1[2]);
#pragma unroll
            for (int r = 3; r < 15; r += 2) { rm0 = att_max3(rm0, s0[r], s0[r + 1]); rm1 = att_max3(rm1, s1[r], s1[r + 1]); }
            float rm = att_max3(rm0, s0[15], att_max3(rm1, s1[15], -INFINITY) + c32);
            rm += tb;
            rm = fmaxf(rm, __shfl_xor(rm, 32));
            mtrue = fmaxf(mtrue, rm);
            if (__any(rm > m_ + 8.0f)) {
                const float mn = fmaxf(m_, rm);
                const float alpha = __builtin_amdgcn_exp2f(m_ - mn);
                m_ = mn; l_ *= alpha;
#pragma unroll
                for (int d = 0; d < 4; ++d)
#pragma unroll
                    for (int r = 0; r < 16; ++r) o[d][r] *= alpha;
            }
            const float off = tb - m_, off1 = off + c32;
            float ps = 0.f;
#pragma unroll
            for (int r = 0; r < 16; ++r) { s0[r] = __builtin_amdgcn_exp2f(s0[r] + off); s1[r] = __builtin_amdgcn_exp2f(s1[r] + off1); ps += s0[r] + s1[r]; }
            l_ += ps;
#pragma unroll
            for (int ks = 0; ks < 2; ++ks) {
                u32x4 w0, w1;
                w0.x = cvtpk(s0[8 * ks + 0], s0[8 * ks + 1]); w0.y = cvtpk(s0[8 * ks + 2], s0[8 * ks + 3]); w0.z = cvtpk(s0[8 * ks + 4], s0[8 * ks + 5]); w0.w = cvtpk(s0[8 * ks + 6], s0[8 * ks + 7]);
                w1.x = cvtpk(s1[8 * ks + 0], s1[8 * ks + 1]); w1.y = cvtpk(s1[8 * ks + 2], s1[8 * ks + 3]); w1.z = cvtpk(s1[8 * ks + 4], s1[8 * ks + 5]); w1.w = cvtpk(s1[8 * ks + 6], s1[8 * ks + 7]);
                pf[ks] = __builtin_bit_cast(bf16x8, w0); pf[2 + ks] = __builtin_bit_cast(bf16x8, w1);
            }
            if (late) pend = true; else ATT_PV(cur);
        }
        { const bool neg = (qn + slope * (float)(k0 - 1 - qpos) <= mtrue - 50.0f);
          if (lane == 0) vote[(it & 1) * 8 + wid] = __all(neg) ? 1u : 0u; }
        if (issued) asm volatile("s_waitcnt vmcnt(4)" ::: "memory"); else asm volatile("s_waitcnt vmcnt(0)" ::: "memory");
        asm volatile("s_waitcnt lgkmcnt(0)" ::: "memory");
        __builtin_amdgcn_s_barrier();
        { const u32x4 va = *(const LAS u32x4*)(vote + (it & 1) * 8), vb2 = *(const LAS u32x4*)(vote + (it & 1) * 8 + 4);
          if ((va.x & va.y & va.z & va.w & vb2.x & vb2.y & vb2.z & vb2.w) != 0u) { ++it; break; } }
    }
    if (late && pend) ATT_PV((it - 1) & 3);
    asm volatile("s_waitcnt vmcnt(0) lgkmcnt(0)" ::: "memory");
    __builtin_amdgcn_s_barrier();
#undef ATT_PV
#undef ATT_DMA
#undef ATT_GLDS
    l_ += __shfl_xor(l_, 32);
    LAS float* xb = (LAS float*)(lds + qblk * 16384);
    if (c == 1) {
        const float i1 = lam / l_;
#pragma unroll
        for (int d = 0; d < 4; ++d)
#pragma unroll
            for (int r = 0; r < 16; ++r) xb[(d * 16 + r) * 64 + lane] = o[d][r] * i1;
    }
    __syncthreads();
    if (c == 0) {
        const float i0 = 1.0f / l_;
        float ss = 0.f;
#pragma unroll
        for (int d = 0; d < 4; ++d)
#pragma unroll
            for (int r = 0; r < 16; ++r) { const float v = o[d][r] * i0 - xb[(d * 16 + r) * 64 + lane]; o[d][r] = v; ss += v * v; }
        ss += __shfl_xor(ss, 32);
        const float rstd = rsqrtf(ss * (1.0f / 128.0f) + NORM_EPS) * (1.0f - LAMBDA_INIT);
        const float* sg = p.in[I_SUBLN];
        bf16_t* yo = (bf16_t*)(p.ws + WS_YMIX) + (size_t)(b * SEQ + qw0 + r32) * D + RW + h * 128;
#pragma unroll
        for (int d = 0; d < 4; ++d)
#pragma unroll
            for (int g = 0; g < 4; ++g) { const int dd = 32 * d + 8 * g + 4 * hi; const f32x4 gv = *(const f32x4*)(sg + dd);
                u32x2 w; w.x = cvtpk(o[d][4 * g] * rstd * gv[0], o[d][4 * g + 1] * rstd * gv[1]); w.y = cvtpk(o[d][4 * g + 2] * rstd * gv[2], o[d][4 * g + 3] * rstd * gv[3]);
                *(u32x2*)(yo + dd) = w; }
    }
    __syncthreads();
}

constexpr int RCH = 32;
constexpr int RK_R = 0, RK_KM = 8192, RK_DEC = 16384, RK_KK = 24576, RK_BB = 32768, RK_VV = 40960, RK_GG = 49152;
constexpr int RK_AW = 57344;
constexpr int RK_AA = RK_AW + 4608;
constexpr int RK_AG = RK_AA + 4608;
constexpr int RK_BON = RK_AG + 8704;
constexpr int RK_MU = RK_BON + 128;
constexpr int RK_RAW = 77824;
constexpr int RK_IM = RK_RAW + 33 * 1024;
constexpr int RK_LSEG = RK_IM + OPREC;
constexpr int RK_END = RK_LSEG + 2048;
static_assert(RK_MU + 1792 <= RK_RAW && RK_END <= LDS_BYTES - 64 && (RK_RAW % 1024) == 0, "rwkv prep LDS map");
template <int CTRL> __device__ __forceinline__ float dpp_add(float v) { return v + __builtin_bit_cast(float, __builtin_amdgcn_update_dpp(0, __builtin_bit_cast(int, v), CTRL, 0xf, 0xf, true)); }
__device__ __forceinline__ float red16(float v) {
    v = dpp_add<0xB1>(v);
    v = dpp_add<0x4E>(v);
    v = dpp_add<0x141>(v);
    v = dpp_add<0x140>(v);
    return v;
}
__device__ __forceinline__ int rk_piece_col(int pc, int h) {
    return pc < 8 ? h * 64 + 8 * pc : (pc < 16 ? 512 + h * 64 + 8 * (pc - 8) : (pc < 24 ? 1024 + h * 64 + 8 * (pc - 16) : 1536 + 8 * (pc - 24)));
}
#define RK_BAR() do { asm volatile("s_waitcnt lgkmcnt(0)" ::: "memory"); __builtin_amdgcn_s_barrier(); asm volatile("" ::: "memory"); } while (0)
__device__ __forceinline__ void rwkv_prep(const Params& p, LAS unsigned char* lds, int b, int h, int ch0, int ch1) {
    const int tid = opaque_tid(), lane = tid & 63, wid = __builtin_amdgcn_readfirstlane(tid >> 6);
    const bf16_t* proj = (const bf16_t*)(p.ws + WS_PROJ) + (size_t)b * SEQ * IC;
    LAS float* R_ = (LAS float*)(lds + RK_R); LAS float* KM_ = (LAS float*)(lds + RK_KM); LAS float* DEC_ = (LAS float*)(lds + RK_DEC); LAS float* KK_ = (LAS float*)(lds + RK_KK);
    LAS float* BB_ = (LAS float*)(lds + RK_BB); LAS float* VV_ = (LAS float*)(lds + RK_VV); LAS float* GG_ = (LAS float*)(lds + RK_GG); LAS float* BON_ = (LAS float*)(lds + RK_BON);
    LAS float* MU_ = (LAS float*)(lds + RK_MU);
    const int dpc = lane < 56 ? lane : 55;
    const bf16_t* dsrc = proj + rk_piece_col(dpc, h);
#define RK_DMA(t0_) do { for (int rho = wid; rho < 33; rho += NWAVES) { int tok = (t0_) - 1 + rho; tok = tok < 0 ? 0 : tok; \
        __builtin_amdgcn_global_load_lds((const unsigned*)(dsrc + (size_t)tok * IC), (LAS unsigned*)(lds + RK_RAW + rho * 1024), 16, 0, 0); } } while (0)
    RK_DMA(ch0 * RCH);
    if (tid < 448) MU_[tid] = p.in[I_MU][rk_piece_col(tid >> 3, h) + (tid & 7)];
    const int ntile = wid & 3, ttile = wid >> 2, fn = lane & 15, fk = lane >> 4;
    const int ncol = h * 64 + ntile * 16 + fn;
    bf16x8 bw[2], ba[2], bg[4];
    {
        const float* wup = p.in[I_WUP]; const float* aup = p.in[I_AUP]; const float* gup = p.in[I_GUP];
#pragma unroll
        for (int ks = 0; ks < 2; ++ks) { float t[8], u[8];
#pragma unroll
            for (int j = 0; j < 8; ++j) { const int k = 32 * ks + 8 * fk + j; t[j] = wup[k * RW + ncol]; u[j] = aup[k * RW + ncol]; }
            u32x4 a, c; a.x = cvtpk(t[0], t[1]); a.y = cvtpk(t[2], t[3]); a.z = cvtpk(t[4], t[5]); a.w = cvtpk(t[6], t[7]);
            c.x = cvtpk(u[0], u[1]); c.y = cvtpk(u[2], u[3]); c.z = cvtpk(u[4], u[5]); c.w = cvtpk(u[6], u[7]);
            bw[ks] = __builtin_bit_cast(bf16x8, a); ba[ks] = __builtin_bit_cast(bf16x8, c); }
#pragma unroll
        for (int ks = 0; ks < 4; ++ks) { float t[8];
#pragma unroll
            for (int j = 0; j < 8; ++j) { const int k = 32 * ks + 8 * fk + j; t[j] = gup[k * RW + ncol]; }
            u32x4 a; a.x = cvtpk(t[0], t[1]); a.y = cvtpk(t[2], t[3]); a.z = cvtpk(t[4], t[5]); a.w = cvtpk(t[6], t[7]);
            bg[ks] = __builtin_bit_cast(bf16x8, a); }
    }
    const float w0n = p.in[I_W0][ncol], a0n = p.in[I_A0][ncol];
    const int q16 = tid & 15, tk16 = tid >> 4;
    const f32x4 kkc = *(const f32x4*)(p.in[I_KK] + h * 64 + 4 * q16), kac = *(const f32x4*)(p.in[I_KA] + h * 64 + 4 * q16), rkc = *(const f32x4*)(p.in[I_RK] + h * 64 + 4 * q16);
    const size_t hb = (size_t)(b * 8 + h) * SEQ * 64;
    bf16_t* gVS = (bf16_t*)(p.ws + WS_VS) + hb; bf16_t* gGG = (bf16_t*)(p.out + (size_t)16 * 1024 * 1024) + hb; float* gBON = (float*)(p.ws + WS_BON) + (size_t)(b * 8 + h) * SEQ;
    unsigned char* gOPS = p.ws + WS_OPS + (size_t)(b * 8 + h) * (SEQ / RCH) * OPREC;
    for (int ch = ch0; ch < ch1; ++ch) {
        const int t0 = ch * RCH;
        if (ch > ch0) { if (wid == 0) asm volatile("s_waitcnt vmcnt(8)" ::: "memory"); else if (wid == 1) asm volatile("s_waitcnt vmcnt(7)" ::: "memory"); else asm volatile("s_waitcnt vmcnt(6)" ::: "memory"); } else asm volatile("s_waitcnt vmcnt(0)" ::: "memory");
        RK_BAR();
#define RK_SHIFT(tk_, pc_) \
            const u32x4 cv = *(const LAS u32x4*)(lds + RK_RAW + ((tk_) + 1) * 1024 + (pc_) * 16); \
            u32x4 pv = *(const LAS u32x4*)(lds + RK_RAW + (tk_) * 1024 + (pc_) * 16); \
            if (t0 + (tk_) == 0) pv = (u32x4){0u, 0u, 0u, 0u}; \
            const f32x4 m0 = *(const LAS f32x4*)(MU_ + (pc_) * 8), m1 = *(const LAS f32x4*)(MU_ + (pc_) * 8 + 4); \
            float xv[8]; \
            _Pragma("unroll") for (int j = 0; j < 4; ++j) { const unsigned cw = cv[j], pw = pv[j]; \
                const float c0 = __uint_as_float(cw << 16), c1 = __uint_as_float(cw & 0xffff0000u), p0 = __uint_as_float(pw << 16), p1 = __uint_as_float(pw & 0xffff0000u); \
                const float ma = (j < 2) ? m0[2 * j] : m1[2 * j - 4], mb = (j < 2) ? m0[2 * j + 1] : m1[2 * j - 3]; \
                xv[2 * j] = c0 + ma * (p0 - c0); xv[2 * j + 1] = c1 + mb * (p1 - c1); }
#pragma unroll
        for (int it = 0; it < 4; ++it) { const int sidx = wid + 8 * it;
            if (sidx < 12) { const int a = sidx * 64 + lane, tk = a / 24, pc = a - tk * 24, seg = pc >> 3, pi = pc & 7;
                RK_SHIFT(tk, pc)
                LAS float* dst = (seg == 0 ? R_ : (seg == 1 ? KM_ : VV_)) + tk * 64 + 8 * pi;
                *(LAS f32x4*)dst = (f32x4){xv[0], xv[1], xv[2], xv[3]}; *(LAS f32x4*)(dst + 4) = (f32x4){xv[4], xv[5], xv[6], xv[7]}; }
            else if (sidx < 16) { const int a = (sidx - 12) * 64 + lane, tk = a >> 3, pi = a & 7, pc = 24 + pi;
                RK_SHIFT(tk, pc)
                u32x4 w; w.x = cvtpk(tanh_fast(xv[0]), tanh_fast(xv[1])); w.y = cvtpk(tanh_fast(xv[2]), tanh_fast(xv[3])); w.z = cvtpk(tanh_fast(xv[4]), tanh_fast(xv[5])); w.w = cvtpk(tanh_fast(xv[6]), tanh_fast(xv[7]));
                *(LAS u32x4*)(lds + RK_AW + tk * 144 + 16 * pi) = w; }
            else if (sidx < 20) { const int a = (sidx - 16) * 64 + lane, tk = a >> 3, pi = a & 7, pc = 32 + pi;
                RK_SHIFT(tk, pc)
                u32x4 w; w.x = cvtpk(xv[0], xv[1]); w.y = cvtpk(xv[2], xv[3]); w.z = cvtpk(xv[4], xv[5]); w.w = cvtpk(xv[6], xv[7]);
                *(LAS u32x4*)(lds + RK_AA + tk * 144 + 16 * pi) = w; }
            else if (sidx < 28) { const int a = (sidx - 20) * 64 + lane, tk = a >> 4, pg = a & 15, pc = 40 + pg;
                RK_SHIFT(tk, pc)
                u32x4 w; w.x = cvtpk(sigmoidf_(xv[0]), sigmoidf_(xv[1])); w.y = cvtpk(sigmoidf_(xv[2]), sigmoidf_(xv[3])); w.z = cvtpk(sigmoidf_(xv[4]), sigmoidf_(xv[5])); w.w = cvtpk(sigmoidf_(xv[6]), sigmoidf_(xv[7]));
                *(LAS u32x4*)(lds + RK_AG + tk * 272 + pg * 16) = w; }
        }
#undef RK_SHIFT
        __syncthreads();
        if (ch + 1 < ch1) RK_DMA(t0 + RCH);
        {
            f32x4 cw = (f32x4){0.f, 0.f, 0.f, 0.f}, ca = cw, cg2 = cw;
            const int tok = ttile * 16 + fn;
#pragma unroll
            for (int ks = 0; ks < 2; ++ks) {
                const bf16x8 aw = *(const LAS bf16x8*)(lds + RK_AW + tok * 144 + (32 * ks + 8 * fk) * 2);
                const bf16x8 aa = *(const LAS bf16x8*)(lds + RK_AA + tok * 144 + (32 * ks + 8 * fk) * 2);
                cw = __builtin_amdgcn_mfma_f32_16x16x32_bf16(aw, bw[ks], cw, 0, 0, 0);
                ca = __builtin_amdgcn_mfma_f32_16x16x32_bf16(aa, ba[ks], ca, 0, 0, 0);
            }
#pragma unroll
            for (int ks = 0; ks < 4; ++ks) {
                const bf16x8 ag = *(const LAS bf16x8*)(lds + RK_AG + tok * 272 + (32 * ks + 8 * fk) * 2);
                cg2 = __builtin_amdgcn_mfma_f32_16x16x32_bf16(ag, bg[ks], cg2, 0, 0, 0);
            }
#pragma unroll
            for (int r = 0; r < 4; ++r) { const int tk = ttile * 16 + 4 * fk + r, n = ntile * 16 + fn;
                DEC_[tk * 64 + n] = -0.6065306597126334f * sigmoidf_(cw[r] + w0n);
                BB_[tk * 64 + n] = sigmoidf_(ca[r] + a0n);
                GG_[tk * 64 + n] = cg2[r]; }
        }
        RK_BAR();
        {
            const f32x4 kp = *(const LAS f32x4*)(KM_ + tk16 * 64 + 4 * q16), av = *(const LAS f32x4*)(BB_ + tk16 * 64 + 4 * q16), rr = *(const LAS f32x4*)(R_ + tk16 * 64 + 4 * q16);
            const f32x4 kkv = kp * kkc;
            const float nrm2 = red16((kkv[0] * kkv[0] + kkv[1] * kkv[1]) + (kkv[2] * kkv[2] + kkv[3] * kkv[3]));
            const f32x4 kkn = kkv * __builtin_amdgcn_rsqf(fmaxf(nrm2, 1e-24f));
            const f32x4 kmod = kp * ((av - 1.0f) * kac + 1.0f);
            const f32x4 t = rr * kmod * rkc;
            const float bs = red16((t[0] + t[1]) + (t[2] + t[3]));
            *(LAS f32x4*)(KK_ + tk16 * 64 + 4 * q16) = kkn; *(LAS f32x4*)(BB_ + tk16 * 64 + 4 * q16) = kkn * av; *(LAS f32x4*)(KM_ + tk16 * 64 + 4 * q16) = kmod;
            if (q16 == 0) BON_[tk16] = bs;
        }
        RK_BAR();
        {
            const int d1 = tid & 63, q1 = wid;
            float lw[4], cs[4];
#pragma unroll
            for (int e = 0; e < 4; ++e) lw[e] = DEC_[(4 * q1 + e) * 64 + d1];
            cs[0] = lw[0]; cs[1] = cs[0] + lw[1]; cs[2] = cs[1] + lw[2]; cs[3] = cs[2] + lw[3];
            ((LAS float*)(lds + RK_LSEG))[q1 * 64 + d1] = cs[3];
            { const float x0 = VV_[(4 * q1) * 64 + d1], x1 = VV_[(4 * q1 + 1) * 64 + d1], x2 = VV_[(4 * q1 + 2) * 64 + d1], x3 = VV_[(4 * q1 + 3) * 64 + d1];
              u32x2 w; w.x = cvtpk(x0, x1); w.y = cvtpk(x2, x3); *(LAS u32x2*)(lds + RK_IM + OP_VT + d1 * 80 + q1 * 8) = w; }
            RK_BAR();
            float off = 0.f, tot = 0.f;
#pragma unroll
            for (int qq = 0; qq < 8; ++qq) { const float sg = ((const LAS float*)(lds + RK_LSEG))[qq * 64 + d1]; tot += sg; if (qq < q1) off += sg; }
            const float etot = __expf(tot);
            float ePprev = __expf(off);
            float bc[4], kc4[4];
#pragma unroll
            for (int e = 0; e < 4; ++e) { const int tk = 4 * q1 + e;
                const float eP = __expf(off + cs[e]), eN = __builtin_amdgcn_rcpf(eP), eE = etot * eN;
                const float kap = KK_[tk * 64 + d1], bet = BB_[tk * 64 + d1], kk_ = KM_[tk * 64 + d1], rr = R_[tk * 64 + d1];
                const unsigned w0 = cvtpk(-kap * ePprev, rr * eP), w1 = cvtpk(bet * eN, kk_ * eN);
                *(LAS unsigned short*)(lds + RK_IM + OP_AT + tk * 144 + d1 * 2) = (unsigned short)(w0 & 0xffffu); *(LAS unsigned short*)(lds + RK_IM + OP_RT + tk * 144 + d1 * 2) = (unsigned short)(w0 >> 16);
                *(LAS unsigned short*)(lds + RK_IM + OP_BH + tk * 144 + d1 * 2) = (unsigned short)(w1 & 0xffffu); *(LAS unsigned short*)(lds + RK_IM + OP_KH + tk * 144 + d1 * 2) = (unsigned short)(w1 >> 16);
                bc[e] = bet * eE; kc4[e] = kk_ * eE; ePprev = eP; }
            u32x2 wb, wk; wb.x = cvtpk(bc[0], bc[1]); wb.y = cvtpk(bc[2], bc[3]); wk.x = cvtpk(kc4[0], kc4[1]); wk.y = cvtpk(kc4[2], kc4[3]);
            *(LAS u32x2*)(lds + RK_IM + OP_BCT + d1 * 80 + q1 * 8) = wb; *(LAS u32x2*)(lds + RK_IM + OP_KCT + d1 * 80 + q1 * 8) = wk;
            if (q1 == 0) ((LAS float*)(lds + RK_IM + OP_P31))[d1] = etot;
        }
        RK_BAR();
        {
            unsigned char* rec = gOPS + (size_t)ch * OPREC;
#pragma unroll
            for (int i = 0; i < 5; ++i) { const int o = (tid + i * NTHREADS) * 16; if (o < OPREC) *(u32x4*)(rec + o) = *(const LAS u32x4*)(lds + RK_IM + o); }
            const size_t go = (size_t)t0 * 64 + tid * 4;
            { const f32x4 a = *(const LAS f32x4*)(VV_ + tid * 4), c = *(const LAS f32x4*)(GG_ + tid * 4);
              u32x2 wa, wc; wa.x = cvtpk(a[0], a[1]); wa.y = cvtpk(a[2], a[3]); wc.x = cvtpk(c[0], c[1]); wc.y = cvtpk(c[2], c[3]);
              *(u32x2*)(gVS + go) = wa; *(u32x2*)(gGG + go) = wc; }
            if (tid < RCH) gBON[t0 + tid] = BON_[tid];
        }
    }
    asm volatile("s_waitcnt vmcnt(0)" ::: "memory");
    __syncthreads();
#undef RK_DMA
}

constexpr int CS_IN = 32768;
constexpr int CS_OP = 2 * CS_IN;
constexpr int CS_AT = 0, CS_RT = 4608, CS_BH = 9216, CS_KH = 13824, CS_BCT = 18432, CS_KCT = 23552, CS_VT = 28672, CS_P31 = 31744;
constexpr int CS_MT2 = CS_OP, CS_MT3 = CS_OP + 2560, CS_MT4 = CS_OP + 5120;
constexpr int CS_M1F = CS_OP + 7680;
constexpr int CS_XF = CS_OP + 12288;
constexpr int CS_UB = CS_OP + 16896;
constexpr int CS_SB = CS_OP + 19456;
constexpr int CS_YY = CS_OP + 24064;
constexpr int CS_END = CS_OP + 28160;
static_assert(CS_END <= LDS_BYTES - 64, "rwkv scan LDS map");
__device__ __forceinline__ int crow32(int r, int hi) { return (r & 3) + 8 * (r >> 2) + 4 * hi; }
__device__ __forceinline__ void rwkv_scan(const Params& p, LAS unsigned char* lds, int b, int h, int half) {
    const int tid = opaque_tid(), lane = tid & 63, wid = __builtin_amdgcn_readfirstlane(tid >> 6), r32 = lane & 31, hi = lane >> 5;
    const unsigned char* gOPS = p.ws + WS_OPS + (size_t)(b * 8 + h) * (SEQ / RCH) * OPREC;
    bf16_t* yraw = (bf16_t*)p.out + (size_t)b * SEQ * RW + h * 64 + half * 32;
#define RS_DMA(ch_, buf) do { LAS unsigned char* bb_ = lds + (buf) * CS_IN; const unsigned char* rec_ = gOPS + (size_t)(ch_) * OPREC; \
        for (int pc = wid; pc < 32; pc += NWAVES) { \
            const unsigned char* src_ = rec_ + (pc < 28 ? pc * 1024 : (pc < 31 ? OP_VT + half * 2560 + (pc - 28) * 1024 : OP_P31)) + lane * 16; \
            __builtin_amdgcn_global_load_lds((const unsigned*)src_, (LAS unsigned*)(bb_ + pc * 1024), 16, 0, 0); } } while (0)
    RS_DMA(0, 0);
    for (int i = tid; i < 4608 / 4; i += NTHREADS) ((LAS unsigned*)(lds + CS_SB))[i] = 0u;
    f32x16 Sacc = f32x16{};
    f32x16 Xacc = f32x16{};
    for (int ch = 0; ch < SEQ / RCH; ++ch) {
        const int t0 = ch * RCH, cur = ch & 1;
        if (wid < 4 && ch > 0) asm volatile("s_waitcnt vmcnt(1)" ::: "memory"); else asm volatile("s_waitcnt vmcnt(0)" ::: "memory");
        RK_BAR();
        if (ch + 1 < SEQ / RCH) RS_DMA(ch + 1, cur ^ 1);
        const LAS unsigned char* ib = lds + cur * CS_IN;
        if (wid < 4) {
            const LAS unsigned char* Am = ib + ((wid & 1) ? CS_KH : CS_BH) + r32 * 144 + hi * 16;
            const LAS unsigned char* Bm = ib + ((wid & 2) ? CS_RT : CS_AT) + r32 * 144 + hi * 16;
            f32x16 acc = f32x16{};
#pragma unroll
            for (int ks = 0; ks < 4; ++ks) acc = __builtin_amdgcn_mfma_f32_32x32x16_bf16(*(const LAS bf16x8*)(Am + ks * 32), *(const LAS bf16x8*)(Bm + ks * 32), acc, 0, 0, 0);
            const int lim = (wid < 2) ? r32 : r32 + 1;
#pragma unroll
            for (int rg = 0; rg < 16; ++rg) if (crow32(rg, hi) >= lim) acc[rg] = 0.f;
            if (wid == 0) {
#pragma unroll
                for (int rg = 0; rg < 16; ++rg) ((LAS float*)(lds + CS_M1F))[crow32(rg, hi) * 36 + r32] = acc[rg];
            } else {
                LAS unsigned char* Mt = lds + (wid == 1 ? CS_MT2 : (wid == 2 ? CS_MT3 : CS_MT4)) + r32 * 80 + hi * 8;
#pragma unroll
                for (int g = 0; g < 4; ++g) { u32x2 w; w.x = cvtpk(acc[4 * g], acc[4 * g + 1]); w.y = cvtpk(acc[4 * g + 2], acc[4 * g + 3]); *(LAS u32x2*)(Mt + g * 16) = w; }
            }
        } else if (wid < 6) {
            const LAS unsigned char* Am = ib + (wid == 4 ? CS_AT : CS_RT) + r32 * 144 + hi * 16;
            const LAS unsigned char* Bm = lds + CS_SB + r32 * 144 + hi * 16;
            Xacc = f32x16{};
#pragma unroll
            for (int ks = 0; ks < 4; ++ks) Xacc = __builtin_amdgcn_mfma_f32_32x32x16_bf16(*(const LAS bf16x8*)(Am + ks * 32), *(const LAS bf16x8*)(Bm + ks * 32), Xacc, 0, 0, 0);
        }
        RK_BAR();
        if (wid == 4) {
            const LAS unsigned char* Am = lds + CS_MT2 + r32 * 80 + hi * 16;
            const LAS unsigned char* Bm = ib + CS_VT + r32 * 80 + hi * 16;
#pragma unroll
            for (int ks = 0; ks < 2; ++ks) Xacc = __builtin_amdgcn_mfma_f32_32x32x16_bf16(*(const LAS bf16x8*)(Am + ks * 32), *(const LAS bf16x8*)(Bm + ks * 32), Xacc, 0, 0, 0);
#pragma unroll
            for (int g = 0; g < 4; ++g) *(LAS f32x4*)(lds + CS_XF + r32 * 144 + (8 * g + 4 * hi) * 4) = (f32x4){Xacc[4 * g], Xacc[4 * g + 1], Xacc[4 * g + 2], Xacc[4 * g + 3]};
        }
        RK_BAR();
        {
            const int v = tid >> 4, l = tid & 15;
            float m0[32], m1[32];
#pragma unroll
            for (int c4 = 0; c4 < 8; ++c4) { const f32x4 a = *(const LAS f32x4*)(lds + CS_M1F + l * 144 + c4 * 16), c = *(const LAS f32x4*)(lds + CS_M1F + (l + 16) * 144 + c4 * 16);
                m0[4 * c4] = a[0]; m0[4 * c4 + 1] = a[1]; m0[4 * c4 + 2] = a[2]; m0[4 * c4 + 3] = a[3]; m1[4 * c4] = c[0]; m1[4 * c4 + 1] = c[1]; m1[4 * c4 + 2] = c[2]; m1[4 * c4 + 3] = c[3]; }
            const float x0 = ((const LAS float*)(lds + CS_XF))[v * 36 + l], x1 = ((const LAS float*)(lds + CS_XF))[v * 36 + l + 16];
            float u0 = 0.f, u1 = 0.f;
#pragma unroll
            for (int i = 0; i < 32; ++i) {
                const float part = (i < 16) ? u0 * m0[i] : (u0 * m0[i] + u1 * m1[i]);
                const float tot = red16(part);
                if (i < 16) u0 = (l == i) ? x0 + tot : u0; else u1 = (l == i - 16) ? x1 + tot : u1;
            }
            const unsigned w = cvtpk(u0, u1);
            *(LAS unsigned short*)(lds + CS_UB + v * 80 + l * 2) = (unsigned short)(w & 0xffffu); *(LAS unsigned short*)(lds + CS_UB + v * 80 + (l + 16) * 2) = (unsigned short)(w >> 16);
        }
        RK_BAR();
        if (wid == 5) {
            const LAS unsigned char* A3 = lds + CS_MT3 + r32 * 80 + hi * 16; const LAS unsigned char* A4 = lds + CS_MT4 + r32 * 80 + hi * 16;
            const LAS unsigned char* Bu = lds + CS_UB + r32 * 80 + hi * 16; const LAS unsigned char* Bv = ib + CS_VT + r32 * 80 + hi * 16;
#pragma unroll
            for (int ks = 0; ks < 2; ++ks) { Xacc = __builtin_amdgcn_mfma_f32_32x32x16_bf16(*(const LAS bf16x8*)(A3 + ks * 32), *(const LAS bf16x8*)(Bu + ks * 32), Xacc, 0, 0, 0);
                Xacc = __builtin_amdgcn_mfma_f32_32x32x16_bf16(*(const LAS bf16x8*)(A4 + ks * 32), *(const LAS bf16x8*)(Bv + ks * 32), Xacc, 0, 0, 0); }
#pragma unroll
            for (int rg = 0; rg < 16; ++rg) ((LAS float*)(lds + CS_YY))[crow32(rg, hi) * 32 + r32] = Xacc[rg];
        } else if (wid < 2) {
#pragma unroll
            for (int g = 0; g < 4; ++g) { const f32x4 pv = *(const LAS f32x4*)(ib + CS_P31 + (32 * wid + 8 * g + 4 * hi) * 4);
                Sacc[4 * g] *= pv[0]; Sacc[4 * g + 1] *= pv[1]; Sacc[4 * g + 2] *= pv[2]; Sacc[4 * g + 3] *= pv[3]; }
            const LAS unsigned char* Ab = ib + CS_BCT + (32 * wid + r32) * 80 + hi * 16; const LAS unsigned char* Ak = ib + CS_KCT + (32 * wid + r32) * 80 + hi * 16;
            const LAS unsigned char* Bu = lds + CS_UB + r32 * 80 + hi * 16; const LAS unsigned char* Bv = ib + CS_VT + r32 * 80 + hi * 16;
#pragma unroll
            for (int ks = 0; ks < 2; ++ks) { Sacc = __builtin_amdgcn_mfma_f32_32x32x16_bf16(*(const LAS bf16x8*)(Ab + ks * 32), *(const LAS bf16x8*)(Bu + ks * 32), Sacc, 0, 0, 0);
                Sacc = __builtin_amdgcn_mfma_f32_32x32x16_bf16(*(const LAS bf16x8*)(Ak + ks * 32), *(const LAS bf16x8*)(Bv + ks * 32), Sacc, 0, 0, 0); }
#pragma unroll
            for (int g = 0; g < 4; ++g) { u32x2 w; w.x = cvtpk(Sacc[4 * g], Sacc[4 * g + 1]); w.y = cvtpk(Sacc[4 * g + 2], Sacc[4 * g + 3]); *(LAS u32x2*)(lds + CS_SB + r32 * 144 + (32 * wid + 8 * g + 4 * hi) * 2) = w; }
        }
        RK_BAR();
        if (tid < 256) { const int tk = tid >> 3, sub = tid & 7; const f32x4 yv = *(const LAS f32x4*)(lds + CS_YY + tk * 128 + sub * 16);
            u32x2 w; w.x = cvtpk(yv[0], yv[1]); w.y = cvtpk(yv[2], yv[3]); *(u32x2*)(yraw + (size_t)(t0 + tk) * RW + sub * 4) = w; }
    }
    asm volatile("s_waitcnt vmcnt(0)" ::: "memory");
    __syncthreads();
#undef RS_DMA
}
__device__ __forceinline__ void rwkv_finalize(const Params& p, int G) {
    const int tid = opaque_tid(), q16 = tid & 15;
    const bf16_t* yraw = (const bf16_t*)p.out; const bf16_t* gGG = (const bf16_t*)(p.out + (size_t)16 * 1024 * 1024); const bf16_t* gVS = (const bf16_t*)(p.ws + WS_VS); const float* gBON = (const float*)(p.ws + WS_BON);
    bf16_t* ymix = (bf16_t*)(p.ws + WS_YMIX);
    for (int item = (int)blockIdx.x * (NTHREADS / 16) + (tid >> 4); item < T * 8; item += G * (NTHREADS / 16)) {
        const int tok = item >> 3, h = item & 7, b = tok / SEQ, t = tok - b * SEQ;
        const u32x2 yw = *(const u32x2*)(yraw + (size_t)tok * RW + h * 64 + 4 * q16);
        const f32x4 y = (f32x4){__uint_as_float(yw.x << 16), __uint_as_float(yw.x & 0xffff0000u), __uint_as_float(yw.y << 16), __uint_as_float(yw.y & 0xffff0000u)};
        const size_t ho = ((size_t)(b * 8 + h) * SEQ + t) * 64 + 4 * q16;
        const u32x2 vw = *(const u32x2*)(gVS + ho), gw2 = *(const u32x2*)(gGG + ho);
        const f32x4 vv = (f32x4){__uint_as_float(vw.x << 16), __uint_as_float(vw.x & 0xffff0000u), __uint_as_float(vw.y << 16), __uint_as_float(vw.y & 0xffff0000u)};
        const f32x4 gg = (f32x4){__uint_as_float(gw2.x << 16), __uint_as_float(gw2.x & 0xffff0000u), __uint_as_float(gw2.y << 16), __uint_as_float(gw2.y & 0xffff0000u)};
        const float bon = gBON[(size_t)(b * 8 + h) * SEQ + t];
        const f32x4 gng = *(const f32x4*)(p.in[I_GNG] + h * 64 + 4 * q16), gnb = *(const f32x4*)(p.in[I_GNB] + h * 64 + 4 * q16);
        const float mean = red16((y[0] + y[1]) + (y[2] + y[3])) * (1.0f / 64.0f);
        const f32x4 dl = y - mean;
        const float var = red16((dl[0] * dl[0] + dl[1] * dl[1]) + (dl[2] * dl[2] + dl[3] * dl[3])) * (1.0f / 64.0f);
        const f32x4 yn = dl * __builtin_amdgcn_rsqf(var + GN_EPS) * gng + gnb;
        const f32x4 ov = (yn + vv * bon) * gg;
        u32x2 w; w.x = cvtpk(ov[0], ov[1]); w.y = cvtpk(ov[2], ov[3]);
        *(u32x2*)(ymix + (size_t)tok * D + h * 64 + 4 * q16) = w;
    }
}
#undef RK_BAR

constexpr int RT_X = 0;
constexpr int RT_LG = 131584;
constexpr int RT_GS = RT_LG + 16896;
constexpr int RT_RS = RT_GS + 8192;
constexpr int RT_HIST = RT_RS + 512;
constexpr int RT_CE = RT_HIST + 128;
static_assert(RT_CE + 1024 <= LDS_BYTES - 64, "router LDS map");
__device__ __forceinline__ int rt_swz(int k) { const int g = k >> 2; return ((g ^ ((g >> 4) & 3)) << 2) | (k & 3); }
__device__ __forceinline__ void phase_router(const Params& p, LAS unsigned char* lds, int G) {
    const int tid = opaque_tid(), lane = tid & 63, wave = __builtin_amdgcn_readfirstlane(tid >> 6);
    LAS float* xt = (LAS float*)(lds + RT_X); LAS float* lg = (LAS float*)(lds + RT_LG); LAS float* gs = (LAS float*)(lds + RT_GS); LAS float* shl = gs + 1024;
    LAS float* rsl = (LAS float*)(lds + RT_RS); LAS int* hist = (LAS int*)(lds + RT_HIST); LAS float* cew = (LAS float*)(lds + RT_CE);
    const float* rw = p.in[I_RTW];
    const float* x1 = p.out; const float* gain = p.in[I_N2G]; const float* mod = (const float*)(p.ws + WS_MOD); const float* rb = p.in[I_RTB];
    unsigned char* h2q = p.ws + WS_H;
    int* ridx = (int*)(p.ws + WS_ROUTE); float* rwt = (float*)(p.ws + WS_ROUTE + 512 * 1024);
    int* blockcnt = (int*)(p.ws + WS_CTL + 4096);
    const int TPB = T / G;
    const int blk = blockIdx.x, tok0 = blk * TPB, b = tok0 / SEQ;
    for (int k = tid; k < 1024; k += NTHREADS) { gs[rt_swz(k)] = gain[k] * (1.0f + mod[b * 6144 + 4096 + k]); shl[rt_swz(k)] = mod[b * 6144 + 3072 + k]; }
    if (tid < 32) hist[tid] = 0;
    __syncthreads();
    const int j = lane & 31, hh = lane >> 5, kb = 128 * wave + 64 * hh;
    float breg[64];
    { float cpart = 0.f;
#pragma unroll
        for (int s_ = 0; s_ < 64; ++s_) { const float w = rw[(size_t)(kb + s_) * 32 + j]; cpart += shl[rt_swz(kb + s_)] * w; breg[s_] = w * gs[rt_swz(kb + s_)]; }
        cpart += __shfl_xor(cpart, 32);
        if (lane < 32) cew[wave * 32 + lane] = cpart; }
    const int xsw = (2 * wave + hh) & 3;
    for (int t0 = 0; t0 < TPB; t0 += 128) {
        f32x4 v[16];
#define RT_LOAD(tl_) do { _Pragma("unroll") for (int q = 0; q < 4; ++q) { const int tq = t0 + 32 * (tl_) + 4 * wave + q; const f32x4* xr = (const f32x4*)(x1 + (size_t)(tok0 + (tq < TPB ? tq : 0)) * D) + lane; \
            _Pragma("unroll") for (int jj = 0; jj < 4; ++jj) v[4 * q + jj] = xr[64 * jj]; } } while (0)
        RT_LOAD(0);
#pragma unroll
        for (int tl = 0; tl < 4; ++tl) {
#pragma unroll
            for (int q = 0; q < 4; ++q) { float s = 0.f;
#pragma unroll
                for (int jj = 0; jj < 4; ++jj) { const f32x4 t = v[4 * q + jj]; s += (t[0] * t[0] + t[1] * t[1]) + (t[2] * t[2] + t[3] * t[3]); }
                const float rstd = rsqrtf(wave_sum(s) * (1.0f / D) + NORM_EPS);
                if (lane == 0) rsl[32 * tl + 4 * wave + q] = rstd;
#pragma unroll
                for (int jj = 0; jj < 4; ++jj) { const int g = lane + 64 * jj; *(LAS f32x4*)(xt + (4 * wave + q) * 1028 + 4 * (g ^ ((g >> 4) & 3))) = v[4 * q + jj]; } }
            __syncthreads();
            if (tl < 3) RT_LOAD(tl + 1);
            f32x16 acc = f32x16{};
            { const LAS float* arow = xt + (lane & 31) * 1028 + kb;
#pragma unroll
                for (int c = 0; c < 16; ++c) { const f32x4 a4 = *(const LAS f32x4*)(arow + 4 * (c ^ xsw));
                    acc = __builtin_amdgcn_mfma_f32_32x32x2f32(a4[0], breg[4 * c + 0], acc, 0, 0, 0);
                    acc = __builtin_amdgcn_mfma_f32_32x32x2f32(a4[1], breg[4 * c + 1], acc, 0, 0, 0);
                    acc = __builtin_amdgcn_mfma_f32_32x32x2f32(a4[2], breg[4 * c + 2], acc, 0, 0, 0);
                    acc = __builtin_amdgcn_mfma_f32_32x32x2f32(a4[3], breg[4 * c + 3], acc, 0, 0, 0); } }
            { const int hsw = (lane >> 2) & 3;
#pragma unroll
                for (int q = 0; q < 4; ++q) { const int tq = t0 + 32 * tl + 4 * wave + q; const float rstd = rsl[32 * tl + 4 * wave + q]; u32x4 o;
#pragma unroll
                    for (int u = 0; u < 4; ++u) { const int go = 4 * ((4 * lane + u) ^ hsw);
                        const f32x4 xv = *(const LAS f32x4*)(xt + (4 * wave + q) * 1028 + go), g4 = *(const LAS f32x4*)(gs + go), s4 = *(const LAS f32x4*)(shl + go);
                        const f32x4 y = (xv * rstd) * g4 + s4;
                        o[u] = cvt4_fp8(Q_H2 * y[0], Q_H2 * y[1], Q_H2 * y[2], Q_H2 * y[3]); }
                    if (tq < TPB) *(u32x4*)(h2q + (size_t)(tok0 + tq) * D + 16 * lane) = o; } }
            __syncthreads();
            { LAS float* part = (LAS float*)(lds + RT_X);
#pragma unroll
                for (int r = 0; r < 16; ++r) part[wave * 1024 + r * 64 + lane] = acc[r];
                __syncthreads();
                const int e = tid & 31; float ce = rb[e];
#pragma unroll
                for (int w = 0; w < 8; ++w) ce += cew[w * 32 + e];
#pragma unroll
                for (int q = 0; q < 2; ++q) { const int idx = tid + 512 * q; float sum = 0.f;
#pragma unroll
                    for (int w = 0; w < 8; ++w) sum += part[w * 1024 + idx];
                    const int r = idx >> 6, tk = 32 * tl + (r & 3) + 8 * (r >> 2) + 4 * ((idx >> 5) & 1);
                    lg[tk * 33 + e] = rsl[tk] * sum + ce; }
                __syncthreads(); }
        }
#undef RT_LOAD
        if (tid < 128 && t0 + tid < TPB) {
            const int row = tok0 + t0 + tid; const LAS float* lr = lg + tid * 33;
            float v0 = -INFINITY, v1 = -INFINITY, v2 = -INFINITY, v3 = -INFINITY; int i0 = 0, i1 = 0, i2 = 0, i3 = 0;
#pragma unroll
            for (int e = 0; e < 32; ++e) { const float x = lr[e];
                if (x > v0) { v3 = v2; i3 = i2; v2 = v1; i2 = i1; v1 = v0; i1 = i0; v0 = x; i0 = e; }
                else if (x > v1) { v3 = v2; i3 = i2; v2 = v1; i2 = i1; v1 = x; i1 = e; }
                else if (x > v2) { v3 = v2; i3 = i2; v2 = x; i2 = e; }
                else if (x > v3) { v3 = x; i3 = e; } }
            const float e1 = __expf(v1 - v0), e2 = __expf(v2 - v0), e3 = __expf(v3 - v0); const float inv = 1.0f / (1.0f + e1 + e2 + e3);
            *(int4*)(ridx + (size_t)row * 4) = make_int4(i0, i1, i2, i3); *(float4*)(rwt + (size_t)row * 4) = make_float4(inv, e1 * inv, e2 * inv, e3 * inv);
            atomicAdd((int*)&hist[i0], 1); atomicAdd((int*)&hist[i1], 1); atomicAdd((int*)&hist[i2], 1); atomicAdd((int*)&hist[i3], 1);
        }
        __syncthreads();
    }
    if (tid < 32) blockcnt[blk * 32 + tid] = hist[tid];
    __syncthreads();
}

__device__ __forceinline__ void phase_assign(const Params& p, LAS unsigned char* lds, int G) {
    const int tid = opaque_tid(), lane = tid & 63, wave = tid >> 6;
    LAS int* part = (LAS int*)lds;
    LAS int* partb = part + 512;
    LAS int* total = partb + 512;
    LAS int* base = total + 32;
    LAS int* segst = base + 32;
    LAS int* cursor = segst + 32;
    LAS int* slotl = cursor + 32;
    const int* blockcnt = (const int*)(p.ws + WS_CTL + 4096);
    const int* ridx = (const int*)(p.ws + WS_ROUTE); int* rslot = (int*)(p.ws + WS_ROUTE + 1024 * 1024); int* tokmap = (int*)(p.ws + WS_ROUTE + 2 * 1024 * 1024);
    const bf16_t* h2 = (const bf16_t*)(p.ws + WS_H); bf16_t* xs = (bf16_t*)(p.ws + WS_PROJ);
    int* tile = (int*)(p.ws + WS_TILE);
    const int TPB = T / G; const int blk = blockIdx.x;
    { const int e = tid & 31, part_i = tid >> 5; int st = 0, sb = 0;
        for (int bb = part_i; bb < G; bb += 16) { const int c = blockcnt[bb * 32 + e]; st += c; if (bb < blk) sb += c; }
        part[part_i * 32 + e] = st; partb[part_i * 32 + e] = sb; }
    __syncthreads();
    if (tid < 32) { int st = 0, sb = 0;
#pragma unroll
        for (int i = 0; i < 16; ++i) { st += part[i * 32 + tid]; sb += partb[i * 32 + tid]; }
        total[tid] = st; base[tid] = sb; cursor[tid] = 0; }
    __syncthreads();
    if (tid == 0) { int acc = 0; for (int e = 0; e < 32; ++e) { segst[e] = acc; acc += (total[e] + 255) & ~255; }
        if (blk == 0) { int pm = 0; for (int e = 0; e < 32; ++e) { const int nt = (total[e] + 255) >> 8; for (int i = 0; i < nt; ++i) tile[16 + pm + i] = e; pm += nt; } tile[0] = pm; } }
    __syncthreads();
    if (tid < 32) base[tid] += segst[tid];
    __syncthreads();
    for (int a = tid; a < TPB * 4; a += NTHREADS) { const int tok = blk * TPB + (a >> 2); const int e = ridx[(size_t)tok * 4 + (a & 3)];
        const int rank = atomicAdd((int*)&cursor[e], 1); const int slot = base[e] + rank; rslot[(size_t)tok * 4 + (a & 3)] = slot; tokmap[slot] = tok; }
    for (int e = blk; e < 32; e += G) { const int s0 = segst[e] + total[e], s1 = segst[e] + ((total[e] + 255) & ~255);
        for (int r = s0 + tid; r < s1; r += NTHREADS) tokmap[r] = 0; }
}

__device__ __forceinline__ void phase_final(const Params& p, int G, int stage) {
    const int tid = opaque_tid(), lane = tid & 63, wave = tid >> 6;
    const int gw = (int)blockIdx.x * NWAVES + wave, NGW = G * NWAVES;
    const float* fg = p.in[I_FG]; const float* mod = (const float*)(p.ws + WS_MOD);
    const int* rslot = (const int*)(p.ws + WS_ROUTE + 1024 * 1024); const float* rwt = (const float*)(p.ws + WS_ROUTE + 512 * 1024);
    const bf16_t* Y = (const bf16_t*)(p.ws + WS_PROJ);
    const float* src = (stage >= 4) ? p.out : p.in[I_X];
    for (int row = gw; row < T; row += NGW) {
        const int b = row / SEQ;
        const f32x4* xr = (const f32x4*)(src + (size_t)row * D) + lane;
        f32x4 v[4];
#pragma unroll
        for (int j = 0; j < 4; ++j) v[j] = xr[64 * j];
        if (stage >= 9) {
            const int4 sl = *(const int4*)(rslot + (size_t)row * 4); const float4 wt = *(const float4*)(rwt + (size_t)row * 4);
            const float* g2 = mod + b * 6144 + 5120;
            const int sls[4] = {sl.x, sl.y, sl.z, sl.w}; const float wts[4] = {wt.x, wt.y, wt.z, wt.w};
#pragma unroll
            for (int j = 0; j < 4; ++j) { f32x4 m = (f32x4){0.f, 0.f, 0.f, 0.f};
#pragma unroll
                for (int k = 0; k < 4; ++k) { const u32x2 yv = *((const u32x2*)(Y + (size_t)sls[k] * D) + lane + 64 * j);
                    m[0] += wts[k] * __uint_as_float(yv.x << 16); m[1] += wts[k] * __uint_as_float(yv.x & 0xffff0000u); m[2] += wts[k] * __uint_as_float(yv.y << 16); m[3] += wts[k] * __uint_as_float(yv.y & 0xffff0000u); }
                const f32x4 g = *(const f32x4*)(g2 + 4 * lane + 256 * j); v[j] = v[j] + g * m; }
        }
        float s = 0.f;
#pragma unroll
        for (int j = 0; j < 4; ++j) s += (v[j][0] * v[j][0] + v[j][1] * v[j][1]) + (v[j][2] * v[j][2] + v[j][3] * v[j][3]);
        const float rstd = rsqrtf(wave_sum(s) * (1.0f / D) + NORM_EPS);
        f32x4* orow = (f32x4*)(p.out + (size_t)row * D) + lane;
#pragma unroll
        for (int j = 0; j < 4; ++j) { const f32x4 g = *(const f32x4*)(fg + 4 * lane + 256 * j); orow[64 * j] = v[j] * rstd * g; }
    }
}


#define XB_TMO      128
#define XB_XCNT(j)  (256  + 64 * (j))
#define XB_XSUB(j)  (1280 + 64 * (j))
#define XB_XGEN(j)  (2304 + 64 * (j))
#define XB_TOP      3328
#define XB_TOPGEN   3392
#define XCD_BAR_WORDS 3456
#define XB_SPIN_CAP (1u << 22)
__device__ __forceinline__ unsigned xb_ld(unsigned* p)              { return __hip_atomic_load(p, __ATOMIC_RELAXED, __HIP_MEMORY_SCOPE_AGENT); }
__device__ __forceinline__ unsigned xb_add(unsigned* p, unsigned v) { return __hip_atomic_fetch_add(p, v, __ATOMIC_RELAXED, __HIP_MEMORY_SCOPE_AGENT); }
__device__ __forceinline__ unsigned xb_xcc_id() { return (unsigned)__builtin_amdgcn_s_getreg((3 << 11) | 20) & 0xFu; }
#define XB_SPIN(cond, bar) do { unsigned _sp = 0; while (cond) { __builtin_amdgcn_s_sleep(1); \
    if ((++_sp & 255u) == 0u) { if (xb_ld(&(bar)[XB_TMO])) break; if (_sp > XB_SPIN_CAP) { atomicAdd(&(bar)[XB_TMO], 1u); break; } } } } while (0)
struct XcdBarrier { unsigned* bar; unsigned x; volatile LAS unsigned* st; };
__device__ __forceinline__ XcdBarrier xcd_barrier_post(unsigned* bar, volatile LAS unsigned* st) {
    XcdBarrier b; b.bar = bar; b.x = xb_xcc_id(); b.st = st;
    if (threadIdx.x == 0) (void)xb_add(&bar[XB_XCNT(b.x)], 1u);
    return b;
}
__device__ __forceinline__ void xcd_barrier_complete(unsigned* bar, unsigned x, unsigned& nloc, unsigned& nx) {
    const unsigned G = gridDim.x * gridDim.y * gridDim.z;
    unsigned sum, cnt, mine, sp = 0u;
    for (;;) {
        sum = 0u; cnt = 0u; mine = 0u;
#pragma unroll
        for (unsigned j = 0; j < 16; ++j) { const unsigned c = xb_ld(&bar[XB_XCNT(j)]); sum += c; cnt += (c > 0u) ? 1u : 0u; mine = (j == x) ? c : mine; }
        if (sum == G) break;
        __builtin_amdgcn_s_sleep(1);
        if ((++sp & 255u) == 0u) { if (xb_ld(&bar[XB_TMO])) break; if (sp > XB_SPIN_CAP) { atomicAdd(&bar[XB_TMO], 1u); break; } }
    }
    nloc = mine > 0u ? mine : 1u; nx = cnt > 0u ? cnt : 1u;
}
__device__ __forceinline__ void xcd_barrier(const XcdBarrier& b) {
    asm volatile("s_waitcnt vmcnt(0)" ::: "memory");
    __syncthreads();
    if (threadIdx.x == 0) {
        unsigned* bar = b.bar;
        __builtin_amdgcn_s_waitcnt(0);
        unsigned nloc = b.st[0], nx = b.st[1];
        if (nloc == 0u) { xcd_barrier_complete(bar, b.x, nloc, nx); b.st[0] = nloc; b.st[1] = nx; }
        const unsigned old = xb_add(&bar[XB_XSUB(b.x)], 1u);
        const unsigned gen = old / nloc;
        if (old + 1u == (gen + 1u) * nloc) {
            __builtin_amdgcn_fence(__ATOMIC_RELEASE, "agent");
            asm volatile("s_waitcnt vmcnt(0)" ::: "memory");
            const unsigned og = xb_add(&bar[XB_TOP], 1u);
            const unsigned tg = og / nx;
            if (og + 1u == (tg + 1u) * nx) xb_add(&bar[XB_TOPGEN], 1u);
            else XB_SPIN(xb_ld(&bar[XB_TOPGEN]) == tg, bar);
            __builtin_amdgcn_fence(__ATOMIC_ACQUIRE, "agent");
            xb_add(&bar[XB_XGEN(b.x)], 1u);
            asm volatile("s_waitcnt vmcnt(0)" ::: "memory");
        } else {
            XB_SPIN(xb_ld(&bar[XB_XGEN(b.x)]) == gen, bar);
            __builtin_amdgcn_fence(__ATOMIC_ACQUIRE, "agent");
            asm volatile("s_waitcnt vmcnt(0)" ::: "memory");
        }
    }
    __syncthreads();
}

__device__ __forceinline__ const Params* launder_params(const Params* q) { asm volatile("" : "+s"(q)); return q; }
__global__ void __launch_bounds__(NTHREADS, 2) hymba_fwd(Params p) {
    extern __shared__ __attribute__((aligned(16))) unsigned char lds_raw[];
    cg::grid_group grid = cg::this_grid();
    LAS unsigned char* lds = (LAS unsigned char*)lds_raw;
    const int G = gridDim.x, tid = threadIdx.x;
    constexpr int STAGE = DBG_STAGE;
    volatile LAS unsigned* xst = (volatile LAS unsigned*)(lds + LDS_BYTES - 64);
    if (tid == 0) { xst[0] = 0u; xst[1] = 0u; }
    __syncthreads();
    const XcdBarrier xbar = xcd_barrier_post((unsigned*)(p.ws + WS_CTL + 40960), xst);
#define GRID_BAR() xcd_barrier(xbar)

    phase_mod(p, lds_raw, G);
    if (G == 0x7fffffff) grid.sync();
    GRID_BAR();
    if (STAGE >= 2) { phase_norm1(p, G); phase_convert(p, lds_raw, G, 0); GRID_BAR(); }
    if (STAGE >= 2) {
        pg8::Gemm g{(const bf16_t*)(p.ws + WS_H), (const bf16_t*)(p.ws + WS_WIN_T), D / 2, nullptr};
        pg8::DenseSched S; S.o.init(T / 256, IC / 256, G, (int)blockIdx.x);
        EpiInProj E{(bf16_t*)(p.ws + WS_PROJ)};
        pg8::gemm_phase<false, true>(lds, g, S, E);
        GRID_BAR();
    }
    if (STAGE >= 3) {
        kmax_pass(p, G);
        for (int it = blockIdx.x; it < NB * 8 * 4; it += G) rwkv_prep(p, lds, it >> 5, (it >> 2) & 7, (it & 3) * 32, (it & 3) * 32 + 32);
        GRID_BAR();
    }
    if (STAGE >= 2) {
        if (STAGE >= 3) { for (int u = blockIdx.x; u < NB * 8 * 2; u += G) rwkv_scan(p, lds, u >> 4, (u >> 1) & 7, u & 1); }
        else {
            bf16_t* ymix = (bf16_t*)(p.ws + WS_YMIX);
            for (size_t i = (size_t)blockIdx.x * NTHREADS + tid; i < (size_t)T * 64; i += (size_t)G * NTHREADS) { const size_t row = i >> 6, c = i & 63; *(u32x4*)(ymix + row * D + c * 8) = (u32x4){0u, 0u, 0u, 0u}; }
        }
        float lam;
        { const float* q1 = p.in[I_LQ1]; const float* k1 = p.in[I_LK1]; const float* q2 = p.in[I_LQ2]; const float* k2 = p.in[I_LK2]; float s1 = 0.f, s2 = 0.f;
            for (int i = 0; i < 64; ++i) { s1 += q1[i] * k1[i]; s2 += q2[i] * k2[i]; } lam = expf(s1) - expf(s2) + LAMBDA_INIT; }
        unsigned* qhead = (unsigned*)(p.ws + WS_CTL);
        LAS unsigned* ubox = (LAS unsigned*)(lds + 4 * ATT_BUF);
        for (;;) {
            __syncthreads();
            if (tid == 0) ubox[0] = atomicAdd(qhead, 1u);
            __syncthreads();
            const unsigned u = (unsigned)__builtin_amdgcn_readfirstlane((int)ubox[0]);
            if (u >= (unsigned)ATT_UNITS) break;
            attn_unit(p, lds, (int)(u & 31u) >> 2, (int)(u & 3u), ATT_NQB - 1 - (int)(u >> 5), lam);
        }
        GRID_BAR();
        if (STAGE >= 3) { rwkv_finalize(p, G); GRID_BAR(); }
    }
    if (STAGE >= 2) {
        pg8::Gemm g{(const bf16_t*)(p.ws + WS_YMIX), (const bf16_t*)(p.ws + WS_WOUT_T), D, nullptr};
        pg8::DenseSched S; S.o.init(T / 256, D / 256, G, (int)blockIdx.x);
        EpiOutProj E{p.in[I_X], (const float*)(p.ws + WS_MOD), p.out};
        pg8::gemm_phase<false, false>(lds, g, S, E);
        GRID_BAR();
    }
    if (STAGE >= 9) {
        phase_router(p, lds, G);
        GRID_BAR();
        phase_assign(p, lds, G);
        __syncthreads();
        phase_convert(p, lds_raw, G, 1);
        GRID_BAR();
        const int* tile = (const int*)(p.ws + WS_TILE);
        const int MT = tile[0];
        {
            pg8::Gemm g{(const bf16_t*)(p.ws + WS_H), (const bf16_t*)(p.ws + WS_WG_T), D / 2, (const int*)(p.ws + WS_ROUTE + 2 * 1024 * 1024)};
            pg8::MoeSched S; S.o.init(MT, 8, G, (int)blockIdx.x); S.tile_e = tile + 16; S.N = 2048;
            EpiMoe1 E{p.in[I_BGU], p.ws + WS_ACT};
            pg8::gemm_phase<true, true>(lds, g, S, E);
        }
        GRID_BAR();
        {
            pg8::Gemm g{(const bf16_t*)(p.ws + WS_ACT), (const bf16_t*)(p.ws + WS_WD_T), D / 2, nullptr};
            pg8::MoeSched S; S.o.init(MT, 4, G, (int)blockIdx.x); S.tile_e = tile + 16; S.N = 1024;
            EpiMoe2 E{p.in[I_BDN], (bf16_t*)(p.ws + WS_PROJ)};
            pg8::gemm_phase<false, true>(lds, g, S, E);
        }
        GRID_BAR();
    }
    phase_final(p, G, STAGE >= 9 ? 9 : (STAGE >= 2 ? 4 : 0));
}

extern "C" void kernel_launch(void* const* d_in, const int* in_sizes, int n_in, void* d_out, int out_size, void* d_ws, size_t ws_size, hipStream_t stream) {
    static int grid = 0;
    if (grid == 0) {
        if (n_in != 31 || out_size != T * D || ws_size < WS_END) { fprintf(stderr, "kernel_launch: unexpected shapes (n_in %d out %d ws %zu)\n", n_in, out_size, ws_size); grid = -1; return; }
        int dev = 0, cus = 0, per_cu = 0;
        hipGetDevice(&dev);
        hipDeviceGetAttribute(&cus, hipDeviceAttributeMultiprocessorCount, dev);
        hipFuncSetAttribute((const void*)hymba_fwd, hipFuncAttributeMaxDynamicSharedMemorySize, LDS_BYTES);
        hipOccupancyMaxActiveBlocksPerMultiprocessor(&per_cu, (const void*)hymba_fwd, NTHREADS, LDS_BYTES);
        if (per_cu < 1) { fprintf(stderr, "kernel_launch: occupancy query returned %d\n", per_cu); grid = -1; return; }
        grid = cus;
        if (grid > 256) grid = 256;
        while (T % grid != 0) --grid;
        (void)hipGetLastError();
    }
    if (grid < 0) return;
    hipMemsetAsync((char*)d_ws + WS_CTL, 0, CTL_BYTES, stream);
    Params p{};
    for (int i = 0; i < 31; ++i) p.in[i] = (const float*)d_in[i];
    p.out = (float*)d_out; p.ws = (unsigned char*)d_ws;
    void* args[] = {&p};
    hipError_t e = hipLaunchCooperativeKernel((const void*)hymba_fwd, dim3(grid), dim3(NTHREADS), args, LDS_BYTES, stream);
    if (e != hipSuccess) fprintf(stderr, "cooperative launch failed: %s (grid %d)\n", hipGetErrorString(e), grid);
}
```

```cpp
#include <hip/hip_runtime.h>
#include <hip/hip_cooperative_groups.h>
#include <cstdio>
#include <cstdint>
namespace cg = cooperative_groups;

#ifndef DBG_STAGE
#define DBG_STAGE 99
#endif

#define LAS __attribute__((address_space(3)))
typedef unsigned short bf16_t;
typedef short bf16x8 __attribute__((ext_vector_type(8)));
typedef short s16x4 __attribute__((ext_vector_type(4)));
typedef float f32x4 __attribute__((ext_vector_type(4)));
typedef float f32x16 __attribute__((ext_vector_type(16)));
typedef float f32x2_t __attribute__((ext_vector_type(2)));
typedef __bf16 bf16x2_t __attribute__((ext_vector_type(2)));
typedef unsigned u32x4 __attribute__((ext_vector_type(4)));
typedef unsigned u32x2 __attribute__((ext_vector_type(2)));

constexpr int D = 1024, NB = 8, SEQ = 4096, T = NB * SEQ;
constexpr int RW = 512, RC = 1792, DC = 1536, IC = 3328;
constexpr int NE = 32, TOPK = 4, NA = T * TOPK;
constexpr int PMAX = NA + NE * 256;
constexpr float NORM_EPS = 1e-5f, GN_EPS = 64e-5f;
constexpr float LOG2E = 1.4426950408889634f;
constexpr float QSCALE = 0.125f * LOG2E;
constexpr float LAMBDA_INIT = 0.2f;
constexpr int NTHREADS = 512, NWAVES = 8;
constexpr int LDS_BYTES = 163840;

constexpr size_t MiB = 1u << 20;
constexpr size_t WS_CTL = 0;
constexpr size_t CTL_BYTES = 65536;
constexpr size_t WS_MOD = 1 * MiB;
constexpr size_t WS_TILE = 1 * MiB + 512 * 1024;
constexpr size_t WS_WIN_T = 2 * MiB;
constexpr size_t WS_WOUT_T = 9 * MiB;
constexpr size_t WS_ROUTE = 11 * MiB;
constexpr size_t WS_WG_T = 16 * MiB;
constexpr size_t WS_WD_T = 144 * MiB;
constexpr size_t WS_H = 208 * MiB;
constexpr size_t WS_YMIX = 272 * MiB;
constexpr size_t WS_PROJ = 336 * MiB;
constexpr size_t WS_ACT = 608 * MiB;
constexpr size_t WS_END = 1008 * MiB;
constexpr int OPREC = 34816;
constexpr int OP_AT = 0, OP_RT = 4608, OP_BH = 9216, OP_KH = 13824, OP_BCT = 18432, OP_KCT = 23552, OP_VT = 28672, OP_P31 = 33792;
constexpr size_t WS_OPS = WS_ACT;
constexpr size_t WS_VS = 944 * MiB;
constexpr size_t WS_X1 = WS_VS;
constexpr size_t WS_BON = WS_H;

__device__ __forceinline__ unsigned cvtpk(float lo, float hi) { f32x2_t v = {lo, hi}; bf16x2_t b = __builtin_convertvector(v, bf16x2_t); return __builtin_bit_cast(unsigned, b); }
__device__ __forceinline__ float bf2f(unsigned short u) { return __uint_as_float(((unsigned)u) << 16); }
__device__ __forceinline__ float wave_sum(float v) {
#pragma unroll
    for (int o = 1; o < 64; o <<= 1) v += __shfl_xor(v, o);
    return v;
}
__device__ __forceinline__ float wave_max(float v) {
#pragma unroll
    for (int o = 1; o < 64; o <<= 1) v = fmaxf(v, __shfl_xor(v, o));
    return v;
}
__device__ __forceinline__ int opaque_tid() { int t = (int)threadIdx.x; asm volatile("" : "+v"(t)); return t; }
__device__ __forceinline__ float sigmoidf_(float x) { return __builtin_amdgcn_rcpf(1.0f + __expf(-x)); }
__device__ __forceinline__ float tanh_fast(float x) { return 1.0f - 2.0f * __builtin_amdgcn_rcpf(1.0f + __expf(2.0f * x)); }

struct Params {
    const float* in[31];
    float* out;
    unsigned char* ws;
};
enum { I_X = 0, I_C, I_MODW, I_MODB, I_N1G, I_WIN, I_MU, I_W0, I_WUP, I_A0, I_AUP, I_GUP, I_KK, I_KA, I_RK, I_GNG, I_GNB, I_LQ1, I_LK1, I_LQ2, I_LK2, I_SUBLN, I_WOUT, I_N2G, I_RTW, I_RTB, I_WGU, I_BGU, I_WDN, I_BDN, I_FG };

namespace pg8 {
constexpr int BM = 256, BK = 64, HALF = 128, HTB = HALF * BK * 2, STAGE_BYTES = 8 * HTB, NXCD = 8, WGM = 8;
__host__ __device__ __forceinline__ int lds_byte(int r, int c) { const int st = (r >> 4) * 2 + (c >> 5), rr = r & 15, cc = c & 31, ob = rr * 64 + cc * 2; return st * 1024 + (ob ^ (((ob >> 9) & 1) << 5)); }
__host__ __device__ __forceinline__ void stage_rc(int b, int& R, int& C) { const int st = b / 1024, sb = b % 1024, swz = sb ^ (((sb >> 9) & 1) << 5); R = (st >> 1) * 16 + swz / 64; C = (st & 1) * 32 + (swz % 64) / 2; }
__host__ __device__ __forceinline__ int perm32(int rho) { const int n = rho >> 4, i = rho & 15; return 8 * (i >> 2) + 4 * n + (i & 3); }

struct Unit { int pm, pn, arow, brow, e; };
struct Gemm { const bf16_t* A; const bf16_t* Bt; int K; const int* rowmap; };

struct TileOrder {
    int nM, nN, nwg, G, c;
    __device__ void init(int nM_, int nN_, int G_, int c_) { nM = nM_; nN = nN_; nwg = nM * nN; G = G_; c = c_; }
    __device__ bool map(int i, int& pm, int& pn) const {
        const long L = (long)i * G + c; if (L >= nwg) return false;
        int wgid = (int)L; { const int q = nwg / NXCD, r = nwg % NXCD, xcd = wgid % NXCD, off = wgid / NXCD; wgid = (xcd < r ? xcd * (q + 1) : r * (q + 1) + (xcd - r) * q) + off; }
        const int nig = WGM * nN, gid = wgid / nig, fm = gid * WGM, gsz = (nM - fm) < WGM ? (nM - fm) : WGM;
        pm = fm + ((wgid % nig) % gsz); pn = (wgid % nig) / gsz; return true;
    }
};
struct DenseSched {
    TileOrder o;
    __device__ bool next(int i, Unit& u) const { int pm, pn; if (!o.map(i, pm, pn)) return false; u.pm = pm; u.pn = pn; u.arow = pm * BM; u.brow = pn * BM; u.e = 0; return true; }
};
struct MoeSched {
    TileOrder o; const LAS int* tile_e; int N;
    __device__ bool next(int i, Unit& u) const { int pm, pn; if (!o.map(i, pm, pn)) return false; const int e = tile_e[pm]; u.pm = pm; u.pn = pn; u.arow = pm * BM; u.brow = e * N + pn * BM; u.e = e; return true; }
};

typedef int v4i_t __attribute__((ext_vector_type(4)));
typedef int v8i_t __attribute__((ext_vector_type(8)));
__device__ __forceinline__ v8i_t cat8(bf16x8 a, bf16x8 b) { return __builtin_shufflevector(__builtin_bit_cast(v4i_t, a), __builtin_bit_cast(v4i_t, b), 0, 1, 2, 3, 4, 5, 6, 7); }
__device__ __forceinline__ void mfma_fp8_tied(f32x4& acc, v8i_t a, v8i_t b) { asm volatile("v_mfma_f32_16x16x128_f8f6f4 %0, %1, %2, %0" : "+v"(acc) : "v"(a), "v"(b)); }
template <bool GATHER, bool FP8, class Epi, class Sched>
__device__ __forceinline__ void gemm_phase(LAS unsigned char* lds, const Gemm g, const Sched& S, const Epi& E) {
    const int tid = opaque_tid(), wid = __builtin_amdgcn_readfirstlane(tid >> 6), lane = tid & 63, wr = wid >> 2, wc = wid & 3, fr = lane & 15, fq = lane >> 4;
    const int K = g.K, nt = K / BK;
    unsigned voffA[2], voffB[2]; int rowA[2], colA2[2];
#pragma unroll
    for (int i = 0; i < 2; ++i) { int R, C; stage_rc(tid * 16 + i * 8192, R, C); const int Rb = (R & ~31) + perm32(R & 31);
        voffA[i] = (unsigned)(R * K + C) * 2u; voffB[i] = (unsigned)(Rb * K + C) * 2u; rowA[i] = R; colA2[i] = C * 2; }
    unsigned gv0[2] = {0u, 0u}, gv1[2] = {0u, 0u}, gn0[2] = {0u, 0u}, gn1[2] = {0u, 0u};
#define PG8_GOFF(u_, o0, o1) do { _Pragma("unroll") for (int _i = 0; _i < 2; ++_i) { o0[_i] = (unsigned)g.rowmap[(u_).arow + rowA[_i]] * (unsigned)(K * 2) + (unsigned)colA2[_i]; o1[_i] = (unsigned)g.rowmap[(u_).arow + HALF + rowA[_i]] * (unsigned)(K * 2) + (unsigned)colA2[_i]; } } while (0)
#define PG8_STAGE_A(bufoff, kptr, half) do { if constexpr (GATHER) { if (half) PG8_STAGE(bufoff, kptr, gv1); else PG8_STAGE(bufoff, kptr, gv0); } else PG8_STAGE(bufoff, (kptr) + ((half) ? hstep : 0), voffA); } while (0)
    const size_t kstep = (size_t)(BK * 2);
    const size_t hstep = (size_t)HALF * K * 2;
    const size_t rowb = (size_t)K * 2;
    const unsigned ldsw = (unsigned)wid * 1024u;
    const int aoff = lds_byte(wr * 64 + fr, fq * 8), boff = lds_byte(wc * 32 + fr, fq * 8);
#define PG8_SA(b, h) (((b) * 2 + (h)) * HTB)
#define PG8_SB(b, h) ((4 + (b) * 2 + (h)) * HTB)
#define PG8_STAGE(bufoff, gbase, voff) do { _Pragma("unroll") for (int _i = 0; _i < 2; ++_i) \
        __builtin_amdgcn_global_load_lds((const unsigned*)((const char*)(gbase) + (voff)[_i]), (LAS unsigned*)(lds + (bufoff) + ldsw + _i * 8192), 16, 0, 0); } while (0)
#define PG8_LDA(dst, b, h) do { _Pragma("unroll") for (int m = 0; m < 4; ++m) _Pragma("unroll") for (int k = 0; k < 2; ++k) dst[m][k] = *(const LAS bf16x8*)(lds + PG8_SA(b, h) + aoff + m * 2048 + k * 1024); } while (0)
#define PG8_LDB(dst, b, h) do { _Pragma("unroll") for (int n = 0; n < 2; ++n) _Pragma("unroll") for (int k = 0; k < 2; ++k) dst[n][k] = *(const LAS bf16x8*)(lds + PG8_SB(b, h) + boff + n * 2048 + k * 1024); } while (0)
#define PG8_MMA(ai, bj, At, Bt) do { __builtin_amdgcn_s_setprio(1); _Pragma("unroll") for (int m = 0; m < 4; ++m) _Pragma("unroll") for (int n = 0; n < 2; ++n) { \
        if constexpr (FP8) mfma_fp8_tied(acc[ai][bj][m][n], cat8(Bt[n][0], Bt[n][1]), cat8(At[m][0], At[m][1])); \
        else { _Pragma("unroll") for (int k = 0; k < 2; ++k) acc[ai][bj][m][n] = __builtin_amdgcn_mfma_f32_16x16x32_bf16(Bt[n][k], At[m][k], acc[ai][bj][m][n], 0, 0, 0); } } __builtin_amdgcn_s_setprio(0); } while (0)
#define PG8_WAIT_V(n) asm volatile("s_waitcnt vmcnt(" #n ")" ::: "memory")
#define PG8_WAIT_L(n) asm volatile("s_waitcnt lgkmcnt(" #n ")" ::: "memory")
#define PG8_BAR __builtin_amdgcn_s_barrier()
#define PG8_SCHED __builtin_amdgcn_sched_barrier(0)
    Unit cur, nxt; int ui = 0;
    if (!S.next(0, cur)) return;
    f32x4 acc[2][2][4][2];
#pragma unroll
    for (int a = 0; a < 2; ++a)
#pragma unroll
        for (int b = 0; b < 2; ++b)
#pragma unroll
            for (int m = 0; m < 4; ++m)
#pragma unroll
                for (int n = 0; n < 2; ++n) acc[a][b][m][n] = (f32x4){0.f, 0.f, 0.f, 0.f};
    bf16x8 At[4][2], B0[2][2], B1[2][2];
    const char* cA = GATHER ? (const char*)g.A : (const char*)g.A + (size_t)cur.arow * rowb; const char* cB = (const char*)g.Bt + (size_t)cur.brow * rowb;
    if constexpr (GATHER) PG8_GOFF(cur, gv0, gv1);
    PG8_STAGE(PG8_SB(0, 0), cB, voffB); PG8_STAGE(PG8_SB(0, 1), cB + hstep, voffB); PG8_STAGE_A(PG8_SA(0, 0), cA, 0); PG8_STAGE_A(PG8_SA(0, 1), cA, 1);
    if (wr == 1) PG8_BAR;
    PG8_WAIT_V(2); PG8_BAR;
    PG8_STAGE(PG8_SB(1, 0), cB + kstep, voffB); PG8_STAGE_A(PG8_SA(1, 0), cA + kstep, 0); PG8_STAGE(PG8_SB(1, 1), cB + hstep + kstep, voffB);
    PG8_WAIT_V(6); PG8_BAR;
    for (;;) {
        const bool has_next = S.next(ui + 1, nxt);
        const char* nA = GATHER ? (const char*)g.A : (has_next ? (const char*)g.A + (size_t)nxt.arow * rowb : cA); const char* nB = has_next ? (const char*)g.Bt + (size_t)nxt.brow * rowb : cB;

        for (int t = 0; t < nt; t += 2) {
            const bool last = (t == nt - 2);
            if constexpr (GATHER) { if (t == nt - 4) { if (has_next) PG8_GOFF(nxt, gn0, gn1); else { gn0[0] = gv0[0]; gn0[1] = gv0[1]; gn1[0] = gv1[0]; gn1[1] = gv1[1]; } } }
            const char* a1 = cA + (size_t)(t + 1) * kstep;
            const char* a2 = last ? nA : cA + (size_t)(t + 2) * kstep; const char* b2 = last ? nB : cB + (size_t)(t + 2) * kstep;
            const char* a3 = a2 + kstep; const char* b3 = b2 + kstep;
            PG8_LDB(B0, 0, 0); PG8_LDB(B1, 0, 1); PG8_SCHED; PG8_LDA(At, 0, 0); PG8_STAGE_A(PG8_SA(1, 1), a1, 1);
            if constexpr (GATHER) { if (last) { gv0[0] = gn0[0]; gv0[1] = gn0[1]; gv1[0] = gn1[0]; gv1[1] = gn1[1]; } }
            PG8_WAIT_V(8); PG8_WAIT_L(0); PG8_BAR; PG8_MMA(0, 0, At, B0); PG8_MMA(0, 1, At, B1); PG8_BAR; PG8_SCHED;
            PG8_LDA(At, 0, 1); PG8_STAGE(PG8_SB(0, 0), b2, voffB); PG8_STAGE(PG8_SB(0, 1), b2 + hstep, voffB); PG8_STAGE_A(PG8_SA(0, 0), a2, 0);
            PG8_WAIT_V(8); PG8_WAIT_L(0); PG8_BAR; PG8_MMA(1, 0, At, B0); PG8_MMA(1, 1, At, B1); PG8_BAR; PG8_SCHED;
            PG8_LDB(B0, 1, 0); PG8_LDB(B1, 1, 1); PG8_SCHED; PG8_LDA(At, 1, 0); PG8_STAGE_A(PG8_SA(0, 1), a2, 1);
            PG8_WAIT_V(8); PG8_WAIT_L(0); PG8_BAR; PG8_MMA(0, 0, At, B0); PG8_MMA(0, 1, At, B1); PG8_BAR; PG8_SCHED;
            PG8_LDA(At, 1, 1); PG8_STAGE(PG8_SB(1, 0), b3, voffB); PG8_STAGE(PG8_SB(1, 1), b3 + hstep, voffB); PG8_STAGE_A(PG8_SA(1, 0), a3, 0);
            PG8_WAIT_V(8); PG8_WAIT_L(0); PG8_BAR; PG8_MMA(1, 0, At, B0); PG8_MMA(1, 1, At, B1); PG8_BAR; PG8_SCHED;
        }
        if (wr == 0) PG8_BAR;
        if constexpr (FP8) asm volatile("s_nop 15\n\ts_nop 15" ::: "memory");
        E(acc, cur, wr, wc, fr, fq);
        if (!has_next) break;
#pragma unroll
        for (int a = 0; a < 2; ++a)
#pragma unroll
            for (int b = 0; b < 2; ++b)
#pragma unroll
                for (int m = 0; m < 4; ++m)
#pragma unroll
                    for (int n = 0; n < 2; ++n) acc[a][b][m][n] = (f32x4){0.f, 0.f, 0.f, 0.f};
        cur = nxt; cA = nA; cB = nB; ++ui;
        if (wr == 1) PG8_BAR;
    }
    PG8_WAIT_V(0);
    PG8_BAR;
#undef PG8_SA
#undef PG8_SB
#undef PG8_STAGE
#undef PG8_STAGE_A
#undef PG8_GOFF
#undef PG8_LDA
#undef PG8_LDB
#undef PG8_MMA
#undef PG8_WAIT_V
#undef PG8_WAIT_L
#undef PG8_BAR
#undef PG8_SCHED
}
}

constexpr float Q_H2 = 8.0f, Q_W = 32.0f, Q_ACT = 4.0f;
__device__ __forceinline__ unsigned cvt4_fp8(float a, float b, float c, float d) { unsigned w = 0u; w = (unsigned)__builtin_amdgcn_cvt_pk_fp8_f32(a, b, (int)w, false); w = (unsigned)__builtin_amdgcn_cvt_pk_fp8_f32(c, d, (int)w, true); return w; }
struct EpiInProj {
    bf16_t* O;
    __device__ __forceinline__ void operator()(const f32x4 (&acc)[2][2][4][2], const pg8::Unit& u, int wr, int wc, int fr, int fq) const {
        const int row0 = u.pm * 256 + wr * 64 + fr, col0 = u.pn * 256 + wc * 32 + 8 * fq;
        const float sc = ((u.pn == 7 || u.pn == 8) ? QSCALE : 1.0f) * (1.0f / (Q_H2 * Q_W));
#pragma unroll
        for (int ai = 0; ai < 2; ++ai)
#pragma unroll
            for (int m = 0; m < 4; ++m) { bf16_t* rowp = O + (size_t)(row0 + ai * 128 + m * 16) * IC + col0;
#pragma unroll
                for (int bj = 0; bj < 2; ++bj) { const f32x4 v0 = acc[ai][bj][m][0] * sc, v1 = acc[ai][bj][m][1] * sc;
                    u32x4 w; w.x = cvtpk(v0[0], v0[1]); w.y = cvtpk(v0[2], v0[3]); w.z = cvtpk(v1[0], v1[1]); w.w = cvtpk(v1[2], v1[3]);
                    *(u32x4*)(rowp + bj * 128) = w; } }
    }
};
struct EpiOutProj {
    const float* x; const float* mod; bf16_t* O;
    __device__ __forceinline__ void operator()(const f32x4 (&acc)[2][2][4][2], const pg8::Unit& u, int wr, int wc, int fr, int fq) const {
        const int row0 = u.pm * 256 + wr * 64 + fr, col0 = u.pn * 256 + wc * 32 + 8 * fq;
        const int b = (u.pm * 256) / SEQ;
        const float* g1 = mod + b * 6144 + 2048;
        f32x4 gv[2][2];
#pragma unroll
        for (int bj = 0; bj < 2; ++bj)
#pragma unroll
            for (int n = 0; n < 2; ++n) gv[bj][n] = *(const f32x4*)(g1 + col0 + bj * 128 + 4 * n);
#pragma unroll
        for (int ai = 0; ai < 2; ++ai)
#pragma unroll
            for (int m = 0; m < 4; ++m) { const size_t off = (size_t)(row0 + ai * 128 + m * 16) * D + col0;
#pragma unroll
                for (int bj = 0; bj < 2; ++bj) { const f32x4 xa = *(const f32x4*)(x + off + bj * 128), xb = *(const f32x4*)(x + off + bj * 128 + 4);
                    const f32x4 v0 = xa + gv[bj][0] * acc[ai][bj][m][0], v1 = xb + gv[bj][1] * acc[ai][bj][m][1];
                    u32x4 w; w.x = cvtpk(v0[0], v0[1]); w.y = cvtpk(v0[2], v0[3]); w.z = cvtpk(v1[0], v1[1]); w.w = cvtpk(v1[2], v1[3]);
                    *(u32x4*)(O + off + bj * 128) = w; } }
    }
};
typedef float f32x2 __attribute__((ext_vector_type(2)));
struct EpiMoe1 {
    const float* bgu; unsigned char* O;
    __device__ __forceinline__ void operator()(const f32x4 (&acc)[2][2][4][2], const pg8::Unit& u, int wr, int wc, int fr, int fq) const {
        const int row0 = u.pm * 256 + wr * 64 + fr, col0 = u.pn * 128 + wc * 32 + 8 * fq;
        const float* bg = bgu + (size_t)u.e * 2048 + col0;
        constexpr float dq = 1.0f / (Q_H2 * Q_W), cc = -1.702f * LOG2E, qc = Q_ACT / cc;
        f32x2 bgc[2][2], buv[2][2];
#pragma unroll
        for (int n = 0; n < 2; ++n) { const f32x4 g4 = *(const f32x4*)(bg + 4 * n) * cc, u4 = *(const f32x4*)(bg + 1024 + 4 * n);
            bgc[n][0] = (f32x2){g4[0], g4[1]}; bgc[n][1] = (f32x2){g4[2], g4[3]}; buv[n][0] = (f32x2){u4[0], u4[1]}; buv[n][1] = (f32x2){u4[2], u4[3]}; }
#pragma unroll
        for (int ai = 0; ai < 2; ++ai)
#pragma unroll
            for (int m = 0; m < 4; ++m) { float a[8];
#pragma unroll
                for (int n = 0; n < 2; ++n)
#pragma unroll
                    for (int hp = 0; hp < 2; ++hp) { const f32x4 ag4 = acc[ai][0][m][n], au4 = acc[ai][1][m][n];
                        const f32x2 ag = (f32x2){ag4[2 * hp], ag4[2 * hp + 1]}, au = (f32x2){au4[2 * hp], au4[2 * hp + 1]};
                        f32x2 t = ag * (dq * cc) + bgc[n][hp];
                        t = (f32x2){fmaxf(t[0], 7.0f * cc), fmaxf(t[1], 7.0f * cc)};
                        const f32x2 d = (f32x2){__builtin_amdgcn_exp2f(t[0]), __builtin_amdgcn_exp2f(t[1])} + 1.0f;
                        const f32x2 sg = (f32x2){__builtin_amdgcn_rcpf(d[0]), __builtin_amdgcn_rcpf(d[1])};
                        f32x2 up = au * dq + buv[n][hp];
                        up = (f32x2){fminf(fmaxf(up[0], -7.0f), 7.0f), fminf(fmaxf(up[1], -7.0f), 7.0f)};
                        const f32x2 r = ((up * qc + qc) * t) * sg;
                        a[4 * n + 2 * hp] = r[0]; a[4 * n + 2 * hp + 1] = r[1]; }
                u32x2 w; w.x = cvt4_fp8(a[0], a[1], a[2], a[3]); w.y = cvt4_fp8(a[4], a[5], a[6], a[7]);
                *(u32x2*)(O + (size_t)(row0 + ai * 128 + m * 16) * 1024 + col0) = w; }
    }
};
struct EpiMoe2 {
    const float* bdn; bf16_t* O;
    __device__ __forceinline__ void operator()(const f32x4 (&acc)[2][2][4][2], const pg8::Unit& u, int wr, int wc, int fr, int fq) const {
        const int row0 = u.pm * 256 + wr * 64 + fr, col0 = u.pn * 256 + wc * 32 + 8 * fq;
        const float* bd = bdn + (size_t)u.e * 1024 + col0;
        constexpr float dq = 1.0f / (Q_ACT * Q_W);
        f32x4 bv[2][2];
#pragma unroll
        for (int bj = 0; bj < 2; ++bj)
#pragma unroll
            for (int n = 0; n < 2; ++n) bv[bj][n] = *(const f32x4*)(bd + bj * 128 + 4 * n);
#pragma unroll
        for (int ai = 0; ai < 2; ++ai)
#pragma unroll
            for (int m = 0; m < 4; ++m) { bf16_t* rowp = O + (size_t)(row0 + ai * 128 + m * 16) * 1024 + col0;
#pragma unroll
                for (int bj = 0; bj < 2; ++bj) { const f32x4 v0 = acc[ai][bj][m][0] * dq + bv[bj][0], v1 = acc[ai][bj][m][1] * dq + bv[bj][1];
                    u32x4 w; w.x = cvtpk(v0[0], v0[1]); w.y = cvtpk(v0[2], v0[3]); w.z = cvtpk(v1[0], v1[1]); w.w = cvtpk(v1[2], v1[3]);
                    *(u32x4*)(rowp + bj * 128) = w; } }
    }
};

__device__ __forceinline__ void phase_mod(const Params& p, unsigned char* lds, int G) {
    const int tid = opaque_tid(), lane = tid & 63, wave = tid >> 6;
    float* sc = (float*)lds;
    float* part = (float*)lds + 8192;
    const float* c = p.in[I_C];
    for (int i = tid; i < 8192; i += NTHREADS) { const int b = i & 7, k = i >> 3; const float cv = c[b * 1024 + k]; sc[k * 8 + b] = cv / (1.0f + __expf(-cv)); }
    __syncthreads();
    float* mod = (float*)(p.ws + WS_MOD);
    const float* mw = p.in[I_MODW]; const float* mb = p.in[I_MODB];
    for (int cg = (int)blockIdx.x; cg < 256; cg += G) {
        const int cc = lane & 31, kh = lane >> 5, k0 = wave * 128 + kh * 64, col = cg * 24 + (cc < 24 ? cc : 0);
        float acc[8];
#pragma unroll
        for (int b = 0; b < 8; ++b) acc[b] = 0.f;
        const float* wp = mw + (size_t)k0 * 6144 + col;
        const float* sp = sc + k0 * 8;
#pragma unroll 1
        for (int k = 0; k < 64; k += 16) { float wv[16];
#pragma unroll
            for (int u = 0; u < 16; ++u) wv[u] = wp[(size_t)(k + u) * 6144];
#pragma unroll
            for (int u = 0; u < 16; ++u) { const f32x4 s0 = *(const f32x4*)(sp + (k + u) * 8), s1 = *(const f32x4*)(sp + (k + u) * 8 + 4);
                acc[0] += s0[0] * wv[u]; acc[1] += s0[1] * wv[u]; acc[2] += s0[2] * wv[u]; acc[3] += s0[3] * wv[u]; acc[4] += s1[0] * wv[u]; acc[5] += s1[1] * wv[u]; acc[6] += s1[2] * wv[u]; acc[7] += s1[3] * wv[u]; } }
#pragma unroll
        for (int b = 0; b < 8; ++b) acc[b] += __shfl_xor(acc[b], 32);
        if (lane < 24) {
#pragma unroll
            for (int b = 0; b < 8; ++b) part[(wave * 24 + lane) * 8 + b] = acc[b]; }
        __syncthreads();
        if (tid < 192) { const int cl = tid >> 3, b = tid & 7; float sum = mb[cg * 24 + cl];
#pragma unroll
            for (int w = 0; w < 8; ++w) sum += part[(w * 24 + cl) * 8 + b];
            mod[b * 6144 + cg * 24 + cl] = sum; }
        __syncthreads();
    }
}
__device__ __forceinline__ void transpose_item(const float* W, int N, int k0, int n0, bf16_t* WT, int Kdst, int dst_row_base, bool gu_interleave, float* scr, int lane) {
#pragma unroll 4
    for (int i = 0; i < 16; ++i) { const int row = 4 * i + (lane >> 4), c4 = lane & 15;
        const f32x4 v = *(const f32x4*)(W + (size_t)(k0 + row) * N + n0 + 4 * c4);
        float* s = scr + row * 65 + 4 * c4; s[0] = v[0]; s[1] = v[1]; s[2] = v[2]; s[3] = v[3]; }
    asm volatile("s_waitcnt lgkmcnt(0)" ::: "memory");
    const int cch = lane & 7;
#pragma unroll
    for (int i = 0; i < 8; ++i) { const int n = 8 * i + (lane >> 3); const float* s = scr + (8 * cch) * 65 + n;
        u32x4 o; o.x = cvtpk(s[0], s[65]); o.y = cvtpk(s[2 * 65], s[3 * 65]); o.z = cvtpk(s[4 * 65], s[5 * 65]); o.w = cvtpk(s[6 * 65], s[7 * 65]);
        int nn = n0 + n;
        if (gu_interleave) nn = (nn < 1024) ? ((nn >> 7) * 256 + (nn & 127)) : (((nn - 1024) >> 7) * 256 + 128 + ((nn - 1024) & 127));
        *(u32x4*)(WT + (size_t)(dst_row_base + nn) * Kdst + k0 + 8 * cch) = o; }
    asm volatile("s_waitcnt lgkmcnt(0)" ::: "memory");
}
constexpr int CVT_WGS = 56;
struct CvtItem { const float* src; unsigned char* dst; int N; };
__device__ __forceinline__ CvtItem cvt_item(const Params& p, int r, int lane) {
    CvtItem c; constexpr int I_GU = 32 * 512;
    const int nq = lane & 7, kq = lane >> 3;
    if (r < I_GU) { const int e = r >> 9, rr = r & 511, k0 = (rr >> 6) * 128, n0 = (rr & 63) * 32; c.N = 2048;
        c.src = p.in[I_WGU] + (size_t)e * 1024 * 2048 + (size_t)(k0 + kq) * 2048 + n0 + 4 * nq;
        const int nn = n0 + 4 * nq, nd = (nn < 1024) ? ((nn >> 7) * 256 + (nn & 127)) : (((nn - 1024) >> 7) * 256 + 128 + ((nn - 1024) & 127));
        c.dst = p.ws + WS_WG_T + ((size_t)(e * 2048 + nd)) * 1024 + k0 + 16 * kq; }
    else if (r < I_GU + 32 * 256) { const int q = r - I_GU, e = q >> 8, rr = q & 255, k0 = (rr >> 5) * 128, n0 = (rr & 31) * 32; c.N = 1024;
        c.src = p.in[I_WDN] + (size_t)e * 1024 * 1024 + (size_t)(k0 + kq) * 1024 + n0 + 4 * nq;
        c.dst = p.ws + WS_WD_T + ((size_t)(e * 1024 + n0 + 4 * nq)) * 1024 + k0 + 16 * kq; }
    else { const int q = r - (I_GU + 32 * 256), k0 = (q / 104) * 128, n0 = (q % 104) * 32; c.N = IC;
        c.src = p.in[I_WIN] + (size_t)(k0 + kq) * IC + n0 + 4 * nq;
        c.dst = p.ws + WS_WIN_T + ((size_t)(n0 + 4 * nq)) * 1024 + k0 + 16 * kq; }
    return c;
}
__device__ __forceinline__ void phase_convert(const Params& p, unsigned char* lds, int cblk, int G, int part) {
    const int tid = opaque_tid(), lane = tid & 63, wave = tid >> 6;
    float* scr = (float*)lds + wave * (64 * 65);
    const int gw = cblk * NWAVES + wave, NGW = G * NWAVES;
    constexpr int I_OUT = 16 * 16, NFE = 32 * 512 + 32 * 256;
    bf16_t* wout_t = (bf16_t*)(p.ws + WS_WOUT_T);
    if (part == 0) {
    for (int it = gw; it < I_OUT; it += NGW) transpose_item(p.in[I_WOUT], D, (it / 16) * 64, (it % 16) * 64, wout_t, 1024, 0, false, scr, lane);
    }
    unsigned* sq = (unsigned*)scr;
    const int wr_off = (lane >> 3) * 9 + (lane & 7), rd_off = (16 * (lane >> 3)) * 9 + (lane & 7);
    const int NF = (part == 0) ? NFE + 8 * 104 : NFE;
    int r = (part == 0) ? NFE + gw : gw;
    if (r >= NF) return;
    CvtItem cur = cvt_item(p, r, lane);
    f32x4 v[16];
#pragma unroll
    for (int i = 0; i < 16; ++i) v[i] = *(const f32x4*)(cur.src + (size_t)(8 * i) * cur.N);
    for (;;) {
#pragma unroll
        for (int i = 0; i < 16; ++i) sq[wr_off + 8 * i * 9] = cvt4_fp8(Q_W * v[i][0], Q_W * v[i][1], Q_W * v[i][2], Q_W * v[i][3]);
        asm volatile("" ::: "memory");
        const int rn = r + NGW; const bool more = rn < NF;
        unsigned char* dst = cur.dst;
        if (more) { cur = cvt_item(p, rn, lane);
#pragma unroll
            for (int i = 0; i < 16; ++i) v[i] = *(const f32x4*)(cur.src + (size_t)(8 * i) * cur.N); }
        asm volatile("s_waitcnt lgkmcnt(0)" ::: "memory");
        unsigned d[16];
#pragma unroll
        for (int j = 0; j < 16; ++j) d[j] = sq[rd_off + j * 9];
        u32x4 o[4];
#pragma unroll
        for (int g = 0; g < 4; ++g) { const unsigned d0 = d[4 * g], d1 = d[4 * g + 1], d2 = d[4 * g + 2], d3 = d[4 * g + 3];
            const unsigned x = __builtin_amdgcn_perm(d1, d0, 0x05010400u), y = __builtin_amdgcn_perm(d1, d0, 0x07030602u), z = __builtin_amdgcn_perm(d3, d2, 0x05010400u), w = __builtin_amdgcn_perm(d3, d2, 0x07030602u);
            o[0][g] = __builtin_amdgcn_perm(z, x, 0x05040100u); o[1][g] = __builtin_amdgcn_perm(z, x, 0x07060302u); o[2][g] = __builtin_amdgcn_perm(w, y, 0x05040100u); o[3][g] = __builtin_amdgcn_perm(w, y, 0x07060302u); }
#pragma unroll
        for (int nn = 0; nn < 4; ++nn) *(u32x4*)(dst + (size_t)nn * 1024) = o[nn];
        asm volatile("" ::: "memory");
        if (!more) break;
        r = rn;
    }
}

__device__ __forceinline__ void phase_norm1(const Params& p, int G) {
    const int tid = opaque_tid(), lane = tid & 63, wave = tid >> 6;
    const int gw = (int)blockIdx.x * NWAVES + wave, NGW = G * NWAVES;
    const float* x = p.in[I_X]; const float* gain = p.in[I_N1G]; const float* mod = (const float*)(p.ws + WS_MOD);
    bf16_t* h = (bf16_t*)(p.ws + WS_H);
    int bprev = -1; f32x4 gsc[4], shf[4];
    for (int row = gw; row < T; row += NGW) {
        const int b = row / SEQ;
        if (b != bprev) { bprev = b;
#pragma unroll
            for (int j = 0; j < 4; ++j) { const int k = 4 * lane + 256 * j; gsc[j] = *(const f32x4*)(gain + k) * (*(const f32x4*)(mod + b * 6144 + 1024 + k) + 1.0f); shf[j] = *(const f32x4*)(mod + b * 6144 + k); } }
        const f32x4* xr = (const f32x4*)(x + (size_t)row * D) + lane;
        f32x4 v[4]; float s = 0.f;
#pragma unroll
        for (int j = 0; j < 4; ++j) { v[j] = xr[64 * j]; s += (v[j][0] * v[j][0] + v[j][1] * v[j][1]) + (v[j][2] * v[j][2] + v[j][3] * v[j][3]); }
        const float rstd = rsqrtf(wave_sum(s) * (1.0f / D) + NORM_EPS);
        unsigned* o4 = (unsigned*)((unsigned char*)h + (size_t)row * D) + lane;
#pragma unroll
        for (int j = 0; j < 4; ++j) {
            const f32x4 y = (v[j] * rstd) * gsc[j] + shf[j];
            o4[64 * j] = cvt4_fp8(Q_H2 * y[0], Q_H2 * y[1], Q_H2 * y[2], Q_H2 * y[3]); }
    }
}

constexpr size_t CTL_KMAX = 57344;
__device__ __forceinline__ void kmax_pass(const Params& p, int G) {
    const int tid = opaque_tid(), lane = tid & 63, wave = tid >> 6;
    const bf16_t* proj = (const bf16_t*)(p.ws + WS_PROJ);
    unsigned* km = (unsigned*)(p.ws + WS_CTL + CTL_KMAX);
    const int TPB = T / G;
    float mx = 0.f; const int tok0 = (int)blockIdx.x * TPB;
    for (int ti = wave; ti < TPB; ti += NWAVES) {
        const u32x4 kv = *(const u32x4*)(proj + (size_t)(tok0 + ti) * IC + RC + 512 + 8 * lane);
        float ss = 0.f;
#pragma unroll
        for (int j = 0; j < 4; ++j) { const float a = __uint_as_float(kv[j] << 16), bq = __uint_as_float(kv[j] & 0xffff0000u); ss += a * a + bq * bq; }
        ss += __shfl_xor(ss, 1); ss += __shfl_xor(ss, 2); ss += __shfl_xor(ss, 4);
        mx = fmaxf(mx, ss);
    }
    if ((lane & 7) == 0) atomicMax(km + (tok0 / SEQ) * 8 + (lane >> 3), __float_as_uint(mx));
}

__device__ __forceinline__ s16x4 vtr(const LAS unsigned char* pp) { typedef short v4i16_t __attribute__((ext_vector_type(4))); return __builtin_bit_cast(s16x4, __builtin_amdgcn_ds_read_tr16_b64_v4i16((LAS v4i16_t*)pp)); }
constexpr int ATT_BUF = 32768;
__device__ __forceinline__ float att_max3(float a, float b, float c) { float r; asm("v_max3_f32 %0, %1, %2, %3" : "=v"(r) : "v"(a), "v"(b), "v"(c)); return r; }
constexpr int ATT_QROWS = 128, ATT_NQB = SEQ / ATT_QROWS, ATT_UNITS = NB * 4 * ATT_NQB;
__device__ __forceinline__ void attn_unit(const Params& p, LAS unsigned char* lds, int b, int h, int qb, float lam) {
    const int tid = opaque_tid(), lane = tid & 63, wid = __builtin_amdgcn_readfirstlane(tid >> 6), r32 = lane & 31, hi = lane >> 5;
    const int c = wid & 1, qblk = wid >> 1;
    const bf16_t* proj = (const bf16_t*)(p.ws + WS_PROJ) + (size_t)b * SEQ * IC;
    const int q0 = qb * ATT_QROWS, qw0 = q0 + 32 * qblk;
    const bf16_t* Qb = proj + RC + h * 128 + c * 64;
    const bf16_t* Kb = proj + RC + 512 + h * 128;
    const bf16_t* Vb = proj + RC + 1024 + h * 128;
    const float slope = exp2f(-2.0f * (float)(h + 1)) * LOG2E;
    f32x16 o[4];
#pragma unroll
    for (int d = 0; d < 4; ++d) o[d] = f32x16{};
    f32x16 cb0;
#pragma unroll
    for (int r = 0; r < 16; ++r) cb0[r] = slope * (float)((r & 3) + 8 * (r >> 2) + 4 * hi);
    const float c32 = slope * 32.0f;
    float m_ = 0.f, l_ = 0.f;
    const int NT = (q0 + ATT_QROWS) / 64;
    const bf16_t* ksrc = Kb + (size_t)(wid * 8 + (lane >> 3)) * IC + (((lane & 7) ^ ((wid * 4 + (lane >> 4)) & 7)) * 8);
    const int p0i = wid, p1i = wid + 8;
    const bf16_t* vsrc0 = Vb + (size_t)(16 * (p0i & 3) + (lane >> 2)) * IC + (p0i >> 2) * 32 + (lane & 3) * 8;
    const bf16_t* vsrc1 = Vb + (size_t)(16 * (p1i & 3) + (lane >> 2)) * IC + (p1i >> 2) * 32 + (lane & 3) * 8;
#define ATT_GLDS(gsrc_, ldsdst_) do { unsigned keep_; asm volatile("s_mov_b32 %0, m0\n\ts_mov_b32 m0, %2\n\ts_nop 0\n\tglobal_load_lds_dwordx4 %1, off\n\ts_mov_b32 m0, %0" : "=&s"(keep_) : "v"(gsrc_), "s"(ldsdst_) : "memory"); } while (0)
    const unsigned lds0 = (unsigned)(uintptr_t)lds;
#define ATT_DMA(t, buf) do { const size_t ro = (size_t)(t) * 64 * IC; const unsigned bb_ = (unsigned)__builtin_amdgcn_readfirstlane((int)(lds0 + (buf) * ATT_BUF + wid * 1024)); \
        ATT_GLDS(ksrc + ro, bb_); ATT_GLDS(ksrc + ro + 64, bb_ + 8192u); ATT_GLDS(vsrc0 + ro, bb_ + 16384u); ATT_GLDS(vsrc1 + ro, bb_ + 16384u + 8192u); } while (0)
    ATT_DMA(NT - 1, 0); ATT_DMA(NT - 2, 1);
    bf16x8 qr[4];
#pragma unroll
    for (int d0 = 0; d0 < 4; ++d0) qr[d0] = *(const bf16x8*)(Qb + (size_t)(qw0 + r32) * IC + d0 * 16 + hi * 8);
    float qn;
    { float q2 = 0.f;
#pragma unroll
      for (int d0 = 0; d0 < 4; ++d0)
#pragma unroll
          for (int j = 0; j < 8; ++j) { const float x = bf2f((unsigned short)qr[d0][j]); q2 += x * x; }
      q2 += __shfl_xor(q2, 32);
      qn = sqrtf(q2 * ((const float*)(p.ws + WS_CTL + CTL_KMAX))[b * 8 + h * 2 + c]) * 1.002f + 0.01f; }
    asm volatile("" : "+v"(qr[0]), "+v"(qr[1]), "+v"(qr[2]), "+v"(qr[3]));
    asm volatile("s_waitcnt vmcnt(0)" ::: "memory");
    __builtin_amdgcn_s_barrier();
    const int voff = ((lane >> 4) & 1) * 32 + (lane & 3) * 8 + (4 * hi + ((lane & 15) >> 2)) * 64;
    const int qpos = qw0 + r32;
    const bool late = wid >= 4;
    bf16x8 pf[4]; bool pend = false;
    float mtrue = -INFINITY;
    LAS unsigned* vote = (LAS unsigned*)(lds + 4 * ATT_BUF + 64);
#define ATT_PV(slot_) do { const LAS unsigned char* vb_ = lds + (slot_) * ATT_BUF + 16384 + voff; \
        _Pragma("unroll") for (int dblk = 0; dblk < 4; ++dblk) { _Pragma("unroll") for (int ks = 0; ks < 4; ++ks) { \
            const s16x4 lo = vtr(vb_ + (dblk * 4 + ks) * 1024), hh = vtr(vb_ + (dblk * 4 + ks) * 1024 + 512); \
            const bf16x8 vf = (bf16x8){lo[0], lo[1], lo[2], lo[3], hh[0], hh[1], hh[2], hh[3]}; \
            o[dblk] = __builtin_amdgcn_mfma_f32_32x32x16_bf16(vf, pf[ks], o[dblk], 0, 0, 0); } } } while (0)
    int it = 0;
    for (; it < NT; ++it) {
        const int kt = NT - 1 - it, cur = it & 3;
        const bool issued = (it + 2 < NT);
        if (issued) ATT_DMA(kt - 2, (it + 2) & 3);
        const int k0 = kt * 64;
        if (late && pend) { ATT_PV((it - 1) & 3); pend = false; }
        if (k0 <= qw0 + 31) {
            const LAS unsigned char* bb = lds + cur * ATT_BUF;
            const bool need_mask = (k0 + 63 > qw0);
            const LAS unsigned char* kb = bb + c * 8192 + (r32 >> 3) * 1024 + (r32 & 7) * 128;
            const int kj0 = hi ^ ((r32 >> 1) & 7);
            f32x16 s0 = cb0, s1 = cb0;
#pragma unroll
            for (int d0 = 0; d0 < 4; ++d0) {
                const int ko = (kj0 ^ (2 * d0)) * 16;
                const bf16x8 a0 = *(const LAS bf16x8*)(kb + ko), a1 = *(const LAS bf16x8*)(kb + ko + 4096);
                s0 = __builtin_amdgcn_mfma_f32_32x32x16_bf16(a0, qr[d0], s0, 0, 0, 0);
                s1 = __builtin_amdgcn_mfma_f32_32x32x16_bf16(a1, qr[d0], s1, 0, 0, 0);
            }
            if (need_mask) {
                const int dq = k0 - qpos + 4 * hi;
#pragma unroll
                for (int r = 0; r < 16; ++r) { if (dq + ((r & 3) + 8 * (r >> 2)) > 0) s0[r] = -INFINITY; if (dq + ((r & 3) + 8 * (r >> 2)) + 32 > 0) s1[r] = -INFINITY; }
            }
            const float tb = slope * (float)(k0 - qpos);
            float rm0 = att_max3(s0[0], s0[1], s0[2]), rm1 = att_max3(s1[0], s1[1], s1[2]);
#pragma unroll
            for (int r = 3; r < 15; r += 2) { rm0 = att_max3(rm0, s0[r], s0[r + 1]); rm1 = att_max3(rm1, s1[r], s1[r + 1]); }
            float rm = att_max3(rm0, s0[15], att_max3(rm1, s1[15], -INFINITY) + c32);
            rm += tb;
            rm = fmaxf(rm, __shfl_xor(rm, 32));
            mtrue = fmaxf(mtrue, rm);
            if (__any(rm > m_ + 8.0f)) {
                const float mn = fmaxf(m_, rm);
                const float alpha = __builtin_amdgcn_exp2f(m_ - mn);
                m_ = mn; l_ *= alpha;
#pragma unroll
                for (int d = 0; d < 4; ++d)
#pragma unroll
                    for (int r = 0; r < 16; ++r) o[d][r] *= alpha;
            }
            const float off = tb - m_, off1 = off + c32;
            float ps = 0.f;
#pragma unroll
            for (int r = 0; r < 16; ++r) { s0[r] = __builtin_amdgcn_exp2f(s0[r] + off); s1[r] = __builtin_amdgcn_exp2f(s1[r] + off1); ps += s0[r] + s1[r]; }
            l_ += ps;
#pragma unroll
            for (int ks = 0; ks < 2; ++ks) {
                u32x4 w0, w1;
                w0.x = cvtpk(s0[8 * ks + 0], s0[8 * ks + 1]); w0.y = cvtpk(s0[8 * ks + 2], s0[8 * ks + 3]); w0.z = cvtpk(s0[8 * ks + 4], s0[8 * ks + 5]); w0.w = cvtpk(s0[8 * ks + 6], s0[8 * ks + 7]);
                w1.x = cvtpk(s1[8 * ks + 0], s1[8 * ks + 1]); w1.y = cvtpk(s1[8 * ks + 2], s1[8 * ks + 3]); w1.z = cvtpk(s1[8 * ks + 4], s1[8 * ks + 5]); w1.w = cvtpk(s1[8 * ks + 6], s1[8 * ks + 7]);
                pf[ks] = __builtin_bit_cast(bf16x8, w0); pf[2 + ks] = __builtin_bit_cast(bf16x8, w1);
            }
            if (late) pend = true; else ATT_PV(cur);
        }
        { const bool neg = (qn + slope * (float)(k0 - 1 - qpos) <= mtrue - 50.0f);
          if (lane == 0) vote[(it & 1) * 8 + wid] = __all(neg) ? 1u : 0u; }
        if (issued) asm volatile("s_waitcnt vmcnt(4)" ::: "memory"); else asm volatile("s_waitcnt vmcnt(0)" ::: "memory");
        asm volatile("s_waitcnt lgkmcnt(0)" ::: "memory");
        __builtin_amdgcn_s_barrier();
        { const u32x4 va = *(const LAS u32x4*)(vote + (it & 1) * 8), vb2 = *(const LAS u32x4*)(vote + (it & 1) * 8 + 4);
          if ((va.x & va.y & va.z & va.w & vb2.x & vb2.y & vb2.z & vb2.w) != 0u) { ++it; break; } }
    }
    if (late && pend) ATT_PV((it - 1) & 3);
    asm volatile("s_waitcnt vmcnt(0) lgkmcnt(0)" ::: "memory");
    __builtin_amdgcn_s_barrier();
#undef ATT_PV
#undef ATT_DMA
#undef ATT_GLDS
    l_ += __shfl_xor(l_, 32);
    LAS float* xb = (LAS float*)(lds + qblk * 16384);
    if (c == 1) {
        const float i1 = lam / l_;
#pragma unroll
        for (int d = 0; d < 4; ++d)
#pragma unroll
            for (int r = 0; r < 16; ++r) xb[(d * 16 + r) * 64 + lane] = o[d][r] * i1;
    }
    __syncthreads();
    if (c == 0) {
        const float i0 = 1.0f / l_;
        float ss = 0.f;
#pragma unroll
        for (int d = 0; d < 4; ++d)
#pragma unroll
            for (int r = 0; r < 16; ++r) { const float v = o[d][r] * i0 - xb[(d * 16 + r) * 64 + lane]; o[d][r] = v; ss += v * v; }
        ss += __shfl_xor(ss, 32);
        const float rstd = rsqrtf(ss * (1.0f / 128.0f) + NORM_EPS) * (1.0f - LAMBDA_INIT);
        const float* sg = p.in[I_SUBLN];
        bf16_t* yo = (bf16_t*)(p.ws + WS_YMIX) + (size_t)(b * SEQ + qw0 + r32) * D + RW + h * 128;
#pragma unroll
        for (int d = 0; d < 4; ++d)
#pragma unroll
            for (int g = 0; g < 4; ++g) { const int dd = 32 * d + 8 * g + 4 * hi; const f32x4 gv = *(const f32x4*)(sg + dd);
                u32x2 w; w.x = cvtpk(o[d][4 * g] * rstd * gv[0], o[d][4 * g + 1] * rstd * gv[1]); w.y = cvtpk(o[d][4 * g + 2] * rstd * gv[2], o[d][4 * g + 3] * rstd * gv[3]);
                *(u32x2*)(yo + dd) = w; }
    }
    __syncthreads();
}

constexpr int RCH = 32;
constexpr int RK_R = 0, RK_KM = 8192, RK_DEC = 16384, RK_KK = 24576, RK_BB = 32768, RK_VV = 40960, RK_GG = 49152;
constexpr int RK_AW = 57344;
constexpr int RK_AA = RK_AW + 4608;
constexpr int RK_AG = RK_AA + 4608;
constexpr int RK_BON = RK_AG + 8704;
constexpr int RK_MU = RK_BON + 128;
constexpr int RK_RAW = 77824;
constexpr int RK_IM = RK_RAW + 33 * 1024;
constexpr int RK_LSEG = RK_IM + OPREC;
constexpr int RK_END = RK_LSEG + 2048;
static_assert(RK_MU + 1792 <= RK_RAW && RK_END <= LDS_BYTES - 64 && (RK_RAW % 1024) == 0, "rwkv prep LDS map");
template <int CTRL> __device__ __forceinline__ float dpp_add(float v) { return v + __builtin_bit_cast(float, __builtin_amdgcn_update_dpp(0, __builtin_bit_cast(int, v), CTRL, 0xf, 0xf, true)); }
__device__ __forceinline__ float red16(float v) {
    v = dpp_add<0xB1>(v);
    v = dpp_add<0x4E>(v);
    v = dpp_add<0x141>(v);
    v = dpp_add<0x140>(v);
    return v;
}
__device__ __forceinline__ int rk_piece_col(int pc, int h) {
    return pc < 8 ? h * 64 + 8 * pc : (pc < 16 ? 512 + h * 64 + 8 * (pc - 8) : (pc < 24 ? 1024 + h * 64 + 8 * (pc - 16) : 1536 + 8 * (pc - 24)));
}
#define RK_BAR() do { asm volatile("s_waitcnt lgkmcnt(0)" ::: "memory"); __builtin_amdgcn_s_barrier(); asm volatile("" ::: "memory"); } while (0)
__device__ __forceinline__ void rwkv_prep(const Params& p, LAS unsigned char* lds, int b, int h, int ch0, int ch1) {
    const int tid = opaque_tid(), lane = tid & 63, wid = __builtin_amdgcn_readfirstlane(tid >> 6);
    const bf16_t* proj = (const bf16_t*)(p.ws + WS_PROJ) + (size_t)b * SEQ * IC;
    LAS float* R_ = (LAS float*)(lds + RK_R); LAS float* KM_ = (LAS float*)(lds + RK_KM); LAS float* DEC_ = (LAS float*)(lds + RK_DEC); LAS float* KK_ = (LAS float*)(lds + RK_KK);
    LAS float* BB_ = (LAS float*)(lds + RK_BB); LAS float* VV_ = (LAS float*)(lds + RK_VV); LAS float* GG_ = (LAS float*)(lds + RK_GG); LAS float* BON_ = (LAS float*)(lds + RK_BON);
    LAS float* MU_ = (LAS float*)(lds + RK_MU);
    const int dpc = lane < 56 ? lane : 55;
    const bf16_t* dsrc = proj + rk_piece_col(dpc, h);
#define RK_DMA(t0_) do { for (int rho = wid; rho < 33; rho += NWAVES) { int tok = (t0_) - 1 + rho; tok = tok < 0 ? 0 : tok; \
        __builtin_amdgcn_global_load_lds((const unsigned*)(dsrc + (size_t)tok * IC), (LAS unsigned*)(lds + RK_RAW + rho * 1024), 16, 0, 0); } } while (0)
    RK_DMA(ch0 * RCH);
    if (tid < 448) MU_[tid] = p.in[I_MU][rk_piece_col(tid >> 3, h) + (tid & 7)];
    const int ntile = wid & 3, ttile = wid >> 2, fn = lane & 15, fk = lane >> 4;
    const int ncol = h * 64 + ntile * 16 + fn;
    bf16x8 bw[2], ba[2], bg[4];
    {
        const float* wup = p.in[I_WUP]; const float* aup = p.in[I_AUP]; const float* gup = p.in[I_GUP];
#pragma unroll
        for (int ks = 0; ks < 2; ++ks) { float t[8], u[8];
#pragma unroll
            for (int j = 0; j < 8; ++j) { const int k = 32 * ks + 8 * fk + j; t[j] = wup[k * RW + ncol]; u[j] = aup[k * RW + ncol]; }
            u32x4 a, c; a.x = cvtpk(t[0], t[1]); a.y = cvtpk(t[2], t[3]); a.z = cvtpk(t[4], t[5]); a.w = cvtpk(t[6], t[7]);
            c.x = cvtpk(u[0], u[1]); c.y = cvtpk(u[2], u[3]); c.z = cvtpk(u[4], u[5]); c.w = cvtpk(u[6], u[7]);
            bw[ks] = __builtin_bit_cast(bf16x8, a); ba[ks] = __builtin_bit_cast(bf16x8, c); }
#pragma unroll
        for (int ks = 0; ks < 4; ++ks) { float t[8];
#pragma unroll
            for (int j = 0; j < 8; ++j) { const int k = 32 * ks + 8 * fk + j; t[j] = gup[k * RW + ncol]; }
            u32x4 a; a.x = cvtpk(t[0], t[1]); a.y = cvtpk(t[2], t[3]); a.z = cvtpk(t[4], t[5]); a.w = cvtpk(t[6], t[7]);
            bg[ks] = __builtin_bit_cast(bf16x8, a); }
    }
    const float w0n = p.in[I_W0][ncol], a0n = p.in[I_A0][ncol];
    const int q16 = tid & 15, tk16 = tid >> 4;
    const f32x4 kkc = *(const f32x4*)(p.in[I_KK] + h * 64 + 4 * q16), kac = *(const f32x4*)(p.in[I_KA] + h * 64 + 4 * q16), rkc = *(const f32x4*)(p.in[I_RK] + h * 64 + 4 * q16);
    const size_t hb = (size_t)(b * 8 + h) * SEQ * 64;
    bf16_t* gVS = (bf16_t*)(p.ws + WS_VS) + hb; bf16_t* gGG = (bf16_t*)(p.out + (size_t)16 * 1024 * 1024) + hb; float* gBON = (float*)(p.ws + WS_BON) + (size_t)(b * 8 + h) * SEQ;
    unsigned char* gOPS = p.ws + WS_OPS + (size_t)(b * 8 + h) * (SEQ / RCH) * OPREC;
    for (int ch = ch0; ch < ch1; ++ch) {
        const int t0 = ch * RCH;
        if (ch > ch0) { if (wid == 0) asm volatile("s_waitcnt vmcnt(8)" ::: "memory"); else if (wid == 1) asm volatile("s_waitcnt vmcnt(7)" ::: "memory"); else asm volatile("s_waitcnt vmcnt(6)" ::: "memory"); } else asm volatile("s_waitcnt vmcnt(0)" ::: "memory");
        RK_BAR();
#define RK_SHIFT(tk_, pc_) \
            const u32x4 cv = *(const LAS u32x4*)(lds + RK_RAW + ((tk_) + 1) * 1024 + (pc_) * 16); \
            u32x4 pv = *(const LAS u32x4*)(lds + RK_RAW + (tk_) * 1024 + (pc_) * 16); \
            if (t0 + (tk_) == 0) pv = (u32x4){0u, 0u, 0u, 0u}; \
            const f32x4 m0 = *(const LAS f32x4*)(MU_ + (pc_) * 8), m1 = *(const LAS f32x4*)(MU_ + (pc_) * 8 + 4); \
            float xv[8]; \
            _Pragma("unroll") for (int j = 0; j < 4; ++j) { const unsigned cw = cv[j], pw = pv[j]; \
                const float c0 = __uint_as_float(cw << 16), c1 = __uint_as_float(cw & 0xffff0000u), p0 = __uint_as_float(pw << 16), p1 = __uint_as_float(pw & 0xffff0000u); \
                const float ma = (j < 2) ? m0[2 * j] : m1[2 * j - 4], mb = (j < 2) ? m0[2 * j + 1] : m1[2 * j - 3]; \
                xv[2 * j] = c0 + ma * (p0 - c0); xv[2 * j + 1] = c1 + mb * (p1 - c1); }
#pragma unroll
        for (int it = 0; it < 4; ++it) { const int sidx = wid + 8 * it;
            if (sidx < 12) { const int a = sidx * 64 + lane, tk = a / 24, pc = a - tk * 24, seg = pc >> 3, pi = pc & 7;
                RK_SHIFT(tk, pc)
                LAS float* dst = (seg == 0 ? R_ : (seg == 1 ? KM_ : VV_)) + tk * 64 + 8 * pi;
                *(LAS f32x4*)dst = (f32x4){xv[0], xv[1], xv[2], xv[3]}; *(LAS f32x4*)(dst + 4) = (f32x4){xv[4], xv[5], xv[6], xv[7]}; }
            else if (sidx < 16) { const int a = (sidx - 12) * 64 + lane, tk = a >> 3, pi = a & 7, pc = 24 + pi;
                RK_SHIFT(tk, pc)
                u32x4 w; w.x = cvtpk(tanh_fast(xv[0]), tanh_fast(xv[1])); w.y = cvtpk(tanh_fast(xv[2]), tanh_fast(xv[3])); w.z = cvtpk(tanh_fast(xv[4]), tanh_fast(xv[5])); w.w = cvtpk(tanh_fast(xv[6]), tanh_fast(xv[7]));
                *(LAS u32x4*)(lds + RK_AW + tk * 144 + 16 * pi) = w; }
            else if (sidx < 20) { const int a = (sidx - 16) * 64 + lane, tk = a >> 3, pi = a & 7, pc = 32 + pi;
                RK_SHIFT(tk, pc)
                u32x4 w; w.x = cvtpk(xv[0], xv[1]); w.y = cvtpk(xv[2], xv[3]); w.z = cvtpk(xv[4], xv[5]); w.w = cvtpk(xv[6], xv[7]);
                *(LAS u32x4*)(lds + RK_AA + tk * 144 + 16 * pi) = w; }
            else if (sidx < 28) { const int a = (sidx - 20) * 64 + lane, tk = a >> 4, pg = a & 15, pc = 40 + pg;
                RK_SHIFT(tk, pc)
                u32x4 w; w.x = cvtpk(sigmoidf_(xv[0]), sigmoidf_(xv[1])); w.y = cvtpk(sigmoidf_(xv[2]), sigmoidf_(xv[3])); w.z = cvtpk(sigmoidf_(xv[4]), sigmoidf_(xv[5])); w.w = cvtpk(sigmoidf_(xv[6]), sigmoidf_(xv[7]));
                *(LAS u32x4*)(lds + RK_AG + tk * 272 + pg * 16) = w; }
        }
#undef RK_SHIFT
        __syncthreads();
        if (ch + 1 < ch1) RK_DMA(t0 + RCH);
        {
            f32x4 cw = (f32x4){0.f, 0.f, 0.f, 0.f}, ca = cw, cg2 = cw;
            const int tok = ttile * 16 + fn;
#pragma unroll
            for (int ks = 0; ks < 2; ++ks) {
                const bf16x8 aw = *(const LAS bf16x8*)(lds + RK_AW + tok * 144 + (32 * ks + 8 * fk) * 2);
                const bf16x8 aa = *(const LAS bf16x8*)(lds + RK_AA + tok * 144 + (32 * ks + 8 * fk) * 2);
                cw = __builtin_amdgcn_mfma_f32_16x16x32_bf16(aw, bw[ks], cw, 0, 0, 0);
                ca = __builtin_amdgcn_mfma_f32_16x16x32_bf16(aa, ba[ks], ca, 0, 0, 0);
            }
#pragma unroll
            for (int ks = 0; ks < 4; ++ks) {
                const bf16x8 ag = *(const LAS bf16x8*)(lds + RK_AG + tok * 272 + (32 * ks + 8 * fk) * 2);
                cg2 = __builtin_amdgcn_mfma_f32_16x16x32_bf16(ag, bg[ks], cg2, 0, 0, 0);
            }
#pragma unroll
            for (int r = 0; r < 4; ++r) { const int tk = ttile * 16 + 4 * fk + r, n = ntile * 16 + fn;
                DEC_[tk * 64 + n] = -0.6065306597126334f * sigmoidf_(cw[r] + w0n);
                BB_[tk * 64 + n] = sigmoidf_(ca[r] + a0n);
                GG_[tk * 64 + n] = cg2[r]; }
        }
        RK_BAR();
        {
            const f32x4 kp = *(const LAS f32x4*)(KM_ + tk16 * 64 + 4 * q16), av = *(const LAS f32x4*)(BB_ + tk16 * 64 + 4 * q16), rr = *(const LAS f32x4*)(R_ + tk16 * 64 + 4 * q16);
            const f32x4 kkv = kp * kkc;
            const float nrm2 = red16((kkv[0] * kkv[0] + kkv[1] * kkv[1]) + (kkv[2] * kkv[2] + kkv[3] * kkv[3]));
            const f32x4 kkn = kkv * __builtin_amdgcn_rsqf(fmaxf(nrm2, 1e-24f));
            const f32x4 kmod = kp * ((av - 1.0f) * kac + 1.0f);
            const f32x4 t = rr * kmod * rkc;
            const float bs = red16((t[0] + t[1]) + (t[2] + t[3]));
            *(LAS f32x4*)(KK_ + tk16 * 64 + 4 * q16) = kkn; *(LAS f32x4*)(BB_ + tk16 * 64 + 4 * q16) = kkn * av; *(LAS f32x4*)(KM_ + tk16 * 64 + 4 * q16) = kmod;
            if (q16 == 0) BON_[tk16] = bs;
        }
        RK_BAR();
        {
            const int d1 = tid & 63, q1 = wid;
            float lw[4], cs[4];
#pragma unroll
            for (int e = 0; e < 4; ++e) lw[e] = DEC_[(4 * q1 + e) * 64 + d1];
            cs[0] = lw[0]; cs[1] = cs[0] + lw[1]; cs[2] = cs[1] + lw[2]; cs[3] = cs[2] + lw[3];
            ((LAS float*)(lds + RK_LSEG))[q1 * 64 + d1] = cs[3];
            { const float x0 = VV_[(4 * q1) * 64 + d1], x1 = VV_[(4 * q1 + 1) * 64 + d1], x2 = VV_[(4 * q1 + 2) * 64 + d1], x3 = VV_[(4 * q1 + 3) * 64 + d1];
              u32x2 w; w.x = cvtpk(x0, x1); w.y = cvtpk(x2, x3); *(LAS u32x2*)(lds + RK_IM + OP_VT + d1 * 80 + q1 * 8) = w; }
            RK_BAR();
            float off = 0.f, tot = 0.f;
#pragma unroll
            for (int qq = 0; qq < 8; ++qq) { const float sg = ((const LAS float*)(lds + RK_LSEG))[qq * 64 + d1]; tot += sg; if (qq < q1) off += sg; }
            const float etot = __expf(tot);
            float ePprev = __expf(off);
            float bc[4], kc4[4];
#pragma unroll
            for (int e = 0; e < 4; ++e) { const int tk = 4 * q1 + e;
                const float eP = __expf(off + cs[e]), eN = __builtin_amdgcn_rcpf(eP), eE = etot * eN;
                const float kap = KK_[tk * 64 + d1], bet = BB_[tk * 64 + d1], kk_ = KM_[tk * 64 + d1], rr = R_[tk * 64 + d1];
                const unsigned w0 = cvtpk(-kap * ePprev, rr * eP), w1 = cvtpk(bet * eN, kk_ * eN);
                *(LAS unsigned short*)(lds + RK_IM + OP_AT + tk * 144 + d1 * 2) = (unsigned short)(w0 & 0xffffu); *(LAS unsigned short*)(lds + RK_IM + OP_RT + tk * 144 + d1 * 2) = (unsigned short)(w0 >> 16);
                *(LAS unsigned short*)(lds + RK_IM + OP_BH + tk * 144 + d1 * 2) = (unsigned short)(w1 & 0xffffu); *(LAS unsigned short*)(lds + RK_IM + OP_KH + tk * 144 + d1 * 2) = (unsigned short)(w1 >> 16);
                bc[e] = bet * eE; kc4[e] = kk_ * eE; ePprev = eP; }
            u32x2 wb, wk; wb.x = cvtpk(bc[0], bc[1]); wb.y = cvtpk(bc[2], bc[3]); wk.x = cvtpk(kc4[0], kc4[1]); wk.y = cvtpk(kc4[2], kc4[3]);
            *(LAS u32x2*)(lds + RK_IM + OP_BCT + d1 * 80 + q1 * 8) = wb; *(LAS u32x2*)(lds + RK_IM + OP_KCT + d1 * 80 + q1 * 8) = wk;
            if (q1 == 0) ((LAS float*)(lds + RK_IM + OP_P31))[d1] = etot;
        }
        RK_BAR();
        {
            unsigned char* rec = gOPS + (size_t)ch * OPREC;
#pragma unroll
            for (int i = 0; i < 5; ++i) { const int o = (tid + i * NTHREADS) * 16; if (o < OPREC) *(u32x4*)(rec + o) = *(const LAS u32x4*)(lds + RK_IM + o); }
            const size_t go = (size_t)t0 * 64 + tid * 4;
            { const f32x4 a = *(const LAS f32x4*)(VV_ + tid * 4), c = *(const LAS f32x4*)(GG_ + tid * 4);
              u32x2 wa, wc; wa.x = cvtpk(a[0], a[1]); wa.y = cvtpk(a[2], a[3]); wc.x = cvtpk(c[0], c[1]); wc.y = cvtpk(c[2], c[3]);
              *(u32x2*)(gVS + go) = wa; *(u32x2*)(gGG + go) = wc; }
            if (tid < RCH) gBON[t0 + tid] = BON_[tid];
        }
    }
    asm volatile("s_waitcnt vmcnt(0)" ::: "memory");
    __syncthreads();
#undef RK_DMA
}

constexpr int CS_IN = 36864;
constexpr int CS_OP = 2 * CS_IN;
constexpr int CS_AT = OP_AT, CS_RT = OP_RT, CS_BH = OP_BH, CS_KH = OP_KH, CS_BCT = OP_BCT, CS_KCT = OP_KCT, CS_VT = OP_VT, CS_P31 = OP_P31;
constexpr int CS_MT2 = CS_OP, CS_MT3 = CS_OP + 2560, CS_MT4 = CS_OP + 5120;
constexpr int CS_UB = CS_OP + 7680;
constexpr int CS_SB = CS_UB + 5120;
constexpr int CS_YY = CS_SB + 9216;
constexpr int CS_PW = CS_YY + 8192;
constexpr int CS_PFLAG = CS_PW + 10240;
constexpr int CS_END = CS_PFLAG + 64;
static_assert(CS_END <= LDS_BYTES - 64 && OPREC == 34 * 1024, "rwkv scan LDS map");
__device__ __forceinline__ int crow32(int r, int hi) { return (r & 3) + 8 * (r >> 2) + 4 * hi; }
__device__ __forceinline__ void rwkv_scan(const Params& p, LAS unsigned char* lds, int b, int h) {
    const int tid = opaque_tid(), lane = tid & 63, wid = __builtin_amdgcn_readfirstlane(tid >> 6), r32 = lane & 31, hi = lane >> 5;
    const unsigned char* gOPS = p.ws + WS_OPS + (size_t)(b * 8 + h) * (SEQ / RCH) * OPREC;
    const int tkf = tid >> 4, q16 = tid & 15;
    const bf16_t* gVSh = (const bf16_t*)(p.ws + WS_VS) + (size_t)(b * 8 + h) * SEQ * 64 + 4 * q16; const bf16_t* gGGh = (const bf16_t*)(p.out + (size_t)16 * 1024 * 1024) + (size_t)(b * 8 + h) * SEQ * 64 + 4 * q16;
    const float* gBONh = (const float*)(p.ws + WS_BON) + (size_t)(b * 8 + h) * SEQ;
    bf16_t* ymixh = (bf16_t*)(p.ws + WS_YMIX) + (size_t)b * SEQ * D + h * 64 + 4 * q16;
    const f32x4 gng = *(const f32x4*)(p.in[I_GNG] + h * 64 + 4 * q16), gnb = *(const f32x4*)(p.in[I_GNB] + h * 64 + 4 * q16);
#define RS_DMA(ch_, buf) do { if (wid >= 4) { LAS unsigned char* bb_ = lds + (buf) * CS_IN; const unsigned char* rec_ = gOPS + (size_t)(ch_) * OPREC + lane * 16; \
        for (int pc = wid - 4; pc < 34; pc += 4) __builtin_amdgcn_global_load_lds((const unsigned*)(rec_ + pc * 1024), (LAS unsigned*)(bb_ + pc * 1024), 16, 0, 0); } } while (0)
    RS_DMA(0, 0);
    for (int i = tid; i < 9216 / 4; i += NTHREADS) ((LAS unsigned*)(lds + CS_SB))[i] = 0u;
    if (tid == 0) *(volatile LAS int*)(lds + CS_PFLAG) = 0;
    const int vh = (wid < 4) ? (wid >> 1) : (wid & 1), dt = wid & 1;
    f32x16 Sacc = f32x16{};
    f32x16 Xacc = f32x16{};
    for (int ch = 0; ch < SEQ / RCH; ++ch) {
        const int t0 = ch * RCH, cur = ch & 1;
        if (ch > 0) asm volatile("s_waitcnt vmcnt(1)" ::: "memory"); else asm volatile("s_waitcnt vmcnt(0)" ::: "memory");
        RK_BAR();
        const u32x2 vw = *(const u32x2*)(gVSh + (size_t)(t0 + tkf) * 64), gw2 = *(const u32x2*)(gGGh + (size_t)(t0 + tkf) * 64);
        const float bon = gBONh[t0 + tkf];
        if (ch + 1 < SEQ / RCH) RS_DMA(ch + 1, cur ^ 1);
        const LAS unsigned char* ib = lds + cur * CS_IN;
        f32x16 accP = f32x16{}, accPT = f32x16{};
#define RS_PACK(dst0, dst1, a_) do { u32x4 w0_, w1_; \
            w0_.x = cvtpk((a_)[0], (a_)[1]); w0_.y = cvtpk((a_)[2], (a_)[3]); w0_.z = cvtpk((a_)[4], (a_)[5]); w0_.w = cvtpk((a_)[6], (a_)[7]); \
            w1_.x = cvtpk((a_)[8], (a_)[9]); w1_.y = cvtpk((a_)[10], (a_)[11]); w1_.z = cvtpk((a_)[12], (a_)[13]); w1_.w = cvtpk((a_)[14], (a_)[15]); \
            dst0 = __builtin_bit_cast(bf16x8, w0_); dst1 = __builtin_bit_cast(bf16x8, w1_); } while (0)
        LAS unsigned char* pwl = lds + CS_PW + lane * 16;
        bf16x8 pf0, pf1, tf0, tf1;
        if (wid < 4) {
            const int mi = (wid + 1) & 3;
            const LAS unsigned char* Am = ib + ((mi & 1) ? CS_KH : CS_BH) + r32 * 144 + hi * 16;
            const LAS unsigned char* Bm = ib + ((mi & 2) ? CS_RT : CS_AT) + r32 * 144 + hi * 16;
            f32x16 acc = f32x16{};
#pragma unroll
            for (int ks = 0; ks < 4; ++ks) acc = __builtin_amdgcn_mfma_f32_32x32x16_bf16(*(const LAS bf16x8*)(Am + ks * 32), *(const LAS bf16x8*)(Bm + ks * 32), acc, 0, 0, 0);
            const int lim = (mi < 2) ? r32 : r32 + 1;
#pragma unroll
            for (int rg = 0; rg < 16; ++rg) if (crow32(rg, hi) >= lim) acc[rg] = 0.f;
            if (mi == 0) {
                accP = acc;
#pragma unroll
                for (int ks = 0; ks < 4; ++ks) accPT = __builtin_amdgcn_mfma_f32_32x32x16_bf16(*(const LAS bf16x8*)(Bm + ks * 32), *(const LAS bf16x8*)(Am + ks * 32), accPT, 0, 0, 0);
#pragma unroll
                for (int rg = 0; rg < 16; ++rg) if (crow32(rg, hi) <= r32) accPT[rg] = 0.f;
                RS_PACK(pf0, pf1, accP); RS_PACK(tf0, tf1, accPT);
                *(LAS bf16x8*)(pwl) = pf0; *(LAS bf16x8*)(pwl + 1024) = pf1;
            } else {
                LAS unsigned char* Mt = lds + (mi == 1 ? CS_MT2 : (mi == 2 ? CS_MT3 : CS_MT4)) + r32 * 80 + hi * 8;
#pragma unroll
                for (int g = 0; g < 4; ++g) { u32x2 w; w.x = cvtpk(acc[4 * g], acc[4 * g + 1]); w.y = cvtpk(acc[4 * g + 2], acc[4 * g + 3]); *(LAS u32x2*)(Mt + g * 16) = w; }
            }
        } else {
            const LAS unsigned char* Am = ib + (wid < 6 ? CS_AT : CS_RT) + r32 * 144 + hi * 16;
            const LAS unsigned char* Bm = lds + CS_SB + (32 * vh + r32) * 144 + hi * 16;
            Xacc = f32x16{};
#pragma unroll
            for (int ks = 0; ks < 4; ++ks) Xacc = __builtin_amdgcn_mfma_f32_32x32x16_bf16(*(const LAS bf16x8*)(Am + ks * 32), *(const LAS bf16x8*)(Bm + ks * 32), Xacc, 0, 0, 0);
        }
        RK_BAR();
        const LAS unsigned char* Bv = ib + CS_VT + (32 * vh + r32) * 80 + hi * 16;
        if (wid == 3) {
#pragma unroll
            for (int k = 1; k < 5; ++k) {
                f32x16 nP = __builtin_amdgcn_mfma_f32_32x32x16_bf16(tf0, pf0, f32x16{}, 0, 0, 0), nT = __builtin_amdgcn_mfma_f32_32x32x16_bf16(pf0, tf0, f32x16{}, 0, 0, 0);
                nP = __builtin_amdgcn_mfma_f32_32x32x16_bf16(tf1, pf1, nP, 0, 0, 0); nT = __builtin_amdgcn_mfma_f32_32x32x16_bf16(pf1, tf1, nT, 0, 0, 0);
                if (k > 1) {
                    *(LAS bf16x8*)(pwl + (k - 1) * 2048) = pf0; *(LAS bf16x8*)(pwl + (k - 1) * 2048 + 1024) = pf1;
                    asm volatile("s_waitcnt lgkmcnt(0)" ::: "memory");
                    if (lane == 0) *(volatile LAS int*)(lds + CS_PFLAG) = ch * 8 + k - 1; }
                RS_PACK(pf0, pf1, nP); RS_PACK(tf0, tf1, nT);
            }
            *(LAS bf16x8*)(pwl + 4 * 2048) = pf0; *(LAS bf16x8*)(pwl + 4 * 2048 + 1024) = pf1;
            asm volatile("s_waitcnt lgkmcnt(0)" ::: "memory");
            if (lane == 0) *(volatile LAS int*)(lds + CS_PFLAG) = ch * 8 + 4;
        }
        if (wid < 4) {
#pragma unroll
            for (int g = 0; g < 4; ++g) { const f32x4 pv = *(const LAS f32x4*)(ib + CS_P31 + (32 * dt + 8 * g + 4 * hi) * 4);
                Sacc[4 * g] *= pv[0]; Sacc[4 * g + 1] *= pv[1]; Sacc[4 * g + 2] *= pv[2]; Sacc[4 * g + 3] *= pv[3]; }
            const LAS unsigned char* Ak = ib + CS_KCT + (32 * dt + r32) * 80 + hi * 16;
#pragma unroll
            for (int ks = 0; ks < 2; ++ks) Sacc = __builtin_amdgcn_mfma_f32_32x32x16_bf16(*(const LAS bf16x8*)(Ak + ks * 32), *(const LAS bf16x8*)(Bv + ks * 32), Sacc, 0, 0, 0);
        } else if (wid >= 6) {
            const LAS unsigned char* A4 = lds + CS_MT4 + r32 * 80 + hi * 16;
#pragma unroll
            for (int ks = 0; ks < 2; ++ks) Xacc = __builtin_amdgcn_mfma_f32_32x32x16_bf16(*(const LAS bf16x8*)(A4 + ks * 32), *(const LAS bf16x8*)(Bv + ks * 32), Xacc, 0, 0, 0);
        } else {
            { const LAS unsigned char* Am = lds + CS_MT2 + r32 * 80 + hi * 16;
#pragma unroll
                for (int ks = 0; ks < 2; ++ks) Xacc = __builtin_amdgcn_mfma_f32_32x32x16_bf16(*(const LAS bf16x8*)(Am + ks * 32), *(const LAS bf16x8*)(Bv + ks * 32), Xacc, 0, 0, 0); }
#pragma unroll
            for (int k = 0; k < 5; ++k) {
                bf16x8 u0, u1; RS_PACK(u0, u1, Xacc);
                if (k > 0) { const int want = ch * 8 + k; while (*(volatile LAS int*)(lds + CS_PFLAG) < want) { } asm volatile("" ::: "memory"); }
                const bf16x8 a0 = *(const LAS bf16x8*)(pwl + k * 2048), a1 = *(const LAS bf16x8*)(pwl + k * 2048 + 1024);
                Xacc = __builtin_amdgcn_mfma_f32_32x32x16_bf16(a0, u0, Xacc, 0, 0, 0);
                Xacc = __builtin_amdgcn_mfma_f32_32x32x16_bf16(a1, u1, Xacc, 0, 0, 0);
            }
#pragma unroll
            for (int g = 0; g < 4; ++g) { u32x2 w; w.x = cvtpk(Xacc[4 * g], Xacc[4 * g + 1]); w.y = cvtpk(Xacc[4 * g + 2], Xacc[4 * g + 3]); *(LAS u32x2*)(lds + CS_UB + (32 * vh + r32) * 80 + (8 * g + 4 * hi) * 2) = w; }
        }
#undef RS_PACK
        RK_BAR();
        const LAS unsigned char* Bu = lds + CS_UB + (32 * vh + r32) * 80 + hi * 16;
        if (wid >= 6) {
            const LAS unsigned char* A3 = lds + CS_MT3 + r32 * 80 + hi * 16;
#pragma unroll
            for (int ks = 0; ks < 2; ++ks) Xacc = __builtin_amdgcn_mfma_f32_32x32x16_bf16(*(const LAS bf16x8*)(A3 + ks * 32), *(const LAS bf16x8*)(Bu + ks * 32), Xacc, 0, 0, 0);
#pragma unroll
            for (int rg = 0; rg < 16; ++rg) ((LAS float*)(lds + CS_YY))[crow32(rg, hi) * 64 + 32 * vh + r32] = Xacc[rg];
        } else if (wid < 4) {
            const LAS unsigned char* Ab = ib + CS_BCT + (32 * dt + r32) * 80 + hi * 16;
#pragma unroll
            for (int ks = 0; ks < 2; ++ks) Sacc = __builtin_amdgcn_mfma_f32_32x32x16_bf16(*(const LAS bf16x8*)(Ab + ks * 32), *(const LAS bf16x8*)(Bu + ks * 32), Sacc, 0, 0, 0);
#pragma unroll
            for (int g = 0; g < 4; ++g) { u32x2 w; w.x = cvtpk(Sacc[4 * g], Sacc[4 * g + 1]); w.y = cvtpk(Sacc[4 * g + 2], Sacc[4 * g + 3]); *(LAS u32x2*)(lds + CS_SB + (32 * vh + r32) * 144 + (32 * dt + 8 * g + 4 * hi) * 2) = w; }
        }
        RK_BAR();
        { const f32x4 y = *(const LAS f32x4*)(lds + CS_YY + tkf * 256 + q16 * 16);
            const f32x4 vv = (f32x4){__uint_as_float(vw.x << 16), __uint_as_float(vw.x & 0xffff0000u), __uint_as_float(vw.y << 16), __uint_as_float(vw.y & 0xffff0000u)};
            const f32x4 gg = (f32x4){__uint_as_float(gw2.x << 16), __uint_as_float(gw2.x & 0xffff0000u), __uint_as_float(gw2.y << 16), __uint_as_float(gw2.y & 0xffff0000u)};
            const float mean = red16((y[0] + y[1]) + (y[2] + y[3])) * (1.0f / 64.0f);
            const f32x4 dl = y - mean;
            const float var = red16((dl[0] * dl[0] + dl[1] * dl[1]) + (dl[2] * dl[2] + dl[3] * dl[3])) * (1.0f / 64.0f);
            const f32x4 yn = dl * __builtin_amdgcn_rsqf(var + GN_EPS) * gng + gnb;
            const f32x4 ov = (yn + vv * bon) * gg;
            u32x2 w; w.x = cvtpk(ov[0], ov[1]); w.y = cvtpk(ov[2], ov[3]);
            *(u32x2*)(ymixh + (size_t)(t0 + tkf) * D) = w; }
    }
    asm volatile("s_waitcnt vmcnt(0)" ::: "memory");
    __syncthreads();
#undef RS_DMA
}
#undef RK_BAR

constexpr int RT_X = 0;
constexpr int RT_LG = 131584;
constexpr int RT_GS = RT_LG + 16896;
constexpr int RT_RS = RT_GS + 8192;
constexpr int RT_HIST = RT_RS + 512;
constexpr int RT_CE = RT_HIST + 128;
static_assert(RT_CE + 1024 <= LDS_BYTES - 64, "router LDS map");
__device__ __forceinline__ int rt_swz(int k) { const int g = k >> 2; return ((g ^ ((g >> 4) & 3)) << 2) | (k & 3); }
__device__ __forceinline__ void phase_router(const Params& p, LAS unsigned char* lds, int G) {
    const int tid = opaque_tid(), lane = tid & 63, wave = __builtin_amdgcn_readfirstlane(tid >> 6);
    LAS float* xt = (LAS float*)(lds + RT_X); LAS float* lg = (LAS float*)(lds + RT_LG); LAS float* gs = (LAS float*)(lds + RT_GS); LAS float* shl = gs + 1024;
    LAS float* rsl = (LAS float*)(lds + RT_RS); LAS int* hist = (LAS int*)(lds + RT_HIST); LAS float* cew = (LAS float*)(lds + RT_CE);
    const float* rw = p.in[I_RTW];
    const unsigned char* x1 = p.ws + WS_X1; const float* gain = p.in[I_N2G]; const float* mod = (const float*)(p.ws + WS_MOD); const float* rb = p.in[I_RTB];
    unsigned char* h2q = p.ws + WS_H;
    int* ridx = (int*)(p.ws + WS_ROUTE); float* rwt = (float*)(p.ws + WS_ROUTE + 512 * 1024);
    int* blockcnt = (int*)(p.ws + WS_CTL + 4096);
    const int TPB = T / G;
    const int blk = blockIdx.x, tok0 = blk * TPB, b = tok0 / SEQ;
    for (int k = tid; k < 1024; k += NTHREADS) { gs[rt_swz(k)] = gain[k] * (1.0f + mod[b * 6144 + 4096 + k]); shl[rt_swz(k)] = mod[b * 6144 + 3072 + k]; }
    if (tid < 32) hist[tid] = 0;
    __syncthreads();
    const int j = lane & 31, hh = lane >> 5, kb = 128 * wave + 64 * hh;
    float breg[64];
    { float cpart = 0.f;
#pragma unroll
        for (int s_ = 0; s_ < 64; ++s_) { const float w = rw[(size_t)(kb + s_) * 32 + j]; cpart += shl[rt_swz(kb + s_)] * w; breg[s_] = w * gs[rt_swz(kb + s_)]; }
        cpart += __shfl_xor(cpart, 32);
        if (lane < 32) cew[wave * 32 + lane] = cpart; }
    const int xsw = (2 * wave + hh) & 3;
    for (int t0 = 0; t0 < TPB; t0 += 128) {
        u32x4 v[8];
#define RT_LOAD(tl_) do { _Pragma("unroll") for (int q = 0; q < 4; ++q) { const int tq = t0 + 32 * (tl_) + 4 * wave + q; const u32x4* xr = (const u32x4*)(x1 + (size_t)(tok0 + (tq < TPB ? tq : 0)) * (2 * D)) + lane; \
            _Pragma("unroll") for (int jj = 0; jj < 2; ++jj) v[2 * q + jj] = xr[64 * jj]; } } while (0)
        RT_LOAD(0);
#pragma unroll
        for (int tl = 0; tl < 4; ++tl) {
#pragma unroll
            for (int q = 0; q < 4; ++q) { float s = 0.f; f32x4 t[4];
#pragma unroll
                for (int jj = 0; jj < 2; ++jj) { const u32x4 w = v[2 * q + jj];
                    t[2 * jj] = (f32x4){__uint_as_float(w.x << 16), __uint_as_float(w.x & 0xffff0000u), __uint_as_float(w.y << 16), __uint_as_float(w.y & 0xffff0000u)};
                    t[2 * jj + 1] = (f32x4){__uint_as_float(w.z << 16), __uint_as_float(w.z & 0xffff0000u), __uint_as_float(w.w << 16), __uint_as_float(w.w & 0xffff0000u)}; }
#pragma unroll
                for (int jj = 0; jj < 4; ++jj) s += (t[jj][0] * t[jj][0] + t[jj][1] * t[jj][1]) + (t[jj][2] * t[jj][2] + t[jj][3] * t[jj][3]);
                const float rstd = rsqrtf(wave_sum(s) * (1.0f / D) + NORM_EPS);
                if (lane == 0) rsl[32 * tl + 4 * wave + q] = rstd;
#pragma unroll
                for (int jj = 0; jj < 4; ++jj) { const int g = 2 * lane + 128 * (jj >> 1) + (jj & 1); *(LAS f32x4*)(xt + (4 * wave + q) * 1028 + 4 * (g ^ ((g >> 4) & 3))) = t[jj]; } }
            if (tl < 3) RT_LOAD(tl + 1);
            __syncthreads();
            f32x16 acc = f32x16{};
            { const LAS float* arow = xt + (lane & 31) * 1028 + kb;
#pragma unroll
                for (int c = 0; c < 16; ++c) { const f32x4 a4 = *(const LAS f32x4*)(arow + 4 * (c ^ xsw));
                    acc = __builtin_amdgcn_mfma_f32_32x32x2f32(a4[0], breg[4 * c + 0], acc, 0, 0, 0);
                    acc = __builtin_amdgcn_mfma_f32_32x32x2f32(a4[1], breg[4 * c + 1], acc, 0, 0, 0);
                    acc = __builtin_amdgcn_mfma_f32_32x32x2f32(a4[2], breg[4 * c + 2], acc, 0, 0, 0);
                    acc = __builtin_amdgcn_mfma_f32_32x32x2f32(a4[3], breg[4 * c + 3], acc, 0, 0, 0); } }
            { const int hsw = (lane >> 2) & 3;
#pragma unroll
                for (int q = 0; q < 4; ++q) { const int tq = t0 + 32 * tl + 4 * wave + q; const float rstd = rsl[32 * tl + 4 * wave + q]; u32x4 o;
#pragma unroll
                    for (int u = 0; u < 4; ++u) { const int go = 4 * ((4 * lane + u) ^ hsw);
                        const f32x4 xv = *(const LAS f32x4*)(xt + (4 * wave + q) * 1028 + go), g4 = *(const LAS f32x4*)(gs + go), s4 = *(const LAS f32x4*)(shl + go);
                        const f32x4 y = (xv * rstd) * g4 + s4;
                        o[u] = cvt4_fp8(Q_H2 * y[0], Q_H2 * y[1], Q_H2 * y[2], Q_H2 * y[3]); }
                    if (tq < TPB) *(u32x4*)(h2q + (size_t)(tok0 + tq) * D + 16 * lane) = o; } }
            __syncthreads();
            { LAS float* part = (LAS float*)(lds + RT_X);
#pragma unroll
                for (int r = 0; r < 16; ++r) part[wave * 1024 + r * 64 + lane] = acc[r];
                __syncthreads();
                const int e = tid & 31; float ce = rb[e];
#pragma unroll
                for (int w = 0; w < 8; ++w) ce += cew[w * 32 + e];
#pragma unroll
                for (int q = 0; q < 2; ++q) { const int idx = tid + 512 * q; float sum = 0.f;
#pragma unroll
                    for (int w = 0; w < 8; ++w) sum += part[w * 1024 + idx];
                    const int r = idx >> 6, tk = 32 * tl + (r & 3) + 8 * (r >> 2) + 4 * ((idx >> 5) & 1);
                    lg[tk * 33 + e] = rsl[tk] * sum + ce; }
                __syncthreads(); }
        }
#undef RT_LOAD
        if (tid < 128 && t0 + tid < TPB) {
            const int row = tok0 + t0 + tid; const LAS float* lr = lg + tid * 33;
            float v0 = -INFINITY, v1 = -INFINITY, v2 = -INFINITY, v3 = -INFINITY; int i0 = 0, i1 = 0, i2 = 0, i3 = 0;
#pragma unroll
            for (int e = 0; e < 32; ++e) { const float x = lr[e];
                if (x > v0) { v3 = v2; i3 = i2; v2 = v1; i2 = i1; v1 = v0; i1 = i0; v0 = x; i0 = e; }
                else if (x > v1) { v3 = v2; i3 = i2; v2 = v1; i2 = i1; v1 = x; i1 = e; }
                else if (x > v2) { v3 = v2; i3 = i2; v2 = x; i2 = e; }
                else if (x > v3) { v3 = x; i3 = e; } }
            const float e1 = __expf(v1 - v0), e2 = __expf(v2 - v0), e3 = __expf(v3 - v0); const float inv = 1.0f / (1.0f + e1 + e2 + e3);
            *(int4*)(ridx + (size_t)row * 4) = make_int4(i0, i1, i2, i3); *(float4*)(rwt + (size_t)row * 4) = make_float4(inv, e1 * inv, e2 * inv, e3 * inv);
            atomicAdd((int*)&hist[i0], 1); atomicAdd((int*)&hist[i1], 1); atomicAdd((int*)&hist[i2], 1); atomicAdd((int*)&hist[i3], 1);
        }
        __syncthreads();
    }
    if (tid < 32) blockcnt[blk * 32 + tid] = hist[tid];
    __syncthreads();
}

__device__ __forceinline__ void phase_assign(const Params& p, LAS unsigned char* lds, int G) {
    const int tid = opaque_tid(), lane = tid & 63, wave = tid >> 6;
    LAS int* part = (LAS int*)lds;
    LAS int* partb = part + 512;
    LAS int* total = partb + 512;
    LAS int* base = total + 32;
    LAS int* segst = base + 32;
    LAS int* cursor = segst + 32;
    LAS int* slotl = cursor + 32;
    const int* blockcnt = (const int*)(p.ws + WS_CTL + 4096);
    const int* ridx = (const int*)(p.ws + WS_ROUTE); int* rslot = (int*)(p.ws + WS_ROUTE + 1024 * 1024); int* tokmap = (int*)(p.ws + WS_ROUTE + 2 * 1024 * 1024);
    const bf16_t* h2 = (const bf16_t*)(p.ws + WS_H); bf16_t* xs = (bf16_t*)(p.ws + WS_PROJ);
    int* tile = (int*)(p.ws + WS_TILE);
    const int TPB = T / G; const int blk = blockIdx.x;
    { const int e = tid & 31, part_i = tid >> 5; int st = 0, sb = 0;
        if (G == 256) { int cv[16];
#pragma unroll
            for (int i = 0; i < 16; ++i) cv[i] = blockcnt[(part_i + 16 * i) * 32 + e];
#pragma unroll
            for (int i = 0; i < 16; ++i) { st += cv[i]; if (part_i + 16 * i < blk) sb += cv[i]; } }
        else for (int bb = part_i; bb < G; bb += 16) { const int c = blockcnt[bb * 32 + e]; st += c; if (bb < blk) sb += c; }
        part[part_i * 32 + e] = st; partb[part_i * 32 + e] = sb; }
    __syncthreads();
    if (tid < 32) { int st = 0, sb = 0;
#pragma unroll
        for (int i = 0; i < 16; ++i) { st += part[i * 32 + tid]; sb += partb[i * 32 + tid]; }
        total[tid] = st; base[tid] = sb; cursor[tid] = 0; }
    __syncthreads();
    if (tid == 0) { int acc = 0; for (int e = 0; e < 32; ++e) { segst[e] = acc; acc += (total[e] + 255) & ~255; } }
    if (blk == 0 && tid >= 64 && tid < 96) { const int e = tid - 64; int pm = 0;
        for (int e2 = 0; e2 < e; ++e2) pm += (total[e2] + 255) >> 8;
        const int nt = (total[e] + 255) >> 8;
        for (int i = 0; i < nt; ++i) tile[16 + pm + i] = e;
        if (e == 31) tile[0] = pm + nt; }
    __syncthreads();
    if (tid < 32) base[tid] += segst[tid];
    __syncthreads();
    for (int a = tid; a < TPB * 4; a += NTHREADS) { const int tok = blk * TPB + (a >> 2); const int e = ridx[(size_t)tok * 4 + (a & 3)];
        const int rank = atomicAdd((int*)&cursor[e], 1); const int slot = base[e] + rank; rslot[(size_t)tok * 4 + (a & 3)] = slot; tokmap[slot] = tok; }
    for (int e = blk; e < 32; e += G) { const int s0 = segst[e] + total[e], s1 = segst[e] + ((total[e] + 255) & ~255);
        for (int r = s0 + tid; r < s1; r += NTHREADS) tokmap[r] = 0; }
}

__device__ __forceinline__ void phase_final(const Params& p, int G, int stage) {
    const int tid = opaque_tid(), lane = tid & 63, wave = tid >> 6;
    const int gw = (int)blockIdx.x * NWAVES + wave, NGW = G * NWAVES;
    const float* fg = p.in[I_FG]; const float* mod = (const float*)(p.ws + WS_MOD);
    const int* rslot = (const int*)(p.ws + WS_ROUTE + 1024 * 1024); const float* rwt = (const float*)(p.ws + WS_ROUTE + 512 * 1024);
    const bf16_t* Y = (const bf16_t*)(p.ws + WS_PROJ);
    const bf16_t* X1 = (const bf16_t*)(p.ws + WS_X1);
    f32x4 fgr[4], g2r[4]; int bprev = -1;
#pragma unroll
    for (int j = 0; j < 4; ++j) fgr[j] = *(const f32x4*)(fg + 4 * lane + 256 * j);
    for (int row = gw; row < T; row += NGW) {
        const int b = row / SEQ;
        if (b != bprev) { bprev = b;
#pragma unroll
            for (int j = 0; j < 4; ++j) g2r[j] = *(const f32x4*)(mod + b * 6144 + 5120 + 4 * lane + 256 * j); }
        f32x4 v[4];
        if (stage >= 4) {
#pragma unroll
            for (int j = 0; j < 4; ++j) { const u32x2 xv = *((const u32x2*)(X1 + (size_t)row * D) + lane + 64 * j);
                v[j] = (f32x4){__uint_as_float(xv.x << 16), __uint_as_float(xv.x & 0xffff0000u), __uint_as_float(xv.y << 16), __uint_as_float(xv.y & 0xffff0000u)}; }
        } else {
            const f32x4* xr = (const f32x4*)(p.in[I_X] + (size_t)row * D) + lane;
#pragma unroll
            for (int j = 0; j < 4; ++j) v[j] = xr[64 * j];
        }
        if (stage >= 9) {
            const int4 sl = *(const int4*)(rslot + (size_t)row * 4); const float4 wt = *(const float4*)(rwt + (size_t)row * 4);
            const int sls[4] = {sl.x, sl.y, sl.z, sl.w}; const float wts[4] = {wt.x, wt.y, wt.z, wt.w};
#pragma unroll
            for (int j = 0; j < 4; ++j) { f32x4 m = (f32x4){0.f, 0.f, 0.f, 0.f};
#pragma unroll
                for (int k = 0; k < 4; ++k) { const u32x2 yv = *((const u32x2*)(Y + (size_t)sls[k] * D) + lane + 64 * j);
                    m[0] += wts[k] * __uint_as_float(yv.x << 16); m[1] += wts[k] * __uint_as_float(yv.x & 0xffff0000u); m[2] += wts[k] * __uint_as_float(yv.y << 16); m[3] += wts[k] * __uint_as_float(yv.y & 0xffff0000u); }
                v[j] = v[j] + g2r[j] * m; }
        }
        float s = 0.f;
#pragma unroll
        for (int j = 0; j < 4; ++j) s += (v[j][0] * v[j][0] + v[j][1] * v[j][1]) + (v[j][2] * v[j][2] + v[j][3] * v[j][3]);
        const float rstd = rsqrtf(wave_sum(s) * (1.0f / D) + NORM_EPS);
        f32x4* orow = (f32x4*)(p.out + (size_t)row * D) + lane;
#pragma unroll
        for (int j = 0; j < 4; ++j) orow[64 * j] = v[j] * rstd * fgr[j];
    }
}


#define XB_TMO      128
#define XB_XCNT(j)  (256  + 64 * (j))
#define XB_XSUB(j)  (1280 + 64 * (j))
#define XB_XGEN(j)  (2304 + 64 * (j))
#define XB_TOP      3328
#define XB_TOPGEN   3392
#define XCD_BAR_WORDS 3456
#define XB_SPIN_CAP (1u << 22)
__device__ __forceinline__ unsigned xb_ld(unsigned* p)              { return __hip_atomic_load(p, __ATOMIC_RELAXED, __HIP_MEMORY_SCOPE_AGENT); }
__device__ __forceinline__ unsigned xb_add(unsigned* p, unsigned v) { return __hip_atomic_fetch_add(p, v, __ATOMIC_RELAXED, __HIP_MEMORY_SCOPE_AGENT); }
__device__ __forceinline__ unsigned xb_xcc_id() { return (unsigned)__builtin_amdgcn_s_getreg((3 << 11) | 20) & 0xFu; }
#define XB_SPIN(cond, bar) do { unsigned _sp = 0; while (cond) { __builtin_amdgcn_s_sleep(1); \
    if ((++_sp & 255u) == 0u) { if (xb_ld(&(bar)[XB_TMO])) break; if (_sp > XB_SPIN_CAP) { atomicAdd(&(bar)[XB_TMO], 1u); break; } } } } while (0)
struct XcdBarrier { unsigned* bar; unsigned x; volatile LAS unsigned* st; };
__device__ __forceinline__ XcdBarrier xcd_barrier_post(unsigned* bar, volatile LAS unsigned* st) {
    XcdBarrier b; b.bar = bar; b.x = xb_xcc_id(); b.st = st;
    if (threadIdx.x == 0) (void)xb_add(&bar[XB_XCNT(b.x)], 1u);
    return b;
}
__device__ __forceinline__ void xcd_barrier_complete(unsigned* bar, unsigned x, unsigned& nloc, unsigned& nx) {
    const unsigned G = gridDim.x * gridDim.y * gridDim.z;
    unsigned sum, cnt, mine, sp = 0u;
    for (;;) {
        sum = 0u; cnt = 0u; mine = 0u;
#pragma unroll
        for (unsigned j = 0; j < 16; ++j) { const unsigned c = xb_ld(&bar[XB_XCNT(j)]); sum += c; cnt += (c > 0u) ? 1u : 0u; mine = (j == x) ? c : mine; }
        if (sum == G) break;
        __builtin_amdgcn_s_sleep(1);
        if ((++sp & 255u) == 0u) { if (xb_ld(&bar[XB_TMO])) break; if (sp > XB_SPIN_CAP) { atomicAdd(&bar[XB_TMO], 1u); break; } }
    }
    nloc = mine > 0u ? mine : 1u; nx = cnt > 0u ? cnt : 1u;
}
__device__ __forceinline__ void xcd_barrier(const XcdBarrier& b) {
    asm volatile("s_waitcnt vmcnt(0)" ::: "memory");
    __syncthreads();
    if (threadIdx.x == 0) {
        unsigned* bar = b.bar;
        __builtin_amdgcn_s_waitcnt(0);
        unsigned nloc = b.st[0], nx = b.st[1];
        if (nloc == 0u) { xcd_barrier_complete(bar, b.x, nloc, nx); b.st[0] = nloc; b.st[1] = nx; }
        const unsigned old = xb_add(&bar[XB_XSUB(b.x)], 1u);
        const unsigned gen = old / nloc;
        if (old + 1u == (gen + 1u) * nloc) {
            __builtin_amdgcn_fence(__ATOMIC_RELEASE, "agent");
            asm volatile("s_waitcnt vmcnt(0)" ::: "memory");
            const unsigned og = xb_add(&bar[XB_TOP], 1u);
            const unsigned tg = og / nx;
            if (og + 1u == (tg + 1u) * nx) xb_add(&bar[XB_TOPGEN], 1u);
            else XB_SPIN(xb_ld(&bar[XB_TOPGEN]) == tg, bar);
            __builtin_amdgcn_fence(__ATOMIC_ACQUIRE, "agent");
            xb_add(&bar[XB_XGEN(b.x)], 1u);
            asm volatile("s_waitcnt vmcnt(0)" ::: "memory");
        } else {
            XB_SPIN(xb_ld(&bar[XB_XGEN(b.x)]) == gen, bar);
            __builtin_amdgcn_fence(__ATOMIC_ACQUIRE, "agent");
            asm volatile("s_waitcnt vmcnt(0)" ::: "memory");
        }
    }
    __syncthreads();
}

__device__ __forceinline__ const Params* launder_params(const Params* q) { asm volatile("" : "+s"(q)); return q; }
__global__ void __launch_bounds__(NTHREADS, 2) hymba_fwd(Params p) {
    extern __shared__ __attribute__((aligned(16))) unsigned char lds_raw[];
    cg::grid_group grid = cg::this_grid();
    LAS unsigned char* lds = (LAS unsigned char*)lds_raw;
    const int G = gridDim.x, tid = threadIdx.x;
    constexpr int STAGE = DBG_STAGE;
    volatile LAS unsigned* xst = (volatile LAS unsigned*)(lds + LDS_BYTES - 64);
    if (tid == 0) { xst[0] = 0u; xst[1] = 0u; }
    __syncthreads();
    const XcdBarrier xbar = xcd_barrier_post((unsigned*)(p.ws + WS_CTL + 40960), xst);
#define GRID_BAR() xcd_barrier(xbar)

    phase_mod(p, lds_raw, G);
    if (G == 0x7fffffff) grid.sync();
    GRID_BAR();
    if (STAGE >= 2) { phase_norm1(p, G); phase_convert(p, lds_raw, (int)blockIdx.x, G, 0); GRID_BAR(); }
    if (STAGE >= 2) {
        pg8::Gemm g{(const bf16_t*)(p.ws + WS_H), (const bf16_t*)(p.ws + WS_WIN_T), D / 2, nullptr};
        pg8::DenseSched S; S.o.init(T / 256, IC / 256, G, (int)blockIdx.x);
        EpiInProj E{(bf16_t*)(p.ws + WS_PROJ)};
        pg8::gemm_phase<false, true>(lds, g, S, E);
        GRID_BAR();
    }
    if (STAGE >= 3) {
        kmax_pass(p, G);
        for (int it = blockIdx.x; it < NB * 8 * 4; it += G) rwkv_prep(p, lds, it >> 5, (it >> 2) & 7, (it & 3) * 32, (it & 3) * 32 + 32);
        GRID_BAR();
    }
    if (STAGE >= 2) {
        if (STAGE >= 3) { for (int u = blockIdx.x; u < NB * 8; u += G) rwkv_scan(p, lds, u >> 3, u & 7); }
        else {
            bf16_t* ymix = (bf16_t*)(p.ws + WS_YMIX);
            for (size_t i = (size_t)blockIdx.x * NTHREADS + tid; i < (size_t)T * 64; i += (size_t)G * NTHREADS) { const size_t row = i >> 6, c = i & 63; *(u32x4*)(ymix + row * D + c * 8) = (u32x4){0u, 0u, 0u, 0u}; }
        }
        if (STAGE >= 9 && G >= NB * 8 + CVT_WGS && (int)blockIdx.x >= NB * 8 && (int)blockIdx.x < NB * 8 + CVT_WGS) phase_convert(p, lds_raw, (int)blockIdx.x - NB * 8, CVT_WGS, 1);
        float lam;
        { const float* q1 = p.in[I_LQ1]; const float* k1 = p.in[I_LK1]; const float* q2 = p.in[I_LQ2]; const float* k2 = p.in[I_LK2]; float s1 = 0.f, s2 = 0.f;
            for (int i = 0; i < 64; ++i) { s1 += q1[i] * k1[i]; s2 += q2[i] * k2[i]; } lam = expf(s1) - expf(s2) + LAMBDA_INIT; }
        unsigned* qhead = (unsigned*)(p.ws + WS_CTL);
        LAS unsigned* ubox = (LAS unsigned*)(lds + 4 * ATT_BUF);
        for (;;) {
            __syncthreads();
            if (tid == 0) ubox[0] = atomicAdd(qhead, 1u);
            __syncthreads();
            const unsigned u = (unsigned)__builtin_amdgcn_readfirstlane((int)ubox[0]);
            if (u >= (unsigned)ATT_UNITS) break;
            attn_unit(p, lds, (int)(u & 31u) >> 2, (int)(u & 3u), ATT_NQB - 1 - (int)(u >> 5), lam);
        }
        GRID_BAR();

    }
    if (STAGE >= 2) {
        pg8::Gemm g{(const bf16_t*)(p.ws + WS_YMIX), (const bf16_t*)(p.ws + WS_WOUT_T), D, nullptr};
        pg8::DenseSched S; S.o.init(T / 256, D / 256, G, (int)blockIdx.x);
        EpiOutProj E{p.in[I_X], (const float*)(p.ws + WS_MOD), (bf16_t*)(p.ws + WS_X1)};
        pg8::gemm_phase<false, false>(lds, g, S, E);
        GRID_BAR();
    }
    if (STAGE >= 9) {
        phase_router(p, lds, G);
        GRID_BAR();
        phase_assign(p, lds, G);
        __syncthreads();
        if (G < NB * 8 + CVT_WGS) phase_convert(p, lds_raw, (int)blockIdx.x, G, 1);
        GRID_BAR();
        const int* tile = (const int*)(p.ws + WS_TILE);
        const int MT = tile[0];
        LAS int* tile_l = (LAS int*)(lds + 131072);
        for (int i = tid; i < MT; i += NTHREADS) tile_l[i] = tile[16 + i];
        __syncthreads();
        {
            pg8::Gemm g{(const bf16_t*)(p.ws + WS_H), (const bf16_t*)(p.ws + WS_WG_T), D / 2, (const int*)(p.ws + WS_ROUTE + 2 * 1024 * 1024)};
            pg8::MoeSched S; S.o.init(MT, 8, G, (int)blockIdx.x); S.tile_e = tile_l; S.N = 2048;
            EpiMoe1 E{p.in[I_BGU], p.ws + WS_ACT};
            pg8::gemm_phase<true, true>(lds, g, S, E);
        }
        GRID_BAR();
        {
            pg8::Gemm g{(const bf16_t*)(p.ws + WS_ACT), (const bf16_t*)(p.ws + WS_WD_T), D / 2, nullptr};
            pg8::MoeSched S; S.o.init(MT, 4, G, (int)blockIdx.x); S.tile_e = tile_l; S.N = 1024;
            EpiMoe2 E{p.in[I_BDN], (bf16_t*)(p.ws + WS_PROJ)};
            pg8::gemm_phase<false, true>(lds, g, S, E);
        }
        GRID_BAR();
    }
    phase_final(p, G, STAGE >= 9 ? 9 : (STAGE >= 2 ? 4 : 0));
}

extern "C" void kernel_launch(void* const* d_in, const int* in_sizes, int n_in, void* d_out, int out_size, void* d_ws, size_t ws_size, hipStream_t stream) {
    static int grid = 0;
    if (grid == 0) {
        if (n_in != 31 || out_size != T * D || ws_size < WS_END) { fprintf(stderr, "kernel_launch: unexpected shapes (n_in %d out %d ws %zu)\n", n_in, out_size, ws_size); grid = -1; return; }
        int dev = 0, cus = 0, per_cu = 0;
        hipGetDevice(&dev);
        hipDeviceGetAttribute(&cus, hipDeviceAttributeMultiprocessorCount, dev);
        hipFuncSetAttribute((const void*)hymba_fwd, hipFuncAttributeMaxDynamicSharedMemorySize, LDS_BYTES);
        hipOccupancyMaxActiveBlocksPerMultiprocessor(&per_cu, (const void*)hymba_fwd, NTHREADS, LDS_BYTES);
        if (per_cu < 1) { fprintf(stderr, "kernel_launch: occupancy query returned %d\n", per_cu); grid = -1; return; }
        grid = cus;
        if (grid > 256) grid = 256;
        while (T % grid != 0) --grid;
        (void)hipGetLastError();
    }
    if (grid < 0) return;
    hipMemsetAsync((char*)d_ws + WS_CTL, 0, CTL_BYTES, stream);
    Params p{};
    for (int i = 0; i < 31; ++i) p.in[i] = (const float*)d_in[i];
    p.out = (float*)d_out; p.ws = (unsigned char*)d_ws;
    void* args[] = {&p};
    hipError_t e = hipLaunchCooperativeKernel((const void*)hymba_fwd, dim3(grid), dim3(NTHREADS), args, LDS_BYTES, stream);
    if (e != hipSuccess) fprintf(stderr, "cooperative launch failed: %s (grid %d)\n", hipGetErrorString(e), grid);
}
```
